# Optimizing an MI355X kernel written in HIP

```python
import math
import jax, jax.numpy as jnp
from jax import lax
import numpy as np

D_MODEL = 1024
BATCH = 4
SEQ = 8192
DEPTH = 4

CONV_WIDTH = 512
CONV_KSIZE = 3
ATTN_HEADS = 8
HEAD_DIM = 64
ATTN_WIDTH = ATTN_HEADS * HEAD_DIM
IDX_HEADS = 8
IDX_DIM = 64
INDEX_TOPK = 256
Q_BLOCK = 128
ROPE_THETA = 10000.0
POOL_WINDOWS = (2, 4, 8, 16)
POOL_GROUPS = 4
POOL_WIDTH = 512
POOL_GROUP_DIM = POOL_WIDTH // POOL_GROUPS
N_BRANCHES = 3
RMS_EPS = 1e-6

IN_SPLITS = (CONV_WIDTH, CONV_WIDTH, CONV_WIDTH, CONV_WIDTH,
             ATTN_WIDTH, ATTN_WIDTH, ATTN_WIDTH, ATTN_WIDTH,
             IDX_HEADS * IDX_DIM, IDX_DIM, IDX_HEADS,
             POOL_WIDTH, POOL_WIDTH,
             N_BRANCHES * D_MODEL)
IN_WIDTH = 4 * CONV_WIDTH + 4 * ATTN_WIDTH + IDX_HEADS * IDX_DIM + IDX_DIM + IDX_HEADS + 2 * POOL_WIDTH + N_BRANCHES * D_MODEL

kernel_name = "hybrid_gated_conv_dsa_pool_trunk"


def rms_norm(x, g):
    xf = x.astype(jnp.float32)
    y = xf * lax.rsqrt(jnp.mean(xf * xf, axis=-1, keepdims=True) + RMS_EPS)
    return (y * g.astype(jnp.float32)).astype(x.dtype)


def split_columns(p):
    out = []
    off = 0
    for n in IN_SPLITS:
        out.append(p[..., off:off + n])
        off += n
    return out


def rope_tables(seq_len, dim):
    inv = 1.0 / (ROPE_THETA ** (jnp.arange(0, dim, 2, dtype=jnp.float32) / dim))
    ang = jnp.arange(seq_len, dtype=jnp.float32)[:, None] * inv[None, :]
    return jnp.cos(ang), jnp.sin(ang)


def apply_rope(x, cos, sin):
    xf = x.astype(jnp.float32)
    half = xf.shape[-1] // 2
    x1, x2 = xf[..., :half], xf[..., half:]
    c, s = cos[None, :, None, :], sin[None, :, None, :]
    return jnp.concatenate([x1 * c - x2 * s, x2 * c + x1 * s], axis=-1).astype(x.dtype)


def short_conv_mixer(b, c, xin, gate, conv_w, w_out):
    S = xin.shape[1]
    z = c * xin
    zp = jnp.pad(z, ((0, 0), (CONV_KSIZE - 1, 0), (0, 0)))
    y = conv_w[0] * zp[:, 0:S]
    for j in range(1, CONV_KSIZE):
        y = y + conv_w[j] * zp[:, j:j + S]
    y = b * y * jax.nn.silu(gate)
    return y @ w_out


def sparse_attention_mixer(q, k, v, gate, iq, ik, iw, q_g, k_g, cos, sin, w_out):
    B, S, _ = q.shape
    q = apply_rope(rms_norm(q.reshape(B, S, ATTN_HEADS, HEAD_DIM), q_g), cos, sin)
    k = apply_rope(rms_norm(k.reshape(B, S, ATTN_HEADS, HEAD_DIM), k_g), cos, sin)
    v = v.reshape(B, S, ATTN_HEADS, HEAD_DIM)
    iq = apply_rope(iq.reshape(B, S, IDX_HEADS, IDX_DIM), cos, sin)
    ik = apply_rope(ik[:, :, None, :], cos, sin)[:, :, 0, :]
    top_k = min(INDEX_TOPK, S // 4)
    nb = S // Q_BLOCK

    def to_blocks(a):
        return jnp.swapaxes(a.reshape((B, nb, Q_BLOCK) + a.shape[2:]), 0, 1)

    starts = jnp.arange(nb, dtype=jnp.int32) * Q_BLOCK
    key_pos = jnp.arange(S, dtype=jnp.int32)

    def block_fn(args):
        qb, iqb, iwb, t0 = args
        tq = t0 + jnp.arange(Q_BLOCK, dtype=jnp.int32)
        sc = jnp.einsum('bqhd,bsd->bqhs', iqb, ik).astype(jnp.float32) * (IDX_DIM ** -0.5)
        score = jnp.einsum('bqhs,bqh->bqs', jax.nn.relu(sc), iwb.astype(jnp.float32)) * (IDX_HEADS ** -0.5)
        admissible = key_pos[None, :] <= tq[:, None]
        score = jnp.where(admissible[None], score, -jnp.inf)
        _, idx = lax.top_k(score, top_k)
        valid = idx <= tq[None, :, None]
        k_sel = jax.vmap(lambda kb, ib: kb[ib])(k, idx)
        v_sel = jax.vmap(lambda vb, ib: vb[ib])(v, idx)
        s = jnp.einsum('bqhd,bqkhd->bhqk', qb, k_sel).astype(jnp.float32) * (HEAD_DIM ** -0.5)
        s = jnp.where(valid[:, None], s, -jnp.inf)
        p = jax.nn.softmax(s, axis=-1).astype(v.dtype)
        return jnp.einsum('bhqk,bqkhd->bqhd', p, v_sel)

    o = lax.map(block_fn, (to_blocks(q), to_blocks(iq), to_blocks(iw), starts))
    o = jnp.swapaxes(o, 0, 1).reshape(B, S, ATTN_WIDTH)
    return (o * jax.nn.silu(gate)) @ w_out


def pool_mixer(u, gate, pool_w, pool_scale, w_out):
    B, S, _ = u.shape
    ug = u.reshape(B, S, POOL_GROUPS, POOL_GROUP_DIM)
    cs = jnp.cumsum(ug.astype(jnp.float32), axis=1)
    t = jnp.arange(S)
    means = []
    for gi, w in enumerate(POOL_WINDOWS):
        c = cs[:, :, gi]
        lagged = jnp.pad(c, ((0, 0), (w, 0), (0, 0)))[:, :S]
        cnt = jnp.minimum(t + 1, w).astype(jnp.float32)[None, :, None]
        means.append((c - lagged) / cnt)
    pooled = (jnp.stack(means, axis=2) - ug.astype(jnp.float32)).astype(u.dtype)
    mixed = jnp.einsum('bsgc,gcd->bsgd', pooled, pool_w).reshape(B, S, POOL_WIDTH)
    y = mixed * pool_scale * jax.nn.silu(gate)
    return y @ w_out


def setup_inputs(seed: int = 0) -> dict:
    key = jax.random.key(seed)
    ks = jax.random.split(key, 13)
    f32 = jnp.float32
    L = DEPTH
    return {
        "x": jax.random.normal(ks[0], (BATCH, SEQ, D_MODEL), f32),
        "norm_g": 1.0 + 0.1 * jax.random.normal(ks[1], (L, D_MODEL), f32),
        "w_in": jax.random.normal(ks[2], (L, D_MODEL, IN_WIDTH), f32) * D_MODEL ** -0.5,
        "conv_w": jax.random.normal(ks[3], (L, CONV_KSIZE, CONV_WIDTH), f32) * CONV_KSIZE ** -0.5,
        "w_out_conv": jax.random.normal(ks[4], (L, CONV_WIDTH, D_MODEL), f32) * CONV_WIDTH ** -0.5,
        "q_norm_g": 1.0 + 0.1 * jax.random.normal(ks[5], (L, HEAD_DIM), f32),
        "k_norm_g": 1.0 + 0.1 * jax.random.normal(ks[6], (L, HEAD_DIM), f32),
        "w_out_attn": jax.random.normal(ks[7], (L, ATTN_WIDTH, D_MODEL), f32) * ATTN_WIDTH ** -0.5,
        "pool_w": jax.random.normal(ks[8], (L, POOL_GROUPS, POOL_GROUP_DIM, POOL_GROUP_DIM), f32) * POOL_GROUP_DIM ** -0.5,
        "pool_scale": 1.0 + 0.1 * jax.random.normal(ks[9], (L, POOL_WIDTH), f32),
        "w_out_pool": jax.random.normal(ks[10], (L, POOL_WIDTH, D_MODEL), f32) * POOL_WIDTH ** -0.5,
        "w_o": jax.random.normal(ks[11], (L, D_MODEL, D_MODEL), f32) * D_MODEL ** -0.5,
    }


def reference(x, norm_g, w_in, conv_w, w_out_conv, q_norm_g, k_norm_g, w_out_attn, pool_w, pool_scale, w_out_pool, w_o):
    B, S, D = x.shape
    cos, sin = rope_tables(S, HEAD_DIM)
    for l in range(DEPTH):
        h = rms_norm(x, norm_g[l])
        p = h @ w_in[l]
        (cb, cc, cx, cgate, q, k, v, agate, iq, ik, iw, pu, pgate, mgate) = split_columns(p)
        y_a = short_conv_mixer(cb, cc, cx, cgate, conv_w[l], w_out_conv[l])
        y_b = sparse_attention_mixer(q, k, v, agate, iq, ik, iw, q_norm_g[l], k_norm_g[l], cos, sin, w_out_attn[l])
        y_c = pool_mixer(pu, pgate, pool_w[l], pool_scale[l], w_out_pool[l])
        g = jax.nn.sigmoid(mgate.reshape(B, S, N_BRANCHES, D))
        merged = g[:, :, 0] * y_a + g[:, :, 1] * y_b + g[:, :, 2] * y_c
        x = x + merged @ w_o[l]
    return x
```

```cpp
#include <hip/hip_runtime.h>
#include <hip/hip_cooperative_groups.h>
#include <stdint.h>
#include <stdio.h>
namespace cg = cooperative_groups;

typedef unsigned short u16;
typedef unsigned long long u64;
typedef __attribute__((ext_vector_type(8))) short bf16x8;
typedef __attribute__((ext_vector_type(4))) short s16x4;
typedef __attribute__((ext_vector_type(4))) float f32x4;
typedef __attribute__((ext_vector_type(16))) float f32x16;
typedef __attribute__((ext_vector_type(4))) unsigned u32x4;
typedef __attribute__((ext_vector_type(2))) unsigned u32x2;

#ifndef MEGA
#define MEGA 1
#endif
__device__ __forceinline__ int TID() { int t = threadIdx.x; asm volatile("" : "+v"(t)); return t; }
__device__ __forceinline__ int BID() { int t = blockIdx.x; asm volatile("" : "+s"(t)); return t; }
__device__ __forceinline__ int GDIM() { int t = gridDim.x; asm volatile("" : "+s"(t)); return t; }

constexpr int SEQ = 8192, NBATCH = 4, T = NBATCH * SEQ, DMODEL = 1024, NL = 4, INW = 8776;
constexpr int NPA = 5888;
constexpr int NTHR = 512;
constexpr int LDS_BYTES = 131072;
constexpr float RMS_EPS = 1e-6f;

struct Params {
    const float *x_in, *norm_g, *w_in, *conv_w, *w_out_conv, *q_g, *k_g, *w_out_attn, *pool_w, *pool_scale, *w_out_pool, *w_o;
    float* x; char* ws;
    __device__ __forceinline__ u16* xb() const { return (u16*)(ws + 0ull); }
    __device__ __forceinline__ u16* z() const { return (u16*)(ws + 67108864ull); }
    __device__ __forceinline__ u16* ga() const { return (u16*)(ws + 100663296ull); }
    __device__ __forceinline__ u16* q() const { return (u16*)(ws + 134217728ull); }
    __device__ __forceinline__ u16* k() const { return (u16*)(ws + 167772160ull); }
    __device__ __forceinline__ u16* v() const { return (u16*)(ws + 201326592ull); }
    __device__ __forceinline__ u16* sg() const { return (u16*)(ws + 234881024ull); }
    __device__ __forceinline__ u16* iq() const { return (u16*)(ws + 268435456ull); }
    __device__ __forceinline__ u16* u() const { return (u16*)(ws + 301989888ull); }
    __device__ __forceinline__ u16* sp() const { return (u16*)(ws + 335544320ull); }
    __device__ __forceinline__ u16* ik() const { return (u16*)(ws + 369098752ull); }
    __device__ __forceinline__ float* iw() const { return (float*)(ws + 373293056ull); }
    __device__ __forceinline__ u16* wt_in() const { return (u16*)(ws + 374341632ull); }
    __device__ __forceinline__ u16* wt_mg() const { return (u16*)(ws + 422576128ull); }
    __device__ __forceinline__ u16* wt_oa() const { return (u16*)(ws + 447741952ull); }
    __device__ __forceinline__ u16* wt_ob() const { return (u16*)(ws + 451936256ull); }
    __device__ __forceinline__ u16* wt_oc() const { return (u16*)(ws + 456130560ull); }
    __device__ __forceinline__ u16* wt_o() const { return (u16*)(ws + 460324864ull); }
    __device__ __forceinline__ float* ropec() const { return (float*)(ws + 468713472ull); }
    __device__ __forceinline__ float* ropes() const { return (float*)(ws + 469762048ull); }
    __device__ __forceinline__ float* sumsq() const { return (float*)(ws + 470810624ull); }
    __device__ __forceinline__ u64* mask() const { return (u64*)(ws + 475004928ull); }
    __device__ __forceinline__ u16* scores() const { return (u16*)(ws + 492306432ull); }
    __device__ __forceinline__ u16* stash() const { return scores(); }
    __device__ __forceinline__ u16* merged() const { return q(); }
    __device__ __forceinline__ u16* bin() const { return iq(); }
};
constexpr size_t WS_NEEDED = 561512448ull;


__device__ __forceinline__ unsigned cvtpk(float lo, float hi) { unsigned r; asm("v_cvt_pk_bf16_f32 %0, %1, %2" : "=v"(r) : "v"(lo), "v"(hi)); return r; }
__device__ __forceinline__ u16 f2bf(float f) { return (u16)(cvtpk(f, 0.f) & 0xffffu); }
__device__ __forceinline__ float bf2f(u16 b) { return __uint_as_float(((unsigned)b) << 16); }
__device__ __forceinline__ float bflo(unsigned w) { return __uint_as_float(w << 16); }
__device__ __forceinline__ float bfhi(unsigned w) { return __uint_as_float(w & 0xffff0000u); }
__device__ __forceinline__ float siluf(float x) { return x / (1.f + __expf(-x)); }
__device__ __forceinline__ float sigmf(float x) { return 1.f / (1.f + __expf(-x)); }

__device__ __forceinline__ float row_rstd(const float* ssp, int row) {
    const f32x4* q = (const f32x4*)(ssp + (size_t)row * 16);
    const f32x4 a = q[0], b = q[1], c = q[2], d = q[3];
    const float s = ((a[0] + a[1]) + (a[2] + a[3])) + ((b[0] + b[1]) + (b[2] + b[3])) + ((c[0] + c[1]) + (c[2] + c[3])) + ((d[0] + d[1]) + (d[2] + d[3]));
    return rsqrtf(s * (1.f / 1024.f) + RMS_EPS);
}
__device__ __forceinline__ int lc_of_tc(int tc) { int bj = tc >> 7, wc = (tc >> 5) & 3, n = (tc >> 4) & 1, fq = (tc >> 2) & 3, j = tc & 3; return ((wc * 4 + fq) << 4) + bj * 8 + n * 4 + j; }
__device__ __forceinline__ int tc_of_lc(int lc) { int cl = lc >> 4, s = lc & 15, wc = cl >> 2, fq = cl & 3, bj = s >> 3, n = (s >> 2) & 1, j = s & 3; return bj * 128 + wc * 32 + n * 16 + fq * 4 + j; }

__device__ __forceinline__ int src_col_in(int np) {
    int pn = np >> 8, tc = np & 255;
    int bj = tc >> 7, wc = (tc >> 5) & 3, n = (tc >> 4) & 1, fq = (tc >> 2) & 3, j = tc & 3, cl = wc * 4 + fq, s = bj * 8 + n * 4 + j, lc = cl * 16 + s;
    int d = (s < 8) ? (8 * fq + s) : (8 * fq + 32 + (s - 8));
    if (pn < 8) return (s & 3) * 512 + pn * 64 + cl * 4 + (s >> 2);
    if (pn < 12) { int which = (pn - 8) >> 1, head = ((pn - 8) & 1) * 4 + wc; return 2048 + which * 512 + head * 64 + d; }
    if (pn < 14) return 3072 + (pn - 12) * 256 + lc;
    if (pn < 16) return 3584 + (pn - 14) * 256 + lc;
    if (pn < 18) { int head = (pn - 16) * 4 + wc; return 4096 + head * 64 + d; }
    if (pn == 18) { if (wc == 0) return 4608 + d; if (wc == 1 && fq == 0 && s < 8) return 4672 + s; return -1; }
    if (pn < 21) return -2;
    return 5192 + (pn - 21) * 256 + lc;
}

__device__ __forceinline__ void prep_x(const Params& p) {
    const int tid_ = TID(); const int lane = tid_ & 63, gw = BID() * (NTHR / 64) + (tid_ >> 6), nw = GDIM() * (NTHR / 64);
    for (int row = gw; row < T; row += nw) {
        const float4* src = (const float4*)(p.x_in + (size_t)row * DMODEL);
        float ss = 0.f;
#pragma unroll
        for (int i = 0; i < 4; ++i) {
            float4 v = src[i * 64 + lane];
            ss += v.x * v.x + v.y * v.y + v.z * v.z + v.w * v.w;
            u32x2 o; o[0] = cvtpk(v.x, v.y); o[1] = cvtpk(v.z, v.w);
            *(u32x2*)(p.xb() + (size_t)row * DMODEL + (i * 64 + lane) * 4) = o;
        }
#pragma unroll
        for (int m = 32; m >= 1; m >>= 1) ss += __shfl_xor(ss, m);
        if (lane < 16) p.sumsq()[(size_t)row * 16 + lane] = (lane == 0) ? ss : 0.f;
    }
}
__device__ __forceinline__ void prep_rope(const Params& p) {
    const int i0 = BID() * NTHR + TID(), istep = GDIM() * NTHR;
    for (int i = i0; i < SEQ * 32; i += istep) {
        int pos = i >> 5, j = i & 31;
        float inv = 1.0f / powf(10000.0f, (float)(2 * j) / 64.0f);
        float ang = (float)pos * inv;
        p.ropec()[i] = cosf(ang); p.ropes()[i] = sinf(ang);
    }
}
__device__ __forceinline__ void prep_wt(const float* src, int lds_, const float* scale, u16* dst, int K, int NP, int mode, float* tile) {
    const int tid_ = TID(); const int tx = tid_ & 63, ty = tid_ >> 6; const int bid_ = BID(), gdim_ = GDIM();
    const int ntn = NP / 64, ntk = K / 64;
    for (int t = bid_; t < ntn * ntk; t += gdim_) {
        const int n0 = (t / ntk) * 64, k0 = (t % ntk) * 64;
        int np = n0 + tx, col;
        if (mode == 0) col = src_col_in(np);
        else if (mode == 1) col = 5704 + (np & ~255) + lc_of_tc(np & 255);
        else col = (np & ~255) + lc_of_tc(np & 255);
        __syncthreads();
#pragma unroll
        for (int i = 0; i < 8; ++i) { int kk = ty + 8 * i; tile[kk * 65 + tx] = (col >= 0) ? src[(size_t)(k0 + kk) * lds_ + col] : 0.f; }
        __syncthreads();
        const float sc = scale ? scale[k0 + tx] : 1.f;
#pragma unroll
        for (int i = 0; i < 8; ++i) {
            int nn = ty + 8 * i; int npo = n0 + nn;
            bool skip = (mode == 0) && ((npo >> 8) == 19 || (npo >> 8) == 20);
            if (!skip) dst[(size_t)npo * K + k0 + tx] = f2bf(tile[tx * 65 + nn] * sc);
        }
    }
}
__device__ __forceinline__ void prep_fold(const float* win, const float* ng, const float* pw, u16* wt_in) {
    const int i0 = BID() * NTHR + TID(), istep = GDIM() * NTHR;
    for (int i = i0; i < 1024 * 512; i += istep) {
        int k = i >> 9, n = i & 511, g = n >> 7, d = n & 127;
        const float* wr = win + (size_t)k * INW + 4680 + g * 128;
        const float* pp = pw + (size_t)g * 128 * 128 + d;
        float acc = 0.f;
        for (int c = 0; c < 128; ++c) acc += wr[c] * pp[c * 128];
        int row = (19 + (n >> 8)) * 256 + tc_of_lc(n & 255);
        wt_in[(size_t)row * 1024 + k] = f2bf(acc * ng[k]);
    }
}
__device__ __forceinline__ void phase_prep0(const Params& p, char* shm) {
    prep_x(p); prep_rope(p);
    float* tile = (float*)shm;
    for (int l = 0; l < NL; ++l) {
        const float* ng = p.norm_g + l * 1024;
        const float* win = p.w_in + (size_t)l * 1024 * INW;
        prep_wt(win, INW, ng, p.wt_in() + (size_t)l * NPA * 1024, 1024, NPA, 0, tile);
        prep_wt(win, INW, ng, p.wt_mg() + (size_t)l * 3072 * 1024, 1024, 3072, 1, tile);
        prep_wt(p.w_out_conv + (size_t)l * 512 * 1024, 1024, nullptr, p.wt_oa() + (size_t)l * 1024 * 512, 512, 1024, 2, tile);
        prep_wt(p.w_out_attn + (size_t)l * 512 * 1024, 1024, nullptr, p.wt_ob() + (size_t)l * 1024 * 512, 512, 1024, 2, tile);
        prep_wt(p.w_out_pool + (size_t)l * 512 * 1024, 1024, nullptr, p.wt_oc() + (size_t)l * 1024 * 512, 512, 1024, 2, tile);
        prep_wt(p.w_o + (size_t)l * 1024 * 1024, 1024, nullptr, p.wt_o() + (size_t)l * 1024 * 1024, 1024, 1024, 3, tile);
        prep_fold(win, ng, p.pool_w + (size_t)l * 4 * 128 * 128, p.wt_in() + (size_t)l * NPA * 1024);
    }
}

namespace pg8 {
#define PG8_LAS __attribute__((address_space(3)))
typedef unsigned short bf16_t;
constexpr int BM = 256, BK = 64, HALF = 128, HTB = HALF * BK * 2, STAGE_BYTES = 8 * HTB;
__device__ __forceinline__ int lds_byte(int r, int c) { const int st = (r >> 4) * 2 + (c >> 5), rr = r & 15, cc = c & 31, ob = rr * 64 + cc * 2; return st * 1024 + (ob ^ (((ob >> 9) & 1) << 5)); }
__device__ __forceinline__ void stage_rc(int b, int& R, int& C) { const int st = b / 1024, sb = b % 1024, swz = sb ^ (((sb >> 9) & 1) << 5); R = (st >> 1) * 16 + swz / 64; C = (st & 1) * 32 + (swz % 64) / 2; }
struct Unit { int pm, pn; };
struct Gemm { const bf16_t* A; const bf16_t* Bt; int M, N, K; };
constexpr int NXCD = 8, WGM = 8;
struct StaticOrder {
    int nM, nN, nwg, G, c;
    __device__ void init(int M, int N, int G_, int c_) { nM = M / BM; nN = N / BM; nwg = nM * nN; G = G_; c = c_; }
    __device__ bool next(int i, Unit& u) const {
        const long L = (long)i * G + c; if (L >= nwg) return false;
        int wgid = (int)L; { const int q = nwg / NXCD, r = nwg % NXCD, xcd = wgid % NXCD, off = wgid / NXCD; wgid = (xcd < r ? xcd * (q + 1) : r * (q + 1) + (xcd - r) * q) + off; }
        const int nig = WGM * nN, gid = wgid / nig, fm = gid * WGM, gsz = (nM - fm) < WGM ? (nM - fm) : WGM;
        u.pm = fm + ((wgid % nig) % gsz); u.pn = (wgid % nig) / gsz; return true;
    }
};
struct RowOrder {
    int nN, ntile, G, c;
    __device__ bool next(int i, Unit& u) const { const int t = c + i * G; if (t >= ntile) return false; u.pm = t / nN; u.pn = t % nN; return true; }
};
template <class Epi, class Sched>
__device__ __forceinline__ void gemm_phase(PG8_LAS unsigned char* lds, const Gemm g, const Sched& S, const Epi& E) {
    const int tid = TID(), wid = __builtin_amdgcn_readfirstlane(tid >> 6), lane = tid & 63, wr = wid >> 2, wc = wid & 3, fr = lane & 15, fq = lane >> 4;
    const int K = g.K, nt = K / BK;
    unsigned voffA[2], voffB[2];
#pragma unroll
    for (int i = 0; i < 2; ++i) { int R, C; stage_rc(tid * 16 + i * 8192, R, C); voffA[i] = (unsigned)(R * K + C) * 2u; voffB[i] = voffA[i]; }
    const size_t kstep = (size_t)(BK * 2);
    const size_t hstep = (size_t)HALF * K * 2;
    const size_t tstep = 2 * hstep;
    const unsigned ldsw = (unsigned)wid * 1024u;
    const int aoff = lds_byte(wr * 64 + fr, fq * 8), boff = lds_byte(wc * 32 + fr, fq * 8);
#define PG8_SA(b, h) (((b) * 2 + (h)) * HTB)
#define PG8_SB(b, h) ((4 + (b) * 2 + (h)) * HTB)
#define PG8_STAGE(bufoff, gbase, voff) do { _Pragma("unroll") for (int _i = 0; _i < 2; ++_i) \
        __builtin_amdgcn_global_load_lds((const unsigned*)((const char*)(gbase) + (voff)[_i]), (PG8_LAS unsigned*)(lds + (bufoff) + ldsw + _i * 8192), 16, 0, 0); } while (0)
#define PG8_LDA(dst, b, h) do { _Pragma("unroll") for (int m = 0; m < 4; ++m) _Pragma("unroll") for (int k = 0; k < 2; ++k) dst[m][k] = *(const PG8_LAS bf16x8*)(lds + PG8_SA(b, h) + aoff + m * 2048 + k * 1024); } while (0)
#define PG8_LDB(dst, b, h) do { _Pragma("unroll") for (int n = 0; n < 2; ++n) _Pragma("unroll") for (int k = 0; k < 2; ++k) dst[n][k] = *(const PG8_LAS bf16x8*)(lds + PG8_SB(b, h) + boff + n * 2048 + k * 1024); } while (0)
#define PG8_MMA(ai, bj, At, Bt) do { __builtin_amdgcn_s_setprio(1); _Pragma("unroll") for (int m = 0; m < 4; ++m) _Pragma("unroll") for (int n = 0; n < 2; ++n) _Pragma("unroll") for (int k = 0; k < 2; ++k) \
        acc[ai][bj][m][n] = __builtin_amdgcn_mfma_f32_16x16x32_bf16(Bt[n][k], At[m][k], acc[ai][bj][m][n], 0, 0, 0); __builtin_amdgcn_s_setprio(0); } while (0)
#define PG8_WAIT_V(n) asm volatile("s_waitcnt vmcnt(" #n ")" ::: "memory")
#define PG8_WAIT_L(n) asm volatile("s_waitcnt lgkmcnt(" #n ")" ::: "memory")
#define PG8_BAR __builtin_amdgcn_s_barrier()
#define PG8_SCHED __builtin_amdgcn_sched_barrier(0)
    Unit cur, nxt; int ui = 0;
    if (!S.next(0, cur)) return;
    f32x4 acc[2][2][4][2];
#pragma unroll
    for (int a = 0; a < 2; ++a)
#pragma unroll
        for (int b = 0; b < 2; ++b)
#pragma unroll
            for (int m = 0; m < 4; ++m)
#pragma unroll
                for (int n = 0; n < 2; ++n) acc[a][b][m][n] = (f32x4){0.f, 0.f, 0.f, 0.f};
    bf16x8 At[4][2], B0[2][2], B1[2][2];
    const char* cA = (const char*)g.A + (size_t)cur.pm * tstep; const char* cB = (const char*)g.Bt + (size_t)cur.pn * tstep;
    PG8_STAGE(PG8_SB(0, 0), cB, voffB); PG8_STAGE(PG8_SA(0, 0), cA, voffA); PG8_STAGE(PG8_SB(0, 1), cB + hstep, voffB); PG8_STAGE(PG8_SA(0, 1), cA + hstep, voffA);
    if (wr == 1) PG8_BAR;
    PG8_WAIT_V(4); PG8_BAR;
    PG8_STAGE(PG8_SB(1, 0), cB + kstep, voffB); PG8_STAGE(PG8_SA(1, 0), cA + kstep, voffA); PG8_STAGE(PG8_SB(1, 1), cB + hstep + kstep, voffB);
    PG8_WAIT_V(6); PG8_BAR;
    for (;;) {
        const bool has_next = S.next(ui + 1, nxt);
        const char* nA = has_next ? (const char*)g.A + (size_t)nxt.pm * tstep : cA; const char* nB = has_next ? (const char*)g.Bt + (size_t)nxt.pn * tstep : cB;
        for (int t = 0; t < nt; t += 2) {
            const bool last = (t == nt - 2);
            const char* a1 = cA + (size_t)(t + 1) * kstep;
            const char* a2 = last ? nA : cA + (size_t)(t + 2) * kstep; const char* b2 = last ? nB : cB + (size_t)(t + 2) * kstep;
            const char* a3 = a2 + kstep; const char* b3 = b2 + kstep;
            PG8_LDB(B0, 0, 0); PG8_SCHED; PG8_LDA(At, 0, 0); PG8_STAGE(PG8_SA(1, 1), a1 + hstep, voffA);
            PG8_WAIT_L(8); PG8_BAR; PG8_WAIT_L(0); PG8_MMA(0, 0, At, B0); PG8_BAR; PG8_SCHED;
            PG8_LDB(B1, 0, 1); PG8_STAGE(PG8_SB(0, 0), b2, voffB);
            PG8_BAR; PG8_WAIT_L(0); PG8_MMA(0, 1, At, B1); PG8_BAR;
            PG8_LDA(At, 0, 1); PG8_STAGE(PG8_SA(0, 0), a2, voffA);
            PG8_BAR; PG8_WAIT_L(0); PG8_MMA(1, 0, At, B0); PG8_BAR; PG8_SCHED;
            PG8_STAGE(PG8_SB(0, 1), b2 + hstep, voffB);
            PG8_WAIT_V(6); PG8_BAR; PG8_MMA(1, 1, At, B1); PG8_BAR;
            PG8_LDB(B0, 1, 0); PG8_SCHED; PG8_LDA(At, 1, 0); PG8_STAGE(PG8_SA(0, 1), a2 + hstep, voffA);
            PG8_WAIT_L(8); PG8_BAR; PG8_WAIT_L(0); PG8_MMA(0, 0, At, B0); PG8_BAR; PG8_SCHED;
            PG8_LDB(B1, 1, 1); PG8_STAGE(PG8_SB(1, 0), b3, voffB);
            PG8_BAR; PG8_WAIT_L(0); PG8_MMA(0, 1, At, B1); PG8_BAR;
            PG8_LDA(At, 1, 1); PG8_STAGE(PG8_SA(1, 0), a3, voffA);
            PG8_BAR; PG8_WAIT_L(0); PG8_MMA(1, 0, At, B0); PG8_BAR; PG8_SCHED;
            PG8_STAGE(PG8_SB(1, 1), b3 + hstep, voffB);
            PG8_WAIT_V(6); PG8_BAR; PG8_MMA(1, 1, At, B1); PG8_BAR;
        }
        E(acc, cur, ui, wr, wc, fr, fq);
        if (!has_next) break;
#pragma unroll
        for (int a = 0; a < 2; ++a)
#pragma unroll
            for (int b = 0; b < 2; ++b)
#pragma unroll
                for (int m = 0; m < 4; ++m)
#pragma unroll
                    for (int n = 0; n < 2; ++n) acc[a][b][m][n] = (f32x4){0.f, 0.f, 0.f, 0.f};
        cur = nxt; cA = nA; cB = nB; ++ui;
    }
    PG8_WAIT_V(0);
    if (wr == 0) PG8_BAR;
    PG8_BAR;
#undef PG8_SA
#undef PG8_SB
#undef PG8_STAGE
#undef PG8_LDA
#undef PG8_LDB
#undef PG8_MMA
#undef PG8_WAIT_V
#undef PG8_WAIT_L
#undef PG8_BAR
#undef PG8_SCHED
}
}
typedef f32x4 acc_t[2][2][4][2];
#define ROWS_LOOP _Pragma("unroll") for (int ai = 0; ai < 2; ++ai) _Pragma("unroll") for (int m = 0; m < 4; ++m)
#define ROW_OF (u.pm * 256 + ai * 128 + wr * 64 + m * 16 + fr)

struct EpiIn {
    const Params& p; int l;
    __device__ __forceinline__ void operator()(const acc_t& acc, const pg8::Unit& u, int ui, int wr, int wc, int fr, int fq) const {
        const float* ssq = p.sumsq() + (size_t)(l & 1) * T * 16;
        const int pn = u.pn, cl = wc * 4 + fq;
        if (pn < 8) {
            ROWS_LOOP { const int row = ROW_OF; const float rs = row_rstd(ssq, row);
                float zz[4], gg[4];
#pragma unroll
                for (int ch = 0; ch < 4; ++ch) { const f32x4 v = acc[ai][ch >> 1][m][ch & 1]; zz[ch] = (v[1] * rs) * (v[2] * rs); gg[ch] = (v[0] * rs) * siluf(v[3] * rs); }
                const size_t o = (size_t)row * 512 + pn * 64 + cl * 4;
                u32x2 a; a[0] = cvtpk(zz[0], zz[1]); a[1] = cvtpk(zz[2], zz[3]); *(u32x2*)(p.z() + o) = a;
                u32x2 b; b[0] = cvtpk(gg[0], gg[1]); b[1] = cvtpk(gg[2], gg[3]); *(u32x2*)(p.ga() + o) = b; }
        } else if (pn < 12 || (pn >= 16 && pn <= 18)) {
            if (pn == 18 && wc >= 1) {
                if (wc == 1 && fq == 0) {
                    ROWS_LOOP { const int row = ROW_OF; const float rs = row_rstd(ssq, row) * 0.04419417382415922f;
                        *(f32x4*)(p.iw() + (size_t)row * 8) = acc[ai][0][m][0] * rs; *(f32x4*)(p.iw() + (size_t)row * 8 + 4) = acc[ai][0][m][1] * rs; }
                }
            } else {
                const bool isqk = pn < 12; const int which = (pn - 8) >> 1;
                int head; u16* dst; int pitch;
                if (isqk) { head = ((pn - 8) & 1) * 4 + wc; dst = which ? p.k() : p.q(); pitch = 512; }
                else if (pn < 18) { head = (pn - 16) * 4 + wc; dst = p.iq(); pitch = 512; }
                else { head = 0; dst = p.ik(); pitch = 64; }
                f32x4 g0[2], g1[2];
#pragma unroll
                for (int n = 0; n < 2; ++n) { g0[n] = (f32x4){1.f, 1.f, 1.f, 1.f}; g1[n] = g0[n]; }
                if (isqk) { const float* gg = (which ? p.k_g : p.q_g) + l * 64 + 8 * fq;
#pragma unroll
                    for (int n = 0; n < 2; ++n) { g0[n] = *(const f32x4*)(gg + 4 * n); g1[n] = *(const f32x4*)(gg + 32 + 4 * n); } }
                ROWS_LOOP { const int row = ROW_OF; const float rs = row_rstd(ssq, row);
                    f32x4 a0[2], a1[2];
#pragma unroll
                    for (int n = 0; n < 2; ++n) { a0[n] = acc[ai][0][m][n] * rs; a1[n] = acc[ai][1][m][n] * rs; }
                    if (isqk) { float ss = 0.f;
#pragma unroll
                        for (int n = 0; n < 2; ++n)
#pragma unroll
                            for (int j = 0; j < 4; ++j) ss += a0[n][j] * a0[n][j] + a1[n][j] * a1[n][j];
                        ss += __shfl_xor(ss, 16); ss += __shfl_xor(ss, 32);
                        const float rn = rsqrtf(ss * (1.f / 64.f) + RMS_EPS);
#pragma unroll
                        for (int n = 0; n < 2; ++n) { a0[n] = a0[n] * rn * g0[n]; a1[n] = a1[n] * rn * g1[n]; } }
                    const int pos = row & (SEQ - 1);
                    u32x4 o0, o1;
#pragma unroll
                    for (int n = 0; n < 2; ++n) { const f32x4 cc = *(const f32x4*)(p.ropec() + pos * 32 + 8 * fq + 4 * n), sn = *(const f32x4*)(p.ropes() + pos * 32 + 8 * fq + 4 * n);
                        const f32x4 r0 = a0[n] * cc - a1[n] * sn, r1 = a1[n] * cc + a0[n] * sn;
                        o0[2 * n] = cvtpk(r0[0], r0[1]); o0[2 * n + 1] = cvtpk(r0[2], r0[3]); o1[2 * n] = cvtpk(r1[0], r1[1]); o1[2 * n + 1] = cvtpk(r1[2], r1[3]); }
                    u16* d = dst + (size_t)row * pitch + head * 64 + 8 * fq;
                    *(u32x4*)d = o0; *(u32x4*)(d + 32) = o1; }
            }
        } else {
            u16* dst; int cb; int kind;
            if (pn < 14) { dst = p.v(); cb = (pn - 12) * 256; kind = 0; }
            else if (pn < 16) { dst = p.sg(); cb = (pn - 14) * 256; kind = 1; }
            else if (pn < 21) { dst = p.u(); cb = (pn - 19) * 256; kind = 0; }
            else { dst = p.sp(); cb = (pn - 21) * 256; kind = 2; }
            f32x4 sc[2][2];
#pragma unroll
            for (int bj = 0; bj < 2; ++bj)
#pragma unroll
                for (int n = 0; n < 2; ++n) sc[bj][n] = (kind == 2) ? *(const f32x4*)(p.pool_scale + l * 512 + cb + 16 * cl + bj * 8 + n * 4) : (f32x4){1.f, 1.f, 1.f, 1.f};
            ROWS_LOOP { const int row = ROW_OF; const float rs = row_rstd(ssq, row);
#pragma unroll
                for (int bj = 0; bj < 2; ++bj) { f32x4 v0 = acc[ai][bj][m][0] * rs, v1 = acc[ai][bj][m][1] * rs;
                    if (kind >= 1) {
#pragma unroll
                        for (int j = 0; j < 4; ++j) { v0[j] = siluf(v0[j]) * sc[bj][0][j]; v1[j] = siluf(v1[j]) * sc[bj][1][j]; } }
                    u32x4 w; w[0] = cvtpk(v0[0], v0[1]); w[1] = cvtpk(v0[2], v0[3]); w[2] = cvtpk(v1[0], v1[1]); w[3] = cvtpk(v1[2], v1[3]);
                    *(u32x4*)(dst + (size_t)row * 512 + cb + 16 * cl + bj * 8) = w; } }
        }
    }
};
__device__ __forceinline__ void phase_in(const Params& p, int l, char* shm) {
    pg8::Gemm g{p.xb(), p.wt_in() + (size_t)l * NPA * 1024, T, NPA, 1024};
    pg8::StaticOrder S; S.init(T, NPA, GDIM(), BID());
    EpiIn E{p, l};
    pg8::gemm_phase((PG8_LAS unsigned char*)shm, g, S, E);
}
__device__ __forceinline__ void phase_mix(const Params& p, int l) {
    const float* cw = p.conv_w + l * 3 * 512;
    const int nitem = (T / 32) * 256;
    const int it0 = BID() * NTHR + TID(), itstep = GDIM() * NTHR;
    for (int it = it0; it < nitem; it += itstep) {
        const int cp = it & 255, c = cp * 2, t0 = (it >> 8) * 32, pos0 = t0 & (SEQ - 1);
        {
            const float w00 = cw[c], w01 = cw[c + 1], w10 = cw[512 + c], w11 = cw[513 + c], w20 = cw[1024 + c], w21 = cw[1025 + c];
            float a0 = 0.f, a1 = 0.f, b0 = 0.f, b1 = 0.f;
            if (pos0 >= 2) { unsigned w = *(const unsigned*)(p.z() + (size_t)(t0 - 2) * 512 + c); a0 = bflo(w); a1 = bfhi(w);
                             w = *(const unsigned*)(p.z() + (size_t)(t0 - 1) * 512 + c); b0 = bflo(w); b1 = bfhi(w); }
            for (int i = 0; i < 32; ++i) {
                const size_t o = (size_t)(t0 + i) * 512 + c;
                unsigned w = *(const unsigned*)(p.z() + o); float z0 = bflo(w), z1 = bfhi(w);
                unsigned gw = *(const unsigned*)(p.ga() + o);
                float y0 = (w00 * a0 + w10 * b0 + w20 * z0) * bflo(gw), y1 = (w01 * a1 + w11 * b1 + w21 * z1) * bfhi(gw);
                *(unsigned*)(p.ga() + o) = cvtpk(y0, y1);
                a0 = b0; a1 = b1; b0 = z0; b1 = z1;
            }
        }
        {
            const int win = 2 << (c >> 7);
            float s0 = 0.f, s1 = 0.f;
            for (int j = 1; j < win; ++j) if (pos0 - j >= 0) { unsigned w = *(const unsigned*)(p.u() + (size_t)(t0 - j) * 512 + c); s0 += bflo(w); s1 += bfhi(w); }
            for (int i = 0; i < 32; ++i) {
                const int pos = pos0 + i; const size_t o = (size_t)(t0 + i) * 512 + c;
                unsigned w = *(const unsigned*)(p.u() + o); float u0 = bflo(w), u1 = bfhi(w);
                s0 += u0; s1 += u1;
                const float ic = 1.f / (float)min(pos + 1, win);
                unsigned gw = *(const unsigned*)(p.sp() + o);
                *(unsigned*)(p.sp() + o) = cvtpk((s0 * ic - u0) * bflo(gw), (s1 * ic - u1) * bfhi(gw));
                if (pos - win + 1 >= 0) { unsigned wo = *(const unsigned*)(p.u() + (size_t)(t0 + i - win + 1) * 512 + c); s0 -= bflo(wo); s1 -= bfhi(wo); }
            }
        }
    }
}

__device__ __forceinline__ int crow(int r, int hi) { return (r & 3) + 8 * (r >> 2) + 4 * hi; }
__device__ __forceinline__ size_t sc_base(int qb) { return (size_t)32768 * qb * (qb + 1); }
__device__ __forceinline__ void phase_indexer(const Params& p, int b) {
    const int tid_ = TID(); const int wid = tid_ >> 6, lane = tid_ & 63, ql = lane & 15, fq = lane >> 4; const int bid_ = BID(), gdim_ = GDIM();
    const int nunit = 1056;
    for (int u = bid_; u < nunit; u += gdim_) {
        const int sh = u & 1, v = u >> 1;
        int a = (int)((sqrtf(8.f * v + 1.f) - 1.f) * 0.5f);
        while ((a + 1) * (a + 2) / 2 <= v) ++a;
        while (a * (a + 1) / 2 > v) --a;
        const int ch = v - a * (a + 1) / 2;
        const int qb128 = 2 * a + sh, ntl = 2 * (qb128 + 1);
        const int qloc = qb128 * 128 + wid * 16 + ql;
        const size_t row = (size_t)b * SEQ + qloc;
        bf16x8 bq[8][2];
#pragma unroll
        for (int h = 0; h < 8; ++h)
#pragma unroll
            for (int kc = 0; kc < 2; ++kc) bq[h][kc] = *(const bf16x8*)(p.iq() + row * 512 + h * 64 + kc * 32 + fq * 8);
        float wv[8];
        { f32x4 x = *(const f32x4*)(p.iw() + row * 8), y = *(const f32x4*)(p.iw() + row * 8 + 4);
          wv[0] = x[0]; wv[1] = x[1]; wv[2] = x[2]; wv[3] = x[3]; wv[4] = y[0]; wv[5] = y[1]; wv[6] = y[2]; wv[7] = y[3]; }
        u16* srow = p.scores() + sc_base(a) + (size_t)(qloc - a * 256) * (256 * (a + 1));
        const int tend = min(ch * 4 + 4, ntl);
        for (int tt = ch * 4; tt < tend; ++tt) {
            const int key0 = tt * 64;
            bf16x8 ka[4][2];
#pragma unroll
            for (int kg = 0; kg < 4; ++kg)
#pragma unroll
                for (int kc = 0; kc < 2; ++kc) ka[kg][kc] = *(const bf16x8*)(p.ik() + ((size_t)b * SEQ + key0 + kg * 16 + ql) * 64 + kc * 32 + fq * 8);
            const bool band = (key0 + 63 > qb128 * 128 + wid * 16);
#pragma unroll
            for (int kg = 0; kg < 4; ++kg) {
                f32x4 sacc = (f32x4){0.f, 0.f, 0.f, 0.f};
#pragma unroll
                for (int h = 0; h < 8; ++h) {
                    f32x4 c = (f32x4){0.f, 0.f, 0.f, 0.f};
                    c = __builtin_amdgcn_mfma_f32_16x16x32_bf16(ka[kg][0], bq[h][0], c, 0, 0, 0);
                    c = __builtin_amdgcn_mfma_f32_16x16x32_bf16(ka[kg][1], bq[h][1], c, 0, 0, 0);
#pragma unroll
                    for (int j = 0; j < 4; ++j) sacc[j] = __builtin_fmaf(wv[h], __builtin_fmaxf(c[j], 0.f), sacc[j]);
                }
                const int kb = key0 + kg * 16 + fq * 4;
                if (band) {
#pragma unroll
                    for (int j = 0; j < 4; ++j) if (kb + j > qloc) sacc[j] = -INFINITY;
                }
                union { _Float16 h[4]; u32x2 v; } pk;
                pk.h[0] = (_Float16)sacc[0]; pk.h[1] = (_Float16)sacc[1]; pk.h[2] = (_Float16)sacc[2]; pk.h[3] = (_Float16)sacc[3];
                *(u32x2*)(srow + kb) = pk.v;
            }
        }
    }
}

__device__ __forceinline__ size_t mk_base(int qb) { return (size_t)512 * qb * (qb + 1); }
constexpr size_t MASK_WORDS_PER_BATCH = 540672;
__device__ __forceinline__ unsigned f16key(unsigned h) { return (h & 0x8000u) ? (~h & 0xffffu) : (h | 0x8000u); }
__device__ __forceinline__ void phase_select(const Params& p, int b) {
    const int tid_ = TID(); const int wid = tid_ >> 6, lane = tid_ & 63;
    const int gw = BID() * 8 + wid, nw = GDIM() * 8;
    for (int i = gw; i < SEQ; i += nw) {
        const int kq = i / nw;
        const int t = (kq & 1) ? (kq * nw + (nw - 1 - (i - kq * nw))) : i;
        if (t >= SEQ) continue;
        const int qb = t >> 8, ntile = 4 * (qb + 1), ntr = 2 * ((t >> 7) + 1);
        const u16* srow = p.scores() + sc_base(qb) + (size_t)(t - qb * 256) * (256 * (qb + 1));
        u64* mrow = p.mask() + (size_t)b * MASK_WORDS_PER_BATCH + mk_base(qb) + (size_t)(t - qb * 256) * ntile;
        unsigned key[64];
#pragma unroll
        for (int g4 = 0; g4 < 32; ++g4) {
            if (g4 * 4 < ntr) {
#pragma unroll
                for (int q = 0; q < 2; ++q) { const int jj = g4 * 2 + q;
                    unsigned lo = 0u, hi = 0u;
                    if (2 * jj < ntr) { lo = f16key(srow[(2 * jj) * 64 + lane]); hi = f16key(srow[(2 * jj + 1) * 64 + lane]); }
                    key[jj] = lo | (hi << 16); }
            } else { key[g4 * 2] = 0u; key[g4 * 2 + 1] = 0u; }
        }
        unsigned thr = 0x03ffu; int need = 0;
        if (t >= 256) {
            thr = 0u;
#pragma unroll 1
            for (int bit = 15; bit >= 0; --bit) {
                const unsigned cand = thr | (1u << bit);
                int cnt = 0;
#pragma unroll
                for (int g4 = 0; g4 < 32; ++g4) {
                    if (g4 * 4 < ntr) {
#pragma unroll
                        for (int q = 0; q < 2; ++q) { const unsigned kk = key[g4 * 2 + q];
                            cnt += __builtin_popcountll(__ballot((kk & 0xffffu) >= cand)) + __builtin_popcountll(__ballot((kk >> 16) >= cand)); }
                    }
                }
                if (cnt >= 256) thr = cand;
            }
            int cgt = 0;
#pragma unroll
            for (int g4 = 0; g4 < 32; ++g4) {
                if (g4 * 4 < ntr) {
#pragma unroll
                    for (int q = 0; q < 2; ++q) { const unsigned kk = key[g4 * 2 + q];
                        cgt += __builtin_popcountll(__ballot((kk & 0xffffu) > thr)) + __builtin_popcountll(__ballot((kk >> 16) > thr)); }
                }
            }
            need = 256 - cgt;
        }
        u64 w0 = 0, w1 = 0;
#pragma unroll
        for (int g4 = 0; g4 < 32; ++g4) {
            if (g4 * 4 < ntr) {
#pragma unroll
                for (int q = 0; q < 4; ++q) {
                    const int j = g4 * 4 + q; const unsigned kk = key[j >> 1]; const unsigned kv = (j & 1) ? (kk >> 16) : (kk & 0xffffu);
                    u64 gt = __ballot(kv > thr);
                    if (need > 0) {
                        u64 eq = __ballot(kv == thr);
                        int ne = __builtin_popcountll(eq);
                        if (ne <= need) { gt |= eq; need -= ne; }
                        else { while (need > 0) { u64 bb = eq & (~eq + 1); gt |= bb; eq ^= bb; --need; } }
                    }
                    if (lane == (j & 63)) { if (j < 64) w0 = gt; else w1 = gt; }
                }
            }
        }
        if (lane < ntile) mrow[lane] = w0;
        if (lane + 64 < ntile) mrow[lane + 64] = w1;
    }
}

constexpr int A_D = 64, A_DM = 512, A_NW = 8, A_QBLK = 32, A_QB = 256, A_KVBLK = 64, A_NQB = SEQ / A_QB, A_NHEAD = 8;
constexpr float A_C2 = 0.125f * 1.4426950408889634f;
constexpr int A_SLOTB = 8192, A_LDS_K = 0, A_LDS_V = 3 * A_SLOTB, A_LDS_WS = 6 * A_SLOTB, A_LDS_OST = A_LDS_WS + A_NW * 256, A_LDS_MK = A_LDS_OST + A_NW * 4096, A_LDS_BYTES = A_LDS_MK + A_NW * 2048;
#define ATTN_THR 8
#define SBAR() __builtin_amdgcn_sched_barrier(0)
#define PIN(x) asm volatile("" : "+v"(x))
#define MFMA32(a, b, c) __builtin_amdgcn_mfma_f32_32x32x16_bf16(a, b, c, 0, 0, 0)
#define WAIT_BAR(N) asm volatile("s_waitcnt vmcnt(" #N ") lgkmcnt(0)\n\ts_barrier" ::: "memory")
__device__ __forceinline__ void glds16s(const void* sbase, unsigned voff, unsigned lds_base) {
    unsigned sv; asm volatile("s_mov_b32 %0, m0\n\ts_mov_b32 m0, %3\n\ts_nop 0\n\tglobal_load_lds_dwordx4 %1, %2\n\ts_mov_b32 m0, %0" : "=&s"(sv) : "v"(voff), "s"(sbase), "s"(lds_base) : "memory"); }
typedef __attribute__((address_space(3))) const char* lds_cptr;
typedef short v4i16_t __attribute__((ext_vector_type(4)));
__device__ __forceinline__ void kload2(bf16x8* kf, lds_cptr kp, int d0) { kf[2 * d0] = *(const __attribute__((address_space(3))) bf16x8*)(kp + d0 * 2048); kf[2 * d0 + 1] = *(const __attribute__((address_space(3))) bf16x8*)(kp + d0 * 2048 + 512); }
__device__ __forceinline__ s16x4 vtr(lds_cptr p) { return __builtin_bit_cast(s16x4, __builtin_amdgcn_ds_read_tr16_b64_v4i16((__attribute__((address_space(3))) v4i16_t*)p)); }
#define MX3(a, b, c) __builtin_fmaxf(__builtin_fmaxf((a), (b)), (c))
__device__ __forceinline__ float rowmax(const f32x16& p0, const f32x16& p1) {
    float a = MX3(p0[0], p0[1], p1[0]), b = MX3(p0[2], p0[3], p1[1]); a = MX3(a, p1[2], p1[3]);
#pragma unroll
    for (int r = 4; r < 16; r += 4) { a = MX3(a, p0[r], p0[r + 1]); b = MX3(b, p0[r + 2], p0[r + 3]); a = MX3(a, p1[r], p1[r + 1]); b = MX3(b, p1[r + 2], p1[r + 3]); }
    float m = __builtin_fmaxf(a, b); auto rr = __builtin_amdgcn_permlane32_swap(__float_as_uint(m), __float_as_uint(m), false, false);
    return __builtin_fmaxf(__uint_as_float(rr[0]), __uint_as_float(rr[1])); }
__device__ __forceinline__ void cmask(f32x16& p0, f32x16& p1, int jb, int qrel, int hi) {
    const int kb = 64 * jb + 4 * hi;
#pragma unroll
    for (int r = 0; r < 16; ++r) { const int kv = kb + (r & 3) + 8 * (r >> 2); if (kv > qrel) p0[r] = -INFINITY; if (kv + 32 > qrel) p1[r] = -INFINITY; } }
__device__ __forceinline__ float mand(float x, unsigned w, int pos) { return __uint_as_float(__float_as_uint(x) & (unsigned)__builtin_amdgcn_sbfe((int)w, pos, 1)); }
#define BITP(i) (((i) & 3) + 8 * ((i) >> 2))

__device__ __forceinline__ void attn64_unit(int b, int h, int qb, const u16* Q, const u16* __restrict__ K, const u16* __restrict__ V, const u16* __restrict__ SG, u16* O, const u64* mrow0, char* lds) {
    const int tid = TID(), lane = tid & 63, r32 = lane & 31, hi = lane >> 5; const int wid = __builtin_amdgcn_readfirstlane(tid >> 6);
    const long rowbase = (long)b * SEQ; const int q0 = qb * A_QB, NT = (q0 + A_QB) / A_KVBLK;
    const u16* Qw = Q + (rowbase + q0 + wid * A_QBLK) * A_DM + h * A_D;
    const unsigned lds0 = (unsigned)(uintptr_t)lds; float* wsf = (float*)(lds + A_LDS_WS) + wid * 64;
    const u16* kbase = K + rowbase * A_DM + h * A_D; const u16* vbase = V + rowbase * A_DM + h * A_D;
    const unsigned koff = (unsigned)(lane * A_DM + wid * 8) * 2u;
    const unsigned voff = (unsigned)((16 * (wid & 3) + (lane >> 2)) * A_DM + (wid >> 2) * 32 + (lane & 3) * 8) * 2u;
    const unsigned kdst = lds0 + A_LDS_K + wid * 1024, vdst = lds0 + A_LDS_V + wid * 1024;
#define DMA_K(t, slot) glds16s(kbase + (long)(t) * A_KVBLK * A_DM, koff, (unsigned)__builtin_amdgcn_readfirstlane(kdst + (slot)))
#define DMA_V(t, slot) glds16s(vbase + (long)(t) * A_KVBLK * A_DM, voff, (unsigned)__builtin_amdgcn_readfirstlane(vdst + (slot)))
#define DMA_M(chunk) glds16s(mrow0 + 2 * (chunk), moff, (unsigned)__builtin_amdgcn_readfirstlane(mdst + ((chunk) & 1) * 1024))
#define MWORD(t) (*(const u64*)(lds + A_LDS_MK + wid * 2048 + (((t) >> 1) & 1) * 1024 + r32 * 16 + ((t) & 1) * 8))
    const lds_cptr vp0 = (lds_cptr)lds + A_LDS_V + ((lane >> 4) & 1) * 32 + (lane & 3) * 8 + (4 * hi + ((lane & 15) >> 2)) * 64;
    const lds_cptr kp0 = (lds_cptr)lds + A_LDS_K + hi * 1024 + r32 * 16;
    const int qrel = wid * A_QBLK + r32;
    const unsigned moff = (unsigned)(qrel * NT) * 8u;
    const unsigned mdst = lds0 + A_LDS_MK + wid * 2048;
    DMA_M(0);
    DMA_K(0, 0); DMA_V(0, 0); DMA_K(1, A_SLOTB);
    bf16x8 qr[4];
#pragma unroll
    for (int d0 = 0; d0 < 4; ++d0) qr[d0] = *reinterpret_cast<const bf16x8*>(&Qw[(long)r32 * A_DM + d0 * 16 + hi * 8]);
    float mhat = 0.f, l_reg = 0.f; f32x16 o[2]; o[0] = f32x16{}; o[1] = f32x16{};
    const f32x16 zero16 = f32x16{};
    bool resc = false;
    f32x16 pA0, pA1, pB0, pB1; bf16x8 kf[8]; s16x4 vlo[8], vhi[8]; u32x4 pw0, pw1, pw2, pw3;
    int sl_prev = 0, sl_cur = 0, sl_next = A_SLOTB;
    const int sh4 = 4 * hi;
#define ROT() do { sl_prev = sl_cur; sl_cur = sl_next; sl_next = (sl_next == 2 * A_SLOTB) ? 0 : sl_next + A_SLOTB; } while (0)
#define EX(v) __builtin_amdgcn_exp2f(__builtin_fmaf((v), A_C2, nmh))
#define RESC() do { if (resc) { _Pragma("unroll") for (int d_ = 0; d_ < 2; ++d_) _Pragma("unroll") for (int r = 0; r < 16; ++r) o[d_][r] *= wsf[crow(r, hi)]; } } while (0)
    DMA_K(2, 2 * A_SLOTB);
    WAIT_BAR(3);
    _Pragma("unroll") for (int d0 = 0; d0 < 4; ++d0) kload2(kf, kp0, d0);
    pA0 = MFMA32(kf[0], qr[0], zero16); pA1 = MFMA32(kf[1], qr[0], zero16); pA0 = MFMA32(kf[2], qr[1], pA0); pA1 = MFMA32(kf[3], qr[1], pA1);
    pA0 = MFMA32(kf[4], qr[2], pA0); pA1 = MFMA32(kf[5], qr[2], pA1); pA0 = MFMA32(kf[6], qr[3], pA0); pA1 = MFMA32(kf[7], qr[3], pA1);
    { const float rm = rowmax(pA0, pA1); mhat = rm * A_C2; const float nmh = -mhat;
      const u64 mw0 = MWORD(0); const unsigned wl = (unsigned)mw0 >> sh4, wh = (unsigned)(mw0 >> 32) >> sh4;
#pragma unroll
      for (int r = 0; r < 16; ++r) { pA0[r] = mand(EX(pA0[r]), wl, BITP(r)); pA1[r] = mand(EX(pA1[r]), wh, BITP(r)); } }
    WAIT_BAR(0);
    DMA_K(3, 0); DMA_V(1, A_SLOTB); ROT();
    _Pragma("unroll") for (int d0 = 0; d0 < 4; ++d0) kload2(kf, kp0 + sl_cur, d0);
    WAIT_BAR(2);
#define PKW(P, i) cvtpk(P[i], P[i + 1])
#define PAF(k) __builtin_bit_cast(bf16x8, pw##k)
#define VFR(i) (bf16x8){vlo[i][0], vlo[i][1], vlo[i][2], vlo[i][3], vhi[i][0], vhi[i][1], vhi[i][2], vhi[i][3]}
#define VRD(i) do { vlo[i] = vtr(vp_ + (((i) >> 2) * 4096 + ((i) & 3) * 1024)); vhi[i] = vtr(vp_ + (((i) >> 2) * 4096 + ((i) & 3) * 1024 + 512)); } while (0)
#define KRD(G, d0) do { if (G) { kload2(kf, kp0 + sl_next, d0); SBAR(); } } while (0)
#define GAPA(MF, a0, a1, a2, a3, W0, W1, PW) do { MF; sacc += a0; sacc += a1; sacc += a2; sacc += a3; W0; W1; PIN(PW); PIN(sacc); SBAR(); } while (0)
#define GAPB(MF, X, i, W) do { MF; X[i] = mand(EX(X[i]), W, BITP(i)); X[i + 1] = mand(EX(X[i + 1]), W, BITP(i + 1)); X[i + 2] = mand(EX(X[i + 2]), W, BITP(i + 2)); X[i + 3] = mand(EX(X[i + 3]), W, BITP(i + 3)); PIN(X); SBAR(); } while (0)
#define STEP(C0, C1, P0, P1, t, MASK, GK, GV, GL, ML) do { SBAR(); \
    if (ML) DMA_M(((t) + 1) >> 1); \
    const u64 mw_ = MWORD(t); \
    const lds_cptr vp_ = vp0 + sl_prev; \
    VRD(0); SBAR(); float sacc = P0[0] + P0[1]; \
                    GAPA(C0 = MFMA32(kf[0], qr[0], zero16), P0[2], P0[3], P0[4], P0[5],     pw0[0] = PKW(P0, 0),  pw0[1] = PKW(P0, 2),  pw0); \
    VRD(4); SBAR(); GAPA(C1 = MFMA32(kf[1], qr[0], zero16), P0[6], P0[7], P0[8], P0[9],     pw0[2] = PKW(P0, 4),  pw0[3] = PKW(P0, 6),  pw0); \
    VRD(1); SBAR(); GAPA(C0 = MFMA32(kf[2], qr[1], C0),    P0[10], P0[11], P0[12], P0[13], pw1[0] = PKW(P0, 8),  pw1[1] = PKW(P0, 10), pw1); \
    VRD(5); SBAR(); GAPA(C1 = MFMA32(kf[3], qr[1], C1),    P0[14], P0[15], P1[0], P1[1],   pw1[2] = PKW(P0, 12), pw1[3] = PKW(P0, 14), pw1); \
    VRD(2); SBAR(); GAPA(C0 = MFMA32(kf[4], qr[2], C0),    P1[2], P1[3], P1[4], P1[5],     pw2[0] = PKW(P1, 0),  pw2[1] = PKW(P1, 2),  pw2); \
    VRD(6); SBAR(); GAPA(C1 = MFMA32(kf[5], qr[2], C1),    P1[6], P1[7], P1[8], P1[9],     pw2[2] = PKW(P1, 4),  pw2[3] = PKW(P1, 6),  pw2); \
    VRD(3); SBAR(); GAPA(C0 = MFMA32(kf[6], qr[3], C0),    P1[10], P1[11], P1[12], P1[13], pw3[0] = PKW(P1, 8),  pw3[1] = PKW(P1, 10), pw3); \
    VRD(7); SBAR(); GAPA(C1 = MFMA32(kf[7], qr[3], C1),    P1[14], P1[15], 0.f, 0.f,       pw3[2] = PKW(P1, 12), pw3[3] = PKW(P1, 14), pw3); \
    l_reg += sacc; \
    if (GK) DMA_K((t) + 3, sl_cur); if (GV) DMA_V((t) + 1, sl_next); \
    { const float rm = __builtin_fmaf(rowmax(C0, C1), A_C2, -mhat); resc = false; \
      if (__builtin_expect(__any(rm > (float)ATTN_THR), 0)) { const float dl = __builtin_fmaxf(rm, 0.f); mhat += dl; \
          const float f = __builtin_amdgcn_exp2f(-dl); l_reg *= f; if (hi == 0) wsf[r32] = f; resc = true; } } \
    const float nmh = -mhat; const unsigned wl_ = (unsigned)(mw_) >> sh4, wh_ = (unsigned)((mw_) >> 32) >> sh4; SBAR(); \
    GAPB(o[0] = MFMA32(PAF(0), VFR(0), o[0]), C0, 0, wl_);              GAPB(o[1] = MFMA32(PAF(0), VFR(4), o[1]), C0, 4, wl_); \
    KRD(GL, 0); GAPB(o[0] = MFMA32(PAF(1), VFR(1), o[0]), C0, 8, wl_);  KRD(GL, 1); GAPB(o[1] = MFMA32(PAF(1), VFR(5), o[1]), C0, 12, wl_); \
    KRD(GL, 2); GAPB(o[0] = MFMA32(PAF(2), VFR(2), o[0]), C1, 0, wh_);  KRD(GL, 3); GAPB(o[1] = MFMA32(PAF(2), VFR(6), o[1]), C1, 4, wh_); \
    GAPB(o[0] = MFMA32(PAF(3), VFR(3), o[0]), C1, 8, wh_);              GAPB(o[1] = MFMA32(PAF(3), VFR(7), o[1]), C1, 12, wh_); \
    } while (0)
    int t = 1;
    for (; t + 5 < NT; t += 2) {
        STEP(pB0, pB1, pA0, pA1, t, false, true, true, true, true);      WAIT_BAR(2); RESC(); ROT();
        STEP(pA0, pA1, pB0, pB1, t + 1, false, true, true, true, false); WAIT_BAR(2); RESC(); ROT();
    }
#define ENDW(tt) do { if ((tt) + 3 < NT) { WAIT_BAR(2); } else if ((tt) + 2 < NT) { WAIT_BAR(1); } else { WAIT_BAR(0); } } while (0)
    for (; t + 1 < NT; t += 2) {
        STEP(pB0, pB1, pA0, pA1, t, true, (t + 3 < NT), (t + 1 < NT), (t + 1 < NT), (t + 1 < NT));         ENDW(t);     RESC(); ROT();
        STEP(pA0, pA1, pB0, pB1, t + 1, true, (t + 4 < NT), (t + 2 < NT), (t + 2 < NT), false);            ENDW(t + 1); RESC(); ROT();
    }
    STEP(pB0, pB1, pA0, pA1, NT - 1, true, false, false, false, false); RESC();
    { float sacc = pB0[0] + pB0[1];
#pragma unroll
      for (int r = 2; r < 16; ++r) sacc += pB0[r];
#pragma unroll
      for (int r = 0; r < 16; ++r) sacc += pB1[r];
      l_reg += sacc;
      pw0 = (u32x4){PKW(pB0, 0), PKW(pB0, 2), PKW(pB0, 4), PKW(pB0, 6)}; pw1 = (u32x4){PKW(pB0, 8), PKW(pB0, 10), PKW(pB0, 12), PKW(pB0, 14)};
      pw2 = (u32x4){PKW(pB1, 0), PKW(pB1, 2), PKW(pB1, 4), PKW(pB1, 6)}; pw3 = (u32x4){PKW(pB1, 8), PKW(pB1, 10), PKW(pB1, 12), PKW(pB1, 14)};
      const lds_cptr vp_ = vp0 + sl_cur; _Pragma("unroll") for (int i = 0; i < 8; ++i) VRD(i);
      o[0] = MFMA32(PAF(0), VFR(0), o[0]); o[1] = MFMA32(PAF(0), VFR(4), o[1]); o[0] = MFMA32(PAF(1), VFR(1), o[0]); o[1] = MFMA32(PAF(1), VFR(5), o[1]);
      o[0] = MFMA32(PAF(2), VFR(2), o[0]); o[1] = MFMA32(PAF(2), VFR(6), o[1]); o[0] = MFMA32(PAF(3), VFR(3), o[0]); o[1] = MFMA32(PAF(3), VFR(7), o[1]); }
    { auto rr = __builtin_amdgcn_permlane32_swap(__float_as_uint(l_reg), __float_as_uint(l_reg), false, false); l_reg = __uint_as_float(rr[0]) + __uint_as_float(rr[1]); }
    if (hi == 0) wsf[32 + r32] = l_reg; asm volatile("s_waitcnt lgkmcnt(0)" ::: "memory");
    float rli[16];
#pragma unroll
    for (int r = 0; r < 16; ++r) rli[r] = __builtin_amdgcn_rcpf(wsf[32 + crow(r, hi)]);
    u16* Ow = O + (rowbase + q0 + wid * A_QBLK) * A_DM + h * A_D; const u16* Gw = SG + (rowbase + q0 + wid * A_QBLK) * A_DM + h * A_D;
    u16* stg = (u16*)(lds + A_LDS_OST) + wid * 2048;
#pragma unroll
    for (int r = 0; r < 16; ++r) { const int orow = crow(r, hi);
#pragma unroll
        for (int d0 = 0; d0 < 2; ++d0) stg[orow * 64 + d0 * 32 + r32] = f2bf(o[d0][r] * rli[r]); }
    asm volatile("s_waitcnt lgkmcnt(0)" ::: "memory");
#pragma unroll
    for (int i = 0; i < 4; ++i) { const int row = i * 8 + (lane >> 3), ch = lane & 7;
        u32x4 ov = *(const u32x4*)(stg + row * 64 + ch * 8); u32x4 gv = *(const u32x4*)(Gw + (long)row * A_DM + ch * 8); u32x4 rv;
#pragma unroll
        for (int e = 0; e < 4; ++e) rv[e] = cvtpk(bflo(ov[e]) * bflo(gv[e]), bfhi(ov[e]) * bfhi(gv[e]));
        *(u32x4*)(Ow + (long)row * A_DM + ch * 8) = rv; }
    asm volatile("s_waitcnt vmcnt(0) lgkmcnt(0)\n\ts_barrier" ::: "memory");
#undef DMA_K
#undef DMA_V
#undef DMA_M
#undef MWORD
#undef ROT
#undef EX
#undef RESC
#undef PKW
#undef PAF
#undef VFR
#undef VRD
#undef KRD
#undef ENDW
#undef GAPA
#undef GAPB
#undef STEP
}
__device__ __forceinline__ void phase_attn(const Params& p, char* lds) {
    constexpr int NPAIR = A_NQB / 2, NUNIT = NBATCH * A_NHEAD * NPAIR;
    const int bid_ = BID(), gdim_ = GDIM();
    for (int u = bid_; u < NUNIT; u += gdim_) {
        const int x = u & 7, kk = u >> 3, bh = x + 8 * (kk / NPAIR), j = kk % NPAIR;
        const int b = bh / A_NHEAD, h = bh % A_NHEAD;
        const u64* mb = p.mask() + (size_t)b * MASK_WORDS_PER_BATCH;
        attn64_unit(b, h, j, p.q(), p.k(), p.v(), p.sg(), p.bin(), mb + mk_base(j), lds);
        attn64_unit(b, h, A_NQB - 1 - j, p.q(), p.k(), p.v(), p.sg(), p.bin(), mb + mk_base(A_NQB - 1 - j), lds);
    }
}

struct EpiStash {
    u16* stash;
    __device__ __forceinline__ void operator()(const acc_t& acc, const pg8::Unit& u, int ui, int wr, int wc, int fr, int fq) const {
        const int tid_ = TID();
        u32x4* st = (u32x4*)(stash + ((size_t)BID() * 2 + ui) * 65536);
        ROWS_LOOP {
#pragma unroll
            for (int bj = 0; bj < 2; ++bj) { const f32x4 v0 = acc[ai][bj][m][0], v1 = acc[ai][bj][m][1];
                u32x4 w; w[0] = cvtpk(v0[0], v0[1]); w[1] = cvtpk(v0[2], v0[3]); w[2] = cvtpk(v1[0], v1[1]); w[3] = cvtpk(v1[2], v1[3]);
                st[((ai * 4 + m) * 2 + bj) * 512 + tid_] = w; } }
    }
};
struct EpiGate {
    const Params& p; int l; int br;
    __device__ __forceinline__ void operator()(const acc_t& acc, const pg8::Unit& u, int ui, int wr, int wc, int fr, int fq) const {
        const float* ssq = p.sumsq() + (size_t)(l & 1) * T * 16;
        const int tid_ = TID();
        const u32x4* st = (const u32x4*)(p.stash() + ((size_t)BID() * 2 + ui) * 65536);
        const int cl = wc * 4 + fq;
        ROWS_LOOP { const int row = ROW_OF; const float rs = row_rstd(ssq, row);
#pragma unroll
            for (int bj = 0; bj < 2; ++bj) { const f32x4 v0 = acc[ai][bj][m][0] * rs, v1 = acc[ai][bj][m][1] * rs;
                const u32x4 y = st[((ai * 4 + m) * 2 + bj) * 512 + tid_];
                float r[8];
                r[0] = sigmf(v0[0]) * bflo(y[0]); r[1] = sigmf(v0[1]) * bfhi(y[0]); r[2] = sigmf(v0[2]) * bflo(y[1]); r[3] = sigmf(v0[3]) * bfhi(y[1]);
                r[4] = sigmf(v1[0]) * bflo(y[2]); r[5] = sigmf(v1[1]) * bfhi(y[2]); r[6] = sigmf(v1[2]) * bflo(y[3]); r[7] = sigmf(v1[3]) * bfhi(y[3]);
                u32x4* mp = (u32x4*)(p.merged() + (size_t)row * 1024 + u.pn * 256 + 16 * cl + bj * 8);
                if (br > 0) { const u32x4 om = *mp;
#pragma unroll
                    for (int e = 0; e < 4; ++e) { r[2 * e] += bflo(om[e]); r[2 * e + 1] += bfhi(om[e]); } }
                u32x4 w; w[0] = cvtpk(r[0], r[1]); w[1] = cvtpk(r[2], r[3]); w[2] = cvtpk(r[4], r[5]); w[3] = cvtpk(r[6], r[7]);
                *mp = w; } }
    }
};
__device__ __forceinline__ void phase_merge(const Params& p, int l, char* shm) {
    pg8::RowOrder S{4, 512, GDIM(), BID()};
    for (int br = 0; br < 3; ++br) {
        const u16* Ain = br == 0 ? p.ga() : (br == 1 ? p.bin() : p.sp());
        const u16* Wy = (br == 0 ? p.wt_oa() : (br == 1 ? p.wt_ob() : p.wt_oc())) + (size_t)l * 1024 * 512;
        { pg8::Gemm g{Ain, Wy, T, 1024, 512}; EpiStash E{p.stash()}; pg8::gemm_phase((PG8_LAS unsigned char*)shm, g, S, E); }
        { pg8::Gemm g{p.xb(), p.wt_mg() + (size_t)l * 3072 * 1024 + (size_t)br * 1024 * 1024, T, 1024, 1024}; EpiGate E{p, l, br}; pg8::gemm_phase((PG8_LAS unsigned char*)shm, g, S, E); }
    }
}

struct EpiOut {
    const Params& p; int l;
    __device__ __forceinline__ void operator()(const acc_t& acc, const pg8::Unit& u, int ui, int wr, int wc, int fr, int fq) const {
        const float* xsrc = (l == 0) ? p.x_in : p.x;
        const int cl = wc * 4 + fq;
        ROWS_LOOP { const int row = ROW_OF; float ss = 0.f;
#pragma unroll
            for (int bj = 0; bj < 2; ++bj) { const size_t o = (size_t)row * 1024 + u.pn * 256 + 16 * cl + bj * 8;
                f32x4 x0 = *(const f32x4*)(xsrc + o) + acc[ai][bj][m][0], x1 = *(const f32x4*)(xsrc + o + 4) + acc[ai][bj][m][1];
                *(f32x4*)(p.x + o) = x0; *(f32x4*)(p.x + o + 4) = x1;
                if (l < NL - 1) { u32x4 w; w[0] = cvtpk(x0[0], x0[1]); w[1] = cvtpk(x0[2], x0[3]); w[2] = cvtpk(x1[0], x1[1]); w[3] = cvtpk(x1[2], x1[3]); *(u32x4*)(p.xb() + o) = w;
#pragma unroll
                    for (int j = 0; j < 4; ++j) ss += x0[j] * x0[j] + x1[j] * x1[j]; } }
            if (l < NL - 1) { ss += __shfl_xor(ss, 16); ss += __shfl_xor(ss, 32); if (fq == 0) p.sumsq()[(size_t)((l + 1) & 1) * T * 16 + (size_t)row * 16 + u.pn * 4 + wc] = ss; } }
    }
};
__device__ __forceinline__ void phase_out(const Params& p, int l, char* shm) {
    pg8::RowOrder S{4, 512, GDIM(), BID()};
    pg8::Gemm g{p.merged(), p.wt_o() + (size_t)l * 1024 * 1024, T, 1024, 1024};
    EpiOut E{p, l};
    pg8::gemm_phase((PG8_LAS unsigned char*)shm, g, S, E);
}

enum { PH_PREP0 = 0, PH_IN, PH_MIX, PH_IDX, PH_SEL, PH_ATTN, PH_MERGE, PH_OUT };
template <int PH> __global__ __launch_bounds__(NTHR) void k_phase(Params p, int l, int b) {
    extern __shared__ __attribute__((aligned(16))) char shm[];
    if (PH == PH_PREP0) phase_prep0(p, shm);
    if (PH == PH_IN) phase_in(p, l, shm);
    if (PH == PH_MIX) phase_mix(p, l);
    if (PH == PH_IDX) phase_indexer(p, b);
    if (PH == PH_SEL) phase_select(p, b);
    if (PH == PH_ATTN) phase_attn(p, shm);
    if (PH == PH_MERGE) phase_merge(p, l, shm);
    if (PH == PH_OUT) phase_out(p, l, shm);
}

#if MEGA
typedef const __attribute__((address_space(4))) Params* kparams_t;
__device__ __forceinline__ Params load_params(kparams_t k) {
    Params q; q.x_in = k->x_in; q.norm_g = k->norm_g; q.w_in = k->w_in; q.conv_w = k->conv_w; q.w_out_conv = k->w_out_conv; q.q_g = k->q_g; q.k_g = k->k_g; q.w_out_attn = k->w_out_attn;
    q.pool_w = k->pool_w; q.pool_scale = k->pool_scale; q.w_out_pool = k->w_out_pool; q.w_o = k->w_o; q.x = k->x; q.ws = k->ws; return q; }
#define PHP(q) kparams_t kq_##q = kp; asm volatile("" : "+s"(kq_##q)); const Params q = load_params(kq_##q);
__global__ __launch_bounds__(NTHR) void k_mega(Params p_unused) {
    extern __shared__ __attribute__((aligned(16))) char shm[];
    cg::grid_group grid = cg::this_grid();
    kparams_t kp = (kparams_t)__builtin_amdgcn_kernarg_segment_ptr();

#ifndef SK_PREP
        { PHP(p) phase_prep0(p, shm); }
#endif

    grid.sync();
    for (int l = 0; l < NL; ++l) {

#ifndef SK_IN
        { PHP(p) phase_in(p, l, shm); }
#endif

        grid.sync();

#ifndef SK_MIX
        { PHP(p) phase_mix(p, l); }
#endif

        for (int b = 0; b < NBATCH; ++b) {

#ifndef SK_IDX
        { PHP(p) phase_indexer(p, b); }
#endif

            grid.sync();

#ifndef SK_SEL
        { PHP(p) phase_select(p, b); }
#endif

            grid.sync();
        }

#ifndef SK_ATTN
        { PHP(p) phase_attn(p, shm); }
#endif

        grid.sync();

#ifndef SK_MERGE
        { PHP(p) phase_merge(p, l, shm); }
#endif

        grid.sync();

#ifndef SK_OUT
        { PHP(p) phase_out(p, l, shm); }
#endif

        grid.sync();
    }
}
#endif

static Params make_params(void* const* d_in, void* d_out, void* d_ws) {
    Params p{};
    p.x_in = (const float*)d_in[0]; p.norm_g = (const float*)d_in[1]; p.w_in = (const float*)d_in[2]; p.conv_w = (const float*)d_in[3];
    p.w_out_conv = (const float*)d_in[4]; p.q_g = (const float*)d_in[5]; p.k_g = (const float*)d_in[6]; p.w_out_attn = (const float*)d_in[7];
    p.pool_w = (const float*)d_in[8]; p.pool_scale = (const float*)d_in[9]; p.w_out_pool = (const float*)d_in[10]; p.w_o = (const float*)d_in[11];
    p.x = (float*)d_out; p.ws = (char*)d_ws;
    return p;
}

extern "C" void kernel_launch(void* const* d_in, const int* in_sizes, int n_in, void* d_out, int out_size, void* d_ws, size_t ws_size, hipStream_t stream) {
    if (ws_size < WS_NEEDED) { fprintf(stderr, "workspace too small: %zu < %zu\n", ws_size, (size_t)WS_NEEDED); return; }
    Params p = make_params(d_in, d_out, d_ws);
    const int grid = 256;
#if MEGA
    static bool attr = false;
    if (!attr) { hipFuncSetAttribute((const void*)k_mega, hipFuncAttributeMaxDynamicSharedMemorySize, LDS_BYTES); attr = true; }
    void* args[] = {&p};
    hipError_t e = hipLaunchCooperativeKernel((void*)k_mega, dim3(grid), dim3(NTHR), args, LDS_BYTES, stream);
    if (e != hipSuccess) fprintf(stderr, "cooperative launch failed: %s\n", hipGetErrorString(e));
#else
    static bool attr = false;
    if (!attr) {
        hipFuncSetAttribute((const void*)k_phase<PH_PREP0>, hipFuncAttributeMaxDynamicSharedMemorySize, LDS_BYTES);
        hipFuncSetAttribute((const void*)k_phase<PH_IN>, hipFuncAttributeMaxDynamicSharedMemorySize, LDS_BYTES);
        hipFuncSetAttribute((const void*)k_phase<PH_MIX>, hipFuncAttributeMaxDynamicSharedMemorySize, LDS_BYTES);
        hipFuncSetAttribute((const void*)k_phase<PH_IDX>, hipFuncAttributeMaxDynamicSharedMemorySize, LDS_BYTES);
        hipFuncSetAttribute((const void*)k_phase<PH_SEL>, hipFuncAttributeMaxDynamicSharedMemorySize, LDS_BYTES);
        hipFuncSetAttribute((const void*)k_phase<PH_ATTN>, hipFuncAttributeMaxDynamicSharedMemorySize, LDS_BYTES);
        hipFuncSetAttribute((const void*)k_phase<PH_MERGE>, hipFuncAttributeMaxDynamicSharedMemorySize, LDS_BYTES);
        hipFuncSetAttribute((const void*)k_phase<PH_OUT>, hipFuncAttributeMaxDynamicSharedMemorySize, LDS_BYTES);
        attr = true;
    }
#define LAUNCH(PH, l, b) hipLaunchKernelGGL(k_phase<PH>, dim3(grid), dim3(NTHR), LDS_BYTES, stream, p, l, b)
    LAUNCH(PH_PREP0, 0, 0);
    for (int l = 0; l < NL; ++l) {
        LAUNCH(PH_IN, l, 0);
        LAUNCH(PH_MIX, l, 0);
        for (int b = 0; b < NBATCH; ++b) { LAUNCH(PH_IDX, l, b); LAUNCH(PH_SEL, l, b); }
        LAUNCH(PH_ATTN, l, 0);
        LAUNCH(PH_MERGE, l, 0);
        LAUNCH(PH_OUT, l, 0);
    }
#endif
}
```

```cpp
#include <hip/hip_runtime.h>
#include <hip/hip_cooperative_groups.h>
#include <stdint.h>
#include <stdio.h>
namespace cg = cooperative_groups;

typedef unsigned short u16;
typedef unsigned long long u64;
typedef __attribute__((ext_vector_type(8))) short bf16x8;
typedef __attribute__((ext_vector_type(4))) short s16x4;
typedef __attribute__((ext_vector_type(4))) float f32x4;
typedef __attribute__((ext_vector_type(16))) float f32x16;
typedef __attribute__((ext_vector_type(4))) unsigned u32x4;
typedef __attribute__((ext_vector_type(2))) unsigned u32x2;

#ifndef MEGA
#define MEGA 1
#endif
__device__ __forceinline__ int TID() { int t = threadIdx.x; asm volatile("" : "+v"(t)); return t; }
__device__ __forceinline__ int BID() { int t = blockIdx.x; asm volatile("" : "+s"(t)); return t; }
__device__ __forceinline__ int GDIM() { int t = gridDim.x; asm volatile("" : "+s"(t)); return t; }

constexpr int SEQ = 8192, NBATCH = 4, T = NBATCH * SEQ, DMODEL = 1024, NL = 4, INW = 8776;
constexpr int NPA = 5888;
constexpr int NTHR = 512;
constexpr int LDS_BYTES = 131072;
constexpr float RMS_EPS = 1e-6f;

struct Params {
    const float *x_in, *norm_g, *w_in, *conv_w, *w_out_conv, *q_g, *k_g, *w_out_attn, *pool_w, *pool_scale, *w_out_pool, *w_o;
    float* x; char* ws;
    __device__ __forceinline__ u16* xb() const { return (u16*)(ws + 0ull); }
    __device__ __forceinline__ u16* z() const { return (u16*)(ws + 67108864ull); }
    __device__ __forceinline__ u16* ga() const { return (u16*)(ws + 100663296ull); }
    __device__ __forceinline__ u16* q() const { return (u16*)(ws + 134217728ull); }
    __device__ __forceinline__ u16* k() const { return (u16*)(ws + 167772160ull); }
    __device__ __forceinline__ u16* v() const { return (u16*)(ws + 201326592ull); }
    __device__ __forceinline__ u16* sg() const { return (u16*)(ws + 234881024ull); }
    __device__ __forceinline__ u16* iq() const { return (u16*)(ws + 268435456ull); }
    __device__ __forceinline__ u16* u() const { return (u16*)(ws + 301989888ull); }
    __device__ __forceinline__ u16* sp() const { return (u16*)(ws + 335544320ull); }
    __device__ __forceinline__ u16* ik() const { return (u16*)(ws + 369098752ull); }
    __device__ __forceinline__ float* iw() const { return (float*)(ws + 373293056ull); }
    __device__ __forceinline__ u16* wt_in() const { return (u16*)(ws + 374341632ull); }
    __device__ __forceinline__ u16* wt_mg() const { return (u16*)(ws + 422576128ull); }
    __device__ __forceinline__ u16* wt_oa() const { return (u16*)(ws + 447741952ull); }
    __device__ __forceinline__ u16* wt_ob() const { return (u16*)(ws + 451936256ull); }
    __device__ __forceinline__ u16* wt_oc() const { return (u16*)(ws + 456130560ull); }
    __device__ __forceinline__ u16* wt_o() const { return (u16*)(ws + 460324864ull); }
    __device__ __forceinline__ float* ropec() const { return (float*)(ws + 468713472ull); }
    __device__ __forceinline__ float* ropes() const { return (float*)(ws + 469762048ull); }
    __device__ __forceinline__ float* sumsq() const { return (float*)(ws + 470810624ull); }
    __device__ __forceinline__ u64* mask() const { return (u64*)(ws + 475004928ull); }
    __device__ __forceinline__ u16* scores() const { return (u16*)(ws + 492306432ull); }
    __device__ __forceinline__ u16* stash() const { return scores(); }
    __device__ __forceinline__ u16* merged() const { return q(); }
    __device__ __forceinline__ u16* bin() const { return iq(); }
};
constexpr size_t WS_BAR = 561512448ull;
constexpr size_t WS_NEEDED = WS_BAR + 16384;


__device__ __forceinline__ unsigned cvtpk(float lo, float hi) { unsigned r; asm("v_cvt_pk_bf16_f32 %0, %1, %2" : "=v"(r) : "v"(lo), "v"(hi)); return r; }
__device__ __forceinline__ u16 f2bf(float f) { return (u16)(cvtpk(f, 0.f) & 0xffffu); }
__device__ __forceinline__ float bf2f(u16 b) { return __uint_as_float(((unsigned)b) << 16); }
__device__ __forceinline__ float bflo(unsigned w) { return __uint_as_float(w << 16); }
__device__ __forceinline__ float bfhi(unsigned w) { return __uint_as_float(w & 0xffff0000u); }
__device__ __forceinline__ float siluf(float x) { return x / (1.f + __expf(-x)); }
__device__ __forceinline__ float sigmf(float x) { return 1.f / (1.f + __expf(-x)); }

__device__ __forceinline__ float row_rstd(const float* ssp, int row) {
    const f32x4* q = (const f32x4*)(ssp + (size_t)row * 16);
    const f32x4 a = q[0], b = q[1], c = q[2], d = q[3];
    const float s = ((a[0] + a[1]) + (a[2] + a[3])) + ((b[0] + b[1]) + (b[2] + b[3])) + ((c[0] + c[1]) + (c[2] + c[3])) + ((d[0] + d[1]) + (d[2] + d[3]));
    return rsqrtf(s * (1.f / 1024.f) + RMS_EPS);
}
__device__ __forceinline__ int lc_of_tc(int tc) { int bj = tc >> 7, wc = (tc >> 5) & 3, n = (tc >> 4) & 1, fq = (tc >> 2) & 3, j = tc & 3; return ((wc * 4 + fq) << 4) + bj * 8 + n * 4 + j; }
__device__ __forceinline__ int tc_of_lc(int lc) { int cl = lc >> 4, s = lc & 15, wc = cl >> 2, fq = cl & 3, bj = s >> 3, n = (s >> 2) & 1, j = s & 3; return bj * 128 + wc * 32 + n * 16 + fq * 4 + j; }

__device__ __forceinline__ int src_col_in(int np) {
    int pn = np >> 8, tc = np & 255;
    int bj = tc >> 7, wc = (tc >> 5) & 3, n = (tc >> 4) & 1, fq = (tc >> 2) & 3, j = tc & 3, cl = wc * 4 + fq, s = bj * 8 + n * 4 + j, lc = cl * 16 + s;
    int d = (s < 8) ? (8 * fq + s) : (8 * fq + 32 + (s - 8));
    if (pn < 8) return (s & 3) * 512 + pn * 64 + cl * 4 + (s >> 2);
    if (pn < 12) { int which = (pn - 8) >> 1, head = ((pn - 8) & 1) * 4 + wc; return 2048 + which * 512 + head * 64 + d; }
    if (pn < 14) return 3072 + (pn - 12) * 256 + lc;
    if (pn < 16) return 3584 + (pn - 14) * 256 + lc;
    if (pn < 18) { int head = (pn - 16) * 4 + wc; return 4096 + head * 64 + d; }
    if (pn == 18) { if (wc == 0) return 4608 + d; if (wc == 1 && fq == 0 && s < 8) return 4672 + s; return -1; }
    if (pn < 21) return -2;
    return 5192 + (pn - 21) * 256 + lc;
}

__device__ __forceinline__ void prep_x(const Params& p) {
    const int tid_ = TID(); const int lane = tid_ & 63, gw = BID() * (NTHR / 64) + (tid_ >> 6), nw = GDIM() * (NTHR / 64);
    for (int row = gw; row < T; row += nw) {
        const float4* src = (const float4*)(p.x_in + (size_t)row * DMODEL);
        float ss = 0.f;
#pragma unroll
        for (int i = 0; i < 4; ++i) {
            float4 v = src[i * 64 + lane];
            ss += v.x * v.x + v.y * v.y + v.z * v.z + v.w * v.w;
            u32x2 o; o[0] = cvtpk(v.x, v.y); o[1] = cvtpk(v.z, v.w);
            *(u32x2*)(p.xb() + (size_t)row * DMODEL + (i * 64 + lane) * 4) = o;
        }
#pragma unroll
        for (int m = 32; m >= 1; m >>= 1) ss += __shfl_xor(ss, m);
        if (lane < 16) p.sumsq()[(size_t)row * 16 + lane] = (lane == 0) ? ss : 0.f;
    }
}
__device__ __forceinline__ void prep_rope(const Params& p) {
    const int i0 = BID() * NTHR + TID(), istep = GDIM() * NTHR;
    for (int i = i0; i < SEQ * 32; i += istep) {
        int pos = i >> 5, j = i & 31;
        float inv = 1.0f / powf(10000.0f, (float)(2 * j) / 64.0f);
        float ang = (float)pos * inv;
        p.ropec()[i] = cosf(ang); p.ropes()[i] = sinf(ang);
    }
}
__device__ __forceinline__ void prep_wt(const float* src, int lds_, const float* scale, u16* dst, int K, int NP, int mode, float* tile) {
    const int tid_ = TID(); const int tx = tid_ & 63, ty = tid_ >> 6; const int bid_ = BID(), gdim_ = GDIM();
    const int ntn = NP / 64, ntk = K / 64;
    for (int t = bid_; t < ntn * ntk; t += gdim_) {
        const int n0 = (t / ntk) * 64, k0 = (t % ntk) * 64;
        int np = n0 + tx, col;
        if (mode == 0) col = src_col_in(np);
        else if (mode == 1) col = 5704 + (np & ~255) + lc_of_tc(np & 255);
        else col = (np & ~255) + lc_of_tc(np & 255);
        __syncthreads();
#pragma unroll
        for (int i = 0; i < 8; ++i) { int kk = ty + 8 * i; tile[kk * 65 + tx] = (col >= 0) ? src[(size_t)(k0 + kk) * lds_ + col] : 0.f; }
        __syncthreads();
        const float sc = scale ? scale[k0 + tx] : 1.f;
#pragma unroll
        for (int i = 0; i < 8; ++i) {
            int nn = ty + 8 * i; int npo = n0 + nn;
            bool skip = (mode == 0) && ((npo >> 8) == 19 || (npo >> 8) == 20);
            if (!skip) dst[(size_t)npo * K + k0 + tx] = f2bf(tile[tx * 65 + nn] * sc);
        }
    }
}
__device__ __forceinline__ void prep_fold(const float* win, const float* ng, const float* pw, u16* wt_in) {
    const int i0 = BID() * NTHR + TID(), istep = GDIM() * NTHR;
    for (int i = i0; i < 1024 * 512; i += istep) {
        int k = i >> 9, n = i & 511, g = n >> 7, d = n & 127;
        const float* wr = win + (size_t)k * INW + 4680 + g * 128;
        const float* pp = pw + (size_t)g * 128 * 128 + d;
        float acc = 0.f;
        for (int c = 0; c < 128; ++c) acc += wr[c] * pp[c * 128];
        int row = (19 + (n >> 8)) * 256 + tc_of_lc(n & 255);
        wt_in[(size_t)row * 1024 + k] = f2bf(acc * ng[k]);
    }
}
__device__ __forceinline__ void phase_prep0(const Params& p, char* shm) {
    prep_x(p); prep_rope(p);
    float* tile = (float*)shm;
    for (int l = 0; l < NL; ++l) {
        const float* ng = p.norm_g + l * 1024;
        const float* win = p.w_in + (size_t)l * 1024 * INW;
        prep_wt(win, INW, ng, p.wt_in() + (size_t)l * NPA * 1024, 1024, NPA, 0, tile);
        prep_wt(win, INW, ng, p.wt_mg() + (size_t)l * 3072 * 1024, 1024, 3072, 1, tile);
        prep_wt(p.w_out_conv + (size_t)l * 512 * 1024, 1024, nullptr, p.wt_oa() + (size_t)l * 1024 * 512, 512, 1024, 2, tile);
        prep_wt(p.w_out_attn + (size_t)l * 512 * 1024, 1024, nullptr, p.wt_ob() + (size_t)l * 1024 * 512, 512, 1024, 2, tile);
        prep_wt(p.w_out_pool + (size_t)l * 512 * 1024, 1024, nullptr, p.wt_oc() + (size_t)l * 1024 * 512, 512, 1024, 2, tile);
        prep_wt(p.w_o + (size_t)l * 1024 * 1024, 1024, nullptr, p.wt_o() + (size_t)l * 1024 * 1024, 1024, 1024, 3, tile);
        prep_fold(win, ng, p.pool_w + (size_t)l * 4 * 128 * 128, p.wt_in() + (size_t)l * NPA * 1024);
    }
}

namespace pg8 {
#define PG8_LAS __attribute__((address_space(3)))
typedef unsigned short bf16_t;
constexpr int BM = 256, BK = 64, HALF = 128, HTB = HALF * BK * 2, STAGE_BYTES = 8 * HTB;
__device__ __forceinline__ int lds_byte(int r, int c) { const int st = (r >> 4) * 2 + (c >> 5), rr = r & 15, cc = c & 31, ob = rr * 64 + cc * 2; return st * 1024 + (ob ^ (((ob >> 9) & 1) << 5)); }
__device__ __forceinline__ void stage_rc(int b, int& R, int& C) { const int st = b / 1024, sb = b % 1024, swz = sb ^ (((sb >> 9) & 1) << 5); R = (st >> 1) * 16 + swz / 64; C = (st & 1) * 32 + (swz % 64) / 2; }
struct Unit { int pm, pn; };
struct Gemm { const bf16_t* A; const bf16_t* Bt; int M, N, K; };
constexpr int NXCD = 8, WGM = 8;
struct StaticOrder {
    int nM, nN, nwg, G, c;
    __device__ void init(int M, int N, int G_, int c_) { nM = M / BM; nN = N / BM; nwg = nM * nN; G = G_; c = c_; }
    __device__ bool next(int i, Unit& u) const {
        const long L = (long)i * G + c; if (L >= nwg) return false;
        int wgid = (int)L; { const int q = nwg / NXCD, r = nwg % NXCD, xcd = wgid % NXCD, off = wgid / NXCD; wgid = (xcd < r ? xcd * (q + 1) : r * (q + 1) + (xcd - r) * q) + off; }
        const int nig = WGM * nN, gid = wgid / nig, fm = gid * WGM, gsz = (nM - fm) < WGM ? (nM - fm) : WGM;
        u.pm = fm + ((wgid % nig) % gsz); u.pn = (wgid % nig) / gsz; return true;
    }
};
struct RowOrder {
    int nN, ntile, G, c;
    __device__ bool next(int i, Unit& u) const { const int t = c + i * G; if (t >= ntile) return false; u.pm = t / nN; u.pn = t % nN; return true; }
};
template <class Epi, class Sched>
__device__ __forceinline__ void gemm_phase(PG8_LAS unsigned char* lds, const Gemm g, const Sched& S, const Epi& E) {
    const int tid = TID(), wid = __builtin_amdgcn_readfirstlane(tid >> 6), lane = tid & 63, wr = wid >> 2, wc = wid & 3, fr = lane & 15, fq = lane >> 4;
    const int K = g.K, nt = K / BK;
    unsigned voffA[2], voffB[2];
#pragma unroll
    for (int i = 0; i < 2; ++i) { int R, C; stage_rc(tid * 16 + i * 8192, R, C); voffA[i] = (unsigned)(R * K + C) * 2u; voffB[i] = voffA[i]; }
    const size_t kstep = (size_t)(BK * 2);
    const size_t hstep = (size_t)HALF * K * 2;
    const size_t tstep = 2 * hstep;
    const unsigned ldsw = (unsigned)wid * 1024u;
    const int aoff = lds_byte(wr * 64 + fr, fq * 8), boff = lds_byte(wc * 32 + fr, fq * 8);
#define PG8_SA(b, h) (((b) * 2 + (h)) * HTB)
#define PG8_SB(b, h) ((4 + (b) * 2 + (h)) * HTB)
#define PG8_STAGE(bufoff, gbase, voff) do { _Pragma("unroll") for (int _i = 0; _i < 2; ++_i) \
        __builtin_amdgcn_global_load_lds((const unsigned*)((const char*)(gbase) + (voff)[_i]), (PG8_LAS unsigned*)(lds + (bufoff) + ldsw + _i * 8192), 16, 0, 0); } while (0)
#define PG8_LDA(dst, b, h) do { _Pragma("unroll") for (int m = 0; m < 4; ++m) _Pragma("unroll") for (int k = 0; k < 2; ++k) dst[m][k] = *(const PG8_LAS bf16x8*)(lds + PG8_SA(b, h) + aoff + m * 2048 + k * 1024); } while (0)
#define PG8_LDB(dst, b, h) do { _Pragma("unroll") for (int n = 0; n < 2; ++n) _Pragma("unroll") for (int k = 0; k < 2; ++k) dst[n][k] = *(const PG8_LAS bf16x8*)(lds + PG8_SB(b, h) + boff + n * 2048 + k * 1024); } while (0)
#define PG8_MMA(ai, bj, At, Bt) do { __builtin_amdgcn_s_setprio(1); _Pragma("unroll") for (int m = 0; m < 4; ++m) _Pragma("unroll") for (int n = 0; n < 2; ++n) _Pragma("unroll") for (int k = 0; k < 2; ++k) \
        acc[ai][bj][m][n] = __builtin_amdgcn_mfma_f32_16x16x32_bf16(Bt[n][k], At[m][k], acc[ai][bj][m][n], 0, 0, 0); __builtin_amdgcn_s_setprio(0); } while (0)
#define PG8_WAIT_V(n) asm volatile("s_waitcnt vmcnt(" #n ")" ::: "memory")
#define PG8_WAIT_L(n) asm volatile("s_waitcnt lgkmcnt(" #n ")" ::: "memory")
#define PG8_BAR __builtin_amdgcn_s_barrier()
#define PG8_SCHED __builtin_amdgcn_sched_barrier(0)
    Unit cur, nxt; int ui = 0;
    if (!S.next(0, cur)) return;
    f32x4 acc[2][2][4][2];
#pragma unroll
    for (int a = 0; a < 2; ++a)
#pragma unroll
        for (int b = 0; b < 2; ++b)
#pragma unroll
            for (int m = 0; m < 4; ++m)
#pragma unroll
                for (int n = 0; n < 2; ++n) acc[a][b][m][n] = (f32x4){0.f, 0.f, 0.f, 0.f};
    bf16x8 At[4][2], B0[2][2], B1[2][2];
    const char* cA = (const char*)g.A + (size_t)cur.pm * tstep; const char* cB = (const char*)g.Bt + (size_t)cur.pn * tstep;
    PG8_STAGE(PG8_SB(0, 0), cB, voffB); PG8_STAGE(PG8_SA(0, 0), cA, voffA); PG8_STAGE(PG8_SB(0, 1), cB + hstep, voffB); PG8_STAGE(PG8_SA(0, 1), cA + hstep, voffA);
    if (wr == 1) PG8_BAR;
    PG8_WAIT_V(4); PG8_BAR;
    PG8_STAGE(PG8_SB(1, 0), cB + kstep, voffB); PG8_STAGE(PG8_SA(1, 0), cA + kstep, voffA); PG8_STAGE(PG8_SB(1, 1), cB + hstep + kstep, voffB);
    PG8_WAIT_V(6); PG8_BAR;
    for (;;) {
        const bool has_next = S.next(ui + 1, nxt);
        const char* nA = has_next ? (const char*)g.A + (size_t)nxt.pm * tstep : cA; const char* nB = has_next ? (const char*)g.Bt + (size_t)nxt.pn * tstep : cB;
        for (int t = 0; t < nt; t += 2) {
            const bool last = (t == nt - 2);
            const char* a1 = cA + (size_t)(t + 1) * kstep;
            const char* a2 = last ? nA : cA + (size_t)(t + 2) * kstep; const char* b2 = last ? nB : cB + (size_t)(t + 2) * kstep;
            const char* a3 = a2 + kstep; const char* b3 = b2 + kstep;
            PG8_LDB(B0, 0, 0); PG8_SCHED; PG8_LDA(At, 0, 0); PG8_STAGE(PG8_SA(1, 1), a1 + hstep, voffA);
            PG8_WAIT_L(8); PG8_BAR; PG8_WAIT_L(0); PG8_MMA(0, 0, At, B0); PG8_BAR; PG8_SCHED;
            PG8_LDB(B1, 0, 1); PG8_STAGE(PG8_SB(0, 0), b2, voffB);
            PG8_BAR; PG8_WAIT_L(0); PG8_MMA(0, 1, At, B1); PG8_BAR;
            PG8_LDA(At, 0, 1); PG8_STAGE(PG8_SA(0, 0), a2, voffA);
            PG8_BAR; PG8_WAIT_L(0); PG8_MMA(1, 0, At, B0); PG8_BAR; PG8_SCHED;
            PG8_STAGE(PG8_SB(0, 1), b2 + hstep, voffB);
            PG8_WAIT_V(6); PG8_BAR; PG8_MMA(1, 1, At, B1); PG8_BAR;
            PG8_LDB(B0, 1, 0); PG8_SCHED; PG8_LDA(At, 1, 0); PG8_STAGE(PG8_SA(0, 1), a2 + hstep, voffA);
            PG8_WAIT_L(8); PG8_BAR; PG8_WAIT_L(0); PG8_MMA(0, 0, At, B0); PG8_BAR; PG8_SCHED;
            PG8_LDB(B1, 1, 1); PG8_STAGE(PG8_SB(1, 0), b3, voffB);
            PG8_BAR; PG8_WAIT_L(0); PG8_MMA(0, 1, At, B1); PG8_BAR;
            PG8_LDA(At, 1, 1); PG8_STAGE(PG8_SA(1, 0), a3, voffA);
            PG8_BAR; PG8_WAIT_L(0); PG8_MMA(1, 0, At, B0); PG8_BAR; PG8_SCHED;
            PG8_STAGE(PG8_SB(1, 1), b3 + hstep, voffB);
            PG8_WAIT_V(6); PG8_BAR; PG8_MMA(1, 1, At, B1); PG8_BAR;
        }
        E(acc, cur, ui, wr, wc, fr, fq);
        if (!has_next) break;
#pragma unroll
        for (int a = 0; a < 2; ++a)
#pragma unroll
            for (int b = 0; b < 2; ++b)
#pragma unroll
                for (int m = 0; m < 4; ++m)
#pragma unroll
                    for (int n = 0; n < 2; ++n) acc[a][b][m][n] = (f32x4){0.f, 0.f, 0.f, 0.f};
        cur = nxt; cA = nA; cB = nB; ++ui;
    }
    PG8_WAIT_V(0);
    if (wr == 0) PG8_BAR;
    PG8_BAR;
#undef PG8_SA
#undef PG8_SB
#undef PG8_STAGE
#undef PG8_LDA
#undef PG8_LDB
#undef PG8_MMA
#undef PG8_WAIT_V
#undef PG8_WAIT_L
#undef PG8_BAR
#undef PG8_SCHED
}
}
typedef f32x4 acc_t[2][2][4][2];
#define ROWS_LOOP _Pragma("unroll") for (int ai = 0; ai < 2; ++ai) _Pragma("unroll") for (int m = 0; m < 4; ++m)
#define ROW_OF (u.pm * 256 + ai * 128 + wr * 64 + m * 16 + fr)

struct EpiIn {
    const Params& p; int l;
    __device__ __forceinline__ void operator()(const acc_t& acc, const pg8::Unit& u, int ui, int wr, int wc, int fr, int fq) const {
        const float* ssq = p.sumsq() + (size_t)(l & 1) * T * 16;
        const int pn = u.pn, cl = wc * 4 + fq;
        if (pn < 8) {
            ROWS_LOOP { const int row = ROW_OF; const float rs = row_rstd(ssq, row);
                float zz[4], gg[4];
#pragma unroll
                for (int ch = 0; ch < 4; ++ch) { const f32x4 v = acc[ai][ch >> 1][m][ch & 1]; zz[ch] = (v[1] * rs) * (v[2] * rs); gg[ch] = (v[0] * rs) * siluf(v[3] * rs); }
                const size_t o = (size_t)row * 512 + pn * 64 + cl * 4;
                u32x2 a; a[0] = cvtpk(zz[0], zz[1]); a[1] = cvtpk(zz[2], zz[3]); *(u32x2*)(p.z() + o) = a;
                u32x2 b; b[0] = cvtpk(gg[0], gg[1]); b[1] = cvtpk(gg[2], gg[3]); *(u32x2*)(p.ga() + o) = b; }
        } else if (pn < 12 || (pn >= 16 && pn <= 18)) {
            if (pn == 18 && wc >= 1) {
                if (wc == 1 && fq == 0) {
                    ROWS_LOOP { const int row = ROW_OF; const float rs = row_rstd(ssq, row) * 0.04419417382415922f;
                        *(f32x4*)(p.iw() + (size_t)row * 8) = acc[ai][0][m][0] * rs; *(f32x4*)(p.iw() + (size_t)row * 8 + 4) = acc[ai][0][m][1] * rs; }
                }
            } else {
                const bool isqk = pn < 12; const int which = (pn - 8) >> 1;
                int head; u16* dst; int pitch;
                if (isqk) { head = ((pn - 8) & 1) * 4 + wc; dst = which ? p.k() : p.q(); pitch = 512; }
                else if (pn < 18) { head = (pn - 16) * 4 + wc; dst = p.iq(); pitch = 512; }
                else { head = 0; dst = p.ik(); pitch = 64; }
                f32x4 g0[2], g1[2];
#pragma unroll
                for (int n = 0; n < 2; ++n) { g0[n] = (f32x4){1.f, 1.f, 1.f, 1.f}; g1[n] = g0[n]; }
                if (isqk) { const float* gg = (which ? p.k_g : p.q_g) + l * 64 + 8 * fq;
#pragma unroll
                    for (int n = 0; n < 2; ++n) { g0[n] = *(const f32x4*)(gg + 4 * n); g1[n] = *(const f32x4*)(gg + 32 + 4 * n); } }
                ROWS_LOOP { const int row = ROW_OF; const float rs = row_rstd(ssq, row);
                    f32x4 a0[2], a1[2];
#pragma unroll
                    for (int n = 0; n < 2; ++n) { a0[n] = acc[ai][0][m][n] * rs; a1[n] = acc[ai][1][m][n] * rs; }
                    if (isqk) { float ss = 0.f;
#pragma unroll
                        for (int n = 0; n < 2; ++n)
#pragma unroll
                            for (int j = 0; j < 4; ++j) ss += a0[n][j] * a0[n][j] + a1[n][j] * a1[n][j];
                        ss += __shfl_xor(ss, 16); ss += __shfl_xor(ss, 32);
                        const float rn = rsqrtf(ss * (1.f / 64.f) + RMS_EPS);
#pragma unroll
                        for (int n = 0; n < 2; ++n) { a0[n] = a0[n] * rn * g0[n]; a1[n] = a1[n] * rn * g1[n]; } }
                    const int pos = row & (SEQ - 1);
                    u32x4 o0, o1;
#pragma unroll
                    for (int n = 0; n < 2; ++n) { const f32x4 cc = *(const f32x4*)(p.ropec() + pos * 32 + 8 * fq + 4 * n), sn = *(const f32x4*)(p.ropes() + pos * 32 + 8 * fq + 4 * n);
                        const f32x4 r0 = a0[n] * cc - a1[n] * sn, r1 = a1[n] * cc + a0[n] * sn;
                        o0[2 * n] = cvtpk(r0[0], r0[1]); o0[2 * n + 1] = cvtpk(r0[2], r0[3]); o1[2 * n] = cvtpk(r1[0], r1[1]); o1[2 * n + 1] = cvtpk(r1[2], r1[3]); }
                    u16* d = dst + (size_t)row * pitch + head * 64 + 8 * fq;
                    *(u32x4*)d = o0; *(u32x4*)(d + 32) = o1; }
            }
        } else {
            u16* dst; int cb; int kind;
            if (pn < 14) { dst = p.v(); cb = (pn - 12) * 256; kind = 0; }
            else if (pn < 16) { dst = p.sg(); cb = (pn - 14) * 256; kind = 1; }
            else if (pn < 21) { dst = p.u(); cb = (pn - 19) * 256; kind = 0; }
            else { dst = p.sp(); cb = (pn - 21) * 256; kind = 2; }
            f32x4 sc[2][2];
#pragma unroll
            for (int bj = 0; bj < 2; ++bj)
#pragma unroll
                for (int n = 0; n < 2; ++n) sc[bj][n] = (kind == 2) ? *(const f32x4*)(p.pool_scale + l * 512 + cb + 16 * cl + bj * 8 + n * 4) : (f32x4){1.f, 1.f, 1.f, 1.f};
            ROWS_LOOP { const int row = ROW_OF; const float rs = row_rstd(ssq, row);
#pragma unroll
                for (int bj = 0; bj < 2; ++bj) { f32x4 v0 = acc[ai][bj][m][0] * rs, v1 = acc[ai][bj][m][1] * rs;
                    if (kind >= 1) {
#pragma unroll
                        for (int j = 0; j < 4; ++j) { v0[j] = siluf(v0[j]) * sc[bj][0][j]; v1[j] = siluf(v1[j]) * sc[bj][1][j]; } }
                    u32x4 w; w[0] = cvtpk(v0[0], v0[1]); w[1] = cvtpk(v0[2], v0[3]); w[2] = cvtpk(v1[0], v1[1]); w[3] = cvtpk(v1[2], v1[3]);
                    *(u32x4*)(dst + (size_t)row * 512 + cb + 16 * cl + bj * 8) = w; } }
        }
    }
};
__device__ __forceinline__ void phase_in(const Params& p, int l, char* shm) {
    pg8::Gemm g{p.xb(), p.wt_in() + (size_t)l * NPA * 1024, T, NPA, 1024};
    pg8::StaticOrder S; S.init(T, NPA, GDIM(), BID());
    EpiIn E{p, l};
    pg8::gemm_phase((PG8_LAS unsigned char*)shm, g, S, E);
}
__device__ __forceinline__ void phase_mix(const Params& p, int l) {
    const float* cw = p.conv_w + l * 3 * 512;
    const int nitem = (T / 32) * 256;
    const int it0 = BID() * NTHR + TID(), itstep = GDIM() * NTHR;
    for (int it = it0; it < nitem; it += itstep) {
        const int cp = it & 255, c = cp * 2, t0 = (it >> 8) * 32, pos0 = t0 & (SEQ - 1);
        {
            const float w00 = cw[c], w01 = cw[c + 1], w10 = cw[512 + c], w11 = cw[513 + c], w20 = cw[1024 + c], w21 = cw[1025 + c];
            float a0 = 0.f, a1 = 0.f, b0 = 0.f, b1 = 0.f;
            if (pos0 >= 2) { unsigned w = *(const unsigned*)(p.z() + (size_t)(t0 - 2) * 512 + c); a0 = bflo(w); a1 = bfhi(w);
                             w = *(const unsigned*)(p.z() + (size_t)(t0 - 1) * 512 + c); b0 = bflo(w); b1 = bfhi(w); }
            for (int i = 0; i < 32; ++i) {
                const size_t o = (size_t)(t0 + i) * 512 + c;
                unsigned w = *(const unsigned*)(p.z() + o); float z0 = bflo(w), z1 = bfhi(w);
                unsigned gw = *(const unsigned*)(p.ga() + o);
                float y0 = (w00 * a0 + w10 * b0 + w20 * z0) * bflo(gw), y1 = (w01 * a1 + w11 * b1 + w21 * z1) * bfhi(gw);
                *(unsigned*)(p.ga() + o) = cvtpk(y0, y1);
                a0 = b0; a1 = b1; b0 = z0; b1 = z1;
            }
        }
        {
            const int win = 2 << (c >> 7);
            float s0 = 0.f, s1 = 0.f;
            for (int j = 1; j < win; ++j) if (pos0 - j >= 0) { unsigned w = *(const unsigned*)(p.u() + (size_t)(t0 - j) * 512 + c); s0 += bflo(w); s1 += bfhi(w); }
            for (int i = 0; i < 32; ++i) {
                const int pos = pos0 + i; const size_t o = (size_t)(t0 + i) * 512 + c;
                unsigned w = *(const unsigned*)(p.u() + o); float u0 = bflo(w), u1 = bfhi(w);
                s0 += u0; s1 += u1;
                const float ic = 1.f / (float)min(pos + 1, win);
                unsigned gw = *(const unsigned*)(p.sp() + o);
                *(unsigned*)(p.sp() + o) = cvtpk((s0 * ic - u0) * bflo(gw), (s1 * ic - u1) * bfhi(gw));
                if (pos - win + 1 >= 0) { unsigned wo = *(const unsigned*)(p.u() + (size_t)(t0 + i - win + 1) * 512 + c); s0 -= bflo(wo); s1 -= bfhi(wo); }
            }
        }
    }
}

__device__ __forceinline__ int crow(int r, int hi) { return (r & 3) + 8 * (r >> 2) + 4 * hi; }
__device__ __forceinline__ size_t sc_base(int qb) { return (size_t)32768 * qb * (qb + 1); }
__device__ __forceinline__ void phase_indexer(const Params& p, int b) {
    const int tid_ = TID(); const int wid = tid_ >> 6, lane = tid_ & 63, ql = lane & 15, fq = lane >> 4; const int bid_ = BID(), gdim_ = GDIM();
    const int nunit = 1056;
    for (int u = bid_; u < nunit; u += gdim_) {
        const int sh = u & 1, v = u >> 1;
        int a = (int)((sqrtf(8.f * v + 1.f) - 1.f) * 0.5f);
        while ((a + 1) * (a + 2) / 2 <= v) ++a;
        while (a * (a + 1) / 2 > v) --a;
        const int ch = v - a * (a + 1) / 2;
        const int qb128 = 2 * a + sh, ntl = 2 * (qb128 + 1);
        const int qloc = qb128 * 128 + wid * 16 + ql;
        const size_t row = (size_t)b * SEQ + qloc;
        bf16x8 bq[8][2];
#pragma unroll
        for (int h = 0; h < 8; ++h)
#pragma unroll
            for (int kc = 0; kc < 2; ++kc) bq[h][kc] = *(const bf16x8*)(p.iq() + row * 512 + h * 64 + kc * 32 + fq * 8);
        float wv[8];
        { f32x4 x = *(const f32x4*)(p.iw() + row * 8), y = *(const f32x4*)(p.iw() + row * 8 + 4);
          wv[0] = x[0]; wv[1] = x[1]; wv[2] = x[2]; wv[3] = x[3]; wv[4] = y[0]; wv[5] = y[1]; wv[6] = y[2]; wv[7] = y[3]; }
        u16* srow = p.scores() + sc_base(a) + (size_t)(qloc - a * 256) * (256 * (a + 1));
        const int tend = min(ch * 4 + 4, ntl);
        for (int tt = ch * 4; tt < tend; ++tt) {
            const int key0 = tt * 64;
            bf16x8 ka[4][2];
#pragma unroll
            for (int kg = 0; kg < 4; ++kg)
#pragma unroll
                for (int kc = 0; kc < 2; ++kc) ka[kg][kc] = *(const bf16x8*)(p.ik() + ((size_t)b * SEQ + key0 + kg * 16 + ql) * 64 + kc * 32 + fq * 8);
            const bool band = (key0 + 63 > qb128 * 128 + wid * 16);
#pragma unroll
            for (int kg = 0; kg < 4; ++kg) {
                f32x4 sacc = (f32x4){0.f, 0.f, 0.f, 0.f};
#pragma unroll
                for (int h = 0; h < 8; ++h) {
                    f32x4 c = (f32x4){0.f, 0.f, 0.f, 0.f};
                    c = __builtin_amdgcn_mfma_f32_16x16x32_bf16(ka[kg][0], bq[h][0], c, 0, 0, 0);
                    c = __builtin_amdgcn_mfma_f32_16x16x32_bf16(ka[kg][1], bq[h][1], c, 0, 0, 0);
#pragma unroll
                    for (int j = 0; j < 4; ++j) sacc[j] = __builtin_fmaf(wv[h], __builtin_fmaxf(c[j], 0.f), sacc[j]);
                }
                const int kb = key0 + kg * 16 + fq * 4;
                if (band) {
#pragma unroll
                    for (int j = 0; j < 4; ++j) if (kb + j > qloc) sacc[j] = -INFINITY;
                }
                union { _Float16 h[4]; u32x2 v; } pk;
                pk.h[0] = (_Float16)sacc[0]; pk.h[1] = (_Float16)sacc[1]; pk.h[2] = (_Float16)sacc[2]; pk.h[3] = (_Float16)sacc[3];
                *(u32x2*)(srow + kb) = pk.v;
            }
        }
    }
}

__device__ __forceinline__ size_t mk_base(int qb) { return (size_t)512 * qb * (qb + 1); }
constexpr size_t MASK_WORDS_PER_BATCH = 540672;
__device__ __forceinline__ unsigned f16key(unsigned h) { return (h & 0x8000u) ? (~h & 0xffffu) : (h | 0x8000u); }
__device__ __forceinline__ void hist_scan(const unsigned* h, int lane, unsigned target, int& bin, unsigned& above) {
    const u32x4 a = *(const u32x4*)(h + 4 * lane), b = *(const u32x4*)(h + 256 + 4 * lane), c = *(const u32x4*)(h + 512 + 4 * lane), d = *(const u32x4*)(h + 768 + 4 * lane);
    const unsigned h0 = a[0] + b[0] + c[0] + d[0], h1 = a[1] + b[1] + c[1] + d[1], h2 = a[2] + b[2] + c[2] + d[2], h3 = a[3] + b[3] + c[3] + d[3];
    const unsigned tot = h0 + h1 + h2 + h3;
    unsigned x = tot;
#pragma unroll
    for (int dd = 1; dd < 64; dd <<= 1) { const unsigned y = __shfl_down(x, dd); if (lane + dd < 64) x += y; }
    const unsigned ab = x - tot, c3 = ab + h3, c2 = c3 + h2, c1 = c2 + h1, c0 = c1 + h0;
    int fb = -1; unsigned fa = 0;
    if (ab < target && c3 >= target) { fb = 4 * lane + 3; fa = ab; }
    else if (c3 < target && c2 >= target) { fb = 4 * lane + 2; fa = c3; }
    else if (c2 < target && c1 >= target) { fb = 4 * lane + 1; fa = c2; }
    else if (c1 < target && c0 >= target) { fb = 4 * lane; fa = c1; }
    const u64 m = __ballot(fb >= 0); const int src = (m == 0) ? 0 : (__ffsll((unsigned long long)m) - 1);
    bin = __shfl(fb, src); above = __shfl(fa, src);
}
__device__ __forceinline__ void phase_select(const Params& p, int b, char* shm) {
    const int tid_ = TID(); const int wid = __builtin_amdgcn_readfirstlane(tid_ >> 6), lane = tid_ & 63;
    const int gw = BID() * 8 + wid, nw = GDIM() * 8;
    unsigned* hist = (unsigned*)shm + wid * 1024;
    unsigned* hsub = hist + (lane >> 4) * 256;
    for (int i = gw; i < SEQ; i += nw) {
        const int kq = i / nw;
        const int t = (kq & 1) ? (kq * nw + (nw - 1 - (i - kq * nw))) : i;
        if (t >= SEQ) continue;
        const int qb = t >> 8, ntile = 4 * (qb + 1), ntr = 2 * ((t >> 7) + 1);
        const u16* srow = p.scores() + sc_base(qb) + (size_t)(t - qb * 256) * (256 * (qb + 1));
        u64* mrow = p.mask() + (size_t)b * MASK_WORDS_PER_BATCH + mk_base(qb) + (size_t)(t - qb * 256) * ntile;
        unsigned key[64];
#pragma unroll
        for (int g4 = 0; g4 < 32; ++g4) {
            if (g4 * 4 < ntr) {
#pragma unroll
                for (int q = 0; q < 2; ++q) { const int jj = g4 * 2 + q;
                    unsigned lo = 0u, hi = 0u;
                    if (2 * jj < ntr) { lo = f16key(srow[(2 * jj) * 64 + lane]); hi = f16key(srow[(2 * jj + 1) * 64 + lane]); }
                    key[jj] = lo | (hi << 16); }
            } else { key[g4 * 2] = 0u; key[g4 * 2 + 1] = 0u; }
        }
        unsigned thr = 0x03ffu; int need = 0;
        if (t >= 256) {
            const u32x4 z4 = (u32x4){0u, 0u, 0u, 0u};
#pragma unroll
            for (int c = 0; c < 4; ++c) *(u32x4*)(hist + c * 256 + 4 * lane) = z4;
#pragma unroll
            for (int g4 = 0; g4 < 32; ++g4) {
                if (g4 * 4 < ntr) {
#pragma unroll
                    for (int q = 0; q < 2; ++q) { const int jj = g4 * 2 + q;
                        if (2 * jj < ntr) { const unsigned kk = key[jj]; atomicAdd(hsub + ((kk >> 8) & 255u), 1u); atomicAdd(hsub + (kk >> 24), 1u); } }
                }
            }
            asm volatile("s_waitcnt lgkmcnt(0)" ::: "memory");
            int B1; unsigned ab1;
            hist_scan(hist, lane, 256u, B1, ab1);
            asm volatile("s_waitcnt lgkmcnt(0)" ::: "memory");
#pragma unroll
            for (int c = 0; c < 4; ++c) *(u32x4*)(hist + c * 256 + 4 * lane) = z4;
#pragma unroll
            for (int g4 = 0; g4 < 32; ++g4) {
                if (g4 * 4 < ntr) {
#pragma unroll
                    for (int q = 0; q < 2; ++q) { const int jj = g4 * 2 + q;
                        if (2 * jj < ntr) { const unsigned kk = key[jj];
                            if (((kk >> 8) & 255u) == (unsigned)B1) atomicAdd(hsub + (kk & 255u), 1u);
                            if ((kk >> 24) == (unsigned)B1) atomicAdd(hsub + ((kk >> 16) & 255u), 1u); } }
                }
            }
            asm volatile("s_waitcnt lgkmcnt(0)" ::: "memory");
            int B2; unsigned ab2;
            hist_scan(hist, lane, 256u - ab1, B2, ab2);
            asm volatile("s_waitcnt lgkmcnt(0)" ::: "memory");
            thr = ((unsigned)B1 << 8) | (unsigned)B2;
            need = 256 - (int)(ab1 + ab2);
            thr = __builtin_amdgcn_readfirstlane(thr); need = __builtin_amdgcn_readfirstlane(need);
        }
        u64 w0 = 0, w1 = 0;
#pragma unroll
        for (int g4 = 0; g4 < 32; ++g4) {
            if (g4 * 4 < ntr) {
#pragma unroll
                for (int q = 0; q < 4; ++q) {
                    const int j = g4 * 4 + q; const unsigned kk = key[j >> 1]; const unsigned kv = (j & 1) ? (kk >> 16) : (kk & 0xffffu);
                    u64 gt = __ballot(kv > thr);
                    if (need > 0) {
                        u64 eq = __ballot(kv == thr);
                        int ne = __builtin_popcountll(eq);
                        if (ne <= need) { gt |= eq; need -= ne; }
                        else { while (need > 0) { u64 bb = eq & (~eq + 1); gt |= bb; eq ^= bb; --need; } }
                    }
                    if (lane == (j & 63)) { if (j < 64) w0 = gt; else w1 = gt; }
                }
            }
        }
        if (lane < ntile) mrow[lane] = w0;
        if (lane + 64 < ntile) mrow[lane + 64] = w1;
    }
}

constexpr int A_D = 64, A_DM = 512, A_NW = 8, A_QBLK = 32, A_QB = 256, A_KVBLK = 64, A_NQB = SEQ / A_QB, A_NHEAD = 8;
constexpr float A_C2 = 0.125f * 1.4426950408889634f;
constexpr int A_SLOTB = 8192, A_LDS_K = 0, A_LDS_V = 3 * A_SLOTB, A_LDS_WS = 6 * A_SLOTB, A_LDS_OST = A_LDS_WS + A_NW * 256, A_LDS_MK = A_LDS_OST + A_NW * 4096, A_LDS_BYTES = A_LDS_MK + A_NW * 2048;
#define ATTN_THR 8
#define SBAR() __builtin_amdgcn_sched_barrier(0)
#define PIN(x) asm volatile("" : "+v"(x))
#define MFMA32(a, b, c) __builtin_amdgcn_mfma_f32_32x32x16_bf16(a, b, c, 0, 0, 0)
#define WAIT_BAR(N) asm volatile("s_waitcnt vmcnt(" #N ") lgkmcnt(0)\n\ts_barrier" ::: "memory")
__device__ __forceinline__ void glds16s(const void* sbase, unsigned voff, unsigned lds_base) {
    unsigned sv; asm volatile("s_mov_b32 %0, m0\n\ts_mov_b32 m0, %3\n\ts_nop 0\n\tglobal_load_lds_dwordx4 %1, %2\n\ts_mov_b32 m0, %0" : "=&s"(sv) : "v"(voff), "s"(sbase), "s"(lds_base) : "memory"); }
typedef __attribute__((address_space(3))) const char* lds_cptr;
typedef short v4i16_t __attribute__((ext_vector_type(4)));
__device__ __forceinline__ void kload2(bf16x8* kf, lds_cptr kp, int d0) { kf[2 * d0] = *(const __attribute__((address_space(3))) bf16x8*)(kp + d0 * 2048); kf[2 * d0 + 1] = *(const __attribute__((address_space(3))) bf16x8*)(kp + d0 * 2048 + 512); }
__device__ __forceinline__ s16x4 vtr(lds_cptr p) { return __builtin_bit_cast(s16x4, __builtin_amdgcn_ds_read_tr16_b64_v4i16((__attribute__((address_space(3))) v4i16_t*)p)); }
#define MX3(a, b, c) __builtin_fmaxf(__builtin_fmaxf((a), (b)), (c))
__device__ __forceinline__ float rowmax(const f32x16& p0, const f32x16& p1) {
    float a = MX3(p0[0], p0[1], p1[0]), b = MX3(p0[2], p0[3], p1[1]); a = MX3(a, p1[2], p1[3]);
#pragma unroll
    for (int r = 4; r < 16; r += 4) { a = MX3(a, p0[r], p0[r + 1]); b = MX3(b, p0[r + 2], p0[r + 3]); a = MX3(a, p1[r], p1[r + 1]); b = MX3(b, p1[r + 2], p1[r + 3]); }
    float m = __builtin_fmaxf(a, b); auto rr = __builtin_amdgcn_permlane32_swap(__float_as_uint(m), __float_as_uint(m), false, false);
    return __builtin_fmaxf(__uint_as_float(rr[0]), __uint_as_float(rr[1])); }
__device__ __forceinline__ void cmask(f32x16& p0, f32x16& p1, int jb, int qrel, int hi) {
    const int kb = 64 * jb + 4 * hi;
#pragma unroll
    for (int r = 0; r < 16; ++r) { const int kv = kb + (r & 3) + 8 * (r >> 2); if (kv > qrel) p0[r] = -INFINITY; if (kv + 32 > qrel) p1[r] = -INFINITY; } }
__device__ __forceinline__ float mand(float x, unsigned w, int pos) { return __uint_as_float(__float_as_uint(x) & (unsigned)__builtin_amdgcn_sbfe((int)w, pos, 1)); }
#define BITP(i) (((i) & 3) + 8 * ((i) >> 2))

__device__ __forceinline__ void attn64_unit(int b, int h, int qb, const u16* Q, const u16* __restrict__ K, const u16* __restrict__ V, const u16* __restrict__ SG, u16* O, const u64* mrow0, char* lds) {
    const int tid = TID(), lane = tid & 63, r32 = lane & 31, hi = lane >> 5; const int wid = __builtin_amdgcn_readfirstlane(tid >> 6);
    const long rowbase = (long)b * SEQ; const int q0 = qb * A_QB, NT = (q0 + A_QB) / A_KVBLK;
    const u16* Qw = Q + (rowbase + q0 + wid * A_QBLK) * A_DM + h * A_D;
    const unsigned lds0 = (unsigned)(uintptr_t)lds; float* wsf = (float*)(lds + A_LDS_WS) + wid * 64;
    const u16* kbase = K + rowbase * A_DM + h * A_D; const u16* vbase = V + rowbase * A_DM + h * A_D;
    const unsigned koff = (unsigned)(lane * A_DM + wid * 8) * 2u;
    const unsigned voff = (unsigned)((16 * (wid & 3) + (lane >> 2)) * A_DM + (wid >> 2) * 32 + (lane & 3) * 8) * 2u;
    const unsigned kdst = lds0 + A_LDS_K + wid * 1024, vdst = lds0 + A_LDS_V + wid * 1024;
#define DMA_K(t, slot) glds16s(kbase + (long)(t) * A_KVBLK * A_DM, koff, (unsigned)__builtin_amdgcn_readfirstlane(kdst + (slot)))
#define DMA_V(t, slot) glds16s(vbase + (long)(t) * A_KVBLK * A_DM, voff, (unsigned)__builtin_amdgcn_readfirstlane(vdst + (slot)))
#define DMA_M(chunk) glds16s(mrow0 + 2 * (chunk), moff, (unsigned)__builtin_amdgcn_readfirstlane(mdst + ((chunk) & 1) * 1024))
#define MWORD(t) (*(const u64*)(lds + A_LDS_MK + wid * 2048 + (((t) >> 1) & 1) * 1024 + r32 * 16 + ((t) & 1) * 8))
    const lds_cptr vp0 = (lds_cptr)lds + A_LDS_V + ((lane >> 4) & 1) * 32 + (lane & 3) * 8 + (4 * hi + ((lane & 15) >> 2)) * 64;
    const lds_cptr kp0 = (lds_cptr)lds + A_LDS_K + hi * 1024 + r32 * 16;
    const int qrel = wid * A_QBLK + r32;
    const unsigned moff = (unsigned)(qrel * NT) * 8u;
    const unsigned mdst = lds0 + A_LDS_MK + wid * 2048;
    DMA_M(0);
    DMA_K(0, 0); DMA_V(0, 0); DMA_K(1, A_SLOTB);
    bf16x8 qr[4];
#pragma unroll
    for (int d0 = 0; d0 < 4; ++d0) qr[d0] = *reinterpret_cast<const bf16x8*>(&Qw[(long)r32 * A_DM + d0 * 16 + hi * 8]);
    float mhat = 0.f, l_reg = 0.f; f32x16 o[2]; o[0] = f32x16{}; o[1] = f32x16{};
    const f32x16 zero16 = f32x16{};
    bool resc = false;
    f32x16 pA0, pA1, pB0, pB1; bf16x8 kf[8]; s16x4 vlo[8], vhi[8]; u32x4 pw0, pw1, pw2, pw3;
    int sl_prev = 0, sl_cur = 0, sl_next = A_SLOTB;
    const int sh4 = 4 * hi;
#define ROT() do { sl_prev = sl_cur; sl_cur = sl_next; sl_next = (sl_next == 2 * A_SLOTB) ? 0 : sl_next + A_SLOTB; } while (0)
#define EX(v) __builtin_amdgcn_exp2f(__builtin_fmaf((v), A_C2, nmh))
#define RESC() do { if (resc) { _Pragma("unroll") for (int d_ = 0; d_ < 2; ++d_) _Pragma("unroll") for (int r = 0; r < 16; ++r) o[d_][r] *= wsf[crow(r, hi)]; } } while (0)
    DMA_K(2, 2 * A_SLOTB);
    WAIT_BAR(3);
    _Pragma("unroll") for (int d0 = 0; d0 < 4; ++d0) kload2(kf, kp0, d0);
    pA0 = MFMA32(kf[0], qr[0], zero16); pA1 = MFMA32(kf[1], qr[0], zero16); pA0 = MFMA32(kf[2], qr[1], pA0); pA1 = MFMA32(kf[3], qr[1], pA1);
    pA0 = MFMA32(kf[4], qr[2], pA0); pA1 = MFMA32(kf[5], qr[2], pA1); pA0 = MFMA32(kf[6], qr[3], pA0); pA1 = MFMA32(kf[7], qr[3], pA1);
    { const float rm = rowmax(pA0, pA1); mhat = rm * A_C2; const float nmh = -mhat;
      const u64 mw0 = MWORD(0); const unsigned wl = (unsigned)mw0 >> sh4, wh = (unsigned)(mw0 >> 32) >> sh4;
#pragma unroll
      for (int r = 0; r < 16; ++r) { pA0[r] = mand(EX(pA0[r]), wl, BITP(r)); pA1[r] = mand(EX(pA1[r]), wh, BITP(r)); } }
    WAIT_BAR(0);
    DMA_K(3, 0); DMA_V(1, A_SLOTB); ROT();
    _Pragma("unroll") for (int d0 = 0; d0 < 4; ++d0) kload2(kf, kp0 + sl_cur, d0);
    WAIT_BAR(2);
#define PKW(P, i) cvtpk(P[i], P[i + 1])
#define PAF(k) __builtin_bit_cast(bf16x8, pw##k)
#define VFR(i) (bf16x8){vlo[i][0], vlo[i][1], vlo[i][2], vlo[i][3], vhi[i][0], vhi[i][1], vhi[i][2], vhi[i][3]}
#define VRD(i) do { vlo[i] = vtr(vp_ + (((i) >> 2) * 4096 + ((i) & 3) * 1024)); vhi[i] = vtr(vp_ + (((i) >> 2) * 4096 + ((i) & 3) * 1024 + 512)); } while (0)
#define KRD(G, d0) do { if (G) { kload2(kf, kp0 + sl_next, d0); SBAR(); } } while (0)
#define GAPA(MF, a0, a1, a2, a3, W0, W1, PW) do { MF; sacc += a0; sacc += a1; sacc += a2; sacc += a3; W0; W1; PIN(PW); PIN(sacc); SBAR(); } while (0)
#define GAPB(MF, X, i, W) do { MF; X[i] = mand(EX(X[i]), W, BITP(i)); X[i + 1] = mand(EX(X[i + 1]), W, BITP(i + 1)); X[i + 2] = mand(EX(X[i + 2]), W, BITP(i + 2)); X[i + 3] = mand(EX(X[i + 3]), W, BITP(i + 3)); PIN(X); SBAR(); } while (0)
#define STEP(C0, C1, P0, P1, t, MASK, GK, GV, GL, ML) do { SBAR(); \
    if (ML) DMA_M(((t) + 1) >> 1); \
    const u64 mw_ = MWORD(t); \
    const lds_cptr vp_ = vp0 + sl_prev; \
    VRD(0); SBAR(); float sacc = P0[0] + P0[1]; \
                    GAPA(C0 = MFMA32(kf[0], qr[0], zero16), P0[2], P0[3], P0[4], P0[5],     pw0[0] = PKW(P0, 0),  pw0[1] = PKW(P0, 2),  pw0); \
    VRD(4); SBAR(); GAPA(C1 = MFMA32(kf[1], qr[0], zero16), P0[6], P0[7], P0[8], P0[9],     pw0[2] = PKW(P0, 4),  pw0[3] = PKW(P0, 6),  pw0); \
    VRD(1); SBAR(); GAPA(C0 = MFMA32(kf[2], qr[1], C0),    P0[10], P0[11], P0[12], P0[13], pw1[0] = PKW(P0, 8),  pw1[1] = PKW(P0, 10), pw1); \
    VRD(5); SBAR(); GAPA(C1 = MFMA32(kf[3], qr[1], C1),    P0[14], P0[15], P1[0], P1[1],   pw1[2] = PKW(P0, 12), pw1[3] = PKW(P0, 14), pw1); \
    VRD(2); SBAR(); GAPA(C0 = MFMA32(kf[4], qr[2], C0),    P1[2], P1[3], P1[4], P1[5],     pw2[0] = PKW(P1, 0),  pw2[1] = PKW(P1, 2),  pw2); \
    VRD(6); SBAR(); GAPA(C1 = MFMA32(kf[5], qr[2], C1),    P1[6], P1[7], P1[8], P1[9],     pw2[2] = PKW(P1, 4),  pw2[3] = PKW(P1, 6),  pw2); \
    VRD(3); SBAR(); GAPA(C0 = MFMA32(kf[6], qr[3], C0),    P1[10], P1[11], P1[12], P1[13], pw3[0] = PKW(P1, 8),  pw3[1] = PKW(P1, 10), pw3); \
    VRD(7); SBAR(); GAPA(C1 = MFMA32(kf[7], qr[3], C1),    P1[14], P1[15], 0.f, 0.f,       pw3[2] = PKW(P1, 12), pw3[3] = PKW(P1, 14), pw3); \
    l_reg += sacc; \
    if (GK) DMA_K((t) + 3, sl_cur); if (GV) DMA_V((t) + 1, sl_next); \
    { const float rm = __builtin_fmaf(rowmax(C0, C1), A_C2, -mhat); resc = false; \
      if (__builtin_expect(__any(rm > (float)ATTN_THR), 0)) { const float dl = __builtin_fmaxf(rm, 0.f); mhat += dl; \
          const float f = __builtin_amdgcn_exp2f(-dl); l_reg *= f; if (hi == 0) wsf[r32] = f; resc = true; } } \
    const float nmh = -mhat; const unsigned wl_ = (unsigned)(mw_) >> sh4, wh_ = (unsigned)((mw_) >> 32) >> sh4; SBAR(); \
    GAPB(o[0] = MFMA32(PAF(0), VFR(0), o[0]), C0, 0, wl_);              GAPB(o[1] = MFMA32(PAF(0), VFR(4), o[1]), C0, 4, wl_); \
    KRD(GL, 0); GAPB(o[0] = MFMA32(PAF(1), VFR(1), o[0]), C0, 8, wl_);  KRD(GL, 1); GAPB(o[1] = MFMA32(PAF(1), VFR(5), o[1]), C0, 12, wl_); \
    KRD(GL, 2); GAPB(o[0] = MFMA32(PAF(2), VFR(2), o[0]), C1, 0, wh_);  KRD(GL, 3); GAPB(o[1] = MFMA32(PAF(2), VFR(6), o[1]), C1, 4, wh_); \
    GAPB(o[0] = MFMA32(PAF(3), VFR(3), o[0]), C1, 8, wh_);              GAPB(o[1] = MFMA32(PAF(3), VFR(7), o[1]), C1, 12, wh_); \
    } while (0)
    int t = 1;
    for (; t + 5 < NT; t += 2) {
        STEP(pB0, pB1, pA0, pA1, t, false, true, true, true, true);      WAIT_BAR(2); RESC(); ROT();
        STEP(pA0, pA1, pB0, pB1, t + 1, false, true, true, true, false); WAIT_BAR(2); RESC(); ROT();
    }
#define ENDW(tt) do { if ((tt) + 3 < NT) { WAIT_BAR(2); } else if ((tt) + 2 < NT) { WAIT_BAR(1); } else { WAIT_BAR(0); } } while (0)
    for (; t + 1 < NT; t += 2) {
        STEP(pB0, pB1, pA0, pA1, t, true, (t + 3 < NT), (t + 1 < NT), (t + 1 < NT), (t + 1 < NT));         ENDW(t);     RESC(); ROT();
        STEP(pA0, pA1, pB0, pB1, t + 1, true, (t + 4 < NT), (t + 2 < NT), (t + 2 < NT), false);            ENDW(t + 1); RESC(); ROT();
    }
    STEP(pB0, pB1, pA0, pA1, NT - 1, true, false, false, false, false); RESC();
    { float sacc = pB0[0] + pB0[1];
#pragma unroll
      for (int r = 2; r < 16; ++r) sacc += pB0[r];
#pragma unroll
      for (int r = 0; r < 16; ++r) sacc += pB1[r];
      l_reg += sacc;
      pw0 = (u32x4){PKW(pB0, 0), PKW(pB0, 2), PKW(pB0, 4), PKW(pB0, 6)}; pw1 = (u32x4){PKW(pB0, 8), PKW(pB0, 10), PKW(pB0, 12), PKW(pB0, 14)};
      pw2 = (u32x4){PKW(pB1, 0), PKW(pB1, 2), PKW(pB1, 4), PKW(pB1, 6)}; pw3 = (u32x4){PKW(pB1, 8), PKW(pB1, 10), PKW(pB1, 12), PKW(pB1, 14)};
      const lds_cptr vp_ = vp0 + sl_cur; _Pragma("unroll") for (int i = 0; i < 8; ++i) VRD(i);
      o[0] = MFMA32(PAF(0), VFR(0), o[0]); o[1] = MFMA32(PAF(0), VFR(4), o[1]); o[0] = MFMA32(PAF(1), VFR(1), o[0]); o[1] = MFMA32(PAF(1), VFR(5), o[1]);
      o[0] = MFMA32(PAF(2), VFR(2), o[0]); o[1] = MFMA32(PAF(2), VFR(6), o[1]); o[0] = MFMA32(PAF(3), VFR(3), o[0]); o[1] = MFMA32(PAF(3), VFR(7), o[1]); }
    { auto rr = __builtin_amdgcn_permlane32_swap(__float_as_uint(l_reg), __float_as_uint(l_reg), false, false); l_reg = __uint_as_float(rr[0]) + __uint_as_float(rr[1]); }
    if (hi == 0) wsf[32 + r32] = l_reg; asm volatile("s_waitcnt lgkmcnt(0)" ::: "memory");
    float rli[16];
#pragma unroll
    for (int r = 0; r < 16; ++r) rli[r] = __builtin_amdgcn_rcpf(wsf[32 + crow(r, hi)]);
    u16* Ow = O + (rowbase + q0 + wid * A_QBLK) * A_DM + h * A_D; const u16* Gw = SG + (rowbase + q0 + wid * A_QBLK) * A_DM + h * A_D;
    u16* stg = (u16*)(lds + A_LDS_OST) + wid * 2048;
#pragma unroll
    for (int r = 0; r < 16; ++r) { const int orow = crow(r, hi);
#pragma unroll
        for (int d0 = 0; d0 < 2; ++d0) stg[orow * 64 + d0 * 32 + r32] = f2bf(o[d0][r] * rli[r]); }
    asm volatile("s_waitcnt lgkmcnt(0)" ::: "memory");
#pragma unroll
    for (int i = 0; i < 4; ++i) { const int row = i * 8 + (lane >> 3), ch = lane & 7;
        u32x4 ov = *(const u32x4*)(stg + row * 64 + ch * 8); u32x4 gv = *(const u32x4*)(Gw + (long)row * A_DM + ch * 8); u32x4 rv;
#pragma unroll
        for (int e = 0; e < 4; ++e) rv[e] = cvtpk(bflo(ov[e]) * bflo(gv[e]), bfhi(ov[e]) * bfhi(gv[e]));
        *(u32x4*)(Ow + (long)row * A_DM + ch * 8) = rv; }
    asm volatile("s_waitcnt vmcnt(0) lgkmcnt(0)\n\ts_barrier" ::: "memory");
#undef DMA_K
#undef DMA_V
#undef DMA_M
#undef MWORD
#undef ROT
#undef EX
#undef RESC
#undef PKW
#undef PAF
#undef VFR
#undef VRD
#undef KRD
#undef ENDW
#undef GAPA
#undef GAPB
#undef STEP
}
__device__ __forceinline__ void phase_attn(const Params& p, char* lds) {
    constexpr int NPAIR = A_NQB / 2, NUNIT = NBATCH * A_NHEAD * NPAIR;
    const int bid_ = BID(), gdim_ = GDIM();
    for (int u = bid_; u < NUNIT; u += gdim_) {
        const int x = u & 7, kk = u >> 3, bh = x + 8 * (kk / NPAIR), j = kk % NPAIR;
        const int b = bh / A_NHEAD, h = bh % A_NHEAD;
        const u64* mb = p.mask() + (size_t)b * MASK_WORDS_PER_BATCH;
        attn64_unit(b, h, j, p.q(), p.k(), p.v(), p.sg(), p.bin(), mb + mk_base(j), lds);
        attn64_unit(b, h, A_NQB - 1 - j, p.q(), p.k(), p.v(), p.sg(), p.bin(), mb + mk_base(A_NQB - 1 - j), lds);
    }
}

struct EpiStash {
    u16* stash;
    __device__ __forceinline__ void operator()(const acc_t& acc, const pg8::Unit& u, int ui, int wr, int wc, int fr, int fq) const {
        const int tid_ = TID();
        u32x4* st = (u32x4*)(stash + ((size_t)BID() * 2 + ui) * 65536);
        ROWS_LOOP {
#pragma unroll
            for (int bj = 0; bj < 2; ++bj) { const f32x4 v0 = acc[ai][bj][m][0], v1 = acc[ai][bj][m][1];
                u32x4 w; w[0] = cvtpk(v0[0], v0[1]); w[1] = cvtpk(v0[2], v0[3]); w[2] = cvtpk(v1[0], v1[1]); w[3] = cvtpk(v1[2], v1[3]);
                st[((ai * 4 + m) * 2 + bj) * 512 + tid_] = w; } }
    }
};
struct EpiGate {
    const Params& p; int l; int br;
    __device__ __forceinline__ void operator()(const acc_t& acc, const pg8::Unit& u, int ui, int wr, int wc, int fr, int fq) const {
        const float* ssq = p.sumsq() + (size_t)(l & 1) * T * 16;
        const int tid_ = TID();
        const u32x4* st = (const u32x4*)(p.stash() + ((size_t)BID() * 2 + ui) * 65536);
        const int cl = wc * 4 + fq;
        ROWS_LOOP { const int row = ROW_OF; const float rs = row_rstd(ssq, row);
#pragma unroll
            for (int bj = 0; bj < 2; ++bj) { const f32x4 v0 = acc[ai][bj][m][0] * rs, v1 = acc[ai][bj][m][1] * rs;
                const u32x4 y = st[((ai * 4 + m) * 2 + bj) * 512 + tid_];
                float r[8];
                r[0] = sigmf(v0[0]) * bflo(y[0]); r[1] = sigmf(v0[1]) * bfhi(y[0]); r[2] = sigmf(v0[2]) * bflo(y[1]); r[3] = sigmf(v0[3]) * bfhi(y[1]);
                r[4] = sigmf(v1[0]) * bflo(y[2]); r[5] = sigmf(v1[1]) * bfhi(y[2]); r[6] = sigmf(v1[2]) * bflo(y[3]); r[7] = sigmf(v1[3]) * bfhi(y[3]);
                u32x4* mp = (u32x4*)(p.merged() + (size_t)row * 1024 + u.pn * 256 + 16 * cl + bj * 8);
                if (br > 0) { const u32x4 om = *mp;
#pragma unroll
                    for (int e = 0; e < 4; ++e) { r[2 * e] += bflo(om[e]); r[2 * e + 1] += bfhi(om[e]); } }
                u32x4 w; w[0] = cvtpk(r[0], r[1]); w[1] = cvtpk(r[2], r[3]); w[2] = cvtpk(r[4], r[5]); w[3] = cvtpk(r[6], r[7]);
                *mp = w; } }
    }
};
__device__ __forceinline__ void phase_merge(const Params& p, int l, char* shm) {
    pg8::RowOrder S{4, 512, GDIM(), BID()};
    for (int br = 0; br < 3; ++br) {
        const u16* Ain = br == 0 ? p.ga() : (br == 1 ? p.bin() : p.sp());
        const u16* Wy = (br == 0 ? p.wt_oa() : (br == 1 ? p.wt_ob() : p.wt_oc())) + (size_t)l * 1024 * 512;
        { pg8::Gemm g{Ain, Wy, T, 1024, 512}; EpiStash E{p.stash()}; pg8::gemm_phase((PG8_LAS unsigned char*)shm, g, S, E); }
        { pg8::Gemm g{p.xb(), p.wt_mg() + (size_t)l * 3072 * 1024 + (size_t)br * 1024 * 1024, T, 1024, 1024}; EpiGate E{p, l, br}; pg8::gemm_phase((PG8_LAS unsigned char*)shm, g, S, E); }
    }
}

struct EpiOut {
    const Params& p; int l;
    __device__ __forceinline__ void operator()(const acc_t& acc, const pg8::Unit& u, int ui, int wr, int wc, int fr, int fq) const {
        const float* xsrc = (l == 0) ? p.x_in : p.x;
        const int cl = wc * 4 + fq;
        ROWS_LOOP { const int row = ROW_OF; float ss = 0.f;
#pragma unroll
            for (int bj = 0; bj < 2; ++bj) { const size_t o = (size_t)row * 1024 + u.pn * 256 + 16 * cl + bj * 8;
                f32x4 x0 = *(const f32x4*)(xsrc + o) + acc[ai][bj][m][0], x1 = *(const f32x4*)(xsrc + o + 4) + acc[ai][bj][m][1];
                *(f32x4*)(p.x + o) = x0; *(f32x4*)(p.x + o + 4) = x1;
                if (l < NL - 1) { u32x4 w; w[0] = cvtpk(x0[0], x0[1]); w[1] = cvtpk(x0[2], x0[3]); w[2] = cvtpk(x1[0], x1[1]); w[3] = cvtpk(x1[2], x1[3]); *(u32x4*)(p.xb() + o) = w;
#pragma unroll
                    for (int j = 0; j < 4; ++j) ss += x0[j] * x0[j] + x1[j] * x1[j]; } }
            if (l < NL - 1) { ss += __shfl_xor(ss, 16); ss += __shfl_xor(ss, 32); if (fq == 0) p.sumsq()[(size_t)((l + 1) & 1) * T * 16 + (size_t)row * 16 + u.pn * 4 + wc] = ss; } }
    }
};
__device__ __forceinline__ void phase_out(const Params& p, int l, char* shm) {
    pg8::RowOrder S{4, 512, GDIM(), BID()};
    pg8::Gemm g{p.merged(), p.wt_o() + (size_t)l * 1024 * 1024, T, 1024, 1024};
    EpiOut E{p, l};
    pg8::gemm_phase((PG8_LAS unsigned char*)shm, g, S, E);
}

enum { PH_PREP0 = 0, PH_IN, PH_MIX, PH_IDX, PH_SEL, PH_ATTN, PH_MERGE, PH_OUT };
template <int PH> __global__ __launch_bounds__(NTHR) void k_phase(Params p, int l, int b) {
    extern __shared__ __attribute__((aligned(16))) char shm[];
    if (PH == PH_PREP0) phase_prep0(p, shm);
    if (PH == PH_IN) phase_in(p, l, shm);
    if (PH == PH_MIX) phase_mix(p, l);
    if (PH == PH_IDX) phase_indexer(p, b);
    if (PH == PH_SEL) phase_select(p, b, shm);
    if (PH == PH_ATTN) phase_attn(p, shm);
    if (PH == PH_MERGE) phase_merge(p, l, shm);
    if (PH == PH_OUT) phase_out(p, l, shm);
}

#define XB_TMO      128
#define XB_XCNT(j)  (256  + 64 * (j))
#define XB_XSUB(j)  (1280 + 64 * (j))
#define XB_XGEN(j)  (2304 + 64 * (j))
#define XB_TOP      3328
#define XB_TOPGEN   3392
#define XCD_BAR_WORDS 3456
#define XB_SPIN_CAP (1u << 22)
#define LAS __attribute__((address_space(3)))
__device__ __forceinline__ unsigned xb_ld(unsigned* p)              { return __hip_atomic_load(p, __ATOMIC_RELAXED, __HIP_MEMORY_SCOPE_AGENT); }
__device__ __forceinline__ unsigned xb_add(unsigned* p, unsigned v) { return __hip_atomic_fetch_add(p, v, __ATOMIC_RELAXED, __HIP_MEMORY_SCOPE_AGENT); }
__device__ __forceinline__ unsigned xb_xcc_id() { return (unsigned)__builtin_amdgcn_s_getreg((3 << 11) | 20) & 0xFu; }
#define XB_SPIN(cond, bar) do { unsigned _sp = 0; while (cond) { __builtin_amdgcn_s_sleep(1); \
    if ((++_sp & 255u) == 0u) { if (xb_ld(&(bar)[XB_TMO])) break; if (_sp > XB_SPIN_CAP) { atomicAdd(&(bar)[XB_TMO], 1u); break; } } } } while (0)
struct XcdBarrier { unsigned* bar; unsigned x; volatile LAS unsigned* st; };
__device__ __forceinline__ XcdBarrier xcd_barrier_post(unsigned* bar, volatile LAS unsigned* st) {
    XcdBarrier b; b.bar = bar; b.x = xb_xcc_id(); b.st = st;
    if (threadIdx.x == 0) (void)xb_add(&bar[XB_XCNT(b.x)], 1u);
    return b;
}
__device__ __forceinline__ void xcd_barrier_complete(unsigned* bar, unsigned x, unsigned& nloc, unsigned& nx) {
    const unsigned G = gridDim.x * gridDim.y * gridDim.z;
    unsigned sum, cnt, mine, sp = 0u;
    for (;;) {
        sum = 0u; cnt = 0u; mine = 0u;
#pragma unroll
        for (unsigned j = 0; j < 16; ++j) { const unsigned c = xb_ld(&bar[XB_XCNT(j)]); sum += c; cnt += (c > 0u) ? 1u : 0u; mine = (j == x) ? c : mine; }
        if (sum == G) break;
        __builtin_amdgcn_s_sleep(1);
        if ((++sp & 255u) == 0u) { if (xb_ld(&bar[XB_TMO])) break; if (sp > XB_SPIN_CAP) { atomicAdd(&bar[XB_TMO], 1u); break; } }
    }
    nloc = mine > 0u ? mine : 1u; nx = cnt > 0u ? cnt : 1u;
}
__device__ __forceinline__ void xcd_barrier(const XcdBarrier& b) {
    asm volatile("s_waitcnt vmcnt(0)" ::: "memory");
    __syncthreads();
    if (threadIdx.x == 0) {
        unsigned* bar = b.bar;
        __builtin_amdgcn_s_waitcnt(0);
        unsigned nloc = b.st[0], nx = b.st[1];
        if (nloc == 0u) { xcd_barrier_complete(bar, b.x, nloc, nx); b.st[0] = nloc; b.st[1] = nx; }
        const unsigned old = xb_add(&bar[XB_XSUB(b.x)], 1u);
        const unsigned gen = old / nloc;
        if (old + 1u == (gen + 1u) * nloc) {
            __builtin_amdgcn_fence(__ATOMIC_RELEASE, "agent");
            asm volatile("s_waitcnt vmcnt(0)" ::: "memory");
            const unsigned og = xb_add(&bar[XB_TOP], 1u);
            const unsigned tg = og / nx;
            if (og + 1u == (tg + 1u) * nx) xb_add(&bar[XB_TOPGEN], 1u);
            else XB_SPIN(xb_ld(&bar[XB_TOPGEN]) == tg, bar);
            __builtin_amdgcn_fence(__ATOMIC_ACQUIRE, "agent");
            xb_add(&bar[XB_XGEN(b.x)], 1u);
            asm volatile("s_waitcnt vmcnt(0)" ::: "memory");
        } else {
            XB_SPIN(xb_ld(&bar[XB_XGEN(b.x)]) == gen, bar);
            __builtin_amdgcn_fence(__ATOMIC_ACQUIRE, "agent");
            asm volatile("s_waitcnt vmcnt(0)" ::: "memory");
        }
    }
    __syncthreads();
}

#if MEGA
typedef const __attribute__((address_space(4))) Params* kparams_t;
__device__ __forceinline__ Params load_params(kparams_t k) {
    Params q; q.x_in = k->x_in; q.norm_g = k->norm_g; q.w_in = k->w_in; q.conv_w = k->conv_w; q.w_out_conv = k->w_out_conv; q.q_g = k->q_g; q.k_g = k->k_g; q.w_out_attn = k->w_out_attn;
    q.pool_w = k->pool_w; q.pool_scale = k->pool_scale; q.w_out_pool = k->w_out_pool; q.w_o = k->w_o; q.x = k->x; q.ws = k->ws; return q; }
#define PHP(q) kparams_t kq_##q = kp; asm volatile("" : "+s"(kq_##q)); const Params q = load_params(kq_##q);
__global__ __launch_bounds__(NTHR) void k_mega(Params p_unused) {
    extern __shared__ __attribute__((aligned(16))) char shm[];
    cg::grid_group grid = cg::this_grid();
    kparams_t kp = (kparams_t)__builtin_amdgcn_kernarg_segment_ptr();
    __shared__ uint4 xb_words;
    if (threadIdx.x == 0) xb_words = make_uint4(0u, 0u, 0u, 0u);
    __syncthreads();
    const XcdBarrier xb = xcd_barrier_post((unsigned*)(kp->ws + WS_BAR), (volatile LAS unsigned*)&xb_words);

#ifndef SK_PREP
        { PHP(p) phase_prep0(p, shm); }
#endif

    grid.sync();
    for (int l = 0; l < NL; ++l) {

#ifndef SK_IN
        { PHP(p) phase_in(p, l, shm); }
#endif
#ifdef DUP_IN
        { PHP(p) phase_in(p, l, shm); }
#endif

        xcd_barrier(xb);

#ifndef SK_MIX
        { PHP(p) phase_mix(p, l); }
#endif

        for (int b = 0; b < NBATCH; ++b) {

#ifndef SK_IDX
        { PHP(p) phase_indexer(p, b); }
#endif
#ifdef DUP_IDX
        { PHP(p) phase_indexer(p, b); }
#endif

            xcd_barrier(xb);

#ifndef SK_SEL
        { PHP(p) phase_select(p, b, shm); }
#endif
#ifdef DUP_SEL
        { PHP(p) phase_select(p, b, shm); }
#endif

            xcd_barrier(xb);
        }

#ifndef SK_ATTN
        { PHP(p) phase_attn(p, shm); }
#endif
#ifdef DUP_ATTN
        { PHP(p) phase_attn(p, shm); }
#endif

        xcd_barrier(xb);

#ifndef SK_MERGE
        { PHP(p) phase_merge(p, l, shm); }
#endif
#ifdef DUP_MERGE
        { PHP(p) phase_merge(p, l, shm); }
#endif

        xcd_barrier(xb);

#ifndef SK_OUT
        { PHP(p) phase_out(p, l, shm); }
#endif

        xcd_barrier(xb);
    }
}
#endif

static Params make_params(void* const* d_in, void* d_out, void* d_ws) {
    Params p{};
    p.x_in = (const float*)d_in[0]; p.norm_g = (const float*)d_in[1]; p.w_in = (const float*)d_in[2]; p.conv_w = (const float*)d_in[3];
    p.w_out_conv = (const float*)d_in[4]; p.q_g = (const float*)d_in[5]; p.k_g = (const float*)d_in[6]; p.w_out_attn = (const float*)d_in[7];
    p.pool_w = (const float*)d_in[8]; p.pool_scale = (const float*)d_in[9]; p.w_out_pool = (const float*)d_in[10]; p.w_o = (const float*)d_in[11];
    p.x = (float*)d_out; p.ws = (char*)d_ws;
    return p;
}

extern "C" void kernel_launch(void* const* d_in, const int* in_sizes, int n_in, void* d_out, int out_size, void* d_ws, size_t ws_size, hipStream_t stream) {
    if (ws_size < WS_NEEDED) { fprintf(stderr, "workspace too small: %zu < %zu\n", ws_size, (size_t)WS_NEEDED); return; }
    Params p = make_params(d_in, d_out, d_ws);
    const int grid = 256;
#if MEGA
    static bool attr = false;
    if (!attr) { hipFuncSetAttribute((const void*)k_mega, hipFuncAttributeMaxDynamicSharedMemorySize, LDS_BYTES); attr = true; }
    hipMemsetAsync((char*)d_ws + WS_BAR, 0, 16384, stream);
    void* args[] = {&p};
    hipError_t e = hipLaunchCooperativeKernel((void*)k_mega, dim3(grid), dim3(NTHR), args, LDS_BYTES, stream);
    if (e != hipSuccess) fprintf(stderr, "cooperative launch failed: %s\n", hipGetErrorString(e));
#else
    static bool attr = false;
    if (!attr) {
        hipFuncSetAttribute((const void*)k_phase<PH_PREP0>, hipFuncAttributeMaxDynamicSharedMemorySize, LDS_BYTES);
        hipFuncSetAttribute((const void*)k_phase<PH_IN>, hipFuncAttributeMaxDynamicSharedMemorySize, LDS_BYTES);
        hipFuncSetAttribute((const void*)k_phase<PH_MIX>, hipFuncAttributeMaxDynamicSharedMemorySize, LDS_BYTES);
        hipFuncSetAttribute((const void*)k_phase<PH_IDX>, hipFuncAttributeMaxDynamicSharedMemorySize, LDS_BYTES);
        hipFuncSetAttribute((const void*)k_phase<PH_SEL>, hipFuncAttributeMaxDynamicSharedMemorySize, LDS_BYTES);
        hipFuncSetAttribute((const void*)k_phase<PH_ATTN>, hipFuncAttributeMaxDynamicSharedMemorySize, LDS_BYTES);
        hipFuncSetAttribute((const void*)k_phase<PH_MERGE>, hipFuncAttributeMaxDynamicSharedMemorySize, LDS_BYTES);
        hipFuncSetAttribute((const void*)k_phase<PH_OUT>, hipFuncAttributeMaxDynamicSharedMemorySize, LDS_BYTES);
        attr = true;
    }
#define LAUNCH(PH, l, b) hipLaunchKernelGGL(k_phase<PH>, dim3(grid), dim3(NTHR), LDS_BYTES, stream, p, l, b)
    LAUNCH(PH_PREP0, 0, 0);
    for (int l = 0; l < NL; ++l) {
        LAUNCH(PH_IN, l, 0);
        LAUNCH(PH_MIX, l, 0);
        for (int b = 0; b < NBATCH; ++b) { LAUNCH(PH_IDX, l, b); LAUNCH(PH_SEL, l, b); }
        LAUNCH(PH_ATTN, l, 0);
        LAUNCH(PH_MERGE, l, 0);
        LAUNCH(PH_OUT, l, 0);
    }
#endif
}
```

```cpp
#include <hip/hip_runtime.h>
#include <hip/hip_cooperative_groups.h>
#include <stdint.h>
#include <stdio.h>
namespace cg = cooperative_groups;

typedef unsigned short u16;
typedef unsigned long long u64;
typedef __attribute__((ext_vector_type(8))) short bf16x8;
typedef __attribute__((ext_vector_type(4))) short s16x4;
typedef __attribute__((ext_vector_type(4))) float f32x4;
typedef __attribute__((ext_vector_type(16))) float f32x16;
typedef __attribute__((ext_vector_type(4))) unsigned u32x4;
typedef __attribute__((ext_vector_type(2))) unsigned u32x2;

#ifndef MEGA
#define MEGA 1
#endif
__device__ __forceinline__ int TID() { int t = threadIdx.x; asm volatile("" : "+v"(t)); return t; }
__device__ __forceinline__ int BID() { int t = blockIdx.x; asm volatile("" : "+s"(t)); return t; }
__device__ __forceinline__ int GDIM() { int t = gridDim.x; asm volatile("" : "+s"(t)); return t; }

constexpr int SEQ = 8192, NBATCH = 4, T = NBATCH * SEQ, DMODEL = 1024, NL = 4, INW = 8776;
constexpr int NPA = 5888;
constexpr int NTHR = 512;
constexpr int LDS_BYTES = 131072;
constexpr float RMS_EPS = 1e-6f;

struct Params {
    const float *x_in, *norm_g, *w_in, *conv_w, *w_out_conv, *q_g, *k_g, *w_out_attn, *pool_w, *pool_scale, *w_out_pool, *w_o;
    float* x; char* ws;
    __device__ __forceinline__ u16* xb() const { return (u16*)(ws + 0ull); }
    __device__ __forceinline__ u16* z() const { return (u16*)(ws + 67108864ull); }
    __device__ __forceinline__ u16* ga() const { return (u16*)(ws + 100663296ull); }
    __device__ __forceinline__ u16* q() const { return (u16*)(ws + 134217728ull); }
    __device__ __forceinline__ u16* k() const { return (u16*)(ws + 167772160ull); }
    __device__ __forceinline__ u16* v() const { return (u16*)(ws + 201326592ull); }
    __device__ __forceinline__ u16* sg() const { return (u16*)(ws + 234881024ull); }
    __device__ __forceinline__ u16* iq() const { return (u16*)(ws + 268435456ull); }
    __device__ __forceinline__ u16* u() const { return (u16*)(ws + 301989888ull); }
    __device__ __forceinline__ u16* sp() const { return (u16*)(ws + 335544320ull); }
    __device__ __forceinline__ u16* ik() const { return (u16*)(ws + 369098752ull); }
    __device__ __forceinline__ float* iw() const { return (float*)(ws + 373293056ull); }
    __device__ __forceinline__ u16* wt_in() const { return (u16*)(ws + 374341632ull); }
    __device__ __forceinline__ u16* wt_mg() const { return (u16*)(ws + 422576128ull); }
    __device__ __forceinline__ u16* wt_oa() const { return (u16*)(ws + 447741952ull); }
    __device__ __forceinline__ u16* wt_ob() const { return (u16*)(ws + 451936256ull); }
    __device__ __forceinline__ u16* wt_oc() const { return (u16*)(ws + 456130560ull); }
    __device__ __forceinline__ u16* wt_o() const { return (u16*)(ws + 460324864ull); }
    __device__ __forceinline__ float* ropec() const { return (float*)(ws + 468713472ull); }
    __device__ __forceinline__ float* ropes() const { return (float*)(ws + 469762048ull); }
    __device__ __forceinline__ float* sumsq() const { return (float*)(ws + 470810624ull); }
    __device__ __forceinline__ u64* mask() const { return (u64*)(ws + 475004928ull); }
    __device__ __forceinline__ u16* scores() const { return (u16*)(ws + 492306432ull); }
    __device__ __forceinline__ u16* stash() const { return scores(); }
    __device__ __forceinline__ u16* merged() const { return q(); }
    __device__ __forceinline__ u16* bin() const { return iq(); }
};
constexpr size_t WS_BAR = 561512448ull;
constexpr size_t WS_NEEDED = WS_BAR + 16384;


__device__ __forceinline__ unsigned cvtpk(float lo, float hi) { unsigned r; asm("v_cvt_pk_bf16_f32 %0, %1, %2" : "=v"(r) : "v"(lo), "v"(hi)); return r; }
__device__ __forceinline__ u16 f2bf(float f) { return (u16)(cvtpk(f, 0.f) & 0xffffu); }
__device__ __forceinline__ float bf2f(u16 b) { return __uint_as_float(((unsigned)b) << 16); }
__device__ __forceinline__ float bflo(unsigned w) { return __uint_as_float(w << 16); }
__device__ __forceinline__ float bfhi(unsigned w) { return __uint_as_float(w & 0xffff0000u); }
__device__ __forceinline__ float siluf(float x) { return x * __builtin_amdgcn_rcpf(1.f + __builtin_amdgcn_exp2f(x * -1.4426950408889634f)); }
__device__ __forceinline__ float sigmf(float x) { return __builtin_amdgcn_rcpf(1.f + __builtin_amdgcn_exp2f(x * -1.4426950408889634f)); }

__device__ __forceinline__ float row_rstd(const float* ssp, int row) {
    const f32x4* q = (const f32x4*)(ssp + (size_t)row * 16);
    const f32x4 a = q[0], b = q[1], c = q[2], d = q[3];
    const float s = ((a[0] + a[1]) + (a[2] + a[3])) + ((b[0] + b[1]) + (b[2] + b[3])) + ((c[0] + c[1]) + (c[2] + c[3])) + ((d[0] + d[1]) + (d[2] + d[3]));
    return __builtin_amdgcn_rsqf(s * (1.f / 1024.f) + RMS_EPS);
}
__device__ __forceinline__ int lc_of_tc(int tc) { int bj = tc >> 7, wc = (tc >> 5) & 3, n = (tc >> 4) & 1, fq = (tc >> 2) & 3, j = tc & 3; return ((wc * 4 + fq) << 4) + bj * 8 + n * 4 + j; }
__device__ __forceinline__ int tc_of_lc(int lc) { int cl = lc >> 4, s = lc & 15, wc = cl >> 2, fq = cl & 3, bj = s >> 3, n = (s >> 2) & 1, j = s & 3; return bj * 128 + wc * 32 + n * 16 + fq * 4 + j; }

__device__ __forceinline__ int src_col_in(int np) {
    int pn = np >> 8, tc = np & 255;
    int bj = tc >> 7, wc = (tc >> 5) & 3, n = (tc >> 4) & 1, fq = (tc >> 2) & 3, j = tc & 3, cl = wc * 4 + fq, s = bj * 8 + n * 4 + j, lc = cl * 16 + s;
    int d = (s < 8) ? (8 * fq + s) : (8 * fq + 32 + (s - 8));
    if (pn < 8) return (s & 3) * 512 + pn * 64 + cl * 4 + (s >> 2);
    if (pn < 12) { int which = (pn - 8) >> 1, head = ((pn - 8) & 1) * 4 + wc; return 2048 + which * 512 + head * 64 + d; }
    if (pn < 14) return 3072 + (pn - 12) * 256 + lc;
    if (pn < 16) return 3584 + (pn - 14) * 256 + lc;
    if (pn < 18) { int head = (pn - 16) * 4 + wc; return 4096 + head * 64 + d; }
    if (pn == 18) { if (wc == 0) return 4608 + d; if (wc == 1 && fq == 0 && s < 8) return 4672 + s; return -1; }
    if (pn < 21) return -2;
    return 5192 + (pn - 21) * 256 + lc;
}

__device__ __forceinline__ void prep_x(const Params& p) {
    const int tid_ = TID(); const int lane = tid_ & 63, gw = BID() * (NTHR / 64) + (tid_ >> 6), nw = GDIM() * (NTHR / 64);
    for (int row = gw; row < T; row += nw) {
        const float4* src = (const float4*)(p.x_in + (size_t)row * DMODEL);
        float ss = 0.f;
#pragma unroll
        for (int i = 0; i < 4; ++i) {
            float4 v = src[i * 64 + lane];
            ss += v.x * v.x + v.y * v.y + v.z * v.z + v.w * v.w;
            u32x2 o; o[0] = cvtpk(v.x, v.y); o[1] = cvtpk(v.z, v.w);
            *(u32x2*)(p.xb() + (size_t)row * DMODEL + (i * 64 + lane) * 4) = o;
        }
#pragma unroll
        for (int m = 32; m >= 1; m >>= 1) ss += __shfl_xor(ss, m);
        if (lane < 16) p.sumsq()[(size_t)row * 16 + lane] = (lane == 0) ? ss : 0.f;
    }
}
__device__ __forceinline__ void prep_rope(const Params& p) {
    const int i0 = BID() * NTHR + TID(), istep = GDIM() * NTHR;
    for (int i = i0; i < SEQ * 32; i += istep) {
        int pos = i >> 5, j = i & 31;
        float inv = 1.0f / powf(10000.0f, (float)(2 * j) / 64.0f);
        float ang = (float)pos * inv;
        p.ropec()[i] = cosf(ang); p.ropes()[i] = sinf(ang);
    }
}
__device__ __forceinline__ void prep_wt(const float* src, int lds_, const float* scale, u16* dst, int K, int NP, int mode, float* tile) {
    const int tid_ = TID(); const int tx = tid_ & 63, ty = tid_ >> 6; const int bid_ = BID(), gdim_ = GDIM();
    const int ntn = NP / 64, ntk = K / 64;
    for (int t = bid_; t < ntn * ntk; t += gdim_) {
        const int n0 = (t / ntk) * 64, k0 = (t % ntk) * 64;
        int np = n0 + tx, col;
        if (mode == 0) col = src_col_in(np);
        else if (mode == 1) col = 5704 + (np & ~255) + lc_of_tc(np & 255);
        else col = (np & ~255) + lc_of_tc(np & 255);
        __syncthreads();
#pragma unroll
        for (int i = 0; i < 8; ++i) { int kk = ty + 8 * i; tile[kk * 65 + tx] = (col >= 0) ? src[(size_t)(k0 + kk) * lds_ + col] : 0.f; }
        __syncthreads();
        const float sc = scale ? scale[k0 + tx] : 1.f;
#pragma unroll
        for (int i = 0; i < 8; ++i) {
            int nn = ty + 8 * i; int npo = n0 + nn;
            bool skip = (mode == 0) && ((npo >> 8) == 19 || (npo >> 8) == 20);
            if (!skip) dst[(size_t)npo * K + k0 + tx] = f2bf(tile[tx * 65 + nn] * sc);
        }
    }
}
__device__ __forceinline__ void prep_fold(const float* win, const float* ng, const float* pw, u16* wt_in) {
    const int i0 = BID() * NTHR + TID(), istep = GDIM() * NTHR;
    for (int i = i0; i < 1024 * 512; i += istep) {
        int k = i >> 9, n = i & 511, g = n >> 7, d = n & 127;
        const float* wr = win + (size_t)k * INW + 4680 + g * 128;
        const float* pp = pw + (size_t)g * 128 * 128 + d;
        float acc = 0.f;
        for (int c = 0; c < 128; ++c) acc += wr[c] * pp[c * 128];
        int row = (19 + (n >> 8)) * 256 + tc_of_lc(n & 255);
        wt_in[(size_t)row * 1024 + k] = f2bf(acc * ng[k]);
    }
}
__device__ __forceinline__ void phase_prep0(const Params& p, char* shm) {
    prep_x(p); prep_rope(p);
    float* tile = (float*)shm;
    for (int l = 0; l < NL; ++l) {
        const float* ng = p.norm_g + l * 1024;
        const float* win = p.w_in + (size_t)l * 1024 * INW;
        prep_wt(win, INW, ng, p.wt_in() + (size_t)l * NPA * 1024, 1024, NPA, 0, tile);
        prep_wt(win, INW, ng, p.wt_mg() + (size_t)l * 3072 * 1024, 1024, 3072, 1, tile);
        prep_wt(p.w_out_conv + (size_t)l * 512 * 1024, 1024, nullptr, p.wt_oa() + (size_t)l * 1024 * 512, 512, 1024, 2, tile);
        prep_wt(p.w_out_attn + (size_t)l * 512 * 1024, 1024, nullptr, p.wt_ob() + (size_t)l * 1024 * 512, 512, 1024, 2, tile);
        prep_wt(p.w_out_pool + (size_t)l * 512 * 1024, 1024, nullptr, p.wt_oc() + (size_t)l * 1024 * 512, 512, 1024, 2, tile);
        prep_wt(p.w_o + (size_t)l * 1024 * 1024, 1024, nullptr, p.wt_o() + (size_t)l * 1024 * 1024, 1024, 1024, 3, tile);
        prep_fold(win, ng, p.pool_w + (size_t)l * 4 * 128 * 128, p.wt_in() + (size_t)l * NPA * 1024);
    }
}

namespace pg8 {
#define PG8_LAS __attribute__((address_space(3)))
typedef unsigned short bf16_t;
constexpr int BM = 256, BK = 64, HALF = 128, HTB = HALF * BK * 2, STAGE_BYTES = 8 * HTB;
__device__ __forceinline__ int lds_byte(int r, int c) { const int st = (r >> 4) * 2 + (c >> 5), rr = r & 15, cc = c & 31, ob = rr * 64 + cc * 2; return st * 1024 + (ob ^ (((ob >> 9) & 1) << 5)); }
__device__ __forceinline__ void stage_rc(int b, int& R, int& C) { const int st = b / 1024, sb = b % 1024, swz = sb ^ (((sb >> 9) & 1) << 5); R = (st >> 1) * 16 + swz / 64; C = (st & 1) * 32 + (swz % 64) / 2; }
struct Unit { int pm, pn; };
struct Gemm { const bf16_t* A; const bf16_t* Bt; int M, N, K; };
constexpr int NXCD = 8, WGM = 8;
struct StaticOrder {
    int nM, nN, nwg, G, c;
    __device__ void init(int M, int N, int G_, int c_) { nM = M / BM; nN = N / BM; nwg = nM * nN; G = G_; c = c_; }
    __device__ bool next(int i, Unit& u) const {
        const long L = (long)i * G + c; if (L >= nwg) return false;
        int wgid = (int)L; { const int q = nwg / NXCD, r = nwg % NXCD, xcd = wgid % NXCD, off = wgid / NXCD; wgid = (xcd < r ? xcd * (q + 1) : r * (q + 1) + (xcd - r) * q) + off; }
        const int nig = WGM * nN, gid = wgid / nig, fm = gid * WGM, gsz = (nM - fm) < WGM ? (nM - fm) : WGM;
        u.pm = fm + ((wgid % nig) % gsz); u.pn = (wgid % nig) / gsz; return true;
    }
};
struct RowOrder {
    int nN, ntile, G, c;
    __device__ bool next(int i, Unit& u) const { const int t = c + i * G; if (t >= ntile) return false; u.pm = t / nN; u.pn = t % nN; return true; }
};
template <class Epi, class Sched>
__device__ __forceinline__ void gemm_phase(PG8_LAS unsigned char* lds, const Gemm g, const Sched& S, const Epi& E) {
    const int tid = TID(), wid = __builtin_amdgcn_readfirstlane(tid >> 6), lane = tid & 63, wr = wid >> 2, wc = wid & 3, fr = lane & 15, fq = lane >> 4;
    const int K = g.K, nt = K / BK;
    unsigned voffA[2], voffB[2];
#pragma unroll
    for (int i = 0; i < 2; ++i) { int R, C; stage_rc(tid * 16 + i * 8192, R, C); voffA[i] = (unsigned)(R * K + C) * 2u; voffB[i] = voffA[i]; }
    const size_t kstep = (size_t)(BK * 2);
    const size_t hstep = (size_t)HALF * K * 2;
    const size_t tstep = 2 * hstep;
    const unsigned ldsw = (unsigned)wid * 1024u;
    const int aoff = lds_byte(wr * 64 + fr, fq * 8), boff = lds_byte(wc * 32 + fr, fq * 8);
#define PG8_SA(b, h) (((b) * 2 + (h)) * HTB)
#define PG8_SB(b, h) ((4 + (b) * 2 + (h)) * HTB)
#define PG8_STAGE(bufoff, gbase, voff) do { _Pragma("unroll") for (int _i = 0; _i < 2; ++_i) \
        __builtin_amdgcn_global_load_lds((const unsigned*)((const char*)(gbase) + (voff)[_i]), (PG8_LAS unsigned*)(lds + (bufoff) + ldsw + _i * 8192), 16, 0, 0); } while (0)
#define PG8_LDA(dst, b, h) do { _Pragma("unroll") for (int m = 0; m < 4; ++m) _Pragma("unroll") for (int k = 0; k < 2; ++k) dst[m][k] = *(const PG8_LAS bf16x8*)(lds + PG8_SA(b, h) + aoff + m * 2048 + k * 1024); } while (0)
#define PG8_LDB(dst, b, h) do { _Pragma("unroll") for (int n = 0; n < 2; ++n) _Pragma("unroll") for (int k = 0; k < 2; ++k) dst[n][k] = *(const PG8_LAS bf16x8*)(lds + PG8_SB(b, h) + boff + n * 2048 + k * 1024); } while (0)
#define PG8_MMA(ai, bj, At, Bt) do { __builtin_amdgcn_s_setprio(1); _Pragma("unroll") for (int m = 0; m < 4; ++m) _Pragma("unroll") for (int n = 0; n < 2; ++n) _Pragma("unroll") for (int k = 0; k < 2; ++k) \
        acc[ai][bj][m][n] = __builtin_amdgcn_mfma_f32_16x16x32_bf16(Bt[n][k], At[m][k], acc[ai][bj][m][n], 0, 0, 0); __builtin_amdgcn_s_setprio(0); } while (0)
#define PG8_WAIT_V(n) asm volatile("s_waitcnt vmcnt(" #n ")" ::: "memory")
#define PG8_WAIT_L(n) asm volatile("s_waitcnt lgkmcnt(" #n ")" ::: "memory")
#define PG8_BAR __builtin_amdgcn_s_barrier()
#define PG8_SCHED __builtin_amdgcn_sched_barrier(0)
    Unit cur, nxt; int ui = 0;
    if (!S.next(0, cur)) return;
    f32x4 acc[2][2][4][2];
#pragma unroll
    for (int a = 0; a < 2; ++a)
#pragma unroll
        for (int b = 0; b < 2; ++b)
#pragma unroll
            for (int m = 0; m < 4; ++m)
#pragma unroll
                for (int n = 0; n < 2; ++n) acc[a][b][m][n] = (f32x4){0.f, 0.f, 0.f, 0.f};
    bf16x8 At[4][2], B0[2][2], B1[2][2];
    const char* cA = (const char*)g.A + (size_t)cur.pm * tstep; const char* cB = (const char*)g.Bt + (size_t)cur.pn * tstep;
    PG8_STAGE(PG8_SB(0, 0), cB, voffB); PG8_STAGE(PG8_SA(0, 0), cA, voffA); PG8_STAGE(PG8_SB(0, 1), cB + hstep, voffB); PG8_STAGE(PG8_SA(0, 1), cA + hstep, voffA);
    if (wr == 1) PG8_BAR;
    PG8_WAIT_V(4); PG8_BAR;
    PG8_STAGE(PG8_SB(1, 0), cB + kstep, voffB); PG8_STAGE(PG8_SA(1, 0), cA + kstep, voffA); PG8_STAGE(PG8_SB(1, 1), cB + hstep + kstep, voffB);
    PG8_WAIT_V(6); PG8_BAR;
    for (;;) {
        const bool has_next = S.next(ui + 1, nxt);
        const char* nA = has_next ? (const char*)g.A + (size_t)nxt.pm * tstep : cA; const char* nB = has_next ? (const char*)g.Bt + (size_t)nxt.pn * tstep : cB;
        for (int t = 0; t < nt; t += 2) {
            const bool last = (t == nt - 2);
            const char* a1 = cA + (size_t)(t + 1) * kstep;
            const char* a2 = last ? nA : cA + (size_t)(t + 2) * kstep; const char* b2 = last ? nB : cB + (size_t)(t + 2) * kstep;
            const char* a3 = a2 + kstep; const char* b3 = b2 + kstep;
            PG8_LDB(B0, 0, 0); PG8_SCHED; PG8_LDA(At, 0, 0); PG8_STAGE(PG8_SA(1, 1), a1 + hstep, voffA);
            PG8_WAIT_L(8); PG8_BAR; PG8_WAIT_L(0); PG8_MMA(0, 0, At, B0); PG8_BAR; PG8_SCHED;
            PG8_LDB(B1, 0, 1); PG8_STAGE(PG8_SB(0, 0), b2, voffB);
            PG8_BAR; PG8_WAIT_L(0); PG8_MMA(0, 1, At, B1); PG8_BAR;
            PG8_LDA(At, 0, 1); PG8_STAGE(PG8_SA(0, 0), a2, voffA);
            PG8_BAR; PG8_WAIT_L(0); PG8_MMA(1, 0, At, B0); PG8_BAR; PG8_SCHED;
            PG8_STAGE(PG8_SB(0, 1), b2 + hstep, voffB);
            PG8_WAIT_V(6); PG8_BAR; PG8_MMA(1, 1, At, B1); PG8_BAR;
            PG8_LDB(B0, 1, 0); PG8_SCHED; PG8_LDA(At, 1, 0); PG8_STAGE(PG8_SA(0, 1), a2 + hstep, voffA);
            PG8_WAIT_L(8); PG8_BAR; PG8_WAIT_L(0); PG8_MMA(0, 0, At, B0); PG8_BAR; PG8_SCHED;
            PG8_LDB(B1, 1, 1); PG8_STAGE(PG8_SB(1, 0), b3, voffB);
            PG8_BAR; PG8_WAIT_L(0); PG8_MMA(0, 1, At, B1); PG8_BAR;
            PG8_LDA(At, 1, 1); PG8_STAGE(PG8_SA(1, 0), a3, voffA);
            PG8_BAR; PG8_WAIT_L(0); PG8_MMA(1, 0, At, B0); PG8_BAR; PG8_SCHED;
            PG8_STAGE(PG8_SB(1, 1), b3 + hstep, voffB);
            PG8_WAIT_V(6); PG8_BAR; PG8_MMA(1, 1, At, B1); PG8_BAR;
        }
        E(acc, cur, ui, wr, wc, fr, fq);
#ifdef DUP_EPI
        if (Epi::DUPOK) E(acc, cur, ui, wr, wc, fr, fq);
#endif
        if (!has_next) break;
#pragma unroll
        for (int a = 0; a < 2; ++a)
#pragma unroll
            for (int b = 0; b < 2; ++b)
#pragma unroll
                for (int m = 0; m < 4; ++m)
#pragma unroll
                    for (int n = 0; n < 2; ++n) acc[a][b][m][n] = (f32x4){0.f, 0.f, 0.f, 0.f};
        cur = nxt; cA = nA; cB = nB; ++ui;
    }
    PG8_WAIT_V(0);
    if (wr == 0) PG8_BAR;
    PG8_BAR;
#undef PG8_SA
#undef PG8_SB
#undef PG8_STAGE
#undef PG8_LDA
#undef PG8_LDB
#undef PG8_MMA
#undef PG8_WAIT_V
#undef PG8_WAIT_L
#undef PG8_BAR
#undef PG8_SCHED
}
}
typedef f32x4 acc_t[2][2][4][2];
#define ROWS_LOOP _Pragma("unroll") for (int ai = 0; ai < 2; ++ai) _Pragma("unroll") for (int m = 0; m < 4; ++m)
#define ROW_OF (u.pm * 256 + ai * 128 + wr * 64 + m * 16 + fr)

struct EpiIn {
    static constexpr bool DUPOK = true;
    const Params& p; int l;
    __device__ __forceinline__ void operator()(const acc_t& acc, const pg8::Unit& u, int ui, int wr, int wc, int fr, int fq) const {
        const float* ssq = p.sumsq() + (size_t)(l & 1) * T * 16;
        const int pn = u.pn, cl = wc * 4 + fq;
        __shared__ float s_rstd[256];
        { const int t_ = TID(); if (t_ < 256) s_rstd[t_] = row_rstd(ssq, u.pm * 256 + t_); __syncthreads(); }
        float rsa[8];
#pragma unroll
        for (int ix = 0; ix < 8; ++ix) rsa[ix] = s_rstd[(ix >> 2) * 128 + wr * 64 + (ix & 3) * 16 + fr];
        if (pn < 8) {
            ROWS_LOOP { const int row = ROW_OF; const float rs = rsa[ai * 4 + m];
                float zz[4], gg[4];
#pragma unroll
                for (int ch = 0; ch < 4; ++ch) { const f32x4 v = acc[ai][ch >> 1][m][ch & 1]; zz[ch] = (v[1] * rs) * (v[2] * rs); gg[ch] = (v[0] * rs) * siluf(v[3] * rs); }
                const size_t o = (size_t)row * 512 + pn * 64 + cl * 4;
                u32x2 a; a[0] = cvtpk(zz[0], zz[1]); a[1] = cvtpk(zz[2], zz[3]); *(u32x2*)(p.z() + o) = a;
                u32x2 b; b[0] = cvtpk(gg[0], gg[1]); b[1] = cvtpk(gg[2], gg[3]); *(u32x2*)(p.ga() + o) = b; }
        } else if (pn < 12 || (pn >= 16 && pn <= 18)) {
            if (pn == 18 && wc >= 1) {
                if (wc == 1 && fq == 0) {
                    ROWS_LOOP { const int row = ROW_OF; const float rs = rsa[ai * 4 + m] * 0.04419417382415922f;
                        *(f32x4*)(p.iw() + (size_t)row * 8) = acc[ai][0][m][0] * rs; *(f32x4*)(p.iw() + (size_t)row * 8 + 4) = acc[ai][0][m][1] * rs; }
                }
            } else {
                const bool isqk = pn < 12; const int which = (pn - 8) >> 1;
                int head; u16* dst; int pitch;
                if (isqk) { head = ((pn - 8) & 1) * 4 + wc; dst = which ? p.k() : p.q(); pitch = 512; }
                else if (pn < 18) { head = (pn - 16) * 4 + wc; dst = p.iq(); pitch = 512; }
                else { head = 0; dst = p.ik(); pitch = 64; }
                f32x4 g0[2], g1[2];
#pragma unroll
                for (int n = 0; n < 2; ++n) { g0[n] = (f32x4){1.f, 1.f, 1.f, 1.f}; g1[n] = g0[n]; }
                if (isqk) { const float* gg = (which ? p.k_g : p.q_g) + l * 64 + 8 * fq;
#pragma unroll
                    for (int n = 0; n < 2; ++n) { g0[n] = *(const f32x4*)(gg + 4 * n); g1[n] = *(const f32x4*)(gg + 32 + 4 * n); } }
                f32x4 rcb[2], rsb[2];
                { const int pos0 = (u.pm * 256 + wr * 64 + fr) & (SEQ - 1);
#pragma unroll
                  for (int n = 0; n < 2; ++n) { rcb[n] = *(const f32x4*)(p.ropec() + pos0 * 32 + 8 * fq + 4 * n); rsb[n] = *(const f32x4*)(p.ropes() + pos0 * 32 + 8 * fq + 4 * n); } }
                ROWS_LOOP { const int row = ROW_OF; const int ix = ai * 4 + m; const float rs = rsa[ix];
                    f32x4 a0[2], a1[2];
#pragma unroll
                    for (int n = 0; n < 2; ++n) { a0[n] = acc[ai][0][m][n] * rs; a1[n] = acc[ai][1][m][n] * rs; }
                    if (isqk) { float ss = 0.f;
#pragma unroll
                        for (int n = 0; n < 2; ++n)
#pragma unroll
                            for (int j = 0; j < 4; ++j) ss += a0[n][j] * a0[n][j] + a1[n][j] * a1[n][j];
                        ss += __shfl_xor(ss, 16); ss += __shfl_xor(ss, 32);
                        const float rn = __builtin_amdgcn_rsqf(ss * (1.f / 64.f) + RMS_EPS);
#pragma unroll
                        for (int n = 0; n < 2; ++n) { a0[n] = a0[n] * rn * g0[n]; a1[n] = a1[n] * rn * g1[n]; } }
                    u32x4 o0, o1;
#pragma unroll
                    for (int n = 0; n < 2; ++n) { const f32x4 cc = rcb[n], sn = rsb[n];
                        const f32x4 r0 = a0[n] * cc - a1[n] * sn, r1 = a1[n] * cc + a0[n] * sn;
                        o0[2 * n] = cvtpk(r0[0], r0[1]); o0[2 * n + 1] = cvtpk(r0[2], r0[3]); o1[2 * n] = cvtpk(r1[0], r1[1]); o1[2 * n + 1] = cvtpk(r1[2], r1[3]); }
                    if (ix < 7) { const int posn = (u.pm * 256 + ((ix + 1) >> 2) * 128 + wr * 64 + ((ix + 1) & 3) * 16 + fr) & (SEQ - 1);
#pragma unroll
                        for (int n = 0; n < 2; ++n) { rcb[n] = *(const f32x4*)(p.ropec() + posn * 32 + 8 * fq + 4 * n); rsb[n] = *(const f32x4*)(p.ropes() + posn * 32 + 8 * fq + 4 * n); } }
                    u16* d = dst + (size_t)row * pitch + head * 64 + 8 * fq;
                    *(u32x4*)d = o0; *(u32x4*)(d + 32) = o1; }
            }
        } else {
            u16* dst; int cb; int kind;
            if (pn < 14) { dst = p.v(); cb = (pn - 12) * 256; kind = 0; }
            else if (pn < 16) { dst = p.sg(); cb = (pn - 14) * 256; kind = 1; }
            else if (pn < 21) { dst = p.u(); cb = (pn - 19) * 256; kind = 0; }
            else { dst = p.sp(); cb = (pn - 21) * 256; kind = 2; }
            f32x4 sc[2][2];
#pragma unroll
            for (int bj = 0; bj < 2; ++bj)
#pragma unroll
                for (int n = 0; n < 2; ++n) sc[bj][n] = (kind == 2) ? *(const f32x4*)(p.pool_scale + l * 512 + cb + 16 * cl + bj * 8 + n * 4) : (f32x4){1.f, 1.f, 1.f, 1.f};
            ROWS_LOOP { const int row = ROW_OF; const float rs = rsa[ai * 4 + m];
#pragma unroll
                for (int bj = 0; bj < 2; ++bj) { f32x4 v0 = acc[ai][bj][m][0] * rs, v1 = acc[ai][bj][m][1] * rs;
                    if (kind >= 1) {
#pragma unroll
                        for (int j = 0; j < 4; ++j) { v0[j] = siluf(v0[j]) * sc[bj][0][j]; v1[j] = siluf(v1[j]) * sc[bj][1][j]; } }
                    u32x4 w; w[0] = cvtpk(v0[0], v0[1]); w[1] = cvtpk(v0[2], v0[3]); w[2] = cvtpk(v1[0], v1[1]); w[3] = cvtpk(v1[2], v1[3]);
                    *(u32x4*)(dst + (size_t)row * 512 + cb + 16 * cl + bj * 8) = w; } }
        }
    }
};
__device__ __forceinline__ void phase_in(const Params& p, int l, char* shm) {
    pg8::Gemm g{p.xb(), p.wt_in() + (size_t)l * NPA * 1024, T, NPA, 1024};
    pg8::StaticOrder S; S.init(T, NPA, GDIM(), BID());
    EpiIn E{p, l};
    pg8::gemm_phase((PG8_LAS unsigned char*)shm, g, S, E);
}
__device__ __forceinline__ void phase_mix(const Params& p, int l) {
    const float* cw = p.conv_w + l * 3 * 512;
    constexpr int RUN = 16;
    const int nitem = (T / RUN) * 256;
    const int it0 = BID() * NTHR + TID(), itstep = GDIM() * NTHR;
    for (int it = it0; it < nitem; it += itstep) {
        const int cp = it & 255, c = cp * 2, t0 = (it >> 8) * RUN, pos0 = t0 & (SEQ - 1);
        {
            const float w00 = cw[c], w01 = cw[c + 1], w10 = cw[512 + c], w11 = cw[513 + c], w20 = cw[1024 + c], w21 = cw[1025 + c];
            unsigned zr[RUN + 2], gr[RUN];
#pragma unroll
            for (int i = 0; i < RUN + 2; ++i) zr[i] = (pos0 + i - 2 >= 0) ? *(const unsigned*)(p.z() + (size_t)(t0 + i - 2) * 512 + c) : 0u;
#pragma unroll
            for (int i = 0; i < RUN; ++i) gr[i] = *(const unsigned*)(p.ga() + (size_t)(t0 + i) * 512 + c);
#pragma unroll
            for (int i = 0; i < RUN; ++i) {
                const float y0 = (w00 * bflo(zr[i]) + w10 * bflo(zr[i + 1]) + w20 * bflo(zr[i + 2])) * bflo(gr[i]);
                const float y1 = (w01 * bfhi(zr[i]) + w11 * bfhi(zr[i + 1]) + w21 * bfhi(zr[i + 2])) * bfhi(gr[i]);
                *(unsigned*)(p.ga() + (size_t)(t0 + i) * 512 + c) = cvtpk(y0, y1);
            }
        }
        {
            const int win = 2 << (c >> 7);
            unsigned ur[RUN + 15], gr[RUN];
#pragma unroll
            for (int i = 0; i < RUN + 15; ++i) ur[i] = (i >= 16 - win && pos0 + i - 15 >= 0) ? *(const unsigned*)(p.u() + (size_t)(t0 + i - 15) * 512 + c) : 0u;
#pragma unroll
            for (int i = 0; i < RUN; ++i) gr[i] = *(const unsigned*)(p.sp() + (size_t)(t0 + i) * 512 + c);
            float s0 = 0.f, s1 = 0.f;
#pragma unroll
            for (int i = 0; i < 15; ++i) { s0 += bflo(ur[i]); s1 += bfhi(ur[i]); }
#pragma unroll
            for (int i = 0; i < RUN; ++i) {
                const int pos = pos0 + i;
                const float u0 = bflo(ur[i + 15]), u1 = bfhi(ur[i + 15]);
                s0 += u0; s1 += u1;
                const float ic = __builtin_amdgcn_rcpf((float)min(pos + 1, win));
                *(unsigned*)(p.sp() + (size_t)(t0 + i) * 512 + c) = cvtpk((s0 * ic - u0) * bflo(gr[i]), (s1 * ic - u1) * bfhi(gr[i]));
                unsigned wo = 0u;
#pragma unroll
                for (int g = 0; g < 4; ++g) if (win == (2 << g)) wo = ur[i + 15 - ((2 << g) - 1)];
                s0 -= bflo(wo); s1 -= bfhi(wo);
            }
        }
    }
}

__device__ __forceinline__ int crow(int r, int hi) { return (r & 3) + 8 * (r >> 2) + 4 * hi; }
__device__ __forceinline__ size_t sc_base(int qb) { return (size_t)32768 * qb * (qb + 1); }
__device__ __forceinline__ void phase_indexer(const Params& p, int b) {
    const int tid_ = TID(); const int wid = tid_ >> 6, lane = tid_ & 63, ql = lane & 15, fq = lane >> 4; const int bid_ = BID(), gdim_ = GDIM();
    constexpr int NSTEP = 64 * 65;
    const int f0 = (int)(((long)bid_ * NSTEP) / gdim_), f1 = (int)(((long)(bid_ + 1) * NSTEP) / gdim_);
    int qcur = -1;
    bf16x8 bq[8][2]; float wv[8]; u16* srow = nullptr; int qloc = 0;
#pragma unroll
    for (int h = 0; h < 8; ++h) { wv[h] = 0.f; bq[h][0] = bq[h][1] = (bf16x8){0, 0, 0, 0, 0, 0, 0, 0}; }
    const u16* ikb = p.ik() + ((size_t)b * SEQ + ql) * 64 + fq * 8;
    for (int f = f0; f < f1; ++f) {
        int q = (int)((sqrtf(4.f * f + 1.f) - 1.f) * 0.5f);
        while ((q + 1) * (q + 2) <= f) ++q;
        while (q * (q + 1) > f) --q;
        const int tt = f - q * (q + 1);
        if (q != qcur) {
            qcur = q; qloc = q * 128 + wid * 16 + ql;
            const size_t row = (size_t)b * SEQ + qloc;
#pragma unroll
            for (int h = 0; h < 8; ++h)
#pragma unroll
                for (int kc = 0; kc < 2; ++kc) bq[h][kc] = *(const bf16x8*)(p.iq() + row * 512 + h * 64 + kc * 32 + fq * 8);
            const f32x4 x = *(const f32x4*)(p.iw() + row * 8), y = *(const f32x4*)(p.iw() + row * 8 + 4);
            wv[0] = x[0]; wv[1] = x[1]; wv[2] = x[2]; wv[3] = x[3]; wv[4] = y[0]; wv[5] = y[1]; wv[6] = y[2]; wv[7] = y[3];
            const int a = q >> 1;
            srow = p.scores() + sc_base(a) + (size_t)(qloc - a * 256) * (256 * (a + 1));
        }
        const int key0 = tt * 64;
        bf16x8 ka[4][2];
#pragma unroll
        for (int kg = 0; kg < 4; ++kg)
#pragma unroll
            for (int kc = 0; kc < 2; ++kc) ka[kg][kc] = *(const bf16x8*)(ikb + (size_t)(key0 + kg * 16) * 64 + kc * 32);
        const bool band = (key0 + 63 > q * 128 + wid * 16);
#pragma unroll
        for (int kg = 0; kg < 4; ++kg) {
            f32x4 sacc = (f32x4){0.f, 0.f, 0.f, 0.f};
#pragma unroll
            for (int h = 0; h < 8; ++h) {
                f32x4 c = (f32x4){0.f, 0.f, 0.f, 0.f};
                c = __builtin_amdgcn_mfma_f32_16x16x32_bf16(ka[kg][0], bq[h][0], c, 0, 0, 0);
                c = __builtin_amdgcn_mfma_f32_16x16x32_bf16(ka[kg][1], bq[h][1], c, 0, 0, 0);
#pragma unroll
                for (int j = 0; j < 4; ++j) sacc[j] = __builtin_fmaf(wv[h], __builtin_fmaxf(c[j], 0.f), sacc[j]);
            }
            const int kb = key0 + kg * 16 + fq * 4;
            if (band) {
#pragma unroll
                for (int j = 0; j < 4; ++j) if (kb + j > qloc) sacc[j] = -INFINITY;
            }
            union { _Float16 h[4]; u32x2 v; } pk;
            pk.h[0] = (_Float16)sacc[0]; pk.h[1] = (_Float16)sacc[1]; pk.h[2] = (_Float16)sacc[2]; pk.h[3] = (_Float16)sacc[3];
            *(u32x2*)(srow + kb) = pk.v;
        }
    }
}

__device__ __forceinline__ size_t mk_base(int qb) { return (size_t)512 * qb * (qb + 1); }
constexpr size_t MASK_WORDS_PER_BATCH = 540672;
__device__ __forceinline__ unsigned f16key(unsigned h) { return (h & 0x8000u) ? (~h & 0xffffu) : (h | 0x8000u); }
__device__ __forceinline__ void hist_scan(const unsigned* h, int lane, unsigned target, int& bin, unsigned& above, unsigned& inbin) {
    const u32x4 a = *(const u32x4*)(h + 4 * lane), b = *(const u32x4*)(h + 256 + 4 * lane), c = *(const u32x4*)(h + 512 + 4 * lane), d = *(const u32x4*)(h + 768 + 4 * lane);
    const unsigned h0 = a[0] + b[0] + c[0] + d[0], h1 = a[1] + b[1] + c[1] + d[1], h2 = a[2] + b[2] + c[2] + d[2], h3 = a[3] + b[3] + c[3] + d[3];
    const unsigned tot = h0 + h1 + h2 + h3;
    unsigned x = tot;
#pragma unroll
    for (int dd = 1; dd < 64; dd <<= 1) { const unsigned y = __shfl_down(x, dd); if (lane + dd < 64) x += y; }
    const unsigned ab = x - tot, c3 = ab + h3, c2 = c3 + h2, c1 = c2 + h1, c0 = c1 + h0;
    int fb = -1; unsigned fa = 0, fc = 0;
    if (ab < target && c3 >= target) { fb = 4 * lane + 3; fa = ab; fc = h3; }
    else if (c3 < target && c2 >= target) { fb = 4 * lane + 2; fa = c3; fc = h2; }
    else if (c2 < target && c1 >= target) { fb = 4 * lane + 1; fa = c2; fc = h1; }
    else if (c1 < target && c0 >= target) { fb = 4 * lane; fa = c1; fc = h0; }
    const u64 m = __ballot(fb >= 0); const int src = (m == 0) ? 0 : (__ffsll((unsigned long long)m) - 1);
    bin = __shfl(fb, src); above = __shfl(fa, src); inbin = __shfl(fc, src);
}
__device__ __forceinline__ unsigned f16key2(unsigned w) { const unsigned sg = (w >> 15) & 0x00010001u; return w ^ (((sg << 15) - sg) | 0x80008000u); }
__device__ __forceinline__ void phase_select(const Params& p, int b, char* shm) {
    const int tid_ = TID(); const int wid = __builtin_amdgcn_readfirstlane(tid_ >> 6), lane = tid_ & 63;
    const int gw = BID() * 8 + wid, nw = GDIM() * 8;
    unsigned* hist = (unsigned*)shm + wid * 1152;
    const int hsubi = (lane >> 4) * 256, dummyi = 1024 + lane;
    typedef unsigned short us2 __attribute__((ext_vector_type(2)));
#define ROW_T(i_) ({ const int kq_ = (i_) / nw; ((kq_ & 1) ? (kq_ * nw + (nw - 1 - ((i_) - kq_ * nw))) : (i_)); })
#define ROW_LOAD(t_) do { const int qb_ = (t_) >> 8, ntr_ = 2 * (((t_) >> 7) + 1), nch_ = (ntr_ + 7) >> 3; \
        const u16* sr_ = p.scores() + sc_base(qb_) + (size_t)((t_) - qb_ * 256) * (256 * (qb_ + 1)); \
        _Pragma("unroll") for (int c = 0; c < 16; ++c) { raw[c] = (u32x4){0u, 0u, 0u, 0u}; if (c < nch_) { if (lane < 8 * (ntr_ - 8 * c)) raw[c] = *(const u32x4*)(sr_ + 512 * c + 8 * lane); } } } while (0)
    u32x4 raw[16];
    if (gw < SEQ) { const int t0_ = ROW_T(gw); ROW_LOAD(t0_); }
    for (int i = gw; i < SEQ; i += nw) {
        const int t = ROW_T(i);
        const int qb = t >> 8, ntile = 4 * (qb + 1), ntr = 2 * ((t >> 7) + 1);
        const int nch = (ntr + 7) >> 3, nchw = (ntile + 7) >> 3;
        unsigned char* mrow = (unsigned char*)(p.mask() + (size_t)b * MASK_WORDS_PER_BATCH + mk_base(qb) + (size_t)(t - qb * 256) * ntile);
        unsigned key[16][4];
#pragma unroll
        for (int c = 0; c < 16; ++c) {
            const bool valid = (c < nch) && (lane < 8 * (ntr - 8 * c));
#pragma unroll
            for (int r = 0; r < 4; ++r) key[c][r] = valid ? f16key2(raw[c][r]) : 0u;
        }
        if (i + nw < SEQ) { const int tn_ = ROW_T(i + nw); ROW_LOAD(tn_); }
        unsigned thrm1 = 0x03ffu, thr = 0x0400u; int need = 0; bool fast = true;
        if (t >= 256) {
            us2 a1 = (us2){0, 0}, a2 = (us2){0, 0};
#pragma unroll
            for (int c = 0; c < 16; ++c) {
                if (c < nch) {
#pragma unroll
                    for (int r = 0; r < 4; ++r) { const us2 kk = __builtin_bit_cast(us2, key[c][r]);
                        const us2 tmx = __builtin_elementwise_max(a1, kk), tmn = __builtin_elementwise_min(a1, kk); a1 = tmx; a2 = __builtin_elementwise_max(a2, tmn); }
                }
            }
            unsigned Lb = min((unsigned)a2[0], (unsigned)a2[1]);
#pragma unroll
            for (int m_ = 32; m_ >= 1; m_ >>= 1) Lb = min(Lb, (unsigned)__shfl_xor((int)Lb, m_));
            Lb = __builtin_amdgcn_readfirstlane(Lb);
            const u32x4 z4 = (u32x4){0u, 0u, 0u, 0u};
#pragma unroll
            for (int c = 0; c < 4; ++c) *(u32x4*)(hist + c * 256 + 4 * lane) = z4;
#pragma unroll
            for (int c = 0; c < 16; ++c) {
                if (c < nch) {
#pragma unroll
                    for (int r = 0; r < 4; ++r) { const unsigned kk = key[c][r]; const unsigned lo = kk & 0xffffu, hi = kk >> 16;
                        atomicAdd(hist + ((lo >= Lb) ? (hsubi + (int)(lo >> 8)) : dummyi), 1u);
                        atomicAdd(hist + ((hi >= Lb) ? (hsubi + (int)(hi >> 8)) : dummyi), 1u); }
                }
            }
            asm volatile("s_waitcnt lgkmcnt(0)" ::: "memory");
            int B1; unsigned ab1, in1;
            hist_scan(hist, lane, 256u, B1, ab1, in1);
            asm volatile("s_waitcnt lgkmcnt(0)" ::: "memory");
#pragma unroll
            for (int c = 0; c < 4; ++c) *(u32x4*)(hist + c * 256 + 4 * lane) = z4;
#pragma unroll
            for (int c = 0; c < 16; ++c) {
                if (c < nch) {
#pragma unroll
                    for (int r = 0; r < 4; ++r) { const unsigned kk = key[c][r]; const unsigned lo = kk & 0xffffu, hi = kk >> 16;
                        const bool ml = ((lo >> 8) == (unsigned)B1) && (lo >= Lb), mh = ((hi >> 8) == (unsigned)B1) && (hi >= Lb);
                        if (__any(ml || mh)) { if (ml) atomicAdd(hist + hsubi + (int)(lo & 255u), 1u); if (mh) atomicAdd(hist + hsubi + (int)(hi & 255u), 1u); } }
                }
            }
            asm volatile("s_waitcnt lgkmcnt(0)" ::: "memory");
            int B2; unsigned ab2, in2;
            hist_scan(hist, lane, 256u - ab1, B2, ab2, in2);
            asm volatile("s_waitcnt lgkmcnt(0)" ::: "memory");
            thr = __builtin_amdgcn_readfirstlane(((unsigned)B1 << 8) | (unsigned)B2);
            need = __builtin_amdgcn_readfirstlane(256 - (int)(ab1 + ab2));
            const int neq = __builtin_amdgcn_readfirstlane((int)in2);
            fast = (need == neq);
            thrm1 = thr - 1u;
        }
        if (fast) {
#pragma unroll
            for (int c = 0; c < 16; ++c) {
                if (c < nchw) {
                    unsigned m = 0u;
#pragma unroll
                    for (int ii = 7; ii >= 0; --ii) { const unsigned kk = key[c][ii >> 1]; const unsigned kv = (ii & 1) ? (kk >> 16) : (kk & 0xffffu); m = m + m + ((kv > thrm1) ? 1u : 0u); }
                    if (64 * c + lane < 8 * ntile) mrow[64 * c + lane] = (unsigned char)m;
                }
            }
        } else {
            int base = 0;
#pragma unroll 1
            for (int c = 0; c < 16; ++c) {
                if (c < nchw) {
                    unsigned m = 0u, e = 0u;
#pragma unroll
                    for (int ii = 7; ii >= 0; --ii) { unsigned kk = (ii >> 1) == 0 ? key[0][0] : 0u;
#pragma unroll
                        for (int cc = 0; cc < 16; ++cc) if (cc == c) kk = key[cc][ii >> 1];
                        const unsigned kv = (ii & 1) ? (kk >> 16) : (kk & 0xffffu); m = m + m + ((kv > thr) ? 1u : 0u); e = e + e + ((kv == thr) ? 1u : 0u); }
                    const int cnt = __builtin_popcount(e);
                    int pre = cnt;
#pragma unroll
                    for (int dd = 1; dd < 64; dd <<= 1) { const int y = __shfl_up(pre, dd); if (lane >= dd) pre += y; }
                    const int tot = __shfl(pre, 63);
                    int rank = base + pre - cnt;
#pragma unroll
                    for (int ii = 0; ii < 8; ++ii) if ((e >> ii) & 1u) { if (rank < need) m |= (1u << ii); ++rank; }
                    base += tot;
                    if (64 * c + lane < 8 * ntile) mrow[64 * c + lane] = (unsigned char)m;
                }
            }
        }
    }
}

constexpr int A_D = 64, A_DM = 512, A_NW = 8, A_QBLK = 32, A_QB = 256, A_KVBLK = 64, A_NQB = SEQ / A_QB, A_NHEAD = 8;
constexpr float A_C2 = 0.125f * 1.4426950408889634f;
constexpr int A_SLOTB = 8192, A_LDS_K = 0, A_LDS_V = 3 * A_SLOTB, A_LDS_WS = 6 * A_SLOTB, A_LDS_OST = A_LDS_WS + A_NW * 256, A_LDS_MK = A_LDS_OST + A_NW * 4096, A_LDS_BYTES = A_LDS_MK + A_NW * 2048;
#define ATTN_THR 8
#define SBAR() __builtin_amdgcn_sched_barrier(0)
#define PIN(x) asm volatile("" : "+v"(x))
#define MFMA32(a, b, c) __builtin_amdgcn_mfma_f32_32x32x16_bf16(a, b, c, 0, 0, 0)
#define WAIT_BAR(N) asm volatile("s_waitcnt vmcnt(" #N ") lgkmcnt(0)\n\ts_barrier" ::: "memory")
__device__ __forceinline__ void glds16s(const void* sbase, unsigned voff, unsigned lds_base) {
    unsigned sv; asm volatile("s_mov_b32 %0, m0\n\ts_mov_b32 m0, %3\n\ts_nop 0\n\tglobal_load_lds_dwordx4 %1, %2\n\ts_mov_b32 m0, %0" : "=&s"(sv) : "v"(voff), "s"(sbase), "s"(lds_base) : "memory"); }
typedef __attribute__((address_space(3))) const char* lds_cptr;
typedef short v4i16_t __attribute__((ext_vector_type(4)));
__device__ __forceinline__ void kload2(bf16x8* kf, lds_cptr kp, int d0) { kf[2 * d0] = *(const __attribute__((address_space(3))) bf16x8*)(kp + d0 * 2048); kf[2 * d0 + 1] = *(const __attribute__((address_space(3))) bf16x8*)(kp + d0 * 2048 + 512); }
__device__ __forceinline__ s16x4 vtr(lds_cptr p) { return __builtin_bit_cast(s16x4, __builtin_amdgcn_ds_read_tr16_b64_v4i16((__attribute__((address_space(3))) v4i16_t*)p)); }
#define MX3(a, b, c) __builtin_fmaxf(__builtin_fmaxf((a), (b)), (c))
__device__ __forceinline__ float rowmax(const f32x16& p0, const f32x16& p1) {
    float a = MX3(p0[0], p0[1], p1[0]), b = MX3(p0[2], p0[3], p1[1]); a = MX3(a, p1[2], p1[3]);
#pragma unroll
    for (int r = 4; r < 16; r += 4) { a = MX3(a, p0[r], p0[r + 1]); b = MX3(b, p0[r + 2], p0[r + 3]); a = MX3(a, p1[r], p1[r + 1]); b = MX3(b, p1[r + 2], p1[r + 3]); }
    float m = __builtin_fmaxf(a, b); auto rr = __builtin_amdgcn_permlane32_swap(__float_as_uint(m), __float_as_uint(m), false, false);
    return __builtin_fmaxf(__uint_as_float(rr[0]), __uint_as_float(rr[1])); }
__device__ __forceinline__ void cmask(f32x16& p0, f32x16& p1, int jb, int qrel, int hi) {
    const int kb = 64 * jb + 4 * hi;
#pragma unroll
    for (int r = 0; r < 16; ++r) { const int kv = kb + (r & 3) + 8 * (r >> 2); if (kv > qrel) p0[r] = -INFINITY; if (kv + 32 > qrel) p1[r] = -INFINITY; } }
__device__ __forceinline__ float mand(float x, unsigned w, int pos) { return __uint_as_float(__float_as_uint(x) & (unsigned)__builtin_amdgcn_sbfe((int)w, pos, 1)); }
#define BITP(i) (((i) & 3) + 8 * ((i) >> 2))

__device__ __forceinline__ void attn64_unit(int b, int h, int qb, const u16* Q, const u16* __restrict__ K, const u16* __restrict__ V, const u16* __restrict__ SG, u16* O, const u64* mrow0, char* lds) {
    const int tid = TID(), lane = tid & 63, r32 = lane & 31, hi = lane >> 5; const int wid = __builtin_amdgcn_readfirstlane(tid >> 6);
    const long rowbase = (long)b * SEQ; const int q0 = qb * A_QB, NT = (q0 + A_QB) / A_KVBLK;
    const u16* Qw = Q + (rowbase + q0 + wid * A_QBLK) * A_DM + h * A_D;
    const unsigned lds0 = (unsigned)(uintptr_t)lds; float* wsf = (float*)(lds + A_LDS_WS) + wid * 64;
    const u16* kbase = K + rowbase * A_DM + h * A_D; const u16* vbase = V + rowbase * A_DM + h * A_D;
    const unsigned koff = (unsigned)(lane * A_DM + wid * 8) * 2u;
    const unsigned voff = (unsigned)((16 * (wid & 3) + (lane >> 2)) * A_DM + (wid >> 2) * 32 + (lane & 3) * 8) * 2u;
    const unsigned kdst = lds0 + A_LDS_K + wid * 1024, vdst = lds0 + A_LDS_V + wid * 1024;
#define DMA_K(t, slot) glds16s(kbase + (long)(t) * A_KVBLK * A_DM, koff, (unsigned)__builtin_amdgcn_readfirstlane(kdst + (slot)))
#define DMA_V(t, slot) glds16s(vbase + (long)(t) * A_KVBLK * A_DM, voff, (unsigned)__builtin_amdgcn_readfirstlane(vdst + (slot)))
#define DMA_M(chunk) glds16s(mrow0 + 2 * (chunk), moff, (unsigned)__builtin_amdgcn_readfirstlane(mdst + ((chunk) & 1) * 1024))
#define MWORD(t) (*(const u64*)(lds + A_LDS_MK + wid * 2048 + (((t) >> 1) & 1) * 1024 + r32 * 16 + ((t) & 1) * 8))
    const lds_cptr vp0 = (lds_cptr)lds + A_LDS_V + ((lane >> 4) & 1) * 32 + (lane & 3) * 8 + (4 * hi + ((lane & 15) >> 2)) * 64;
    const lds_cptr kp0 = (lds_cptr)lds + A_LDS_K + hi * 1024 + r32 * 16;
    const int qrel = wid * A_QBLK + r32;
    const unsigned moff = (unsigned)(qrel * NT) * 8u;
    const unsigned mdst = lds0 + A_LDS_MK + wid * 2048;
    DMA_M(0);
    DMA_K(0, 0); DMA_V(0, 0); DMA_K(1, A_SLOTB);
    bf16x8 qr[4];
#pragma unroll
    for (int d0 = 0; d0 < 4; ++d0) qr[d0] = *reinterpret_cast<const bf16x8*>(&Qw[(long)r32 * A_DM + d0 * 16 + hi * 8]);
    float mhat = 0.f, l_reg = 0.f; f32x16 o[2]; o[0] = f32x16{}; o[1] = f32x16{};
    const f32x16 zero16 = f32x16{};
    bool resc = false;
    f32x16 pA0, pA1, pB0, pB1; bf16x8 kf[8]; s16x4 vlo[8], vhi[8]; u32x4 pw0, pw1, pw2, pw3;
    int sl_prev = 0, sl_cur = 0, sl_next = A_SLOTB;
    const int sh4 = 4 * hi;
#define ROT() do { sl_prev = sl_cur; sl_cur = sl_next; sl_next = (sl_next == 2 * A_SLOTB) ? 0 : sl_next + A_SLOTB; } while (0)
#define EX(v) __builtin_amdgcn_exp2f(__builtin_fmaf((v), A_C2, nmh))
#define RESC() do { if (resc) { _Pragma("unroll") for (int d_ = 0; d_ < 2; ++d_) _Pragma("unroll") for (int r = 0; r < 16; ++r) o[d_][r] *= wsf[crow(r, hi)]; } } while (0)
    DMA_K(2, 2 * A_SLOTB);
    WAIT_BAR(3);
    _Pragma("unroll") for (int d0 = 0; d0 < 4; ++d0) kload2(kf, kp0, d0);
    pA0 = MFMA32(kf[0], qr[0], zero16); pA1 = MFMA32(kf[1], qr[0], zero16); pA0 = MFMA32(kf[2], qr[1], pA0); pA1 = MFMA32(kf[3], qr[1], pA1);
    pA0 = MFMA32(kf[4], qr[2], pA0); pA1 = MFMA32(kf[5], qr[2], pA1); pA0 = MFMA32(kf[6], qr[3], pA0); pA1 = MFMA32(kf[7], qr[3], pA1);
    { const float rm = rowmax(pA0, pA1); mhat = rm * A_C2; const float nmh = -mhat;
      const u64 mw0 = MWORD(0); const unsigned wl = (unsigned)mw0 >> sh4, wh = (unsigned)(mw0 >> 32) >> sh4;
#pragma unroll
      for (int r = 0; r < 16; ++r) { pA0[r] = mand(EX(pA0[r]), wl, BITP(r)); pA1[r] = mand(EX(pA1[r]), wh, BITP(r)); } }
    WAIT_BAR(0);
    DMA_K(3, 0); DMA_V(1, A_SLOTB); ROT();
    _Pragma("unroll") for (int d0 = 0; d0 < 4; ++d0) kload2(kf, kp0 + sl_cur, d0);
    WAIT_BAR(2);
#define PKW(P, i) cvtpk(P[i], P[i + 1])
#define PAF(k) __builtin_bit_cast(bf16x8, pw##k)
#define VFR(i) (bf16x8){vlo[i][0], vlo[i][1], vlo[i][2], vlo[i][3], vhi[i][0], vhi[i][1], vhi[i][2], vhi[i][3]}
#define VRD(i) do { vlo[i] = vtr(vp_ + (((i) >> 2) * 4096 + ((i) & 3) * 1024)); vhi[i] = vtr(vp_ + (((i) >> 2) * 4096 + ((i) & 3) * 1024 + 512)); } while (0)
#define KRD(G, d0) do { if (G) { kload2(kf, kp0 + sl_next, d0); SBAR(); } } while (0)
#define GAPA(MF, a0, a1, a2, a3, W0, W1, PW) do { MF; sacc += a0; sacc += a1; sacc += a2; sacc += a3; W0; W1; PIN(PW); PIN(sacc); SBAR(); } while (0)
#define GAPB(MF, X, i, W) do { MF; X[i] = mand(EX(X[i]), W, BITP(i)); X[i + 1] = mand(EX(X[i + 1]), W, BITP(i + 1)); X[i + 2] = mand(EX(X[i + 2]), W, BITP(i + 2)); X[i + 3] = mand(EX(X[i + 3]), W, BITP(i + 3)); PIN(X); SBAR(); } while (0)
#define STEP(C0, C1, P0, P1, t, MASK, GK, GV, GL, ML) do { SBAR(); \
    if (ML) DMA_M(((t) + 1) >> 1); \
    const u64 mw_ = MWORD(t); \
    const lds_cptr vp_ = vp0 + sl_prev; \
    VRD(0); SBAR(); float sacc = P0[0] + P0[1]; \
                    GAPA(C0 = MFMA32(kf[0], qr[0], zero16), P0[2], P0[3], P0[4], P0[5],     pw0[0] = PKW(P0, 0),  pw0[1] = PKW(P0, 2),  pw0); \
    VRD(4); SBAR(); GAPA(C1 = MFMA32(kf[1], qr[0], zero16), P0[6], P0[7], P0[8], P0[9],     pw0[2] = PKW(P0, 4),  pw0[3] = PKW(P0, 6),  pw0); \
    VRD(1); SBAR(); GAPA(C0 = MFMA32(kf[2], qr[1], C0),    P0[10], P0[11], P0[12], P0[13], pw1[0] = PKW(P0, 8),  pw1[1] = PKW(P0, 10), pw1); \
    VRD(5); SBAR(); GAPA(C1 = MFMA32(kf[3], qr[1], C1),    P0[14], P0[15], P1[0], P1[1],   pw1[2] = PKW(P0, 12), pw1[3] = PKW(P0, 14), pw1); \
    VRD(2); SBAR(); GAPA(C0 = MFMA32(kf[4], qr[2], C0),    P1[2], P1[3], P1[4], P1[5],     pw2[0] = PKW(P1, 0),  pw2[1] = PKW(P1, 2),  pw2); \
    VRD(6); SBAR(); GAPA(C1 = MFMA32(kf[5], qr[2], C1),    P1[6], P1[7], P1[8], P1[9],     pw2[2] = PKW(P1, 4),  pw2[3] = PKW(P1, 6),  pw2); \
    VRD(3); SBAR(); GAPA(C0 = MFMA32(kf[6], qr[3], C0),    P1[10], P1[11], P1[12], P1[13], pw3[0] = PKW(P1, 8),  pw3[1] = PKW(P1, 10), pw3); \
    VRD(7); SBAR(); GAPA(C1 = MFMA32(kf[7], qr[3], C1),    P1[14], P1[15], 0.f, 0.f,       pw3[2] = PKW(P1, 12), pw3[3] = PKW(P1, 14), pw3); \
    l_reg += sacc; \
    if (GK) DMA_K((t) + 3, sl_cur); if (GV) DMA_V((t) + 1, sl_next); \
    { const float rm = __builtin_fmaf(rowmax(C0, C1), A_C2, -mhat); resc = false; \
      if (__builtin_expect(__any(rm > (float)ATTN_THR), 0)) { const float dl = __builtin_fmaxf(rm, 0.f); mhat += dl; \
          const float f = __builtin_amdgcn_exp2f(-dl); l_reg *= f; if (hi == 0) wsf[r32] = f; resc = true; } } \
    const float nmh = -mhat; const unsigned wl_ = (unsigned)(mw_) >> sh4, wh_ = (unsigned)((mw_) >> 32) >> sh4; SBAR(); \
    GAPB(o[0] = MFMA32(PAF(0), VFR(0), o[0]), C0, 0, wl_);              GAPB(o[1] = MFMA32(PAF(0), VFR(4), o[1]), C0, 4, wl_); \
    KRD(GL, 0); GAPB(o[0] = MFMA32(PAF(1), VFR(1), o[0]), C0, 8, wl_);  KRD(GL, 1); GAPB(o[1] = MFMA32(PAF(1), VFR(5), o[1]), C0, 12, wl_); \
    KRD(GL, 2); GAPB(o[0] = MFMA32(PAF(2), VFR(2), o[0]), C1, 0, wh_);  KRD(GL, 3); GAPB(o[1] = MFMA32(PAF(2), VFR(6), o[1]), C1, 4, wh_); \
    GAPB(o[0] = MFMA32(PAF(3), VFR(3), o[0]), C1, 8, wh_);              GAPB(o[1] = MFMA32(PAF(3), VFR(7), o[1]), C1, 12, wh_); \
    } while (0)
    int t = 1;
    for (; t + 5 < NT; t += 2) {
        STEP(pB0, pB1, pA0, pA1, t, false, true, true, true, true);      WAIT_BAR(2); RESC(); ROT();
        STEP(pA0, pA1, pB0, pB1, t + 1, false, true, true, true, false); WAIT_BAR(2); RESC(); ROT();
    }
#define ENDW(tt) do { if ((tt) + 3 < NT) { WAIT_BAR(2); } else if ((tt) + 2 < NT) { WAIT_BAR(1); } else { WAIT_BAR(0); } } while (0)
    for (; t + 1 < NT; t += 2) {
        STEP(pB0, pB1, pA0, pA1, t, true, (t + 3 < NT), (t + 1 < NT), (t + 1 < NT), (t + 1 < NT));         ENDW(t);     RESC(); ROT();
        STEP(pA0, pA1, pB0, pB1, t + 1, true, (t + 4 < NT), (t + 2 < NT), (t + 2 < NT), false);            ENDW(t + 1); RESC(); ROT();
    }
    STEP(pB0, pB1, pA0, pA1, NT - 1, true, false, false, false, false); RESC();
    { float sacc = pB0[0] + pB0[1];
#pragma unroll
      for (int r = 2; r < 16; ++r) sacc += pB0[r];
#pragma unroll
      for (int r = 0; r < 16; ++r) sacc += pB1[r];
      l_reg += sacc;
      pw0 = (u32x4){PKW(pB0, 0), PKW(pB0, 2), PKW(pB0, 4), PKW(pB0, 6)}; pw1 = (u32x4){PKW(pB0, 8), PKW(pB0, 10), PKW(pB0, 12), PKW(pB0, 14)};
      pw2 = (u32x4){PKW(pB1, 0), PKW(pB1, 2), PKW(pB1, 4), PKW(pB1, 6)}; pw3 = (u32x4){PKW(pB1, 8), PKW(pB1, 10), PKW(pB1, 12), PKW(pB1, 14)};
      const lds_cptr vp_ = vp0 + sl_cur; _Pragma("unroll") for (int i = 0; i < 8; ++i) VRD(i);
      o[0] = MFMA32(PAF(0), VFR(0), o[0]); o[1] = MFMA32(PAF(0), VFR(4), o[1]); o[0] = MFMA32(PAF(1), VFR(1), o[0]); o[1] = MFMA32(PAF(1), VFR(5), o[1]);
      o[0] = MFMA32(PAF(2), VFR(2), o[0]); o[1] = MFMA32(PAF(2), VFR(6), o[1]); o[0] = MFMA32(PAF(3), VFR(3), o[0]); o[1] = MFMA32(PAF(3), VFR(7), o[1]); }
    { auto rr = __builtin_amdgcn_permlane32_swap(__float_as_uint(l_reg), __float_as_uint(l_reg), false, false); l_reg = __uint_as_float(rr[0]) + __uint_as_float(rr[1]); }
    if (hi == 0) wsf[32 + r32] = l_reg; asm volatile("s_waitcnt lgkmcnt(0)" ::: "memory");
    float rli[16];
#pragma unroll
    for (int r = 0; r < 16; ++r) rli[r] = __builtin_amdgcn_rcpf(wsf[32 + crow(r, hi)]);
    u16* Ow = O + (rowbase + q0 + wid * A_QBLK) * A_DM + h * A_D; const u16* Gw = SG + (rowbase + q0 + wid * A_QBLK) * A_DM + h * A_D;
    u16* stg = (u16*)(lds + A_LDS_OST) + wid * 2048;
#pragma unroll
    for (int r = 0; r < 16; ++r) { const int orow = crow(r, hi);
#pragma unroll
        for (int d0 = 0; d0 < 2; ++d0) stg[orow * 64 + d0 * 32 + r32] = f2bf(o[d0][r] * rli[r]); }
    asm volatile("s_waitcnt lgkmcnt(0)" ::: "memory");
#pragma unroll
    for (int i = 0; i < 4; ++i) { const int row = i * 8 + (lane >> 3), ch = lane & 7;
        u32x4 ov = *(const u32x4*)(stg + row * 64 + ch * 8); u32x4 gv = *(const u32x4*)(Gw + (long)row * A_DM + ch * 8); u32x4 rv;
#pragma unroll
        for (int e = 0; e < 4; ++e) rv[e] = cvtpk(bflo(ov[e]) * bflo(gv[e]), bfhi(ov[e]) * bfhi(gv[e]));
        *(u32x4*)(Ow + (long)row * A_DM + ch * 8) = rv; }
    asm volatile("s_waitcnt vmcnt(0) lgkmcnt(0)\n\ts_barrier" ::: "memory");
#undef DMA_K
#undef DMA_V
#undef DMA_M
#undef MWORD
#undef ROT
#undef EX
#undef RESC
#undef PKW
#undef PAF
#undef VFR
#undef VRD
#undef KRD
#undef ENDW
#undef GAPA
#undef GAPB
#undef STEP
}
__device__ __forceinline__ void phase_attn(const Params& p, char* lds) {
    constexpr int NPAIR = A_NQB / 2, NUNIT = NBATCH * A_NHEAD * NPAIR;
    const int bid_ = BID(), gdim_ = GDIM();
    for (int u = bid_; u < NUNIT; u += gdim_) {
        const int x = u & 7, kk = u >> 3, bh = x + 8 * (kk / NPAIR), j = kk % NPAIR;
        const int b = bh / A_NHEAD, h = bh % A_NHEAD;
        const u64* mb = p.mask() + (size_t)b * MASK_WORDS_PER_BATCH;
        attn64_unit(b, h, j, p.q(), p.k(), p.v(), p.sg(), p.bin(), mb + mk_base(j), lds);
        attn64_unit(b, h, A_NQB - 1 - j, p.q(), p.k(), p.v(), p.sg(), p.bin(), mb + mk_base(A_NQB - 1 - j), lds);
    }
}

struct EpiStash {
    static constexpr bool DUPOK = false;
    u16* stash;
    __device__ __forceinline__ void operator()(const acc_t& acc, const pg8::Unit& u, int ui, int wr, int wc, int fr, int fq) const {
        const int tid_ = TID();
        u32x4* st = (u32x4*)(stash + ((size_t)BID() * 2 + ui) * 65536);
        ROWS_LOOP {
#pragma unroll
            for (int bj = 0; bj < 2; ++bj) { const f32x4 v0 = acc[ai][bj][m][0], v1 = acc[ai][bj][m][1];
                u32x4 w; w[0] = cvtpk(v0[0], v0[1]); w[1] = cvtpk(v0[2], v0[3]); w[2] = cvtpk(v1[0], v1[1]); w[3] = cvtpk(v1[2], v1[3]);
                st[((ai * 4 + m) * 2 + bj) * 512 + tid_] = w; } }
    }
};
struct EpiGate {
    static constexpr bool DUPOK = false;
    const Params& p; int l; int br;
    __device__ __forceinline__ void operator()(const acc_t& acc, const pg8::Unit& u, int ui, int wr, int wc, int fr, int fq) const {
        const float* ssq = p.sumsq() + (size_t)(l & 1) * T * 16;
        const int tid_ = TID();
        const u32x4* st = (const u32x4*)(p.stash() + ((size_t)BID() * 2 + ui) * 65536);
        const int cl = wc * 4 + fq;
        __shared__ float s_rstd[256];
        { if (tid_ < 256) s_rstd[tid_] = row_rstd(ssq, u.pm * 256 + tid_); __syncthreads(); }
        float rsa[8];
#pragma unroll
        for (int ix = 0; ix < 8; ++ix) rsa[ix] = s_rstd[(ix >> 2) * 128 + wr * 64 + (ix & 3) * 16 + fr];
        const char* stp = (const char*)st + (size_t)tid_ * 16;
        char* mpp = (char*)(p.merged() + (size_t)(u.pm * 256 + wr * 64 + fr) * 1024 + u.pn * 256 + 16 * cl);
        u32x4 yb = *(const u32x4*)stp, ob = (br > 0) ? *(const u32x4*)mpp : (u32x4){0u, 0u, 0u, 0u};
        ROWS_LOOP { const int ix = ai * 4 + m; const float rs = rsa[ix];
#pragma unroll
            for (int bj = 0; bj < 2; ++bj) { const f32x4 v0 = acc[ai][bj][m][0] * rs, v1 = acc[ai][bj][m][1] * rs;
                float r[8];
                r[0] = sigmf(v0[0]) * bflo(yb[0]); r[1] = sigmf(v0[1]) * bfhi(yb[0]); r[2] = sigmf(v0[2]) * bflo(yb[1]); r[3] = sigmf(v0[3]) * bfhi(yb[1]);
                r[4] = sigmf(v1[0]) * bflo(yb[2]); r[5] = sigmf(v1[1]) * bfhi(yb[2]); r[6] = sigmf(v1[2]) * bflo(yb[3]); r[7] = sigmf(v1[3]) * bfhi(yb[3]);
                if (br > 0) {
#pragma unroll
                    for (int e = 0; e < 4; ++e) { r[2 * e] += bflo(ob[e]); r[2 * e + 1] += bfhi(ob[e]); } }
                u32x4 wo; wo[0] = cvtpk(r[0], r[1]); wo[1] = cvtpk(r[2], r[3]); wo[2] = cvtpk(r[4], r[5]); wo[3] = cvtpk(r[6], r[7]);
                const char* stn = stp + 8192; char* mpn = (bj == 0) ? (mpp + 16) : (mpp - 16 + ((ix == 3) ? 80 : 16) * 2048);
                asm volatile("" : "+v"(stn), "+v"(mpn));
                if (!(ix == 7 && bj == 1)) { yb = *(const u32x4*)stn; if (br > 0) ob = *(const u32x4*)mpn; }
                *(u32x4*)mpp = wo;
                stp = stn; mpp = mpn; } }
    }
};
__device__ __forceinline__ void phase_merge(const Params& p, int l, char* shm) {
    pg8::RowOrder S{4, 512, GDIM(), BID()};
    for (int br = 0; br < 3; ++br) {
        const u16* Ain = br == 0 ? p.ga() : (br == 1 ? p.bin() : p.sp());
        const u16* Wy = (br == 0 ? p.wt_oa() : (br == 1 ? p.wt_ob() : p.wt_oc())) + (size_t)l * 1024 * 512;
        { pg8::Gemm g{Ain, Wy, T, 1024, 512}; EpiStash E{p.stash()}; pg8::gemm_phase((PG8_LAS unsigned char*)shm, g, S, E); }
        { pg8::Gemm g{p.xb(), p.wt_mg() + (size_t)l * 3072 * 1024 + (size_t)br * 1024 * 1024, T, 1024, 1024}; EpiGate E{p, l, br}; pg8::gemm_phase((PG8_LAS unsigned char*)shm, g, S, E); }
    }
}

struct EpiOut {
    static constexpr bool DUPOK = false;
    const Params& p; int l;
    __device__ __forceinline__ void operator()(const acc_t& acc, const pg8::Unit& u, int ui, int wr, int wc, int fr, int fq) const {
        const float* xsrc = (l == 0) ? p.x_in : p.x;
        const int cl = wc * 4 + fq;
        f32x4 xb0[2], xb1[2];
#pragma unroll
        for (int bj = 0; bj < 2; ++bj) { const size_t o = (size_t)(u.pm * 256 + wr * 64 + fr) * 1024 + u.pn * 256 + 16 * cl + bj * 8; xb0[bj] = *(const f32x4*)(xsrc + o); xb1[bj] = *(const f32x4*)(xsrc + o + 4); }
        ROWS_LOOP { const int row = ROW_OF; const int ix = ai * 4 + m; float ss = 0.f;
            f32x4 x0[2], x1[2];
#pragma unroll
            for (int bj = 0; bj < 2; ++bj) { x0[bj] = xb0[bj] + acc[ai][bj][m][0]; x1[bj] = xb1[bj] + acc[ai][bj][m][1]; }
            if (ix < 7) { const int rown = u.pm * 256 + ((ix + 1) >> 2) * 128 + wr * 64 + ((ix + 1) & 3) * 16 + fr;
#pragma unroll
                for (int bj = 0; bj < 2; ++bj) { const size_t o = (size_t)rown * 1024 + u.pn * 256 + 16 * cl + bj * 8; xb0[bj] = *(const f32x4*)(xsrc + o); xb1[bj] = *(const f32x4*)(xsrc + o + 4); } }
#pragma unroll
            for (int bj = 0; bj < 2; ++bj) { const size_t o = (size_t)row * 1024 + u.pn * 256 + 16 * cl + bj * 8;
                *(f32x4*)(p.x + o) = x0[bj]; *(f32x4*)(p.x + o + 4) = x1[bj];
                if (l < NL - 1) { u32x4 w; w[0] = cvtpk(x0[bj][0], x0[bj][1]); w[1] = cvtpk(x0[bj][2], x0[bj][3]); w[2] = cvtpk(x1[bj][0], x1[bj][1]); w[3] = cvtpk(x1[bj][2], x1[bj][3]); *(u32x4*)(p.xb() + o) = w;
#pragma unroll
                    for (int j = 0; j < 4; ++j) ss += x0[bj][j] * x0[bj][j] + x1[bj][j] * x1[bj][j]; } }
            if (l < NL - 1) { ss += __shfl_xor(ss, 16); ss += __shfl_xor(ss, 32); if (fq == 0) p.sumsq()[(size_t)((l + 1) & 1) * T * 16 + (size_t)row * 16 + u.pn * 4 + wc] = ss; } }
    }
};
__device__ __forceinline__ void phase_out(const Params& p, int l, char* shm) {
    pg8::RowOrder S{4, 512, GDIM(), BID()};
    pg8::Gemm g{p.merged(), p.wt_o() + (size_t)l * 1024 * 1024, T, 1024, 1024};
    EpiOut E{p, l};
    pg8::gemm_phase((PG8_LAS unsigned char*)shm, g, S, E);
}

enum { PH_PREP0 = 0, PH_IN, PH_MIX, PH_IDX, PH_SEL, PH_ATTN, PH_MERGE, PH_OUT };
template <int PH> __global__ __launch_bounds__(NTHR) void k_phase(Params p, int l, int b) {
    extern __shared__ __attribute__((aligned(16))) char shm[];
    if (PH == PH_PREP0) phase_prep0(p, shm);
    if (PH == PH_IN) phase_in(p, l, shm);
    if (PH == PH_MIX) phase_mix(p, l);
    if (PH == PH_IDX) phase_indexer(p, b);
    if (PH == PH_SEL) phase_select(p, b, shm);
    if (PH == PH_ATTN) phase_attn(p, shm);
    if (PH == PH_MERGE) phase_merge(p, l, shm);
    if (PH == PH_OUT) phase_out(p, l, shm);
}

#define XB_TMO      128
#define XB_XCNT(j)  (256  + 64 * (j))
#define XB_XSUB(j)  (1280 + 64 * (j))
#define XB_XGEN(j)  (2304 + 64 * (j))
#define XB_TOP      3328
#define XB_TOPGEN   3392
#define XCD_BAR_WORDS 3456
#define XB_SPIN_CAP (1u << 22)
#define LAS __attribute__((address_space(3)))
__device__ __forceinline__ unsigned xb_ld(unsigned* p)              { return __hip_atomic_load(p, __ATOMIC_RELAXED, __HIP_MEMORY_SCOPE_AGENT); }
__device__ __forceinline__ unsigned xb_add(unsigned* p, unsigned v) { return __hip_atomic_fetch_add(p, v, __ATOMIC_RELAXED, __HIP_MEMORY_SCOPE_AGENT); }
__device__ __forceinline__ unsigned xb_xcc_id() { return (unsigned)__builtin_amdgcn_s_getreg((3 << 11) | 20) & 0xFu; }
#define XB_SPIN(cond, bar) do { unsigned _sp = 0; while (cond) { __builtin_amdgcn_s_sleep(1); \
    if ((++_sp & 255u) == 0u) { if (xb_ld(&(bar)[XB_TMO])) break; if (_sp > XB_SPIN_CAP) { atomicAdd(&(bar)[XB_TMO], 1u); break; } } } } while (0)
struct XcdBarrier { unsigned* bar; unsigned x; volatile LAS unsigned* st; };
__device__ __forceinline__ XcdBarrier xcd_barrier_post(unsigned* bar, volatile LAS unsigned* st) {
    XcdBarrier b; b.bar = bar; b.x = xb_xcc_id(); b.st = st;
    if (threadIdx.x == 0) (void)xb_add(&bar[XB_XCNT(b.x)], 1u);
    return b;
}
__device__ __forceinline__ void xcd_barrier_complete(unsigned* bar, unsigned x, unsigned& nloc, unsigned& nx) {
    const unsigned G = gridDim.x * gridDim.y * gridDim.z;
    unsigned sum, cnt, mine, sp = 0u;
    for (;;) {
        sum = 0u; cnt = 0u; mine = 0u;
#pragma unroll
        for (unsigned j = 0; j < 16; ++j) { const unsigned c = xb_ld(&bar[XB_XCNT(j)]); sum += c; cnt += (c > 0u) ? 1u : 0u; mine = (j == x) ? c : mine; }
        if (sum == G) break;
        __builtin_amdgcn_s_sleep(1);
        if ((++sp & 255u) == 0u) { if (xb_ld(&bar[XB_TMO])) break; if (sp > XB_SPIN_CAP) { atomicAdd(&bar[XB_TMO], 1u); break; } }
    }
    nloc = mine > 0u ? mine : 1u; nx = cnt > 0u ? cnt : 1u;
}
__device__ __forceinline__ void xcd_barrier(const XcdBarrier& b) {
    asm volatile("s_waitcnt vmcnt(0)" ::: "memory");
    __syncthreads();
    if (threadIdx.x == 0) {
        unsigned* bar = b.bar;
        __builtin_amdgcn_s_waitcnt(0);
        unsigned nloc = b.st[0], nx = b.st[1];
        if (nloc == 0u) { xcd_barrier_complete(bar, b.x, nloc, nx); b.st[0] = nloc; b.st[1] = nx; }
        const unsigned old = xb_add(&bar[XB_XSUB(b.x)], 1u);
        const unsigned gen = old / nloc;
        if (old + 1u == (gen + 1u) * nloc) {
            __builtin_amdgcn_fence(__ATOMIC_RELEASE, "agent");
            asm volatile("s_waitcnt vmcnt(0)" ::: "memory");
            const unsigned og = xb_add(&bar[XB_TOP], 1u);
            const unsigned tg = og / nx;
            if (og + 1u == (tg + 1u) * nx) xb_add(&bar[XB_TOPGEN], 1u);
            else XB_SPIN(xb_ld(&bar[XB_TOPGEN]) == tg, bar);
            __builtin_amdgcn_fence(__ATOMIC_ACQUIRE, "agent");
            xb_add(&bar[XB_XGEN(b.x)], 1u);
            asm volatile("s_waitcnt vmcnt(0)" ::: "memory");
        } else {
            XB_SPIN(xb_ld(&bar[XB_XGEN(b.x)]) == gen, bar);
            __builtin_amdgcn_fence(__ATOMIC_ACQUIRE, "agent");
            asm volatile("s_waitcnt vmcnt(0)" ::: "memory");
        }
    }
    __syncthreads();
}

#if MEGA
typedef const __attribute__((address_space(4))) Params* kparams_t;
__device__ __forceinline__ Params load_params(kparams_t k) {
    Params q; q.x_in = k->x_in; q.norm_g = k->norm_g; q.w_in = k->w_in; q.conv_w = k->conv_w; q.w_out_conv = k->w_out_conv; q.q_g = k->q_g; q.k_g = k->k_g; q.w_out_attn = k->w_out_attn;
    q.pool_w = k->pool_w; q.pool_scale = k->pool_scale; q.w_out_pool = k->w_out_pool; q.w_o = k->w_o; q.x = k->x; q.ws = k->ws; return q; }
#define PHP(q) kparams_t kq_##q = kp; asm volatile("" : "+s"(kq_##q)); const Params q = load_params(kq_##q);
__global__ __launch_bounds__(NTHR) void k_mega(Params p_unused) {
    extern __shared__ __attribute__((aligned(16))) char shm[];
    cg::grid_group grid = cg::this_grid();
    kparams_t kp = (kparams_t)__builtin_amdgcn_kernarg_segment_ptr();
    __shared__ uint4 xb_words;
    if (threadIdx.x == 0) xb_words = make_uint4(0u, 0u, 0u, 0u);
    __syncthreads();
    const XcdBarrier xb = xcd_barrier_post((unsigned*)(kp->ws + WS_BAR), (volatile LAS unsigned*)&xb_words);

#ifndef SK_PREP
        { PHP(p) phase_prep0(p, shm); }
#endif
#ifdef DUP_PREP
        { PHP(p) phase_prep0(p, shm); }
#endif

    grid.sync();
    for (int l = 0; l < NL; ++l) {

#ifndef SK_IN
        { PHP(p) phase_in(p, l, shm); }
#endif
#ifdef DUP_IN
        { PHP(p) phase_in(p, l, shm); }
#endif

        xcd_barrier(xb);

#ifndef SK_MIX
        { PHP(p) phase_mix(p, l); }
#endif

        for (int b = 0; b < NBATCH; ++b) {

#ifndef SK_IDX
        { PHP(p) phase_indexer(p, b); }
#endif
#ifdef DUP_IDX
        { PHP(p) phase_indexer(p, b); }
#endif

            xcd_barrier(xb);

#ifndef SK_SEL
        { PHP(p) phase_select(p, b, shm); }
#endif
#ifdef DUP_SEL
        { PHP(p) phase_select(p, b, shm); }
#endif

            xcd_barrier(xb);
        }

#ifndef SK_ATTN
        { PHP(p) phase_attn(p, shm); }
#endif
#ifdef DUP_ATTN
        { PHP(p) phase_attn(p, shm); }
#endif

        xcd_barrier(xb);

#ifndef SK_MERGE
        { PHP(p) phase_merge(p, l, shm); }
#endif
#ifdef DUP_MERGE
        { PHP(p) phase_merge(p, l, shm); }
#endif

        xcd_barrier(xb);

#ifndef SK_OUT
        { PHP(p) phase_out(p, l, shm); }
#endif

        xcd_barrier(xb);
    }
}
#endif

static Params make_params(void* const* d_in, void* d_out, void* d_ws) {
    Params p{};
    p.x_in = (const float*)d_in[0]; p.norm_g = (const float*)d_in[1]; p.w_in = (const float*)d_in[2]; p.conv_w = (const float*)d_in[3];
    p.w_out_conv = (const float*)d_in[4]; p.q_g = (const float*)d_in[5]; p.k_g = (const float*)d_in[6]; p.w_out_attn = (const float*)d_in[7];
    p.pool_w = (const float*)d_in[8]; p.pool_scale = (const float*)d_in[9]; p.w_out_pool = (const float*)d_in[10]; p.w_o = (const float*)d_in[11];
    p.x = (float*)d_out; p.ws = (char*)d_ws;
    return p;
}

extern "C" void kernel_launch(void* const* d_in, const int* in_sizes, int n_in, void* d_out, int out_size, void* d_ws, size_t ws_size, hipStream_t stream) {
    if (ws_size < WS_NEEDED) { fprintf(stderr, "workspace too small: %zu < %zu\n", ws_size, (size_t)WS_NEEDED); return; }
    Params p = make_params(d_in, d_out, d_ws);
    const int grid = 256;
#if MEGA
    static bool attr = false;
    if (!attr) { hipFuncSetAttribute((const void*)k_mega, hipFuncAttributeMaxDynamicSharedMemorySize, LDS_BYTES); attr = true; }
    hipMemsetAsync((char*)d_ws + WS_BAR, 0, 16384, stream);
    void* args[] = {&p};
    hipError_t e = hipLaunchCooperativeKernel((void*)k_mega, dim3(grid), dim3(NTHR), args, LDS_BYTES, stream);
    if (e != hipSuccess) fprintf(stderr, "cooperative launch failed: %s\n", hipGetErrorString(e));
#else
    static bool attr = false;
    if (!attr) {
        hipFuncSetAttribute((const void*)k_phase<PH_PREP0>, hipFuncAttributeMaxDynamicSharedMemorySize, LDS_BYTES);
        hipFuncSetAttribute((const void*)k_phase<PH_IN>, hipFuncAttributeMaxDynamicSharedMemorySize, LDS_BYTES);
        hipFuncSetAttribute((const void*)k_phase<PH_MIX>, hipFuncAttributeMaxDynamicSharedMemorySize, LDS_BYTES);
        hipFuncSetAttribute((const void*)k_phase<PH_IDX>, hipFuncAttributeMaxDynamicSharedMemorySize, LDS_BYTES);
        hipFuncSetAttribute((const void*)k_phase<PH_SEL>, hipFuncAttributeMaxDynamicSharedMemorySize, LDS_BYTES);
        hipFuncSetAttribute((const void*)k_phase<PH_ATTN>, hipFuncAttributeMaxDynamicSharedMemorySize, LDS_BYTES);
        hipFuncSetAttribute((const void*)k_phase<PH_MERGE>, hipFuncAttributeMaxDynamicSharedMemorySize, LDS_BYTES);
        hipFuncSetAttribute((const void*)k_phase<PH_OUT>, hipFuncAttributeMaxDynamicSharedMemorySize, LDS_BYTES);
        attr = true;
    }
#define LAUNCH(PH, l, b) hipLaunchKernelGGL(k_phase<PH>, dim3(grid), dim3(NTHR), LDS_BYTES, stream, p, l, b)
    LAUNCH(PH_PREP0, 0, 0);
    for (int l = 0; l < NL; ++l) {
        LAUNCH(PH_IN, l, 0);
        LAUNCH(PH_MIX, l, 0);
        for (int b = 0; b < NBATCH; ++b) { LAUNCH(PH_IDX, l, b); LAUNCH(PH_SEL, l, b); }
        LAUNCH(PH_ATTN, l, 0);
        LAUNCH(PH_MERGE, l, 0);
        LAUNCH(PH_OUT, l, 0);
    }
#endif
}
```

```cpp
#include <hip/hip_runtime.h>
#include <hip/hip_cooperative_groups.h>
#include <stdint.h>
#include <stdio.h>
namespace cg = cooperative_groups;

typedef unsigned short u16;
typedef unsigned long long u64;
typedef __attribute__((ext_vector_type(8))) short bf16x8;
typedef __attribute__((ext_vector_type(4))) short s16x4;
typedef __attribute__((ext_vector_type(4))) float f32x4;
typedef __attribute__((ext_vector_type(16))) float f32x16;
typedef __attribute__((ext_vector_type(4))) unsigned u32x4;
typedef __attribute__((ext_vector_type(2))) unsigned u32x2;

#ifndef MEGA
#define MEGA 1
#endif
__device__ __forceinline__ int TID() { int t = threadIdx.x; asm volatile("" : "+v"(t)); return t; }
__device__ __forceinline__ int BID() { int t = blockIdx.x; asm volatile("" : "+s"(t)); return t; }
__device__ __forceinline__ int GDIM() { int t = gridDim.x; asm volatile("" : "+s"(t)); return t; }

constexpr int SEQ = 8192, NBATCH = 4, T = NBATCH * SEQ, DMODEL = 1024, NL = 4, INW = 8776;
constexpr int NPA = 5888;
constexpr int NTHR = 512;
constexpr int LDS_BYTES = 131072;
constexpr float RMS_EPS = 1e-6f;

struct Params {
    const float *x_in, *norm_g, *w_in, *conv_w, *w_out_conv, *q_g, *k_g, *w_out_attn, *pool_w, *pool_scale, *w_out_pool, *w_o;
    float* x; char* ws;
    __device__ __forceinline__ u16* xb() const { return (u16*)(ws + 0ull); }
    __device__ __forceinline__ u16* z() const { return (u16*)(ws + 67108864ull); }
    __device__ __forceinline__ u16* ga() const { return (u16*)(ws + 100663296ull); }
    __device__ __forceinline__ u16* q() const { return (u16*)(ws + 134217728ull); }
    __device__ __forceinline__ u16* k() const { return (u16*)(ws + 167772160ull); }
    __device__ __forceinline__ u16* v() const { return (u16*)(ws + 201326592ull); }
    __device__ __forceinline__ u16* sg() const { return (u16*)(ws + 234881024ull); }
    __device__ __forceinline__ u16* iq() const { return (u16*)(ws + 268435456ull); }
    __device__ __forceinline__ u16* u() const { return (u16*)(ws + 301989888ull); }
    __device__ __forceinline__ u16* sp() const { return (u16*)(ws + 335544320ull); }
    __device__ __forceinline__ u16* ik() const { return (u16*)(ws + 369098752ull); }
    __device__ __forceinline__ float* iw() const { return (float*)(ws + 373293056ull); }
    __device__ __forceinline__ u16* wt_in() const { return (u16*)(ws + 374341632ull); }
    __device__ __forceinline__ u16* wt_mg() const { return (u16*)(ws + 422576128ull); }
    __device__ __forceinline__ u16* wt_oa() const { return (u16*)(ws + 447741952ull); }
    __device__ __forceinline__ u16* wt_ob() const { return (u16*)(ws + 451936256ull); }
    __device__ __forceinline__ u16* wt_oc() const { return (u16*)(ws + 456130560ull); }
    __device__ __forceinline__ u16* wt_o() const { return (u16*)(ws + 460324864ull); }
    __device__ __forceinline__ float* ropec() const { return (float*)(ws + 468713472ull); }
    __device__ __forceinline__ float* ropes() const { return (float*)(ws + 469762048ull); }
    __device__ __forceinline__ float* sumsq() const { return (float*)(ws + 470810624ull); }
    __device__ __forceinline__ u64* mask() const { return (u64*)(ws + 475004928ull); }
    __device__ __forceinline__ u16* scores() const { return (u16*)(ws + 492306432ull); }
    __device__ __forceinline__ u16* stash() const { return scores(); }
    __device__ __forceinline__ u16* merged() const { return q(); }
    __device__ __forceinline__ u16* bin() const { return iq(); }
};
constexpr size_t WS_BAR = 561512448ull;
constexpr size_t WS_NEEDED = WS_BAR + 16384;


__device__ __forceinline__ unsigned cvtpk(float lo, float hi) { unsigned r; asm("v_cvt_pk_bf16_f32 %0, %1, %2" : "=v"(r) : "v"(lo), "v"(hi)); return r; }
__device__ __forceinline__ u16 f2bf(float f) { return (u16)(cvtpk(f, 0.f) & 0xffffu); }
__device__ __forceinline__ float bf2f(u16 b) { return __uint_as_float(((unsigned)b) << 16); }
__device__ __forceinline__ float bflo(unsigned w) { return __uint_as_float(w << 16); }
__device__ __forceinline__ float bfhi(unsigned w) { return __uint_as_float(w & 0xffff0000u); }
__device__ __forceinline__ float siluf(float x) { return x * __builtin_amdgcn_rcpf(1.f + __builtin_amdgcn_exp2f(x * -1.4426950408889634f)); }
__device__ __forceinline__ float sigmf(float x) { return __builtin_amdgcn_rcpf(1.f + __builtin_amdgcn_exp2f(x * -1.4426950408889634f)); }

__device__ __forceinline__ float row_rstd(const float* ssp, int row) {
    const f32x4* q = (const f32x4*)(ssp + (size_t)row * 16);
    const f32x4 a = q[0], b = q[1], c = q[2], d = q[3];
    const float s = ((a[0] + a[1]) + (a[2] + a[3])) + ((b[0] + b[1]) + (b[2] + b[3])) + ((c[0] + c[1]) + (c[2] + c[3])) + ((d[0] + d[1]) + (d[2] + d[3]));
    return __builtin_amdgcn_rsqf(s * (1.f / 1024.f) + RMS_EPS);
}
__device__ __forceinline__ int lc_of_tc(int tc) { int bj = tc >> 7, wc = (tc >> 5) & 3, n = (tc >> 4) & 1, fq = (tc >> 2) & 3, j = tc & 3; return ((wc * 4 + fq) << 4) + bj * 8 + n * 4 + j; }
__device__ __forceinline__ int tc_of_lc(int lc) { int cl = lc >> 4, s = lc & 15, wc = cl >> 2, fq = cl & 3, bj = s >> 3, n = (s >> 2) & 1, j = s & 3; return bj * 128 + wc * 32 + n * 16 + fq * 4 + j; }

__device__ __forceinline__ int src_col_in(int np) {
    int pn = np >> 8, tc = np & 255;
    int bj = tc >> 7, wc = (tc >> 5) & 3, n = (tc >> 4) & 1, fq = (tc >> 2) & 3, j = tc & 3, cl = wc * 4 + fq, s = bj * 8 + n * 4 + j, lc = cl * 16 + s;
    int d = (s < 8) ? (8 * fq + s) : (8 * fq + 32 + (s - 8));
    if (pn < 8) return (s & 3) * 512 + pn * 64 + cl * 4 + (s >> 2);
    if (pn < 12) { int which = (pn - 8) >> 1, head = ((pn - 8) & 1) * 4 + wc; return 2048 + which * 512 + head * 64 + d; }
    if (pn < 14) return 3072 + (pn - 12) * 256 + lc;
    if (pn < 16) return 3584 + (pn - 14) * 256 + lc;
    if (pn < 18) { int head = (pn - 16) * 4 + wc; return 4096 + head * 64 + d; }
    if (pn == 18) { if (wc == 0) return 4608 + d; if (wc == 1 && fq == 0 && s < 8) return 4672 + s; return -1; }
    if (pn < 21) return -2;
    return 5192 + (pn - 21) * 256 + lc;
}

__device__ __forceinline__ void prep_x(const Params& p) {
    const int tid_ = TID(); const int lane = tid_ & 63, gw = BID() * (NTHR / 64) + (tid_ >> 6), nw = GDIM() * (NTHR / 64);
    for (int row = gw; row < T; row += nw) {
        const float4* src = (const float4*)(p.x_in + (size_t)row * DMODEL);
        float ss = 0.f;
#pragma unroll
        for (int i = 0; i < 4; ++i) {
            float4 v = src[i * 64 + lane];
            ss += v.x * v.x + v.y * v.y + v.z * v.z + v.w * v.w;
            u32x2 o; o[0] = cvtpk(v.x, v.y); o[1] = cvtpk(v.z, v.w);
            *(u32x2*)(p.xb() + (size_t)row * DMODEL + (i * 64 + lane) * 4) = o;
        }
#pragma unroll
        for (int m = 32; m >= 1; m >>= 1) ss += __shfl_xor(ss, m);
        if (lane < 16) p.sumsq()[(size_t)row * 16 + lane] = (lane == 0) ? ss : 0.f;
    }
}
__device__ __forceinline__ void prep_rope(const Params& p) {
    const int i0 = BID() * NTHR + TID(), istep = GDIM() * NTHR;
    for (int i = i0; i < SEQ * 32; i += istep) {
        int pos = i >> 5, j = i & 31;
        float inv = 1.0f / powf(10000.0f, (float)(2 * j) / 64.0f);
        float ang = (float)pos * inv;
        p.ropec()[i] = cosf(ang); p.ropes()[i] = sinf(ang);
    }
}
__device__ __forceinline__ void prep_wt(const float* src, int lds_, const float* scale, u16* dst, int K, int NP, int mode, float* tile) {
    const int tid_ = TID(); const int tx = tid_ & 63, ty = tid_ >> 6; const int bid_ = BID(), gdim_ = GDIM();
    const int ntn = NP / 64, ntk = K / 64;
    for (int t = bid_; t < ntn * ntk; t += gdim_) {
        const int n0 = (t / ntk) * 64, k0 = (t % ntk) * 64;
        int np = n0 + tx, col;
        if (mode == 0) col = src_col_in(np);
        else if (mode == 1) col = 5704 + (np & ~255) + lc_of_tc(np & 255);
        else col = (np & ~255) + lc_of_tc(np & 255);
        __syncthreads();
#pragma unroll
        for (int i = 0; i < 8; ++i) { int kk = ty + 8 * i; tile[kk * 65 + tx] = (col >= 0) ? src[(size_t)(k0 + kk) * lds_ + col] : 0.f; }
        __syncthreads();
        const float sc = scale ? scale[k0 + tx] : 1.f;
#pragma unroll
        for (int i = 0; i < 8; ++i) {
            int nn = ty + 8 * i; int npo = n0 + nn;
            bool skip = (mode == 0) && ((npo >> 8) == 19 || (npo >> 8) == 20);
            if (!skip) dst[(size_t)npo * K + k0 + tx] = f2bf(tile[tx * 65 + nn] * sc);
        }
    }
}
__device__ __forceinline__ void prep_fold(const float* win, const float* ng, const float* pw, u16* wt_in) {
    const int i0 = BID() * NTHR + TID(), istep = GDIM() * NTHR;
    for (int i = i0; i < 1024 * 512; i += istep) {
        int k = i >> 9, n = i & 511, g = n >> 7, d = n & 127;
        const float* wr = win + (size_t)k * INW + 4680 + g * 128;
        const float* pp = pw + (size_t)g * 128 * 128 + d;
        float acc = 0.f;
        for (int c = 0; c < 128; ++c) acc += wr[c] * pp[c * 128];
        int row = (19 + (n >> 8)) * 256 + tc_of_lc(n & 255);
        wt_in[(size_t)row * 1024 + k] = f2bf(acc * ng[k]);
    }
}
__device__ __forceinline__ void phase_prep0(const Params& p, char* shm) {
    prep_x(p); prep_rope(p);
    float* tile = (float*)shm;
    for (int l = 0; l < NL; ++l) {
        const float* ng = p.norm_g + l * 1024;
        const float* win = p.w_in + (size_t)l * 1024 * INW;
        prep_wt(win, INW, ng, p.wt_in() + (size_t)l * NPA * 1024, 1024, NPA, 0, tile);
        prep_wt(win, INW, ng, p.wt_mg() + (size_t)l * 3072 * 1024, 1024, 3072, 1, tile);
        prep_wt(p.w_out_conv + (size_t)l * 512 * 1024, 1024, nullptr, p.wt_oa() + (size_t)l * 1024 * 512, 512, 1024, 2, tile);
        prep_wt(p.w_out_attn + (size_t)l * 512 * 1024, 1024, nullptr, p.wt_ob() + (size_t)l * 1024 * 512, 512, 1024, 2, tile);
        prep_wt(p.w_out_pool + (size_t)l * 512 * 1024, 1024, nullptr, p.wt_oc() + (size_t)l * 1024 * 512, 512, 1024, 2, tile);
        prep_wt(p.w_o + (size_t)l * 1024 * 1024, 1024, nullptr, p.wt_o() + (size_t)l * 1024 * 1024, 1024, 1024, 3, tile);
        prep_fold(win, ng, p.pool_w + (size_t)l * 4 * 128 * 128, p.wt_in() + (size_t)l * NPA * 1024);
    }
}

namespace pg8 {
#define PG8_LAS __attribute__((address_space(3)))
typedef unsigned short bf16_t;
constexpr int BM = 256, BK = 64, HALF = 128, HTB = HALF * BK * 2, STAGE_BYTES = 8 * HTB;
__device__ __forceinline__ int lds_byte(int r, int c) { const int st = (r >> 4) * 2 + (c >> 5), rr = r & 15, cc = c & 31, ob = rr * 64 + cc * 2; return st * 1024 + (ob ^ (((ob >> 9) & 1) << 5)); }
__device__ __forceinline__ void stage_rc(int b, int& R, int& C) { const int st = b / 1024, sb = b % 1024, swz = sb ^ (((sb >> 9) & 1) << 5); R = (st >> 1) * 16 + swz / 64; C = (st & 1) * 32 + (swz % 64) / 2; }
struct Unit { int pm, pn; };
struct Gemm { const bf16_t* A; const bf16_t* Bt; int M, N, K; };
constexpr int NXCD = 8, WGM = 8;
struct StaticOrder {
    int nM, nN, nwg, G, c;
    __device__ void init(int M, int N, int G_, int c_) { nM = M / BM; nN = N / BM; nwg = nM * nN; G = G_; c = c_; }
    __device__ bool next(int i, Unit& u) const {
        const long L = (long)i * G + c; if (L >= nwg) return false;
        int wgid = (int)L; { const int q = nwg / NXCD, r = nwg % NXCD, xcd = wgid % NXCD, off = wgid / NXCD; wgid = (xcd < r ? xcd * (q + 1) : r * (q + 1) + (xcd - r) * q) + off; }
        const int nig = WGM * nN, gid = wgid / nig, fm = gid * WGM, gsz = (nM - fm) < WGM ? (nM - fm) : WGM;
        u.pm = fm + ((wgid % nig) % gsz); u.pn = (wgid % nig) / gsz; return true;
    }
};
struct RowOrder {
    int nN, ntile, G, c;
    __device__ bool next(int i, Unit& u) const {
        const int x = c & 7, lt = (c >> 3) + (G >> 3) * i;
        const int quad = lt >> 2, pm = quad * 8 + x;
        if (pm * 4 >= ntile) return false;
        u.pm = pm; u.pn = lt & 3; return true; }
};
template <class Epi, class Sched>
__device__ __forceinline__ void gemm_phase(PG8_LAS unsigned char* lds, const Gemm g, const Sched& S, const Epi& E) {
    const int tid = TID(), wid = __builtin_amdgcn_readfirstlane(tid >> 6), lane = tid & 63, wr = wid >> 2, wc = wid & 3, fr = lane & 15, fq = lane >> 4;
    const int K = g.K, nt = K / BK;
    unsigned voffA[2], voffB[2];
#pragma unroll
    for (int i = 0; i < 2; ++i) { int R, C; stage_rc(tid * 16 + i * 8192, R, C); voffA[i] = (unsigned)(R * K + C) * 2u; voffB[i] = voffA[i]; }
    const size_t kstep = (size_t)(BK * 2);
    const size_t hstep = (size_t)HALF * K * 2;
    const size_t tstep = 2 * hstep;
    const unsigned ldsw = (unsigned)wid * 1024u;
    const int aoff = lds_byte(wr * 64 + fr, fq * 8), boff = lds_byte(wc * 32 + fr, fq * 8);
#define PG8_SA(b, h) (((b) * 2 + (h)) * HTB)
#define PG8_SB(b, h) ((4 + (b) * 2 + (h)) * HTB)
#define PG8_STAGE(bufoff, gbase, voff) do { _Pragma("unroll") for (int _i = 0; _i < 2; ++_i) \
        __builtin_amdgcn_global_load_lds((const unsigned*)((const char*)(gbase) + (voff)[_i]), (PG8_LAS unsigned*)(lds + (bufoff) + ldsw + _i * 8192), 16, 0, 0); } while (0)
#define PG8_LDA(dst, b, h) do { _Pragma("unroll") for (int m = 0; m < 4; ++m) _Pragma("unroll") for (int k = 0; k < 2; ++k) dst[m][k] = *(const PG8_LAS bf16x8*)(lds + PG8_SA(b, h) + aoff + m * 2048 + k * 1024); } while (0)
#define PG8_LDB(dst, b, h) do { _Pragma("unroll") for (int n = 0; n < 2; ++n) _Pragma("unroll") for (int k = 0; k < 2; ++k) dst[n][k] = *(const PG8_LAS bf16x8*)(lds + PG8_SB(b, h) + boff + n * 2048 + k * 1024); } while (0)
#define PG8_MMA(ai, bj, At, Bt) do { __builtin_amdgcn_s_setprio(1); _Pragma("unroll") for (int m = 0; m < 4; ++m) _Pragma("unroll") for (int n = 0; n < 2; ++n) _Pragma("unroll") for (int k = 0; k < 2; ++k) \
        acc[ai][bj][m][n] = __builtin_amdgcn_mfma_f32_16x16x32_bf16(Bt[n][k], At[m][k], acc[ai][bj][m][n], 0, 0, 0); __builtin_amdgcn_s_setprio(0); } while (0)
#define PG8_WAIT_V(n) asm volatile("s_waitcnt vmcnt(" #n ")" ::: "memory")
#define PG8_WAIT_L(n) asm volatile("s_waitcnt lgkmcnt(" #n ")" ::: "memory")
#define PG8_BAR __builtin_amdgcn_s_barrier()
#define PG8_SCHED __builtin_amdgcn_sched_barrier(0)
    Unit cur, nxt; int ui = 0;
    if (!S.next(0, cur)) return;
    f32x4 acc[2][2][4][2];
#pragma unroll
    for (int a = 0; a < 2; ++a)
#pragma unroll
        for (int b = 0; b < 2; ++b)
#pragma unroll
            for (int m = 0; m < 4; ++m)
#pragma unroll
                for (int n = 0; n < 2; ++n) acc[a][b][m][n] = (f32x4){0.f, 0.f, 0.f, 0.f};
    bf16x8 At[4][2], B0[2][2], B1[2][2];
    const char* cA = (const char*)g.A + (size_t)cur.pm * tstep; const char* cB = (const char*)g.Bt + (size_t)cur.pn * tstep;
    PG8_STAGE(PG8_SB(0, 0), cB, voffB); PG8_STAGE(PG8_SA(0, 0), cA, voffA); PG8_STAGE(PG8_SB(0, 1), cB + hstep, voffB); PG8_STAGE(PG8_SA(0, 1), cA + hstep, voffA);
    if (wr == 1) PG8_BAR;
    PG8_WAIT_V(4); PG8_BAR;
    PG8_STAGE(PG8_SB(1, 0), cB + kstep, voffB); PG8_STAGE(PG8_SA(1, 0), cA + kstep, voffA); PG8_STAGE(PG8_SB(1, 1), cB + hstep + kstep, voffB);
    PG8_WAIT_V(6); PG8_BAR;
    for (;;) {
        const bool has_next = S.next(ui + 1, nxt);
        const char* nA = has_next ? (const char*)g.A + (size_t)nxt.pm * tstep : cA; const char* nB = has_next ? (const char*)g.Bt + (size_t)nxt.pn * tstep : cB;
        for (int t = 0; t < nt; t += 2) {
            const bool last = (t == nt - 2);
            const char* a1 = cA + (size_t)(t + 1) * kstep;
            const char* a2 = last ? nA : cA + (size_t)(t + 2) * kstep; const char* b2 = last ? nB : cB + (size_t)(t + 2) * kstep;
            const char* a3 = a2 + kstep; const char* b3 = b2 + kstep;
            PG8_LDB(B0, 0, 0); PG8_SCHED; PG8_LDA(At, 0, 0); PG8_STAGE(PG8_SA(1, 1), a1 + hstep, voffA);
            PG8_WAIT_L(8); PG8_BAR; PG8_WAIT_L(0); PG8_MMA(0, 0, At, B0); PG8_BAR; PG8_SCHED;
            PG8_LDB(B1, 0, 1); PG8_STAGE(PG8_SB(0, 0), b2, voffB);
            PG8_BAR; PG8_WAIT_L(0); PG8_MMA(0, 1, At, B1); PG8_BAR;
            PG8_LDA(At, 0, 1); PG8_STAGE(PG8_SA(0, 0), a2, voffA);
            PG8_BAR; PG8_WAIT_L(0); PG8_MMA(1, 0, At, B0); PG8_BAR; PG8_SCHED;
            PG8_STAGE(PG8_SB(0, 1), b2 + hstep, voffB);
            PG8_WAIT_V(6); PG8_BAR; PG8_MMA(1, 1, At, B1); PG8_BAR;
            PG8_LDB(B0, 1, 0); PG8_SCHED; PG8_LDA(At, 1, 0); PG8_STAGE(PG8_SA(0, 1), a2 + hstep, voffA);
            PG8_WAIT_L(8); PG8_BAR; PG8_WAIT_L(0); PG8_MMA(0, 0, At, B0); PG8_BAR; PG8_SCHED;
            PG8_LDB(B1, 1, 1); PG8_STAGE(PG8_SB(1, 0), b3, voffB);
            PG8_BAR; PG8_WAIT_L(0); PG8_MMA(0, 1, At, B1); PG8_BAR;
            PG8_LDA(At, 1, 1); PG8_STAGE(PG8_SA(1, 0), a3, voffA);
            PG8_BAR; PG8_WAIT_L(0); PG8_MMA(1, 0, At, B0); PG8_BAR; PG8_SCHED;
            PG8_STAGE(PG8_SB(1, 1), b3 + hstep, voffB);
            PG8_WAIT_V(6); PG8_BAR; PG8_MMA(1, 1, At, B1); PG8_BAR;
        }
        E(acc, cur, ui, wr, wc, fr, fq);
#ifdef DUP_EPI
        if (Epi::DUPOK) E(acc, cur, ui, wr, wc, fr, fq);
#endif
        if (!has_next) break;
#pragma unroll
        for (int a = 0; a < 2; ++a)
#pragma unroll
            for (int b = 0; b < 2; ++b)
#pragma unroll
                for (int m = 0; m < 4; ++m)
#pragma unroll
                    for (int n = 0; n < 2; ++n) acc[a][b][m][n] = (f32x4){0.f, 0.f, 0.f, 0.f};
        cur = nxt; cA = nA; cB = nB; ++ui;
    }
    PG8_WAIT_V(0);
    if (wr == 0) PG8_BAR;
    PG8_BAR;
#undef PG8_SA
#undef PG8_SB
#undef PG8_STAGE
#undef PG8_LDA
#undef PG8_LDB
#undef PG8_MMA
#undef PG8_WAIT_V
#undef PG8_WAIT_L
#undef PG8_BAR
#undef PG8_SCHED
}
}
typedef f32x4 acc_t[2][2][4][2];
#define ROWS_LOOP _Pragma("unroll") for (int ai = 0; ai < 2; ++ai) _Pragma("unroll") for (int m = 0; m < 4; ++m)
#define ROW_OF (u.pm * 256 + ai * 128 + wr * 64 + m * 16 + fr)

struct EpiIn {
    static constexpr bool DUPOK = true;
    const Params& p; int l;
    __device__ __forceinline__ void operator()(const acc_t& acc, const pg8::Unit& u, int ui, int wr, int wc, int fr, int fq) const {
        const float* ssq = p.sumsq() + (size_t)(l & 1) * T * 16;
        const int pn = u.pn, cl = wc * 4 + fq;
        __shared__ float s_rstd[256];
        { const int t_ = TID(); if (t_ < 256) s_rstd[t_] = row_rstd(ssq, u.pm * 256 + t_); __syncthreads(); }
        float rsa[8];
#pragma unroll
        for (int ix = 0; ix < 8; ++ix) rsa[ix] = s_rstd[(ix >> 2) * 128 + wr * 64 + (ix & 3) * 16 + fr];
        if (pn < 8) {
            ROWS_LOOP { const int row = ROW_OF; const float rs = rsa[ai * 4 + m];
                float zz[4], gg[4];
#pragma unroll
                for (int ch = 0; ch < 4; ++ch) { const f32x4 v = acc[ai][ch >> 1][m][ch & 1]; zz[ch] = (v[1] * rs) * (v[2] * rs); gg[ch] = (v[0] * rs) * siluf(v[3] * rs); }
                const size_t o = (size_t)row * 512 + pn * 64 + cl * 4;
                u32x2 a; a[0] = cvtpk(zz[0], zz[1]); a[1] = cvtpk(zz[2], zz[3]); *(u32x2*)(p.z() + o) = a;
                u32x2 b; b[0] = cvtpk(gg[0], gg[1]); b[1] = cvtpk(gg[2], gg[3]); *(u32x2*)(p.ga() + o) = b; }
        } else if (pn < 12 || (pn >= 16 && pn <= 18)) {
            if (pn == 18 && wc >= 1) {
                if (wc == 1 && fq == 0) {
                    ROWS_LOOP { const int row = ROW_OF; const float rs = rsa[ai * 4 + m] * 0.04419417382415922f;
                        *(f32x4*)(p.iw() + (size_t)row * 8) = acc[ai][0][m][0] * rs; *(f32x4*)(p.iw() + (size_t)row * 8 + 4) = acc[ai][0][m][1] * rs; }
                }
            } else {
                const bool isqk = pn < 12; const int which = (pn - 8) >> 1;
                int head; u16* dst; int pitch;
                if (isqk) { head = ((pn - 8) & 1) * 4 + wc; dst = which ? p.k() : p.q(); pitch = 512; }
                else if (pn < 18) { head = (pn - 16) * 4 + wc; dst = p.iq(); pitch = 512; }
                else { head = 0; dst = p.ik(); pitch = 64; }
                f32x4 g0[2], g1[2];
#pragma unroll
                for (int n = 0; n < 2; ++n) { g0[n] = (f32x4){1.f, 1.f, 1.f, 1.f}; g1[n] = g0[n]; }
                if (isqk) { const float* gg = (which ? p.k_g : p.q_g) + l * 64 + 8 * fq;
#pragma unroll
                    for (int n = 0; n < 2; ++n) { g0[n] = *(const f32x4*)(gg + 4 * n); g1[n] = *(const f32x4*)(gg + 32 + 4 * n); } }
                f32x4 rcb[2], rsb[2];
                { const int pos0 = (u.pm * 256 + wr * 64 + fr) & (SEQ - 1);
#pragma unroll
                  for (int n = 0; n < 2; ++n) { rcb[n] = *(const f32x4*)(p.ropec() + pos0 * 32 + 8 * fq + 4 * n); rsb[n] = *(const f32x4*)(p.ropes() + pos0 * 32 + 8 * fq + 4 * n); } }
                ROWS_LOOP { const int row = ROW_OF; const int ix = ai * 4 + m; const float rs = rsa[ix];
                    f32x4 a0[2], a1[2];
#pragma unroll
                    for (int n = 0; n < 2; ++n) { a0[n] = acc[ai][0][m][n] * rs; a1[n] = acc[ai][1][m][n] * rs; }
                    if (isqk) { float ss = 0.f;
#pragma unroll
                        for (int n = 0; n < 2; ++n)
#pragma unroll
                            for (int j = 0; j < 4; ++j) ss += a0[n][j] * a0[n][j] + a1[n][j] * a1[n][j];
                        ss += __shfl_xor(ss, 16); ss += __shfl_xor(ss, 32);
                        const float rn = __builtin_amdgcn_rsqf(ss * (1.f / 64.f) + RMS_EPS);
#pragma unroll
                        for (int n = 0; n < 2; ++n) { a0[n] = a0[n] * rn * g0[n]; a1[n] = a1[n] * rn * g1[n]; } }
                    u32x4 o0, o1;
#pragma unroll
                    for (int n = 0; n < 2; ++n) { const f32x4 cc = rcb[n], sn = rsb[n];
                        const f32x4 r0 = a0[n] * cc - a1[n] * sn, r1 = a1[n] * cc + a0[n] * sn;
                        o0[2 * n] = cvtpk(r0[0], r0[1]); o0[2 * n + 1] = cvtpk(r0[2], r0[3]); o1[2 * n] = cvtpk(r1[0], r1[1]); o1[2 * n + 1] = cvtpk(r1[2], r1[3]); }
                    if (ix < 7) { const int posn = (u.pm * 256 + ((ix + 1) >> 2) * 128 + wr * 64 + ((ix + 1) & 3) * 16 + fr) & (SEQ - 1);
#pragma unroll
                        for (int n = 0; n < 2; ++n) { rcb[n] = *(const f32x4*)(p.ropec() + posn * 32 + 8 * fq + 4 * n); rsb[n] = *(const f32x4*)(p.ropes() + posn * 32 + 8 * fq + 4 * n); } }
                    u16* d = dst + (size_t)row * pitch + head * 64 + 8 * fq;
                    *(u32x4*)d = o0; *(u32x4*)(d + 32) = o1; }
            }
        } else {
            u16* dst; int cb; int kind;
            if (pn < 14) { dst = p.v(); cb = (pn - 12) * 256; kind = 0; }
            else if (pn < 16) { dst = p.sg(); cb = (pn - 14) * 256; kind = 1; }
            else if (pn < 21) { dst = p.u(); cb = (pn - 19) * 256; kind = 0; }
            else { dst = p.sp(); cb = (pn - 21) * 256; kind = 2; }
            f32x4 sc[2][2];
#pragma unroll
            for (int bj = 0; bj < 2; ++bj)
#pragma unroll
                for (int n = 0; n < 2; ++n) sc[bj][n] = (kind == 2) ? *(const f32x4*)(p.pool_scale + l * 512 + cb + 16 * cl + bj * 8 + n * 4) : (f32x4){1.f, 1.f, 1.f, 1.f};
            ROWS_LOOP { const int row = ROW_OF; const float rs = rsa[ai * 4 + m];
#pragma unroll
                for (int bj = 0; bj < 2; ++bj) { f32x4 v0 = acc[ai][bj][m][0] * rs, v1 = acc[ai][bj][m][1] * rs;
                    if (kind >= 1) {
#pragma unroll
                        for (int j = 0; j < 4; ++j) { v0[j] = siluf(v0[j]) * sc[bj][0][j]; v1[j] = siluf(v1[j]) * sc[bj][1][j]; } }
                    u32x4 w; w[0] = cvtpk(v0[0], v0[1]); w[1] = cvtpk(v0[2], v0[3]); w[2] = cvtpk(v1[0], v1[1]); w[3] = cvtpk(v1[2], v1[3]);
                    *(u32x4*)(dst + (size_t)row * 512 + cb + 16 * cl + bj * 8) = w; } }
        }
    }
};
__device__ __forceinline__ void phase_in(const Params& p, int l, char* shm) {
    pg8::Gemm g{p.xb(), p.wt_in() + (size_t)l * NPA * 1024, T, NPA, 1024};
    pg8::StaticOrder S; S.init(T, NPA, GDIM(), BID());
    EpiIn E{p, l};
    pg8::gemm_phase((PG8_LAS unsigned char*)shm, g, S, E);
}
__device__ __forceinline__ void phase_mix(const Params& p, int l) {
    const float* cw = p.conv_w + l * 3 * 512;
    constexpr int RUN = 16;
    const int nitem = (T / RUN) * 256;
    const int it0 = BID() * NTHR + TID(), itstep = GDIM() * NTHR;
    for (int it = it0; it < nitem; it += itstep) {
        const int cp = it & 255, c = cp * 2, t0 = (it >> 8) * RUN, pos0 = t0 & (SEQ - 1);
        {
            const float w00 = cw[c], w01 = cw[c + 1], w10 = cw[512 + c], w11 = cw[513 + c], w20 = cw[1024 + c], w21 = cw[1025 + c];
            unsigned zr[RUN + 2], gr[RUN];
#pragma unroll
            for (int i = 0; i < RUN + 2; ++i) zr[i] = (pos0 + i - 2 >= 0) ? *(const unsigned*)(p.z() + (size_t)(t0 + i - 2) * 512 + c) : 0u;
#pragma unroll
            for (int i = 0; i < RUN; ++i) gr[i] = *(const unsigned*)(p.ga() + (size_t)(t0 + i) * 512 + c);
#pragma unroll
            for (int i = 0; i < RUN; ++i) {
                const float y0 = (w00 * bflo(zr[i]) + w10 * bflo(zr[i + 1]) + w20 * bflo(zr[i + 2])) * bflo(gr[i]);
                const float y1 = (w01 * bfhi(zr[i]) + w11 * bfhi(zr[i + 1]) + w21 * bfhi(zr[i + 2])) * bfhi(gr[i]);
                *(unsigned*)(p.ga() + (size_t)(t0 + i) * 512 + c) = cvtpk(y0, y1);
            }
        }
        {
            const int win = 2 << (c >> 7);
            unsigned ur[RUN + 15], gr[RUN];
#pragma unroll
            for (int i = 0; i < RUN + 15; ++i) ur[i] = (i >= 16 - win && pos0 + i - 15 >= 0) ? *(const unsigned*)(p.u() + (size_t)(t0 + i - 15) * 512 + c) : 0u;
#pragma unroll
            for (int i = 0; i < RUN; ++i) gr[i] = *(const unsigned*)(p.sp() + (size_t)(t0 + i) * 512 + c);
            float s0 = 0.f, s1 = 0.f;
#pragma unroll
            for (int i = 0; i < 15; ++i) { s0 += bflo(ur[i]); s1 += bfhi(ur[i]); }
#pragma unroll
            for (int i = 0; i < RUN; ++i) {
                const int pos = pos0 + i;
                const float u0 = bflo(ur[i + 15]), u1 = bfhi(ur[i + 15]);
                s0 += u0; s1 += u1;
                const float ic = __builtin_amdgcn_rcpf((float)min(pos + 1, win));
                *(unsigned*)(p.sp() + (size_t)(t0 + i) * 512 + c) = cvtpk((s0 * ic - u0) * bflo(gr[i]), (s1 * ic - u1) * bfhi(gr[i]));
                unsigned wo = 0u;
#pragma unroll
                for (int g = 0; g < 4; ++g) if (win == (2 << g)) wo = ur[i + 15 - ((2 << g) - 1)];
                s0 -= bflo(wo); s1 -= bfhi(wo);
            }
        }
    }
}

__device__ __forceinline__ int crow(int r, int hi) { return (r & 3) + 8 * (r >> 2) + 4 * hi; }
__device__ __forceinline__ size_t sc_base(int qb) { return (size_t)32768 * qb * (qb + 1); }
__device__ __forceinline__ void phase_indexer(const Params& p, int b) {
    const int tid_ = TID(); const int wid = tid_ >> 6, lane = tid_ & 63, ql = lane & 15, fq = lane >> 4; const int bid_ = BID(), gdim_ = GDIM();
    constexpr int NSTEP = 64 * 65;
    const int f0 = (int)(((long)bid_ * NSTEP) / gdim_), f1 = (int)(((long)(bid_ + 1) * NSTEP) / gdim_);
    int qcur = -1;
    bf16x8 bq[8][2]; float wv[8]; u16* srow = nullptr; int qloc = 0;
#pragma unroll
    for (int h = 0; h < 8; ++h) { wv[h] = 0.f; bq[h][0] = bq[h][1] = (bf16x8){0, 0, 0, 0, 0, 0, 0, 0}; }
    const u16* ikb = p.ik() + ((size_t)b * SEQ + ql) * 64 + fq * 8;
    for (int f = f0; f < f1; ++f) {
        int q = (int)((sqrtf(4.f * f + 1.f) - 1.f) * 0.5f);
        while ((q + 1) * (q + 2) <= f) ++q;
        while (q * (q + 1) > f) --q;
        const int tt = f - q * (q + 1);
        if (q != qcur) {
            qcur = q; qloc = q * 128 + wid * 16 + ql;
            const size_t row = (size_t)b * SEQ + qloc;
#pragma unroll
            for (int h = 0; h < 8; ++h)
#pragma unroll
                for (int kc = 0; kc < 2; ++kc) bq[h][kc] = *(const bf16x8*)(p.iq() + row * 512 + h * 64 + kc * 32 + fq * 8);
            const f32x4 x = *(const f32x4*)(p.iw() + row * 8), y = *(const f32x4*)(p.iw() + row * 8 + 4);
            wv[0] = x[0]; wv[1] = x[1]; wv[2] = x[2]; wv[3] = x[3]; wv[4] = y[0]; wv[5] = y[1]; wv[6] = y[2]; wv[7] = y[3];
            const int a = q >> 1;
            srow = p.scores() + sc_base(a) + (size_t)(qloc - a * 256) * (256 * (a + 1));
        }
        const int key0 = tt * 64;
        bf16x8 ka[4][2];
#pragma unroll
        for (int kg = 0; kg < 4; ++kg)
#pragma unroll
            for (int kc = 0; kc < 2; ++kc) ka[kg][kc] = *(const bf16x8*)(ikb + (size_t)(key0 + kg * 16) * 64 + kc * 32);
        const bool band = (key0 + 63 > q * 128 + wid * 16);
#pragma unroll
        for (int kg = 0; kg < 4; ++kg) {
            f32x4 sacc = (f32x4){0.f, 0.f, 0.f, 0.f};
#pragma unroll
            for (int h = 0; h < 8; ++h) {
                f32x4 c = (f32x4){0.f, 0.f, 0.f, 0.f};
                c = __builtin_amdgcn_mfma_f32_16x16x32_bf16(ka[kg][0], bq[h][0], c, 0, 0, 0);
                c = __builtin_amdgcn_mfma_f32_16x16x32_bf16(ka[kg][1], bq[h][1], c, 0, 0, 0);
#pragma unroll
                for (int j = 0; j < 4; ++j) sacc[j] = __builtin_fmaf(wv[h], __builtin_fmaxf(c[j], 0.f), sacc[j]);
            }
            const int kb = key0 + kg * 16 + fq * 4;
            if (band) {
#pragma unroll
                for (int j = 0; j < 4; ++j) if (kb + j > qloc) sacc[j] = -INFINITY;
            }
            union { _Float16 h[4]; u32x2 v; } pk;
            pk.h[0] = (_Float16)sacc[0]; pk.h[1] = (_Float16)sacc[1]; pk.h[2] = (_Float16)sacc[2]; pk.h[3] = (_Float16)sacc[3];
            *(u32x2*)(srow + kb) = pk.v;
        }
    }
}

__device__ __forceinline__ size_t mk_base(int qb) { return (size_t)512 * qb * (qb + 1); }
constexpr size_t MASK_WORDS_PER_BATCH = 540672;
__device__ __forceinline__ unsigned f16key(unsigned h) { return (h & 0x8000u) ? (~h & 0xffffu) : (h | 0x8000u); }
__device__ __forceinline__ void hist_scan(const unsigned* h, int lane, unsigned target, int& bin, unsigned& above, unsigned& inbin) {
    const u32x4 a = *(const u32x4*)(h + 4 * lane), b = *(const u32x4*)(h + 256 + 4 * lane), c = *(const u32x4*)(h + 512 + 4 * lane), d = *(const u32x4*)(h + 768 + 4 * lane);
    const unsigned h0 = a[0] + b[0] + c[0] + d[0], h1 = a[1] + b[1] + c[1] + d[1], h2 = a[2] + b[2] + c[2] + d[2], h3 = a[3] + b[3] + c[3] + d[3];
    const unsigned tot = h0 + h1 + h2 + h3;
    unsigned x = tot;
#pragma unroll
    for (int dd = 1; dd < 64; dd <<= 1) { const unsigned y = __shfl_down(x, dd); if (lane + dd < 64) x += y; }
    const unsigned ab = x - tot, c3 = ab + h3, c2 = c3 + h2, c1 = c2 + h1, c0 = c1 + h0;
    int fb = -1; unsigned fa = 0, fc = 0;
    if (ab < target && c3 >= target) { fb = 4 * lane + 3; fa = ab; fc = h3; }
    else if (c3 < target && c2 >= target) { fb = 4 * lane + 2; fa = c3; fc = h2; }
    else if (c2 < target && c1 >= target) { fb = 4 * lane + 1; fa = c2; fc = h1; }
    else if (c1 < target && c0 >= target) { fb = 4 * lane; fa = c1; fc = h0; }
    const u64 m = __ballot(fb >= 0); const int src = (m == 0) ? 0 : (__ffsll((unsigned long long)m) - 1);
    bin = __shfl(fb, src); above = __shfl(fa, src); inbin = __shfl(fc, src);
}
__device__ __forceinline__ unsigned f16key2(unsigned w) { const unsigned sg = (w >> 15) & 0x00010001u; return w ^ (((sg << 15) - sg) | 0x80008000u); }
__device__ __forceinline__ void phase_select(const Params& p, int b, char* shm) {
    const int tid_ = TID(); const int wid = __builtin_amdgcn_readfirstlane(tid_ >> 6), lane = tid_ & 63;
    const int gw = BID() * 8 + wid, nw = GDIM() * 8;
    unsigned* hist = (unsigned*)shm + wid * 1152;
    const int hsubi = (lane >> 4) * 256, dummyi = 1024 + lane;
    typedef unsigned short us2 __attribute__((ext_vector_type(2)));
#define ROW_T(i_) ({ const int kq_ = (i_) / nw; ((mirror && (kq_ & 1)) ? (kq_ * nw + (nw - 1 - ((i_) - kq_ * nw))) : (i_)); })
#define ROW_LOAD(t_) do { const int qb_ = (t_) >> 8, ntr_ = 2 * (((t_) >> 7) + 1), nch_ = (ntr_ + 7) >> 3; \
        const u16* sr_ = p.scores() + sc_base(qb_) + (size_t)((t_) - qb_ * 256) * (256 * (qb_ + 1)); \
        _Pragma("unroll") for (int c = 0; c < 16; ++c) { raw[c] = (u32x4){0u, 0u, 0u, 0u}; if (c < nch_) { if (lane < 8 * (ntr_ - 8 * c)) raw[c] = *(const u32x4*)(sr_ + 512 * c + 8 * lane); } } } while (0)
    const bool mirror = (SEQ % (2 * nw)) == 0;
    u32x4 raw[16];
    if (gw < SEQ) { const int t0_ = ROW_T(gw); ROW_LOAD(t0_); }
    for (int i = gw; i < SEQ; i += nw) {
        const int t = ROW_T(i);
        const int qb = t >> 8, ntile = 4 * (qb + 1), ntr = 2 * ((t >> 7) + 1);
        const int nch = (ntr + 7) >> 3, nchw = (ntile + 7) >> 3;
        unsigned char* mrow = (unsigned char*)(p.mask() + (size_t)b * MASK_WORDS_PER_BATCH + mk_base(qb) + (size_t)(t - qb * 256) * ntile);
        unsigned key[16][4];
#pragma unroll
        for (int c = 0; c < 16; ++c) {
            const bool valid = (c < nch) && (lane < 8 * (ntr - 8 * c));
#pragma unroll
            for (int r = 0; r < 4; ++r) key[c][r] = valid ? f16key2(raw[c][r]) : 0u;
        }
        if (i + nw < SEQ) { const int tn_ = ROW_T(i + nw); ROW_LOAD(tn_); }
        unsigned thrm1 = 0x03ffu, thr = 0x0400u; int need = 0; bool fast = true;
        if (t >= 256) {
            us2 a1 = (us2){0, 0}, a2 = (us2){0, 0};
#pragma unroll
            for (int c = 0; c < 16; ++c) {
                if (c < nch) {
#pragma unroll
                    for (int r = 0; r < 4; ++r) { const us2 kk = __builtin_bit_cast(us2, key[c][r]);
                        const us2 tmx = __builtin_elementwise_max(a1, kk), tmn = __builtin_elementwise_min(a1, kk); a1 = tmx; a2 = __builtin_elementwise_max(a2, tmn); }
                }
            }
            unsigned Lb = min((unsigned)a2[0], (unsigned)a2[1]);
#pragma unroll
            for (int m_ = 32; m_ >= 1; m_ >>= 1) Lb = min(Lb, (unsigned)__shfl_xor((int)Lb, m_));
            Lb = __builtin_amdgcn_readfirstlane(Lb);
            const u32x4 z4 = (u32x4){0u, 0u, 0u, 0u};
#pragma unroll
            for (int c = 0; c < 4; ++c) *(u32x4*)(hist + c * 256 + 4 * lane) = z4;
#pragma unroll
            for (int c = 0; c < 16; ++c) {
                if (c < nch) {
#pragma unroll
                    for (int r = 0; r < 4; ++r) { const unsigned kk = key[c][r]; const unsigned lo = kk & 0xffffu, hi = kk >> 16;
                        atomicAdd(hist + ((lo >= Lb) ? (hsubi + (int)(lo >> 8)) : dummyi), 1u);
                        atomicAdd(hist + ((hi >= Lb) ? (hsubi + (int)(hi >> 8)) : dummyi), 1u); }
                }
            }
            asm volatile("s_waitcnt lgkmcnt(0)" ::: "memory");
            int B1; unsigned ab1, in1;
            hist_scan(hist, lane, 256u, B1, ab1, in1);
            asm volatile("s_waitcnt lgkmcnt(0)" ::: "memory");
#pragma unroll
            for (int c = 0; c < 4; ++c) *(u32x4*)(hist + c * 256 + 4 * lane) = z4;
#pragma unroll
            for (int c = 0; c < 16; ++c) {
                if (c < nch) {
#pragma unroll
                    for (int r = 0; r < 4; ++r) { const unsigned kk = key[c][r]; const unsigned lo = kk & 0xffffu, hi = kk >> 16;
                        const bool ml = ((lo >> 8) == (unsigned)B1) && (lo >= Lb), mh = ((hi >> 8) == (unsigned)B1) && (hi >= Lb);
                        if (__any(ml || mh)) { if (ml) atomicAdd(hist + hsubi + (int)(lo & 255u), 1u); if (mh) atomicAdd(hist + hsubi + (int)(hi & 255u), 1u); } }
                }
            }
            asm volatile("s_waitcnt lgkmcnt(0)" ::: "memory");
            int B2; unsigned ab2, in2;
            hist_scan(hist, lane, 256u - ab1, B2, ab2, in2);
            asm volatile("s_waitcnt lgkmcnt(0)" ::: "memory");
            thr = __builtin_amdgcn_readfirstlane(((unsigned)B1 << 8) | (unsigned)B2);
            need = __builtin_amdgcn_readfirstlane(256 - (int)(ab1 + ab2));
            const int neq = __builtin_amdgcn_readfirstlane((int)in2);
            fast = (need == neq);
            thrm1 = thr - 1u;
        }
        if (fast) {
#pragma unroll
            for (int c = 0; c < 16; ++c) {
                if (c < nchw) {
                    unsigned m = 0u;
#pragma unroll
                    for (int ii = 7; ii >= 0; --ii) { const unsigned kk = key[c][ii >> 1]; const unsigned kv = (ii & 1) ? (kk >> 16) : (kk & 0xffffu); m = m + m + ((kv > thrm1) ? 1u : 0u); }
                    if (64 * c + lane < 8 * ntile) mrow[64 * c + lane] = (unsigned char)m;
                }
            }
        } else {
            int base = 0;
#pragma unroll 1
            for (int c = 0; c < 16; ++c) {
                if (c < nchw) {
                    unsigned m = 0u, e = 0u;
#pragma unroll
                    for (int ii = 7; ii >= 0; --ii) { unsigned kk = (ii >> 1) == 0 ? key[0][0] : 0u;
#pragma unroll
                        for (int cc = 0; cc < 16; ++cc) if (cc == c) kk = key[cc][ii >> 1];
                        const unsigned kv = (ii & 1) ? (kk >> 16) : (kk & 0xffffu); m = m + m + ((kv > thr) ? 1u : 0u); e = e + e + ((kv == thr) ? 1u : 0u); }
                    const int cnt = __builtin_popcount(e);
                    int pre = cnt;
#pragma unroll
                    for (int dd = 1; dd < 64; dd <<= 1) { const int y = __shfl_up(pre, dd); if (lane >= dd) pre += y; }
                    const int tot = __shfl(pre, 63);
                    int rank = base + pre - cnt;
#pragma unroll
                    for (int ii = 0; ii < 8; ++ii) if ((e >> ii) & 1u) { if (rank < need) m |= (1u << ii); ++rank; }
                    base += tot;
                    if (64 * c + lane < 8 * ntile) mrow[64 * c + lane] = (unsigned char)m;
                }
            }
        }
    }
}

constexpr int A_D = 64, A_DM = 512, A_NW = 8, A_QBLK = 32, A_QB = 256, A_KVBLK = 64, A_NQB = SEQ / A_QB, A_NHEAD = 8;
constexpr float A_C2 = 0.125f * 1.4426950408889634f;
constexpr int A_SLOTB = 8192, A_LDS_K = 0, A_LDS_V = 3 * A_SLOTB, A_LDS_WS = 6 * A_SLOTB, A_LDS_OST = A_LDS_WS + A_NW * 256, A_LDS_MK = A_LDS_OST + A_NW * 4096, A_LDS_BYTES = A_LDS_MK + A_NW * 2048;
#define ATTN_THR 8
#define SBAR() __builtin_amdgcn_sched_barrier(0)
#define PIN(x) asm volatile("" : "+v"(x))
#define MFMA32(a, b, c) __builtin_amdgcn_mfma_f32_32x32x16_bf16(a, b, c, 0, 0, 0)
#define WAIT_BAR(N) asm volatile("s_waitcnt vmcnt(" #N ") lgkmcnt(0)\n\ts_barrier" ::: "memory")
__device__ __forceinline__ void glds16s(const void* sbase, unsigned voff, unsigned lds_base) {
    unsigned sv; asm volatile("s_mov_b32 %0, m0\n\ts_mov_b32 m0, %3\n\ts_nop 0\n\tglobal_load_lds_dwordx4 %1, %2\n\ts_mov_b32 m0, %0" : "=&s"(sv) : "v"(voff), "s"(sbase), "s"(lds_base) : "memory"); }
typedef __attribute__((address_space(3))) const char* lds_cptr;
typedef short v4i16_t __attribute__((ext_vector_type(4)));
__device__ __forceinline__ void kload2(bf16x8* kf, lds_cptr kp, int d0) { kf[2 * d0] = *(const __attribute__((address_space(3))) bf16x8*)(kp + d0 * 2048); kf[2 * d0 + 1] = *(const __attribute__((address_space(3))) bf16x8*)(kp + d0 * 2048 + 512); }
__device__ __forceinline__ s16x4 vtr(lds_cptr p) { return __builtin_bit_cast(s16x4, __builtin_amdgcn_ds_read_tr16_b64_v4i16((__attribute__((address_space(3))) v4i16_t*)p)); }
#define MX3(a, b, c) __builtin_fmaxf(__builtin_fmaxf((a), (b)), (c))
__device__ __forceinline__ float rowmax(const f32x16& p0, const f32x16& p1) {
    float a = MX3(p0[0], p0[1], p1[0]), b = MX3(p0[2], p0[3], p1[1]); a = MX3(a, p1[2], p1[3]);
#pragma unroll
    for (int r = 4; r < 16; r += 4) { a = MX3(a, p0[r], p0[r + 1]); b = MX3(b, p0[r + 2], p0[r + 3]); a = MX3(a, p1[r], p1[r + 1]); b = MX3(b, p1[r + 2], p1[r + 3]); }
    float m = __builtin_fmaxf(a, b); auto rr = __builtin_amdgcn_permlane32_swap(__float_as_uint(m), __float_as_uint(m), false, false);
    return __builtin_fmaxf(__uint_as_float(rr[0]), __uint_as_float(rr[1])); }
__device__ __forceinline__ void cmask(f32x16& p0, f32x16& p1, int jb, int qrel, int hi) {
    const int kb = 64 * jb + 4 * hi;
#pragma unroll
    for (int r = 0; r < 16; ++r) { const int kv = kb + (r & 3) + 8 * (r >> 2); if (kv > qrel) p0[r] = -INFINITY; if (kv + 32 > qrel) p1[r] = -INFINITY; } }
__device__ __forceinline__ float mand(float x, unsigned w, int pos) { return __uint_as_float(__float_as_uint(x) & (unsigned)__builtin_amdgcn_sbfe((int)w, pos, 1)); }
#define BITP(i) (((i) & 3) + 8 * ((i) >> 2))

__device__ __forceinline__ void attn64_unit(int b, int h, int qb, const u16* Q, const u16* __restrict__ K, const u16* __restrict__ V, const u16* __restrict__ SG, u16* O, const u64* mrow0, char* lds) {
    const int tid = TID(), lane = tid & 63, r32 = lane & 31, hi = lane >> 5; const int wid = __builtin_amdgcn_readfirstlane(tid >> 6);
    const long rowbase = (long)b * SEQ; const int q0 = qb * A_QB, NT = (q0 + A_QB) / A_KVBLK;
    const u16* Qw = Q + (rowbase + q0 + wid * A_QBLK) * A_DM + h * A_D;
    const unsigned lds0 = (unsigned)(uintptr_t)lds; float* wsf = (float*)(lds + A_LDS_WS) + wid * 64;
    const u16* kbase = K + rowbase * A_DM + h * A_D; const u16* vbase = V + rowbase * A_DM + h * A_D;
    const unsigned koff = (unsigned)(lane * A_DM + wid * 8) * 2u;
    const unsigned voff = (unsigned)((16 * (wid & 3) + (lane >> 2)) * A_DM + (wid >> 2) * 32 + (lane & 3) * 8) * 2u;
    const unsigned kdst = lds0 + A_LDS_K + wid * 1024, vdst = lds0 + A_LDS_V + wid * 1024;
#define DMA_K(t, slot) glds16s(kbase + (long)(t) * A_KVBLK * A_DM, koff, (unsigned)__builtin_amdgcn_readfirstlane(kdst + (slot)))
#define DMA_V(t, slot) glds16s(vbase + (long)(t) * A_KVBLK * A_DM, voff, (unsigned)__builtin_amdgcn_readfirstlane(vdst + (slot)))
#define DMA_M(chunk) glds16s(mrow0 + 2 * (chunk), moff, (unsigned)__builtin_amdgcn_readfirstlane(mdst + ((chunk) & 1) * 1024))
#define MWORD(t) (*(const u64*)(lds + A_LDS_MK + wid * 2048 + (((t) >> 1) & 1) * 1024 + r32 * 16 + ((t) & 1) * 8))
    const lds_cptr vp0 = (lds_cptr)lds + A_LDS_V + ((lane >> 4) & 1) * 32 + (lane & 3) * 8 + (4 * hi + ((lane & 15) >> 2)) * 64;
    const lds_cptr kp0 = (lds_cptr)lds + A_LDS_K + hi * 1024 + r32 * 16;
    const int qrel = wid * A_QBLK + r32;
    const unsigned moff = (unsigned)(qrel * NT) * 8u;
    const unsigned mdst = lds0 + A_LDS_MK + wid * 2048;
    DMA_M(0);
    DMA_K(0, 0); DMA_V(0, 0); DMA_K(1, A_SLOTB);
    bf16x8 qr[4];
#pragma unroll
    for (int d0 = 0; d0 < 4; ++d0) qr[d0] = *reinterpret_cast<const bf16x8*>(&Qw[(long)r32 * A_DM + d0 * 16 + hi * 8]);
    float mhat = 0.f, l_reg = 0.f; f32x16 o[2]; o[0] = f32x16{}; o[1] = f32x16{};
    const f32x16 zero16 = f32x16{};
    bool resc = false;
    f32x16 pA0, pA1, pB0, pB1; bf16x8 kf[8]; s16x4 vlo[8], vhi[8]; u32x4 pw0, pw1, pw2, pw3;
    int sl_prev = 0, sl_cur = 0, sl_next = A_SLOTB;
    const int sh4 = 4 * hi;
#define ROT() do { sl_prev = sl_cur; sl_cur = sl_next; sl_next = (sl_next == 2 * A_SLOTB) ? 0 : sl_next + A_SLOTB; } while (0)
#define EX(v) __builtin_amdgcn_exp2f(__builtin_fmaf((v), A_C2, nmh))
#define RESC() do { if (resc) { _Pragma("unroll") for (int d_ = 0; d_ < 2; ++d_) _Pragma("unroll") for (int r = 0; r < 16; ++r) o[d_][r] *= wsf[crow(r, hi)]; } } while (0)
    DMA_K(2, 2 * A_SLOTB);
    WAIT_BAR(3);
    _Pragma("unroll") for (int d0 = 0; d0 < 4; ++d0) kload2(kf, kp0, d0);
    pA0 = MFMA32(kf[0], qr[0], zero16); pA1 = MFMA32(kf[1], qr[0], zero16); pA0 = MFMA32(kf[2], qr[1], pA0); pA1 = MFMA32(kf[3], qr[1], pA1);
    pA0 = MFMA32(kf[4], qr[2], pA0); pA1 = MFMA32(kf[5], qr[2], pA1); pA0 = MFMA32(kf[6], qr[3], pA0); pA1 = MFMA32(kf[7], qr[3], pA1);
    { const float rm = rowmax(pA0, pA1); mhat = rm * A_C2; const float nmh = -mhat;
      const u64 mw0 = MWORD(0); const unsigned wl = (unsigned)mw0 >> sh4, wh = (unsigned)(mw0 >> 32) >> sh4;
#pragma unroll
      for (int r = 0; r < 16; ++r) { pA0[r] = mand(EX(pA0[r]), wl, BITP(r)); pA1[r] = mand(EX(pA1[r]), wh, BITP(r)); } }
    WAIT_BAR(0);
    DMA_K(3, 0); DMA_V(1, A_SLOTB); ROT();
    _Pragma("unroll") for (int d0 = 0; d0 < 4; ++d0) kload2(kf, kp0 + sl_cur, d0);
    WAIT_BAR(2);
#define PKW(P, i) cvtpk(P[i], P[i + 1])
#define PAF(k) __builtin_bit_cast(bf16x8, pw##k)
#define VFR(i) (bf16x8){vlo[i][0], vlo[i][1], vlo[i][2], vlo[i][3], vhi[i][0], vhi[i][1], vhi[i][2], vhi[i][3]}
#define VRD(i) do { vlo[i] = vtr(vp_ + (((i) >> 2) * 4096 + ((i) & 3) * 1024)); vhi[i] = vtr(vp_ + (((i) >> 2) * 4096 + ((i) & 3) * 1024 + 512)); } while (0)
#define KRD(G, d0) do { if (G) { kload2(kf, kp0 + sl_next, d0); SBAR(); } } while (0)
#define GAPA(MF, a0, a1, a2, a3, W0, W1, PW) do { MF; sacc += a0; sacc += a1; sacc += a2; sacc += a3; W0; W1; PIN(PW); PIN(sacc); SBAR(); } while (0)
#define GAPB(MF, X, i, W) do { MF; X[i] = mand(EX(X[i]), W, BITP(i)); X[i + 1] = mand(EX(X[i + 1]), W, BITP(i + 1)); X[i + 2] = mand(EX(X[i + 2]), W, BITP(i + 2)); X[i + 3] = mand(EX(X[i + 3]), W, BITP(i + 3)); PIN(X); SBAR(); } while (0)
#define STEP(C0, C1, P0, P1, t, MASK, GK, GV, GL, ML) do { SBAR(); \
    if (ML) DMA_M(((t) + 1) >> 1); \
    const u64 mw_ = MWORD(t); \
    const lds_cptr vp_ = vp0 + sl_prev; \
    VRD(0); SBAR(); float sacc = P0[0] + P0[1]; \
                    GAPA(C0 = MFMA32(kf[0], qr[0], zero16), P0[2], P0[3], P0[4], P0[5],     pw0[0] = PKW(P0, 0),  pw0[1] = PKW(P0, 2),  pw0); \
    VRD(4); SBAR(); GAPA(C1 = MFMA32(kf[1], qr[0], zero16), P0[6], P0[7], P0[8], P0[9],     pw0[2] = PKW(P0, 4),  pw0[3] = PKW(P0, 6),  pw0); \
    VRD(1); SBAR(); GAPA(C0 = MFMA32(kf[2], qr[1], C0),    P0[10], P0[11], P0[12], P0[13], pw1[0] = PKW(P0, 8),  pw1[1] = PKW(P0, 10), pw1); \
    VRD(5); SBAR(); GAPA(C1 = MFMA32(kf[3], qr[1], C1),    P0[14], P0[15], P1[0], P1[1],   pw1[2] = PKW(P0, 12), pw1[3] = PKW(P0, 14), pw1); \
    VRD(2); SBAR(); GAPA(C0 = MFMA32(kf[4], qr[2], C0),    P1[2], P1[3], P1[4], P1[5],     pw2[0] = PKW(P1, 0),  pw2[1] = PKW(P1, 2),  pw2); \
    VRD(6); SBAR(); GAPA(C1 = MFMA32(kf[5], qr[2], C1),    P1[6], P1[7], P1[8], P1[9],     pw2[2] = PKW(P1, 4),  pw2[3] = PKW(P1, 6),  pw2); \
    VRD(3); SBAR(); GAPA(C0 = MFMA32(kf[6], qr[3], C0),    P1[10], P1[11], P1[12], P1[13], pw3[0] = PKW(P1, 8),  pw3[1] = PKW(P1, 10), pw3); \
    VRD(7); SBAR(); GAPA(C1 = MFMA32(kf[7], qr[3], C1),    P1[14], P1[15], 0.f, 0.f,       pw3[2] = PKW(P1, 12), pw3[3] = PKW(P1, 14), pw3); \
    l_reg += sacc; \
    if (GK) DMA_K((t) + 3, sl_cur); if (GV) DMA_V((t) + 1, sl_next); \
    { const float rm = __builtin_fmaf(rowmax(C0, C1), A_C2, -mhat); resc = false; \
      if (__builtin_expect(__any(rm > (float)ATTN_THR), 0)) { const float dl = __builtin_fmaxf(rm, 0.f); mhat += dl; \
          const float f = __builtin_amdgcn_exp2f(-dl); l_reg *= f; if (hi == 0) wsf[r32] = f; resc = true; } } \
    const float nmh = -mhat; const unsigned wl_ = (unsigned)(mw_) >> sh4, wh_ = (unsigned)((mw_) >> 32) >> sh4; SBAR(); \
    GAPB(o[0] = MFMA32(PAF(0), VFR(0), o[0]), C0, 0, wl_);              GAPB(o[1] = MFMA32(PAF(0), VFR(4), o[1]), C0, 4, wl_); \
    KRD(GL, 0); GAPB(o[0] = MFMA32(PAF(1), VFR(1), o[0]), C0, 8, wl_);  KRD(GL, 1); GAPB(o[1] = MFMA32(PAF(1), VFR(5), o[1]), C0, 12, wl_); \
    KRD(GL, 2); GAPB(o[0] = MFMA32(PAF(2), VFR(2), o[0]), C1, 0, wh_);  KRD(GL, 3); GAPB(o[1] = MFMA32(PAF(2), VFR(6), o[1]), C1, 4, wh_); \
    GAPB(o[0] = MFMA32(PAF(3), VFR(3), o[0]), C1, 8, wh_);              GAPB(o[1] = MFMA32(PAF(3), VFR(7), o[1]), C1, 12, wh_); \
    } while (0)
    int t = 1;
    for (; t + 5 < NT; t += 2) {
        STEP(pB0, pB1, pA0, pA1, t, false, true, true, true, true);      WAIT_BAR(2); RESC(); ROT();
        STEP(pA0, pA1, pB0, pB1, t + 1, false, true, true, true, false); WAIT_BAR(2); RESC(); ROT();
    }
#define ENDW(tt) do { if ((tt) + 3 < NT) { WAIT_BAR(2); } else if ((tt) + 2 < NT) { WAIT_BAR(1); } else { WAIT_BAR(0); } } while (0)
    for (; t + 1 < NT; t += 2) {
        STEP(pB0, pB1, pA0, pA1, t, true, (t + 3 < NT), (t + 1 < NT), (t + 1 < NT), (t + 1 < NT));         ENDW(t);     RESC(); ROT();
        STEP(pA0, pA1, pB0, pB1, t + 1, true, (t + 4 < NT), (t + 2 < NT), (t + 2 < NT), false);            ENDW(t + 1); RESC(); ROT();
    }
    STEP(pB0, pB1, pA0, pA1, NT - 1, true, false, false, false, false); RESC();
    { float sacc = pB0[0] + pB0[1];
#pragma unroll
      for (int r = 2; r < 16; ++r) sacc += pB0[r];
#pragma unroll
      for (int r = 0; r < 16; ++r) sacc += pB1[r];
      l_reg += sacc;
      pw0 = (u32x4){PKW(pB0, 0), PKW(pB0, 2), PKW(pB0, 4), PKW(pB0, 6)}; pw1 = (u32x4){PKW(pB0, 8), PKW(pB0, 10), PKW(pB0, 12), PKW(pB0, 14)};
      pw2 = (u32x4){PKW(pB1, 0), PKW(pB1, 2), PKW(pB1, 4), PKW(pB1, 6)}; pw3 = (u32x4){PKW(pB1, 8), PKW(pB1, 10), PKW(pB1, 12), PKW(pB1, 14)};
      const lds_cptr vp_ = vp0 + sl_cur; _Pragma("unroll") for (int i = 0; i < 8; ++i) VRD(i);
      o[0] = MFMA32(PAF(0), VFR(0), o[0]); o[1] = MFMA32(PAF(0), VFR(4), o[1]); o[0] = MFMA32(PAF(1), VFR(1), o[0]); o[1] = MFMA32(PAF(1), VFR(5), o[1]);
      o[0] = MFMA32(PAF(2), VFR(2), o[0]); o[1] = MFMA32(PAF(2), VFR(6), o[1]); o[0] = MFMA32(PAF(3), VFR(3), o[0]); o[1] = MFMA32(PAF(3), VFR(7), o[1]); }
    { auto rr = __builtin_amdgcn_permlane32_swap(__float_as_uint(l_reg), __float_as_uint(l_reg), false, false); l_reg = __uint_as_float(rr[0]) + __uint_as_float(rr[1]); }
    if (hi == 0) wsf[32 + r32] = l_reg; asm volatile("s_waitcnt lgkmcnt(0)" ::: "memory");
    float rli[16];
#pragma unroll
    for (int r = 0; r < 16; ++r) rli[r] = __builtin_amdgcn_rcpf(wsf[32 + crow(r, hi)]);
    u16* Ow = O + (rowbase + q0 + wid * A_QBLK) * A_DM + h * A_D; const u16* Gw = SG + (rowbase + q0 + wid * A_QBLK) * A_DM + h * A_D;
    u16* stg = (u16*)(lds + A_LDS_OST) + wid * 2048;
#pragma unroll
    for (int r = 0; r < 16; ++r) { const int orow = crow(r, hi);
#pragma unroll
        for (int d0 = 0; d0 < 2; ++d0) stg[orow * 64 + d0 * 32 + r32] = f2bf(o[d0][r] * rli[r]); }
    asm volatile("s_waitcnt lgkmcnt(0)" ::: "memory");
#pragma unroll
    for (int i = 0; i < 4; ++i) { const int row = i * 8 + (lane >> 3), ch = lane & 7;
        u32x4 ov = *(const u32x4*)(stg + row * 64 + ch * 8); u32x4 gv = *(const u32x4*)(Gw + (long)row * A_DM + ch * 8); u32x4 rv;
#pragma unroll
        for (int e = 0; e < 4; ++e) rv[e] = cvtpk(bflo(ov[e]) * bflo(gv[e]), bfhi(ov[e]) * bfhi(gv[e]));
        *(u32x4*)(Ow + (long)row * A_DM + ch * 8) = rv; }
    asm volatile("s_waitcnt vmcnt(0) lgkmcnt(0)\n\ts_barrier" ::: "memory");
#undef DMA_K
#undef DMA_V
#undef DMA_M
#undef MWORD
#undef ROT
#undef EX
#undef RESC
#undef PKW
#undef PAF
#undef VFR
#undef VRD
#undef KRD
#undef ENDW
#undef GAPA
#undef GAPB
#undef STEP
}
__device__ __forceinline__ void phase_attn(const Params& p, char* lds) {
    constexpr int NPAIR = A_NQB / 2, NUNIT = NBATCH * A_NHEAD * NPAIR;
    const int bid_ = BID(), gdim_ = GDIM();
    for (int u = bid_; u < NUNIT; u += gdim_) {
        const int x = u & 7, kk = u >> 3, bh = x + 8 * (kk / NPAIR), j = kk % NPAIR;
        const int b = bh / A_NHEAD, h = bh % A_NHEAD;
        const u64* mb = p.mask() + (size_t)b * MASK_WORDS_PER_BATCH;
        attn64_unit(b, h, j, p.q(), p.k(), p.v(), p.sg(), p.bin(), mb + mk_base(j), lds);
        attn64_unit(b, h, A_NQB - 1 - j, p.q(), p.k(), p.v(), p.sg(), p.bin(), mb + mk_base(A_NQB - 1 - j), lds);
    }
}

struct EpiStash {
    static constexpr bool DUPOK = false;
    u16* stash;
    __device__ __forceinline__ void operator()(const acc_t& acc, const pg8::Unit& u, int ui, int wr, int wc, int fr, int fq) const {
        const int tid_ = TID();
        u32x4* st = (u32x4*)(stash + (size_t)(u.pm * 4 + u.pn) * 65536);
        ROWS_LOOP {
#pragma unroll
            for (int bj = 0; bj < 2; ++bj) { const f32x4 v0 = acc[ai][bj][m][0], v1 = acc[ai][bj][m][1];
                u32x4 w; w[0] = cvtpk(v0[0], v0[1]); w[1] = cvtpk(v0[2], v0[3]); w[2] = cvtpk(v1[0], v1[1]); w[3] = cvtpk(v1[2], v1[3]);
                st[((ai * 4 + m) * 2 + bj) * 512 + tid_] = w; } }
    }
};
struct EpiGate {
    static constexpr bool DUPOK = false;
    const Params& p; int l; int br;
    __device__ __forceinline__ void operator()(const acc_t& acc, const pg8::Unit& u, int ui, int wr, int wc, int fr, int fq) const {
        const float* ssq = p.sumsq() + (size_t)(l & 1) * T * 16;
        const int tid_ = TID();
        const u32x4* st = (const u32x4*)(p.stash() + (size_t)(u.pm * 4 + u.pn) * 65536);
        const int cl = wc * 4 + fq;
        __shared__ float s_rstd[256];
        { if (tid_ < 256) s_rstd[tid_] = row_rstd(ssq, u.pm * 256 + tid_); __syncthreads(); }
        float rsa[8];
#pragma unroll
        for (int ix = 0; ix < 8; ++ix) rsa[ix] = s_rstd[(ix >> 2) * 128 + wr * 64 + (ix & 3) * 16 + fr];
        const char* stp = (const char*)st + (size_t)tid_ * 16;
        char* mpp = (char*)(p.merged() + (size_t)(u.pm * 256 + wr * 64 + fr) * 1024 + u.pn * 256 + 16 * cl);
        u32x4 yb = *(const u32x4*)stp, ob = (br > 0) ? *(const u32x4*)mpp : (u32x4){0u, 0u, 0u, 0u};
        ROWS_LOOP { const int ix = ai * 4 + m; const float rs = rsa[ix];
#pragma unroll
            for (int bj = 0; bj < 2; ++bj) { const f32x4 v0 = acc[ai][bj][m][0] * rs, v1 = acc[ai][bj][m][1] * rs;
                float r[8];
                r[0] = sigmf(v0[0]) * bflo(yb[0]); r[1] = sigmf(v0[1]) * bfhi(yb[0]); r[2] = sigmf(v0[2]) * bflo(yb[1]); r[3] = sigmf(v0[3]) * bfhi(yb[1]);
                r[4] = sigmf(v1[0]) * bflo(yb[2]); r[5] = sigmf(v1[1]) * bfhi(yb[2]); r[6] = sigmf(v1[2]) * bflo(yb[3]); r[7] = sigmf(v1[3]) * bfhi(yb[3]);
                if (br > 0) {
#pragma unroll
                    for (int e = 0; e < 4; ++e) { r[2 * e] += bflo(ob[e]); r[2 * e + 1] += bfhi(ob[e]); } }
                u32x4 wo; wo[0] = cvtpk(r[0], r[1]); wo[1] = cvtpk(r[2], r[3]); wo[2] = cvtpk(r[4], r[5]); wo[3] = cvtpk(r[6], r[7]);
                const char* stn = stp + 8192; char* mpn = (bj == 0) ? (mpp + 16) : (mpp - 16 + ((ix == 3) ? 80 : 16) * 2048);
                asm volatile("" : "+v"(stn), "+v"(mpn));
                if (!(ix == 7 && bj == 1)) { yb = *(const u32x4*)stn; if (br > 0) ob = *(const u32x4*)mpn; }
                *(u32x4*)mpp = wo;
                stp = stn; mpp = mpn; } }
    }
};
__device__ __forceinline__ void phase_merge(const Params& p, int l, char* shm) {
    pg8::RowOrder S{4, 512, GDIM(), BID()};
    for (int br = 0; br < 3; ++br) {
        const u16* Ain = br == 0 ? p.ga() : (br == 1 ? p.bin() : p.sp());
        const u16* Wy = (br == 0 ? p.wt_oa() : (br == 1 ? p.wt_ob() : p.wt_oc())) + (size_t)l * 1024 * 512;
        { pg8::Gemm g{Ain, Wy, T, 1024, 512}; EpiStash E{p.stash()}; pg8::gemm_phase((PG8_LAS unsigned char*)shm, g, S, E); }
        { pg8::Gemm g{p.xb(), p.wt_mg() + (size_t)l * 3072 * 1024 + (size_t)br * 1024 * 1024, T, 1024, 1024}; EpiGate E{p, l, br}; pg8::gemm_phase((PG8_LAS unsigned char*)shm, g, S, E); }
    }
}

struct EpiOut {
    static constexpr bool DUPOK = false;
    const Params& p; int l;
    __device__ __forceinline__ void operator()(const acc_t& acc, const pg8::Unit& u, int ui, int wr, int wc, int fr, int fq) const {
        const float* xsrc = (l == 0) ? p.x_in : p.x;
        const int cl = wc * 4 + fq;
        f32x4 xb0[2], xb1[2];
#pragma unroll
        for (int bj = 0; bj < 2; ++bj) { const size_t o = (size_t)(u.pm * 256 + wr * 64 + fr) * 1024 + u.pn * 256 + 16 * cl + bj * 8; xb0[bj] = *(const f32x4*)(xsrc + o); xb1[bj] = *(const f32x4*)(xsrc + o + 4); }
        ROWS_LOOP { const int row = ROW_OF; const int ix = ai * 4 + m; float ss = 0.f;
            f32x4 x0[2], x1[2];
#pragma unroll
            for (int bj = 0; bj < 2; ++bj) { x0[bj] = xb0[bj] + acc[ai][bj][m][0]; x1[bj] = xb1[bj] + acc[ai][bj][m][1]; }
            if (ix < 7) { const int rown = u.pm * 256 + ((ix + 1) >> 2) * 128 + wr * 64 + ((ix + 1) & 3) * 16 + fr;
#pragma unroll
                for (int bj = 0; bj < 2; ++bj) { const size_t o = (size_t)rown * 1024 + u.pn * 256 + 16 * cl + bj * 8; xb0[bj] = *(const f32x4*)(xsrc + o); xb1[bj] = *(const f32x4*)(xsrc + o + 4); } }
#pragma unroll
            for (int bj = 0; bj < 2; ++bj) { const size_t o = (size_t)row * 1024 + u.pn * 256 + 16 * cl + bj * 8;
                *(f32x4*)(p.x + o) = x0[bj]; *(f32x4*)(p.x + o + 4) = x1[bj];
                if (l < NL - 1) { u32x4 w; w[0] = cvtpk(x0[bj][0], x0[bj][1]); w[1] = cvtpk(x0[bj][2], x0[bj][3]); w[2] = cvtpk(x1[bj][0], x1[bj][1]); w[3] = cvtpk(x1[bj][2], x1[bj][3]); *(u32x4*)(p.xb() + o) = w;
#pragma unroll
                    for (int j = 0; j < 4; ++j) ss += x0[bj][j] * x0[bj][j] + x1[bj][j] * x1[bj][j]; } }
            if (l < NL - 1) { ss += __shfl_xor(ss, 16); ss += __shfl_xor(ss, 32); if (fq == 0) p.sumsq()[(size_t)((l + 1) & 1) * T * 16 + (size_t)row * 16 + u.pn * 4 + wc] = ss; } }
    }
};
__device__ __forceinline__ void phase_out(const Params& p, int l, char* shm) {
    pg8::RowOrder S{4, 512, GDIM(), BID()};
    pg8::Gemm g{p.merged(), p.wt_o() + (size_t)l * 1024 * 1024, T, 1024, 1024};
    EpiOut E{p, l};
    pg8::gemm_phase((PG8_LAS unsigned char*)shm, g, S, E);
}

enum { PH_PREP0 = 0, PH_IN, PH_MIX, PH_IDX, PH_SEL, PH_ATTN, PH_MERGE, PH_OUT };
template <int PH> __global__ __launch_bounds__(NTHR) void k_phase(Params p, int l, int b) {
    extern __shared__ __attribute__((aligned(16))) char shm[];
    if (PH == PH_PREP0) phase_prep0(p, shm);
    if (PH == PH_IN) phase_in(p, l, shm);
    if (PH == PH_MIX) phase_mix(p, l);
    if (PH == PH_IDX) phase_indexer(p, b);
    if (PH == PH_SEL) phase_select(p, b, shm);
    if (PH == PH_ATTN) phase_attn(p, shm);
    if (PH == PH_MERGE) phase_merge(p, l, shm);
    if (PH == PH_OUT) phase_out(p, l, shm);
}

#define XB_TMO      128
#define XB_XCNT(j)  (256  + 64 * (j))
#define XB_XSUB(j)  (1280 + 64 * (j))
#define XB_XGEN(j)  (2304 + 64 * (j))
#define XB_TOP      3328
#define XB_TOPGEN   3392
#define XCD_BAR_WORDS 3456
#define XB_SPIN_CAP (1u << 22)
#define LAS __attribute__((address_space(3)))
__device__ __forceinline__ unsigned xb_ld(unsigned* p)              { return __hip_atomic_load(p, __ATOMIC_RELAXED, __HIP_MEMORY_SCOPE_AGENT); }
__device__ __forceinline__ unsigned xb_add(unsigned* p, unsigned v) { return __hip_atomic_fetch_add(p, v, __ATOMIC_RELAXED, __HIP_MEMORY_SCOPE_AGENT); }
__device__ __forceinline__ unsigned xb_xcc_id() { return (unsigned)__builtin_amdgcn_s_getreg((3 << 11) | 20) & 0xFu; }
#define XB_SPIN(cond, bar) do { unsigned _sp = 0; while (cond) { __builtin_amdgcn_s_sleep(1); \
    if ((++_sp & 255u) == 0u) { if (xb_ld(&(bar)[XB_TMO])) break; if (_sp > XB_SPIN_CAP) { atomicAdd(&(bar)[XB_TMO], 1u); break; } } } } while (0)
struct XcdBarrier { unsigned* bar; unsigned x; volatile LAS unsigned* st; };
__device__ __forceinline__ XcdBarrier xcd_barrier_post(unsigned* bar, volatile LAS unsigned* st) {
    XcdBarrier b; b.bar = bar; b.x = xb_xcc_id(); b.st = st;
    if (threadIdx.x == 0) (void)xb_add(&bar[XB_XCNT(b.x)], 1u);
    return b;
}
__device__ __forceinline__ void xcd_barrier_complete(unsigned* bar, unsigned x, unsigned& nloc, unsigned& nx) {
    const unsigned G = gridDim.x * gridDim.y * gridDim.z;
    unsigned sum, cnt, mine, sp = 0u;
    for (;;) {
        sum = 0u; cnt = 0u; mine = 0u;
#pragma unroll
        for (unsigned j = 0; j < 16; ++j) { const unsigned c = xb_ld(&bar[XB_XCNT(j)]); sum += c; cnt += (c > 0u) ? 1u : 0u; mine = (j == x) ? c : mine; }
        if (sum == G) break;
        __builtin_amdgcn_s_sleep(1);
        if ((++sp & 255u) == 0u) { if (xb_ld(&bar[XB_TMO])) break; if (sp > XB_SPIN_CAP) { atomicAdd(&bar[XB_TMO], 1u); break; } }
    }
    nloc = mine > 0u ? mine : 1u; nx = cnt > 0u ? cnt : 1u;
}
__device__ __forceinline__ void xcd_barrier(const XcdBarrier& b) {
    asm volatile("s_waitcnt vmcnt(0)" ::: "memory");
    __syncthreads();
    if (threadIdx.x == 0) {
        unsigned* bar = b.bar;
        __builtin_amdgcn_s_waitcnt(0);
        unsigned nloc = b.st[0], nx = b.st[1];
        if (nloc == 0u) { xcd_barrier_complete(bar, b.x, nloc, nx); b.st[0] = nloc; b.st[1] = nx; }
        const unsigned old = xb_add(&bar[XB_XSUB(b.x)], 1u);
        const unsigned gen = old / nloc;
        if (old + 1u == (gen + 1u) * nloc) {
            __builtin_amdgcn_fence(__ATOMIC_RELEASE, "agent");
            asm volatile("s_waitcnt vmcnt(0)" ::: "memory");
            const unsigned og = xb_add(&bar[XB_TOP], 1u);
            const unsigned tg = og / nx;
            if (og + 1u == (tg + 1u) * nx) xb_add(&bar[XB_TOPGEN], 1u);
            else XB_SPIN(xb_ld(&bar[XB_TOPGEN]) == tg, bar);
            __builtin_amdgcn_fence(__ATOMIC_ACQUIRE, "agent");
            xb_add(&bar[XB_XGEN(b.x)], 1u);
            asm volatile("s_waitcnt vmcnt(0)" ::: "memory");
        } else {
            XB_SPIN(xb_ld(&bar[XB_XGEN(b.x)]) == gen, bar);
            __builtin_amdgcn_fence(__ATOMIC_ACQUIRE, "agent");
            asm volatile("s_waitcnt vmcnt(0)" ::: "memory");
        }
    }
    __syncthreads();
}

#if MEGA
typedef const __attribute__((address_space(4))) Params* kparams_t;
__device__ __forceinline__ Params load_params(kparams_t k) {
    Params q; q.x_in = k->x_in; q.norm_g = k->norm_g; q.w_in = k->w_in; q.conv_w = k->conv_w; q.w_out_conv = k->w_out_conv; q.q_g = k->q_g; q.k_g = k->k_g; q.w_out_attn = k->w_out_attn;
    q.pool_w = k->pool_w; q.pool_scale = k->pool_scale; q.w_out_pool = k->w_out_pool; q.w_o = k->w_o; q.x = k->x; q.ws = k->ws; return q; }
#define PHP(q) kparams_t kq_##q = kp; asm volatile("" : "+s"(kq_##q)); const Params q = load_params(kq_##q);
__global__ __launch_bounds__(NTHR) void k_mega(Params p_unused) {
    extern __shared__ __attribute__((aligned(16))) char shm[];
    cg::grid_group grid = cg::this_grid();
    kparams_t kp = (kparams_t)__builtin_amdgcn_kernarg_segment_ptr();
    __shared__ uint4 xb_words;
    if (threadIdx.x == 0) xb_words = make_uint4(0u, 0u, 0u, 0u);
    __syncthreads();
    const XcdBarrier xb = xcd_barrier_post((unsigned*)(kp->ws + WS_BAR), (volatile LAS unsigned*)&xb_words);

#ifndef SK_PREP
        { PHP(p) phase_prep0(p, shm); }
#endif
#ifdef DUP_PREP
        { PHP(p) phase_prep0(p, shm); }
#endif

    grid.sync();
    for (int l = 0; l < NL; ++l) {

#ifndef SK_IN
        { PHP(p) phase_in(p, l, shm); }
#endif
#ifdef DUP_IN
        { PHP(p) phase_in(p, l, shm); }
#endif

        xcd_barrier(xb);

#ifndef SK_MIX
        { PHP(p) phase_mix(p, l); }
#endif

        for (int b = 0; b < NBATCH; ++b) {

#ifndef SK_IDX
        { PHP(p) phase_indexer(p, b); }
#endif
#ifdef DUP_IDX
        { PHP(p) phase_indexer(p, b); }
#endif

            xcd_barrier(xb);

#ifndef SK_SEL
        { PHP(p) phase_select(p, b, shm); }
#endif
#ifdef DUP_SEL
        { PHP(p) phase_select(p, b, shm); }
#endif

            xcd_barrier(xb);
        }

#ifndef SK_ATTN
        { PHP(p) phase_attn(p, shm); }
#endif
#ifdef DUP_ATTN
        { PHP(p) phase_attn(p, shm); }
#endif

        xcd_barrier(xb);

#ifndef SK_MERGE
        { PHP(p) phase_merge(p, l, shm); }
#endif
#ifdef DUP_MERGE
        { PHP(p) phase_merge(p, l, shm); }
#endif

        xcd_barrier(xb);

#ifndef SK_OUT
        { PHP(p) phase_out(p, l, shm); }
#endif

        xcd_barrier(xb);
    }
}
#endif

static Params make_params(void* const* d_in, void* d_out, void* d_ws) {
    Params p{};
    p.x_in = (const float*)d_in[0]; p.norm_g = (const float*)d_in[1]; p.w_in = (const float*)d_in[2]; p.conv_w = (const float*)d_in[3];
    p.w_out_conv = (const float*)d_in[4]; p.q_g = (const float*)d_in[5]; p.k_g = (const float*)d_in[6]; p.w_out_attn = (const float*)d_in[7];
    p.pool_w = (const float*)d_in[8]; p.pool_scale = (const float*)d_in[9]; p.w_out_pool = (const float*)d_in[10]; p.w_o = (const float*)d_in[11];
    p.x = (float*)d_out; p.ws = (char*)d_ws;
    return p;
}

extern "C" void kernel_launch(void* const* d_in, const int* in_sizes, int n_in, void* d_out, int out_size, void* d_ws, size_t ws_size, hipStream_t stream) {
    if (ws_size < WS_NEEDED) { fprintf(stderr, "workspace too small: %zu < %zu\n", ws_size, (size_t)WS_NEEDED); return; }
    Params p = make_params(d_in, d_out, d_ws);
    static int grid = 0;
    if (!grid) { int dev = 0, cus = 0; hipGetDevice(&dev); hipDeviceGetAttribute(&cus, hipDeviceAttributeMultiprocessorCount, dev); if (cus <= 0 || cus > 256) cus = 256; grid = (cus / 8) * 8; }
#if MEGA
    static bool attr = false;
    if (!attr) { hipFuncSetAttribute((const void*)k_mega, hipFuncAttributeMaxDynamicSharedMemorySize, LDS_BYTES); attr = true; }
    hipMemsetAsync((char*)d_ws + WS_BAR, 0, 16384, stream);
    void* args[] = {&p};
    hipError_t e = hipLaunchCooperativeKernel((void*)k_mega, dim3(grid), dim3(NTHR), args, LDS_BYTES, stream);
    if (e != hipSuccess) fprintf(stderr, "cooperative launch failed: %s\n", hipGetErrorString(e));
#else
    static bool attr = false;
    if (!attr) {
        hipFuncSetAttribute((const void*)k_phase<PH_PREP0>, hipFuncAttributeMaxDynamicSharedMemorySize, LDS_BYTES);
        hipFuncSetAttribute((const void*)k_phase<PH_IN>, hipFuncAttributeMaxDynamicSharedMemorySize, LDS_BYTES);
        hipFuncSetAttribute((const void*)k_phase<PH_MIX>, hipFuncAttributeMaxDynamicSharedMemorySize, LDS_BYTES);
        hipFuncSetAttribute((const void*)k_phase<PH_IDX>, hipFuncAttributeMaxDynamicSharedMemorySize, LDS_BYTES);
        hipFuncSetAttribute((const void*)k_phase<PH_SEL>, hipFuncAttributeMaxDynamicSharedMemorySize, LDS_BYTES);
        hipFuncSetAttribute((const void*)k_phase<PH_ATTN>, hipFuncAttributeMaxDynamicSharedMemorySize, LDS_BYTES);
        hipFuncSetAttribute((const void*)k_phase<PH_MERGE>, hipFuncAttributeMaxDynamicSharedMemorySize, LDS_BYTES);
        hipFuncSetAttribute((const void*)k_phase<PH_OUT>, hipFuncAttributeMaxDynamicSharedMemorySize, LDS_BYTES);
        attr = true;
    }
#define LAUNCH(PH, l, b) hipLaunchKernelGGL(k_phase<PH>, dim3(grid), dim3(NTHR), LDS_BYTES, stream, p, l, b)
    LAUNCH(PH_PREP0, 0, 0);
    for (int l = 0; l < NL; ++l) {
        LAUNCH(PH_IN, l, 0);
        LAUNCH(PH_MIX, l, 0);
        for (int b = 0; b < NBATCH; ++b) { LAUNCH(PH_IDX, l, b); LAUNCH(PH_SEL, l, b); }
        LAUNCH(PH_ATTN, l, 0);
        LAUNCH(PH_MERGE, l, 0);
        LAUNCH(PH_OUT, l, 0);
    }
#endif
}
```

```cpp
#include <hip/hip_runtime.h>
#include <hip/hip_cooperative_groups.h>
#include <stdint.h>
#include <stdio.h>
namespace cg = cooperative_groups;

typedef unsigned short u16;
typedef unsigned long long u64;
typedef __attribute__((ext_vector_type(8))) short bf16x8;
typedef __attribute__((ext_vector_type(4))) short s16x4;
typedef __attribute__((ext_vector_type(4))) float f32x4;
typedef __attribute__((ext_vector_type(16))) float f32x16;
typedef __attribute__((ext_vector_type(4))) unsigned u32x4;
typedef __attribute__((ext_vector_type(2))) unsigned u32x2;

#ifndef MEGA
#define MEGA 1
#endif
__device__ __forceinline__ int TID() { int t = threadIdx.x; asm volatile("" : "+v"(t)); return t; }
__device__ __forceinline__ int BID() { int t = blockIdx.x; asm volatile("" : "+s"(t)); return t; }
__device__ __forceinline__ int GDIM() { int t = gridDim.x; asm volatile("" : "+s"(t)); return t; }

constexpr int SEQ = 8192, NBATCH = 4, T = NBATCH * SEQ, DMODEL = 1024, NL = 4, INW = 8776;
constexpr int NPA = 5888;
constexpr int NTHR = 512;
constexpr int LDS_BYTES = 131072;
constexpr float RMS_EPS = 1e-6f;

struct Params {
    const float *x_in, *norm_g, *w_in, *conv_w, *w_out_conv, *q_g, *k_g, *w_out_attn, *pool_w, *pool_scale, *w_out_pool, *w_o;
    float* x; char* ws;
    __device__ __forceinline__ u16* xb() const { return (u16*)(ws + 0ull); }
    __device__ __forceinline__ u16* ga() const { return (u16*)(ws + 67108864ull); }
    __device__ __forceinline__ u16* q() const { return (u16*)(ws + 100663296ull); }
    __device__ __forceinline__ u16* k() const { return (u16*)(ws + 134217728ull); }
    __device__ __forceinline__ u16* v() const { return (u16*)(ws + 167772160ull); }
    __device__ __forceinline__ u16* sg() const { return (u16*)(ws + 201326592ull); }
    __device__ __forceinline__ u16* iq() const { return (u16*)(ws + 234881024ull); }
    __device__ __forceinline__ u16* sp() const { return (u16*)(ws + 268435456ull); }
    __device__ __forceinline__ u16* z() const { return (u16*)(ws + 301989888ull); }
    __device__ __forceinline__ u16* u() const { return (u16*)(ws + 335544320ull); }
    __device__ __forceinline__ u16* zuspare() const { return (u16*)(ws + 369098752ull); }
    __device__ __forceinline__ u16* ik() const { return (u16*)(ws + 371195904ull); }
    __device__ __forceinline__ float* iw() const { return (float*)(ws + 375390208ull); }
    __device__ __forceinline__ u16* wt_in() const { return (u16*)(ws + 376438784ull); }
    __device__ __forceinline__ u16* wt_mg() const { return (u16*)(ws + 424673280ull); }
    __device__ __forceinline__ u16* wt_oa() const { return (u16*)(ws + 449839104ull); }
    __device__ __forceinline__ u16* wt_ob() const { return (u16*)(ws + 454033408ull); }
    __device__ __forceinline__ u16* wt_oc() const { return (u16*)(ws + 458227712ull); }
    __device__ __forceinline__ u16* wt_o() const { return (u16*)(ws + 462422016ull); }
    __device__ __forceinline__ float* ropec() const { return (float*)(ws + 470810624ull); }
    __device__ __forceinline__ float* ropes() const { return (float*)(ws + 471859200ull); }
    __device__ __forceinline__ float* sumsq() const { return (float*)(ws + 472907776ull); }
    __device__ __forceinline__ u64* mask() const { return (u64*)(ws + 477102080ull); }
    __device__ __forceinline__ u16* scores() const { return (u16*)(ws + 494403584ull); }
    __device__ __forceinline__ u16* scores2() const { return z(); }
    __device__ __forceinline__ u16* stash() const { return scores(); }
    __device__ __forceinline__ u16* merged() const { return q(); }
    __device__ __forceinline__ u16* bin() const { return iq(); }
};
constexpr size_t WS_BAR = 563609600ull;
constexpr size_t WS_NEEDED = WS_BAR + 16384;


__device__ __forceinline__ unsigned cvtpk(float lo, float hi) { unsigned r; asm("v_cvt_pk_bf16_f32 %0, %1, %2" : "=v"(r) : "v"(lo), "v"(hi)); return r; }
__device__ __forceinline__ u16 f2bf(float f) { return (u16)(cvtpk(f, 0.f) & 0xffffu); }
__device__ __forceinline__ float bf2f(u16 b) { return __uint_as_float(((unsigned)b) << 16); }
__device__ __forceinline__ float bflo(unsigned w) { return __uint_as_float(w << 16); }
__device__ __forceinline__ float bfhi(unsigned w) { return __uint_as_float(w & 0xffff0000u); }
__device__ __forceinline__ float siluf(float x) { return x * __builtin_amdgcn_rcpf(1.f + __builtin_amdgcn_exp2f(x * -1.4426950408889634f)); }
__device__ __forceinline__ float sigmf(float x) { return __builtin_amdgcn_rcpf(1.f + __builtin_amdgcn_exp2f(x * -1.4426950408889634f)); }

__device__ __forceinline__ float row_rstd(const float* ssp, int row) {
    const f32x4* q = (const f32x4*)(ssp + (size_t)row * 16);
    const f32x4 a = q[0], b = q[1], c = q[2], d = q[3];
    const float s = ((a[0] + a[1]) + (a[2] + a[3])) + ((b[0] + b[1]) + (b[2] + b[3])) + ((c[0] + c[1]) + (c[2] + c[3])) + ((d[0] + d[1]) + (d[2] + d[3]));
    return __builtin_amdgcn_rsqf(s * (1.f / 1024.f) + RMS_EPS);
}
__device__ __forceinline__ int lc_of_tc(int tc) { int bj = tc >> 7, wc = (tc >> 5) & 3, n = (tc >> 4) & 1, fq = (tc >> 2) & 3, j = tc & 3; return ((wc * 4 + fq) << 4) + bj * 8 + n * 4 + j; }
__device__ __forceinline__ int tc_of_lc(int lc) { int cl = lc >> 4, s = lc & 15, wc = cl >> 2, fq = cl & 3, bj = s >> 3, n = (s >> 2) & 1, j = s & 3; return bj * 128 + wc * 32 + n * 16 + fq * 4 + j; }

__device__ __forceinline__ int src_col_in(int np) {
    int pn = np >> 8, tc = np & 255;
    int bj = tc >> 7, wc = (tc >> 5) & 3, n = (tc >> 4) & 1, fq = (tc >> 2) & 3, j = tc & 3, cl = wc * 4 + fq, s = bj * 8 + n * 4 + j, lc = cl * 16 + s;
    int d = (s < 8) ? (8 * fq + s) : (8 * fq + 32 + (s - 8));
    if (pn < 8) return (s & 3) * 512 + pn * 64 + cl * 4 + (s >> 2);
    if (pn < 12) { int which = (pn - 8) >> 1, head = ((pn - 8) & 1) * 4 + wc; return 2048 + which * 512 + head * 64 + d; }
    if (pn < 14) return 3072 + (pn - 12) * 256 + lc;
    if (pn < 16) return 3584 + (pn - 14) * 256 + lc;
    if (pn < 18) { int head = (pn - 16) * 4 + wc; return 4096 + head * 64 + d; }
    if (pn == 18) { if (wc == 0) return 4608 + d; if (wc == 1 && fq == 0 && s < 8) return 4672 + s; return -1; }
    if (pn < 21) return -2;
    return 5192 + (pn - 21) * 256 + lc;
}

__device__ __forceinline__ void prep_x(const Params& p) {
    const int tid_ = TID(); const int lane = tid_ & 63, gw = BID() * (NTHR / 64) + (tid_ >> 6), nw = GDIM() * (NTHR / 64);
    for (int row = gw; row < T; row += nw) {
        const float4* src = (const float4*)(p.x_in + (size_t)row * DMODEL);
        float ss = 0.f;
#pragma unroll
        for (int i = 0; i < 4; ++i) {
            float4 v = src[i * 64 + lane];
            ss += v.x * v.x + v.y * v.y + v.z * v.z + v.w * v.w;
            u32x2 o; o[0] = cvtpk(v.x, v.y); o[1] = cvtpk(v.z, v.w);
            *(u32x2*)(p.xb() + (size_t)row * DMODEL + (i * 64 + lane) * 4) = o;
        }
#pragma unroll
        for (int m = 32; m >= 1; m >>= 1) ss += __shfl_xor(ss, m);
        if (lane < 16) p.sumsq()[(size_t)row * 16 + lane] = (lane == 0) ? ss : 0.f;
    }
}
__device__ __forceinline__ void prep_rope(const Params& p) {
    const int i0 = BID() * NTHR + TID(), istep = GDIM() * NTHR;
    for (int i = i0; i < SEQ * 32; i += istep) {
        int pos = i >> 5, j = i & 31;
        float inv = 1.0f / powf(10000.0f, (float)(2 * j) / 64.0f);
        float ang = (float)pos * inv;
        p.ropec()[i] = cosf(ang); p.ropes()[i] = sinf(ang);
    }
}
__device__ __forceinline__ void prep_wt(const float* src, int lds_, const float* scale, u16* dst, int K, int NP, int mode, float* tile) {
    const int tid_ = TID(); const int tx = tid_ & 63, ty = tid_ >> 6; const int bid_ = BID(), gdim_ = GDIM();
    const int ntn = NP / 64, ntk = K / 64;
    for (int t = bid_; t < ntn * ntk; t += gdim_) {
        const int n0 = (t / ntk) * 64, k0 = (t % ntk) * 64;
        int np = n0 + tx, col;
        if (mode == 0) col = src_col_in(np);
        else if (mode == 1) col = 5704 + (np & ~255) + lc_of_tc(np & 255);
        else col = (np & ~255) + lc_of_tc(np & 255);
        __syncthreads();
#pragma unroll
        for (int i = 0; i < 8; ++i) { int kk = ty + 8 * i; tile[kk * 65 + tx] = (col >= 0) ? src[(size_t)(k0 + kk) * lds_ + col] : 0.f; }
        __syncthreads();
        const float sc = scale ? scale[k0 + tx] : 1.f;
#pragma unroll
        for (int i = 0; i < 8; ++i) {
            int nn = ty + 8 * i; int npo = n0 + nn;
            bool skip = (mode == 0) && ((npo >> 8) == 19 || (npo >> 8) == 20);
            if (!skip) dst[(size_t)npo * K + k0 + tx] = f2bf(tile[tx * 65 + nn] * sc);
        }
    }
}
__device__ __forceinline__ void prep_fold(const float* win, const float* ng, const float* pw, u16* wt_in) {
    const int i0 = BID() * NTHR + TID(), istep = GDIM() * NTHR;
    for (int i = i0; i < 1024 * 512; i += istep) {
        int k = i >> 9, n = i & 511, g = n >> 7, d = n & 127;
        const float* wr = win + (size_t)k * INW + 4680 + g * 128;
        const float* pp = pw + (size_t)g * 128 * 128 + d;
        float acc = 0.f;
        for (int c = 0; c < 128; ++c) acc += wr[c] * pp[c * 128];
        int row = (19 + (n >> 8)) * 256 + tc_of_lc(n & 255);
        wt_in[(size_t)row * 1024 + k] = f2bf(acc * ng[k]);
    }
}
__device__ __forceinline__ void phase_prep0(const Params& p, char* shm) {
    prep_x(p); prep_rope(p);
    float* tile = (float*)shm;
    for (int l = 0; l < NL; ++l) {
        const float* ng = p.norm_g + l * 1024;
        const float* win = p.w_in + (size_t)l * 1024 * INW;
        prep_wt(win, INW, ng, p.wt_in() + (size_t)l * NPA * 1024, 1024, NPA, 0, tile);
        prep_wt(win, INW, ng, p.wt_mg() + (size_t)l * 3072 * 1024, 1024, 3072, 1, tile);
        prep_wt(p.w_out_conv + (size_t)l * 512 * 1024, 1024, nullptr, p.wt_oa() + (size_t)l * 1024 * 512, 512, 1024, 2, tile);
        prep_wt(p.w_out_attn + (size_t)l * 512 * 1024, 1024, nullptr, p.wt_ob() + (size_t)l * 1024 * 512, 512, 1024, 2, tile);
        prep_wt(p.w_out_pool + (size_t)l * 512 * 1024, 1024, nullptr, p.wt_oc() + (size_t)l * 1024 * 512, 512, 1024, 2, tile);
        prep_wt(p.w_o + (size_t)l * 1024 * 1024, 1024, nullptr, p.wt_o() + (size_t)l * 1024 * 1024, 1024, 1024, 3, tile);
        prep_fold(win, ng, p.pool_w + (size_t)l * 4 * 128 * 128, p.wt_in() + (size_t)l * NPA * 1024);
    }
}

namespace pg8 {
#define PG8_LAS __attribute__((address_space(3)))
typedef unsigned short bf16_t;
constexpr int BM = 256, BK = 64, HALF = 128, HTB = HALF * BK * 2, STAGE_BYTES = 8 * HTB;
__device__ __forceinline__ int lds_byte(int r, int c) { const int st = (r >> 4) * 2 + (c >> 5), rr = r & 15, cc = c & 31, ob = rr * 64 + cc * 2; return st * 1024 + (ob ^ (((ob >> 9) & 1) << 5)); }
__device__ __forceinline__ void stage_rc(int b, int& R, int& C) { const int st = b / 1024, sb = b % 1024, swz = sb ^ (((sb >> 9) & 1) << 5); R = (st >> 1) * 16 + swz / 64; C = (st & 1) * 32 + (swz % 64) / 2; }
struct Unit { int pm, pn; };
struct Gemm { const bf16_t* A; const bf16_t* Bt; int M, N, K; };
constexpr int NXCD = 8, WGM = 8;
struct StaticOrder {
    int nM, nN, nwg, G, c;
    __device__ void init(int M, int N, int G_, int c_) { nM = M / BM; nN = N / BM; nwg = nM * nN; G = G_; c = c_; }
    __device__ bool next(int i, Unit& u) const {
        const long L = (long)i * G + c; if (L >= nwg) return false;
        int wgid = (int)L; { const int q = nwg / NXCD, r = nwg % NXCD, xcd = wgid % NXCD, off = wgid / NXCD; wgid = (xcd < r ? xcd * (q + 1) : r * (q + 1) + (xcd - r) * q) + off; }
        const int nig = WGM * nN, gid = wgid / nig, fm = gid * WGM, gsz = (nM - fm) < WGM ? (nM - fm) : WGM;
        u.pm = fm + ((wgid % nig) % gsz); u.pn = (wgid % nig) / gsz; return true;
    }
};
struct RowOrder {
    int nN, ntile, G, c;
    __device__ bool next(int i, Unit& u) const {
        const int x = c & 7, lt = (c >> 3) + (G >> 3) * i;
        const int quad = lt >> 2, pm = quad * 8 + x;
        if (pm * 4 >= ntile) return false;
        u.pm = pm; u.pn = lt & 3; return true; }
};
template <class Epi, class Sched>
__device__ __forceinline__ void gemm_phase(PG8_LAS unsigned char* lds, const Gemm g, const Sched& S, const Epi& E) {
    const int tid = TID(), wid = __builtin_amdgcn_readfirstlane(tid >> 6), lane = tid & 63, wr = wid >> 2, wc = wid & 3, fr = lane & 15, fq = lane >> 4;
    const int K = g.K, nt = K / BK;
    unsigned voffA[2], voffB[2];
#pragma unroll
    for (int i = 0; i < 2; ++i) { int R, C; stage_rc(tid * 16 + i * 8192, R, C); voffA[i] = (unsigned)(R * K + C) * 2u; voffB[i] = voffA[i]; }
    const size_t kstep = (size_t)(BK * 2);
    const size_t hstep = (size_t)HALF * K * 2;
    const size_t tstep = 2 * hstep;
    const unsigned ldsw = (unsigned)wid * 1024u;
    const int aoff = lds_byte(wr * 64 + fr, fq * 8), boff = lds_byte(wc * 32 + fr, fq * 8);
#define PG8_SA(b, h) (((b) * 2 + (h)) * HTB)
#define PG8_SB(b, h) ((4 + (b) * 2 + (h)) * HTB)
#define PG8_STAGE(bufoff, gbase, voff) do { _Pragma("unroll") for (int _i = 0; _i < 2; ++_i) \
        __builtin_amdgcn_global_load_lds((const unsigned*)((const char*)(gbase) + (voff)[_i]), (PG8_LAS unsigned*)(lds + (bufoff) + ldsw + _i * 8192), 16, 0, 0); } while (0)
#define PG8_LDA(dst, b, h) do { _Pragma("unroll") for (int m = 0; m < 4; ++m) _Pragma("unroll") for (int k = 0; k < 2; ++k) dst[m][k] = *(const PG8_LAS bf16x8*)(lds + PG8_SA(b, h) + aoff + m * 2048 + k * 1024); } while (0)
#define PG8_LDB(dst, b, h) do { _Pragma("unroll") for (int n = 0; n < 2; ++n) _Pragma("unroll") for (int k = 0; k < 2; ++k) dst[n][k] = *(const PG8_LAS bf16x8*)(lds + PG8_SB(b, h) + boff + n * 2048 + k * 1024); } while (0)
#define PG8_MMA(ai, bj, At, Bt) do { __builtin_amdgcn_s_setprio(1); _Pragma("unroll") for (int m = 0; m < 4; ++m) _Pragma("unroll") for (int n = 0; n < 2; ++n) _Pragma("unroll") for (int k = 0; k < 2; ++k) \
        acc[ai][bj][m][n] = __builtin_amdgcn_mfma_f32_16x16x32_bf16(Bt[n][k], At[m][k], acc[ai][bj][m][n], 0, 0, 0); __builtin_amdgcn_s_setprio(0); } while (0)
#define PG8_WAIT_V(n) asm volatile("s_waitcnt vmcnt(" #n ")" ::: "memory")
#define PG8_WAIT_L(n) asm volatile("s_waitcnt lgkmcnt(" #n ")" ::: "memory")
#define PG8_BAR __builtin_amdgcn_s_barrier()
#define PG8_SCHED __builtin_amdgcn_sched_barrier(0)
    Unit cur, nxt; int ui = 0;
    if (!S.next(0, cur)) return;
    f32x4 acc[2][2][4][2];
#pragma unroll
    for (int a = 0; a < 2; ++a)
#pragma unroll
        for (int b = 0; b < 2; ++b)
#pragma unroll
            for (int m = 0; m < 4; ++m)
#pragma unroll
                for (int n = 0; n < 2; ++n) acc[a][b][m][n] = (f32x4){0.f, 0.f, 0.f, 0.f};
    bf16x8 At[4][2], B0[2][2], B1[2][2];
    const char* cA = (const char*)g.A + (size_t)cur.pm * tstep; const char* cB = (const char*)g.Bt + (size_t)cur.pn * tstep;
    PG8_STAGE(PG8_SB(0, 0), cB, voffB); PG8_STAGE(PG8_SA(0, 0), cA, voffA); PG8_STAGE(PG8_SB(0, 1), cB + hstep, voffB); PG8_STAGE(PG8_SA(0, 1), cA + hstep, voffA);
    if (wr == 1) PG8_BAR;
    PG8_WAIT_V(4); PG8_BAR;
    PG8_STAGE(PG8_SB(1, 0), cB + kstep, voffB); PG8_STAGE(PG8_SA(1, 0), cA + kstep, voffA); PG8_STAGE(PG8_SB(1, 1), cB + hstep + kstep, voffB);
    PG8_WAIT_V(6); PG8_BAR;
    for (;;) {
        const bool has_next = S.next(ui + 1, nxt);
        const char* nA = has_next ? (const char*)g.A + (size_t)nxt.pm * tstep : cA; const char* nB = has_next ? (const char*)g.Bt + (size_t)nxt.pn * tstep : cB;
        for (int t = 0; t < nt; t += 2) {
            const bool last = (t == nt - 2);
            const char* a1 = cA + (size_t)(t + 1) * kstep;
            const char* a2 = last ? nA : cA + (size_t)(t + 2) * kstep; const char* b2 = last ? nB : cB + (size_t)(t + 2) * kstep;
            const char* a3 = a2 + kstep; const char* b3 = b2 + kstep;
            PG8_LDB(B0, 0, 0); PG8_SCHED; PG8_LDA(At, 0, 0); PG8_STAGE(PG8_SA(1, 1), a1 + hstep, voffA);
            PG8_WAIT_L(8); PG8_BAR; PG8_WAIT_L(0); PG8_MMA(0, 0, At, B0); PG8_BAR; PG8_SCHED;
            PG8_LDB(B1, 0, 1); PG8_STAGE(PG8_SB(0, 0), b2, voffB);
            PG8_BAR; PG8_WAIT_L(0); PG8_MMA(0, 1, At, B1); PG8_BAR;
            PG8_LDA(At, 0, 1); PG8_STAGE(PG8_SA(0, 0), a2, voffA);
            PG8_BAR; PG8_WAIT_L(0); PG8_MMA(1, 0, At, B0); PG8_BAR; PG8_SCHED;
            PG8_STAGE(PG8_SB(0, 1), b2 + hstep, voffB);
            PG8_WAIT_V(6); PG8_BAR; PG8_MMA(1, 1, At, B1); PG8_BAR;
            PG8_LDB(B0, 1, 0); PG8_SCHED; PG8_LDA(At, 1, 0); PG8_STAGE(PG8_SA(0, 1), a2 + hstep, voffA);
            PG8_WAIT_L(8); PG8_BAR; PG8_WAIT_L(0); PG8_MMA(0, 0, At, B0); PG8_BAR; PG8_SCHED;
            PG8_LDB(B1, 1, 1); PG8_STAGE(PG8_SB(1, 0), b3, voffB);
            PG8_BAR; PG8_WAIT_L(0); PG8_MMA(0, 1, At, B1); PG8_BAR;
            PG8_LDA(At, 1, 1); PG8_STAGE(PG8_SA(1, 0), a3, voffA);
            PG8_BAR; PG8_WAIT_L(0); PG8_MMA(1, 0, At, B0); PG8_BAR; PG8_SCHED;
            PG8_STAGE(PG8_SB(1, 1), b3 + hstep, voffB);
            PG8_WAIT_V(6); PG8_BAR; PG8_MMA(1, 1, At, B1); PG8_BAR;
        }
        E(acc, cur, ui, wr, wc, fr, fq);
#ifdef DUP_EPI
        if (Epi::DUPOK) E(acc, cur, ui, wr, wc, fr, fq);
#endif
        if (!has_next) break;
#pragma unroll
        for (int a = 0; a < 2; ++a)
#pragma unroll
            for (int b = 0; b < 2; ++b)
#pragma unroll
                for (int m = 0; m < 4; ++m)
#pragma unroll
                    for (int n = 0; n < 2; ++n) acc[a][b][m][n] = (f32x4){0.f, 0.f, 0.f, 0.f};
        cur = nxt; cA = nA; cB = nB; ++ui;
    }
    PG8_WAIT_V(0);
    if (wr == 0) PG8_BAR;
    PG8_BAR;
#undef PG8_SA
#undef PG8_SB
#undef PG8_STAGE
#undef PG8_LDA
#undef PG8_LDB
#undef PG8_MMA
#undef PG8_WAIT_V
#undef PG8_WAIT_L
#undef PG8_BAR
#undef PG8_SCHED
}
}
typedef f32x4 acc_t[2][2][4][2];
#define ROWS_LOOP _Pragma("unroll") for (int ai = 0; ai < 2; ++ai) _Pragma("unroll") for (int m = 0; m < 4; ++m)
#define ROW_OF (u.pm * 256 + ai * 128 + wr * 64 + m * 16 + fr)

struct EpiIn {
    static constexpr bool DUPOK = true;
    const Params& p; int l;
    __device__ __forceinline__ void operator()(const acc_t& acc, const pg8::Unit& u, int ui, int wr, int wc, int fr, int fq) const {
        const float* ssq = p.sumsq() + (size_t)(l & 1) * T * 16;
        const int pn = u.pn, cl = wc * 4 + fq;
        __shared__ float s_rstd[256];
        { const int t_ = TID(); if (t_ < 256) s_rstd[t_] = row_rstd(ssq, u.pm * 256 + t_); __syncthreads(); }
        float rsa[8];
#pragma unroll
        for (int ix = 0; ix < 8; ++ix) rsa[ix] = s_rstd[(ix >> 2) * 128 + wr * 64 + (ix & 3) * 16 + fr];
        if (pn < 8) {
            ROWS_LOOP { const int row = ROW_OF; const float rs = rsa[ai * 4 + m];
                float zz[4], gg[4];
#pragma unroll
                for (int ch = 0; ch < 4; ++ch) { const f32x4 v = acc[ai][ch >> 1][m][ch & 1]; zz[ch] = (v[1] * rs) * (v[2] * rs); gg[ch] = (v[0] * rs) * siluf(v[3] * rs); }
                const size_t o = (size_t)row * 512 + pn * 64 + cl * 4;
                u32x2 a; a[0] = cvtpk(zz[0], zz[1]); a[1] = cvtpk(zz[2], zz[3]); *(u32x2*)(p.z() + o) = a;
                u32x2 b; b[0] = cvtpk(gg[0], gg[1]); b[1] = cvtpk(gg[2], gg[3]); *(u32x2*)(p.ga() + o) = b; }
        } else if (pn < 12 || (pn >= 16 && pn <= 18)) {
            if (pn == 18 && wc >= 1) {
                if (wc == 1 && fq == 0) {
                    ROWS_LOOP { const int row = ROW_OF; const float rs = rsa[ai * 4 + m] * 0.04419417382415922f;
                        *(f32x4*)(p.iw() + (size_t)row * 8) = acc[ai][0][m][0] * rs; *(f32x4*)(p.iw() + (size_t)row * 8 + 4) = acc[ai][0][m][1] * rs; }
                }
            } else {
                const bool isqk = pn < 12; const int which = (pn - 8) >> 1;
                int head; u16* dst; int pitch;
                if (isqk) { head = ((pn - 8) & 1) * 4 + wc; dst = which ? p.k() : p.q(); pitch = 512; }
                else if (pn < 18) { head = (pn - 16) * 4 + wc; dst = p.iq(); pitch = 512; }
                else { head = 0; dst = p.ik(); pitch = 64; }
                f32x4 g0[2], g1[2];
#pragma unroll
                for (int n = 0; n < 2; ++n) { g0[n] = (f32x4){1.f, 1.f, 1.f, 1.f}; g1[n] = g0[n]; }
                if (isqk) { const float* gg = (which ? p.k_g : p.q_g) + l * 64 + 8 * fq;
#pragma unroll
                    for (int n = 0; n < 2; ++n) { g0[n] = *(const f32x4*)(gg + 4 * n); g1[n] = *(const f32x4*)(gg + 32 + 4 * n); } }
                f32x4 rcb[2], rsb[2];
                { const int pos0 = (u.pm * 256 + wr * 64 + fr) & (SEQ - 1);
#pragma unroll
                  for (int n = 0; n < 2; ++n) { rcb[n] = *(const f32x4*)(p.ropec() + pos0 * 32 + 8 * fq + 4 * n); rsb[n] = *(const f32x4*)(p.ropes() + pos0 * 32 + 8 * fq + 4 * n); } }
                ROWS_LOOP { const int row = ROW_OF; const int ix = ai * 4 + m; const float rs = rsa[ix];
                    f32x4 a0[2], a1[2];
#pragma unroll
                    for (int n = 0; n < 2; ++n) { a0[n] = acc[ai][0][m][n] * rs; a1[n] = acc[ai][1][m][n] * rs; }
                    if (isqk) { float ss = 0.f;
#pragma unroll
                        for (int n = 0; n < 2; ++n)
#pragma unroll
                            for (int j = 0; j < 4; ++j) ss += a0[n][j] * a0[n][j] + a1[n][j] * a1[n][j];
                        ss += __shfl_xor(ss, 16); ss += __shfl_xor(ss, 32);
                        const float rn = __builtin_amdgcn_rsqf(ss * (1.f / 64.f) + RMS_EPS);
#pragma unroll
                        for (int n = 0; n < 2; ++n) { a0[n] = a0[n] * rn * g0[n]; a1[n] = a1[n] * rn * g1[n]; } }
                    u32x4 o0, o1;
#pragma unroll
                    for (int n = 0; n < 2; ++n) { const f32x4 cc = rcb[n], sn = rsb[n];
                        const f32x4 r0 = a0[n] * cc - a1[n] * sn, r1 = a1[n] * cc + a0[n] * sn;
                        o0[2 * n] = cvtpk(r0[0], r0[1]); o0[2 * n + 1] = cvtpk(r0[2], r0[3]); o1[2 * n] = cvtpk(r1[0], r1[1]); o1[2 * n + 1] = cvtpk(r1[2], r1[3]); }
                    if (ix < 7) { const int posn = (u.pm * 256 + ((ix + 1) >> 2) * 128 + wr * 64 + ((ix + 1) & 3) * 16 + fr) & (SEQ - 1);
#pragma unroll
                        for (int n = 0; n < 2; ++n) { rcb[n] = *(const f32x4*)(p.ropec() + posn * 32 + 8 * fq + 4 * n); rsb[n] = *(const f32x4*)(p.ropes() + posn * 32 + 8 * fq + 4 * n); } }
                    u16* d = dst + (size_t)row * pitch + head * 64 + 8 * fq;
                    *(u32x4*)d = o0; *(u32x4*)(d + 32) = o1; }
            }
        } else {
            u16* dst; int cb; int kind;
            if (pn < 14) { dst = p.v(); cb = (pn - 12) * 256; kind = 0; }
            else if (pn < 16) { dst = p.sg(); cb = (pn - 14) * 256; kind = 1; }
            else if (pn < 21) { dst = p.u(); cb = (pn - 19) * 256; kind = 0; }
            else { dst = p.sp(); cb = (pn - 21) * 256; kind = 2; }
            f32x4 sc[2][2];
#pragma unroll
            for (int bj = 0; bj < 2; ++bj)
#pragma unroll
                for (int n = 0; n < 2; ++n) sc[bj][n] = (kind == 2) ? *(const f32x4*)(p.pool_scale + l * 512 + cb + 16 * cl + bj * 8 + n * 4) : (f32x4){1.f, 1.f, 1.f, 1.f};
            ROWS_LOOP { const int row = ROW_OF; const float rs = rsa[ai * 4 + m];
#pragma unroll
                for (int bj = 0; bj < 2; ++bj) { f32x4 v0 = acc[ai][bj][m][0] * rs, v1 = acc[ai][bj][m][1] * rs;
                    if (kind >= 1) {
#pragma unroll
                        for (int j = 0; j < 4; ++j) { v0[j] = siluf(v0[j]) * sc[bj][0][j]; v1[j] = siluf(v1[j]) * sc[bj][1][j]; } }
                    u32x4 w; w[0] = cvtpk(v0[0], v0[1]); w[1] = cvtpk(v0[2], v0[3]); w[2] = cvtpk(v1[0], v1[1]); w[3] = cvtpk(v1[2], v1[3]);
                    *(u32x4*)(dst + (size_t)row * 512 + cb + 16 * cl + bj * 8) = w; } }
        }
    }
};
__device__ __forceinline__ void phase_in(const Params& p, int l, char* shm) {
    pg8::Gemm g{p.xb(), p.wt_in() + (size_t)l * NPA * 1024, T, NPA, 1024};
    pg8::StaticOrder S; S.init(T, NPA, GDIM(), BID());
    EpiIn E{p, l};
    pg8::gemm_phase((PG8_LAS unsigned char*)shm, g, S, E);
}
__device__ __forceinline__ void phase_mix(const Params& p, int l) {
    const float* cw = p.conv_w + l * 3 * 512;
    constexpr int RUN = 16;
    const int nitem = (T / RUN) * 256;
    const int it0 = BID() * NTHR + TID(), itstep = GDIM() * NTHR;
    for (int it = it0; it < nitem; it += itstep) {
        const int cp = it & 255, c = cp * 2, t0 = (it >> 8) * RUN, pos0 = t0 & (SEQ - 1);
        {
            const float w00 = cw[c], w01 = cw[c + 1], w10 = cw[512 + c], w11 = cw[513 + c], w20 = cw[1024 + c], w21 = cw[1025 + c];
            unsigned zr[RUN + 2], gr[RUN];
#pragma unroll
            for (int i = 0; i < RUN + 2; ++i) zr[i] = (pos0 + i - 2 >= 0) ? *(const unsigned*)(p.z() + (size_t)(t0 + i - 2) * 512 + c) : 0u;
#pragma unroll
            for (int i = 0; i < RUN; ++i) gr[i] = *(const unsigned*)(p.ga() + (size_t)(t0 + i) * 512 + c);
#pragma unroll
            for (int i = 0; i < RUN; ++i) {
                const float y0 = (w00 * bflo(zr[i]) + w10 * bflo(zr[i + 1]) + w20 * bflo(zr[i + 2])) * bflo(gr[i]);
                const float y1 = (w01 * bfhi(zr[i]) + w11 * bfhi(zr[i + 1]) + w21 * bfhi(zr[i + 2])) * bfhi(gr[i]);
                *(unsigned*)(p.ga() + (size_t)(t0 + i) * 512 + c) = cvtpk(y0, y1);
            }
        }
        {
            const int win = 2 << (c >> 7);
            unsigned ur[RUN + 15], gr[RUN];
#pragma unroll
            for (int i = 0; i < RUN + 15; ++i) ur[i] = (i >= 16 - win && pos0 + i - 15 >= 0) ? *(const unsigned*)(p.u() + (size_t)(t0 + i - 15) * 512 + c) : 0u;
#pragma unroll
            for (int i = 0; i < RUN; ++i) gr[i] = *(const unsigned*)(p.sp() + (size_t)(t0 + i) * 512 + c);
            float s0 = 0.f, s1 = 0.f;
#pragma unroll
            for (int i = 0; i < 15; ++i) { s0 += bflo(ur[i]); s1 += bfhi(ur[i]); }
#pragma unroll
            for (int i = 0; i < RUN; ++i) {
                const int pos = pos0 + i;
                const float u0 = bflo(ur[i + 15]), u1 = bfhi(ur[i + 15]);
                s0 += u0; s1 += u1;
                const float ic = __builtin_amdgcn_rcpf((float)min(pos + 1, win));
                *(unsigned*)(p.sp() + (size_t)(t0 + i) * 512 + c) = cvtpk((s0 * ic - u0) * bflo(gr[i]), (s1 * ic - u1) * bfhi(gr[i]));
                unsigned wo = 0u;
#pragma unroll
                for (int g = 0; g < 4; ++g) if (win == (2 << g)) wo = ur[i + 15 - ((2 << g) - 1)];
                s0 -= bflo(wo); s1 -= bfhi(wo);
            }
        }
    }
}

__device__ __forceinline__ int crow(int r, int hi) { return (r & 3) + 8 * (r >> 2) + 4 * hi; }
__device__ __forceinline__ size_t sc_base(int qb) { return (size_t)32768 * qb * (qb + 1); }
__device__ __forceinline__ void phase_indexer(const Params& p, int b, u16* scbuf) {
    const int tid_ = TID(); const int wid = tid_ >> 6, lane = tid_ & 63, ql = lane & 15, fq = lane >> 4; const int bid_ = BID(), gdim_ = GDIM();
    constexpr int NSTEP = 64 * 65;
    const int f0 = (int)(((long)bid_ * NSTEP) / gdim_), f1 = (int)(((long)(bid_ + 1) * NSTEP) / gdim_);
    int qcur = -1;
    bf16x8 bq[8][2]; float wv[8]; u16* srow = nullptr; int qloc = 0;
#pragma unroll
    for (int h = 0; h < 8; ++h) { wv[h] = 0.f; bq[h][0] = bq[h][1] = (bf16x8){0, 0, 0, 0, 0, 0, 0, 0}; }
    const u16* ikb = p.ik() + ((size_t)b * SEQ + ql) * 64 + fq * 8;
    for (int f = f0; f < f1; ++f) {
        int q = (int)((sqrtf(4.f * f + 1.f) - 1.f) * 0.5f);
        while ((q + 1) * (q + 2) <= f) ++q;
        while (q * (q + 1) > f) --q;
        const int tt = f - q * (q + 1);
        if (q != qcur) {
            qcur = q; qloc = q * 128 + wid * 16 + ql;
            const size_t row = (size_t)b * SEQ + qloc;
#pragma unroll
            for (int h = 0; h < 8; ++h)
#pragma unroll
                for (int kc = 0; kc < 2; ++kc) bq[h][kc] = *(const bf16x8*)(p.iq() + row * 512 + h * 64 + kc * 32 + fq * 8);
            const f32x4 x = *(const f32x4*)(p.iw() + row * 8), y = *(const f32x4*)(p.iw() + row * 8 + 4);
            wv[0] = x[0]; wv[1] = x[1]; wv[2] = x[2]; wv[3] = x[3]; wv[4] = y[0]; wv[5] = y[1]; wv[6] = y[2]; wv[7] = y[3];
            const int a = q >> 1;
            srow = scbuf + sc_base(a) + (size_t)(qloc - a * 256) * (256 * (a + 1));
        }
        const int key0 = tt * 64;
        bf16x8 ka[4][2];
#pragma unroll
        for (int kg = 0; kg < 4; ++kg)
#pragma unroll
            for (int kc = 0; kc < 2; ++kc) ka[kg][kc] = *(const bf16x8*)(ikb + (size_t)(key0 + kg * 16) * 64 + kc * 32);
        const bool band = (key0 + 63 > q * 128 + wid * 16);
#pragma unroll
        for (int kg = 0; kg < 4; ++kg) {
            f32x4 sacc = (f32x4){0.f, 0.f, 0.f, 0.f};
#pragma unroll
            for (int h = 0; h < 8; ++h) {
                f32x4 c = (f32x4){0.f, 0.f, 0.f, 0.f};
                c = __builtin_amdgcn_mfma_f32_16x16x32_bf16(ka[kg][0], bq[h][0], c, 0, 0, 0);
                c = __builtin_amdgcn_mfma_f32_16x16x32_bf16(ka[kg][1], bq[h][1], c, 0, 0, 0);
#pragma unroll
                for (int j = 0; j < 4; ++j) sacc[j] = __builtin_fmaf(wv[h], __builtin_fmaxf(c[j], 0.f), sacc[j]);
            }
            const int kb = key0 + kg * 16 + fq * 4;
            if (band) {
#pragma unroll
                for (int j = 0; j < 4; ++j) if (kb + j > qloc) sacc[j] = -INFINITY;
            }
            union { _Float16 h[4]; u32x2 v; } pk;
            pk.h[0] = (_Float16)sacc[0]; pk.h[1] = (_Float16)sacc[1]; pk.h[2] = (_Float16)sacc[2]; pk.h[3] = (_Float16)sacc[3];
            *(u32x2*)(srow + kb) = pk.v;
        }
    }
}

__device__ __forceinline__ size_t mk_base(int qb) { return (size_t)512 * qb * (qb + 1); }
constexpr size_t MASK_WORDS_PER_BATCH = 540672;
__device__ __forceinline__ unsigned f16key(unsigned h) { return (h & 0x8000u) ? (~h & 0xffffu) : (h | 0x8000u); }
__device__ __forceinline__ void hist_scan(const unsigned* h, int lane, unsigned target, int& bin, unsigned& above, unsigned& inbin) {
    const u32x4 a = *(const u32x4*)(h + 4 * lane), b = *(const u32x4*)(h + 256 + 4 * lane), c = *(const u32x4*)(h + 512 + 4 * lane), d = *(const u32x4*)(h + 768 + 4 * lane);
    const unsigned h0 = a[0] + b[0] + c[0] + d[0], h1 = a[1] + b[1] + c[1] + d[1], h2 = a[2] + b[2] + c[2] + d[2], h3 = a[3] + b[3] + c[3] + d[3];
    const unsigned tot = h0 + h1 + h2 + h3;
    unsigned x = tot;
#pragma unroll
    for (int dd = 1; dd < 64; dd <<= 1) { const unsigned y = __shfl_down(x, dd); if (lane + dd < 64) x += y; }
    const unsigned ab = x - tot, c3 = ab + h3, c2 = c3 + h2, c1 = c2 + h1, c0 = c1 + h0;
    int fb = -1; unsigned fa = 0, fc = 0;
    if (ab < target && c3 >= target) { fb = 4 * lane + 3; fa = ab; fc = h3; }
    else if (c3 < target && c2 >= target) { fb = 4 * lane + 2; fa = c3; fc = h2; }
    else if (c2 < target && c1 >= target) { fb = 4 * lane + 1; fa = c2; fc = h1; }
    else if (c1 < target && c0 >= target) { fb = 4 * lane; fa = c1; fc = h0; }
    const u64 m = __ballot(fb >= 0); const int src = (m == 0) ? 0 : (__ffsll((unsigned long long)m) - 1);
    bin = __shfl(fb, src); above = __shfl(fa, src); inbin = __shfl(fc, src);
}
__device__ __forceinline__ unsigned f16key2(unsigned w) { const unsigned sg = (w >> 15) & 0x00010001u; return w ^ (((sg << 15) - sg) | 0x80008000u); }
__device__ __forceinline__ void phase_select(const Params& p, int b, char* shm, const u16* scbuf) {
    const int tid_ = TID(); const int wid = __builtin_amdgcn_readfirstlane(tid_ >> 6), lane = tid_ & 63;
    const int gw = BID() * 8 + wid, nw = GDIM() * 8;
    unsigned* hist = (unsigned*)shm + wid * 1152;
    const int hsubi = (lane >> 4) * 256, dummyi = 1024 + lane;
    typedef unsigned short us2 __attribute__((ext_vector_type(2)));
#define ROW_T(i_) ({ const int kq_ = (i_) / nw; ((mirror && (kq_ & 1)) ? (kq_ * nw + (nw - 1 - ((i_) - kq_ * nw))) : (i_)); })
#define ROW_LOAD(t_) do { const int qb_ = (t_) >> 8, ntr_ = 2 * (((t_) >> 7) + 1), nch_ = (ntr_ + 7) >> 3; \
        const u16* sr_ = scbuf + sc_base(qb_) + (size_t)((t_) - qb_ * 256) * (256 * (qb_ + 1)); \
        _Pragma("unroll") for (int c = 0; c < 16; ++c) { raw[c] = (u32x4){0u, 0u, 0u, 0u}; if (c < nch_) { if (lane < 8 * (ntr_ - 8 * c)) raw[c] = *(const u32x4*)(sr_ + 512 * c + 8 * lane); } } } while (0)
    const bool mirror = (SEQ % (2 * nw)) == 0;
    u32x4 raw[16];
    if (gw < SEQ) { const int t0_ = ROW_T(gw); ROW_LOAD(t0_); }
    for (int i = gw; i < SEQ; i += nw) {
        const int t = ROW_T(i);
        const int qb = t >> 8, ntile = 4 * (qb + 1), ntr = 2 * ((t >> 7) + 1);
        const int nch = (ntr + 7) >> 3, nchw = (ntile + 7) >> 3;
        unsigned char* mrow = (unsigned char*)(p.mask() + (size_t)b * MASK_WORDS_PER_BATCH + mk_base(qb) + (size_t)(t - qb * 256) * ntile);
        unsigned key[16][4];
#pragma unroll
        for (int c = 0; c < 16; ++c) {
            const bool valid = (c < nch) && (lane < 8 * (ntr - 8 * c));
#pragma unroll
            for (int r = 0; r < 4; ++r) key[c][r] = valid ? f16key2(raw[c][r]) : 0u;
        }
        if (i + nw < SEQ) { const int tn_ = ROW_T(i + nw); ROW_LOAD(tn_); }
        unsigned thrm1 = 0x03ffu, thr = 0x0400u; int need = 0; bool fast = true;
        if (t >= 256) {
            us2 a1 = (us2){0, 0}, a2 = (us2){0, 0};
#pragma unroll
            for (int c = 0; c < 16; ++c) {
                if (c < nch) {
#pragma unroll
                    for (int r = 0; r < 4; ++r) { const us2 kk = __builtin_bit_cast(us2, key[c][r]);
                        const us2 tmx = __builtin_elementwise_max(a1, kk), tmn = __builtin_elementwise_min(a1, kk); a1 = tmx; a2 = __builtin_elementwise_max(a2, tmn); }
                }
            }
            unsigned Lb = min((unsigned)a2[0], (unsigned)a2[1]);
#pragma unroll
            for (int m_ = 32; m_ >= 1; m_ >>= 1) Lb = min(Lb, (unsigned)__shfl_xor((int)Lb, m_));
            Lb = __builtin_amdgcn_readfirstlane(Lb);
            const u32x4 z4 = (u32x4){0u, 0u, 0u, 0u};
#pragma unroll
            for (int c = 0; c < 4; ++c) *(u32x4*)(hist + c * 256 + 4 * lane) = z4;
#pragma unroll
            for (int c = 0; c < 16; ++c) {
                if (c < nch) {
#pragma unroll
                    for (int r = 0; r < 4; ++r) { const unsigned kk = key[c][r]; const unsigned lo = kk & 0xffffu, hi = kk >> 16;
                        atomicAdd(hist + ((lo >= Lb) ? (hsubi + (int)(lo >> 8)) : dummyi), 1u);
                        atomicAdd(hist + ((hi >= Lb) ? (hsubi + (int)(hi >> 8)) : dummyi), 1u); }
                }
            }
            asm volatile("s_waitcnt lgkmcnt(0)" ::: "memory");
            int B1; unsigned ab1, in1;
            hist_scan(hist, lane, 256u, B1, ab1, in1);
            asm volatile("s_waitcnt lgkmcnt(0)" ::: "memory");
#pragma unroll
            for (int c = 0; c < 4; ++c) *(u32x4*)(hist + c * 256 + 4 * lane) = z4;
#pragma unroll
            for (int c = 0; c < 16; ++c) {
                if (c < nch) {
#pragma unroll
                    for (int r = 0; r < 4; ++r) { const unsigned kk = key[c][r]; const unsigned lo = kk & 0xffffu, hi = kk >> 16;
                        const bool ml = ((lo >> 8) == (unsigned)B1) && (lo >= Lb), mh = ((hi >> 8) == (unsigned)B1) && (hi >= Lb);
                        if (__any(ml || mh)) { if (ml) atomicAdd(hist + hsubi + (int)(lo & 255u), 1u); if (mh) atomicAdd(hist + hsubi + (int)(hi & 255u), 1u); } }
                }
            }
            asm volatile("s_waitcnt lgkmcnt(0)" ::: "memory");
            int B2; unsigned ab2, in2;
            hist_scan(hist, lane, 256u - ab1, B2, ab2, in2);
            asm volatile("s_waitcnt lgkmcnt(0)" ::: "memory");
            thr = __builtin_amdgcn_readfirstlane(((unsigned)B1 << 8) | (unsigned)B2);
            need = __builtin_amdgcn_readfirstlane(256 - (int)(ab1 + ab2));
            const int neq = __builtin_amdgcn_readfirstlane((int)in2);
            fast = (need == neq);
            thrm1 = thr - 1u;
        }
        if (fast) {
#pragma unroll
            for (int c = 0; c < 16; ++c) {
                if (c < nchw) {
                    unsigned m = 0u;
#pragma unroll
                    for (int ii = 7; ii >= 0; --ii) { const unsigned kk = key[c][ii >> 1]; const unsigned kv = (ii & 1) ? (kk >> 16) : (kk & 0xffffu); m = m + m + ((kv > thrm1) ? 1u : 0u); }
                    if (64 * c + lane < 8 * ntile) mrow[64 * c + lane] = (unsigned char)m;
                }
            }
        } else {
            int base = 0;
#pragma unroll 1
            for (int c = 0; c < 16; ++c) {
                if (c < nchw) {
                    unsigned m = 0u, e = 0u;
#pragma unroll
                    for (int ii = 7; ii >= 0; --ii) { unsigned kk = (ii >> 1) == 0 ? key[0][0] : 0u;
#pragma unroll
                        for (int cc = 0; cc < 16; ++cc) if (cc == c) kk = key[cc][ii >> 1];
                        const unsigned kv = (ii & 1) ? (kk >> 16) : (kk & 0xffffu); m = m + m + ((kv > thr) ? 1u : 0u); e = e + e + ((kv == thr) ? 1u : 0u); }
                    const int cnt = __builtin_popcount(e);
                    int pre = cnt;
#pragma unroll
                    for (int dd = 1; dd < 64; dd <<= 1) { const int y = __shfl_up(pre, dd); if (lane >= dd) pre += y; }
                    const int tot = __shfl(pre, 63);
                    int rank = base + pre - cnt;
#pragma unroll
                    for (int ii = 0; ii < 8; ++ii) if ((e >> ii) & 1u) { if (rank < need) m |= (1u << ii); ++rank; }
                    base += tot;
                    if (64 * c + lane < 8 * ntile) mrow[64 * c + lane] = (unsigned char)m;
                }
            }
        }
    }
}

constexpr int A_D = 64, A_DM = 512, A_NW = 8, A_QBLK = 32, A_QB = 256, A_KVBLK = 64, A_NQB = SEQ / A_QB, A_NHEAD = 8;
constexpr float A_C2 = 0.125f * 1.4426950408889634f;
constexpr int A_SLOTB = 8192, A_LDS_K = 0, A_LDS_V = 3 * A_SLOTB, A_LDS_WS = 6 * A_SLOTB, A_LDS_OST = A_LDS_WS + A_NW * 256, A_LDS_MK = A_LDS_OST + A_NW * 4096, A_LDS_BYTES = A_LDS_MK + A_NW * 2048;
#define ATTN_THR 8
#define SBAR() __builtin_amdgcn_sched_barrier(0)
#define PIN(x) asm volatile("" : "+v"(x))
#define MFMA32(a, b, c) __builtin_amdgcn_mfma_f32_32x32x16_bf16(a, b, c, 0, 0, 0)
#define WAIT_BAR(N) asm volatile("s_waitcnt vmcnt(" #N ") lgkmcnt(0)\n\ts_barrier" ::: "memory")
__device__ __forceinline__ void glds16s(const void* sbase, unsigned voff, unsigned lds_base) {
    unsigned sv; asm volatile("s_mov_b32 %0, m0\n\ts_mov_b32 m0, %3\n\ts_nop 0\n\tglobal_load_lds_dwordx4 %1, %2\n\ts_mov_b32 m0, %0" : "=&s"(sv) : "v"(voff), "s"(sbase), "s"(lds_base) : "memory"); }
typedef __attribute__((address_space(3))) const char* lds_cptr;
typedef short v4i16_t __attribute__((ext_vector_type(4)));
__device__ __forceinline__ void kload2(bf16x8* kf, lds_cptr kp, int d0) { kf[2 * d0] = *(const __attribute__((address_space(3))) bf16x8*)(kp + d0 * 2048); kf[2 * d0 + 1] = *(const __attribute__((address_space(3))) bf16x8*)(kp + d0 * 2048 + 512); }
__device__ __forceinline__ s16x4 vtr(lds_cptr p) { return __builtin_bit_cast(s16x4, __builtin_amdgcn_ds_read_tr16_b64_v4i16((__attribute__((address_space(3))) v4i16_t*)p)); }
#define MX3(a, b, c) __builtin_fmaxf(__builtin_fmaxf((a), (b)), (c))
__device__ __forceinline__ float rowmax(const f32x16& p0, const f32x16& p1) {
    float a = MX3(p0[0], p0[1], p1[0]), b = MX3(p0[2], p0[3], p1[1]); a = MX3(a, p1[2], p1[3]);
#pragma unroll
    for (int r = 4; r < 16; r += 4) { a = MX3(a, p0[r], p0[r + 1]); b = MX3(b, p0[r + 2], p0[r + 3]); a = MX3(a, p1[r], p1[r + 1]); b = MX3(b, p1[r + 2], p1[r + 3]); }
    float m = __builtin_fmaxf(a, b); auto rr = __builtin_amdgcn_permlane32_swap(__float_as_uint(m), __float_as_uint(m), false, false);
    return __builtin_fmaxf(__uint_as_float(rr[0]), __uint_as_float(rr[1])); }
__device__ __forceinline__ void cmask(f32x16& p0, f32x16& p1, int jb, int qrel, int hi) {
    const int kb = 64 * jb + 4 * hi;
#pragma unroll
    for (int r = 0; r < 16; ++r) { const int kv = kb + (r & 3) + 8 * (r >> 2); if (kv > qrel) p0[r] = -INFINITY; if (kv + 32 > qrel) p1[r] = -INFINITY; } }
__device__ __forceinline__ float mand(float x, unsigned w, int pos) { return __uint_as_float(__float_as_uint(x) & (unsigned)__builtin_amdgcn_sbfe((int)w, pos, 1)); }
#define BITP(i) (((i) & 3) + 8 * ((i) >> 2))

__device__ __forceinline__ void attn64_unit(int b, int h, int qb, const u16* Q, const u16* __restrict__ K, const u16* __restrict__ V, const u16* __restrict__ SG, u16* O, const u64* mrow0, char* lds) {
    const int tid = TID(), lane = tid & 63, r32 = lane & 31, hi = lane >> 5; const int wid = __builtin_amdgcn_readfirstlane(tid >> 6);
    const long rowbase = (long)b * SEQ; const int q0 = qb * A_QB, NT = (q0 + A_QB) / A_KVBLK;
    const u16* Qw = Q + (rowbase + q0 + wid * A_QBLK) * A_DM + h * A_D;
    const unsigned lds0 = (unsigned)(uintptr_t)lds; float* wsf = (float*)(lds + A_LDS_WS) + wid * 64;
    const u16* kbase = K + rowbase * A_DM + h * A_D; const u16* vbase = V + rowbase * A_DM + h * A_D;
    const unsigned koff = (unsigned)(lane * A_DM + wid * 8) * 2u;
    const unsigned voff = (unsigned)((16 * (wid & 3) + (lane >> 2)) * A_DM + (wid >> 2) * 32 + (lane & 3) * 8) * 2u;
    const unsigned kdst = lds0 + A_LDS_K + wid * 1024, vdst = lds0 + A_LDS_V + wid * 1024;
#define DMA_K(t, slot) glds16s(kbase + (long)(t) * A_KVBLK * A_DM, koff, (unsigned)__builtin_amdgcn_readfirstlane(kdst + (slot)))
#define DMA_V(t, slot) glds16s(vbase + (long)(t) * A_KVBLK * A_DM, voff, (unsigned)__builtin_amdgcn_readfirstlane(vdst + (slot)))
#define DMA_M(chunk) glds16s(mrow0 + 2 * (chunk), moff, (unsigned)__builtin_amdgcn_readfirstlane(mdst + ((chunk) & 1) * 1024))
#define MWORD(t) (*(const u64*)(lds + A_LDS_MK + wid * 2048 + (((t) >> 1) & 1) * 1024 + r32 * 16 + ((t) & 1) * 8))
    const lds_cptr vp0 = (lds_cptr)lds + A_LDS_V + ((lane >> 4) & 1) * 32 + (lane & 3) * 8 + (4 * hi + ((lane & 15) >> 2)) * 64;
    const lds_cptr kp0 = (lds_cptr)lds + A_LDS_K + hi * 1024 + r32 * 16;
    const int qrel = wid * A_QBLK + r32;
    const unsigned moff = (unsigned)(qrel * NT) * 8u;
    const unsigned mdst = lds0 + A_LDS_MK + wid * 2048;
    DMA_M(0);
    DMA_K(0, 0); DMA_V(0, 0); DMA_K(1, A_SLOTB);
    bf16x8 qr[4];
#pragma unroll
    for (int d0 = 0; d0 < 4; ++d0) qr[d0] = *reinterpret_cast<const bf16x8*>(&Qw[(long)r32 * A_DM + d0 * 16 + hi * 8]);
    float mhat = 0.f, l_reg = 0.f; f32x16 o[2]; o[0] = f32x16{}; o[1] = f32x16{};
    const f32x16 zero16 = f32x16{};
    bool resc = false;
    f32x16 pA0, pA1, pB0, pB1; bf16x8 kf[8]; s16x4 vlo[8], vhi[8]; u32x4 pw0, pw1, pw2, pw3;
    int sl_prev = 0, sl_cur = 0, sl_next = A_SLOTB;
    const int sh4 = 4 * hi;
#define ROT() do { sl_prev = sl_cur; sl_cur = sl_next; sl_next = (sl_next == 2 * A_SLOTB) ? 0 : sl_next + A_SLOTB; } while (0)
#define EX(v) __builtin_amdgcn_exp2f(__builtin_fmaf((v), A_C2, nmh))
#define RESC() do { if (resc) { _Pragma("unroll") for (int d_ = 0; d_ < 2; ++d_) _Pragma("unroll") for (int r = 0; r < 16; ++r) o[d_][r] *= wsf[crow(r, hi)]; } } while (0)
    DMA_K(2, 2 * A_SLOTB);
    WAIT_BAR(3);
    _Pragma("unroll") for (int d0 = 0; d0 < 4; ++d0) kload2(kf, kp0, d0);
    pA0 = MFMA32(kf[0], qr[0], zero16); pA1 = MFMA32(kf[1], qr[0], zero16); pA0 = MFMA32(kf[2], qr[1], pA0); pA1 = MFMA32(kf[3], qr[1], pA1);
    pA0 = MFMA32(kf[4], qr[2], pA0); pA1 = MFMA32(kf[5], qr[2], pA1); pA0 = MFMA32(kf[6], qr[3], pA0); pA1 = MFMA32(kf[7], qr[3], pA1);
    { const float rm = rowmax(pA0, pA1); mhat = rm * A_C2; const float nmh = -mhat;
      const u64 mw0 = MWORD(0); const unsigned wl = (unsigned)mw0 >> sh4, wh = (unsigned)(mw0 >> 32) >> sh4;
#pragma unroll
      for (int r = 0; r < 16; ++r) { pA0[r] = mand(EX(pA0[r]), wl, BITP(r)); pA1[r] = mand(EX(pA1[r]), wh, BITP(r)); } }
    WAIT_BAR(0);
    DMA_K(3, 0); DMA_V(1, A_SLOTB); ROT();
    _Pragma("unroll") for (int d0 = 0; d0 < 4; ++d0) kload2(kf, kp0 + sl_cur, d0);
    WAIT_BAR(2);
#define PKW(P, i) cvtpk(P[i], P[i + 1])
#define PAF(k) __builtin_bit_cast(bf16x8, pw##k)
#define VFR(i) (bf16x8){vlo[i][0], vlo[i][1], vlo[i][2], vlo[i][3], vhi[i][0], vhi[i][1], vhi[i][2], vhi[i][3]}
#define VRD(i) do { vlo[i] = vtr(vp_ + (((i) >> 2) * 4096 + ((i) & 3) * 1024)); vhi[i] = vtr(vp_ + (((i) >> 2) * 4096 + ((i) & 3) * 1024 + 512)); } while (0)
#define KRD(G, d0) do { if (G) { kload2(kf, kp0 + sl_next, d0); SBAR(); } } while (0)
#define GAPA(MF, a0, a1, a2, a3, W0, W1, PW) do { MF; sacc += a0; sacc += a1; sacc += a2; sacc += a3; W0; W1; PIN(PW); PIN(sacc); SBAR(); } while (0)
#define GAPB(MF, X, i, W) do { MF; X[i] = mand(EX(X[i]), W, BITP(i)); X[i + 1] = mand(EX(X[i + 1]), W, BITP(i + 1)); X[i + 2] = mand(EX(X[i + 2]), W, BITP(i + 2)); X[i + 3] = mand(EX(X[i + 3]), W, BITP(i + 3)); PIN(X); SBAR(); } while (0)
#define STEP(C0, C1, P0, P1, t, MASK, GK, GV, GL, ML) do { SBAR(); \
    if (ML) DMA_M(((t) + 1) >> 1); \
    const u64 mw_ = MWORD(t); \
    const lds_cptr vp_ = vp0 + sl_prev; \
    VRD(0); SBAR(); float sacc = P0[0] + P0[1]; \
                    GAPA(C0 = MFMA32(kf[0], qr[0], zero16), P0[2], P0[3], P0[4], P0[5],     pw0[0] = PKW(P0, 0),  pw0[1] = PKW(P0, 2),  pw0); \
    VRD(4); SBAR(); GAPA(C1 = MFMA32(kf[1], qr[0], zero16), P0[6], P0[7], P0[8], P0[9],     pw0[2] = PKW(P0, 4),  pw0[3] = PKW(P0, 6),  pw0); \
    VRD(1); SBAR(); GAPA(C0 = MFMA32(kf[2], qr[1], C0),    P0[10], P0[11], P0[12], P0[13], pw1[0] = PKW(P0, 8),  pw1[1] = PKW(P0, 10), pw1); \
    VRD(5); SBAR(); GAPA(C1 = MFMA32(kf[3], qr[1], C1),    P0[14], P0[15], P1[0], P1[1],   pw1[2] = PKW(P0, 12), pw1[3] = PKW(P0, 14), pw1); \
    VRD(2); SBAR(); GAPA(C0 = MFMA32(kf[4], qr[2], C0),    P1[2], P1[3], P1[4], P1[5],     pw2[0] = PKW(P1, 0),  pw2[1] = PKW(P1, 2),  pw2); \
    VRD(6); SBAR(); GAPA(C1 = MFMA32(kf[5], qr[2], C1),    P1[6], P1[7], P1[8], P1[9],     pw2[2] = PKW(P1, 4),  pw2[3] = PKW(P1, 6),  pw2); \
    VRD(3); SBAR(); GAPA(C0 = MFMA32(kf[6], qr[3], C0),    P1[10], P1[11], P1[12], P1[13], pw3[0] = PKW(P1, 8),  pw3[1] = PKW(P1, 10), pw3); \
    VRD(7); SBAR(); GAPA(C1 = MFMA32(kf[7], qr[3], C1),    P1[14], P1[15], 0.f, 0.f,       pw3[2] = PKW(P1, 12), pw3[3] = PKW(P1, 14), pw3); \
    l_reg += sacc; \
    if (GK) DMA_K((t) + 3, sl_cur); if (GV) DMA_V((t) + 1, sl_next); \
    { const float rm = __builtin_fmaf(rowmax(C0, C1), A_C2, -mhat); resc = false; \
      if (__builtin_expect(__any(rm > (float)ATTN_THR), 0)) { const float dl = __builtin_fmaxf(rm, 0.f); mhat += dl; \
          const float f = __builtin_amdgcn_exp2f(-dl); l_reg *= f; if (hi == 0) wsf[r32] = f; resc = true; } } \
    const float nmh = -mhat; const unsigned wl_ = (unsigned)(mw_) >> sh4, wh_ = (unsigned)((mw_) >> 32) >> sh4; SBAR(); \
    GAPB(o[0] = MFMA32(PAF(0), VFR(0), o[0]), C0, 0, wl_);              GAPB(o[1] = MFMA32(PAF(0), VFR(4), o[1]), C0, 4, wl_); \
    KRD(GL, 0); GAPB(o[0] = MFMA32(PAF(1), VFR(1), o[0]), C0, 8, wl_);  KRD(GL, 1); GAPB(o[1] = MFMA32(PAF(1), VFR(5), o[1]), C0, 12, wl_); \
    KRD(GL, 2); GAPB(o[0] = MFMA32(PAF(2), VFR(2), o[0]), C1, 0, wh_);  KRD(GL, 3); GAPB(o[1] = MFMA32(PAF(2), VFR(6), o[1]), C1, 4, wh_); \
    GAPB(o[0] = MFMA32(PAF(3), VFR(3), o[0]), C1, 8, wh_);              GAPB(o[1] = MFMA32(PAF(3), VFR(7), o[1]), C1, 12, wh_); \
    } while (0)
    int t = 1;
    for (; t + 5 < NT; t += 2) {
        STEP(pB0, pB1, pA0, pA1, t, false, true, true, true, true);      WAIT_BAR(2); RESC(); ROT();
        STEP(pA0, pA1, pB0, pB1, t + 1, false, true, true, true, false); WAIT_BAR(2); RESC(); ROT();
    }
#define ENDW(tt) do { if ((tt) + 3 < NT) { WAIT_BAR(2); } else if ((tt) + 2 < NT) { WAIT_BAR(1); } else { WAIT_BAR(0); } } while (0)
    for (; t + 1 < NT; t += 2) {
        STEP(pB0, pB1, pA0, pA1, t, true, (t + 3 < NT), (t + 1 < NT), (t + 1 < NT), (t + 1 < NT));         ENDW(t);     RESC(); ROT();
        STEP(pA0, pA1, pB0, pB1, t + 1, true, (t + 4 < NT), (t + 2 < NT), (t + 2 < NT), false);            ENDW(t + 1); RESC(); ROT();
    }
    STEP(pB0, pB1, pA0, pA1, NT - 1, true, false, false, false, false); RESC();
    { float sacc = pB0[0] + pB0[1];
#pragma unroll
      for (int r = 2; r < 16; ++r) sacc += pB0[r];
#pragma unroll
      for (int r = 0; r < 16; ++r) sacc += pB1[r];
      l_reg += sacc;
      pw0 = (u32x4){PKW(pB0, 0), PKW(pB0, 2), PKW(pB0, 4), PKW(pB0, 6)}; pw1 = (u32x4){PKW(pB0, 8), PKW(pB0, 10), PKW(pB0, 12), PKW(pB0, 14)};
      pw2 = (u32x4){PKW(pB1, 0), PKW(pB1, 2), PKW(pB1, 4), PKW(pB1, 6)}; pw3 = (u32x4){PKW(pB1, 8), PKW(pB1, 10), PKW(pB1, 12), PKW(pB1, 14)};
      const lds_cptr vp_ = vp0 + sl_cur; _Pragma("unroll") for (int i = 0; i < 8; ++i) VRD(i);
      o[0] = MFMA32(PAF(0), VFR(0), o[0]); o[1] = MFMA32(PAF(0), VFR(4), o[1]); o[0] = MFMA32(PAF(1), VFR(1), o[0]); o[1] = MFMA32(PAF(1), VFR(5), o[1]);
      o[0] = MFMA32(PAF(2), VFR(2), o[0]); o[1] = MFMA32(PAF(2), VFR(6), o[1]); o[0] = MFMA32(PAF(3), VFR(3), o[0]); o[1] = MFMA32(PAF(3), VFR(7), o[1]); }
    { auto rr = __builtin_amdgcn_permlane32_swap(__float_as_uint(l_reg), __float_as_uint(l_reg), false, false); l_reg = __uint_as_float(rr[0]) + __uint_as_float(rr[1]); }
    if (hi == 0) wsf[32 + r32] = l_reg; asm volatile("s_waitcnt lgkmcnt(0)" ::: "memory");
    float rli[16];
#pragma unroll
    for (int r = 0; r < 16; ++r) rli[r] = __builtin_amdgcn_rcpf(wsf[32 + crow(r, hi)]);
    u16* Ow = O + (rowbase + q0 + wid * A_QBLK) * A_DM + h * A_D; const u16* Gw = SG + (rowbase + q0 + wid * A_QBLK) * A_DM + h * A_D;
    u16* stg = (u16*)(lds + A_LDS_OST) + wid * 2048;
#pragma unroll
    for (int r = 0; r < 16; ++r) { const int orow = crow(r, hi);
#pragma unroll
        for (int d0 = 0; d0 < 2; ++d0) stg[orow * 64 + d0 * 32 + r32] = f2bf(o[d0][r] * rli[r]); }
    asm volatile("s_waitcnt lgkmcnt(0)" ::: "memory");
#pragma unroll
    for (int i = 0; i < 4; ++i) { const int row = i * 8 + (lane >> 3), ch = lane & 7;
        u32x4 ov = *(const u32x4*)(stg + row * 64 + ch * 8); u32x4 gv = *(const u32x4*)(Gw + (long)row * A_DM + ch * 8); u32x4 rv;
#pragma unroll
        for (int e = 0; e < 4; ++e) rv[e] = cvtpk(bflo(ov[e]) * bflo(gv[e]), bfhi(ov[e]) * bfhi(gv[e]));
        *(u32x4*)(Ow + (long)row * A_DM + ch * 8) = rv; }
    asm volatile("s_waitcnt vmcnt(0) lgkmcnt(0)\n\ts_barrier" ::: "memory");
#undef DMA_K
#undef DMA_V
#undef DMA_M
#undef MWORD
#undef ROT
#undef EX
#undef RESC
#undef PKW
#undef PAF
#undef VFR
#undef VRD
#undef KRD
#undef ENDW
#undef GAPA
#undef GAPB
#undef STEP
}
__device__ __forceinline__ void phase_attn(const Params& p, char* lds) {
    constexpr int NPAIR = A_NQB / 2, NUNIT = NBATCH * A_NHEAD * NPAIR;
    const int bid_ = BID(), gdim_ = GDIM();
    for (int u = bid_; u < NUNIT; u += gdim_) {
        const int x = u & 7, kk = u >> 3, bh = x + 8 * (kk / NPAIR), j = kk % NPAIR;
        const int b = bh / A_NHEAD, h = bh % A_NHEAD;
        const u64* mb = p.mask() + (size_t)b * MASK_WORDS_PER_BATCH;
        attn64_unit(b, h, j, p.q(), p.k(), p.v(), p.sg(), p.bin(), mb + mk_base(j), lds);
        attn64_unit(b, h, A_NQB - 1 - j, p.q(), p.k(), p.v(), p.sg(), p.bin(), mb + mk_base(A_NQB - 1 - j), lds);
    }
}

struct EpiStash {
    static constexpr bool DUPOK = false;
    u16* stash;
    __device__ __forceinline__ void operator()(const acc_t& acc, const pg8::Unit& u, int ui, int wr, int wc, int fr, int fq) const {
        const int tid_ = TID();
        u32x4* st = (u32x4*)(stash + (size_t)(u.pm * 4 + u.pn) * 65536);
        ROWS_LOOP {
#pragma unroll
            for (int bj = 0; bj < 2; ++bj) { const f32x4 v0 = acc[ai][bj][m][0], v1 = acc[ai][bj][m][1];
                u32x4 w; w[0] = cvtpk(v0[0], v0[1]); w[1] = cvtpk(v0[2], v0[3]); w[2] = cvtpk(v1[0], v1[1]); w[3] = cvtpk(v1[2], v1[3]);
                st[((ai * 4 + m) * 2 + bj) * 512 + tid_] = w; } }
    }
};
struct EpiGate {
    static constexpr bool DUPOK = false;
    const Params& p; int l; int br;
    __device__ __forceinline__ void operator()(const acc_t& acc, const pg8::Unit& u, int ui, int wr, int wc, int fr, int fq) const {
        const float* ssq = p.sumsq() + (size_t)(l & 1) * T * 16;
        const int tid_ = TID();
        const u32x4* st = (const u32x4*)(p.stash() + (size_t)(u.pm * 4 + u.pn) * 65536);
        const int cl = wc * 4 + fq;
        __shared__ float s_rstd[256];
        { if (tid_ < 256) s_rstd[tid_] = row_rstd(ssq, u.pm * 256 + tid_); __syncthreads(); }
        float rsa[8];
#pragma unroll
        for (int ix = 0; ix < 8; ++ix) rsa[ix] = s_rstd[(ix >> 2) * 128 + wr * 64 + (ix & 3) * 16 + fr];
        const char* stp = (const char*)st + (size_t)tid_ * 16;
        char* mpp = (char*)(p.merged() + (size_t)(u.pm * 256 + wr * 64 + fr) * 1024 + u.pn * 256 + 16 * cl);
        u32x4 yb = *(const u32x4*)stp, ob = (br > 0) ? *(const u32x4*)mpp : (u32x4){0u, 0u, 0u, 0u};
        ROWS_LOOP { const int ix = ai * 4 + m; const float rs = rsa[ix];
#pragma unroll
            for (int bj = 0; bj < 2; ++bj) { const f32x4 v0 = acc[ai][bj][m][0] * rs, v1 = acc[ai][bj][m][1] * rs;
                float r[8];
                r[0] = sigmf(v0[0]) * bflo(yb[0]); r[1] = sigmf(v0[1]) * bfhi(yb[0]); r[2] = sigmf(v0[2]) * bflo(yb[1]); r[3] = sigmf(v0[3]) * bfhi(yb[1]);
                r[4] = sigmf(v1[0]) * bflo(yb[2]); r[5] = sigmf(v1[1]) * bfhi(yb[2]); r[6] = sigmf(v1[2]) * bflo(yb[3]); r[7] = sigmf(v1[3]) * bfhi(yb[3]);
                if (br > 0) {
#pragma unroll
                    for (int e = 0; e < 4; ++e) { r[2 * e] += bflo(ob[e]); r[2 * e + 1] += bfhi(ob[e]); } }
                u32x4 wo; wo[0] = cvtpk(r[0], r[1]); wo[1] = cvtpk(r[2], r[3]); wo[2] = cvtpk(r[4], r[5]); wo[3] = cvtpk(r[6], r[7]);
                const char* stn = stp + 8192; char* mpn = (bj == 0) ? (mpp + 16) : (mpp - 16 + ((ix == 3) ? 80 : 16) * 2048);
                asm volatile("" : "+v"(stn), "+v"(mpn));
                if (!(ix == 7 && bj == 1)) { yb = *(const u32x4*)stn; if (br > 0) ob = *(const u32x4*)mpn; }
                *(u32x4*)mpp = wo;
                stp = stn; mpp = mpn; } }
    }
};
__device__ __forceinline__ void phase_merge(const Params& p, int l, char* shm) {
    pg8::RowOrder S{4, 512, GDIM(), BID()};
    for (int br = 0; br < 3; ++br) {
        const u16* Ain = br == 0 ? p.ga() : (br == 1 ? p.bin() : p.sp());
        const u16* Wy = (br == 0 ? p.wt_oa() : (br == 1 ? p.wt_ob() : p.wt_oc())) + (size_t)l * 1024 * 512;
        { pg8::Gemm g{Ain, Wy, T, 1024, 512}; EpiStash E{p.stash()}; pg8::gemm_phase((PG8_LAS unsigned char*)shm, g, S, E); }
        { pg8::Gemm g{p.xb(), p.wt_mg() + (size_t)l * 3072 * 1024 + (size_t)br * 1024 * 1024, T, 1024, 1024}; EpiGate E{p, l, br}; pg8::gemm_phase((PG8_LAS unsigned char*)shm, g, S, E); }
    }
}

struct EpiOut {
    static constexpr bool DUPOK = false;
    const Params& p; int l;
    __device__ __forceinline__ void operator()(const acc_t& acc, const pg8::Unit& u, int ui, int wr, int wc, int fr, int fq) const {
        const float* xsrc = (l == 0) ? p.x_in : p.x;
        const int cl = wc * 4 + fq;
        f32x4 xb0[2], xb1[2];
#pragma unroll
        for (int bj = 0; bj < 2; ++bj) { const size_t o = (size_t)(u.pm * 256 + wr * 64 + fr) * 1024 + u.pn * 256 + 16 * cl + bj * 8; xb0[bj] = *(const f32x4*)(xsrc + o); xb1[bj] = *(const f32x4*)(xsrc + o + 4); }
        ROWS_LOOP { const int row = ROW_OF; const int ix = ai * 4 + m; float ss = 0.f;
            f32x4 x0[2], x1[2];
#pragma unroll
            for (int bj = 0; bj < 2; ++bj) { x0[bj] = xb0[bj] + acc[ai][bj][m][0]; x1[bj] = xb1[bj] + acc[ai][bj][m][1]; }
            if (ix < 7) { const int rown = u.pm * 256 + ((ix + 1) >> 2) * 128 + wr * 64 + ((ix + 1) & 3) * 16 + fr;
#pragma unroll
                for (int bj = 0; bj < 2; ++bj) { const size_t o = (size_t)rown * 1024 + u.pn * 256 + 16 * cl + bj * 8; xb0[bj] = *(const f32x4*)(xsrc + o); xb1[bj] = *(const f32x4*)(xsrc + o + 4); } }
#pragma unroll
            for (int bj = 0; bj < 2; ++bj) { const size_t o = (size_t)row * 1024 + u.pn * 256 + 16 * cl + bj * 8;
                *(f32x4*)(p.x + o) = x0[bj]; *(f32x4*)(p.x + o + 4) = x1[bj];
                if (l < NL - 1) { u32x4 w; w[0] = cvtpk(x0[bj][0], x0[bj][1]); w[1] = cvtpk(x0[bj][2], x0[bj][3]); w[2] = cvtpk(x1[bj][0], x1[bj][1]); w[3] = cvtpk(x1[bj][2], x1[bj][3]); *(u32x4*)(p.xb() + o) = w;
#pragma unroll
                    for (int j = 0; j < 4; ++j) ss += x0[bj][j] * x0[bj][j] + x1[bj][j] * x1[bj][j]; } }
            if (l < NL - 1) { ss += __shfl_xor(ss, 16); ss += __shfl_xor(ss, 32); if (fq == 0) p.sumsq()[(size_t)((l + 1) & 1) * T * 16 + (size_t)row * 16 + u.pn * 4 + wc] = ss; } }
    }
};
__device__ __forceinline__ void phase_out(const Params& p, int l, char* shm) {
    pg8::RowOrder S{4, 512, GDIM(), BID()};
    pg8::Gemm g{p.merged(), p.wt_o() + (size_t)l * 1024 * 1024, T, 1024, 1024};
    EpiOut E{p, l};
    pg8::gemm_phase((PG8_LAS unsigned char*)shm, g, S, E);
}

enum { PH_PREP0 = 0, PH_IN, PH_MIX, PH_IDX, PH_SEL, PH_ATTN, PH_MERGE, PH_OUT };
template <int PH> __global__ __launch_bounds__(NTHR) void k_phase(Params p, int l, int b) {
    extern __shared__ __attribute__((aligned(16))) char shm[];
    if (PH == PH_PREP0) phase_prep0(p, shm);
    if (PH == PH_IN) phase_in(p, l, shm);
    if (PH == PH_MIX) phase_mix(p, l);
    if (PH == PH_IDX) phase_indexer(p, b, p.scores());
    if (PH == PH_SEL) phase_select(p, b, shm, p.scores());
    if (PH == PH_ATTN) phase_attn(p, shm);
    if (PH == PH_MERGE) phase_merge(p, l, shm);
    if (PH == PH_OUT) phase_out(p, l, shm);
}

#define XB_TMO      128
#define XB_XCNT(j)  (256  + 64 * (j))
#define XB_XSUB(j)  (1280 + 64 * (j))
#define XB_XGEN(j)  (2304 + 64 * (j))
#define XB_TOP      3328
#define XB_TOPGEN   3392
#define XCD_BAR_WORDS 3456
#define XB_SPIN_CAP (1u << 22)
#define LAS __attribute__((address_space(3)))
__device__ __forceinline__ unsigned xb_ld(unsigned* p)              { return __hip_atomic_load(p, __ATOMIC_RELAXED, __HIP_MEMORY_SCOPE_AGENT); }
__device__ __forceinline__ unsigned xb_add(unsigned* p, unsigned v) { return __hip_atomic_fetch_add(p, v, __ATOMIC_RELAXED, __HIP_MEMORY_SCOPE_AGENT); }
__device__ __forceinline__ unsigned xb_xcc_id() { return (unsigned)__builtin_amdgcn_s_getreg((3 << 11) | 20) & 0xFu; }
#define XB_SPIN(cond, bar) do { unsigned _sp = 0; while (cond) { __builtin_amdgcn_s_sleep(1); \
    if ((++_sp & 255u) == 0u) { if (xb_ld(&(bar)[XB_TMO])) break; if (_sp > XB_SPIN_CAP) { atomicAdd(&(bar)[XB_TMO], 1u); break; } } } } while (0)
struct XcdBarrier { unsigned* bar; unsigned x; volatile LAS unsigned* st; };
__device__ __forceinline__ XcdBarrier xcd_barrier_post(unsigned* bar, volatile LAS unsigned* st) {
    XcdBarrier b; b.bar = bar; b.x = xb_xcc_id(); b.st = st;
    if (threadIdx.x == 0) (void)xb_add(&bar[XB_XCNT(b.x)], 1u);
    return b;
}
__device__ __forceinline__ void xcd_barrier_complete(unsigned* bar, unsigned x, unsigned& nloc, unsigned& nx) {
    const unsigned G = gridDim.x * gridDim.y * gridDim.z;
    unsigned sum, cnt, mine, sp = 0u;
    for (;;) {
        sum = 0u; cnt = 0u; mine = 0u;
#pragma unroll
        for (unsigned j = 0; j < 16; ++j) { const unsigned c = xb_ld(&bar[XB_XCNT(j)]); sum += c; cnt += (c > 0u) ? 1u : 0u; mine = (j == x) ? c : mine; }
        if (sum == G) break;
        __builtin_amdgcn_s_sleep(1);
        if ((++sp & 255u) == 0u) { if (xb_ld(&bar[XB_TMO])) break; if (sp > XB_SPIN_CAP) { atomicAdd(&bar[XB_TMO], 1u); break; } }
    }
    nloc = mine > 0u ? mine : 1u; nx = cnt > 0u ? cnt : 1u;
}
__device__ __forceinline__ void xcd_barrier(const XcdBarrier& b) {
    asm volatile("s_waitcnt vmcnt(0)" ::: "memory");
    __syncthreads();
    if (threadIdx.x == 0) {
        unsigned* bar = b.bar;
        __builtin_amdgcn_s_waitcnt(0);
        unsigned nloc = b.st[0], nx = b.st[1];
        if (nloc == 0u) { xcd_barrier_complete(bar, b.x, nloc, nx); b.st[0] = nloc; b.st[1] = nx; }
        const unsigned old = xb_add(&bar[XB_XSUB(b.x)], 1u);
        const unsigned gen = old / nloc;
        if (old + 1u == (gen + 1u) * nloc) {
            __builtin_amdgcn_fence(__ATOMIC_RELEASE, "agent");
            asm volatile("s_waitcnt vmcnt(0)" ::: "memory");
            const unsigned og = xb_add(&bar[XB_TOP], 1u);
            const unsigned tg = og / nx;
            if (og + 1u == (tg + 1u) * nx) xb_add(&bar[XB_TOPGEN], 1u);
            else XB_SPIN(xb_ld(&bar[XB_TOPGEN]) == tg, bar);
            __builtin_amdgcn_fence(__ATOMIC_ACQUIRE, "agent");
            xb_add(&bar[XB_XGEN(b.x)], 1u);
            asm volatile("s_waitcnt vmcnt(0)" ::: "memory");
        } else {
            XB_SPIN(xb_ld(&bar[XB_XGEN(b.x)]) == gen, bar);
            __builtin_amdgcn_fence(__ATOMIC_ACQUIRE, "agent");
            asm volatile("s_waitcnt vmcnt(0)" ::: "memory");
        }
    }
    __syncthreads();
}

#if MEGA
typedef const __attribute__((address_space(4))) Params* kparams_t;
__device__ __forceinline__ Params load_params(kparams_t k) {
    Params q; q.x_in = k->x_in; q.norm_g = k->norm_g; q.w_in = k->w_in; q.conv_w = k->conv_w; q.w_out_conv = k->w_out_conv; q.q_g = k->q_g; q.k_g = k->k_g; q.w_out_attn = k->w_out_attn;
    q.pool_w = k->pool_w; q.pool_scale = k->pool_scale; q.w_out_pool = k->w_out_pool; q.w_o = k->w_o; q.x = k->x; q.ws = k->ws; return q; }
#define PHP(q) kparams_t kq_##q = kp; asm volatile("" : "+s"(kq_##q)); const Params q = load_params(kq_##q);
__global__ __launch_bounds__(NTHR) void k_mega(Params p_unused) {
    extern __shared__ __attribute__((aligned(16))) char shm[];
    cg::grid_group grid = cg::this_grid();
    kparams_t kp = (kparams_t)__builtin_amdgcn_kernarg_segment_ptr();
    __shared__ uint4 xb_words;
    if (threadIdx.x == 0) xb_words = make_uint4(0u, 0u, 0u, 0u);
    __syncthreads();
    const XcdBarrier xb = xcd_barrier_post((unsigned*)(kp->ws + WS_BAR), (volatile LAS unsigned*)&xb_words);

#ifndef SK_PREP
        { PHP(p) phase_prep0(p, shm); }
#endif
#ifdef DUP_PREP
        { PHP(p) phase_prep0(p, shm); }
#endif

    grid.sync();
    for (int l = 0; l < NL; ++l) {

#ifndef SK_IN
        { PHP(p) phase_in(p, l, shm); }
#endif
#ifdef DUP_IN
        { PHP(p) phase_in(p, l, shm); }
#endif

        xcd_barrier(xb);

        { PHP(p) phase_mix(p, l); phase_indexer(p, 0, p.scores()); }
        xcd_barrier(xb);
        { PHP(p) phase_indexer(p, 1, p.scores2()); phase_select(p, 0, shm, p.scores()); }
        xcd_barrier(xb);
        { PHP(p) phase_indexer(p, 2, p.scores()); phase_select(p, 1, shm, p.scores2()); }
        xcd_barrier(xb);
        { PHP(p) phase_indexer(p, 3, p.scores2()); phase_select(p, 2, shm, p.scores()); }
        xcd_barrier(xb);
        { PHP(p) phase_select(p, 3, shm, p.scores2()); }
        xcd_barrier(xb);
#ifndef SK_ATTN
        { PHP(p) phase_attn(p, shm); }
#endif
#ifdef DUP_ATTN
        { PHP(p) phase_attn(p, shm); }
#endif

        xcd_barrier(xb);

#ifndef SK_MERGE
        { PHP(p) phase_merge(p, l, shm); }
#endif
#ifdef DUP_MERGE
        { PHP(p) phase_merge(p, l, shm); }
#endif

        xcd_barrier(xb);

#ifndef SK_OUT
        { PHP(p) phase_out(p, l, shm); }
#endif

        xcd_barrier(xb);
    }
}
#endif

static Params make_params(void* const* d_in, void* d_out, void* d_ws) {
    Params p{};
    p.x_in = (const float*)d_in[0]; p.norm_g = (const float*)d_in[1]; p.w_in = (const float*)d_in[2]; p.conv_w = (const float*)d_in[3];
    p.w_out_conv = (const float*)d_in[4]; p.q_g = (const float*)d_in[5]; p.k_g = (const float*)d_in[6]; p.w_out_attn = (const float*)d_in[7];
    p.pool_w = (const float*)d_in[8]; p.pool_scale = (const float*)d_in[9]; p.w_out_pool = (const float*)d_in[10]; p.w_o = (const float*)d_in[11];
    p.x = (float*)d_out; p.ws = (char*)d_ws;
    return p;
}

extern "C" void kernel_launch(void* const* d_in, const int* in_sizes, int n_in, void* d_out, int out_size, void* d_ws, size_t ws_size, hipStream_t stream) {
    if (ws_size < WS_NEEDED) { fprintf(stderr, "workspace too small: %zu < %zu\n", ws_size, (size_t)WS_NEEDED); return; }
    Params p = make_params(d_in, d_out, d_ws);
    static int grid = 0;
    if (!grid) { int dev = 0, cus = 0; hipGetDevice(&dev); hipDeviceGetAttribute(&cus, hipDeviceAttributeMultiprocessorCount, dev); if (cus <= 0 || cus > 256) cus = 256; grid = (cus / 8) * 8; }
#if MEGA
    static bool attr = false;
    if (!attr) { hipFuncSetAttribute((const void*)k_mega, hipFuncAttributeMaxDynamicSharedMemorySize, LDS_BYTES); attr = true; }
    hipMemsetAsync((char*)d_ws + WS_BAR, 0, 16384, stream);
    void* args[] = {&p};
    hipError_t e = hipLaunchCooperativeKernel((void*)k_mega, dim3(grid), dim3(NTHR), args, LDS_BYTES, stream);
    if (e != hipSuccess) fprintf(stderr, "cooperative launch failed: %s\n", hipGetErrorString(e));
#else
    static bool attr = false;
    if (!attr) {
        hipFuncSetAttribute((const void*)k_phase<PH_PREP0>, hipFuncAttributeMaxDynamicSharedMemorySize, LDS_BYTES);
        hipFuncSetAttribute((const void*)k_phase<PH_IN>, hipFuncAttributeMaxDynamicSharedMemorySize, LDS_BYTES);
        hipFuncSetAttribute((const void*)k_phase<PH_MIX>, hipFuncAttributeMaxDynamicSharedMemorySize, LDS_BYTES);
        hipFuncSetAttribute((const void*)k_phase<PH_IDX>, hipFuncAttributeMaxDynamicSharedMemorySize, LDS_BYTES);
        hipFuncSetAttribute((const void*)k_phase<PH_SEL>, hipFuncAttributeMaxDynamicSharedMemorySize, LDS_BYTES);
        hipFuncSetAttribute((const void*)k_phase<PH_ATTN>, hipFuncAttributeMaxDynamicSharedMemorySize, LDS_BYTES);
        hipFuncSetAttribute((const void*)k_phase<PH_MERGE>, hipFuncAttributeMaxDynamicSharedMemorySize, LDS_BYTES);
        hipFuncSetAttribute((const void*)k_phase<PH_OUT>, hipFuncAttributeMaxDynamicSharedMemorySize, LDS_BYTES);
        attr = true;
    }
#define LAUNCH(PH, l, b) hipLaunchKernelGGL(k_phase<PH>, dim3(grid), dim3(NTHR), LDS_BYTES, stream, p, l, b)
    LAUNCH(PH_PREP0, 0, 0);
    for (int l = 0; l < NL; ++l) {
        LAUNCH(PH_IN, l, 0);
        LAUNCH(PH_MIX, l, 0);
        for (int b = 0; b < NBATCH; ++b) { LAUNCH(PH_IDX, l, b); LAUNCH(PH_SEL, l, b); }
        LAUNCH(PH_ATTN, l, 0);
        LAUNCH(PH_MERGE, l, 0);
        LAUNCH(PH_OUT, l, 0);
    }
#endif
}
```

```cpp
#include <hip/hip_runtime.h>
#include <hip/hip_cooperative_groups.h>
#include <stdint.h>
#include <stdio.h>
namespace cg = cooperative_groups;

typedef unsigned short u16;
typedef unsigned long long u64;
typedef __attribute__((ext_vector_type(8))) short bf16x8;
typedef __attribute__((ext_vector_type(4))) short s16x4;
typedef __attribute__((ext_vector_type(4))) float f32x4;
typedef __attribute__((ext_vector_type(16))) float f32x16;
typedef __attribute__((ext_vector_type(4))) unsigned u32x4;
typedef __attribute__((ext_vector_type(2))) unsigned u32x2;

#ifndef MEGA
#define MEGA 1
#endif
__device__ __forceinline__ int TID() { int t = threadIdx.x; asm volatile("" : "+v"(t)); return t; }
__device__ __forceinline__ int BID() { int t = blockIdx.x; asm volatile("" : "+s"(t)); return t; }
__device__ __forceinline__ int GDIM() { int t = gridDim.x; asm volatile("" : "+s"(t)); return t; }

constexpr int SEQ = 8192, NBATCH = 4, T = NBATCH * SEQ, DMODEL = 1024, NL = 4, INW = 8776;
constexpr int NPA = 5888;
constexpr int NTHR = 512;
constexpr int LDS_BYTES = 131072;
constexpr float RMS_EPS = 1e-6f;

struct Params {
    const float *x_in, *norm_g, *w_in, *conv_w, *w_out_conv, *q_g, *k_g, *w_out_attn, *pool_w, *pool_scale, *w_out_pool, *w_o;
    float* x; char* ws;
    __device__ __forceinline__ u16* xb() const { return (u16*)(ws + 0ull); }
    __device__ __forceinline__ u16* ga() const { return (u16*)(ws + 67108864ull); }
    __device__ __forceinline__ u16* q() const { return (u16*)(ws + 100663296ull); }
    __device__ __forceinline__ u16* k() const { return (u16*)(ws + 134217728ull); }
    __device__ __forceinline__ u16* v() const { return (u16*)(ws + 167772160ull); }
    __device__ __forceinline__ u16* sg() const { return (u16*)(ws + 201326592ull); }
    __device__ __forceinline__ u16* iq() const { return (u16*)(ws + 234881024ull); }
    __device__ __forceinline__ u16* sp() const { return (u16*)(ws + 268435456ull); }
    __device__ __forceinline__ u16* z() const { return (u16*)(ws + 301989888ull); }
    __device__ __forceinline__ u16* u() const { return (u16*)(ws + 335544320ull); }
    __device__ __forceinline__ u16* zuspare() const { return (u16*)(ws + 369098752ull); }
    __device__ __forceinline__ u16* ik() const { return (u16*)(ws + 371195904ull); }
    __device__ __forceinline__ float* iw() const { return (float*)(ws + 375390208ull); }
    __device__ __forceinline__ u16* wt_in() const { return (u16*)(ws + 376438784ull); }
    __device__ __forceinline__ u16* wt_mg() const { return (u16*)(ws + 424673280ull); }
    __device__ __forceinline__ u16* wt_oa() const { return (u16*)(ws + 449839104ull); }
    __device__ __forceinline__ u16* wt_ob() const { return (u16*)(ws + 454033408ull); }
    __device__ __forceinline__ u16* wt_oc() const { return (u16*)(ws + 458227712ull); }
    __device__ __forceinline__ u16* wt_o() const { return (u16*)(ws + 462422016ull); }
    __device__ __forceinline__ float* ropec() const { return (float*)(ws + 470810624ull); }
    __device__ __forceinline__ float* ropes() const { return (float*)(ws + 471859200ull); }
    __device__ __forceinline__ float* sumsq() const { return (float*)(ws + 472907776ull); }
    __device__ __forceinline__ u64* mask() const { return (u64*)(ws + 477102080ull); }
    __device__ __forceinline__ u16* scores() const { return (u16*)(ws + 494403584ull); }
    __device__ __forceinline__ u16* scores2() const { return z(); }
    __device__ __forceinline__ u16* stash() const { return scores(); }
    __device__ __forceinline__ u16* merged() const { return q(); }
    __device__ __forceinline__ u16* bin() const { return iq(); }
};
constexpr size_t WS_BAR = 563609600ull;
constexpr size_t WS_NEEDED = WS_BAR + 16384;


__device__ __forceinline__ unsigned cvtpk(float lo, float hi) { unsigned r; asm("v_cvt_pk_bf16_f32 %0, %1, %2" : "=v"(r) : "v"(lo), "v"(hi)); return r; }
__device__ __forceinline__ u16 f2bf(float f) { return (u16)(cvtpk(f, 0.f) & 0xffffu); }
__device__ __forceinline__ float bf2f(u16 b) { return __uint_as_float(((unsigned)b) << 16); }
__device__ __forceinline__ float bflo(unsigned w) { return __uint_as_float(w << 16); }
__device__ __forceinline__ float bfhi(unsigned w) { return __uint_as_float(w & 0xffff0000u); }
__device__ __forceinline__ float siluf(float x) { return x * __builtin_amdgcn_rcpf(1.f + __builtin_amdgcn_exp2f(x * -1.4426950408889634f)); }
__device__ __forceinline__ float sigmf(float x) { return __builtin_amdgcn_rcpf(1.f + __builtin_amdgcn_exp2f(x * -1.4426950408889634f)); }

__device__ __forceinline__ float row_rstd(const float* ssp, int row) {
    const f32x4* q = (const f32x4*)(ssp + (size_t)row * 16);
    const f32x4 a = q[0], b = q[1], c = q[2], d = q[3];
    const float s = ((a[0] + a[1]) + (a[2] + a[3])) + ((b[0] + b[1]) + (b[2] + b[3])) + ((c[0] + c[1]) + (c[2] + c[3])) + ((d[0] + d[1]) + (d[2] + d[3]));
    return __builtin_amdgcn_rsqf(s * (1.f / 1024.f) + RMS_EPS);
}
__device__ __forceinline__ int lc_of_tc(int tc) { int bj = tc >> 7, wc = (tc >> 5) & 3, n = (tc >> 4) & 1, fq = (tc >> 2) & 3, j = tc & 3; return ((wc * 4 + fq) << 4) + bj * 8 + n * 4 + j; }
__device__ __forceinline__ int tc_of_lc(int lc) { int cl = lc >> 4, s = lc & 15, wc = cl >> 2, fq = cl & 3, bj = s >> 3, n = (s >> 2) & 1, j = s & 3; return bj * 128 + wc * 32 + n * 16 + fq * 4 + j; }

__device__ __forceinline__ int src_col_in(int np) {
    int pn = np >> 8, tc = np & 255;
    int bj = tc >> 7, wc = (tc >> 5) & 3, n = (tc >> 4) & 1, fq = (tc >> 2) & 3, j = tc & 3, cl = wc * 4 + fq, s = bj * 8 + n * 4 + j, lc = cl * 16 + s;
    int d = (s < 8) ? (8 * fq + s) : (8 * fq + 32 + (s - 8));
    if (pn < 8) return (s & 3) * 512 + pn * 64 + cl * 4 + (s >> 2);
    if (pn < 12) { int which = (pn - 8) >> 1, head = ((pn - 8) & 1) * 4 + wc; return 2048 + which * 512 + head * 64 + d; }
    if (pn < 14) return 3072 + (pn - 12) * 256 + lc;
    if (pn < 16) return 3584 + (pn - 14) * 256 + lc;
    if (pn < 18) { int head = (pn - 16) * 4 + wc; return 4096 + head * 64 + d; }
    if (pn == 18) { if (wc == 0) return 4608 + d; if (wc == 1 && fq == 0 && s < 8) return 4672 + s; return -1; }
    if (pn < 21) return -2;
    return 5192 + (pn - 21) * 256 + lc;
}

__device__ __forceinline__ void prep_x(const Params& p) {
    const int tid_ = TID(); const int lane = tid_ & 63, gw = BID() * (NTHR / 64) + (tid_ >> 6), nw = GDIM() * (NTHR / 64);
    for (int row0 = gw * 4; row0 < T; row0 += nw * 4) {
        float4 v[4][4];
#pragma unroll
        for (int r = 0; r < 4; ++r)
#pragma unroll
            for (int i = 0; i < 4; ++i) v[r][i] = ((const float4*)(p.x_in + (size_t)(row0 + r) * DMODEL))[i * 64 + lane];
        float ss[4];
#pragma unroll
        for (int r = 0; r < 4; ++r) { ss[r] = 0.f;
#pragma unroll
            for (int i = 0; i < 4; ++i) { const float4 q = v[r][i]; ss[r] += q.x * q.x + q.y * q.y + q.z * q.z + q.w * q.w;
                u32x2 o; o[0] = cvtpk(q.x, q.y); o[1] = cvtpk(q.z, q.w);
                *(u32x2*)(p.xb() + (size_t)(row0 + r) * DMODEL + (i * 64 + lane) * 4) = o; } }
#pragma unroll
        for (int m = 32; m >= 1; m >>= 1) {
#pragma unroll
            for (int r = 0; r < 4; ++r) ss[r] += __shfl_xor(ss[r], m); }
        if (lane < 16) {
#pragma unroll
            for (int r = 0; r < 4; ++r) p.sumsq()[(size_t)(row0 + r) * 16 + lane] = (lane == 0) ? ss[r] : 0.f; }
    }
}
__device__ __forceinline__ void prep_rope(const Params& p) {
    const int i0 = BID() * NTHR + TID(), istep = GDIM() * NTHR;
    for (int i = i0; i < SEQ * 32; i += istep) {
        int pos = i >> 5, j = i & 31;
        float inv = 1.0f / powf(10000.0f, (float)(2 * j) / 64.0f);
        float ang = (float)pos * inv;
        p.ropec()[i] = cosf(ang); p.ropes()[i] = sinf(ang);
    }
}
__device__ __forceinline__ void prep_wt(const float* src, int lds_, const float* scale, u16* dst, int K, int NP, int mode, float* tile) {
    const int tid_ = TID(); const int tx = tid_ & 63, ty = tid_ >> 6; const int bid_ = BID(), gdim_ = GDIM();
    const int ntn = NP / 64, ntk = K / 64;
    for (int t = bid_; t < ntn * ntk; t += gdim_) {
        const int n0 = (t / ntk) * 64, k0 = (t % ntk) * 64;
        int np = n0 + tx, col;
        if (mode == 0) col = src_col_in(np);
        else if (mode == 1) col = 5704 + (np & ~255) + lc_of_tc(np & 255);
        else col = (np & ~255) + lc_of_tc(np & 255);
        __syncthreads();
#pragma unroll
        for (int i = 0; i < 8; ++i) { int kk = ty + 8 * i; tile[kk * 65 + tx] = (col >= 0) ? src[(size_t)(k0 + kk) * lds_ + col] : 0.f; }
        __syncthreads();
        const float sc = scale ? scale[k0 + tx] : 1.f;
#pragma unroll
        for (int i = 0; i < 8; ++i) {
            int nn = ty + 8 * i; int npo = n0 + nn;
            bool skip = (mode == 0) && ((npo >> 8) == 19 || (npo >> 8) == 20);
            if (!skip) dst[(size_t)npo * K + k0 + tx] = f2bf(tile[tx * 65 + nn] * sc);
        }
    }
}
__device__ __forceinline__ void prep_fold(const float* win, const float* ng, const float* pw, u16* wt_in) {
    const int i0 = BID() * NTHR + TID(), istep = GDIM() * NTHR;
    for (int i = i0; i < 1024 * 512; i += istep) {
        int k = i >> 9, n = i & 511, g = n >> 7, d = n & 127;
        const float* wr = win + (size_t)k * INW + 4680 + g * 128;
        const float* pp = pw + (size_t)g * 128 * 128 + d;
        float acc = 0.f;
        for (int c = 0; c < 128; ++c) acc += wr[c] * pp[c * 128];
        int row = (19 + (n >> 8)) * 256 + tc_of_lc(n & 255);
        wt_in[(size_t)row * 1024 + k] = f2bf(acc * ng[k]);
    }
}
__device__ __forceinline__ void phase_prep0(const Params& p, char* shm) {
    prep_x(p); prep_rope(p);
    float* tile = (float*)shm;
    for (int l = 0; l < NL; ++l) {
        const float* ng = p.norm_g + l * 1024;
        const float* win = p.w_in + (size_t)l * 1024 * INW;
        prep_wt(win, INW, ng, p.wt_in() + (size_t)l * NPA * 1024, 1024, NPA, 0, tile);
        prep_wt(win, INW, ng, p.wt_mg() + (size_t)l * 3072 * 1024, 1024, 3072, 1, tile);
        prep_wt(p.w_out_conv + (size_t)l * 512 * 1024, 1024, nullptr, p.wt_oa() + (size_t)l * 1024 * 512, 512, 1024, 2, tile);
        prep_wt(p.w_out_attn + (size_t)l * 512 * 1024, 1024, nullptr, p.wt_ob() + (size_t)l * 1024 * 512, 512, 1024, 2, tile);
        prep_wt(p.w_out_pool + (size_t)l * 512 * 1024, 1024, nullptr, p.wt_oc() + (size_t)l * 1024 * 512, 512, 1024, 2, tile);
        prep_wt(p.w_o + (size_t)l * 1024 * 1024, 1024, nullptr, p.wt_o() + (size_t)l * 1024 * 1024, 1024, 1024, 3, tile);
        prep_fold(win, ng, p.pool_w + (size_t)l * 4 * 128 * 128, p.wt_in() + (size_t)l * NPA * 1024);
    }
}

namespace pg8 {
#define PG8_LAS __attribute__((address_space(3)))
typedef unsigned short bf16_t;
constexpr int BM = 256, BK = 64, HALF = 128, HTB = HALF * BK * 2, STAGE_BYTES = 8 * HTB;
__device__ __forceinline__ int lds_byte(int r, int c) { const int st = (r >> 4) * 2 + (c >> 5), rr = r & 15, cc = c & 31, ob = rr * 64 + cc * 2; return st * 1024 + (ob ^ (((ob >> 9) & 1) << 5)); }
__device__ __forceinline__ void stage_rc(int b, int& R, int& C) { const int st = b / 1024, sb = b % 1024, swz = sb ^ (((sb >> 9) & 1) << 5); R = (st >> 1) * 16 + swz / 64; C = (st & 1) * 32 + (swz % 64) / 2; }
struct Unit { int pm, pn; };
struct Gemm { const bf16_t* A; const bf16_t* Bt; int M, N, K; };
constexpr int NXCD = 8, WGM = 8;
struct StaticOrder {
    int nM, nN, nwg, G, c;
    __device__ void init(int M, int N, int G_, int c_) { nM = M / BM; nN = N / BM; nwg = nM * nN; G = G_; c = c_; }
    __device__ bool next(int i, Unit& u) const {
        const long L = (long)i * G + c; if (L >= nwg) return false;
        int wgid = (int)L; { const int q = nwg / NXCD, r = nwg % NXCD, xcd = wgid % NXCD, off = wgid / NXCD; wgid = (xcd < r ? xcd * (q + 1) : r * (q + 1) + (xcd - r) * q) + off; }
        const int nig = WGM * nN, gid = wgid / nig, fm = gid * WGM, gsz = (nM - fm) < WGM ? (nM - fm) : WGM;
        u.pm = fm + ((wgid % nig) % gsz); u.pn = (wgid % nig) / gsz; return true;
    }
};
struct RowOrder {
    int nN, ntile, G, c;
    __device__ bool next(int i, Unit& u) const {
        const int x = c & 7, lt = (c >> 3) + (G >> 3) * i;
        const int quad = lt >> 2, pm = quad * 8 + x;
        if (pm * 4 >= ntile) return false;
        u.pm = pm; u.pn = lt & 3; return true; }
};
template <class Epi, class Sched>
__device__ __forceinline__ void gemm_phase(PG8_LAS unsigned char* lds, const Gemm g, const Sched& S, const Epi& E) {
    const int tid = TID(), wid = __builtin_amdgcn_readfirstlane(tid >> 6), lane = tid & 63, wr = wid >> 2, wc = wid & 3, fr = lane & 15, fq = lane >> 4;
    const int K = g.K, nt = K / BK;
    unsigned voffA[2], voffB[2];
#pragma unroll
    for (int i = 0; i < 2; ++i) { int R, C; stage_rc(tid * 16 + i * 8192, R, C); voffA[i] = (unsigned)(R * K + C) * 2u; voffB[i] = voffA[i]; }
    const size_t kstep = (size_t)(BK * 2);
    const size_t hstep = (size_t)HALF * K * 2;
    const size_t tstep = 2 * hstep;
    const unsigned ldsw = (unsigned)wid * 1024u;
    const int aoff = lds_byte(wr * 64 + fr, fq * 8), boff = lds_byte(wc * 32 + fr, fq * 8);
#define PG8_SA(b, h) (((b) * 2 + (h)) * HTB)
#define PG8_SB(b, h) ((4 + (b) * 2 + (h)) * HTB)
#define PG8_STAGE(bufoff, gbase, voff) do { _Pragma("unroll") for (int _i = 0; _i < 2; ++_i) \
        __builtin_amdgcn_global_load_lds((const unsigned*)((const char*)(gbase) + (voff)[_i]), (PG8_LAS unsigned*)(lds + (bufoff) + ldsw + _i * 8192), 16, 0, 0); } while (0)
#define PG8_LDA(dst, b, h) do { _Pragma("unroll") for (int m = 0; m < 4; ++m) _Pragma("unroll") for (int k = 0; k < 2; ++k) dst[m][k] = *(const PG8_LAS bf16x8*)(lds + PG8_SA(b, h) + aoff + m * 2048 + k * 1024); } while (0)
#define PG8_LDB(dst, b, h) do { _Pragma("unroll") for (int n = 0; n < 2; ++n) _Pragma("unroll") for (int k = 0; k < 2; ++k) dst[n][k] = *(const PG8_LAS bf16x8*)(lds + PG8_SB(b, h) + boff + n * 2048 + k * 1024); } while (0)
#define PG8_MMA(ai, bj, At, Bt) do { __builtin_amdgcn_s_setprio(1); _Pragma("unroll") for (int m = 0; m < 4; ++m) _Pragma("unroll") for (int n = 0; n < 2; ++n) _Pragma("unroll") for (int k = 0; k < 2; ++k) \
        acc[ai][bj][m][n] = __builtin_amdgcn_mfma_f32_16x16x32_bf16(Bt[n][k], At[m][k], acc[ai][bj][m][n], 0, 0, 0); __builtin_amdgcn_s_setprio(0); } while (0)
#define PG8_WAIT_V(n) asm volatile("s_waitcnt vmcnt(" #n ")" ::: "memory")
#define PG8_WAIT_L(n) asm volatile("s_waitcnt lgkmcnt(" #n ")" ::: "memory")
#define PG8_BAR __builtin_amdgcn_s_barrier()
#define PG8_SCHED __builtin_amdgcn_sched_barrier(0)
    Unit cur, nxt; int ui = 0;
    if (!S.next(0, cur)) return;
    f32x4 acc[2][2][4][2];
#pragma unroll
    for (int a = 0; a < 2; ++a)
#pragma unroll
        for (int b = 0; b < 2; ++b)
#pragma unroll
            for (int m = 0; m < 4; ++m)
#pragma unroll
                for (int n = 0; n < 2; ++n) acc[a][b][m][n] = (f32x4){0.f, 0.f, 0.f, 0.f};
    bf16x8 At[4][2], B0[2][2], B1[2][2];
    const char* cA = (const char*)g.A + (size_t)cur.pm * tstep; const char* cB = (const char*)g.Bt + (size_t)cur.pn * tstep;
    PG8_STAGE(PG8_SB(0, 0), cB, voffB); PG8_STAGE(PG8_SA(0, 0), cA, voffA); PG8_STAGE(PG8_SB(0, 1), cB + hstep, voffB); PG8_STAGE(PG8_SA(0, 1), cA + hstep, voffA);
    if (wr == 1) PG8_BAR;
    PG8_WAIT_V(4); PG8_BAR;
    PG8_STAGE(PG8_SB(1, 0), cB + kstep, voffB); PG8_STAGE(PG8_SA(1, 0), cA + kstep, voffA); PG8_STAGE(PG8_SB(1, 1), cB + hstep + kstep, voffB);
    PG8_WAIT_V(6); PG8_BAR;
    for (;;) {
        const bool has_next = S.next(ui + 1, nxt);
        const char* nA = has_next ? (const char*)g.A + (size_t)nxt.pm * tstep : cA; const char* nB = has_next ? (const char*)g.Bt + (size_t)nxt.pn * tstep : cB;
        for (int t = 0; t < nt; t += 2) {
            const bool last = (t == nt - 2);
            const char* a1 = cA + (size_t)(t + 1) * kstep;
            const char* a2 = last ? nA : cA + (size_t)(t + 2) * kstep; const char* b2 = last ? nB : cB + (size_t)(t + 2) * kstep;
            const char* a3 = a2 + kstep; const char* b3 = b2 + kstep;
            PG8_LDB(B0, 0, 0); PG8_SCHED; PG8_LDA(At, 0, 0); PG8_STAGE(PG8_SA(1, 1), a1 + hstep, voffA);
            PG8_WAIT_L(8); PG8_BAR; PG8_WAIT_L(0); PG8_MMA(0, 0, At, B0); PG8_BAR; PG8_SCHED;
            PG8_LDB(B1, 0, 1); PG8_STAGE(PG8_SB(0, 0), b2, voffB);
            PG8_BAR; PG8_WAIT_L(0); PG8_MMA(0, 1, At, B1); PG8_BAR;
            PG8_LDA(At, 0, 1); PG8_STAGE(PG8_SA(0, 0), a2, voffA);
            PG8_BAR; PG8_WAIT_L(0); PG8_MMA(1, 0, At, B0); PG8_BAR; PG8_SCHED;
            PG8_STAGE(PG8_SB(0, 1), b2 + hstep, voffB);
            PG8_WAIT_V(6); PG8_BAR; PG8_MMA(1, 1, At, B1); PG8_BAR;
            PG8_LDB(B0, 1, 0); PG8_SCHED; PG8_LDA(At, 1, 0); PG8_STAGE(PG8_SA(0, 1), a2 + hstep, voffA);
            PG8_WAIT_L(8); PG8_BAR; PG8_WAIT_L(0); PG8_MMA(0, 0, At, B0); PG8_BAR; PG8_SCHED;
            PG8_LDB(B1, 1, 1); PG8_STAGE(PG8_SB(1, 0), b3, voffB);
            PG8_BAR; PG8_WAIT_L(0); PG8_MMA(0, 1, At, B1); PG8_BAR;
            PG8_LDA(At, 1, 1); PG8_STAGE(PG8_SA(1, 0), a3, voffA);
            PG8_BAR; PG8_WAIT_L(0); PG8_MMA(1, 0, At, B0); PG8_BAR; PG8_SCHED;
            PG8_STAGE(PG8_SB(1, 1), b3 + hstep, voffB);
            PG8_WAIT_V(6); PG8_BAR; PG8_MMA(1, 1, At, B1); PG8_BAR;
        }
        E(acc, cur, ui, wr, wc, fr, fq);
#ifdef DUP_EPI
        if (Epi::DUPOK) E(acc, cur, ui, wr, wc, fr, fq);
#endif
        if (!has_next) break;
#pragma unroll
        for (int a = 0; a < 2; ++a)
#pragma unroll
            for (int b = 0; b < 2; ++b)
#pragma unroll
                for (int m = 0; m < 4; ++m)
#pragma unroll
                    for (int n = 0; n < 2; ++n) acc[a][b][m][n] = (f32x4){0.f, 0.f, 0.f, 0.f};
        cur = nxt; cA = nA; cB = nB; ++ui;
    }
    PG8_WAIT_V(0);
    if (wr == 0) PG8_BAR;
    PG8_BAR;
#undef PG8_SA
#undef PG8_SB
#undef PG8_STAGE
#undef PG8_LDA
#undef PG8_LDB
#undef PG8_MMA
#undef PG8_WAIT_V
#undef PG8_WAIT_L
#undef PG8_BAR
#undef PG8_SCHED
}
}
typedef f32x4 acc_t[2][2][4][2];
#define ROWS_LOOP _Pragma("unroll") for (int ai = 0; ai < 2; ++ai) _Pragma("unroll") for (int m = 0; m < 4; ++m)
#define ROW_OF (u.pm * 256 + ai * 128 + wr * 64 + m * 16 + fr)

struct EpiIn {
    static constexpr bool DUPOK = true;
    const Params& p; int l;
    __device__ __forceinline__ void operator()(const acc_t& acc, const pg8::Unit& u, int ui, int wr, int wc, int fr, int fq) const {
        const float* ssq = p.sumsq() + (size_t)(l & 1) * T * 16;
        const int pn = u.pn, cl = wc * 4 + fq;
        __shared__ float s_rstd[256];
        { const int t_ = TID(); if (t_ < 256) s_rstd[t_] = row_rstd(ssq, u.pm * 256 + t_); __syncthreads(); }
        float rsa[8];
#pragma unroll
        for (int ix = 0; ix < 8; ++ix) rsa[ix] = s_rstd[(ix >> 2) * 128 + wr * 64 + (ix & 3) * 16 + fr];
        if (pn < 8) {
            ROWS_LOOP { const int row = ROW_OF; const float rs = rsa[ai * 4 + m];
                float zz[4], gg[4];
#pragma unroll
                for (int ch = 0; ch < 4; ++ch) { const f32x4 v = acc[ai][ch >> 1][m][ch & 1]; zz[ch] = (v[1] * rs) * (v[2] * rs); gg[ch] = (v[0] * rs) * siluf(v[3] * rs); }
                const size_t o = (size_t)row * 512 + pn * 64 + cl * 4;
                u32x2 a; a[0] = cvtpk(zz[0], zz[1]); a[1] = cvtpk(zz[2], zz[3]); *(u32x2*)(p.z() + o) = a;
                u32x2 b; b[0] = cvtpk(gg[0], gg[1]); b[1] = cvtpk(gg[2], gg[3]); *(u32x2*)(p.ga() + o) = b; }
        } else if (pn < 12 || (pn >= 16 && pn <= 18)) {
            if (pn == 18 && wc >= 1) {
                if (wc == 1 && fq == 0) {
                    ROWS_LOOP { const int row = ROW_OF; const float rs = rsa[ai * 4 + m] * 0.04419417382415922f;
                        *(f32x4*)(p.iw() + (size_t)row * 8) = acc[ai][0][m][0] * rs; *(f32x4*)(p.iw() + (size_t)row * 8 + 4) = acc[ai][0][m][1] * rs; }
                }
            } else {
                const bool isqk = pn < 12; const int which = (pn - 8) >> 1;
                int head; u16* dst; int pitch;
                if (isqk) { head = ((pn - 8) & 1) * 4 + wc; dst = which ? p.k() : p.q(); pitch = 512; }
                else if (pn < 18) { head = (pn - 16) * 4 + wc; dst = p.iq(); pitch = 512; }
                else { head = 0; dst = p.ik(); pitch = 64; }
                f32x4 g0[2], g1[2];
#pragma unroll
                for (int n = 0; n < 2; ++n) { g0[n] = (f32x4){1.f, 1.f, 1.f, 1.f}; g1[n] = g0[n]; }
                if (isqk) { const float* gg = (which ? p.k_g : p.q_g) + l * 64 + 8 * fq;
#pragma unroll
                    for (int n = 0; n < 2; ++n) { g0[n] = *(const f32x4*)(gg + 4 * n); g1[n] = *(const f32x4*)(gg + 32 + 4 * n); } }
                f32x4 rcb[2], rsb[2];
                { const int pos0 = (u.pm * 256 + wr * 64 + fr) & (SEQ - 1);
#pragma unroll
                  for (int n = 0; n < 2; ++n) { rcb[n] = *(const f32x4*)(p.ropec() + pos0 * 32 + 8 * fq + 4 * n); rsb[n] = *(const f32x4*)(p.ropes() + pos0 * 32 + 8 * fq + 4 * n); } }
                ROWS_LOOP { const int row = ROW_OF; const int ix = ai * 4 + m; const float rs = rsa[ix];
                    f32x4 a0[2], a1[2];
#pragma unroll
                    for (int n = 0; n < 2; ++n) { a0[n] = acc[ai][0][m][n] * rs; a1[n] = acc[ai][1][m][n] * rs; }
                    if (isqk) { float ss = 0.f;
#pragma unroll
                        for (int n = 0; n < 2; ++n)
#pragma unroll
                            for (int j = 0; j < 4; ++j) ss += a0[n][j] * a0[n][j] + a1[n][j] * a1[n][j];
                        ss += __shfl_xor(ss, 16); ss += __shfl_xor(ss, 32);
                        const float rn = __builtin_amdgcn_rsqf(ss * (1.f / 64.f) + RMS_EPS);
#pragma unroll
                        for (int n = 0; n < 2; ++n) { a0[n] = a0[n] * rn * g0[n]; a1[n] = a1[n] * rn * g1[n]; } }
                    u32x4 o0, o1;
#pragma unroll
                    for (int n = 0; n < 2; ++n) { const f32x4 cc = rcb[n], sn = rsb[n];
                        const f32x4 r0 = a0[n] * cc - a1[n] * sn, r1 = a1[n] * cc + a0[n] * sn;
                        o0[2 * n] = cvtpk(r0[0], r0[1]); o0[2 * n + 1] = cvtpk(r0[2], r0[3]); o1[2 * n] = cvtpk(r1[0], r1[1]); o1[2 * n + 1] = cvtpk(r1[2], r1[3]); }
                    if (ix < 7) { const int posn = (u.pm * 256 + ((ix + 1) >> 2) * 128 + wr * 64 + ((ix + 1) & 3) * 16 + fr) & (SEQ - 1);
#pragma unroll
                        for (int n = 0; n < 2; ++n) { rcb[n] = *(const f32x4*)(p.ropec() + posn * 32 + 8 * fq + 4 * n); rsb[n] = *(const f32x4*)(p.ropes() + posn * 32 + 8 * fq + 4 * n); } }
                    u16* d = dst + (size_t)row * pitch + head * 64 + 8 * fq;
                    *(u32x4*)d = o0; *(u32x4*)(d + 32) = o1; }
            }
        } else {
            u16* dst; int cb; int kind;
            if (pn < 14) { dst = p.v(); cb = (pn - 12) * 256; kind = 0; }
            else if (pn < 16) { dst = p.sg(); cb = (pn - 14) * 256; kind = 1; }
            else if (pn < 21) { dst = p.u(); cb = (pn - 19) * 256; kind = 0; }
            else { dst = p.sp(); cb = (pn - 21) * 256; kind = 2; }
            f32x4 sc[2][2];
#pragma unroll
            for (int bj = 0; bj < 2; ++bj)
#pragma unroll
                for (int n = 0; n < 2; ++n) sc[bj][n] = (kind == 2) ? *(const f32x4*)(p.pool_scale + l * 512 + cb + 16 * cl + bj * 8 + n * 4) : (f32x4){1.f, 1.f, 1.f, 1.f};
            ROWS_LOOP { const int row = ROW_OF; const float rs = rsa[ai * 4 + m];
#pragma unroll
                for (int bj = 0; bj < 2; ++bj) { f32x4 v0 = acc[ai][bj][m][0] * rs, v1 = acc[ai][bj][m][1] * rs;
                    if (kind >= 1) {
#pragma unroll
                        for (int j = 0; j < 4; ++j) { v0[j] = siluf(v0[j]) * sc[bj][0][j]; v1[j] = siluf(v1[j]) * sc[bj][1][j]; } }
                    u32x4 w; w[0] = cvtpk(v0[0], v0[1]); w[1] = cvtpk(v0[2], v0[3]); w[2] = cvtpk(v1[0], v1[1]); w[3] = cvtpk(v1[2], v1[3]);
                    *(u32x4*)(dst + (size_t)row * 512 + cb + 16 * cl + bj * 8) = w; } }
        }
    }
};
__device__ __forceinline__ void phase_in(const Params& p, int l, char* shm) {
    pg8::Gemm g{p.xb(), p.wt_in() + (size_t)l * NPA * 1024, T, NPA, 1024};
    pg8::StaticOrder S; S.init(T, NPA, GDIM(), BID());
    EpiIn E{p, l};
    pg8::gemm_phase((PG8_LAS unsigned char*)shm, g, S, E);
}
__device__ __forceinline__ void phase_mix(const Params& p, int l) {
    const float* cw = p.conv_w + l * 3 * 512;
    constexpr int RUN = 16;
    const int nitem = (T / RUN) * 256;
    const int it0 = BID() * NTHR + TID(), itstep = GDIM() * NTHR;
    for (int it = it0; it < nitem; it += itstep) {
        const int cp = it & 255, c = cp * 2, t0 = (it >> 8) * RUN, pos0 = t0 & (SEQ - 1);
        {
            const float w00 = cw[c], w01 = cw[c + 1], w10 = cw[512 + c], w11 = cw[513 + c], w20 = cw[1024 + c], w21 = cw[1025 + c];
            unsigned zr[RUN + 2], gr[RUN];
#pragma unroll
            for (int i = 0; i < RUN + 2; ++i) zr[i] = (pos0 + i - 2 >= 0) ? *(const unsigned*)(p.z() + (size_t)(t0 + i - 2) * 512 + c) : 0u;
#pragma unroll
            for (int i = 0; i < RUN; ++i) gr[i] = *(const unsigned*)(p.ga() + (size_t)(t0 + i) * 512 + c);
#pragma unroll
            for (int i = 0; i < RUN; ++i) {
                const float y0 = (w00 * bflo(zr[i]) + w10 * bflo(zr[i + 1]) + w20 * bflo(zr[i + 2])) * bflo(gr[i]);
                const float y1 = (w01 * bfhi(zr[i]) + w11 * bfhi(zr[i + 1]) + w21 * bfhi(zr[i + 2])) * bfhi(gr[i]);
                *(unsigned*)(p.ga() + (size_t)(t0 + i) * 512 + c) = cvtpk(y0, y1);
            }
        }
        {
            const int win = 2 << (c >> 7);
            unsigned ur[RUN + 15], gr[RUN];
#pragma unroll
            for (int i = 0; i < RUN + 15; ++i) ur[i] = (i >= 16 - win && pos0 + i - 15 >= 0) ? *(const unsigned*)(p.u() + (size_t)(t0 + i - 15) * 512 + c) : 0u;
#pragma unroll
            for (int i = 0; i < RUN; ++i) gr[i] = *(const unsigned*)(p.sp() + (size_t)(t0 + i) * 512 + c);
            float s0 = 0.f, s1 = 0.f;
#pragma unroll
            for (int i = 0; i < 15; ++i) { s0 += bflo(ur[i]); s1 += bfhi(ur[i]); }
#pragma unroll
            for (int i = 0; i < RUN; ++i) {
                const int pos = pos0 + i;
                const float u0 = bflo(ur[i + 15]), u1 = bfhi(ur[i + 15]);
                s0 += u0; s1 += u1;
                const float ic = __builtin_amdgcn_rcpf((float)min(pos + 1, win));
                *(unsigned*)(p.sp() + (size_t)(t0 + i) * 512 + c) = cvtpk((s0 * ic - u0) * bflo(gr[i]), (s1 * ic - u1) * bfhi(gr[i]));
                unsigned wo = 0u;
#pragma unroll
                for (int g = 0; g < 4; ++g) if (win == (2 << g)) wo = ur[i + 15 - ((2 << g) - 1)];
                s0 -= bflo(wo); s1 -= bfhi(wo);
            }
        }
    }
}

__device__ __forceinline__ int crow(int r, int hi) { return (r & 3) + 8 * (r >> 2) + 4 * hi; }
__device__ __forceinline__ size_t sc_base(int qb) { return (size_t)32768 * qb * (qb + 1); }
__device__ __forceinline__ void phase_indexer(const Params& p, int b, u16* scbuf) {
    const int tid_ = TID(); const int wid = tid_ >> 6, lane = tid_ & 63, ql = lane & 15, fq = lane >> 4; const int bid_ = BID(), gdim_ = GDIM();
    constexpr int NSTEP = 64 * 65;
    const int f0 = (int)(((long)bid_ * NSTEP) / gdim_), f1 = (int)(((long)(bid_ + 1) * NSTEP) / gdim_);
    int qcur = -1;
    bf16x8 bq[8][2]; float wv[8]; u16* srow = nullptr; int qloc = 0;
#pragma unroll
    for (int h = 0; h < 8; ++h) { wv[h] = 0.f; bq[h][0] = bq[h][1] = (bf16x8){0, 0, 0, 0, 0, 0, 0, 0}; }
    const u16* ikb = p.ik() + ((size_t)b * SEQ + ql) * 64 + fq * 8;
    for (int f = f0; f < f1; ++f) {
        int q = (int)((sqrtf(4.f * f + 1.f) - 1.f) * 0.5f);
        while ((q + 1) * (q + 2) <= f) ++q;
        while (q * (q + 1) > f) --q;
        const int tt = f - q * (q + 1);
        if (q != qcur) {
            qcur = q; qloc = q * 128 + wid * 16 + ql;
            const size_t row = (size_t)b * SEQ + qloc;
#pragma unroll
            for (int h = 0; h < 8; ++h)
#pragma unroll
                for (int kc = 0; kc < 2; ++kc) bq[h][kc] = *(const bf16x8*)(p.iq() + row * 512 + h * 64 + kc * 32 + fq * 8);
            const f32x4 x = *(const f32x4*)(p.iw() + row * 8), y = *(const f32x4*)(p.iw() + row * 8 + 4);
            wv[0] = x[0]; wv[1] = x[1]; wv[2] = x[2]; wv[3] = x[3]; wv[4] = y[0]; wv[5] = y[1]; wv[6] = y[2]; wv[7] = y[3];
            const int a = q >> 1;
            srow = scbuf + sc_base(a) + (size_t)(qloc - a * 256) * (256 * (a + 1));
        }
        const int key0 = tt * 64;
        bf16x8 ka[4][2];
#pragma unroll
        for (int kg = 0; kg < 4; ++kg)
#pragma unroll
            for (int kc = 0; kc < 2; ++kc) ka[kg][kc] = *(const bf16x8*)(ikb + (size_t)(key0 + kg * 16) * 64 + kc * 32);
        const bool band = (key0 + 63 > q * 128 + wid * 16);
#pragma unroll
        for (int kg = 0; kg < 4; ++kg) {
            f32x4 sacc = (f32x4){0.f, 0.f, 0.f, 0.f};
#pragma unroll
            for (int h = 0; h < 8; ++h) {
                f32x4 c = (f32x4){0.f, 0.f, 0.f, 0.f};
                c = __builtin_amdgcn_mfma_f32_16x16x32_bf16(ka[kg][0], bq[h][0], c, 0, 0, 0);
                c = __builtin_amdgcn_mfma_f32_16x16x32_bf16(ka[kg][1], bq[h][1], c, 0, 0, 0);
#pragma unroll
                for (int j = 0; j < 4; ++j) sacc[j] = __builtin_fmaf(wv[h], __builtin_fmaxf(c[j], 0.f), sacc[j]);
            }
            const int kb = key0 + kg * 16 + fq * 4;
            if (band) {
#pragma unroll
                for (int j = 0; j < 4; ++j) if (kb + j > qloc) sacc[j] = -INFINITY;
            }
            union { _Float16 h[4]; u32x2 v; } pk;
            pk.h[0] = (_Float16)sacc[0]; pk.h[1] = (_Float16)sacc[1]; pk.h[2] = (_Float16)sacc[2]; pk.h[3] = (_Float16)sacc[3];
            *(u32x2*)(srow + kb) = pk.v;
        }
    }
}

__device__ __forceinline__ size_t mk_base(int qb) { return (size_t)512 * qb * (qb + 1); }
constexpr size_t MASK_WORDS_PER_BATCH = 540672;
__device__ __forceinline__ unsigned f16key(unsigned h) { return (h & 0x8000u) ? (~h & 0xffffu) : (h | 0x8000u); }
__device__ __forceinline__ void hist_scan(const unsigned* h, int lane, unsigned target, int& bin, unsigned& above, unsigned& inbin) {
    const u32x4 a = *(const u32x4*)(h + 4 * lane), b = *(const u32x4*)(h + 256 + 4 * lane), c = *(const u32x4*)(h + 512 + 4 * lane), d = *(const u32x4*)(h + 768 + 4 * lane);
    const unsigned h0 = a[0] + b[0] + c[0] + d[0], h1 = a[1] + b[1] + c[1] + d[1], h2 = a[2] + b[2] + c[2] + d[2], h3 = a[3] + b[3] + c[3] + d[3];
    const unsigned tot = h0 + h1 + h2 + h3;
    unsigned x = tot;
#pragma unroll
    for (int dd = 1; dd < 64; dd <<= 1) { const unsigned y = __shfl_down(x, dd); if (lane + dd < 64) x += y; }
    const unsigned ab = x - tot, c3 = ab + h3, c2 = c3 + h2, c1 = c2 + h1, c0 = c1 + h0;
    int fb = -1; unsigned fa = 0, fc = 0;
    if (ab < target && c3 >= target) { fb = 4 * lane + 3; fa = ab; fc = h3; }
    else if (c3 < target && c2 >= target) { fb = 4 * lane + 2; fa = c3; fc = h2; }
    else if (c2 < target && c1 >= target) { fb = 4 * lane + 1; fa = c2; fc = h1; }
    else if (c1 < target && c0 >= target) { fb = 4 * lane; fa = c1; fc = h0; }
    const u64 m = __ballot(fb >= 0); const int src = (m == 0) ? 0 : (__ffsll((unsigned long long)m) - 1);
    bin = __shfl(fb, src); above = __shfl(fa, src); inbin = __shfl(fc, src);
}
__device__ __forceinline__ unsigned f16key2(unsigned w) { const unsigned sg = (w >> 15) & 0x00010001u; return w ^ (((sg << 15) - sg) | 0x80008000u); }
__device__ __forceinline__ void phase_select(const Params& p, int b, char* shm, const u16* scbuf) {
    const int tid_ = TID(); const int wid = __builtin_amdgcn_readfirstlane(tid_ >> 6), lane = tid_ & 63;
    const int gw = BID() * 8 + wid, nw = GDIM() * 8;
    unsigned* hist = (unsigned*)shm + wid * 1152;
    const int hsubi = (lane >> 4) * 256, dummyi = 1024 + lane;
    typedef unsigned short us2 __attribute__((ext_vector_type(2)));
#define ROW_T(i_) ({ const int kq_ = (i_) / nw; ((mirror && (kq_ & 1)) ? (kq_ * nw + (nw - 1 - ((i_) - kq_ * nw))) : (i_)); })
#define ROW_LOAD(t_) do { const int qb_ = (t_) >> 8, ntr_ = 2 * (((t_) >> 7) + 1), nch_ = (ntr_ + 7) >> 3; \
        const u16* sr_ = scbuf + sc_base(qb_) + (size_t)((t_) - qb_ * 256) * (256 * (qb_ + 1)); \
        _Pragma("unroll") for (int c = 0; c < 16; ++c) { raw[c] = (u32x4){0u, 0u, 0u, 0u}; if (c < nch_) { if (lane < 8 * (ntr_ - 8 * c)) raw[c] = *(const u32x4*)(sr_ + 512 * c + 8 * lane); } } } while (0)
    const bool mirror = (SEQ % (2 * nw)) == 0;
    u32x4 raw[16];
    if (gw < SEQ) { const int t0_ = ROW_T(gw); ROW_LOAD(t0_); }
    for (int i = gw; i < SEQ; i += nw) {
        const int t = ROW_T(i);
        const int qb = t >> 8, ntile = 4 * (qb + 1), ntr = 2 * ((t >> 7) + 1);
        const int nch = (ntr + 7) >> 3, nchw = (ntile + 7) >> 3;
        unsigned char* mrow = (unsigned char*)(p.mask() + (size_t)b * MASK_WORDS_PER_BATCH + mk_base(qb) + (size_t)(t - qb * 256) * ntile);
        unsigned key[16][4];
#pragma unroll
        for (int c = 0; c < 16; ++c) {
            const bool valid = (c < nch) && (lane < 8 * (ntr - 8 * c));
#pragma unroll
            for (int r = 0; r < 4; ++r) key[c][r] = valid ? f16key2(raw[c][r]) : 0u;
        }
        if (i + nw < SEQ) { const int tn_ = ROW_T(i + nw); ROW_LOAD(tn_); }
        unsigned thrm1 = 0x03ffu, thr = 0x0400u; int need = 0; bool fast = true;
        if (t >= 256) {
            us2 a1 = (us2){0, 0}, a2 = (us2){0, 0};
#pragma unroll
            for (int c = 0; c < 16; ++c) {
                if (c < nch) {
#pragma unroll
                    for (int r = 0; r < 4; ++r) { const us2 kk = __builtin_bit_cast(us2, key[c][r]);
                        const us2 tmx = __builtin_elementwise_max(a1, kk), tmn = __builtin_elementwise_min(a1, kk); a1 = tmx; a2 = __builtin_elementwise_max(a2, tmn); }
                }
            }
            unsigned Lb = min((unsigned)a2[0], (unsigned)a2[1]);
#pragma unroll
            for (int m_ = 32; m_ >= 1; m_ >>= 1) Lb = min(Lb, (unsigned)__shfl_xor((int)Lb, m_));
            Lb = __builtin_amdgcn_readfirstlane(Lb);
            const u32x4 z4 = (u32x4){0u, 0u, 0u, 0u};
#pragma unroll
            for (int c = 0; c < 4; ++c) *(u32x4*)(hist + c * 256 + 4 * lane) = z4;
#pragma unroll
            for (int c = 0; c < 16; ++c) {
                if (c < nch) {
#pragma unroll
                    for (int r = 0; r < 4; ++r) { const unsigned kk = key[c][r]; const unsigned lo = kk & 0xffffu, hi = kk >> 16;
                        atomicAdd(hist + ((lo >= Lb) ? (hsubi + (int)(lo >> 8)) : dummyi), 1u);
                        atomicAdd(hist + ((hi >= Lb) ? (hsubi + (int)(hi >> 8)) : dummyi), 1u); }
                }
            }
            asm volatile("s_waitcnt lgkmcnt(0)" ::: "memory");
            int B1; unsigned ab1, in1;
            hist_scan(hist, lane, 256u, B1, ab1, in1);
            asm volatile("s_waitcnt lgkmcnt(0)" ::: "memory");
#pragma unroll
            for (int c = 0; c < 4; ++c) *(u32x4*)(hist + c * 256 + 4 * lane) = z4;
#pragma unroll
            for (int c = 0; c < 16; ++c) {
                if (c < nch) {
#pragma unroll
                    for (int r = 0; r < 4; ++r) { const unsigned kk = key[c][r]; const unsigned lo = kk & 0xffffu, hi = kk >> 16;
                        const bool ml = ((lo >> 8) == (unsigned)B1) && (lo >= Lb), mh = ((hi >> 8) == (unsigned)B1) && (hi >= Lb);
                        if (__any(ml || mh)) { if (ml) atomicAdd(hist + hsubi + (int)(lo & 255u), 1u); if (mh) atomicAdd(hist + hsubi + (int)(hi & 255u), 1u); } }
                }
            }
            asm volatile("s_waitcnt lgkmcnt(0)" ::: "memory");
            int B2; unsigned ab2, in2;
            hist_scan(hist, lane, 256u - ab1, B2, ab2, in2);
            asm volatile("s_waitcnt lgkmcnt(0)" ::: "memory");
            thr = __builtin_amdgcn_readfirstlane(((unsigned)B1 << 8) | (unsigned)B2);
            need = __builtin_amdgcn_readfirstlane(256 - (int)(ab1 + ab2));
            const int neq = __builtin_amdgcn_readfirstlane((int)in2);
            fast = (need == neq);
            thrm1 = thr - 1u;
        }
        if (fast) {
#pragma unroll
            for (int c = 0; c < 16; ++c) {
                if (c < nchw) {
                    unsigned m = 0u;
#pragma unroll
                    for (int ii = 7; ii >= 0; --ii) { const unsigned kk = key[c][ii >> 1]; const unsigned kv = (ii & 1) ? (kk >> 16) : (kk & 0xffffu); m = m + m + ((kv > thrm1) ? 1u : 0u); }
                    if (64 * c + lane < 8 * ntile) mrow[64 * c + lane] = (unsigned char)m;
                }
            }
        } else {
            int base = 0;
#pragma unroll 1
            for (int c = 0; c < 16; ++c) {
                if (c < nchw) {
                    unsigned m = 0u, e = 0u;
#pragma unroll
                    for (int ii = 7; ii >= 0; --ii) { unsigned kk = (ii >> 1) == 0 ? key[0][0] : 0u;
#pragma unroll
                        for (int cc = 0; cc < 16; ++cc) if (cc == c) kk = key[cc][ii >> 1];
                        const unsigned kv = (ii & 1) ? (kk >> 16) : (kk & 0xffffu); m = m + m + ((kv > thr) ? 1u : 0u); e = e + e + ((kv == thr) ? 1u : 0u); }
                    const int cnt = __builtin_popcount(e);
                    int pre = cnt;
#pragma unroll
                    for (int dd = 1; dd < 64; dd <<= 1) { const int y = __shfl_up(pre, dd); if (lane >= dd) pre += y; }
                    const int tot = __shfl(pre, 63);
                    int rank = base + pre - cnt;
#pragma unroll
                    for (int ii = 0; ii < 8; ++ii) if ((e >> ii) & 1u) { if (rank < need) m |= (1u << ii); ++rank; }
                    base += tot;
                    if (64 * c + lane < 8 * ntile) mrow[64 * c + lane] = (unsigned char)m;
                }
            }
        }
    }
}

constexpr int A_D = 64, A_DM = 512, A_NW = 8, A_QBLK = 32, A_QB = 256, A_KVBLK = 64, A_NQB = SEQ / A_QB, A_NHEAD = 8;
constexpr float A_C2 = 0.125f * 1.4426950408889634f;
constexpr int A_SLOTB = 8192, A_LDS_K = 0, A_LDS_V = 3 * A_SLOTB, A_LDS_WS = 6 * A_SLOTB, A_LDS_OST = A_LDS_WS + A_NW * 256, A_LDS_MK = A_LDS_OST + A_NW * 4096, A_LDS_BYTES = A_LDS_MK + A_NW * 2048;
#define ATTN_THR 8
#define SBAR() __builtin_amdgcn_sched_barrier(0)
#define PIN(x) asm volatile("" : "+v"(x))
#define MFMA32(a, b, c) __builtin_amdgcn_mfma_f32_32x32x16_bf16(a, b, c, 0, 0, 0)
#define WAIT_BAR(N) asm volatile("s_waitcnt vmcnt(" #N ") lgkmcnt(0)\n\ts_barrier" ::: "memory")
__device__ __forceinline__ void glds16s(const void* sbase, unsigned voff, unsigned lds_base) {
    unsigned sv; asm volatile("s_mov_b32 %0, m0\n\ts_mov_b32 m0, %3\n\ts_nop 0\n\tglobal_load_lds_dwordx4 %1, %2\n\ts_mov_b32 m0, %0" : "=&s"(sv) : "v"(voff), "s"(sbase), "s"(lds_base) : "memory"); }
typedef __attribute__((address_space(3))) const char* lds_cptr;
typedef short v4i16_t __attribute__((ext_vector_type(4)));
__device__ __forceinline__ void kload2(bf16x8* kf, lds_cptr kp, int d0) { kf[2 * d0] = *(const __attribute__((address_space(3))) bf16x8*)(kp + d0 * 2048); kf[2 * d0 + 1] = *(const __attribute__((address_space(3))) bf16x8*)(kp + d0 * 2048 + 512); }
__device__ __forceinline__ s16x4 vtr(lds_cptr p) { return __builtin_bit_cast(s16x4, __builtin_amdgcn_ds_read_tr16_b64_v4i16((__attribute__((address_space(3))) v4i16_t*)p)); }
#define MX3(a, b, c) __builtin_fmaxf(__builtin_fmaxf((a), (b)), (c))
__device__ __forceinline__ float rowmax(const f32x16& p0, const f32x16& p1) {
    float a = MX3(p0[0], p0[1], p1[0]), b = MX3(p0[2], p0[3], p1[1]); a = MX3(a, p1[2], p1[3]);
#pragma unroll
    for (int r = 4; r < 16; r += 4) { a = MX3(a, p0[r], p0[r + 1]); b = MX3(b, p0[r + 2], p0[r + 3]); a = MX3(a, p1[r], p1[r + 1]); b = MX3(b, p1[r + 2], p1[r + 3]); }
    float m = __builtin_fmaxf(a, b); auto rr = __builtin_amdgcn_permlane32_swap(__float_as_uint(m), __float_as_uint(m), false, false);
    return __builtin_fmaxf(__uint_as_float(rr[0]), __uint_as_float(rr[1])); }
__device__ __forceinline__ void cmask(f32x16& p0, f32x16& p1, int jb, int qrel, int hi) {
    const int kb = 64 * jb + 4 * hi;
#pragma unroll
    for (int r = 0; r < 16; ++r) { const int kv = kb + (r & 3) + 8 * (r >> 2); if (kv > qrel) p0[r] = -INFINITY; if (kv + 32 > qrel) p1[r] = -INFINITY; } }
__device__ __forceinline__ float mand(float x, unsigned w, int pos) { return __uint_as_float(__float_as_uint(x) & (unsigned)__builtin_amdgcn_sbfe((int)w, pos, 1)); }
#define BITP(i) (((i) & 3) + 8 * ((i) >> 2))

__device__ __forceinline__ void attn64_unit(int b, int h, int qb, const u16* Q, const u16* __restrict__ K, const u16* __restrict__ V, const u16* __restrict__ SG, u16* O, const u64* mrow0, char* lds) {
    const int tid = TID(), lane = tid & 63, r32 = lane & 31, hi = lane >> 5; const int wid = __builtin_amdgcn_readfirstlane(tid >> 6);
    const long rowbase = (long)b * SEQ; const int q0 = qb * A_QB, NT = (q0 + A_QB) / A_KVBLK;
    const u16* Qw = Q + (rowbase + q0 + wid * A_QBLK) * A_DM + h * A_D;
    const unsigned lds0 = (unsigned)(uintptr_t)lds; float* wsf = (float*)(lds + A_LDS_WS) + wid * 64;
    const u16* kbase = K + rowbase * A_DM + h * A_D; const u16* vbase = V + rowbase * A_DM + h * A_D;
    const unsigned koff = (unsigned)(lane * A_DM + wid * 8) * 2u;
    const unsigned voff = (unsigned)((16 * (wid & 3) + (lane >> 2)) * A_DM + (wid >> 2) * 32 + (lane & 3) * 8) * 2u;
    const unsigned kdst = lds0 + A_LDS_K + wid * 1024, vdst = lds0 + A_LDS_V + wid * 1024;
#define DMA_K(t, slot) glds16s(kbase + (long)(t) * A_KVBLK * A_DM, koff, (unsigned)__builtin_amdgcn_readfirstlane(kdst + (slot)))
#define DMA_V(t, slot) glds16s(vbase + (long)(t) * A_KVBLK * A_DM, voff, (unsigned)__builtin_amdgcn_readfirstlane(vdst + (slot)))
#define DMA_M(chunk) glds16s(mrow0 + 2 * (chunk), moff, (unsigned)__builtin_amdgcn_readfirstlane(mdst + ((chunk) & 1) * 1024))
#define MWORD(t) (*(const u64*)(lds + A_LDS_MK + wid * 2048 + (((t) >> 1) & 1) * 1024 + r32 * 16 + ((t) & 1) * 8))
    const lds_cptr vp0 = (lds_cptr)lds + A_LDS_V + ((lane >> 4) & 1) * 32 + (lane & 3) * 8 + (4 * hi + ((lane & 15) >> 2)) * 64;
    const lds_cptr kp0 = (lds_cptr)lds + A_LDS_K + hi * 1024 + r32 * 16;
    const int qrel = wid * A_QBLK + r32;
    const unsigned moff = (unsigned)(qrel * NT) * 8u;
    const unsigned mdst = lds0 + A_LDS_MK + wid * 2048;
    DMA_M(0);
    DMA_K(0, 0); DMA_V(0, 0); DMA_K(1, A_SLOTB);
    bf16x8 qr[4];
#pragma unroll
    for (int d0 = 0; d0 < 4; ++d0) qr[d0] = *reinterpret_cast<const bf16x8*>(&Qw[(long)r32 * A_DM + d0 * 16 + hi * 8]);
    float mhat = 0.f, l_reg = 0.f; f32x16 o[2]; o[0] = f32x16{}; o[1] = f32x16{};
    const f32x16 zero16 = f32x16{};
    bool resc = false;
    f32x16 pA0, pA1, pB0, pB1; bf16x8 kf[8]; s16x4 vlo[8], vhi[8]; u32x4 pw0, pw1, pw2, pw3;
    int sl_prev = 0, sl_cur = 0, sl_next = A_SLOTB;
    const int sh4 = 4 * hi;
#define ROT() do { sl_prev = sl_cur; sl_cur = sl_next; sl_next = (sl_next == 2 * A_SLOTB) ? 0 : sl_next + A_SLOTB; } while (0)
#define EX(v) __builtin_amdgcn_exp2f(__builtin_fmaf((v), A_C2, nmh))
#define RESC() do { if (resc) { _Pragma("unroll") for (int d_ = 0; d_ < 2; ++d_) _Pragma("unroll") for (int r = 0; r < 16; ++r) o[d_][r] *= wsf[crow(r, hi)]; } } while (0)
    DMA_K(2, 2 * A_SLOTB);
    WAIT_BAR(3);
    _Pragma("unroll") for (int d0 = 0; d0 < 4; ++d0) kload2(kf, kp0, d0);
    pA0 = MFMA32(kf[0], qr[0], zero16); pA1 = MFMA32(kf[1], qr[0], zero16); pA0 = MFMA32(kf[2], qr[1], pA0); pA1 = MFMA32(kf[3], qr[1], pA1);
    pA0 = MFMA32(kf[4], qr[2], pA0); pA1 = MFMA32(kf[5], qr[2], pA1); pA0 = MFMA32(kf[6], qr[3], pA0); pA1 = MFMA32(kf[7], qr[3], pA1);
    { const float rm = rowmax(pA0, pA1); mhat = rm * A_C2; const float nmh = -mhat;
      const u64 mw0 = MWORD(0); const unsigned wl = (unsigned)mw0 >> sh4, wh = (unsigned)(mw0 >> 32) >> sh4;
#pragma unroll
      for (int r = 0; r < 16; ++r) { pA0[r] = mand(EX(pA0[r]), wl, BITP(r)); pA1[r] = mand(EX(pA1[r]), wh, BITP(r)); } }
    WAIT_BAR(0);
    DMA_K(3, 0); DMA_V(1, A_SLOTB); ROT();
    _Pragma("unroll") for (int d0 = 0; d0 < 4; ++d0) kload2(kf, kp0 + sl_cur, d0);
    WAIT_BAR(2);
#define PKW(P, i) cvtpk(P[i], P[i + 1])
#define PAF(k) __builtin_bit_cast(bf16x8, pw##k)
#define VFR(i) (bf16x8){vlo[i][0], vlo[i][1], vlo[i][2], vlo[i][3], vhi[i][0], vhi[i][1], vhi[i][2], vhi[i][3]}
#define VRD(i) do { vlo[i] = vtr(vp_ + (((i) >> 2) * 4096 + ((i) & 3) * 1024)); vhi[i] = vtr(vp_ + (((i) >> 2) * 4096 + ((i) & 3) * 1024 + 512)); } while (0)
#define KRD(G, d0) do { if (G) { kload2(kf, kp0 + sl_next, d0); SBAR(); } } while (0)
#define GAPA(MF, a0, a1, a2, a3, W0, W1, PW) do { MF; sacc += a0; sacc += a1; sacc += a2; sacc += a3; W0; W1; PIN(PW); PIN(sacc); SBAR(); } while (0)
#define GAPB(MF, X, i, W) do { MF; X[i] = mand(EX(X[i]), W, BITP(i)); X[i + 1] = mand(EX(X[i + 1]), W, BITP(i + 1)); X[i + 2] = mand(EX(X[i + 2]), W, BITP(i + 2)); X[i + 3] = mand(EX(X[i + 3]), W, BITP(i + 3)); PIN(X); SBAR(); } while (0)
#define STEP(C0, C1, P0, P1, t, MASK, GK, GV, GL, ML) do { SBAR(); \
    if (ML) DMA_M(((t) + 1) >> 1); \
    const u64 mw_ = MWORD(t); \
    const lds_cptr vp_ = vp0 + sl_prev; \
    VRD(0); SBAR(); float sacc = P0[0] + P0[1]; \
                    GAPA(C0 = MFMA32(kf[0], qr[0], zero16), P0[2], P0[3], P0[4], P0[5],     pw0[0] = PKW(P0, 0),  pw0[1] = PKW(P0, 2),  pw0); \
    VRD(4); SBAR(); GAPA(C1 = MFMA32(kf[1], qr[0], zero16), P0[6], P0[7], P0[8], P0[9],     pw0[2] = PKW(P0, 4),  pw0[3] = PKW(P0, 6),  pw0); \
    VRD(1); SBAR(); GAPA(C0 = MFMA32(kf[2], qr[1], C0),    P0[10], P0[11], P0[12], P0[13], pw1[0] = PKW(P0, 8),  pw1[1] = PKW(P0, 10), pw1); \
    VRD(5); SBAR(); GAPA(C1 = MFMA32(kf[3], qr[1], C1),    P0[14], P0[15], P1[0], P1[1],   pw1[2] = PKW(P0, 12), pw1[3] = PKW(P0, 14), pw1); \
    VRD(2); SBAR(); GAPA(C0 = MFMA32(kf[4], qr[2], C0),    P1[2], P1[3], P1[4], P1[5],     pw2[0] = PKW(P1, 0),  pw2[1] = PKW(P1, 2),  pw2); \
    VRD(6); SBAR(); GAPA(C1 = MFMA32(kf[5], qr[2], C1),    P1[6], P1[7], P1[8], P1[9],     pw2[2] = PKW(P1, 4),  pw2[3] = PKW(P1, 6),  pw2); \
    VRD(3); SBAR(); GAPA(C0 = MFMA32(kf[6], qr[3], C0),    P1[10], P1[11], P1[12], P1[13], pw3[0] = PKW(P1, 8),  pw3[1] = PKW(P1, 10), pw3); \
    VRD(7); SBAR(); GAPA(C1 = MFMA32(kf[7], qr[3], C1),    P1[14], P1[15], 0.f, 0.f,       pw3[2] = PKW(P1, 12), pw3[3] = PKW(P1, 14), pw3); \
    l_reg += sacc; \
    if (GK) DMA_K((t) + 3, sl_cur); if (GV) DMA_V((t) + 1, sl_next); \
    { const float rm = __builtin_fmaf(rowmax(C0, C1), A_C2, -mhat); resc = false; \
      if (__builtin_expect(__any(rm > (float)ATTN_THR), 0)) { const float dl = __builtin_fmaxf(rm, 0.f); mhat += dl; \
          const float f = __builtin_amdgcn_exp2f(-dl); l_reg *= f; if (hi == 0) wsf[r32] = f; resc = true; } } \
    const float nmh = -mhat; const unsigned wl_ = (unsigned)(mw_) >> sh4, wh_ = (unsigned)((mw_) >> 32) >> sh4; SBAR(); \
    GAPB(o[0] = MFMA32(PAF(0), VFR(0), o[0]), C0, 0, wl_);              GAPB(o[1] = MFMA32(PAF(0), VFR(4), o[1]), C0, 4, wl_); \
    KRD(GL, 0); GAPB(o[0] = MFMA32(PAF(1), VFR(1), o[0]), C0, 8, wl_);  KRD(GL, 1); GAPB(o[1] = MFMA32(PAF(1), VFR(5), o[1]), C0, 12, wl_); \
    KRD(GL, 2); GAPB(o[0] = MFMA32(PAF(2), VFR(2), o[0]), C1, 0, wh_);  KRD(GL, 3); GAPB(o[1] = MFMA32(PAF(2), VFR(6), o[1]), C1, 4, wh_); \
    GAPB(o[0] = MFMA32(PAF(3), VFR(3), o[0]), C1, 8, wh_);              GAPB(o[1] = MFMA32(PAF(3), VFR(7), o[1]), C1, 12, wh_); \
    } while (0)
    int t = 1;
    for (; t + 5 < NT; t += 2) {
        STEP(pB0, pB1, pA0, pA1, t, false, true, true, true, true);      WAIT_BAR(2); RESC(); ROT();
        STEP(pA0, pA1, pB0, pB1, t + 1, false, true, true, true, false); WAIT_BAR(2); RESC(); ROT();
    }
#define ENDW(tt) do { if ((tt) + 3 < NT) { WAIT_BAR(2); } else if ((tt) + 2 < NT) { WAIT_BAR(1); } else { WAIT_BAR(0); } } while (0)
    for (; t + 1 < NT; t += 2) {
        STEP(pB0, pB1, pA0, pA1, t, true, (t + 3 < NT), (t + 1 < NT), (t + 1 < NT), (t + 1 < NT));         ENDW(t);     RESC(); ROT();
        STEP(pA0, pA1, pB0, pB1, t + 1, true, (t + 4 < NT), (t + 2 < NT), (t + 2 < NT), false);            ENDW(t + 1); RESC(); ROT();
    }
    STEP(pB0, pB1, pA0, pA1, NT - 1, true, false, false, false, false); RESC();
    { float sacc = pB0[0] + pB0[1];
#pragma unroll
      for (int r = 2; r < 16; ++r) sacc += pB0[r];
#pragma unroll
      for (int r = 0; r < 16; ++r) sacc += pB1[r];
      l_reg += sacc;
      pw0 = (u32x4){PKW(pB0, 0), PKW(pB0, 2), PKW(pB0, 4), PKW(pB0, 6)}; pw1 = (u32x4){PKW(pB0, 8), PKW(pB0, 10), PKW(pB0, 12), PKW(pB0, 14)};
      pw2 = (u32x4){PKW(pB1, 0), PKW(pB1, 2), PKW(pB1, 4), PKW(pB1, 6)}; pw3 = (u32x4){PKW(pB1, 8), PKW(pB1, 10), PKW(pB1, 12), PKW(pB1, 14)};
      const lds_cptr vp_ = vp0 + sl_cur; _Pragma("unroll") for (int i = 0; i < 8; ++i) VRD(i);
      o[0] = MFMA32(PAF(0), VFR(0), o[0]); o[1] = MFMA32(PAF(0), VFR(4), o[1]); o[0] = MFMA32(PAF(1), VFR(1), o[0]); o[1] = MFMA32(PAF(1), VFR(5), o[1]);
      o[0] = MFMA32(PAF(2), VFR(2), o[0]); o[1] = MFMA32(PAF(2), VFR(6), o[1]); o[0] = MFMA32(PAF(3), VFR(3), o[0]); o[1] = MFMA32(PAF(3), VFR(7), o[1]); }
    { auto rr = __builtin_amdgcn_permlane32_swap(__float_as_uint(l_reg), __float_as_uint(l_reg), false, false); l_reg = __uint_as_float(rr[0]) + __uint_as_float(rr[1]); }
    if (hi == 0) wsf[32 + r32] = l_reg; asm volatile("s_waitcnt lgkmcnt(0)" ::: "memory");
    float rli[16];
#pragma unroll
    for (int r = 0; r < 16; ++r) rli[r] = __builtin_amdgcn_rcpf(wsf[32 + crow(r, hi)]);
    u16* Ow = O + (rowbase + q0 + wid * A_QBLK) * A_DM + h * A_D; const u16* Gw = SG + (rowbase + q0 + wid * A_QBLK) * A_DM + h * A_D;
    u16* stg = (u16*)(lds + A_LDS_OST) + wid * 2048;
#pragma unroll
    for (int r = 0; r < 16; ++r) { const int orow = crow(r, hi);
#pragma unroll
        for (int d0 = 0; d0 < 2; ++d0) stg[orow * 64 + d0 * 32 + r32] = f2bf(o[d0][r] * rli[r]); }
    asm volatile("s_waitcnt lgkmcnt(0)" ::: "memory");
#pragma unroll
    for (int i = 0; i < 4; ++i) { const int row = i * 8 + (lane >> 3), ch = lane & 7;
        u32x4 ov = *(const u32x4*)(stg + row * 64 + ch * 8); u32x4 gv = *(const u32x4*)(Gw + (long)row * A_DM + ch * 8); u32x4 rv;
#pragma unroll
        for (int e = 0; e < 4; ++e) rv[e] = cvtpk(bflo(ov[e]) * bflo(gv[e]), bfhi(ov[e]) * bfhi(gv[e]));
        *(u32x4*)(Ow + (long)row * A_DM + ch * 8) = rv; }
    asm volatile("s_waitcnt vmcnt(0) lgkmcnt(0)\n\ts_barrier" ::: "memory");
#undef DMA_K
#undef DMA_V
#undef DMA_M
#undef MWORD
#undef ROT
#undef EX
#undef RESC
#undef PKW
#undef PAF
#undef VFR
#undef VRD
#undef KRD
#undef ENDW
#undef GAPA
#undef GAPB
#undef STEP
}
__device__ __forceinline__ void phase_attn(const Params& p, char* lds) {
    constexpr int NPAIR = A_NQB / 2, NUNIT = NBATCH * A_NHEAD * NPAIR;
    const int bid_ = BID(), gdim_ = GDIM();
    for (int u = bid_; u < NUNIT; u += gdim_) {
        const int x = u & 7, kk = u >> 3, bh = x + 8 * (kk / NPAIR), j = kk % NPAIR;
        const int b = bh / A_NHEAD, h = bh % A_NHEAD;
        const u64* mb = p.mask() + (size_t)b * MASK_WORDS_PER_BATCH;
        attn64_unit(b, h, j, p.q(), p.k(), p.v(), p.sg(), p.bin(), mb + mk_base(j), lds);
        attn64_unit(b, h, A_NQB - 1 - j, p.q(), p.k(), p.v(), p.sg(), p.bin(), mb + mk_base(A_NQB - 1 - j), lds);
    }
}

struct EpiStash {
    static constexpr bool DUPOK = false;
    u16* stash;
    __device__ __forceinline__ void operator()(const acc_t& acc, const pg8::Unit& u, int ui, int wr, int wc, int fr, int fq) const {
        const int tid_ = TID();
        u32x4* st = (u32x4*)(stash + (size_t)(u.pm * 4 + u.pn) * 65536);
        ROWS_LOOP {
#pragma unroll
            for (int bj = 0; bj < 2; ++bj) { const f32x4 v0 = acc[ai][bj][m][0], v1 = acc[ai][bj][m][1];
                u32x4 w; w[0] = cvtpk(v0[0], v0[1]); w[1] = cvtpk(v0[2], v0[3]); w[2] = cvtpk(v1[0], v1[1]); w[3] = cvtpk(v1[2], v1[3]);
                st[((ai * 4 + m) * 2 + bj) * 512 + tid_] = w; } }
    }
};
struct EpiGate {
    static constexpr bool DUPOK = false;
    const Params& p; int l; int br;
    __device__ __forceinline__ void operator()(const acc_t& acc, const pg8::Unit& u, int ui, int wr, int wc, int fr, int fq) const {
        const float* ssq = p.sumsq() + (size_t)(l & 1) * T * 16;
        const int tid_ = TID();
        const u32x4* st = (const u32x4*)(p.stash() + (size_t)(u.pm * 4 + u.pn) * 65536);
        const int cl = wc * 4 + fq;
        __shared__ float s_rstd[256];
        { if (tid_ < 256) s_rstd[tid_] = row_rstd(ssq, u.pm * 256 + tid_); __syncthreads(); }
        float rsa[8];
#pragma unroll
        for (int ix = 0; ix < 8; ++ix) rsa[ix] = s_rstd[(ix >> 2) * 128 + wr * 64 + (ix & 3) * 16 + fr];
        const char* stp = (const char*)st + (size_t)tid_ * 16;
        char* mpp = (char*)(p.merged() + (size_t)(u.pm * 256 + wr * 64 + fr) * 1024 + u.pn * 256 + 16 * cl);
        u32x4 yb = *(const u32x4*)stp, ob = (br > 0) ? *(const u32x4*)mpp : (u32x4){0u, 0u, 0u, 0u};
        ROWS_LOOP { const int ix = ai * 4 + m; const float rs = rsa[ix];
#pragma unroll
            for (int bj = 0; bj < 2; ++bj) { const f32x4 v0 = acc[ai][bj][m][0] * rs, v1 = acc[ai][bj][m][1] * rs;
                float r[8];
                r[0] = sigmf(v0[0]) * bflo(yb[0]); r[1] = sigmf(v0[1]) * bfhi(yb[0]); r[2] = sigmf(v0[2]) * bflo(yb[1]); r[3] = sigmf(v0[3]) * bfhi(yb[1]);
                r[4] = sigmf(v1[0]) * bflo(yb[2]); r[5] = sigmf(v1[1]) * bfhi(yb[2]); r[6] = sigmf(v1[2]) * bflo(yb[3]); r[7] = sigmf(v1[3]) * bfhi(yb[3]);
                if (br > 0) {
#pragma unroll
                    for (int e = 0; e < 4; ++e) { r[2 * e] += bflo(ob[e]); r[2 * e + 1] += bfhi(ob[e]); } }
                u32x4 wo; wo[0] = cvtpk(r[0], r[1]); wo[1] = cvtpk(r[2], r[3]); wo[2] = cvtpk(r[4], r[5]); wo[3] = cvtpk(r[6], r[7]);
                const char* stn = stp + 8192; char* mpn = (bj == 0) ? (mpp + 16) : (mpp - 16 + ((ix == 3) ? 80 : 16) * 2048);
                asm volatile("" : "+v"(stn), "+v"(mpn));
                if (!(ix == 7 && bj == 1)) { yb = *(const u32x4*)stn; if (br > 0) ob = *(const u32x4*)mpn; }
                *(u32x4*)mpp = wo;
                stp = stn; mpp = mpn; } }
    }
};
__device__ __forceinline__ void phase_merge(const Params& p, int l, char* shm) {
    pg8::RowOrder S{4, 512, GDIM(), BID()};
    for (int br = 0; br < 3; ++br) {
        const u16* Ain = br == 0 ? p.ga() : (br == 1 ? p.bin() : p.sp());
        const u16* Wy = (br == 0 ? p.wt_oa() : (br == 1 ? p.wt_ob() : p.wt_oc())) + (size_t)l * 1024 * 512;
        { pg8::Gemm g{Ain, Wy, T, 1024, 512}; EpiStash E{p.stash()}; pg8::gemm_phase((PG8_LAS unsigned char*)shm, g, S, E); }
        { pg8::Gemm g{p.xb(), p.wt_mg() + (size_t)l * 3072 * 1024 + (size_t)br * 1024 * 1024, T, 1024, 1024}; EpiGate E{p, l, br}; pg8::gemm_phase((PG8_LAS unsigned char*)shm, g, S, E); }
    }
}

struct EpiOut {
    static constexpr bool DUPOK = false;
    const Params& p; int l;
    __device__ __forceinline__ void operator()(const acc_t& acc, const pg8::Unit& u, int ui, int wr, int wc, int fr, int fq) const {
        const float* xsrc = (l == 0) ? p.x_in : p.x;
        const int cl = wc * 4 + fq;
        f32x4 xb0[2], xb1[2];
#pragma unroll
        for (int bj = 0; bj < 2; ++bj) { const size_t o = (size_t)(u.pm * 256 + wr * 64 + fr) * 1024 + u.pn * 256 + 16 * cl + bj * 8; xb0[bj] = *(const f32x4*)(xsrc + o); xb1[bj] = *(const f32x4*)(xsrc + o + 4); }
        ROWS_LOOP { const int row = ROW_OF; const int ix = ai * 4 + m; float ss = 0.f;
            f32x4 x0[2], x1[2];
#pragma unroll
            for (int bj = 0; bj < 2; ++bj) { x0[bj] = xb0[bj] + acc[ai][bj][m][0]; x1[bj] = xb1[bj] + acc[ai][bj][m][1]; }
            if (ix < 7) { const int rown = u.pm * 256 + ((ix + 1) >> 2) * 128 + wr * 64 + ((ix + 1) & 3) * 16 + fr;
#pragma unroll
                for (int bj = 0; bj < 2; ++bj) { const size_t o = (size_t)rown * 1024 + u.pn * 256 + 16 * cl + bj * 8; xb0[bj] = *(const f32x4*)(xsrc + o); xb1[bj] = *(const f32x4*)(xsrc + o + 4); } }
#pragma unroll
            for (int bj = 0; bj < 2; ++bj) { const size_t o = (size_t)row * 1024 + u.pn * 256 + 16 * cl + bj * 8;
                *(f32x4*)(p.x + o) = x0[bj]; *(f32x4*)(p.x + o + 4) = x1[bj];
                if (l < NL - 1) { u32x4 w; w[0] = cvtpk(x0[bj][0], x0[bj][1]); w[1] = cvtpk(x0[bj][2], x0[bj][3]); w[2] = cvtpk(x1[bj][0], x1[bj][1]); w[3] = cvtpk(x1[bj][2], x1[bj][3]); *(u32x4*)(p.xb() + o) = w;
#pragma unroll
                    for (int j = 0; j < 4; ++j) ss += x0[bj][j] * x0[bj][j] + x1[bj][j] * x1[bj][j]; } }
            if (l < NL - 1) { ss += __shfl_xor(ss, 16); ss += __shfl_xor(ss, 32); if (fq == 0) p.sumsq()[(size_t)((l + 1) & 1) * T * 16 + (size_t)row * 16 + u.pn * 4 + wc] = ss; } }
    }
};
__device__ __forceinline__ void phase_out(const Params& p, int l, char* shm) {
    pg8::RowOrder S{4, 512, GDIM(), BID()};
    pg8::Gemm g{p.merged(), p.wt_o() + (size_t)l * 1024 * 1024, T, 1024, 1024};
    EpiOut E{p, l};
    pg8::gemm_phase((PG8_LAS unsigned char*)shm, g, S, E);
}

enum { PH_PREP0 = 0, PH_IN, PH_MIX, PH_IDX, PH_SEL, PH_ATTN, PH_MERGE, PH_OUT };
template <int PH> __global__ __launch_bounds__(NTHR) void k_phase(Params p, int l, int b) {
    extern __shared__ __attribute__((aligned(16))) char shm[];
    if (PH == PH_PREP0) phase_prep0(p, shm);
    if (PH == PH_IN) phase_in(p, l, shm);
    if (PH == PH_MIX) phase_mix(p, l);
    if (PH == PH_IDX) phase_indexer(p, b, p.scores());
    if (PH == PH_SEL) phase_select(p, b, shm, p.scores());
    if (PH == PH_ATTN) phase_attn(p, shm);
    if (PH == PH_MERGE) phase_merge(p, l, shm);
    if (PH == PH_OUT) phase_out(p, l, shm);
}

#define XB_TMO      128
#define XB_XCNT(j)  (256  + 64 * (j))
#define XB_XSUB(j)  (1280 + 64 * (j))
#define XB_XGEN(j)  (2304 + 64 * (j))
#define XB_TOP      3328
#define XB_TOPGEN   3392
#define XCD_BAR_WORDS 3456
#define XB_SPIN_CAP (1u << 22)
#define LAS __attribute__((address_space(3)))
__device__ __forceinline__ unsigned xb_ld(unsigned* p)              { return __hip_atomic_load(p, __ATOMIC_RELAXED, __HIP_MEMORY_SCOPE_AGENT); }
__device__ __forceinline__ unsigned xb_add(unsigned* p, unsigned v) { return __hip_atomic_fetch_add(p, v, __ATOMIC_RELAXED, __HIP_MEMORY_SCOPE_AGENT); }
__device__ __forceinline__ unsigned xb_xcc_id() { return (unsigned)__builtin_amdgcn_s_getreg((3 << 11) | 20) & 0xFu; }
#define XB_SPIN(cond, bar) do { unsigned _sp = 0; while (cond) { __builtin_amdgcn_s_sleep(1); \
    if ((++_sp & 255u) == 0u) { if (xb_ld(&(bar)[XB_TMO])) break; if (_sp > XB_SPIN_CAP) { atomicAdd(&(bar)[XB_TMO], 1u); break; } } } } while (0)
struct XcdBarrier { unsigned* bar; unsigned x; volatile LAS unsigned* st; };
__device__ __forceinline__ XcdBarrier xcd_barrier_post(unsigned* bar, volatile LAS unsigned* st) {
    XcdBarrier b; b.bar = bar; b.x = xb_xcc_id(); b.st = st;
    if (threadIdx.x == 0) (void)xb_add(&bar[XB_XCNT(b.x)], 1u);
    return b;
}
__device__ __forceinline__ void xcd_barrier_complete(unsigned* bar, unsigned x, unsigned& nloc, unsigned& nx) {
    const unsigned G = gridDim.x * gridDim.y * gridDim.z;
    unsigned sum, cnt, mine, sp = 0u;
    for (;;) {
        sum = 0u; cnt = 0u; mine = 0u;
#pragma unroll
        for (unsigned j = 0; j < 16; ++j) { const unsigned c = xb_ld(&bar[XB_XCNT(j)]); sum += c; cnt += (c > 0u) ? 1u : 0u; mine = (j == x) ? c : mine; }
        if (sum == G) break;
        __builtin_amdgcn_s_sleep(1);
        if ((++sp & 255u) == 0u) { if (xb_ld(&bar[XB_TMO])) break; if (sp > XB_SPIN_CAP) { atomicAdd(&bar[XB_TMO], 1u); break; } }
    }
    nloc = mine > 0u ? mine : 1u; nx = cnt > 0u ? cnt : 1u;
}
__device__ __forceinline__ void xcd_barrier(const XcdBarrier& b) {
    asm volatile("s_waitcnt vmcnt(0)" ::: "memory");
    __syncthreads();
    if (threadIdx.x == 0) {
        unsigned* bar = b.bar;
        __builtin_amdgcn_s_waitcnt(0);
        unsigned nloc = b.st[0], nx = b.st[1];
        if (nloc == 0u) { xcd_barrier_complete(bar, b.x, nloc, nx); b.st[0] = nloc; b.st[1] = nx; }
        const unsigned old = xb_add(&bar[XB_XSUB(b.x)], 1u);
        const unsigned gen = old / nloc;
        if (old + 1u == (gen + 1u) * nloc) {
            __builtin_amdgcn_fence(__ATOMIC_RELEASE, "agent");
            asm volatile("s_waitcnt vmcnt(0)" ::: "memory");
            const unsigned og = xb_add(&bar[XB_TOP], 1u);
            const unsigned tg = og / nx;
            if (og + 1u == (tg + 1u) * nx) xb_add(&bar[XB_TOPGEN], 1u);
            else XB_SPIN(xb_ld(&bar[XB_TOPGEN]) == tg, bar);
            __builtin_amdgcn_fence(__ATOMIC_ACQUIRE, "agent");
            xb_add(&bar[XB_XGEN(b.x)], 1u);
            asm volatile("s_waitcnt vmcnt(0)" ::: "memory");
        } else {
            XB_SPIN(xb_ld(&bar[XB_XGEN(b.x)]) == gen, bar);
            __builtin_amdgcn_fence(__ATOMIC_ACQUIRE, "agent");
            asm volatile("s_waitcnt vmcnt(0)" ::: "memory");
        }
    }
    __syncthreads();
}

#if MEGA
typedef const __attribute__((address_space(4))) Params* kparams_t;
__device__ __forceinline__ Params load_params(kparams_t k) {
    Params q; q.x_in = k->x_in; q.norm_g = k->norm_g; q.w_in = k->w_in; q.conv_w = k->conv_w; q.w_out_conv = k->w_out_conv; q.q_g = k->q_g; q.k_g = k->k_g; q.w_out_attn = k->w_out_attn;
    q.pool_w = k->pool_w; q.pool_scale = k->pool_scale; q.w_out_pool = k->w_out_pool; q.w_o = k->w_o; q.x = k->x; q.ws = k->ws; return q; }
#define PHP(q) kparams_t kq_##q = kp; asm volatile("" : "+s"(kq_##q)); const Params q = load_params(kq_##q);
__global__ __launch_bounds__(NTHR) void k_mega(Params p_unused) {
    extern __shared__ __attribute__((aligned(16))) char shm[];
    cg::grid_group grid = cg::this_grid();
    kparams_t kp = (kparams_t)__builtin_amdgcn_kernarg_segment_ptr();
    __shared__ uint4 xb_words;
    if (threadIdx.x == 0) xb_words = make_uint4(0u, 0u, 0u, 0u);
    __syncthreads();
    const XcdBarrier xb = xcd_barrier_post((unsigned*)(kp->ws + WS_BAR), (volatile LAS unsigned*)&xb_words);

#ifndef SK_PREP
        { PHP(p) phase_prep0(p, shm); }
#endif
#ifdef DUP_PREP
        { PHP(p) phase_prep0(p, shm); }
#endif

    grid.sync();
    for (int l = 0; l < NL; ++l) {

#ifndef SK_IN
        { PHP(p) phase_in(p, l, shm); }
#endif
#ifdef DUP_IN
        { PHP(p) phase_in(p, l, shm); }
#endif

        xcd_barrier(xb);

        { PHP(p) phase_mix(p, l); phase_indexer(p, 0, p.scores()); }
        xcd_barrier(xb);
        { PHP(p) phase_indexer(p, 1, p.scores2()); phase_select(p, 0, shm, p.scores()); }
        xcd_barrier(xb);
        { PHP(p) phase_indexer(p, 2, p.scores()); phase_select(p, 1, shm, p.scores2()); }
        xcd_barrier(xb);
        { PHP(p) phase_indexer(p, 3, p.scores2()); phase_select(p, 2, shm, p.scores()); }
        xcd_barrier(xb);
        { PHP(p) phase_select(p, 3, shm, p.scores2()); }
        xcd_barrier(xb);
#ifndef SK_ATTN
        { PHP(p) phase_attn(p, shm); }
#endif
#ifdef DUP_ATTN
        { PHP(p) phase_attn(p, shm); }
#endif

        xcd_barrier(xb);

#ifndef SK_MERGE
        { PHP(p) phase_merge(p, l, shm); }
#endif
#ifdef DUP_MERGE
        { PHP(p) phase_merge(p, l, shm); }
#endif

        xcd_barrier(xb);

#ifndef SK_OUT
        { PHP(p) phase_out(p, l, shm); }
#endif

        xcd_barrier(xb);
    }
}
#endif

static Params make_params(void* const* d_in, void* d_out, void* d_ws) {
    Params p{};
    p.x_in = (const float*)d_in[0]; p.norm_g = (const float*)d_in[1]; p.w_in = (const float*)d_in[2]; p.conv_w = (const float*)d_in[3];
    p.w_out_conv = (const float*)d_in[4]; p.q_g = (const float*)d_in[5]; p.k_g = (const float*)d_in[6]; p.w_out_attn = (const float*)d_in[7];
    p.pool_w = (const float*)d_in[8]; p.pool_scale = (const float*)d_in[9]; p.w_out_pool = (const float*)d_in[10]; p.w_o = (const float*)d_in[11];
    p.x = (float*)d_out; p.ws = (char*)d_ws;
    return p;
}

extern "C" void kernel_launch(void* const* d_in, const int* in_sizes, int n_in, void* d_out, int out_size, void* d_ws, size_t ws_size, hipStream_t stream) {
    if (ws_size < WS_NEEDED) { fprintf(stderr, "workspace too small: %zu < %zu\n", ws_size, (size_t)WS_NEEDED); return; }
    Params p = make_params(d_in, d_out, d_ws);
    static int grid = 0;
    if (!grid) { int dev = 0, cus = 0; hipGetDevice(&dev); hipDeviceGetAttribute(&cus, hipDeviceAttributeMultiprocessorCount, dev); if (cus <= 0 || cus > 256) cus = 256; grid = (cus / 8) * 8; }
#if MEGA
    static bool attr = false;
    if (!attr) { hipFuncSetAttribute((const void*)k_mega, hipFuncAttributeMaxDynamicSharedMemorySize, LDS_BYTES); attr = true; }
    hipMemsetAsync((char*)d_ws + WS_BAR, 0, 16384, stream);
    void* args[] = {&p};
    hipError_t e = hipLaunchCooperativeKernel((void*)k_mega, dim3(grid), dim3(NTHR), args, LDS_BYTES, stream);
    if (e != hipSuccess) fprintf(stderr, "cooperative launch failed: %s\n", hipGetErrorString(e));
#else
    static bool attr = false;
    if (!attr) {
        hipFuncSetAttribute((const void*)k_phase<PH_PREP0>, hipFuncAttributeMaxDynamicSharedMemorySize, LDS_BYTES);
        hipFuncSetAttribute((const void*)k_phase<PH_IN>, hipFuncAttributeMaxDynamicSharedMemorySize, LDS_BYTES);
        hipFuncSetAttribute((const void*)k_phase<PH_MIX>, hipFuncAttributeMaxDynamicSharedMemorySize, LDS_BYTES);
        hipFuncSetAttribute((const void*)k_phase<PH_IDX>, hipFuncAttributeMaxDynamicSharedMemorySize, LDS_BYTES);
        hipFuncSetAttribute((const void*)k_phase<PH_SEL>, hipFuncAttributeMaxDynamicSharedMemorySize, LDS_BYTES);
        hipFuncSetAttribute((const void*)k_phase<PH_ATTN>, hipFuncAttributeMaxDynamicSharedMemorySize, LDS_BYTES);
        hipFuncSetAttribute((const void*)k_phase<PH_MERGE>, hipFuncAttributeMaxDynamicSharedMemorySize, LDS_BYTES);
        hipFuncSetAttribute((const void*)k_phase<PH_OUT>, hipFuncAttributeMaxDynamicSharedMemorySize, LDS_BYTES);
        attr = true;
    }
#define LAUNCH(PH, l, b) hipLaunchKernelGGL(k_phase<PH>, dim3(grid), dim3(NTHR), LDS_BYTES, stream, p, l, b)
    LAUNCH(PH_PREP0, 0, 0);
    for (int l = 0; l < NL; ++l) {
        LAUNCH(PH_IN, l, 0);
        LAUNCH(PH_MIX, l, 0);
        for (int b = 0; b < NBATCH; ++b) { LAUNCH(PH_IDX, l, b); LAUNCH(PH_SEL, l, b); }
        LAUNCH(PH_ATTN, l, 0);
        LAUNCH(PH_MERGE, l, 0);
        LAUNCH(PH_OUT, l, 0);
    }
#endif
}
```

```cpp
#include <hip/hip_runtime.h>
#include <hip/hip_cooperative_groups.h>
#include <stdint.h>
#include <stdio.h>
namespace cg = cooperative_groups;

typedef unsigned short u16;
typedef unsigned long long u64;
typedef __attribute__((ext_vector_type(8))) short bf16x8;
typedef __attribute__((ext_vector_type(4))) short s16x4;
typedef __attribute__((ext_vector_type(4))) float f32x4;
typedef __attribute__((ext_vector_type(16))) float f32x16;
typedef __attribute__((ext_vector_type(4))) unsigned u32x4;
typedef __attribute__((ext_vector_type(2))) unsigned u32x2;

#ifndef MEGA
#define MEGA 1
#endif
__device__ __forceinline__ int TID() { int t = threadIdx.x; asm volatile("" : "+v"(t)); return t; }
__device__ __forceinline__ int BID() { int t = blockIdx.x; asm volatile("" : "+s"(t)); return t; }
__device__ __forceinline__ int GDIM() { int t = gridDim.x; asm volatile("" : "+s"(t)); return t; }

constexpr int SEQ = 8192, NBATCH = 4, T = NBATCH * SEQ, DMODEL = 1024, NL = 4, INW = 8776;
constexpr int NPA = 5888;
constexpr int NTHR = 512;
constexpr int LDS_BYTES = 131072;
constexpr float RMS_EPS = 1e-6f;

struct Params {
    const float *x_in, *norm_g, *w_in, *conv_w, *w_out_conv, *q_g, *k_g, *w_out_attn, *pool_w, *pool_scale, *w_out_pool, *w_o;
    float* x; char* ws;
    __device__ __forceinline__ u16* xb() const { return (u16*)(ws + 0ull); }
    __device__ __forceinline__ u16* ga() const { return (u16*)(ws + 67108864ull); }
    __device__ __forceinline__ u16* q() const { return (u16*)(ws + 100663296ull); }
    __device__ __forceinline__ u16* k() const { return (u16*)(ws + 134217728ull); }
    __device__ __forceinline__ u16* v() const { return (u16*)(ws + 167772160ull); }
    __device__ __forceinline__ u16* sg() const { return (u16*)(ws + 201326592ull); }
    __device__ __forceinline__ u16* iq() const { return (u16*)(ws + 234881024ull); }
    __device__ __forceinline__ u16* sp() const { return (u16*)(ws + 268435456ull); }
    __device__ __forceinline__ u16* z() const { return (u16*)(ws + 301989888ull); }
    __device__ __forceinline__ u16* u() const { return (u16*)(ws + 335544320ull); }
    __device__ __forceinline__ u16* zuspare() const { return (u16*)(ws + 369098752ull); }
    __device__ __forceinline__ u16* ik() const { return (u16*)(ws + 371195904ull); }
    __device__ __forceinline__ float* iw() const { return (float*)(ws + 375390208ull); }
    __device__ __forceinline__ u16* wt_in() const { return (u16*)(ws + 376438784ull); }
    __device__ __forceinline__ u16* wt_mg() const { return (u16*)(ws + 424673280ull); }
    __device__ __forceinline__ u16* wt_oa() const { return (u16*)(ws + 449839104ull); }
    __device__ __forceinline__ u16* wt_ob() const { return (u16*)(ws + 454033408ull); }
    __device__ __forceinline__ u16* wt_oc() const { return (u16*)(ws + 458227712ull); }
    __device__ __forceinline__ u16* wt_o() const { return (u16*)(ws + 462422016ull); }
    __device__ __forceinline__ float* ropec() const { return (float*)(ws + 470810624ull); }
    __device__ __forceinline__ float* ropes() const { return (float*)(ws + 471859200ull); }
    __device__ __forceinline__ float* sumsq() const { return (float*)(ws + 472907776ull); }
    __device__ __forceinline__ u64* mask() const { return (u64*)(ws + 477102080ull); }
    __device__ __forceinline__ u16* scores() const { return (u16*)(ws + 494403584ull); }
    __device__ __forceinline__ u16* scores2() const { return z(); }
    __device__ __forceinline__ u16* stash() const { return scores(); }
    __device__ __forceinline__ u16* merged() const { return q(); }
    __device__ __forceinline__ u16* bin() const { return iq(); }
};
constexpr size_t WS_BAR = 563609600ull;
constexpr size_t WS_NEEDED = WS_BAR + 16384;


__device__ __forceinline__ unsigned cvtpk(float lo, float hi) { unsigned r; asm("v_cvt_pk_bf16_f32 %0, %1, %2" : "=v"(r) : "v"(lo), "v"(hi)); return r; }
__device__ __forceinline__ u16 f2bf(float f) { return (u16)(cvtpk(f, 0.f) & 0xffffu); }
__device__ __forceinline__ float bf2f(u16 b) { return __uint_as_float(((unsigned)b) << 16); }
__device__ __forceinline__ float bflo(unsigned w) { return __uint_as_float(w << 16); }
__device__ __forceinline__ float bfhi(unsigned w) { return __uint_as_float(w & 0xffff0000u); }
__device__ __forceinline__ float siluf(float x) { return x * __builtin_amdgcn_rcpf(1.f + __builtin_amdgcn_exp2f(x * -1.4426950408889634f)); }
__device__ __forceinline__ float sigmf(float x) { return __builtin_amdgcn_rcpf(1.f + __builtin_amdgcn_exp2f(x * -1.4426950408889634f)); }

__device__ __forceinline__ float row_rstd(const float* ssp, int row) {
    const f32x4* q = (const f32x4*)(ssp + (size_t)row * 16);
    const f32x4 a = q[0], b = q[1], c = q[2], d = q[3];
    const float s = ((a[0] + a[1]) + (a[2] + a[3])) + ((b[0] + b[1]) + (b[2] + b[3])) + ((c[0] + c[1]) + (c[2] + c[3])) + ((d[0] + d[1]) + (d[2] + d[3]));
    return __builtin_amdgcn_rsqf(s * (1.f / 1024.f) + RMS_EPS);
}
__device__ __forceinline__ int lc_of_tc(int tc) { int bj = tc >> 7, wc = (tc >> 5) & 3, n = (tc >> 4) & 1, fq = (tc >> 2) & 3, j = tc & 3; return ((wc * 4 + fq) << 4) + bj * 8 + n * 4 + j; }
__device__ __forceinline__ int tc_of_lc(int lc) { int cl = lc >> 4, s = lc & 15, wc = cl >> 2, fq = cl & 3, bj = s >> 3, n = (s >> 2) & 1, j = s & 3; return bj * 128 + wc * 32 + n * 16 + fq * 4 + j; }

__device__ __forceinline__ int src_col_in(int np) {
    int pn = np >> 8, tc = np & 255;
    int bj = tc >> 7, wc = (tc >> 5) & 3, n = (tc >> 4) & 1, fq = (tc >> 2) & 3, j = tc & 3, cl = wc * 4 + fq, s = bj * 8 + n * 4 + j, lc = cl * 16 + s;
    int d = (s < 8) ? (8 * fq + s) : (8 * fq + 32 + (s - 8));
    if (pn < 8) return (s & 3) * 512 + pn * 64 + cl * 4 + (s >> 2);
    if (pn < 12) { int which = (pn - 8) >> 1, head = ((pn - 8) & 1) * 4 + wc; return 2048 + which * 512 + head * 64 + d; }
    if (pn < 14) return 3072 + (pn - 12) * 256 + lc;
    if (pn < 16) return 3584 + (pn - 14) * 256 + lc;
    if (pn < 18) { int head = (pn - 16) * 4 + wc; return 4096 + head * 64 + d; }
    if (pn == 18) { if (wc == 0) return 4608 + d; if (wc == 1 && fq == 0 && s < 8) return 4672 + s; return -1; }
    if (pn < 21) return -2;
    return 5192 + (pn - 21) * 256 + lc;
}

__device__ __forceinline__ void prep_x(const Params& p) {
    const int tid_ = TID(); const int lane = tid_ & 63, gw = BID() * (NTHR / 64) + (tid_ >> 6), nw = GDIM() * (NTHR / 64);
    for (int row0 = gw * 4; row0 < T; row0 += nw * 4) {
        float4 v[4][4];
#pragma unroll
        for (int r = 0; r < 4; ++r)
#pragma unroll
            for (int i = 0; i < 4; ++i) v[r][i] = ((const float4*)(p.x_in + (size_t)(row0 + r) * DMODEL))[i * 64 + lane];
        float ss[4];
#pragma unroll
        for (int r = 0; r < 4; ++r) { ss[r] = 0.f;
#pragma unroll
            for (int i = 0; i < 4; ++i) { const float4 q = v[r][i]; ss[r] += q.x * q.x + q.y * q.y + q.z * q.z + q.w * q.w;
                u32x2 o; o[0] = cvtpk(q.x, q.y); o[1] = cvtpk(q.z, q.w);
                *(u32x2*)(p.xb() + (size_t)(row0 + r) * DMODEL + (i * 64 + lane) * 4) = o; } }
#pragma unroll
        for (int m = 32; m >= 1; m >>= 1) {
#pragma unroll
            for (int r = 0; r < 4; ++r) ss[r] += __shfl_xor(ss[r], m); }
        if (lane < 16) {
#pragma unroll
            for (int r = 0; r < 4; ++r) p.sumsq()[(size_t)(row0 + r) * 16 + lane] = (lane == 0) ? ss[r] : 0.f; }
    }
}
__device__ __forceinline__ void prep_rope(const Params& p) {
    const int i0 = BID() * NTHR + TID(), istep = GDIM() * NTHR;
    for (int i = i0; i < SEQ * 32; i += istep) {
        int pos = i >> 5, j = i & 31;
        float inv = 1.0f / powf(10000.0f, (float)(2 * j) / 64.0f);
        float ang = (float)pos * inv;
        p.ropec()[i] = cosf(ang); p.ropes()[i] = sinf(ang);
    }
}
__device__ __forceinline__ void prep_wt(const float* src, int lds_, const float* scale, u16* dst, int K, int NP, int mode, float* tile) {
    const int tid_ = TID(); const int tx = tid_ & 63, ty = tid_ >> 6; const int bid_ = BID(), gdim_ = GDIM();
    const int ntn = NP / 64, ntk = K / 64;
    for (int t = bid_; t < ntn * ntk; t += gdim_) {
        const int n0 = (t / ntk) * 64, k0 = (t % ntk) * 64;
        int np = n0 + tx, col;
        if (mode == 0) col = src_col_in(np);
        else if (mode == 1) col = 5704 + (np & ~255) + lc_of_tc(np & 255);
        else col = (np & ~255) + lc_of_tc(np & 255);
        __syncthreads();
#pragma unroll
        for (int i = 0; i < 8; ++i) { int kk = ty + 8 * i; tile[kk * 65 + tx] = (col >= 0) ? src[(size_t)(k0 + kk) * lds_ + col] : 0.f; }
        __syncthreads();
        const float sc = scale ? scale[k0 + tx] : 1.f;
#pragma unroll
        for (int i = 0; i < 8; ++i) {
            int nn = ty + 8 * i; int npo = n0 + nn;
            bool skip = (mode == 0) && ((npo >> 8) == 19 || (npo >> 8) == 20);
            if (!skip) dst[(size_t)npo * K + k0 + tx] = f2bf(tile[tx * 65 + nn] * sc);
        }
    }
}
__device__ __forceinline__ void prep_fold(const float* win, const float* ng, const float* pw, u16* wt_in) {
    const int i0 = BID() * NTHR + TID(), istep = GDIM() * NTHR;
    for (int i = i0; i < 1024 * 512; i += istep) {
        int k = i >> 9, n = i & 511, g = n >> 7, d = n & 127;
        const float* wr = win + (size_t)k * INW + 4680 + g * 128;
        const float* pp = pw + (size_t)g * 128 * 128 + d;
        float acc = 0.f;
        for (int c = 0; c < 128; ++c) acc += wr[c] * pp[c * 128];
        int row = (19 + (n >> 8)) * 256 + tc_of_lc(n & 255);
        wt_in[(size_t)row * 1024 + k] = f2bf(acc * ng[k]);
    }
}
__device__ __forceinline__ void phase_prep0(const Params& p, char* shm) {
    prep_x(p); prep_rope(p);
    float* tile = (float*)shm;
    for (int l = 0; l < NL; ++l) {
        const float* ng = p.norm_g + l * 1024;
        const float* win = p.w_in + (size_t)l * 1024 * INW;
        prep_wt(win, INW, ng, p.wt_in() + (size_t)l * NPA * 1024, 1024, NPA, 0, tile);
        prep_wt(win, INW, ng, p.wt_mg() + (size_t)l * 3072 * 1024, 1024, 3072, 1, tile);
        prep_wt(p.w_out_conv + (size_t)l * 512 * 1024, 1024, nullptr, p.wt_oa() + (size_t)l * 1024 * 512, 512, 1024, 2, tile);
        prep_wt(p.w_out_attn + (size_t)l * 512 * 1024, 1024, nullptr, p.wt_ob() + (size_t)l * 1024 * 512, 512, 1024, 2, tile);
        prep_wt(p.w_out_pool + (size_t)l * 512 * 1024, 1024, nullptr, p.wt_oc() + (size_t)l * 1024 * 512, 512, 1024, 2, tile);
        prep_wt(p.w_o + (size_t)l * 1024 * 1024, 1024, nullptr, p.wt_o() + (size_t)l * 1024 * 1024, 1024, 1024, 3, tile);
        prep_fold(win, ng, p.pool_w + (size_t)l * 4 * 128 * 128, p.wt_in() + (size_t)l * NPA * 1024);
    }
}

namespace pg8 {
#define PG8_LAS __attribute__((address_space(3)))
typedef unsigned short bf16_t;
constexpr int BM = 256, BK = 64, HALF = 128, HTB = HALF * BK * 2, STAGE_BYTES = 8 * HTB;
__device__ __forceinline__ int lds_byte(int r, int c) { const int st = (r >> 4) * 2 + (c >> 5), rr = r & 15, cc = c & 31, ob = rr * 64 + cc * 2; return st * 1024 + (ob ^ (((ob >> 9) & 1) << 5)); }
__device__ __forceinline__ void stage_rc(int b, int& R, int& C) { const int st = b / 1024, sb = b % 1024, swz = sb ^ (((sb >> 9) & 1) << 5); R = (st >> 1) * 16 + swz / 64; C = (st & 1) * 32 + (swz % 64) / 2; }
struct Unit { int pm, pn; };
struct Gemm { const bf16_t* A; const bf16_t* Bt; int M, N, K; };
constexpr int NXCD = 8, WGM = 8;
struct StaticOrder {
    int nM, nN, nwg, G, c;
    __device__ void init(int M, int N, int G_, int c_) { nM = M / BM; nN = N / BM; nwg = nM * nN; G = G_; c = c_; }
    __device__ bool next(int i, Unit& u) const {
        const long L = (long)i * G + c; if (L >= nwg) return false;
        int wgid = (int)L; { const int q = nwg / NXCD, r = nwg % NXCD, xcd = wgid % NXCD, off = wgid / NXCD; wgid = (xcd < r ? xcd * (q + 1) : r * (q + 1) + (xcd - r) * q) + off; }
        const int nig = WGM * nN, gid = wgid / nig, fm = gid * WGM, gsz = (nM - fm) < WGM ? (nM - fm) : WGM;
        u.pm = fm + ((wgid % nig) % gsz); u.pn = (wgid % nig) / gsz; return true;
    }
};
struct RowOrder {
    int nN, ntile, G, c;
    __device__ bool next(int i, Unit& u) const {
        const int x = c & 7, lt = (c >> 3) + (G >> 3) * i;
        const int quad = lt >> 2, pm = quad * 8 + x;
        if (pm * 4 >= ntile) return false;
        u.pm = pm; u.pn = lt & 3; return true; }
};
template <class Epi, class Sched>
__device__ __forceinline__ void gemm_phase(PG8_LAS unsigned char* lds, const Gemm g, const Sched& S, const Epi& E) {
    const int tid = TID(), wid = __builtin_amdgcn_readfirstlane(tid >> 6), lane = tid & 63, wr = wid >> 2, wc = wid & 3, fr = lane & 15, fq = lane >> 4;
    const int K = g.K, nt = K / BK;
    unsigned voffA[2], voffB[2];
#pragma unroll
    for (int i = 0; i < 2; ++i) { int R, C; stage_rc(tid * 16 + i * 8192, R, C); voffA[i] = (unsigned)(R * K + C) * 2u; voffB[i] = voffA[i]; }
    const size_t kstep = (size_t)(BK * 2);
    const size_t hstep = (size_t)HALF * K * 2;
    const size_t tstep = 2 * hstep;
    const unsigned ldsw = (unsigned)wid * 1024u;
    const int aoff = lds_byte(wr * 64 + fr, fq * 8), boff = lds_byte(wc * 32 + fr, fq * 8);
#define PG8_SA(b, h) (((b) * 2 + (h)) * HTB)
#define PG8_SB(b, h) ((4 + (b) * 2 + (h)) * HTB)
#define PG8_STAGE(bufoff, gbase, voff) do { _Pragma("unroll") for (int _i = 0; _i < 2; ++_i) \
        __builtin_amdgcn_global_load_lds((const unsigned*)((const char*)(gbase) + (voff)[_i]), (PG8_LAS unsigned*)(lds + (bufoff) + ldsw + _i * 8192), 16, 0, 0); } while (0)
#define PG8_LDA(dst, b, h) do { _Pragma("unroll") for (int m = 0; m < 4; ++m) _Pragma("unroll") for (int k = 0; k < 2; ++k) dst[m][k] = *(const PG8_LAS bf16x8*)(lds + PG8_SA(b, h) + aoff + m * 2048 + k * 1024); } while (0)
#define PG8_LDB(dst, b, h) do { _Pragma("unroll") for (int n = 0; n < 2; ++n) _Pragma("unroll") for (int k = 0; k < 2; ++k) dst[n][k] = *(const PG8_LAS bf16x8*)(lds + PG8_SB(b, h) + boff + n * 2048 + k * 1024); } while (0)
#define PG8_MMA(ai, bj, At, Bt) do { __builtin_amdgcn_s_setprio(1); _Pragma("unroll") for (int m = 0; m < 4; ++m) _Pragma("unroll") for (int n = 0; n < 2; ++n) _Pragma("unroll") for (int k = 0; k < 2; ++k) \
        acc[ai][bj][m][n] = __builtin_amdgcn_mfma_f32_16x16x32_bf16(Bt[n][k], At[m][k], acc[ai][bj][m][n], 0, 0, 0); __builtin_amdgcn_s_setprio(0); } while (0)
#define PG8_WAIT_V(n) asm volatile("s_waitcnt vmcnt(" #n ")" ::: "memory")
#define PG8_WAIT_L(n) asm volatile("s_waitcnt lgkmcnt(" #n ")" ::: "memory")
#define PG8_BAR __builtin_amdgcn_s_barrier()
#define PG8_SCHED __builtin_amdgcn_sched_barrier(0)
    Unit cur, nxt; int ui = 0;
    if (!S.next(0, cur)) return;
    f32x4 acc[2][2][4][2];
#pragma unroll
    for (int a = 0; a < 2; ++a)
#pragma unroll
        for (int b = 0; b < 2; ++b)
#pragma unroll
            for (int m = 0; m < 4; ++m)
#pragma unroll
                for (int n = 0; n < 2; ++n) acc[a][b][m][n] = (f32x4){0.f, 0.f, 0.f, 0.f};
    bf16x8 At[4][2], B0[2][2], B1[2][2];
    const char* cA = (const char*)g.A + (size_t)cur.pm * tstep; const char* cB = (const char*)g.Bt + (size_t)cur.pn * tstep;
    PG8_STAGE(PG8_SB(0, 0), cB, voffB); PG8_STAGE(PG8_SA(0, 0), cA, voffA); PG8_STAGE(PG8_SB(0, 1), cB + hstep, voffB); PG8_STAGE(PG8_SA(0, 1), cA + hstep, voffA);
    if (wr == 1) PG8_BAR;
    PG8_WAIT_V(4); PG8_BAR;
    PG8_STAGE(PG8_SB(1, 0), cB + kstep, voffB); PG8_STAGE(PG8_SA(1, 0), cA + kstep, voffA); PG8_STAGE(PG8_SB(1, 1), cB + hstep + kstep, voffB);
    PG8_WAIT_V(6); PG8_BAR;
    for (;;) {
        const bool has_next = S.next(ui + 1, nxt);
        const char* nA = has_next ? (const char*)g.A + (size_t)nxt.pm * tstep : cA; const char* nB = has_next ? (const char*)g.Bt + (size_t)nxt.pn * tstep : cB;
        for (int t = 0; t < nt; t += 2) {
            const bool last = (t == nt - 2);
            const char* a1 = cA + (size_t)(t + 1) * kstep;
            const char* a2 = last ? nA : cA + (size_t)(t + 2) * kstep; const char* b2 = last ? nB : cB + (size_t)(t + 2) * kstep;
            const char* a3 = a2 + kstep; const char* b3 = b2 + kstep;
            PG8_LDB(B0, 0, 0); PG8_SCHED; PG8_LDA(At, 0, 0); PG8_STAGE(PG8_SA(1, 1), a1 + hstep, voffA);
            PG8_WAIT_L(8); PG8_BAR; PG8_WAIT_L(0); PG8_MMA(0, 0, At, B0); PG8_BAR; PG8_SCHED;
            PG8_LDB(B1, 0, 1); PG8_STAGE(PG8_SB(0, 0), b2, voffB);
            PG8_BAR; PG8_WAIT_L(0); PG8_MMA(0, 1, At, B1); PG8_BAR;
            PG8_LDA(At, 0, 1); PG8_STAGE(PG8_SA(0, 0), a2, voffA);
            PG8_BAR; PG8_WAIT_L(0); PG8_MMA(1, 0, At, B0); PG8_BAR; PG8_SCHED;
            PG8_STAGE(PG8_SB(0, 1), b2 + hstep, voffB);
            PG8_WAIT_V(6); PG8_BAR; PG8_MMA(1, 1, At, B1); PG8_BAR;
            PG8_LDB(B0, 1, 0); PG8_SCHED; PG8_LDA(At, 1, 0); PG8_STAGE(PG8_SA(0, 1), a2 + hstep, voffA);
            PG8_WAIT_L(8); PG8_BAR; PG8_WAIT_L(0); PG8_MMA(0, 0, At, B0); PG8_BAR; PG8_SCHED;
            PG8_LDB(B1, 1, 1); PG8_STAGE(PG8_SB(1, 0), b3, voffB);
            PG8_BAR; PG8_WAIT_L(0); PG8_MMA(0, 1, At, B1); PG8_BAR;
            PG8_LDA(At, 1, 1); PG8_STAGE(PG8_SA(1, 0), a3, voffA);
            PG8_BAR; PG8_WAIT_L(0); PG8_MMA(1, 0, At, B0); PG8_BAR; PG8_SCHED;
            PG8_STAGE(PG8_SB(1, 1), b3 + hstep, voffB);
            PG8_WAIT_V(6); PG8_BAR; PG8_MMA(1, 1, At, B1); PG8_BAR;
        }
        E(acc, cur, ui, wr, wc, fr, fq);
#ifdef DUP_EPI
        if (Epi::DUPOK) E(acc, cur, ui, wr, wc, fr, fq);
#endif
        if (!has_next) break;
#pragma unroll
        for (int a = 0; a < 2; ++a)
#pragma unroll
            for (int b = 0; b < 2; ++b)
#pragma unroll
                for (int m = 0; m < 4; ++m)
#pragma unroll
                    for (int n = 0; n < 2; ++n) acc[a][b][m][n] = (f32x4){0.f, 0.f, 0.f, 0.f};
        cur = nxt; cA = nA; cB = nB; ++ui;
    }
    PG8_WAIT_V(0);
    if (wr == 0) PG8_BAR;
    PG8_BAR;
#undef PG8_SA
#undef PG8_SB
#undef PG8_STAGE
#undef PG8_LDA
#undef PG8_LDB
#undef PG8_MMA
#undef PG8_WAIT_V
#undef PG8_WAIT_L
#undef PG8_BAR
#undef PG8_SCHED
}
}
typedef f32x4 acc_t[2][2][4][2];
#define ROWS_LOOP _Pragma("unroll") for (int ai = 0; ai < 2; ++ai) _Pragma("unroll") for (int m = 0; m < 4; ++m)
#define ROW_OF (u.pm * 256 + ai * 128 + wr * 64 + m * 16 + fr)

struct EpiIn {
    static constexpr bool DUPOK = true;
    const Params& p; int l;
    __device__ __forceinline__ void operator()(const acc_t& acc, const pg8::Unit& u, int ui, int wr, int wc, int fr, int fq) const {
        const float* ssq = p.sumsq() + (size_t)(l & 1) * T * 16;
        const int pn = u.pn, cl = wc * 4 + fq;
        __shared__ float s_rstd[256];
        { const int t_ = TID(); if (t_ < 256) s_rstd[t_] = row_rstd(ssq, u.pm * 256 + t_); __syncthreads(); }
        float rsa[8];
#pragma unroll
        for (int ix = 0; ix < 8; ++ix) rsa[ix] = s_rstd[(ix >> 2) * 128 + wr * 64 + (ix & 3) * 16 + fr];
        if (pn < 8) {
            ROWS_LOOP { const int row = ROW_OF; const float rs = rsa[ai * 4 + m];
                float zz[4], gg[4];
#pragma unroll
                for (int ch = 0; ch < 4; ++ch) { const f32x4 v = acc[ai][ch >> 1][m][ch & 1]; zz[ch] = (v[1] * rs) * (v[2] * rs); gg[ch] = (v[0] * rs) * siluf(v[3] * rs); }
                const size_t o = (size_t)row * 512 + pn * 64 + cl * 4;
                u32x2 a; a[0] = cvtpk(zz[0], zz[1]); a[1] = cvtpk(zz[2], zz[3]); *(u32x2*)(p.z() + o) = a;
                u32x2 b; b[0] = cvtpk(gg[0], gg[1]); b[1] = cvtpk(gg[2], gg[3]); *(u32x2*)(p.ga() + o) = b; }
        } else if (pn < 12 || (pn >= 16 && pn <= 18)) {
            if (pn == 18 && wc >= 1) {
                if (wc == 1 && fq == 0) {
                    ROWS_LOOP { const int row = ROW_OF; const float rs = rsa[ai * 4 + m] * 0.04419417382415922f;
                        *(f32x4*)(p.iw() + (size_t)row * 8) = acc[ai][0][m][0] * rs; *(f32x4*)(p.iw() + (size_t)row * 8 + 4) = acc[ai][0][m][1] * rs; }
                }
            } else {
                const bool isqk = pn < 12; const int which = (pn - 8) >> 1;
                int head; u16* dst; int pitch;
                if (isqk) { head = ((pn - 8) & 1) * 4 + wc; dst = which ? p.k() : p.q(); pitch = 512; }
                else if (pn < 18) { head = (pn - 16) * 4 + wc; dst = p.iq(); pitch = 512; }
                else { head = 0; dst = p.ik(); pitch = 64; }
                f32x4 g0[2], g1[2];
#pragma unroll
                for (int n = 0; n < 2; ++n) { g0[n] = (f32x4){1.f, 1.f, 1.f, 1.f}; g1[n] = g0[n]; }
                if (isqk) { const float* gg = (which ? p.k_g : p.q_g) + l * 64 + 8 * fq;
#pragma unroll
                    for (int n = 0; n < 2; ++n) { g0[n] = *(const f32x4*)(gg + 4 * n); g1[n] = *(const f32x4*)(gg + 32 + 4 * n); } }
                f32x4 rcb[2], rsb[2];
                { const int pos0 = (u.pm * 256 + wr * 64 + fr) & (SEQ - 1);
#pragma unroll
                  for (int n = 0; n < 2; ++n) { rcb[n] = *(const f32x4*)(p.ropec() + pos0 * 32 + 8 * fq + 4 * n); rsb[n] = *(const f32x4*)(p.ropes() + pos0 * 32 + 8 * fq + 4 * n); } }
                ROWS_LOOP { const int row = ROW_OF; const int ix = ai * 4 + m; const float rs = rsa[ix];
                    f32x4 a0[2], a1[2];
#pragma unroll
                    for (int n = 0; n < 2; ++n) { a0[n] = acc[ai][0][m][n] * rs; a1[n] = acc[ai][1][m][n] * rs; }
                    if (isqk) { float ss = 0.f;
#pragma unroll
                        for (int n = 0; n < 2; ++n)
#pragma unroll
                            for (int j = 0; j < 4; ++j) ss += a0[n][j] * a0[n][j] + a1[n][j] * a1[n][j];
                        ss += __shfl_xor(ss, 16); ss += __shfl_xor(ss, 32);
                        const float rn = __builtin_amdgcn_rsqf(ss * (1.f / 64.f) + RMS_EPS);
#pragma unroll
                        for (int n = 0; n < 2; ++n) { a0[n] = a0[n] * rn * g0[n]; a1[n] = a1[n] * rn * g1[n]; } }
                    u32x4 o0, o1;
#pragma unroll
                    for (int n = 0; n < 2; ++n) { const f32x4 cc = rcb[n], sn = rsb[n];
                        const f32x4 r0 = a0[n] * cc - a1[n] * sn, r1 = a1[n] * cc + a0[n] * sn;
                        o0[2 * n] = cvtpk(r0[0], r0[1]); o0[2 * n + 1] = cvtpk(r0[2], r0[3]); o1[2 * n] = cvtpk(r1[0], r1[1]); o1[2 * n + 1] = cvtpk(r1[2], r1[3]); }
                    if (ix < 7) { const int posn = (u.pm * 256 + ((ix + 1) >> 2) * 128 + wr * 64 + ((ix + 1) & 3) * 16 + fr) & (SEQ - 1);
#pragma unroll
                        for (int n = 0; n < 2; ++n) { rcb[n] = *(const f32x4*)(p.ropec() + posn * 32 + 8 * fq + 4 * n); rsb[n] = *(const f32x4*)(p.ropes() + posn * 32 + 8 * fq + 4 * n); } }
                    u16* d = dst + (size_t)row * pitch + head * 64 + 8 * fq;
                    *(u32x4*)d = o0; *(u32x4*)(d + 32) = o1; }
            }
        } else {
            u16* dst; int cb; int kind;
            if (pn < 14) { dst = p.v(); cb = (pn - 12) * 256; kind = 0; }
            else if (pn < 16) { dst = p.sg(); cb = (pn - 14) * 256; kind = 1; }
            else if (pn < 21) { dst = p.u(); cb = (pn - 19) * 256; kind = 0; }
            else { dst = p.sp(); cb = (pn - 21) * 256; kind = 2; }
            f32x4 sc[2][2];
#pragma unroll
            for (int bj = 0; bj < 2; ++bj)
#pragma unroll
                for (int n = 0; n < 2; ++n) sc[bj][n] = (kind == 2) ? *(const f32x4*)(p.pool_scale + l * 512 + cb + 16 * cl + bj * 8 + n * 4) : (f32x4){1.f, 1.f, 1.f, 1.f};
            ROWS_LOOP { const int row = ROW_OF; const float rs = rsa[ai * 4 + m];
#pragma unroll
                for (int bj = 0; bj < 2; ++bj) { f32x4 v0 = acc[ai][bj][m][0] * rs, v1 = acc[ai][bj][m][1] * rs;
                    if (kind >= 1) {
#pragma unroll
                        for (int j = 0; j < 4; ++j) { v0[j] = siluf(v0[j]) * sc[bj][0][j]; v1[j] = siluf(v1[j]) * sc[bj][1][j]; } }
                    u32x4 w; w[0] = cvtpk(v0[0], v0[1]); w[1] = cvtpk(v0[2], v0[3]); w[2] = cvtpk(v1[0], v1[1]); w[3] = cvtpk(v1[2], v1[3]);
                    *(u32x4*)(dst + (size_t)row * 512 + cb + 16 * cl + bj * 8) = w; } }
        }
    }
};
__device__ __forceinline__ void phase_in(const Params& p, int l, char* shm) {
    pg8::Gemm g{p.xb(), p.wt_in() + (size_t)l * NPA * 1024, T, NPA, 1024};
    pg8::StaticOrder S; S.init(T, NPA, GDIM(), BID());
    EpiIn E{p, l};
    pg8::gemm_phase((PG8_LAS unsigned char*)shm, g, S, E);
}
__device__ __forceinline__ void phase_mix(const Params& p, int l) {
    const float* cw = p.conv_w + l * 3 * 512;
    constexpr int RUN = 16;
    const int nitem = (T / RUN) * 256;
    const int it0 = BID() * NTHR + TID(), itstep = GDIM() * NTHR;
    for (int it = it0; it < nitem; it += itstep) {
        const int cp = it & 255, c = cp * 2, t0 = (it >> 8) * RUN, pos0 = t0 & (SEQ - 1);
        {
            const float w00 = cw[c], w01 = cw[c + 1], w10 = cw[512 + c], w11 = cw[513 + c], w20 = cw[1024 + c], w21 = cw[1025 + c];
            unsigned zr[RUN + 2], gr[RUN];
#pragma unroll
            for (int i = 0; i < RUN + 2; ++i) zr[i] = (pos0 + i - 2 >= 0) ? *(const unsigned*)(p.z() + (size_t)(t0 + i - 2) * 512 + c) : 0u;
#pragma unroll
            for (int i = 0; i < RUN; ++i) gr[i] = *(const unsigned*)(p.ga() + (size_t)(t0 + i) * 512 + c);
#pragma unroll
            for (int i = 0; i < RUN; ++i) {
                const float y0 = (w00 * bflo(zr[i]) + w10 * bflo(zr[i + 1]) + w20 * bflo(zr[i + 2])) * bflo(gr[i]);
                const float y1 = (w01 * bfhi(zr[i]) + w11 * bfhi(zr[i + 1]) + w21 * bfhi(zr[i + 2])) * bfhi(gr[i]);
                *(unsigned*)(p.ga() + (size_t)(t0 + i) * 512 + c) = cvtpk(y0, y1);
            }
        }
        {
            const int win = 2 << (c >> 7);
            unsigned ur[RUN + 15], gr[RUN];
#pragma unroll
            for (int i = 0; i < RUN + 15; ++i) ur[i] = (i >= 16 - win && pos0 + i - 15 >= 0) ? *(const unsigned*)(p.u() + (size_t)(t0 + i - 15) * 512 + c) : 0u;
#pragma unroll
            for (int i = 0; i < RUN; ++i) gr[i] = *(const unsigned*)(p.sp() + (size_t)(t0 + i) * 512 + c);
            float s0 = 0.f, s1 = 0.f;
#pragma unroll
            for (int i = 0; i < 15; ++i) { s0 += bflo(ur[i]); s1 += bfhi(ur[i]); }
#pragma unroll
            for (int i = 0; i < RUN; ++i) {
                const int pos = pos0 + i;
                const float u0 = bflo(ur[i + 15]), u1 = bfhi(ur[i + 15]);
                s0 += u0; s1 += u1;
                const float ic = __builtin_amdgcn_rcpf((float)min(pos + 1, win));
                *(unsigned*)(p.sp() + (size_t)(t0 + i) * 512 + c) = cvtpk((s0 * ic - u0) * bflo(gr[i]), (s1 * ic - u1) * bfhi(gr[i]));
                unsigned wo = 0u;
#pragma unroll
                for (int g = 0; g < 4; ++g) if (win == (2 << g)) wo = ur[i + 15 - ((2 << g) - 1)];
                s0 -= bflo(wo); s1 -= bfhi(wo);
            }
        }
    }
}

__device__ __forceinline__ int crow(int r, int hi) { return (r & 3) + 8 * (r >> 2) + 4 * hi; }
__device__ __forceinline__ size_t sc_base(int qb) { return (size_t)32768 * qb * (qb + 1); }
__device__ __forceinline__ void phase_indexer(const Params& p, int b, u16* scbuf, char* shm) {
    const int tid_ = TID(); const int wid = tid_ >> 6, lane = tid_ & 63, ql = lane & 15, fq = lane >> 4; const int bid_ = BID(), gdim_ = GDIM();
    constexpr int NSTEP = 64 * 65;
    const int f0 = (int)(((long)bid_ * NSTEP) / gdim_), f1 = (int)(((long)(bid_ + 1) * NSTEP) / gdim_);
    int qcur = -1;
    bf16x8 bq[8][2]; float wv[8]; u16* srow = nullptr; int qloc = 0;
    char* tl = shm + 40960 + wid * 2304;
#pragma unroll
    for (int h = 0; h < 8; ++h) { wv[h] = 0.f; bq[h][0] = bq[h][1] = (bf16x8){0, 0, 0, 0, 0, 0, 0, 0}; }
    const u16* ikb = p.ik() + ((size_t)b * SEQ + ql) * 64 + fq * 8;
    for (int f = f0; f < f1; ++f) {
        int q = (int)((sqrtf(4.f * f + 1.f) - 1.f) * 0.5f);
        while ((q + 1) * (q + 2) <= f) ++q;
        while (q * (q + 1) > f) --q;
        const int tt = f - q * (q + 1);
        if (q != qcur) {
            qcur = q; qloc = q * 128 + wid * 16 + ql;
            const size_t row = (size_t)b * SEQ + qloc;
#pragma unroll
            for (int h = 0; h < 8; ++h)
#pragma unroll
                for (int kc = 0; kc < 2; ++kc) bq[h][kc] = *(const bf16x8*)(p.iq() + row * 512 + h * 64 + kc * 32 + fq * 8);
            const f32x4 x = *(const f32x4*)(p.iw() + row * 8), y = *(const f32x4*)(p.iw() + row * 8 + 4);
            wv[0] = x[0]; wv[1] = x[1]; wv[2] = x[2]; wv[3] = x[3]; wv[4] = y[0]; wv[5] = y[1]; wv[6] = y[2]; wv[7] = y[3];
            const int a = q >> 1;
            srow = scbuf + sc_base(a) + (size_t)(q * 128 + wid * 16 + (lane >> 2) - a * 256) * (256 * (a + 1)) + (lane & 3) * 16;
        }
        const int key0 = tt * 64;
        bf16x8 ka[4][2];
#pragma unroll
        for (int kg = 0; kg < 4; ++kg)
#pragma unroll
            for (int kc = 0; kc < 2; ++kc) ka[kg][kc] = *(const bf16x8*)(ikb + (size_t)(key0 + kg * 16) * 64 + kc * 32);
        const bool band = (key0 + 63 > q * 128 + wid * 16);
#pragma unroll
        for (int kg = 0; kg < 4; ++kg) {
            f32x4 sacc = (f32x4){0.f, 0.f, 0.f, 0.f};
#pragma unroll
            for (int h = 0; h < 8; ++h) {
                f32x4 c = (f32x4){0.f, 0.f, 0.f, 0.f};
                c = __builtin_amdgcn_mfma_f32_16x16x32_bf16(ka[kg][0], bq[h][0], c, 0, 0, 0);
                c = __builtin_amdgcn_mfma_f32_16x16x32_bf16(ka[kg][1], bq[h][1], c, 0, 0, 0);
#pragma unroll
                for (int j = 0; j < 4; ++j) sacc[j] = __builtin_fmaf(wv[h], __builtin_fmaxf(c[j], 0.f), sacc[j]);
            }
            const int kb = key0 + kg * 16 + fq * 4;
            if (band) {
#pragma unroll
                for (int j = 0; j < 4; ++j) if (kb + j > qloc) sacc[j] = -INFINITY;
            }
            union { _Float16 h[4]; u32x2 v; } pk;
            pk.h[0] = (_Float16)sacc[0]; pk.h[1] = (_Float16)sacc[1]; pk.h[2] = (_Float16)sacc[2]; pk.h[3] = (_Float16)sacc[3];
            *(u32x2*)(tl + ql * 144 + kg * 32 + fq * 8) = pk.v;
        }
        { const u32x4 r0 = *(const u32x4*)(tl + (lane >> 2) * 144 + (lane & 3) * 32), r1 = *(const u32x4*)(tl + (lane >> 2) * 144 + (lane & 3) * 32 + 16);
          *(u32x4*)(srow + key0) = r0; *(u32x4*)(srow + key0 + 8) = r1; }
    }
}

__device__ __forceinline__ size_t mk_base(int qb) { return (size_t)512 * qb * (qb + 1); }
constexpr size_t MASK_WORDS_PER_BATCH = 540672;
__device__ __forceinline__ unsigned f16key(unsigned h) { return (h & 0x8000u) ? (~h & 0xffffu) : (h | 0x8000u); }
__device__ __forceinline__ void hist_scan(const unsigned* h, int lane, unsigned target, int& bin, unsigned& above, unsigned& inbin) {
    const u32x4 a = *(const u32x4*)(h + 4 * lane), b = *(const u32x4*)(h + 256 + 4 * lane), c = *(const u32x4*)(h + 512 + 4 * lane), d = *(const u32x4*)(h + 768 + 4 * lane);
    const unsigned h0 = a[0] + b[0] + c[0] + d[0], h1 = a[1] + b[1] + c[1] + d[1], h2 = a[2] + b[2] + c[2] + d[2], h3 = a[3] + b[3] + c[3] + d[3];
    const unsigned tot = h0 + h1 + h2 + h3;
    unsigned x = tot;
#pragma unroll
    for (int dd = 1; dd < 64; dd <<= 1) { const unsigned y = __shfl_down(x, dd); if (lane + dd < 64) x += y; }
    const unsigned ab = x - tot, c3 = ab + h3, c2 = c3 + h2, c1 = c2 + h1, c0 = c1 + h0;
    int fb = -1; unsigned fa = 0, fc = 0;
    if (ab < target && c3 >= target) { fb = 4 * lane + 3; fa = ab; fc = h3; }
    else if (c3 < target && c2 >= target) { fb = 4 * lane + 2; fa = c3; fc = h2; }
    else if (c2 < target && c1 >= target) { fb = 4 * lane + 1; fa = c2; fc = h1; }
    else if (c1 < target && c0 >= target) { fb = 4 * lane; fa = c1; fc = h0; }
    const u64 m = __ballot(fb >= 0); const int src = (m == 0) ? 0 : (__ffsll((unsigned long long)m) - 1);
    bin = __shfl(fb, src); above = __shfl(fa, src); inbin = __shfl(fc, src);
}
__device__ __forceinline__ unsigned f16key2(unsigned w) { const unsigned sg = (w >> 15) & 0x00010001u; return w ^ (((sg << 15) - sg) | 0x80008000u); }
__device__ __forceinline__ void phase_select(const Params& p, int b, char* shm, const u16* scbuf) {
    const int tid_ = TID(); const int wid = __builtin_amdgcn_readfirstlane(tid_ >> 6), lane = tid_ & 63;
    const int gw = BID() * 8 + wid, nw = GDIM() * 8;
    unsigned* hist = (unsigned*)shm + wid * 1152;
    const int hsubi = (lane >> 4) * 256, dummyi = 1024 + lane;
    typedef unsigned short us2 __attribute__((ext_vector_type(2)));
#define ROW_T(i_) ({ const int kq_ = (i_) / nw; ((mirror && (kq_ & 1)) ? (kq_ * nw + (nw - 1 - ((i_) - kq_ * nw))) : (i_)); })
#define ROW_LOAD(t_) do { const int qb_ = (t_) >> 8, ntr_ = 2 * (((t_) >> 7) + 1), nch_ = (ntr_ + 7) >> 3; \
        const u16* sr_ = scbuf + sc_base(qb_) + (size_t)((t_) - qb_ * 256) * (256 * (qb_ + 1)); \
        _Pragma("unroll") for (int c = 0; c < 16; ++c) { raw[c] = (u32x4){0u, 0u, 0u, 0u}; if (c < nch_) { if (lane < 8 * (ntr_ - 8 * c)) raw[c] = *(const u32x4*)(sr_ + 512 * c + 8 * lane); } } } while (0)
    const bool mirror = (SEQ % (2 * nw)) == 0;
    u32x4 raw[16];
    if (gw < SEQ) { const int t0_ = ROW_T(gw); ROW_LOAD(t0_); }
    for (int i = gw; i < SEQ; i += nw) {
        const int t = ROW_T(i);
        const int qb = t >> 8, ntile = 4 * (qb + 1), ntr = 2 * ((t >> 7) + 1);
        const int nch = (ntr + 7) >> 3, nchw = (ntile + 7) >> 3;
        unsigned char* mrow = (unsigned char*)(p.mask() + (size_t)b * MASK_WORDS_PER_BATCH + mk_base(qb) + (size_t)(t - qb * 256) * ntile);
        unsigned key[16][4];
#pragma unroll
        for (int c = 0; c < 16; ++c) {
            const bool valid = (c < nch) && (lane < 8 * (ntr - 8 * c));
#pragma unroll
            for (int r = 0; r < 4; ++r) key[c][r] = valid ? f16key2(raw[c][r]) : 0u;
        }
        if (i + nw < SEQ) { const int tn_ = ROW_T(i + nw); ROW_LOAD(tn_); }
        unsigned thrm1 = 0x03ffu, thr = 0x0400u; int need = 0; bool fast = true;
        if (t >= 256) {
            us2 a1 = (us2){0, 0}, a2 = (us2){0, 0};
#pragma unroll
            for (int c = 0; c < 16; ++c) {
                if (c < nch) {
#pragma unroll
                    for (int r = 0; r < 4; ++r) { const us2 kk = __builtin_bit_cast(us2, key[c][r]);
                        const us2 tmx = __builtin_elementwise_max(a1, kk), tmn = __builtin_elementwise_min(a1, kk); a1 = tmx; a2 = __builtin_elementwise_max(a2, tmn); }
                }
            }
            unsigned Lb = min((unsigned)a2[0], (unsigned)a2[1]);
#pragma unroll
            for (int m_ = 32; m_ >= 1; m_ >>= 1) Lb = min(Lb, (unsigned)__shfl_xor((int)Lb, m_));
            Lb = __builtin_amdgcn_readfirstlane(Lb);
            const u32x4 z4 = (u32x4){0u, 0u, 0u, 0u};
#pragma unroll
            for (int c = 0; c < 4; ++c) *(u32x4*)(hist + c * 256 + 4 * lane) = z4;
#pragma unroll
            for (int c = 0; c < 16; ++c) {
                if (c < nch) {
#pragma unroll
                    for (int r = 0; r < 4; ++r) { const unsigned kk = key[c][r]; const unsigned lo = kk & 0xffffu, hi = kk >> 16;
                        atomicAdd(hist + ((lo >= Lb) ? (hsubi + (int)(lo >> 8)) : dummyi), 1u);
                        atomicAdd(hist + ((hi >= Lb) ? (hsubi + (int)(hi >> 8)) : dummyi), 1u); }
                }
            }
            asm volatile("s_waitcnt lgkmcnt(0)" ::: "memory");
            int B1; unsigned ab1, in1;
            hist_scan(hist, lane, 256u, B1, ab1, in1);
            asm volatile("s_waitcnt lgkmcnt(0)" ::: "memory");
#pragma unroll
            for (int c = 0; c < 4; ++c) *(u32x4*)(hist + c * 256 + 4 * lane) = z4;
#pragma unroll
            for (int c = 0; c < 16; ++c) {
                if (c < nch) {
#pragma unroll
                    for (int r = 0; r < 4; ++r) { const unsigned kk = key[c][r]; const unsigned lo = kk & 0xffffu, hi = kk >> 16;
                        const bool ml = ((lo >> 8) == (unsigned)B1) && (lo >= Lb), mh = ((hi >> 8) == (unsigned)B1) && (hi >= Lb);
                        if (__any(ml || mh)) { if (ml) atomicAdd(hist + hsubi + (int)(lo & 255u), 1u); if (mh) atomicAdd(hist + hsubi + (int)(hi & 255u), 1u); } }
                }
            }
            asm volatile("s_waitcnt lgkmcnt(0)" ::: "memory");
            int B2; unsigned ab2, in2;
            hist_scan(hist, lane, 256u - ab1, B2, ab2, in2);
            asm volatile("s_waitcnt lgkmcnt(0)" ::: "memory");
            thr = __builtin_amdgcn_readfirstlane(((unsigned)B1 << 8) | (unsigned)B2);
            need = __builtin_amdgcn_readfirstlane(256 - (int)(ab1 + ab2));
            const int neq = __builtin_amdgcn_readfirstlane((int)in2);
            fast = (need == neq);
            thrm1 = thr - 1u;
        }
        if (fast) {
#pragma unroll
            for (int c = 0; c < 16; ++c) {
                if (c < nchw) {
                    unsigned m = 0u;
#pragma unroll
                    for (int ii = 7; ii >= 0; --ii) { const unsigned kk = key[c][ii >> 1]; const unsigned kv = (ii & 1) ? (kk >> 16) : (kk & 0xffffu); m = m + m + ((kv > thrm1) ? 1u : 0u); }
                    if (64 * c + lane < 8 * ntile) mrow[64 * c + lane] = (unsigned char)m;
                }
            }
        } else {
            int base = 0;
#pragma unroll 1
            for (int c = 0; c < 16; ++c) {
                if (c < nchw) {
                    unsigned m = 0u, e = 0u;
#pragma unroll
                    for (int ii = 7; ii >= 0; --ii) { unsigned kk = (ii >> 1) == 0 ? key[0][0] : 0u;
#pragma unroll
                        for (int cc = 0; cc < 16; ++cc) if (cc == c) kk = key[cc][ii >> 1];
                        const unsigned kv = (ii & 1) ? (kk >> 16) : (kk & 0xffffu); m = m + m + ((kv > thr) ? 1u : 0u); e = e + e + ((kv == thr) ? 1u : 0u); }
                    const int cnt = __builtin_popcount(e);
                    int pre = cnt;
#pragma unroll
                    for (int dd = 1; dd < 64; dd <<= 1) { const int y = __shfl_up(pre, dd); if (lane >= dd) pre += y; }
                    const int tot = __shfl(pre, 63);
                    int rank = base + pre - cnt;
#pragma unroll
                    for (int ii = 0; ii < 8; ++ii) if ((e >> ii) & 1u) { if (rank < need) m |= (1u << ii); ++rank; }
                    base += tot;
                    if (64 * c + lane < 8 * ntile) mrow[64 * c + lane] = (unsigned char)m;
                }
            }
        }
    }
}

constexpr int A_D = 64, A_DM = 512, A_NW = 8, A_QBLK = 32, A_QB = 256, A_KVBLK = 64, A_NQB = SEQ / A_QB, A_NHEAD = 8;
constexpr float A_C2 = 0.125f * 1.4426950408889634f;
constexpr int A_SLOTB = 8192, A_LDS_K = 0, A_LDS_V = 3 * A_SLOTB, A_LDS_WS = 6 * A_SLOTB, A_LDS_OST = A_LDS_WS + A_NW * 256, A_LDS_MK = A_LDS_OST + A_NW * 4096, A_LDS_BYTES = A_LDS_MK + A_NW * 2048;
#define ATTN_THR 8
#define SBAR() __builtin_amdgcn_sched_barrier(0)
#define PIN(x) asm volatile("" : "+v"(x))
#define MFMA32(a, b, c) __builtin_amdgcn_mfma_f32_32x32x16_bf16(a, b, c, 0, 0, 0)
#define WAIT_BAR(N) asm volatile("s_waitcnt vmcnt(" #N ") lgkmcnt(0)\n\ts_barrier" ::: "memory")
__device__ __forceinline__ void glds16s(const void* sbase, unsigned voff, unsigned lds_base) {
    unsigned sv; asm volatile("s_mov_b32 %0, m0\n\ts_mov_b32 m0, %3\n\ts_nop 0\n\tglobal_load_lds_dwordx4 %1, %2\n\ts_mov_b32 m0, %0" : "=&s"(sv) : "v"(voff), "s"(sbase), "s"(lds_base) : "memory"); }
typedef __attribute__((address_space(3))) const char* lds_cptr;
typedef short v4i16_t __attribute__((ext_vector_type(4)));
__device__ __forceinline__ void kload2(bf16x8* kf, lds_cptr kp, int d0) { kf[2 * d0] = *(const __attribute__((address_space(3))) bf16x8*)(kp + d0 * 2048); kf[2 * d0 + 1] = *(const __attribute__((address_space(3))) bf16x8*)(kp + d0 * 2048 + 512); }
__device__ __forceinline__ s16x4 vtr(lds_cptr p) { return __builtin_bit_cast(s16x4, __builtin_amdgcn_ds_read_tr16_b64_v4i16((__attribute__((address_space(3))) v4i16_t*)p)); }
#define MX3(a, b, c) __builtin_fmaxf(__builtin_fmaxf((a), (b)), (c))
__device__ __forceinline__ float rowmax(const f32x16& p0, const f32x16& p1) {
    float a = MX3(p0[0], p0[1], p1[0]), b = MX3(p0[2], p0[3], p1[1]); a = MX3(a, p1[2], p1[3]);
#pragma unroll
    for (int r = 4; r < 16; r += 4) { a = MX3(a, p0[r], p0[r + 1]); b = MX3(b, p0[r + 2], p0[r + 3]); a = MX3(a, p1[r], p1[r + 1]); b = MX3(b, p1[r + 2], p1[r + 3]); }
    float m = __builtin_fmaxf(a, b); auto rr = __builtin_amdgcn_permlane32_swap(__float_as_uint(m), __float_as_uint(m), false, false);
    return __builtin_fmaxf(__uint_as_float(rr[0]), __uint_as_float(rr[1])); }
__device__ __forceinline__ void cmask(f32x16& p0, f32x16& p1, int jb, int qrel, int hi) {
    const int kb = 64 * jb + 4 * hi;
#pragma unroll
    for (int r = 0; r < 16; ++r) { const int kv = kb + (r & 3) + 8 * (r >> 2); if (kv > qrel) p0[r] = -INFINITY; if (kv + 32 > qrel) p1[r] = -INFINITY; } }
__device__ __forceinline__ float mand(float x, unsigned w, int pos) { return __uint_as_float(__float_as_uint(x) & (unsigned)__builtin_amdgcn_sbfe((int)w, pos, 1)); }
#define BITP(i) (((i) & 3) + 8 * ((i) >> 2))

__device__ __forceinline__ void attn64_unit(int b, int h, int qb, const u16* Q, const u16* __restrict__ K, const u16* __restrict__ V, const u16* __restrict__ SG, u16* O, const u64* mrow0, char* lds) {
    const int tid = TID(), lane = tid & 63, r32 = lane & 31, hi = lane >> 5; const int wid = __builtin_amdgcn_readfirstlane(tid >> 6);
    const long rowbase = (long)b * SEQ; const int q0 = qb * A_QB, NT = (q0 + A_QB) / A_KVBLK;
    const u16* Qw = Q + (rowbase + q0 + wid * A_QBLK) * A_DM + h * A_D;
    const unsigned lds0 = (unsigned)(uintptr_t)lds; float* wsf = (float*)(lds + A_LDS_WS) + wid * 64;
    const u16* kbase = K + rowbase * A_DM + h * A_D; const u16* vbase = V + rowbase * A_DM + h * A_D;
    const unsigned koff = (unsigned)(lane * A_DM + wid * 8) * 2u;
    const unsigned voff = (unsigned)((16 * (wid & 3) + (lane >> 2)) * A_DM + (wid >> 2) * 32 + (lane & 3) * 8) * 2u;
    const unsigned kdst = lds0 + A_LDS_K + wid * 1024, vdst = lds0 + A_LDS_V + wid * 1024;
#define DMA_K(t, slot) glds16s(kbase + (long)(t) * A_KVBLK * A_DM, koff, (unsigned)__builtin_amdgcn_readfirstlane(kdst + (slot)))
#define DMA_V(t, slot) glds16s(vbase + (long)(t) * A_KVBLK * A_DM, voff, (unsigned)__builtin_amdgcn_readfirstlane(vdst + (slot)))
#define DMA_M(chunk) glds16s(mrow0 + 2 * (chunk), moff, (unsigned)__builtin_amdgcn_readfirstlane(mdst + ((chunk) & 1) * 1024))
#define MWORD(t) (*(const u64*)(lds + A_LDS_MK + wid * 2048 + (((t) >> 1) & 1) * 1024 + r32 * 16 + ((t) & 1) * 8))
    const lds_cptr vp0 = (lds_cptr)lds + A_LDS_V + ((lane >> 4) & 1) * 32 + (lane & 3) * 8 + (4 * hi + ((lane & 15) >> 2)) * 64;
    const lds_cptr kp0 = (lds_cptr)lds + A_LDS_K + hi * 1024 + r32 * 16;
    const int qrel = wid * A_QBLK + r32;
    const unsigned moff = (unsigned)(qrel * NT) * 8u;
    const unsigned mdst = lds0 + A_LDS_MK + wid * 2048;
    DMA_M(0);
    DMA_K(0, 0); DMA_V(0, 0); DMA_K(1, A_SLOTB);
    bf16x8 qr[4];
#pragma unroll
    for (int d0 = 0; d0 < 4; ++d0) qr[d0] = *reinterpret_cast<const bf16x8*>(&Qw[(long)r32 * A_DM + d0 * 16 + hi * 8]);
    float mhat = 0.f, l_reg = 0.f; f32x16 o[2]; o[0] = f32x16{}; o[1] = f32x16{};
    const f32x16 zero16 = f32x16{};
    bool resc = false;
    f32x16 pA0, pA1, pB0, pB1; bf16x8 kf[8]; s16x4 vlo[8], vhi[8]; u32x4 pw0, pw1, pw2, pw3;
    int sl_prev = 0, sl_cur = 0, sl_next = A_SLOTB;
    const int sh4 = 4 * hi;
#define ROT() do { sl_prev = sl_cur; sl_cur = sl_next; sl_next = (sl_next == 2 * A_SLOTB) ? 0 : sl_next + A_SLOTB; } while (0)
#define EX(v) __builtin_amdgcn_exp2f(__builtin_fmaf((v), A_C2, nmh))
#define RESC() do { if (resc) { _Pragma("unroll") for (int d_ = 0; d_ < 2; ++d_) _Pragma("unroll") for (int r = 0; r < 16; ++r) o[d_][r] *= wsf[crow(r, hi)]; } } while (0)
    DMA_K(2, 2 * A_SLOTB);
    WAIT_BAR(3);
    _Pragma("unroll") for (int d0 = 0; d0 < 4; ++d0) kload2(kf, kp0, d0);
    pA0 = MFMA32(kf[0], qr[0], zero16); pA1 = MFMA32(kf[1], qr[0], zero16); pA0 = MFMA32(kf[2], qr[1], pA0); pA1 = MFMA32(kf[3], qr[1], pA1);
    pA0 = MFMA32(kf[4], qr[2], pA0); pA1 = MFMA32(kf[5], qr[2], pA1); pA0 = MFMA32(kf[6], qr[3], pA0); pA1 = MFMA32(kf[7], qr[3], pA1);
    { const float rm = rowmax(pA0, pA1); mhat = rm * A_C2; const float nmh = -mhat;
      const u64 mw0 = MWORD(0); const unsigned wl = (unsigned)mw0 >> sh4, wh = (unsigned)(mw0 >> 32) >> sh4;
#pragma unroll
      for (int r = 0; r < 16; ++r) { pA0[r] = mand(EX(pA0[r]), wl, BITP(r)); pA1[r] = mand(EX(pA1[r]), wh, BITP(r)); } }
    WAIT_BAR(0);
    DMA_K(3, 0); DMA_V(1, A_SLOTB); ROT();
    _Pragma("unroll") for (int d0 = 0; d0 < 4; ++d0) kload2(kf, kp0 + sl_cur, d0);
    WAIT_BAR(2);
#define PKW(P, i) cvtpk(P[i], P[i + 1])
#define PAF(k) __builtin_bit_cast(bf16x8, pw##k)
#define VFR(i) (bf16x8){vlo[i][0], vlo[i][1], vlo[i][2], vlo[i][3], vhi[i][0], vhi[i][1], vhi[i][2], vhi[i][3]}
#define VRD(i) do { vlo[i] = vtr(vp_ + (((i) >> 2) * 4096 + ((i) & 3) * 1024)); vhi[i] = vtr(vp_ + (((i) >> 2) * 4096 + ((i) & 3) * 1024 + 512)); } while (0)
#define KRD(G, d0) do { if (G) { kload2(kf, kp0 + sl_next, d0); SBAR(); } } while (0)
#define GAPA(MF, a0, a1, a2, a3, W0, W1, PW) do { MF; sacc += a0; sacc += a1; sacc += a2; sacc += a3; W0; W1; PIN(PW); PIN(sacc); SBAR(); } while (0)
#define GAPB(MF, X, i, W) do { MF; X[i] = mand(EX(X[i]), W, BITP(i)); X[i + 1] = mand(EX(X[i + 1]), W, BITP(i + 1)); X[i + 2] = mand(EX(X[i + 2]), W, BITP(i + 2)); X[i + 3] = mand(EX(X[i + 3]), W, BITP(i + 3)); PIN(X); SBAR(); } while (0)
#define STEP(C0, C1, P0, P1, t, MASK, GK, GV, GL, ML) do { SBAR(); \
    if (ML) DMA_M(((t) + 1) >> 1); \
    const u64 mw_ = MWORD(t); \
    const lds_cptr vp_ = vp0 + sl_prev; \
    VRD(0); SBAR(); float sacc = P0[0] + P0[1]; \
                    GAPA(C0 = MFMA32(kf[0], qr[0], zero16), P0[2], P0[3], P0[4], P0[5],     pw0[0] = PKW(P0, 0),  pw0[1] = PKW(P0, 2),  pw0); \
    VRD(4); SBAR(); GAPA(C1 = MFMA32(kf[1], qr[0], zero16), P0[6], P0[7], P0[8], P0[9],     pw0[2] = PKW(P0, 4),  pw0[3] = PKW(P0, 6),  pw0); \
    VRD(1); SBAR(); GAPA(C0 = MFMA32(kf[2], qr[1], C0),    P0[10], P0[11], P0[12], P0[13], pw1[0] = PKW(P0, 8),  pw1[1] = PKW(P0, 10), pw1); \
    VRD(5); SBAR(); GAPA(C1 = MFMA32(kf[3], qr[1], C1),    P0[14], P0[15], P1[0], P1[1],   pw1[2] = PKW(P0, 12), pw1[3] = PKW(P0, 14), pw1); \
    VRD(2); SBAR(); GAPA(C0 = MFMA32(kf[4], qr[2], C0),    P1[2], P1[3], P1[4], P1[5],     pw2[0] = PKW(P1, 0),  pw2[1] = PKW(P1, 2),  pw2); \
    VRD(6); SBAR(); GAPA(C1 = MFMA32(kf[5], qr[2], C1),    P1[6], P1[7], P1[8], P1[9],     pw2[2] = PKW(P1, 4),  pw2[3] = PKW(P1, 6),  pw2); \
    VRD(3); SBAR(); GAPA(C0 = MFMA32(kf[6], qr[3], C0),    P1[10], P1[11], P1[12], P1[13], pw3[0] = PKW(P1, 8),  pw3[1] = PKW(P1, 10), pw3); \
    VRD(7); SBAR(); GAPA(C1 = MFMA32(kf[7], qr[3], C1),    P1[14], P1[15], 0.f, 0.f,       pw3[2] = PKW(P1, 12), pw3[3] = PKW(P1, 14), pw3); \
    l_reg += sacc; \
    if (GK) DMA_K((t) + 3, sl_cur); if (GV) DMA_V((t) + 1, sl_next); \
    { const float rm = __builtin_fmaf(rowmax(C0, C1), A_C2, -mhat); resc = false; \
      if (__builtin_expect(__any(rm > (float)ATTN_THR), 0)) { const float dl = __builtin_fmaxf(rm, 0.f); mhat += dl; \
          const float f = __builtin_amdgcn_exp2f(-dl); l_reg *= f; if (hi == 0) wsf[r32] = f; resc = true; } } \
    const float nmh = -mhat; const unsigned wl_ = (unsigned)(mw_) >> sh4, wh_ = (unsigned)((mw_) >> 32) >> sh4; SBAR(); \
    GAPB(o[0] = MFMA32(PAF(0), VFR(0), o[0]), C0, 0, wl_);              GAPB(o[1] = MFMA32(PAF(0), VFR(4), o[1]), C0, 4, wl_); \
    KRD(GL, 0); GAPB(o[0] = MFMA32(PAF(1), VFR(1), o[0]), C0, 8, wl_);  KRD(GL, 1); GAPB(o[1] = MFMA32(PAF(1), VFR(5), o[1]), C0, 12, wl_); \
    KRD(GL, 2); GAPB(o[0] = MFMA32(PAF(2), VFR(2), o[0]), C1, 0, wh_);  KRD(GL, 3); GAPB(o[1] = MFMA32(PAF(2), VFR(6), o[1]), C1, 4, wh_); \
    GAPB(o[0] = MFMA32(PAF(3), VFR(3), o[0]), C1, 8, wh_);              GAPB(o[1] = MFMA32(PAF(3), VFR(7), o[1]), C1, 12, wh_); \
    } while (0)
    int t = 1;
    for (; t + 5 < NT; t += 2) {
        STEP(pB0, pB1, pA0, pA1, t, false, true, true, true, true);      WAIT_BAR(2); RESC(); ROT();
        STEP(pA0, pA1, pB0, pB1, t + 1, false, true, true, true, false); WAIT_BAR(2); RESC(); ROT();
    }
#define ENDW(tt) do { if ((tt) + 3 < NT) { WAIT_BAR(2); } else if ((tt) + 2 < NT) { WAIT_BAR(1); } else { WAIT_BAR(0); } } while (0)
    for (; t + 1 < NT; t += 2) {
        STEP(pB0, pB1, pA0, pA1, t, true, (t + 3 < NT), (t + 1 < NT), (t + 1 < NT), (t + 1 < NT));         ENDW(t);     RESC(); ROT();
        STEP(pA0, pA1, pB0, pB1, t + 1, true, (t + 4 < NT), (t + 2 < NT), (t + 2 < NT), false);            ENDW(t + 1); RESC(); ROT();
    }
    STEP(pB0, pB1, pA0, pA1, NT - 1, true, false, false, false, false); RESC();
    { float sacc = pB0[0] + pB0[1];
#pragma unroll
      for (int r = 2; r < 16; ++r) sacc += pB0[r];
#pragma unroll
      for (int r = 0; r < 16; ++r) sacc += pB1[r];
      l_reg += sacc;
      pw0 = (u32x4){PKW(pB0, 0), PKW(pB0, 2), PKW(pB0, 4), PKW(pB0, 6)}; pw1 = (u32x4){PKW(pB0, 8), PKW(pB0, 10), PKW(pB0, 12), PKW(pB0, 14)};
      pw2 = (u32x4){PKW(pB1, 0), PKW(pB1, 2), PKW(pB1, 4), PKW(pB1, 6)}; pw3 = (u32x4){PKW(pB1, 8), PKW(pB1, 10), PKW(pB1, 12), PKW(pB1, 14)};
      const lds_cptr vp_ = vp0 + sl_cur; _Pragma("unroll") for (int i = 0; i < 8; ++i) VRD(i);
      o[0] = MFMA32(PAF(0), VFR(0), o[0]); o[1] = MFMA32(PAF(0), VFR(4), o[1]); o[0] = MFMA32(PAF(1), VFR(1), o[0]); o[1] = MFMA32(PAF(1), VFR(5), o[1]);
      o[0] = MFMA32(PAF(2), VFR(2), o[0]); o[1] = MFMA32(PAF(2), VFR(6), o[1]); o[0] = MFMA32(PAF(3), VFR(3), o[0]); o[1] = MFMA32(PAF(3), VFR(7), o[1]); }
    { auto rr = __builtin_amdgcn_permlane32_swap(__float_as_uint(l_reg), __float_as_uint(l_reg), false, false); l_reg = __uint_as_float(rr[0]) + __uint_as_float(rr[1]); }
    if (hi == 0) wsf[32 + r32] = l_reg; asm volatile("s_waitcnt lgkmcnt(0)" ::: "memory");
    float rli[16];
#pragma unroll
    for (int r = 0; r < 16; ++r) rli[r] = __builtin_amdgcn_rcpf(wsf[32 + crow(r, hi)]);
    u16* Ow = O + (rowbase + q0 + wid * A_QBLK) * A_DM + h * A_D; const u16* Gw = SG + (rowbase + q0 + wid * A_QBLK) * A_DM + h * A_D;
    u16* stg = (u16*)(lds + A_LDS_OST) + wid * 2048;
#pragma unroll
    for (int r = 0; r < 16; ++r) { const int orow = crow(r, hi);
#pragma unroll
        for (int d0 = 0; d0 < 2; ++d0) stg[orow * 64 + d0 * 32 + r32] = f2bf(o[d0][r] * rli[r]); }
    asm volatile("s_waitcnt lgkmcnt(0)" ::: "memory");
#pragma unroll
    for (int i = 0; i < 4; ++i) { const int row = i * 8 + (lane >> 3), ch = lane & 7;
        u32x4 ov = *(const u32x4*)(stg + row * 64 + ch * 8); u32x4 gv = *(const u32x4*)(Gw + (long)row * A_DM + ch * 8); u32x4 rv;
#pragma unroll
        for (int e = 0; e < 4; ++e) rv[e] = cvtpk(bflo(ov[e]) * bflo(gv[e]), bfhi(ov[e]) * bfhi(gv[e]));
        *(u32x4*)(Ow + (long)row * A_DM + ch * 8) = rv; }
    asm volatile("s_waitcnt vmcnt(0) lgkmcnt(0)\n\ts_barrier" ::: "memory");
#undef DMA_K
#undef DMA_V
#undef DMA_M
#undef MWORD
#undef ROT
#undef EX
#undef RESC
#undef PKW
#undef PAF
#undef VFR
#undef VRD
#undef KRD
#undef ENDW
#undef GAPA
#undef GAPB
#undef STEP
}
__device__ __forceinline__ void phase_attn(const Params& p, char* lds) {
    constexpr int NPAIR = A_NQB / 2, NUNIT = NBATCH * A_NHEAD * NPAIR;
    const int bid_ = BID(), gdim_ = GDIM();
    for (int u = bid_; u < NUNIT; u += gdim_) {
        const int x = u & 7, kk = u >> 3, bh = x + 8 * (kk / NPAIR), j = kk % NPAIR;
        const int b = bh / A_NHEAD, h = bh % A_NHEAD;
        const u64* mb = p.mask() + (size_t)b * MASK_WORDS_PER_BATCH;
        attn64_unit(b, h, j, p.q(), p.k(), p.v(), p.sg(), p.bin(), mb + mk_base(j), lds);
        attn64_unit(b, h, A_NQB - 1 - j, p.q(), p.k(), p.v(), p.sg(), p.bin(), mb + mk_base(A_NQB - 1 - j), lds);
    }
}

struct EpiStash {
    static constexpr bool DUPOK = false;
    u16* stash;
    __device__ __forceinline__ void operator()(const acc_t& acc, const pg8::Unit& u, int ui, int wr, int wc, int fr, int fq) const {
        const int tid_ = TID();
        u32x4* st = (u32x4*)(stash + (size_t)(u.pm * 4 + u.pn) * 65536);
        ROWS_LOOP {
#pragma unroll
            for (int bj = 0; bj < 2; ++bj) { const f32x4 v0 = acc[ai][bj][m][0], v1 = acc[ai][bj][m][1];
                u32x4 w; w[0] = cvtpk(v0[0], v0[1]); w[1] = cvtpk(v0[2], v0[3]); w[2] = cvtpk(v1[0], v1[1]); w[3] = cvtpk(v1[2], v1[3]);
                st[((ai * 4 + m) * 2 + bj) * 512 + tid_] = w; } }
    }
};
struct EpiGate {
    static constexpr bool DUPOK = false;
    const Params& p; int l; int br;
    __device__ __forceinline__ void operator()(const acc_t& acc, const pg8::Unit& u, int ui, int wr, int wc, int fr, int fq) const {
        const float* ssq = p.sumsq() + (size_t)(l & 1) * T * 16;
        const int tid_ = TID();
        const u32x4* st = (const u32x4*)(p.stash() + (size_t)(u.pm * 4 + u.pn) * 65536);
        const int cl = wc * 4 + fq;
        __shared__ float s_rstd[256];
        { if (tid_ < 256) s_rstd[tid_] = row_rstd(ssq, u.pm * 256 + tid_); __syncthreads(); }
        float rsa[8];
#pragma unroll
        for (int ix = 0; ix < 8; ++ix) rsa[ix] = s_rstd[(ix >> 2) * 128 + wr * 64 + (ix & 3) * 16 + fr];
        const char* stp = (const char*)st + (size_t)tid_ * 16;
        char* mpp = (char*)(p.merged() + (size_t)(u.pm * 256 + wr * 64 + fr) * 1024 + u.pn * 256 + 16 * cl);
        u32x4 yb = *(const u32x4*)stp, ob = (br > 0) ? *(const u32x4*)mpp : (u32x4){0u, 0u, 0u, 0u};
        ROWS_LOOP { const int ix = ai * 4 + m; const float rs = rsa[ix];
#pragma unroll
            for (int bj = 0; bj < 2; ++bj) { const f32x4 v0 = acc[ai][bj][m][0] * rs, v1 = acc[ai][bj][m][1] * rs;
                float r[8];
                r[0] = sigmf(v0[0]) * bflo(yb[0]); r[1] = sigmf(v0[1]) * bfhi(yb[0]); r[2] = sigmf(v0[2]) * bflo(yb[1]); r[3] = sigmf(v0[3]) * bfhi(yb[1]);
                r[4] = sigmf(v1[0]) * bflo(yb[2]); r[5] = sigmf(v1[1]) * bfhi(yb[2]); r[6] = sigmf(v1[2]) * bflo(yb[3]); r[7] = sigmf(v1[3]) * bfhi(yb[3]);
                if (br > 0) {
#pragma unroll
                    for (int e = 0; e < 4; ++e) { r[2 * e] += bflo(ob[e]); r[2 * e + 1] += bfhi(ob[e]); } }
                u32x4 wo; wo[0] = cvtpk(r[0], r[1]); wo[1] = cvtpk(r[2], r[3]); wo[2] = cvtpk(r[4], r[5]); wo[3] = cvtpk(r[6], r[7]);
                const char* stn = stp + 8192; char* mpn = (bj == 0) ? (mpp + 16) : (mpp - 16 + ((ix == 3) ? 80 : 16) * 2048);
                asm volatile("" : "+v"(stn), "+v"(mpn));
                if (!(ix == 7 && bj == 1)) { yb = *(const u32x4*)stn; if (br > 0) ob = *(const u32x4*)mpn; }
                *(u32x4*)mpp = wo;
                stp = stn; mpp = mpn; } }
    }
};
__device__ __forceinline__ void phase_merge(const Params& p, int l, char* shm) {
    pg8::RowOrder S{4, 512, GDIM(), BID()};
    for (int br = 0; br < 3; ++br) {
        const u16* Ain = br == 0 ? p.ga() : (br == 1 ? p.bin() : p.sp());
        const u16* Wy = (br == 0 ? p.wt_oa() : (br == 1 ? p.wt_ob() : p.wt_oc())) + (size_t)l * 1024 * 512;
        { pg8::Gemm g{Ain, Wy, T, 1024, 512}; EpiStash E{p.stash()}; pg8::gemm_phase((PG8_LAS unsigned char*)shm, g, S, E); }
        { pg8::Gemm g{p.xb(), p.wt_mg() + (size_t)l * 3072 * 1024 + (size_t)br * 1024 * 1024, T, 1024, 1024}; EpiGate E{p, l, br}; pg8::gemm_phase((PG8_LAS unsigned char*)shm, g, S, E); }
    }
}

struct EpiOut {
    static constexpr bool DUPOK = false;
    const Params& p; int l;
    __device__ __forceinline__ void operator()(const acc_t& acc, const pg8::Unit& u, int ui, int wr, int wc, int fr, int fq) const {
        const float* xsrc = (l == 0) ? p.x_in : p.x;
        const int cl = wc * 4 + fq;
        f32x4 xb0[2], xb1[2];
#pragma unroll
        for (int bj = 0; bj < 2; ++bj) { const size_t o = (size_t)(u.pm * 256 + wr * 64 + fr) * 1024 + u.pn * 256 + 16 * cl + bj * 8; xb0[bj] = *(const f32x4*)(xsrc + o); xb1[bj] = *(const f32x4*)(xsrc + o + 4); }
        ROWS_LOOP { const int row = ROW_OF; const int ix = ai * 4 + m; float ss = 0.f;
            f32x4 x0[2], x1[2];
#pragma unroll
            for (int bj = 0; bj < 2; ++bj) { x0[bj] = xb0[bj] + acc[ai][bj][m][0]; x1[bj] = xb1[bj] + acc[ai][bj][m][1]; }
            if (ix < 7) { const int rown = u.pm * 256 + ((ix + 1) >> 2) * 128 + wr * 64 + ((ix + 1) & 3) * 16 + fr;
#pragma unroll
                for (int bj = 0; bj < 2; ++bj) { const size_t o = (size_t)rown * 1024 + u.pn * 256 + 16 * cl + bj * 8; xb0[bj] = *(const f32x4*)(xsrc + o); xb1[bj] = *(const f32x4*)(xsrc + o + 4); } }
#pragma unroll
            for (int bj = 0; bj < 2; ++bj) { const size_t o = (size_t)row * 1024 + u.pn * 256 + 16 * cl + bj * 8;
                *(f32x4*)(p.x + o) = x0[bj]; *(f32x4*)(p.x + o + 4) = x1[bj];
                if (l < NL - 1) { u32x4 w; w[0] = cvtpk(x0[bj][0], x0[bj][1]); w[1] = cvtpk(x0[bj][2], x0[bj][3]); w[2] = cvtpk(x1[bj][0], x1[bj][1]); w[3] = cvtpk(x1[bj][2], x1[bj][3]); *(u32x4*)(p.xb() + o) = w;
#pragma unroll
                    for (int j = 0; j < 4; ++j) ss += x0[bj][j] * x0[bj][j] + x1[bj][j] * x1[bj][j]; } }
            if (l < NL - 1) { ss += __shfl_xor(ss, 16); ss += __shfl_xor(ss, 32); if (fq == 0) p.sumsq()[(size_t)((l + 1) & 1) * T * 16 + (size_t)row * 16 + u.pn * 4 + wc] = ss; } }
    }
};
__device__ __forceinline__ void phase_out(const Params& p, int l, char* shm) {
    pg8::RowOrder S{4, 512, GDIM(), BID()};
    pg8::Gemm g{p.merged(), p.wt_o() + (size_t)l * 1024 * 1024, T, 1024, 1024};
    EpiOut E{p, l};
    pg8::gemm_phase((PG8_LAS unsigned char*)shm, g, S, E);
}

enum { PH_PREP0 = 0, PH_IN, PH_MIX, PH_IDX, PH_SEL, PH_ATTN, PH_MERGE, PH_OUT };
template <int PH> __global__ __launch_bounds__(NTHR) void k_phase(Params p, int l, int b) {
    extern __shared__ __attribute__((aligned(16))) char shm[];
    if (PH == PH_PREP0) phase_prep0(p, shm);
    if (PH == PH_IN) phase_in(p, l, shm);
    if (PH == PH_MIX) phase_mix(p, l);
    if (PH == PH_IDX) phase_indexer(p, b, p.scores(), shm);
    if (PH == PH_SEL) phase_select(p, b, shm, p.scores());
    if (PH == PH_ATTN) phase_attn(p, shm);
    if (PH == PH_MERGE) phase_merge(p, l, shm);
    if (PH == PH_OUT) phase_out(p, l, shm);
}

#define XB_TMO      128
#define XB_XCNT(j)  (256  + 64 * (j))
#define XB_XSUB(j)  (1280 + 64 * (j))
#define XB_XGEN(j)  (2304 + 64 * (j))
#define XB_TOP      3328
#define XB_TOPGEN   3392
#define XCD_BAR_WORDS 3456
#define XB_SPIN_CAP (1u << 22)
#define LAS __attribute__((address_space(3)))
__device__ __forceinline__ unsigned xb_ld(unsigned* p)              { return __hip_atomic_load(p, __ATOMIC_RELAXED, __HIP_MEMORY_SCOPE_AGENT); }
__device__ __forceinline__ unsigned xb_add(unsigned* p, unsigned v) { return __hip_atomic_fetch_add(p, v, __ATOMIC_RELAXED, __HIP_MEMORY_SCOPE_AGENT); }
__device__ __forceinline__ unsigned xb_xcc_id() { return (unsigned)__builtin_amdgcn_s_getreg((3 << 11) | 20) & 0xFu; }
#define XB_SPIN(cond, bar) do { unsigned _sp = 0; while (cond) { __builtin_amdgcn_s_sleep(1); \
    if ((++_sp & 255u) == 0u) { if (xb_ld(&(bar)[XB_TMO])) break; if (_sp > XB_SPIN_CAP) { atomicAdd(&(bar)[XB_TMO], 1u); break; } } } } while (0)
struct XcdBarrier { unsigned* bar; unsigned x; volatile LAS unsigned* st; };
__device__ __forceinline__ XcdBarrier xcd_barrier_post(unsigned* bar, volatile LAS unsigned* st) {
    XcdBarrier b; b.bar = bar; b.x = xb_xcc_id(); b.st = st;
    if (threadIdx.x == 0) (void)xb_add(&bar[XB_XCNT(b.x)], 1u);
    return b;
}
__device__ __forceinline__ void xcd_barrier_complete(unsigned* bar, unsigned x, unsigned& nloc, unsigned& nx) {
    const unsigned G = gridDim.x * gridDim.y * gridDim.z;
    unsigned sum, cnt, mine, sp = 0u;
    for (;;) {
        sum = 0u; cnt = 0u; mine = 0u;
#pragma unroll
        for (unsigned j = 0; j < 16; ++j) { const unsigned c = xb_ld(&bar[XB_XCNT(j)]); sum += c; cnt += (c > 0u) ? 1u : 0u; mine = (j == x) ? c : mine; }
        if (sum == G) break;
        __builtin_amdgcn_s_sleep(1);
        if ((++sp & 255u) == 0u) { if (xb_ld(&bar[XB_TMO])) break; if (sp > XB_SPIN_CAP) { atomicAdd(&bar[XB_TMO], 1u); break; } }
    }
    nloc = mine > 0u ? mine : 1u; nx = cnt > 0u ? cnt : 1u;
}
__device__ __forceinline__ void xcd_barrier(const XcdBarrier& b) {
    asm volatile("s_waitcnt vmcnt(0)" ::: "memory");
    __syncthreads();
    if (threadIdx.x == 0) {
        unsigned* bar = b.bar;
        __builtin_amdgcn_s_waitcnt(0);
        unsigned nloc = b.st[0], nx = b.st[1];
        if (nloc == 0u) { xcd_barrier_complete(bar, b.x, nloc, nx); b.st[0] = nloc; b.st[1] = nx; }
        const unsigned old = xb_add(&bar[XB_XSUB(b.x)], 1u);
        const unsigned gen = old / nloc;
        if (old + 1u == (gen + 1u) * nloc) {
            __builtin_amdgcn_fence(__ATOMIC_RELEASE, "agent");
            asm volatile("s_waitcnt vmcnt(0)" ::: "memory");
            const unsigned og = xb_add(&bar[XB_TOP], 1u);
            const unsigned tg = og / nx;
            if (og + 1u == (tg + 1u) * nx) xb_add(&bar[XB_TOPGEN], 1u);
            else XB_SPIN(xb_ld(&bar[XB_TOPGEN]) == tg, bar);
            __builtin_amdgcn_fence(__ATOMIC_ACQUIRE, "agent");
            xb_add(&bar[XB_XGEN(b.x)], 1u);
            asm volatile("s_waitcnt vmcnt(0)" ::: "memory");
        } else {
            XB_SPIN(xb_ld(&bar[XB_XGEN(b.x)]) == gen, bar);
            __builtin_amdgcn_fence(__ATOMIC_ACQUIRE, "agent");
            asm volatile("s_waitcnt vmcnt(0)" ::: "memory");
        }
    }
    __syncthreads();
}

#if MEGA
typedef const __attribute__((address_space(4))) Params* kparams_t;
__device__ __forceinline__ Params load_params(kparams_t k) {
    Params q; q.x_in = k->x_in; q.norm_g = k->norm_g; q.w_in = k->w_in; q.conv_w = k->conv_w; q.w_out_conv = k->w_out_conv; q.q_g = k->q_g; q.k_g = k->k_g; q.w_out_attn = k->w_out_attn;
    q.pool_w = k->pool_w; q.pool_scale = k->pool_scale; q.w_out_pool = k->w_out_pool; q.w_o = k->w_o; q.x = k->x; q.ws = k->ws; return q; }
#define PHP(q) kparams_t kq_##q = kp; asm volatile("" : "+s"(kq_##q)); const Params q = load_params(kq_##q);
__global__ __launch_bounds__(NTHR) void k_mega(Params p_unused) {
    extern __shared__ __attribute__((aligned(16))) char shm[];
    cg::grid_group grid = cg::this_grid();
    kparams_t kp = (kparams_t)__builtin_amdgcn_kernarg_segment_ptr();
    __shared__ uint4 xb_words;
    if (threadIdx.x == 0) xb_words = make_uint4(0u, 0u, 0u, 0u);
    __syncthreads();
    const XcdBarrier xb = xcd_barrier_post((unsigned*)(kp->ws + WS_BAR), (volatile LAS unsigned*)&xb_words);

#ifndef SK_PREP
        { PHP(p) phase_prep0(p, shm); }
#endif
#ifdef DUP_PREP
        { PHP(p) phase_prep0(p, shm); }
#endif

    grid.sync();
    for (int l = 0; l < NL; ++l) {

#ifndef SK_IN
        { PHP(p) phase_in(p, l, shm); }
#endif
#ifdef DUP_IN
        { PHP(p) phase_in(p, l, shm); }
#endif

        xcd_barrier(xb);

        { PHP(p) phase_mix(p, l); phase_indexer(p, 0, p.scores(), shm); }
        xcd_barrier(xb);
        { PHP(p) phase_indexer(p, 1, p.scores2(), shm); phase_select(p, 0, shm, p.scores()); }
        xcd_barrier(xb);
        { PHP(p) phase_indexer(p, 2, p.scores(), shm); phase_select(p, 1, shm, p.scores2()); }
        xcd_barrier(xb);
        { PHP(p) phase_indexer(p, 3, p.scores2(), shm); phase_select(p, 2, shm, p.scores()); }
        xcd_barrier(xb);
        { PHP(p) phase_select(p, 3, shm, p.scores2()); }
        xcd_barrier(xb);
#ifndef SK_ATTN
        { PHP(p) phase_attn(p, shm); }
#endif
#ifdef DUP_ATTN
        { PHP(p) phase_attn(p, shm); }
#endif

        xcd_barrier(xb);

#ifndef SK_MERGE
        { PHP(p) phase_merge(p, l, shm); }
#endif
#ifdef DUP_MERGE
        { PHP(p) phase_merge(p, l, shm); }
#endif

        xcd_barrier(xb);

#ifndef SK_OUT
        { PHP(p) phase_out(p, l, shm); }
#endif

        xcd_barrier(xb);
    }
}
#endif

static Params make_params(void* const* d_in, void* d_out, void* d_ws) {
    Params p{};
    p.x_in = (const float*)d_in[0]; p.norm_g = (const float*)d_in[1]; p.w_in = (const float*)d_in[2]; p.conv_w = (const float*)d_in[3];
    p.w_out_conv = (const float*)d_in[4]; p.q_g = (const float*)d_in[5]; p.k_g = (const float*)d_in[6]; p.w_out_attn = (const float*)d_in[7];
    p.pool_w = (const float*)d_in[8]; p.pool_scale = (const float*)d_in[9]; p.w_out_pool = (const float*)d_in[10]; p.w_o = (const float*)d_in[11];
    p.x = (float*)d_out; p.ws = (char*)d_ws;
    return p;
}

extern "C" void kernel_launch(void* const* d_in, const int* in_sizes, int n_in, void* d_out, int out_size, void* d_ws, size_t ws_size, hipStream_t stream) {
    if (ws_size < WS_NEEDED) { fprintf(stderr, "workspace too small: %zu < %zu\n", ws_size, (size_t)WS_NEEDED); return; }
    Params p = make_params(d_in, d_out, d_ws);
    static int grid = 0;
    if (!grid) { int dev = 0, cus = 0; hipGetDevice(&dev); hipDeviceGetAttribute(&cus, hipDeviceAttributeMultiprocessorCount, dev); if (cus <= 0 || cus > 256) cus = 256; grid = (cus / 8) * 8; }
#if MEGA
    static bool attr = false;
    if (!attr) { hipFuncSetAttribute((const void*)k_mega, hipFuncAttributeMaxDynamicSharedMemorySize, LDS_BYTES); attr = true; }
    hipMemsetAsync((char*)d_ws + WS_BAR, 0, 16384, stream);
    void* args[] = {&p};
    hipError_t e = hipLaunchCooperativeKernel((void*)k_mega, dim3(grid), dim3(NTHR), args, LDS_BYTES, stream);
    if (e != hipSuccess) fprintf(stderr, "cooperative launch failed: %s\n", hipGetErrorString(e));
#else
    static bool attr = false;
    if (!attr) {
        hipFuncSetAttribute((const void*)k_phase<PH_PREP0>, hipFuncAttributeMaxDynamicSharedMemorySize, LDS_BYTES);
        hipFuncSetAttribute((const void*)k_phase<PH_IN>, hipFuncAttributeMaxDynamicSharedMemorySize, LDS_BYTES);
        hipFuncSetAttribute((const void*)k_phase<PH_MIX>, hipFuncAttributeMaxDynamicSharedMemorySize, LDS_BYTES);
        hipFuncSetAttribute((const void*)k_phase<PH_IDX>, hipFuncAttributeMaxDynamicSharedMemorySize, LDS_BYTES);
        hipFuncSetAttribute((const void*)k_phase<PH_SEL>, hipFuncAttributeMaxDynamicSharedMemorySize, LDS_BYTES);
        hipFuncSetAttribute((const void*)k_phase<PH_ATTN>, hipFuncAttributeMaxDynamicSharedMemorySize, LDS_BYTES);
        hipFuncSetAttribute((const void*)k_phase<PH_MERGE>, hipFuncAttributeMaxDynamicSharedMemorySize, LDS_BYTES);
        hipFuncSetAttribute((const void*)k_phase<PH_OUT>, hipFuncAttributeMaxDynamicSharedMemorySize, LDS_BYTES);
        attr = true;
    }
#define LAUNCH(PH, l, b) hipLaunchKernelGGL(k_phase<PH>, dim3(grid), dim3(NTHR), LDS_BYTES, stream, p, l, b)
    LAUNCH(PH_PREP0, 0, 0);
    for (int l = 0; l < NL; ++l) {
        LAUNCH(PH_IN, l, 0);
        LAUNCH(PH_MIX, l, 0);
        for (int b = 0; b < NBATCH; ++b) { LAUNCH(PH_IDX, l, b); LAUNCH(PH_SEL, l, b); }
        LAUNCH(PH_ATTN, l, 0);
        LAUNCH(PH_MERGE, l, 0);
        LAUNCH(PH_OUT, l, 0);
    }
#endif
}
```

```cpp
#include <hip/hip_runtime.h>
#include <hip/hip_cooperative_groups.h>
#include <stdint.h>
#include <stdio.h>
namespace cg = cooperative_groups;

typedef unsigned short u16;
typedef unsigned long long u64;
typedef __attribute__((ext_vector_type(8))) short bf16x8;
typedef __attribute__((ext_vector_type(4))) short s16x4;
typedef __attribute__((ext_vector_type(4))) float f32x4;
typedef __attribute__((ext_vector_type(16))) float f32x16;
typedef __attribute__((ext_vector_type(4))) unsigned u32x4;
typedef __attribute__((ext_vector_type(2))) unsigned u32x2;

#ifndef MEGA
#define MEGA 1
#endif
__device__ __forceinline__ int TID() { int t = threadIdx.x; asm volatile("" : "+v"(t)); return t; }
__device__ __forceinline__ int BID() { int t = blockIdx.x; asm volatile("" : "+s"(t)); return t; }
__device__ __forceinline__ int GDIM() { int t = gridDim.x; asm volatile("" : "+s"(t)); return t; }

constexpr int SEQ = 8192, NBATCH = 4, T = NBATCH * SEQ, DMODEL = 1024, NL = 4, INW = 8776;
constexpr int NPA = 5888;
constexpr int NTHR = 512;
constexpr int LDS_BYTES = 131072;
constexpr float RMS_EPS = 1e-6f;

struct Params {
    const float *x_in, *norm_g, *w_in, *conv_w, *w_out_conv, *q_g, *k_g, *w_out_attn, *pool_w, *pool_scale, *w_out_pool, *w_o;
    float* x; char* ws;
    __device__ __forceinline__ u16* xb() const { return (u16*)(ws + 0ull); }
    __device__ __forceinline__ u16* ga() const { return (u16*)(ws + 67108864ull); }
    __device__ __forceinline__ u16* q() const { return (u16*)(ws + 100663296ull); }
    __device__ __forceinline__ u16* k() const { return (u16*)(ws + 134217728ull); }
    __device__ __forceinline__ u16* v() const { return (u16*)(ws + 167772160ull); }
    __device__ __forceinline__ u16* sg() const { return (u16*)(ws + 201326592ull); }
    __device__ __forceinline__ u16* iq() const { return (u16*)(ws + 234881024ull); }
    __device__ __forceinline__ u16* sp() const { return (u16*)(ws + 268435456ull); }
    __device__ __forceinline__ u16* z() const { return (u16*)(ws + 301989888ull); }
    __device__ __forceinline__ u16* u() const { return (u16*)(ws + 335544320ull); }
    __device__ __forceinline__ u16* zuspare() const { return (u16*)(ws + 369098752ull); }
    __device__ __forceinline__ u16* ik() const { return (u16*)(ws + 371195904ull); }
    __device__ __forceinline__ float* iw() const { return (float*)(ws + 375390208ull); }
    __device__ __forceinline__ u16* wt_in() const { return (u16*)(ws + 376438784ull); }
    __device__ __forceinline__ u16* wt_mg() const { return (u16*)(ws + 424673280ull); }
    __device__ __forceinline__ u16* wt_oa() const { return (u16*)(ws + 449839104ull); }
    __device__ __forceinline__ u16* wt_ob() const { return (u16*)(ws + 454033408ull); }
    __device__ __forceinline__ u16* wt_oc() const { return (u16*)(ws + 458227712ull); }
    __device__ __forceinline__ u16* wt_o() const { return (u16*)(ws + 462422016ull); }
    __device__ __forceinline__ float* ropec() const { return (float*)(ws + 470810624ull); }
    __device__ __forceinline__ float* ropes() const { return (float*)(ws + 471859200ull); }
    __device__ __forceinline__ float* sumsq() const { return (float*)(ws + 472907776ull); }
    __device__ __forceinline__ u64* mask() const { return (u64*)(ws + 477102080ull); }
    __device__ __forceinline__ u16* scores() const { return (u16*)(ws + 494403584ull); }
    __device__ __forceinline__ u16* scores2() const { return z(); }
    __device__ __forceinline__ u16* stash() const { return scores(); }
    __device__ __forceinline__ u16* merged() const { return q(); }
    __device__ __forceinline__ u16* bin() const { return iq(); }
};
constexpr size_t WS_BAR = 563609600ull;
constexpr size_t WS_NEEDED = WS_BAR + 16384;


__device__ __forceinline__ unsigned cvtpk(float lo, float hi) { unsigned r; asm("v_cvt_pk_bf16_f32 %0, %1, %2" : "=v"(r) : "v"(lo), "v"(hi)); return r; }
__device__ __forceinline__ u16 f2bf(float f) { return (u16)(cvtpk(f, 0.f) & 0xffffu); }
__device__ __forceinline__ float bf2f(u16 b) { return __uint_as_float(((unsigned)b) << 16); }
__device__ __forceinline__ float bflo(unsigned w) { return __uint_as_float(w << 16); }
__device__ __forceinline__ float bfhi(unsigned w) { return __uint_as_float(w & 0xffff0000u); }
__device__ __forceinline__ float siluf(float x) { return x * __builtin_amdgcn_rcpf(1.f + __builtin_amdgcn_exp2f(x * -1.4426950408889634f)); }
__device__ __forceinline__ float sigmf(float x) { return __builtin_amdgcn_rcpf(1.f + __builtin_amdgcn_exp2f(x * -1.4426950408889634f)); }

__device__ __forceinline__ float row_rstd(const float* ssp, int row) {
    const f32x4* q = (const f32x4*)(ssp + (size_t)row * 16);
    const f32x4 a = q[0], b = q[1], c = q[2], d = q[3];
    const float s = ((a[0] + a[1]) + (a[2] + a[3])) + ((b[0] + b[1]) + (b[2] + b[3])) + ((c[0] + c[1]) + (c[2] + c[3])) + ((d[0] + d[1]) + (d[2] + d[3]));
    return __builtin_amdgcn_rsqf(s * (1.f / 1024.f) + RMS_EPS);
}
__device__ __forceinline__ int lc_of_tc(int tc) { int bj = tc >> 7, wc = (tc >> 5) & 3, n = (tc >> 4) & 1, fq = (tc >> 2) & 3, j = tc & 3; return ((wc * 4 + fq) << 4) + bj * 8 + n * 4 + j; }
__device__ __forceinline__ int tc_of_lc(int lc) { int cl = lc >> 4, s = lc & 15, wc = cl >> 2, fq = cl & 3, bj = s >> 3, n = (s >> 2) & 1, j = s & 3; return bj * 128 + wc * 32 + n * 16 + fq * 4 + j; }

__device__ __forceinline__ int src_col_in(int np) {
    int pn = np >> 8, tc = np & 255;
    int bj = tc >> 7, wc = (tc >> 5) & 3, n = (tc >> 4) & 1, fq = (tc >> 2) & 3, j = tc & 3, cl = wc * 4 + fq, s = bj * 8 + n * 4 + j, lc = cl * 16 + s;
    int d = (s < 8) ? (8 * fq + s) : (8 * fq + 32 + (s - 8));
    if (pn < 8) return (s & 3) * 512 + pn * 64 + cl * 4 + (s >> 2);
    if (pn < 12) { int which = (pn - 8) >> 1, head = ((pn - 8) & 1) * 4 + wc; return 2048 + which * 512 + head * 64 + d; }
    if (pn < 14) return 3072 + (pn - 12) * 256 + lc;
    if (pn < 16) return 3584 + (pn - 14) * 256 + lc;
    if (pn < 18) { int head = (pn - 16) * 4 + wc; return 4096 + head * 64 + d; }
    if (pn == 18) { if (wc == 0) return 4608 + d; if (wc == 1 && fq == 0 && s < 8) return 4672 + s; return -1; }
    if (pn < 21) return -2;
    return 5192 + (pn - 21) * 256 + lc;
}

__device__ __forceinline__ void prep_x(const Params& p) {
    const int tid_ = TID(); const int lane = tid_ & 63, gw = BID() * (NTHR / 64) + (tid_ >> 6), nw = GDIM() * (NTHR / 64);
    for (int row0 = gw * 4; row0 < T; row0 += nw * 4) {
        float4 v[4][4];
#pragma unroll
        for (int r = 0; r < 4; ++r)
#pragma unroll
            for (int i = 0; i < 4; ++i) v[r][i] = ((const float4*)(p.x_in + (size_t)(row0 + r) * DMODEL))[i * 64 + lane];
        float ss[4];
#pragma unroll
        for (int r = 0; r < 4; ++r) { ss[r] = 0.f;
#pragma unroll
            for (int i = 0; i < 4; ++i) { const float4 q = v[r][i]; ss[r] += q.x * q.x + q.y * q.y + q.z * q.z + q.w * q.w;
                u32x2 o; o[0] = cvtpk(q.x, q.y); o[1] = cvtpk(q.z, q.w);
                *(u32x2*)(p.xb() + (size_t)(row0 + r) * DMODEL + (i * 64 + lane) * 4) = o; } }
#pragma unroll
        for (int m = 32; m >= 1; m >>= 1) {
#pragma unroll
            for (int r = 0; r < 4; ++r) ss[r] += __shfl_xor(ss[r], m); }
        if (lane < 16) {
#pragma unroll
            for (int r = 0; r < 4; ++r) p.sumsq()[(size_t)(row0 + r) * 16 + lane] = (lane == 0) ? ss[r] : 0.f; }
    }
}
__device__ __forceinline__ void prep_rope(const Params& p) {
    const int i0 = BID() * NTHR + TID(), istep = GDIM() * NTHR;
    for (int i = i0; i < SEQ * 32; i += istep) {
        int pos = i >> 5, j = i & 31;
        float inv = 1.0f / powf(10000.0f, (float)(2 * j) / 64.0f);
        float ang = (float)pos * inv;
        p.ropec()[i] = cosf(ang); p.ropes()[i] = sinf(ang);
    }
}
__device__ __forceinline__ void prep_wt(const float* src, int lds_, const float* scale, u16* dst, int K, int NP, int mode, float* tile) {
    const int tid_ = TID(); const int tx = tid_ & 63, ty = tid_ >> 6; const int bid_ = BID(), gdim_ = GDIM();
    const int ntn = NP / 64, ntk = K / 64;
    for (int t = bid_; t < ntn * ntk; t += gdim_) {
        const int n0 = (t / ntk) * 64, k0 = (t % ntk) * 64;
        int np = n0 + tx, col;
        if (mode == 0) col = src_col_in(np);
        else if (mode == 1) col = 5704 + (np & ~255) + lc_of_tc(np & 255);
        else col = (np & ~255) + lc_of_tc(np & 255);
        __syncthreads();
#pragma unroll
        for (int i = 0; i < 8; ++i) { int kk = ty + 8 * i; tile[kk * 65 + tx] = (col >= 0) ? src[(size_t)(k0 + kk) * lds_ + col] : 0.f; }
        __syncthreads();
        const float sc = scale ? scale[k0 + tx] : 1.f;
#pragma unroll
        for (int i = 0; i < 8; ++i) {
            int nn = ty + 8 * i; int npo = n0 + nn;
            bool skip = (mode == 0) && ((npo >> 8) == 19 || (npo >> 8) == 20);
            if (!skip) dst[(size_t)npo * K + k0 + tx] = f2bf(tile[tx * 65 + nn] * sc);
        }
    }
}
__device__ __forceinline__ void prep_fold(const float* win, const float* ng, const float* pw, u16* wt_in) {
    const int i0 = BID() * NTHR + TID(), istep = GDIM() * NTHR;
    for (int i = i0; i < 1024 * 512; i += istep) {
        int k = i >> 9, n = i & 511, g = n >> 7, d = n & 127;
        const float* wr = win + (size_t)k * INW + 4680 + g * 128;
        const float* pp = pw + (size_t)g * 128 * 128 + d;
        float acc = 0.f;
        for (int c = 0; c < 128; ++c) acc += wr[c] * pp[c * 128];
        int row = (19 + (n >> 8)) * 256 + tc_of_lc(n & 255);
        wt_in[(size_t)row * 1024 + k] = f2bf(acc * ng[k]);
    }
}
__device__ __forceinline__ void phase_prep0(const Params& p, char* shm) {
    prep_x(p); prep_rope(p);
    float* tile = (float*)shm;
    for (int l = 0; l < NL; ++l) {
        const float* ng = p.norm_g + l * 1024;
        const float* win = p.w_in + (size_t)l * 1024 * INW;
        prep_wt(win, INW, ng, p.wt_in() + (size_t)l * NPA * 1024, 1024, NPA, 0, tile);
        prep_wt(win, INW, ng, p.wt_mg() + (size_t)l * 3072 * 1024, 1024, 3072, 1, tile);
        prep_wt(p.w_out_conv + (size_t)l * 512 * 1024, 1024, nullptr, p.wt_oa() + (size_t)l * 1024 * 512, 512, 1024, 2, tile);
        prep_wt(p.w_out_attn + (size_t)l * 512 * 1024, 1024, nullptr, p.wt_ob() + (size_t)l * 1024 * 512, 512, 1024, 2, tile);
        prep_wt(p.w_out_pool + (size_t)l * 512 * 1024, 1024, nullptr, p.wt_oc() + (size_t)l * 1024 * 512, 512, 1024, 2, tile);
        prep_wt(p.w_o + (size_t)l * 1024 * 1024, 1024, nullptr, p.wt_o() + (size_t)l * 1024 * 1024, 1024, 1024, 3, tile);
        prep_fold(win, ng, p.pool_w + (size_t)l * 4 * 128 * 128, p.wt_in() + (size_t)l * NPA * 1024);
    }
}

namespace pg8 {
#define PG8_LAS __attribute__((address_space(3)))
typedef unsigned short bf16_t;
constexpr int BM = 256, BK = 64, HALF = 128, HTB = HALF * BK * 2, STAGE_BYTES = 8 * HTB;
__device__ __forceinline__ int lds_byte(int r, int c) { const int st = (r >> 4) * 2 + (c >> 5), rr = r & 15, cc = c & 31, ob = rr * 64 + cc * 2; return st * 1024 + (ob ^ (((ob >> 9) & 1) << 5)); }
__device__ __forceinline__ void stage_rc(int b, int& R, int& C) { const int st = b / 1024, sb = b % 1024, swz = sb ^ (((sb >> 9) & 1) << 5); R = (st >> 1) * 16 + swz / 64; C = (st & 1) * 32 + (swz % 64) / 2; }
struct Unit { int pm, pn; };
struct Gemm { const bf16_t* A; const bf16_t* Bt; int M, N, K; };
constexpr int NXCD = 8, WGM = 8;
struct StaticOrder {
    int nM, nN, nwg, G, c;
    __device__ void init(int M, int N, int G_, int c_) { nM = M / BM; nN = N / BM; nwg = nM * nN; G = G_; c = c_; }
    __device__ bool next(int i, Unit& u) const {
        const long L = (long)i * G + c; if (L >= nwg) return false;
        int wgid = (int)L; { const int q = nwg / NXCD, r = nwg % NXCD, xcd = wgid % NXCD, off = wgid / NXCD; wgid = (xcd < r ? xcd * (q + 1) : r * (q + 1) + (xcd - r) * q) + off; }
        const int nig = WGM * nN, gid = wgid / nig, fm = gid * WGM, gsz = (nM - fm) < WGM ? (nM - fm) : WGM;
        u.pm = fm + ((wgid % nig) % gsz); u.pn = (wgid % nig) / gsz; return true;
    }
};
struct RowOrder {
    int nN, ntile, G, c;
    __device__ bool next(int i, Unit& u) const {
        const int x = c & 7, lt = (c >> 3) + (G >> 3) * i;
        const int quad = lt >> 2, pm = quad * 8 + x;
        if (pm * 4 >= ntile) return false;
        u.pm = pm; u.pn = lt & 3; return true; }
};
template <class Epi, class Sched>
__device__ __forceinline__ void gemm_phase(PG8_LAS unsigned char* lds, const Gemm g, const Sched& S, const Epi& E) {
    const int tid = TID(), wid = __builtin_amdgcn_readfirstlane(tid >> 6), lane = tid & 63, wr = wid >> 2, wc = wid & 3, fr = lane & 15, fq = lane >> 4;
    const int K = g.K, nt = K / BK;
    unsigned voffA[2], voffB[2];
#pragma unroll
    for (int i = 0; i < 2; ++i) { int R, C; stage_rc(tid * 16 + i * 8192, R, C); voffA[i] = (unsigned)(R * K + C) * 2u; voffB[i] = voffA[i]; }
    const size_t kstep = (size_t)(BK * 2);
    const size_t hstep = (size_t)HALF * K * 2;
    const size_t tstep = 2 * hstep;
    const unsigned ldsw = (unsigned)wid * 1024u;
    const int aoff = lds_byte(wr * 64 + fr, fq * 8), boff = lds_byte(wc * 32 + fr, fq * 8);
#define PG8_SA(b, h) (((b) * 2 + (h)) * HTB)
#define PG8_SB(b, h) ((4 + (b) * 2 + (h)) * HTB)
#define PG8_STAGE(bufoff, gbase, voff) do { _Pragma("unroll") for (int _i = 0; _i < 2; ++_i) \
        __builtin_amdgcn_global_load_lds((const unsigned*)((const char*)(gbase) + (voff)[_i]), (PG8_LAS unsigned*)(lds + (bufoff) + ldsw + _i * 8192), 16, 0, 0); } while (0)
#define PG8_LDA(dst, b, h) do { _Pragma("unroll") for (int m = 0; m < 4; ++m) _Pragma("unroll") for (int k = 0; k < 2; ++k) dst[m][k] = *(const PG8_LAS bf16x8*)(lds + PG8_SA(b, h) + aoff + m * 2048 + k * 1024); } while (0)
#define PG8_LDB(dst, b, h) do { _Pragma("unroll") for (int n = 0; n < 2; ++n) _Pragma("unroll") for (int k = 0; k < 2; ++k) dst[n][k] = *(const PG8_LAS bf16x8*)(lds + PG8_SB(b, h) + boff + n * 2048 + k * 1024); } while (0)
#define PG8_MMA(ai, bj, At, Bt) do { __builtin_amdgcn_s_setprio(1); _Pragma("unroll") for (int m = 0; m < 4; ++m) _Pragma("unroll") for (int n = 0; n < 2; ++n) _Pragma("unroll") for (int k = 0; k < 2; ++k) \
        acc[ai][bj][m][n] = __builtin_amdgcn_mfma_f32_16x16x32_bf16(Bt[n][k], At[m][k], acc[ai][bj][m][n], 0, 0, 0); __builtin_amdgcn_s_setprio(0); } while (0)
#define PG8_WAIT_V(n) asm volatile("s_waitcnt vmcnt(" #n ")" ::: "memory")
#define PG8_WAIT_L(n) asm volatile("s_waitcnt lgkmcnt(" #n ")" ::: "memory")
#define PG8_BAR __builtin_amdgcn_s_barrier()
#define PG8_SCHED __builtin_amdgcn_sched_barrier(0)
    Unit cur, nxt; int ui = 0;
    if (!S.next(0, cur)) return;
    f32x4 acc[2][2][4][2];
#pragma unroll
    for (int a = 0; a < 2; ++a)
#pragma unroll
        for (int b = 0; b < 2; ++b)
#pragma unroll
            for (int m = 0; m < 4; ++m)
#pragma unroll
                for (int n = 0; n < 2; ++n) acc[a][b][m][n] = (f32x4){0.f, 0.f, 0.f, 0.f};
    bf16x8 At[4][2], B0[2][2], B1[2][2];
    const char* cA = (const char*)g.A + (size_t)cur.pm * tstep; const char* cB = (const char*)g.Bt + (size_t)cur.pn * tstep;
    PG8_STAGE(PG8_SB(0, 0), cB, voffB); PG8_STAGE(PG8_SA(0, 0), cA, voffA); PG8_STAGE(PG8_SB(0, 1), cB + hstep, voffB); PG8_STAGE(PG8_SA(0, 1), cA + hstep, voffA);
    if (wr == 1) PG8_BAR;
    PG8_WAIT_V(4); PG8_BAR;
    PG8_STAGE(PG8_SB(1, 0), cB + kstep, voffB); PG8_STAGE(PG8_SA(1, 0), cA + kstep, voffA); PG8_STAGE(PG8_SB(1, 1), cB + hstep + kstep, voffB);
    PG8_WAIT_V(6); PG8_BAR;
    for (;;) {
        const bool has_next = S.next(ui + 1, nxt);
        const char* nA = has_next ? (const char*)g.A + (size_t)nxt.pm * tstep : cA; const char* nB = has_next ? (const char*)g.Bt + (size_t)nxt.pn * tstep : cB;
        for (int t = 0; t < nt; t += 2) {
            const bool last = (t == nt - 2);
            const char* a1 = cA + (size_t)(t + 1) * kstep;
            const char* a2 = last ? nA : cA + (size_t)(t + 2) * kstep; const char* b2 = last ? nB : cB + (size_t)(t + 2) * kstep;
            const char* a3 = a2 + kstep; const char* b3 = b2 + kstep;
            PG8_LDB(B0, 0, 0); PG8_SCHED; PG8_LDA(At, 0, 0); PG8_STAGE(PG8_SA(1, 1), a1 + hstep, voffA);
            PG8_WAIT_L(8); PG8_BAR; PG8_WAIT_L(0); PG8_MMA(0, 0, At, B0); PG8_BAR; PG8_SCHED;
            PG8_LDB(B1, 0, 1); PG8_STAGE(PG8_SB(0, 0), b2, voffB);
            PG8_BAR; PG8_WAIT_L(0); PG8_MMA(0, 1, At, B1); PG8_BAR;
            PG8_LDA(At, 0, 1); PG8_STAGE(PG8_SA(0, 0), a2, voffA);
            PG8_BAR; PG8_WAIT_L(0); PG8_MMA(1, 0, At, B0); PG8_BAR; PG8_SCHED;
            PG8_STAGE(PG8_SB(0, 1), b2 + hstep, voffB);
            PG8_WAIT_V(6); PG8_BAR; PG8_MMA(1, 1, At, B1); PG8_BAR;
            PG8_LDB(B0, 1, 0); PG8_SCHED; PG8_LDA(At, 1, 0); PG8_STAGE(PG8_SA(0, 1), a2 + hstep, voffA);
            PG8_WAIT_L(8); PG8_BAR; PG8_WAIT_L(0); PG8_MMA(0, 0, At, B0); PG8_BAR; PG8_SCHED;
            PG8_LDB(B1, 1, 1); PG8_STAGE(PG8_SB(1, 0), b3, voffB);
            PG8_BAR; PG8_WAIT_L(0); PG8_MMA(0, 1, At, B1); PG8_BAR;
            PG8_LDA(At, 1, 1); PG8_STAGE(PG8_SA(1, 0), a3, voffA);
            PG8_BAR; PG8_WAIT_L(0); PG8_MMA(1, 0, At, B0); PG8_BAR; PG8_SCHED;
            PG8_STAGE(PG8_SB(1, 1), b3 + hstep, voffB);
            PG8_WAIT_V(6); PG8_BAR; PG8_MMA(1, 1, At, B1); PG8_BAR;
        }
        E(acc, cur, ui, wr, wc, fr, fq);
#ifdef DUP_EPI
        if (Epi::DUPOK) E(acc, cur, ui, wr, wc, fr, fq);
#endif
        if (!has_next) break;
#pragma unroll
        for (int a = 0; a < 2; ++a)
#pragma unroll
            for (int b = 0; b < 2; ++b)
#pragma unroll
                for (int m = 0; m < 4; ++m)
#pragma unroll
                    for (int n = 0; n < 2; ++n) acc[a][b][m][n] = (f32x4){0.f, 0.f, 0.f, 0.f};
        cur = nxt; cA = nA; cB = nB; ++ui;
    }
    PG8_WAIT_V(0);
    if (wr == 0) PG8_BAR;
    PG8_BAR;
#undef PG8_SA
#undef PG8_SB
#undef PG8_STAGE
#undef PG8_LDA
#undef PG8_LDB
#undef PG8_MMA
#undef PG8_WAIT_V
#undef PG8_WAIT_L
#undef PG8_BAR
#undef PG8_SCHED
}
}
typedef f32x4 acc_t[2][2][4][2];
#define ROWS_LOOP _Pragma("unroll") for (int ai = 0; ai < 2; ++ai) _Pragma("unroll") for (int m = 0; m < 4; ++m)
#define ROW_OF (u.pm * 256 + ai * 128 + wr * 64 + m * 16 + fr)

struct EpiIn {
    static constexpr bool DUPOK = true;
    const Params& p; int l;
    __device__ __forceinline__ void operator()(const acc_t& acc, const pg8::Unit& u, int ui, int wr, int wc, int fr, int fq) const {
        const float* ssq = p.sumsq() + (size_t)(l & 1) * T * 16;
        const int pn = u.pn, cl = wc * 4 + fq;
        __shared__ float s_rstd[256];
        { const int t_ = TID(); if (t_ < 256) s_rstd[t_] = row_rstd(ssq, u.pm * 256 + t_); __syncthreads(); }
        float rsa[8];
#pragma unroll
        for (int ix = 0; ix < 8; ++ix) rsa[ix] = s_rstd[(ix >> 2) * 128 + wr * 64 + (ix & 3) * 16 + fr];
        if (pn < 8) {
            ROWS_LOOP { const int row = ROW_OF; const float rs = rsa[ai * 4 + m];
                float zz[4], gg[4];
#pragma unroll
                for (int ch = 0; ch < 4; ++ch) { const f32x4 v = acc[ai][ch >> 1][m][ch & 1]; zz[ch] = (v[1] * rs) * (v[2] * rs); gg[ch] = (v[0] * rs) * siluf(v[3] * rs); }
                const size_t o = (size_t)row * 512 + pn * 64 + cl * 4;
                u32x2 a; a[0] = cvtpk(zz[0], zz[1]); a[1] = cvtpk(zz[2], zz[3]); *(u32x2*)(p.z() + o) = a;
                u32x2 b; b[0] = cvtpk(gg[0], gg[1]); b[1] = cvtpk(gg[2], gg[3]); *(u32x2*)(p.ga() + o) = b; }
        } else if (pn < 12 || (pn >= 16 && pn <= 18)) {
            if (pn == 18 && wc >= 1) {
                if (wc == 1 && fq == 0) {
                    ROWS_LOOP { const int row = ROW_OF; const float rs = rsa[ai * 4 + m] * 0.04419417382415922f;
                        *(f32x4*)(p.iw() + (size_t)row * 8) = acc[ai][0][m][0] * rs; *(f32x4*)(p.iw() + (size_t)row * 8 + 4) = acc[ai][0][m][1] * rs; }
                }
            } else {
                const bool isqk = pn < 12; const int which = (pn - 8) >> 1;
                int head; u16* dst; int pitch;
                if (isqk) { head = ((pn - 8) & 1) * 4 + wc; dst = which ? p.k() : p.q(); pitch = 512; }
                else if (pn < 18) { head = (pn - 16) * 4 + wc; dst = p.iq(); pitch = 512; }
                else { head = 0; dst = p.ik(); pitch = 64; }
                f32x4 g0[2], g1[2];
#pragma unroll
                for (int n = 0; n < 2; ++n) { g0[n] = (f32x4){1.f, 1.f, 1.f, 1.f}; g1[n] = g0[n]; }
                if (isqk) { const float* gg = (which ? p.k_g : p.q_g) + l * 64 + 8 * fq;
#pragma unroll
                    for (int n = 0; n < 2; ++n) { g0[n] = *(const f32x4*)(gg + 4 * n); g1[n] = *(const f32x4*)(gg + 32 + 4 * n); } }
                f32x4 rcb[2], rsb[2];
                { const int pos0 = (u.pm * 256 + wr * 64 + fr) & (SEQ - 1);
#pragma unroll
                  for (int n = 0; n < 2; ++n) { rcb[n] = *(const f32x4*)(p.ropec() + pos0 * 32 + 8 * fq + 4 * n); rsb[n] = *(const f32x4*)(p.ropes() + pos0 * 32 + 8 * fq + 4 * n); } }
                ROWS_LOOP { const int row = ROW_OF; const int ix = ai * 4 + m; const float rs = rsa[ix];
                    f32x4 a0[2], a1[2];
#pragma unroll
                    for (int n = 0; n < 2; ++n) { a0[n] = acc[ai][0][m][n] * rs; a1[n] = acc[ai][1][m][n] * rs; }
                    if (isqk) { float ss = 0.f;
#pragma unroll
                        for (int n = 0; n < 2; ++n)
#pragma unroll
                            for (int j = 0; j < 4; ++j) ss += a0[n][j] * a0[n][j] + a1[n][j] * a1[n][j];
                        ss += __shfl_xor(ss, 16); ss += __shfl_xor(ss, 32);
                        const float rn = __builtin_amdgcn_rsqf(ss * (1.f / 64.f) + RMS_EPS);
#pragma unroll
                        for (int n = 0; n < 2; ++n) { a0[n] = a0[n] * rn * g0[n]; a1[n] = a1[n] * rn * g1[n]; } }
                    u32x4 o0, o1;
#pragma unroll
                    for (int n = 0; n < 2; ++n) { const f32x4 cc = rcb[n], sn = rsb[n];
                        const f32x4 r0 = a0[n] * cc - a1[n] * sn, r1 = a1[n] * cc + a0[n] * sn;
                        o0[2 * n] = cvtpk(r0[0], r0[1]); o0[2 * n + 1] = cvtpk(r0[2], r0[3]); o1[2 * n] = cvtpk(r1[0], r1[1]); o1[2 * n + 1] = cvtpk(r1[2], r1[3]); }
                    if (ix < 7) { const int posn = (u.pm * 256 + ((ix + 1) >> 2) * 128 + wr * 64 + ((ix + 1) & 3) * 16 + fr) & (SEQ - 1);
#pragma unroll
                        for (int n = 0; n < 2; ++n) { rcb[n] = *(const f32x4*)(p.ropec() + posn * 32 + 8 * fq + 4 * n); rsb[n] = *(const f32x4*)(p.ropes() + posn * 32 + 8 * fq + 4 * n); } }
                    u16* d = dst + (size_t)row * pitch + head * 64 + 8 * fq;
                    *(u32x4*)d = o0; *(u32x4*)(d + 32) = o1; }
            }
        } else {
            u16* dst; int cb; int kind;
            if (pn < 14) { dst = p.v(); cb = (pn - 12) * 256; kind = 0; }
            else if (pn < 16) { dst = p.sg(); cb = (pn - 14) * 256; kind = 1; }
            else if (pn < 21) { dst = p.u(); cb = (pn - 19) * 256; kind = 0; }
            else { dst = p.sp(); cb = (pn - 21) * 256; kind = 2; }
            f32x4 sc[2][2];
#pragma unroll
            for (int bj = 0; bj < 2; ++bj)
#pragma unroll
                for (int n = 0; n < 2; ++n) sc[bj][n] = (kind == 2) ? *(const f32x4*)(p.pool_scale + l * 512 + cb + 16 * cl + bj * 8 + n * 4) : (f32x4){1.f, 1.f, 1.f, 1.f};
            ROWS_LOOP { const int row = ROW_OF; const float rs = rsa[ai * 4 + m];
#pragma unroll
                for (int bj = 0; bj < 2; ++bj) { f32x4 v0 = acc[ai][bj][m][0] * rs, v1 = acc[ai][bj][m][1] * rs;
                    if (kind >= 1) {
#pragma unroll
                        for (int j = 0; j < 4; ++j) { v0[j] = siluf(v0[j]) * sc[bj][0][j]; v1[j] = siluf(v1[j]) * sc[bj][1][j]; } }
                    u32x4 w; w[0] = cvtpk(v0[0], v0[1]); w[1] = cvtpk(v0[2], v0[3]); w[2] = cvtpk(v1[0], v1[1]); w[3] = cvtpk(v1[2], v1[3]);
                    *(u32x4*)(dst + (size_t)row * 512 + cb + 16 * cl + bj * 8) = w; } }
        }
    }
};
__device__ __forceinline__ void phase_in(const Params& p, int l, char* shm) {
    pg8::Gemm g{p.xb(), p.wt_in() + (size_t)l * NPA * 1024, T, NPA, 1024};
    pg8::StaticOrder S; S.init(T, NPA, GDIM(), BID());
    EpiIn E{p, l};
    pg8::gemm_phase((PG8_LAS unsigned char*)shm, g, S, E);
}
__device__ __forceinline__ void phase_mix(const Params& p, int l) {
    const float* cw = p.conv_w + l * 3 * 512;
    constexpr int RUN = 16;
    const int nitem = (T / RUN) * 256;
    const int it0 = BID() * NTHR + TID(), itstep = GDIM() * NTHR;
    for (int it = it0; it < nitem; it += itstep) {
        const int cp = it & 255, c = cp * 2, t0 = (it >> 8) * RUN, pos0 = t0 & (SEQ - 1);
        {
            const float w00 = cw[c], w01 = cw[c + 1], w10 = cw[512 + c], w11 = cw[513 + c], w20 = cw[1024 + c], w21 = cw[1025 + c];
            unsigned zr[RUN + 2], gr[RUN];
#pragma unroll
            for (int i = 0; i < RUN + 2; ++i) zr[i] = (pos0 + i - 2 >= 0) ? *(const unsigned*)(p.z() + (size_t)(t0 + i - 2) * 512 + c) : 0u;
#pragma unroll
            for (int i = 0; i < RUN; ++i) gr[i] = *(const unsigned*)(p.ga() + (size_t)(t0 + i) * 512 + c);
#pragma unroll
            for (int i = 0; i < RUN; ++i) {
                const float y0 = (w00 * bflo(zr[i]) + w10 * bflo(zr[i + 1]) + w20 * bflo(zr[i + 2])) * bflo(gr[i]);
                const float y1 = (w01 * bfhi(zr[i]) + w11 * bfhi(zr[i + 1]) + w21 * bfhi(zr[i + 2])) * bfhi(gr[i]);
                *(unsigned*)(p.ga() + (size_t)(t0 + i) * 512 + c) = cvtpk(y0, y1);
            }
        }
        {
            const int win = 2 << (c >> 7);
            unsigned ur[RUN + 15], gr[RUN];
#pragma unroll
            for (int i = 0; i < RUN + 15; ++i) ur[i] = (i >= 16 - win && pos0 + i - 15 >= 0) ? *(const unsigned*)(p.u() + (size_t)(t0 + i - 15) * 512 + c) : 0u;
#pragma unroll
            for (int i = 0; i < RUN; ++i) gr[i] = *(const unsigned*)(p.sp() + (size_t)(t0 + i) * 512 + c);
            float s0 = 0.f, s1 = 0.f;
#pragma unroll
            for (int i = 0; i < 15; ++i) { s0 += bflo(ur[i]); s1 += bfhi(ur[i]); }
#pragma unroll
            for (int i = 0; i < RUN; ++i) {
                const int pos = pos0 + i;
                const float u0 = bflo(ur[i + 15]), u1 = bfhi(ur[i + 15]);
                s0 += u0; s1 += u1;
                const float ic = __builtin_amdgcn_rcpf((float)min(pos + 1, win));
                *(unsigned*)(p.sp() + (size_t)(t0 + i) * 512 + c) = cvtpk((s0 * ic - u0) * bflo(gr[i]), (s1 * ic - u1) * bfhi(gr[i]));
                unsigned wo = 0u;
#pragma unroll
                for (int g = 0; g < 4; ++g) if (win == (2 << g)) wo = ur[i + 15 - ((2 << g) - 1)];
                s0 -= bflo(wo); s1 -= bfhi(wo);
            }
        }
    }
}

__device__ __forceinline__ int crow(int r, int hi) { return (r & 3) + 8 * (r >> 2) + 4 * hi; }
__device__ __forceinline__ size_t sc_base(int qb) { return (size_t)32768 * qb * (qb + 1); }
__device__ __forceinline__ void phase_indexer(const Params& p, int b, u16* scbuf, char* shm) {
    const int tid_ = TID(); const int wid = tid_ >> 6, lane = tid_ & 63, ql = lane & 15, fq = lane >> 4; const int bid_ = BID(), gdim_ = GDIM();
    constexpr int NSTEP = 64 * 65;
    const int f0 = (int)(((long)bid_ * NSTEP) / gdim_), f1 = (int)(((long)(bid_ + 1) * NSTEP) / gdim_);
    int qcur = -1;
    bf16x8 bq[8][2]; float wv[8]; u16* srow = nullptr; int qloc = 0;
    char* tl = shm + 40960 + wid * 2304;
#pragma unroll
    for (int h = 0; h < 8; ++h) { wv[h] = 0.f; bq[h][0] = bq[h][1] = (bf16x8){0, 0, 0, 0, 0, 0, 0, 0}; }
    const u16* ikb = p.ik() + ((size_t)b * SEQ + ql) * 64 + fq * 8;
    for (int f = f0; f < f1; ++f) {
        int q = (int)((sqrtf(4.f * f + 1.f) - 1.f) * 0.5f);
        while ((q + 1) * (q + 2) <= f) ++q;
        while (q * (q + 1) > f) --q;
        const int tt = f - q * (q + 1);
        if (q != qcur) {
            qcur = q; qloc = q * 128 + wid * 16 + ql;
            const size_t row = (size_t)b * SEQ + qloc;
#pragma unroll
            for (int h = 0; h < 8; ++h)
#pragma unroll
                for (int kc = 0; kc < 2; ++kc) bq[h][kc] = *(const bf16x8*)(p.iq() + row * 512 + h * 64 + kc * 32 + fq * 8);
            const f32x4 x = *(const f32x4*)(p.iw() + row * 8), y = *(const f32x4*)(p.iw() + row * 8 + 4);
            wv[0] = x[0]; wv[1] = x[1]; wv[2] = x[2]; wv[3] = x[3]; wv[4] = y[0]; wv[5] = y[1]; wv[6] = y[2]; wv[7] = y[3];
            const int a = q >> 1;
            srow = scbuf + sc_base(a) + (size_t)(q * 128 + wid * 16 + (lane >> 2) - a * 256) * (256 * (a + 1)) + (lane & 3) * 16;
        }
        const int key0 = tt * 64;
        bf16x8 ka[4][2];
#pragma unroll
        for (int kg = 0; kg < 4; ++kg)
#pragma unroll
            for (int kc = 0; kc < 2; ++kc) ka[kg][kc] = *(const bf16x8*)(ikb + (size_t)(key0 + kg * 16) * 64 + kc * 32);
        const bool band = (key0 + 63 > q * 128 + wid * 16);
#pragma unroll
        for (int kg = 0; kg < 4; ++kg) {
            f32x4 sacc = (f32x4){0.f, 0.f, 0.f, 0.f};
#pragma unroll
            for (int h = 0; h < 8; ++h) {
                f32x4 c = (f32x4){0.f, 0.f, 0.f, 0.f};
                c = __builtin_amdgcn_mfma_f32_16x16x32_bf16(ka[kg][0], bq[h][0], c, 0, 0, 0);
                c = __builtin_amdgcn_mfma_f32_16x16x32_bf16(ka[kg][1], bq[h][1], c, 0, 0, 0);
#pragma unroll
                for (int j = 0; j < 4; ++j) sacc[j] = __builtin_fmaf(wv[h], __builtin_fmaxf(c[j], 0.f), sacc[j]);
            }
            const int kb = key0 + kg * 16 + fq * 4;
            if (band) {
#pragma unroll
                for (int j = 0; j < 4; ++j) if (kb + j > qloc) sacc[j] = -INFINITY;
            }
            union { _Float16 h[4]; u32x2 v; } pk;
            pk.h[0] = (_Float16)sacc[0]; pk.h[1] = (_Float16)sacc[1]; pk.h[2] = (_Float16)sacc[2]; pk.h[3] = (_Float16)sacc[3];
            *(u32x2*)(tl + ql * 144 + kg * 32 + fq * 8) = pk.v;
        }
        { const u32x4 r0 = *(const u32x4*)(tl + (lane >> 2) * 144 + (lane & 3) * 32), r1 = *(const u32x4*)(tl + (lane >> 2) * 144 + (lane & 3) * 32 + 16);
          *(u32x4*)(srow + key0) = r0; *(u32x4*)(srow + key0 + 8) = r1; }
    }
}

__device__ __forceinline__ size_t mk_base(int qb) { return (size_t)512 * qb * (qb + 1); }
constexpr size_t MASK_WORDS_PER_BATCH = 540672;
__device__ __forceinline__ unsigned f16key(unsigned h) { return (h & 0x8000u) ? (~h & 0xffffu) : (h | 0x8000u); }
__device__ __forceinline__ void hist_scan(const unsigned* h, int lane, unsigned target, int& bin, unsigned& above, unsigned& inbin) {
    const u32x4 a = *(const u32x4*)(h + 4 * lane), b = *(const u32x4*)(h + 256 + 4 * lane), c = *(const u32x4*)(h + 512 + 4 * lane), d = *(const u32x4*)(h + 768 + 4 * lane);
    const unsigned h0 = a[0] + b[0] + c[0] + d[0], h1 = a[1] + b[1] + c[1] + d[1], h2 = a[2] + b[2] + c[2] + d[2], h3 = a[3] + b[3] + c[3] + d[3];
    const unsigned tot = h0 + h1 + h2 + h3;
    unsigned x = tot;
#pragma unroll
    for (int dd = 1; dd < 64; dd <<= 1) { const unsigned y = __shfl_down(x, dd); if (lane + dd < 64) x += y; }
    const unsigned ab = x - tot, c3 = ab + h3, c2 = c3 + h2, c1 = c2 + h1, c0 = c1 + h0;
    int fb = -1; unsigned fa = 0, fc = 0;
    if (ab < target && c3 >= target) { fb = 4 * lane + 3; fa = ab; fc = h3; }
    else if (c3 < target && c2 >= target) { fb = 4 * lane + 2; fa = c3; fc = h2; }
    else if (c2 < target && c1 >= target) { fb = 4 * lane + 1; fa = c2; fc = h1; }
    else if (c1 < target && c0 >= target) { fb = 4 * lane; fa = c1; fc = h0; }
    const u64 m = __ballot(fb >= 0); const int src = (m == 0) ? 0 : (__ffsll((unsigned long long)m) - 1);
    bin = __shfl(fb, src); above = __shfl(fa, src); inbin = __shfl(fc, src);
}
__device__ __forceinline__ unsigned f16key2(unsigned w) { const unsigned sg = (w >> 15) & 0x00010001u; return w ^ (((sg << 15) - sg) | 0x80008000u); }
__device__ __forceinline__ void phase_select(const Params& p, int b, char* shm, const u16* scbuf) {
    const int tid_ = TID(); const int wid = __builtin_amdgcn_readfirstlane(tid_ >> 6), lane = tid_ & 63;
    const int gw = BID() * 8 + wid, nw = GDIM() * 8;
    unsigned* hist = (unsigned*)shm + wid * 1152;
    const int hsubi = (lane >> 4) * 256, dummyi = 1024 + lane;
    typedef unsigned short us2 __attribute__((ext_vector_type(2)));
#define ROW_T(i_) ({ const int kq_ = (i_) / nw; ((mirror && (kq_ & 1)) ? (kq_ * nw + (nw - 1 - ((i_) - kq_ * nw))) : (i_)); })
#define ROW_LOAD(t_) do { const int qb_ = (t_) >> 8, ntr_ = 2 * (((t_) >> 7) + 1), nch_ = (ntr_ + 7) >> 3; \
        const u16* sr_ = scbuf + sc_base(qb_) + (size_t)((t_) - qb_ * 256) * (256 * (qb_ + 1)); \
        _Pragma("unroll") for (int c = 0; c < 16; ++c) { raw[c] = (u32x4){0u, 0u, 0u, 0u}; if (c < nch_) { if (lane < 8 * (ntr_ - 8 * c)) raw[c] = *(const u32x4*)(sr_ + 512 * c + 8 * lane); } } } while (0)
    const bool mirror = (SEQ % (2 * nw)) == 0;
    u32x4 raw[16];
    if (gw < SEQ) { const int t0_ = ROW_T(gw); ROW_LOAD(t0_); }
    for (int i = gw; i < SEQ; i += nw) {
        const int t = ROW_T(i);
        const int qb = t >> 8, ntile = 4 * (qb + 1), ntr = 2 * ((t >> 7) + 1);
        const int nch = (ntr + 7) >> 3, nchw = (ntile + 7) >> 3;
        unsigned char* mrow = (unsigned char*)(p.mask() + (size_t)b * MASK_WORDS_PER_BATCH + mk_base(qb) + (size_t)(t - qb * 256) * ntile);
        unsigned key[16][4];
#pragma unroll
        for (int c = 0; c < 16; ++c) {
            const bool valid = (c < nch) && (lane < 8 * (ntr - 8 * c));
#pragma unroll
            for (int r = 0; r < 4; ++r) key[c][r] = valid ? f16key2(raw[c][r]) : 0u;
        }
        if (i + nw < SEQ) { const int tn_ = ROW_T(i + nw); ROW_LOAD(tn_); }
        unsigned thrm1 = 0x03ffu, thr = 0x0400u; int need = 0; bool fast = true;
        if (t >= 256) {
            us2 a1 = (us2){0, 0}, a2 = (us2){0, 0};
#pragma unroll
            for (int c = 0; c < 16; ++c) {
                if (c < nch) {
#pragma unroll
                    for (int r = 0; r < 4; ++r) { const us2 kk = __builtin_bit_cast(us2, key[c][r]);
                        const us2 tmx = __builtin_elementwise_max(a1, kk), tmn = __builtin_elementwise_min(a1, kk); a1 = tmx; a2 = __builtin_elementwise_max(a2, tmn); }
                }
            }
            unsigned Lb = min((unsigned)a2[0], (unsigned)a2[1]);
#pragma unroll
            for (int m_ = 32; m_ >= 1; m_ >>= 1) Lb = min(Lb, (unsigned)__shfl_xor((int)Lb, m_));
            Lb = __builtin_amdgcn_readfirstlane(Lb);
            const u32x4 z4 = (u32x4){0u, 0u, 0u, 0u};
#pragma unroll
            for (int c = 0; c < 4; ++c) *(u32x4*)(hist + c * 256 + 4 * lane) = z4;
#pragma unroll
            for (int c = 0; c < 16; ++c) {
                if (c < nch) {
#pragma unroll
                    for (int r = 0; r < 4; ++r) { const unsigned kk = key[c][r]; const unsigned lo = kk & 0xffffu, hi = kk >> 16;
                        atomicAdd(hist + ((lo >= Lb) ? (hsubi + (int)(lo >> 8)) : dummyi), 1u);
                        atomicAdd(hist + ((hi >= Lb) ? (hsubi + (int)(hi >> 8)) : dummyi), 1u); }
                }
            }
            asm volatile("s_waitcnt lgkmcnt(0)" ::: "memory");
            int B1; unsigned ab1, in1;
            hist_scan(hist, lane, 256u, B1, ab1, in1);
            asm volatile("s_waitcnt lgkmcnt(0)" ::: "memory");
#pragma unroll
            for (int c = 0; c < 4; ++c) *(u32x4*)(hist + c * 256 + 4 * lane) = z4;
#pragma unroll
            for (int c = 0; c < 16; ++c) {
                if (c < nch) {
#pragma unroll
                    for (int r = 0; r < 4; ++r) { const unsigned kk = key[c][r]; const unsigned lo = kk & 0xffffu, hi = kk >> 16;
                        const bool ml = ((lo >> 8) == (unsigned)B1) && (lo >= Lb), mh = ((hi >> 8) == (unsigned)B1) && (hi >= Lb);
                        if (__any(ml || mh)) { if (ml) atomicAdd(hist + hsubi + (int)(lo & 255u), 1u); if (mh) atomicAdd(hist + hsubi + (int)(hi & 255u), 1u); } }
                }
            }
            asm volatile("s_waitcnt lgkmcnt(0)" ::: "memory");
            int B2; unsigned ab2, in2;
            hist_scan(hist, lane, 256u - ab1, B2, ab2, in2);
            asm volatile("s_waitcnt lgkmcnt(0)" ::: "memory");
            thr = __builtin_amdgcn_readfirstlane(((unsigned)B1 << 8) | (unsigned)B2);
            need = __builtin_amdgcn_readfirstlane(256 - (int)(ab1 + ab2));
            const int neq = __builtin_amdgcn_readfirstlane((int)in2);
            fast = (need == neq);
            thrm1 = thr - 1u;
        }
        if (fast) {
#pragma unroll
            for (int c = 0; c < 16; ++c) {
                if (c < nchw) {
                    unsigned m = 0u;
#pragma unroll
                    for (int ii = 7; ii >= 0; --ii) { const unsigned kk = key[c][ii >> 1]; const unsigned kv = (ii & 1) ? (kk >> 16) : (kk & 0xffffu); m = m + m + ((kv > thrm1) ? 1u : 0u); }
                    if (64 * c + lane < 8 * ntile) mrow[64 * c + lane] = (unsigned char)m;
                }
            }
        } else {
            int base = 0;
#pragma unroll 1
            for (int c = 0; c < 16; ++c) {
                if (c < nchw) {
                    unsigned m = 0u, e = 0u;
#pragma unroll
                    for (int ii = 7; ii >= 0; --ii) { unsigned kk = (ii >> 1) == 0 ? key[0][0] : 0u;
#pragma unroll
                        for (int cc = 0; cc < 16; ++cc) if (cc == c) kk = key[cc][ii >> 1];
                        const unsigned kv = (ii & 1) ? (kk >> 16) : (kk & 0xffffu); m = m + m + ((kv > thr) ? 1u : 0u); e = e + e + ((kv == thr) ? 1u : 0u); }
                    const int cnt = __builtin_popcount(e);
                    int pre = cnt;
#pragma unroll
                    for (int dd = 1; dd < 64; dd <<= 1) { const int y = __shfl_up(pre, dd); if (lane >= dd) pre += y; }
                    const int tot = __shfl(pre, 63);
                    int rank = base + pre - cnt;
#pragma unroll
                    for (int ii = 0; ii < 8; ++ii) if ((e >> ii) & 1u) { if (rank < need) m |= (1u << ii); ++rank; }
                    base += tot;
                    if (64 * c + lane < 8 * ntile) mrow[64 * c + lane] = (unsigned char)m;
                }
            }
        }
    }
}

constexpr int A_D = 64, A_DM = 512, A_NW = 8, A_QBLK = 32, A_QB = 256, A_KVBLK = 64, A_NQB = SEQ / A_QB, A_NHEAD = 8;
constexpr float A_C2 = 0.125f * 1.4426950408889634f;
constexpr int A_SLOTB = 8192, A_LDS_K = 0, A_LDS_V = 3 * A_SLOTB, A_LDS_WS = 6 * A_SLOTB, A_LDS_OST = A_LDS_WS + A_NW * 256, A_LDS_MK = A_LDS_OST + A_NW * 4096, A_LDS_BYTES = A_LDS_MK + A_NW * 2048;
#define ATTN_THR 8
#define SBAR() __builtin_amdgcn_sched_barrier(0)
#define PIN(x) asm volatile("" : "+v"(x))
#define MFMA32(a, b, c) __builtin_amdgcn_mfma_f32_32x32x16_bf16(a, b, c, 0, 0, 0)
#define WAIT_BAR(N) asm volatile("s_waitcnt vmcnt(" #N ") lgkmcnt(0)\n\ts_barrier" ::: "memory")
__device__ __forceinline__ void glds16s(const void* sbase, unsigned voff, unsigned lds_base) {
    unsigned sv; asm volatile("s_mov_b32 %0, m0\n\ts_mov_b32 m0, %3\n\ts_nop 0\n\tglobal_load_lds_dwordx4 %1, %2\n\ts_mov_b32 m0, %0" : "=&s"(sv) : "v"(voff), "s"(sbase), "s"(lds_base) : "memory"); }
typedef __attribute__((address_space(3))) const char* lds_cptr;
typedef short v4i16_t __attribute__((ext_vector_type(4)));
__device__ __forceinline__ void kload2(bf16x8* kf, lds_cptr kp, int d0) { kf[2 * d0] = *(const __attribute__((address_space(3))) bf16x8*)(kp + d0 * 2048); kf[2 * d0 + 1] = *(const __attribute__((address_space(3))) bf16x8*)(kp + d0 * 2048 + 512); }
__device__ __forceinline__ s16x4 vtr(lds_cptr p) { return __builtin_bit_cast(s16x4, __builtin_amdgcn_ds_read_tr16_b64_v4i16((__attribute__((address_space(3))) v4i16_t*)p)); }
#define MX3(a, b, c) __builtin_fmaxf(__builtin_fmaxf((a), (b)), (c))
__device__ __forceinline__ float rowmax(const f32x16& p0, const f32x16& p1) {
    float a = MX3(p0[0], p0[1], p1[0]), b = MX3(p0[2], p0[3], p1[1]); a = MX3(a, p1[2], p1[3]);
#pragma unroll
    for (int r = 4; r < 16; r += 4) { a = MX3(a, p0[r], p0[r + 1]); b = MX3(b, p0[r + 2], p0[r + 3]); a = MX3(a, p1[r], p1[r + 1]); b = MX3(b, p1[r + 2], p1[r + 3]); }
    float m = __builtin_fmaxf(a, b); auto rr = __builtin_amdgcn_permlane32_swap(__float_as_uint(m), __float_as_uint(m), false, false);
    return __builtin_fmaxf(__uint_as_float(rr[0]), __uint_as_float(rr[1])); }
__device__ __forceinline__ void cmask(f32x16& p0, f32x16& p1, int jb, int qrel, int hi) {
    const int kb = 64 * jb + 4 * hi;
#pragma unroll
    for (int r = 0; r < 16; ++r) { const int kv = kb + (r & 3) + 8 * (r >> 2); if (kv > qrel) p0[r] = -INFINITY; if (kv + 32 > qrel) p1[r] = -INFINITY; } }
__device__ __forceinline__ float mand(float x, unsigned w, int pos) { return __uint_as_float(__float_as_uint(x) & (unsigned)__builtin_amdgcn_sbfe((int)w, pos, 1)); }
#define BITP(i) (((i) & 3) + 8 * ((i) >> 2))

__device__ __forceinline__ void attn64_unit(int b, int h, int qb, const u16* Q, const u16* __restrict__ K, const u16* __restrict__ V, const u16* __restrict__ SG, u16* O, const u64* mrow0, char* lds) {
    const int tid = TID(), lane = tid & 63, r32 = lane & 31, hi = lane >> 5; const int wid = __builtin_amdgcn_readfirstlane(tid >> 6);
    const long rowbase = (long)b * SEQ; const int q0 = qb * A_QB, NT = (q0 + A_QB) / A_KVBLK;
    const u16* Qw = Q + (rowbase + q0 + wid * A_QBLK) * A_DM + h * A_D;
    const unsigned lds0 = (unsigned)(uintptr_t)lds; float* wsf = (float*)(lds + A_LDS_WS) + wid * 64;
    const u16* kbase = K + rowbase * A_DM + h * A_D; const u16* vbase = V + rowbase * A_DM + h * A_D;
    const unsigned koff = (unsigned)(lane * A_DM + wid * 8) * 2u;
    const unsigned voff = (unsigned)((16 * (wid & 3) + (lane >> 2)) * A_DM + (wid >> 2) * 32 + (lane & 3) * 8) * 2u;
    const unsigned kdst = lds0 + A_LDS_K + wid * 1024, vdst = lds0 + A_LDS_V + wid * 1024;
#define DMA_K(t, slot) glds16s(kbase + (long)(t) * A_KVBLK * A_DM, koff, (unsigned)__builtin_amdgcn_readfirstlane(kdst + (slot)))
#define DMA_V(t, slot) glds16s(vbase + (long)(t) * A_KVBLK * A_DM, voff, (unsigned)__builtin_amdgcn_readfirstlane(vdst + (slot)))
#define DMA_M(chunk) glds16s(mrow0 + 2 * (chunk), moff, (unsigned)__builtin_amdgcn_readfirstlane(mdst + ((chunk) & 1) * 1024))
#define MWORD(t) (*(const u64*)(lds + A_LDS_MK + wid * 2048 + (((t) >> 1) & 1) * 1024 + r32 * 16 + ((t) & 1) * 8))
    const lds_cptr vp0 = (lds_cptr)lds + A_LDS_V + ((lane >> 4) & 1) * 32 + (lane & 3) * 8 + (4 * hi + ((lane & 15) >> 2)) * 64;
    const lds_cptr kp0 = (lds_cptr)lds + A_LDS_K + hi * 1024 + r32 * 16;
    const int qrel = wid * A_QBLK + r32;
    const unsigned moff = (unsigned)(qrel * NT) * 8u;
    const unsigned mdst = lds0 + A_LDS_MK + wid * 2048;
    DMA_M(0);
    DMA_K(0, 0); DMA_V(0, 0); DMA_K(1, A_SLOTB);
    bf16x8 qr[4];
#pragma unroll
    for (int d0 = 0; d0 < 4; ++d0) qr[d0] = *reinterpret_cast<const bf16x8*>(&Qw[(long)r32 * A_DM + d0 * 16 + hi * 8]);
    float mhat = 0.f, l_reg = 0.f; f32x16 o[2]; o[0] = f32x16{}; o[1] = f32x16{};
    const f32x16 zero16 = f32x16{};
    bool resc = false;
    f32x16 pA0, pA1, pB0, pB1; bf16x8 kf[8]; s16x4 vlo[8], vhi[8]; u32x4 pw0, pw1, pw2, pw3;
    typedef unsigned u32x16 __attribute__((ext_vector_type(16)));
    u32x16 mk0, mk1;
    int sl_prev = 0, sl_cur = 0, sl_next = A_SLOTB;
    const int sh4 = 4 * hi;
#define ROT() do { sl_prev = sl_cur; sl_cur = sl_next; sl_next = (sl_next == 2 * A_SLOTB) ? 0 : sl_next + A_SLOTB; } while (0)
#define EX(v) __builtin_amdgcn_exp2f(__builtin_fmaf((v), A_C2, nmh))
#define RESC() do { if (resc) { _Pragma("unroll") for (int d_ = 0; d_ < 2; ++d_) _Pragma("unroll") for (int r = 0; r < 16; ++r) o[d_][r] *= wsf[crow(r, hi)]; } } while (0)
    DMA_K(2, 2 * A_SLOTB);
    WAIT_BAR(3);
    _Pragma("unroll") for (int d0 = 0; d0 < 4; ++d0) kload2(kf, kp0, d0);
    pA0 = MFMA32(kf[0], qr[0], zero16); pA1 = MFMA32(kf[1], qr[0], zero16); pA0 = MFMA32(kf[2], qr[1], pA0); pA1 = MFMA32(kf[3], qr[1], pA1);
    pA0 = MFMA32(kf[4], qr[2], pA0); pA1 = MFMA32(kf[5], qr[2], pA1); pA0 = MFMA32(kf[6], qr[3], pA0); pA1 = MFMA32(kf[7], qr[3], pA1);
    { const float rm = rowmax(pA0, pA1); mhat = rm * A_C2; const float nmh = -mhat;
      const u64 mw0 = MWORD(0); const unsigned wl = (unsigned)mw0 >> sh4, wh = (unsigned)(mw0 >> 32) >> sh4;
#pragma unroll
      for (int r = 0; r < 16; ++r) { pA0[r] = mand(EX(pA0[r]), wl, BITP(r)); pA1[r] = mand(EX(pA1[r]), wh, BITP(r)); } }
    WAIT_BAR(0);
    DMA_K(3, 0); DMA_V(1, A_SLOTB); ROT();
    _Pragma("unroll") for (int d0 = 0; d0 < 4; ++d0) kload2(kf, kp0 + sl_cur, d0);
    WAIT_BAR(2);
#define PKW(P, i) cvtpk(P[i], P[i + 1])
#define PAF(k) __builtin_bit_cast(bf16x8, pw##k)
#define VFR(i) (bf16x8){vlo[i][0], vlo[i][1], vlo[i][2], vlo[i][3], vhi[i][0], vhi[i][1], vhi[i][2], vhi[i][3]}
#define VRD(i) do { vlo[i] = vtr(vp_ + (((i) >> 2) * 4096 + ((i) & 3) * 1024)); vhi[i] = vtr(vp_ + (((i) >> 2) * 4096 + ((i) & 3) * 1024 + 512)); } while (0)
#define KRD(G, d0) do { if (G) { kload2(kf, kp0 + sl_next, d0); SBAR(); } } while (0)
#define GAPA(MF, a0, a1, a2, a3, W0, W1, PW, MK, WW, i) do { MF; sacc += a0; sacc += a1; sacc += a2; sacc += a3; W0; W1; \
    MK[i] = (unsigned)__builtin_amdgcn_sbfe((int)(WW), BITP(i), 1); MK[i + 1] = (unsigned)__builtin_amdgcn_sbfe((int)(WW), BITP(i + 1), 1); MK[i + 2] = (unsigned)__builtin_amdgcn_sbfe((int)(WW), BITP(i + 2), 1); MK[i + 3] = (unsigned)__builtin_amdgcn_sbfe((int)(WW), BITP(i + 3), 1); \
    PIN(PW); PIN(sacc); PIN(MK); SBAR(); } while (0)
#define MAND(x, m) __uint_as_float(__float_as_uint(x) & (m))
#define GAPB(MF, X, i, MK) do { MF; X[i] = MAND(EX(X[i]), MK[i]); X[i + 1] = MAND(EX(X[i + 1]), MK[i + 1]); X[i + 2] = MAND(EX(X[i + 2]), MK[i + 2]); X[i + 3] = MAND(EX(X[i + 3]), MK[i + 3]); PIN(X); SBAR(); } while (0)
#define STEP(C0, C1, P0, P1, t, MASK, GK, GV, GL, ML) do { SBAR(); \
    if (ML) DMA_M(((t) + 1) >> 1); \
    const u64 mw_ = MWORD(t); const unsigned wl_ = (unsigned)(mw_) >> sh4, wh_ = (unsigned)((mw_) >> 32) >> sh4; \
    const lds_cptr vp_ = vp0 + sl_prev; \
    VRD(0); SBAR(); float sacc = P0[0] + P0[1]; \
                    GAPA(C0 = MFMA32(kf[0], qr[0], zero16), P0[2], P0[3], P0[4], P0[5],     pw0[0] = PKW(P0, 0),  pw0[1] = PKW(P0, 2),  pw0, mk0, wl_, 0); \
    VRD(4); SBAR(); GAPA(C1 = MFMA32(kf[1], qr[0], zero16), P0[6], P0[7], P0[8], P0[9],     pw0[2] = PKW(P0, 4),  pw0[3] = PKW(P0, 6),  pw0, mk0, wl_, 4); \
    VRD(1); SBAR(); GAPA(C0 = MFMA32(kf[2], qr[1], C0),    P0[10], P0[11], P0[12], P0[13], pw1[0] = PKW(P0, 8),  pw1[1] = PKW(P0, 10), pw1, mk0, wl_, 8); \
    VRD(5); SBAR(); GAPA(C1 = MFMA32(kf[3], qr[1], C1),    P0[14], P0[15], P1[0], P1[1],   pw1[2] = PKW(P0, 12), pw1[3] = PKW(P0, 14), pw1, mk0, wl_, 12); \
    VRD(2); SBAR(); GAPA(C0 = MFMA32(kf[4], qr[2], C0),    P1[2], P1[3], P1[4], P1[5],     pw2[0] = PKW(P1, 0),  pw2[1] = PKW(P1, 2),  pw2, mk1, wh_, 0); \
    VRD(6); SBAR(); GAPA(C1 = MFMA32(kf[5], qr[2], C1),    P1[6], P1[7], P1[8], P1[9],     pw2[2] = PKW(P1, 4),  pw2[3] = PKW(P1, 6),  pw2, mk1, wh_, 4); \
    VRD(3); SBAR(); GAPA(C0 = MFMA32(kf[6], qr[3], C0),    P1[10], P1[11], P1[12], P1[13], pw3[0] = PKW(P1, 8),  pw3[1] = PKW(P1, 10), pw3, mk1, wh_, 8); \
    VRD(7); SBAR(); GAPA(C1 = MFMA32(kf[7], qr[3], C1),    P1[14], P1[15], 0.f, 0.f,       pw3[2] = PKW(P1, 12), pw3[3] = PKW(P1, 14), pw3, mk1, wh_, 12); \
    l_reg += sacc; \
    if (GK) DMA_K((t) + 3, sl_cur); if (GV) DMA_V((t) + 1, sl_next); \
    { const float rm = __builtin_fmaf(rowmax(C0, C1), A_C2, -mhat); resc = false; \
      if (__builtin_expect(__any(rm > (float)ATTN_THR), 0)) { const float dl = __builtin_fmaxf(rm, 0.f); mhat += dl; \
          const float f = __builtin_amdgcn_exp2f(-dl); l_reg *= f; if (hi == 0) wsf[r32] = f; resc = true; } } \
    const float nmh = -mhat; SBAR(); \
    GAPB(o[0] = MFMA32(PAF(0), VFR(0), o[0]), C0, 0, mk0);              GAPB(o[1] = MFMA32(PAF(0), VFR(4), o[1]), C0, 4, mk0); \
    KRD(GL, 0); GAPB(o[0] = MFMA32(PAF(1), VFR(1), o[0]), C0, 8, mk0);  KRD(GL, 1); GAPB(o[1] = MFMA32(PAF(1), VFR(5), o[1]), C0, 12, mk0); \
    KRD(GL, 2); GAPB(o[0] = MFMA32(PAF(2), VFR(2), o[0]), C1, 0, mk1);  KRD(GL, 3); GAPB(o[1] = MFMA32(PAF(2), VFR(6), o[1]), C1, 4, mk1); \
    GAPB(o[0] = MFMA32(PAF(3), VFR(3), o[0]), C1, 8, mk1);              GAPB(o[1] = MFMA32(PAF(3), VFR(7), o[1]), C1, 12, mk1); \
    } while (0)
    int t = 1;
    for (; t + 5 < NT; t += 2) {
        STEP(pB0, pB1, pA0, pA1, t, false, true, true, true, true);      WAIT_BAR(2); RESC(); ROT();
        STEP(pA0, pA1, pB0, pB1, t + 1, false, true, true, true, false); WAIT_BAR(2); RESC(); ROT();
    }
#define ENDW(tt) do { if ((tt) + 3 < NT) { WAIT_BAR(2); } else if ((tt) + 2 < NT) { WAIT_BAR(1); } else { WAIT_BAR(0); } } while (0)
    for (; t + 1 < NT; t += 2) {
        STEP(pB0, pB1, pA0, pA1, t, true, (t + 3 < NT), (t + 1 < NT), (t + 1 < NT), (t + 1 < NT));         ENDW(t);     RESC(); ROT();
        STEP(pA0, pA1, pB0, pB1, t + 1, true, (t + 4 < NT), (t + 2 < NT), (t + 2 < NT), false);            ENDW(t + 1); RESC(); ROT();
    }
    STEP(pB0, pB1, pA0, pA1, NT - 1, true, false, false, false, false); RESC();
    { float sacc = pB0[0] + pB0[1];
#pragma unroll
      for (int r = 2; r < 16; ++r) sacc += pB0[r];
#pragma unroll
      for (int r = 0; r < 16; ++r) sacc += pB1[r];
      l_reg += sacc;
      pw0 = (u32x4){PKW(pB0, 0), PKW(pB0, 2), PKW(pB0, 4), PKW(pB0, 6)}; pw1 = (u32x4){PKW(pB0, 8), PKW(pB0, 10), PKW(pB0, 12), PKW(pB0, 14)};
      pw2 = (u32x4){PKW(pB1, 0), PKW(pB1, 2), PKW(pB1, 4), PKW(pB1, 6)}; pw3 = (u32x4){PKW(pB1, 8), PKW(pB1, 10), PKW(pB1, 12), PKW(pB1, 14)};
      const lds_cptr vp_ = vp0 + sl_cur; _Pragma("unroll") for (int i = 0; i < 8; ++i) VRD(i);
      o[0] = MFMA32(PAF(0), VFR(0), o[0]); o[1] = MFMA32(PAF(0), VFR(4), o[1]); o[0] = MFMA32(PAF(1), VFR(1), o[0]); o[1] = MFMA32(PAF(1), VFR(5), o[1]);
      o[0] = MFMA32(PAF(2), VFR(2), o[0]); o[1] = MFMA32(PAF(2), VFR(6), o[1]); o[0] = MFMA32(PAF(3), VFR(3), o[0]); o[1] = MFMA32(PAF(3), VFR(7), o[1]); }
    { auto rr = __builtin_amdgcn_permlane32_swap(__float_as_uint(l_reg), __float_as_uint(l_reg), false, false); l_reg = __uint_as_float(rr[0]) + __uint_as_float(rr[1]); }
    if (hi == 0) wsf[32 + r32] = l_reg; asm volatile("s_waitcnt lgkmcnt(0)" ::: "memory");
    float rli[16];
#pragma unroll
    for (int r = 0; r < 16; ++r) rli[r] = __builtin_amdgcn_rcpf(wsf[32 + crow(r, hi)]);
    u16* Ow = O + (rowbase + q0 + wid * A_QBLK) * A_DM + h * A_D; const u16* Gw = SG + (rowbase + q0 + wid * A_QBLK) * A_DM + h * A_D;
    u16* stg = (u16*)(lds + A_LDS_OST) + wid * 2048;
#pragma unroll
    for (int r = 0; r < 16; ++r) { const int orow = crow(r, hi);
#pragma unroll
        for (int d0 = 0; d0 < 2; ++d0) stg[orow * 64 + d0 * 32 + r32] = f2bf(o[d0][r] * rli[r]); }
    asm volatile("s_waitcnt lgkmcnt(0)" ::: "memory");
#pragma unroll
    for (int i = 0; i < 4; ++i) { const int row = i * 8 + (lane >> 3), ch = lane & 7;
        u32x4 ov = *(const u32x4*)(stg + row * 64 + ch * 8); u32x4 gv = *(const u32x4*)(Gw + (long)row * A_DM + ch * 8); u32x4 rv;
#pragma unroll
        for (int e = 0; e < 4; ++e) rv[e] = cvtpk(bflo(ov[e]) * bflo(gv[e]), bfhi(ov[e]) * bfhi(gv[e]));
        *(u32x4*)(Ow + (long)row * A_DM + ch * 8) = rv; }
    asm volatile("s_waitcnt vmcnt(0) lgkmcnt(0)\n\ts_barrier" ::: "memory");
#undef DMA_K
#undef DMA_V
#undef DMA_M
#undef MWORD
#undef ROT
#undef EX
#undef RESC
#undef PKW
#undef PAF
#undef VFR
#undef VRD
#undef KRD
#undef ENDW
#undef GAPA
#undef GAPB
#undef MAND
#undef STEP
}
__device__ __forceinline__ void phase_attn(const Params& p, char* lds) {
    constexpr int NPAIR = A_NQB / 2, NUNIT = NBATCH * A_NHEAD * NPAIR;
    const int bid_ = BID(), gdim_ = GDIM();
    for (int u = bid_; u < NUNIT; u += gdim_) {
        const int x = u & 7, kk = u >> 3, bh = x + 8 * (kk / NPAIR), j = kk % NPAIR;
        const int b = bh / A_NHEAD, h = bh % A_NHEAD;
        const u64* mb = p.mask() + (size_t)b * MASK_WORDS_PER_BATCH;
        attn64_unit(b, h, j, p.q(), p.k(), p.v(), p.sg(), p.bin(), mb + mk_base(j), lds);
        attn64_unit(b, h, A_NQB - 1 - j, p.q(), p.k(), p.v(), p.sg(), p.bin(), mb + mk_base(A_NQB - 1 - j), lds);
    }
}

struct EpiStash {
    static constexpr bool DUPOK = false;
    u16* stash;
    __device__ __forceinline__ void operator()(const acc_t& acc, const pg8::Unit& u, int ui, int wr, int wc, int fr, int fq) const {
        const int tid_ = TID();
        u32x4* st = (u32x4*)(stash + (size_t)(u.pm * 4 + u.pn) * 65536);
        ROWS_LOOP {
#pragma unroll
            for (int bj = 0; bj < 2; ++bj) { const f32x4 v0 = acc[ai][bj][m][0], v1 = acc[ai][bj][m][1];
                u32x4 w; w[0] = cvtpk(v0[0], v0[1]); w[1] = cvtpk(v0[2], v0[3]); w[2] = cvtpk(v1[0], v1[1]); w[3] = cvtpk(v1[2], v1[3]);
                st[((ai * 4 + m) * 2 + bj) * 512 + tid_] = w; } }
    }
};
struct EpiGate {
    static constexpr bool DUPOK = false;
    const Params& p; int l; int br;
    __device__ __forceinline__ void operator()(const acc_t& acc, const pg8::Unit& u, int ui, int wr, int wc, int fr, int fq) const {
        const float* ssq = p.sumsq() + (size_t)(l & 1) * T * 16;
        const int tid_ = TID();
        const u32x4* st = (const u32x4*)(p.stash() + (size_t)(u.pm * 4 + u.pn) * 65536);
        const int cl = wc * 4 + fq;
        __shared__ float s_rstd[256];
        { if (tid_ < 256) s_rstd[tid_] = row_rstd(ssq, u.pm * 256 + tid_); __syncthreads(); }
        float rsa[8];
#pragma unroll
        for (int ix = 0; ix < 8; ++ix) rsa[ix] = s_rstd[(ix >> 2) * 128 + wr * 64 + (ix & 3) * 16 + fr];
        const char* stp = (const char*)st + (size_t)tid_ * 16;
        char* mpp = (char*)(p.merged() + (size_t)(u.pm * 256 + wr * 64 + fr) * 1024 + u.pn * 256 + 16 * cl);
        u32x4 yb = *(const u32x4*)stp, ob = (br > 0) ? *(const u32x4*)mpp : (u32x4){0u, 0u, 0u, 0u};
        ROWS_LOOP { const int ix = ai * 4 + m; const float rs = rsa[ix];
#pragma unroll
            for (int bj = 0; bj < 2; ++bj) { const f32x4 v0 = acc[ai][bj][m][0] * rs, v1 = acc[ai][bj][m][1] * rs;
                float r[8];
                r[0] = sigmf(v0[0]) * bflo(yb[0]); r[1] = sigmf(v0[1]) * bfhi(yb[0]); r[2] = sigmf(v0[2]) * bflo(yb[1]); r[3] = sigmf(v0[3]) * bfhi(yb[1]);
                r[4] = sigmf(v1[0]) * bflo(yb[2]); r[5] = sigmf(v1[1]) * bfhi(yb[2]); r[6] = sigmf(v1[2]) * bflo(yb[3]); r[7] = sigmf(v1[3]) * bfhi(yb[3]);
                if (br > 0) {
#pragma unroll
                    for (int e = 0; e < 4; ++e) { r[2 * e] += bflo(ob[e]); r[2 * e + 1] += bfhi(ob[e]); } }
                u32x4 wo; wo[0] = cvtpk(r[0], r[1]); wo[1] = cvtpk(r[2], r[3]); wo[2] = cvtpk(r[4], r[5]); wo[3] = cvtpk(r[6], r[7]);
                const char* stn = stp + 8192; char* mpn = (bj == 0) ? (mpp + 16) : (mpp - 16 + ((ix == 3) ? 80 : 16) * 2048);
                asm volatile("" : "+v"(stn), "+v"(mpn));
                if (!(ix == 7 && bj == 1)) { yb = *(const u32x4*)stn; if (br > 0) ob = *(const u32x4*)mpn; }
                *(u32x4*)mpp = wo;
                stp = stn; mpp = mpn; } }
    }
};
__device__ __forceinline__ void phase_merge(const Params& p, int l, char* shm) {
    pg8::RowOrder S{4, 512, GDIM(), BID()};
    for (int br = 0; br < 3; ++br) {
        const u16* Ain = br == 0 ? p.ga() : (br == 1 ? p.bin() : p.sp());
        const u16* Wy = (br == 0 ? p.wt_oa() : (br == 1 ? p.wt_ob() : p.wt_oc())) + (size_t)l * 1024 * 512;
        { pg8::Gemm g{Ain, Wy, T, 1024, 512}; EpiStash E{p.stash()}; pg8::gemm_phase((PG8_LAS unsigned char*)shm, g, S, E); }
        { pg8::Gemm g{p.xb(), p.wt_mg() + (size_t)l * 3072 * 1024 + (size_t)br * 1024 * 1024, T, 1024, 1024}; EpiGate E{p, l, br}; pg8::gemm_phase((PG8_LAS unsigned char*)shm, g, S, E); }
    }
}

struct EpiOut {
    static constexpr bool DUPOK = false;
    const Params& p; int l;
    __device__ __forceinline__ void operator()(const acc_t& acc, const pg8::Unit& u, int ui, int wr, int wc, int fr, int fq) const {
        const float* xsrc = (l == 0) ? p.x_in : p.x;
        const int cl = wc * 4 + fq;
        f32x4 xb0[2], xb1[2];
#pragma unroll
        for (int bj = 0; bj < 2; ++bj) { const size_t o = (size_t)(u.pm * 256 + wr * 64 + fr) * 1024 + u.pn * 256 + 16 * cl + bj * 8; xb0[bj] = *(const f32x4*)(xsrc + o); xb1[bj] = *(const f32x4*)(xsrc + o + 4); }
        ROWS_LOOP { const int row = ROW_OF; const int ix = ai * 4 + m; float ss = 0.f;
            f32x4 x0[2], x1[2];
#pragma unroll
            for (int bj = 0; bj < 2; ++bj) { x0[bj] = xb0[bj] + acc[ai][bj][m][0]; x1[bj] = xb1[bj] + acc[ai][bj][m][1]; }
            if (ix < 7) { const int rown = u.pm * 256 + ((ix + 1) >> 2) * 128 + wr * 64 + ((ix + 1) & 3) * 16 + fr;
#pragma unroll
                for (int bj = 0; bj < 2; ++bj) { const size_t o = (size_t)rown * 1024 + u.pn * 256 + 16 * cl + bj * 8; xb0[bj] = *(const f32x4*)(xsrc + o); xb1[bj] = *(const f32x4*)(xsrc + o + 4); } }
#pragma unroll
            for (int bj = 0; bj < 2; ++bj) { const size_t o = (size_t)row * 1024 + u.pn * 256 + 16 * cl + bj * 8;
                *(f32x4*)(p.x + o) = x0[bj]; *(f32x4*)(p.x + o + 4) = x1[bj];
                if (l < NL - 1) { u32x4 w; w[0] = cvtpk(x0[bj][0], x0[bj][1]); w[1] = cvtpk(x0[bj][2], x0[bj][3]); w[2] = cvtpk(x1[bj][0], x1[bj][1]); w[3] = cvtpk(x1[bj][2], x1[bj][3]); *(u32x4*)(p.xb() + o) = w;
#pragma unroll
                    for (int j = 0; j < 4; ++j) ss += x0[bj][j] * x0[bj][j] + x1[bj][j] * x1[bj][j]; } }
            if (l < NL - 1) { ss += __shfl_xor(ss, 16); ss += __shfl_xor(ss, 32); if (fq == 0) p.sumsq()[(size_t)((l + 1) & 1) * T * 16 + (size_t)row * 16 + u.pn * 4 + wc] = ss; } }
    }
};
__device__ __forceinline__ void phase_out(const Params& p, int l, char* shm) {
    pg8::RowOrder S{4, 512, GDIM(), BID()};
    pg8::Gemm g{p.merged(), p.wt_o() + (size_t)l * 1024 * 1024, T, 1024, 1024};
    EpiOut E{p, l};
    pg8::gemm_phase((PG8_LAS unsigned char*)shm, g, S, E);
}

enum { PH_PREP0 = 0, PH_IN, PH_MIX, PH_IDX, PH_SEL, PH_ATTN, PH_MERGE, PH_OUT };
template <int PH> __global__ __launch_bounds__(NTHR) void k_phase(Params p, int l, int b) {
    extern __shared__ __attribute__((aligned(16))) char shm[];
    if (PH == PH_PREP0) phase_prep0(p, shm);
    if (PH == PH_IN) phase_in(p, l, shm);
    if (PH == PH_MIX) phase_mix(p, l);
    if (PH == PH_IDX) phase_indexer(p, b, p.scores(), shm);
    if (PH == PH_SEL) phase_select(p, b, shm, p.scores());
    if (PH == PH_ATTN) phase_attn(p, shm);
    if (PH == PH_MERGE) phase_merge(p, l, shm);
    if (PH == PH_OUT) phase_out(p, l, shm);
}

#define XB_TMO      128
#define XB_XCNT(j)  (256  + 64 * (j))
#define XB_XSUB(j)  (1280 + 64 * (j))
#define XB_XGEN(j)  (2304 + 64 * (j))
#define XB_TOP      3328
#define XB_TOPGEN   3392
#define XCD_BAR_WORDS 3456
#define XB_SPIN_CAP (1u << 22)
#define LAS __attribute__((address_space(3)))
__device__ __forceinline__ unsigned xb_ld(unsigned* p)              { return __hip_atomic_load(p, __ATOMIC_RELAXED, __HIP_MEMORY_SCOPE_AGENT); }
__device__ __forceinline__ unsigned xb_add(unsigned* p, unsigned v) { return __hip_atomic_fetch_add(p, v, __ATOMIC_RELAXED, __HIP_MEMORY_SCOPE_AGENT); }
__device__ __forceinline__ unsigned xb_xcc_id() { return (unsigned)__builtin_amdgcn_s_getreg((3 << 11) | 20) & 0xFu; }
#define XB_SPIN(cond, bar) do { unsigned _sp = 0; while (cond) { __builtin_amdgcn_s_sleep(1); \
    if ((++_sp & 255u) == 0u) { if (xb_ld(&(bar)[XB_TMO])) break; if (_sp > XB_SPIN_CAP) { atomicAdd(&(bar)[XB_TMO], 1u); break; } } } } while (0)
struct XcdBarrier { unsigned* bar; unsigned x; volatile LAS unsigned* st; };
__device__ __forceinline__ XcdBarrier xcd_barrier_post(unsigned* bar, volatile LAS unsigned* st) {
    XcdBarrier b; b.bar = bar; b.x = xb_xcc_id(); b.st = st;
    if (threadIdx.x == 0) (void)xb_add(&bar[XB_XCNT(b.x)], 1u);
    return b;
}
__device__ __forceinline__ void xcd_barrier_complete(unsigned* bar, unsigned x, unsigned& nloc, unsigned& nx) {
    const unsigned G = gridDim.x * gridDim.y * gridDim.z;
    unsigned sum, cnt, mine, sp = 0u;
    for (;;) {
        sum = 0u; cnt = 0u; mine = 0u;
#pragma unroll
        for (unsigned j = 0; j < 16; ++j) { const unsigned c = xb_ld(&bar[XB_XCNT(j)]); sum += c; cnt += (c > 0u) ? 1u : 0u; mine = (j == x) ? c : mine; }
        if (sum == G) break;
        __builtin_amdgcn_s_sleep(1);
        if ((++sp & 255u) == 0u) { if (xb_ld(&bar[XB_TMO])) break; if (sp > XB_SPIN_CAP) { atomicAdd(&bar[XB_TMO], 1u); break; } }
    }
    nloc = mine > 0u ? mine : 1u; nx = cnt > 0u ? cnt : 1u;
}
__device__ __forceinline__ void xcd_barrier(const XcdBarrier& b) {
    asm volatile("s_waitcnt vmcnt(0)" ::: "memory");
    __syncthreads();
    if (threadIdx.x == 0) {
        unsigned* bar = b.bar;
        __builtin_amdgcn_s_waitcnt(0);
        unsigned nloc = b.st[0], nx = b.st[1];
        if (nloc == 0u) { xcd_barrier_complete(bar, b.x, nloc, nx); b.st[0] = nloc; b.st[1] = nx; }
        const unsigned old = xb_add(&bar[XB_XSUB(b.x)], 1u);
        const unsigned gen = old / nloc;
        if (old + 1u == (gen + 1u) * nloc) {
            __builtin_amdgcn_fence(__ATOMIC_RELEASE, "agent");
            asm volatile("s_waitcnt vmcnt(0)" ::: "memory");
            const unsigned og = xb_add(&bar[XB_TOP], 1u);
            const unsigned tg = og / nx;
            if (og + 1u == (tg + 1u) * nx) xb_add(&bar[XB_TOPGEN], 1u);
            else XB_SPIN(xb_ld(&bar[XB_TOPGEN]) == tg, bar);
            __builtin_amdgcn_fence(__ATOMIC_ACQUIRE, "agent");
            xb_add(&bar[XB_XGEN(b.x)], 1u);
            asm volatile("s_waitcnt vmcnt(0)" ::: "memory");
        } else {
            XB_SPIN(xb_ld(&bar[XB_XGEN(b.x)]) == gen, bar);
            __builtin_amdgcn_fence(__ATOMIC_ACQUIRE, "agent");
            asm volatile("s_waitcnt vmcnt(0)" ::: "memory");
        }
    }
    __syncthreads();
}

#if MEGA
typedef const __attribute__((address_space(4))) Params* kparams_t;
__device__ __forceinline__ Params load_params(kparams_t k) {
    Params q; q.x_in = k->x_in; q.norm_g = k->norm_g; q.w_in = k->w_in; q.conv_w = k->conv_w; q.w_out_conv = k->w_out_conv; q.q_g = k->q_g; q.k_g = k->k_g; q.w_out_attn = k->w_out_attn;
    q.pool_w = k->pool_w; q.pool_scale = k->pool_scale; q.w_out_pool = k->w_out_pool; q.w_o = k->w_o; q.x = k->x; q.ws = k->ws; return q; }
#define PHP(q) kparams_t kq_##q = kp; asm volatile("" : "+s"(kq_##q)); const Params q = load_params(kq_##q);
__global__ __launch_bounds__(NTHR) void k_mega(Params p_unused) {
    extern __shared__ __attribute__((aligned(16))) char shm[];
    cg::grid_group grid = cg::this_grid();
    kparams_t kp = (kparams_t)__builtin_amdgcn_kernarg_segment_ptr();
    __shared__ uint4 xb_words;
    if (threadIdx.x == 0) xb_words = make_uint4(0u, 0u, 0u, 0u);
    __syncthreads();
    const XcdBarrier xb = xcd_barrier_post((unsigned*)(kp->ws + WS_BAR), (volatile LAS unsigned*)&xb_words);

#ifndef SK_PREP
        { PHP(p) phase_prep0(p, shm); }
#endif
#ifdef DUP_PREP
        { PHP(p) phase_prep0(p, shm); }
#endif

    grid.sync();
    for (int l = 0; l < NL; ++l) {

#ifndef SK_IN
        { PHP(p) phase_in(p, l, shm); }
#endif
#ifdef DUP_IN
        { PHP(p) phase_in(p, l, shm); }
#endif

        xcd_barrier(xb);

        { PHP(p) phase_mix(p, l); phase_indexer(p, 0, p.scores(), shm); }
        xcd_barrier(xb);
        { PHP(p) phase_indexer(p, 1, p.scores2(), shm); phase_select(p, 0, shm, p.scores()); }
        xcd_barrier(xb);
        { PHP(p) phase_indexer(p, 2, p.scores(), shm); phase_select(p, 1, shm, p.scores2()); }
        xcd_barrier(xb);
        { PHP(p) phase_indexer(p, 3, p.scores2(), shm); phase_select(p, 2, shm, p.scores()); }
        xcd_barrier(xb);
        { PHP(p) phase_select(p, 3, shm, p.scores2()); }
        xcd_barrier(xb);
#ifndef SK_ATTN
        { PHP(p) phase_attn(p, shm); }
#endif
#ifdef DUP_ATTN
        { PHP(p) phase_attn(p, shm); }
#endif

        xcd_barrier(xb);

#ifndef SK_MERGE
        { PHP(p) phase_merge(p, l, shm); }
#endif
#ifdef DUP_MERGE
        { PHP(p) phase_merge(p, l, shm); }
#endif

        xcd_barrier(xb);

#ifndef SK_OUT
        { PHP(p) phase_out(p, l, shm); }
#endif

        xcd_barrier(xb);
    }
}
#endif

static Params make_params(void* const* d_in, void* d_out, void* d_ws) {
    Params p{};
    p.x_in = (const float*)d_in[0]; p.norm_g = (const float*)d_in[1]; p.w_in = (const float*)d_in[2]; p.conv_w = (const float*)d_in[3];
    p.w_out_conv = (const float*)d_in[4]; p.q_g = (const float*)d_in[5]; p.k_g = (const float*)d_in[6]; p.w_out_attn = (const float*)d_in[7];
    p.pool_w = (const float*)d_in[8]; p.pool_scale = (const float*)d_in[9]; p.w_out_pool = (const float*)d_in[10]; p.w_o = (const float*)d_in[11];
    p.x = (float*)d_out; p.ws = (char*)d_ws;
    return p;
}

extern "C" void kernel_launch(void* const* d_in, const int* in_sizes, int n_in, void* d_out, int out_size, void* d_ws, size_t ws_size, hipStream_t stream) {
    if (ws_size < WS_NEEDED) { fprintf(stderr, "workspace too small: %zu < %zu\n", ws_size, (size_t)WS_NEEDED); return; }
    Params p = make_params(d_in, d_out, d_ws);
    static int grid = 0;
    if (!grid) { int dev = 0, cus = 0; hipGetDevice(&dev); hipDeviceGetAttribute(&cus, hipDeviceAttributeMultiprocessorCount, dev); if (cus <= 0 || cus > 256) cus = 256; grid = (cus / 8) * 8; }
#if MEGA
    static bool attr = false;
    if (!attr) { hipFuncSetAttribute((const void*)k_mega, hipFuncAttributeMaxDynamicSharedMemorySize, LDS_BYTES); attr = true; }
    hipMemsetAsync((char*)d_ws + WS_BAR, 0, 16384, stream);
    void* args[] = {&p};
    hipError_t e = hipLaunchCooperativeKernel((void*)k_mega, dim3(grid), dim3(NTHR), args, LDS_BYTES, stream);
    if (e != hipSuccess) fprintf(stderr, "cooperative launch failed: %s\n", hipGetErrorString(e));
#else
    static bool attr = false;
    if (!attr) {
        hipFuncSetAttribute((const void*)k_phase<PH_PREP0>, hipFuncAttributeMaxDynamicSharedMemorySize, LDS_BYTES);
        hipFuncSetAttribute((const void*)k_phase<PH_IN>, hipFuncAttributeMaxDynamicSharedMemorySize, LDS_BYTES);
        hipFuncSetAttribute((const void*)k_phase<PH_MIX>, hipFuncAttributeMaxDynamicSharedMemorySize, LDS_BYTES);
        hipFuncSetAttribute((const void*)k_phase<PH_IDX>, hipFuncAttributeMaxDynamicSharedMemorySize, LDS_BYTES);
        hipFuncSetAttribute((const void*)k_phase<PH_SEL>, hipFuncAttributeMaxDynamicSharedMemorySize, LDS_BYTES);
        hipFuncSetAttribute((const void*)k_phase<PH_ATTN>, hipFuncAttributeMaxDynamicSharedMemorySize, LDS_BYTES);
        hipFuncSetAttribute((const void*)k_phase<PH_MERGE>, hipFuncAttributeMaxDynamicSharedMemorySize, LDS_BYTES);
        hipFuncSetAttribute((const void*)k_phase<PH_OUT>, hipFuncAttributeMaxDynamicSharedMemorySize, LDS_BYTES);
        attr = true;
    }
#define LAUNCH(PH, l, b) hipLaunchKernelGGL(k_phase<PH>, dim3(grid), dim3(NTHR), LDS_BYTES, stream, p, l, b)
    LAUNCH(PH_PREP0, 0, 0);
    for (int l = 0; l < NL; ++l) {
        LAUNCH(PH_IN, l, 0);
        LAUNCH(PH_MIX, l, 0);
        for (int b = 0; b < NBATCH; ++b) { LAUNCH(PH_IDX, l, b); LAUNCH(PH_SEL, l, b); }
        LAUNCH(PH_ATTN, l, 0);
        LAUNCH(PH_MERGE, l, 0);
        LAUNCH(PH_OUT, l, 0);
    }
#endif
}
```

```cpp
#include <hip/hip_runtime.h>
#include <hip/hip_cooperative_groups.h>
#include <stdint.h>
#include <stdio.h>
namespace cg = cooperative_groups;

typedef unsigned short u16;
typedef unsigned long long u64;
typedef __attribute__((ext_vector_type(8))) short bf16x8;
typedef __attribute__((ext_vector_type(4))) short s16x4;
typedef __attribute__((ext_vector_type(4))) float f32x4;
typedef __attribute__((ext_vector_type(16))) float f32x16;
typedef __attribute__((ext_vector_type(4))) unsigned u32x4;
typedef __attribute__((ext_vector_type(2))) unsigned u32x2;

#ifndef MEGA
#define MEGA 1
#endif
__device__ __forceinline__ int TID() { int t = threadIdx.x; asm volatile("" : "+v"(t)); return t; }
__device__ __forceinline__ int BID() { int t = blockIdx.x; asm volatile("" : "+s"(t)); return t; }
__device__ __forceinline__ int GDIM() { int t = gridDim.x; asm volatile("" : "+s"(t)); return t; }

constexpr int SEQ = 8192, NBATCH = 4, T = NBATCH * SEQ, DMODEL = 1024, NL = 4, INW = 8776;
constexpr int NPA = 5888;
constexpr int NTHR = 512;
constexpr int LDS_BYTES = 131072;
constexpr float RMS_EPS = 1e-6f;

struct Params {
    const float *x_in, *norm_g, *w_in, *conv_w, *w_out_conv, *q_g, *k_g, *w_out_attn, *pool_w, *pool_scale, *w_out_pool, *w_o;
    float* x; char* ws;
    __device__ __forceinline__ u16* xb() const { return (u16*)(ws + 0ull); }
    __device__ __forceinline__ u16* ga() const { return (u16*)(ws + 67108864ull); }
    __device__ __forceinline__ u16* q() const { return (u16*)(ws + 100663296ull); }
    __device__ __forceinline__ u16* k() const { return (u16*)(ws + 134217728ull); }
    __device__ __forceinline__ u16* v() const { return (u16*)(ws + 167772160ull); }
    __device__ __forceinline__ u16* sg() const { return (u16*)(ws + 201326592ull); }
    __device__ __forceinline__ u16* iq() const { return (u16*)(ws + 234881024ull); }
    __device__ __forceinline__ u16* sp() const { return (u16*)(ws + 268435456ull); }
    __device__ __forceinline__ u16* z() const { return (u16*)(ws + 301989888ull); }
    __device__ __forceinline__ u16* u() const { return (u16*)(ws + 335544320ull); }
    __device__ __forceinline__ u16* zuspare() const { return (u16*)(ws + 369098752ull); }
    __device__ __forceinline__ u16* ik() const { return (u16*)(ws + 371195904ull); }
    __device__ __forceinline__ float* iw() const { return (float*)(ws + 375390208ull); }
    __device__ __forceinline__ u16* wt_in() const { return (u16*)(ws + 376438784ull); }
    __device__ __forceinline__ u16* wt_mg() const { return (u16*)(ws + 424673280ull); }
    __device__ __forceinline__ u16* wt_oa() const { return (u16*)(ws + 449839104ull); }
    __device__ __forceinline__ u16* wt_ob() const { return (u16*)(ws + 454033408ull); }
    __device__ __forceinline__ u16* wt_oc() const { return (u16*)(ws + 458227712ull); }
    __device__ __forceinline__ u16* wt_o() const { return (u16*)(ws + 462422016ull); }
    __device__ __forceinline__ float* ropec() const { return (float*)(ws + 470810624ull); }
    __device__ __forceinline__ float* ropes() const { return (float*)(ws + 471859200ull); }
    __device__ __forceinline__ float* sumsq() const { return (float*)(ws + 472907776ull); }
    __device__ __forceinline__ u64* mask() const { return (u64*)(ws + 477102080ull); }
    __device__ __forceinline__ u16* scores() const { return (u16*)(ws + 494403584ull); }
    __device__ __forceinline__ u16* scores2() const { return z(); }
    __device__ __forceinline__ u16* stash() const { return scores(); }
    __device__ __forceinline__ u16* merged() const { return q(); }
    __device__ __forceinline__ u16* bin() const { return iq(); }
};
constexpr size_t WS_BAR = 563609600ull;
constexpr size_t WS_NEEDED = WS_BAR + 16384;


__device__ __forceinline__ unsigned cvtpk(float lo, float hi) { unsigned r; asm("v_cvt_pk_bf16_f32 %0, %1, %2" : "=v"(r) : "v"(lo), "v"(hi)); return r; }
__device__ __forceinline__ u16 f2bf(float f) { return (u16)(cvtpk(f, 0.f) & 0xffffu); }
__device__ __forceinline__ float bf2f(u16 b) { return __uint_as_float(((unsigned)b) << 16); }
__device__ __forceinline__ float bflo(unsigned w) { return __uint_as_float(w << 16); }
__device__ __forceinline__ float bfhi(unsigned w) { return __uint_as_float(w & 0xffff0000u); }
__device__ __forceinline__ float siluf(float x) { return x * __builtin_amdgcn_rcpf(1.f + __builtin_amdgcn_exp2f(x * -1.4426950408889634f)); }
__device__ __forceinline__ float sigmf(float x) { return __builtin_amdgcn_rcpf(1.f + __builtin_amdgcn_exp2f(x * -1.4426950408889634f)); }

__device__ __forceinline__ float row_rstd(const float* ssp, int row) {
    const f32x4* q = (const f32x4*)(ssp + (size_t)row * 16);
    const f32x4 a = q[0], b = q[1], c = q[2], d = q[3];
    const float s = ((a[0] + a[1]) + (a[2] + a[3])) + ((b[0] + b[1]) + (b[2] + b[3])) + ((c[0] + c[1]) + (c[2] + c[3])) + ((d[0] + d[1]) + (d[2] + d[3]));
    return __builtin_amdgcn_rsqf(s * (1.f / 1024.f) + RMS_EPS);
}
__device__ __forceinline__ int lc_of_tc(int tc) { int bj = tc >> 7, wc = (tc >> 5) & 3, n = (tc >> 4) & 1, fq = (tc >> 2) & 3, j = tc & 3; return ((wc * 4 + fq) << 4) + bj * 8 + n * 4 + j; }
__device__ __forceinline__ int tc_of_lc(int lc) { int cl = lc >> 4, s = lc & 15, wc = cl >> 2, fq = cl & 3, bj = s >> 3, n = (s >> 2) & 1, j = s & 3; return bj * 128 + wc * 32 + n * 16 + fq * 4 + j; }

__device__ __forceinline__ int src_col_in(int np) {
    int pn = np >> 8, tc = np & 255;
    int bj = tc >> 7, wc = (tc >> 5) & 3, n = (tc >> 4) & 1, fq = (tc >> 2) & 3, j = tc & 3, cl = wc * 4 + fq, s = bj * 8 + n * 4 + j, lc = cl * 16 + s;
    int d = (s < 8) ? (8 * fq + s) : (8 * fq + 32 + (s - 8));
    if (pn < 8) return (s & 3) * 512 + pn * 64 + cl * 4 + (s >> 2);
    if (pn < 12) { int which = (pn - 8) >> 1, head = ((pn - 8) & 1) * 4 + wc; return 2048 + which * 512 + head * 64 + d; }
    if (pn < 14) return 3072 + (pn - 12) * 256 + lc;
    if (pn < 16) return 3584 + (pn - 14) * 256 + lc;
    if (pn < 18) { int head = (pn - 16) * 4 + wc; return 4096 + head * 64 + d; }
    if (pn == 18) { if (wc == 0) return 4608 + d; if (wc == 1 && fq == 0 && s < 8) return 4672 + s; return -1; }
    if (pn < 21) return -2;
    return 5192 + (pn - 21) * 256 + lc;
}

__device__ __forceinline__ void prep_x(const Params& p) {
    const int tid_ = TID(); const int lane = tid_ & 63, gw = BID() * (NTHR / 64) + (tid_ >> 6), nw = GDIM() * (NTHR / 64);
    for (int row0 = gw * 4; row0 < T; row0 += nw * 4) {
        float4 v[4][4];
#pragma unroll
        for (int r = 0; r < 4; ++r)
#pragma unroll
            for (int i = 0; i < 4; ++i) v[r][i] = ((const float4*)(p.x_in + (size_t)(row0 + r) * DMODEL))[i * 64 + lane];
        float ss[4];
#pragma unroll
        for (int r = 0; r < 4; ++r) { ss[r] = 0.f;
#pragma unroll
            for (int i = 0; i < 4; ++i) { const float4 q = v[r][i]; ss[r] += q.x * q.x + q.y * q.y + q.z * q.z + q.w * q.w;
                u32x2 o; o[0] = cvtpk(q.x, q.y); o[1] = cvtpk(q.z, q.w);
                *(u32x2*)(p.xb() + (size_t)(row0 + r) * DMODEL + (i * 64 + lane) * 4) = o; } }
#pragma unroll
        for (int m = 32; m >= 1; m >>= 1) {
#pragma unroll
            for (int r = 0; r < 4; ++r) ss[r] += __shfl_xor(ss[r], m); }
        if (lane < 16) {
#pragma unroll
            for (int r = 0; r < 4; ++r) p.sumsq()[(size_t)(row0 + r) * 16 + lane] = (lane == 0) ? ss[r] : 0.f; }
    }
}
__device__ __forceinline__ void prep_rope(const Params& p) {
    const int i0 = BID() * NTHR + TID(), istep = GDIM() * NTHR;
    for (int i = i0; i < SEQ * 32; i += istep) {
        int pos = i >> 5, j = i & 31;
        float inv = 1.0f / powf(10000.0f, (float)(2 * j) / 64.0f);
        float ang = (float)pos * inv;
        p.ropec()[i] = cosf(ang); p.ropes()[i] = sinf(ang);
    }
}
__device__ __forceinline__ void prep_wt(const float* src, int lds_, const float* scale, u16* dst, int K, int NP, int mode, float* tile) {
    const int tid_ = TID(); const int tx = tid_ & 63, ty = tid_ >> 6; const int bid_ = BID(), gdim_ = GDIM();
    const int ntn = NP / 64, ntk = K / 64;
    for (int t = bid_; t < ntn * ntk; t += gdim_) {
        const int n0 = (t / ntk) * 64, k0 = (t % ntk) * 64;
        int np = n0 + tx, col;
        if (mode == 0) col = src_col_in(np);
        else if (mode == 1) col = 5704 + (np & ~255) + lc_of_tc(np & 255);
        else col = (np & ~255) + lc_of_tc(np & 255);
        __syncthreads();
#pragma unroll
        for (int i = 0; i < 8; ++i) { int kk = ty + 8 * i; tile[kk * 65 + tx] = (col >= 0) ? src[(size_t)(k0 + kk) * lds_ + col] : 0.f; }
        __syncthreads();
        const float sc = scale ? scale[k0 + tx] : 1.f;
#pragma unroll
        for (int i = 0; i < 8; ++i) {
            int nn = ty + 8 * i; int npo = n0 + nn;
            bool skip = (mode == 0) && ((npo >> 8) == 19 || (npo >> 8) == 20);
            if (!skip) dst[(size_t)npo * K + k0 + tx] = f2bf(tile[tx * 65 + nn] * sc);
        }
    }
}
__device__ __forceinline__ void prep_fold(const float* win, const float* ng, const float* pw, u16* wt_in) {
    const int i0 = BID() * NTHR + TID(), istep = GDIM() * NTHR;
    for (int i = i0; i < 1024 * 512; i += istep) {
        int k = i >> 9, n = i & 511, g = n >> 7, d = n & 127;
        const float* wr = win + (size_t)k * INW + 4680 + g * 128;
        const float* pp = pw + (size_t)g * 128 * 128 + d;
        float acc = 0.f;
        for (int c = 0; c < 128; ++c) acc += wr[c] * pp[c * 128];
        int row = (19 + (n >> 8)) * 256 + tc_of_lc(n & 255);
        wt_in[(size_t)row * 1024 + k] = f2bf(acc * ng[k]);
    }
}
__device__ __forceinline__ void phase_prep0(const Params& p, char* shm) {
    prep_x(p); prep_rope(p);
    float* tile = (float*)shm;
    for (int l = 0; l < NL; ++l) {
        const float* ng = p.norm_g + l * 1024;
        const float* win = p.w_in + (size_t)l * 1024 * INW;
        prep_wt(win, INW, ng, p.wt_in() + (size_t)l * NPA * 1024, 1024, NPA, 0, tile);
        prep_wt(win, INW, ng, p.wt_mg() + (size_t)l * 3072 * 1024, 1024, 3072, 1, tile);
        prep_wt(p.w_out_conv + (size_t)l * 512 * 1024, 1024, nullptr, p.wt_oa() + (size_t)l * 1024 * 512, 512, 1024, 2, tile);
        prep_wt(p.w_out_attn + (size_t)l * 512 * 1024, 1024, nullptr, p.wt_ob() + (size_t)l * 1024 * 512, 512, 1024, 2, tile);
        prep_wt(p.w_out_pool + (size_t)l * 512 * 1024, 1024, nullptr, p.wt_oc() + (size_t)l * 1024 * 512, 512, 1024, 2, tile);
        prep_wt(p.w_o + (size_t)l * 1024 * 1024, 1024, nullptr, p.wt_o() + (size_t)l * 1024 * 1024, 1024, 1024, 3, tile);
        prep_fold(win, ng, p.pool_w + (size_t)l * 4 * 128 * 128, p.wt_in() + (size_t)l * NPA * 1024);
    }
}

namespace pg8 {
#define PG8_LAS __attribute__((address_space(3)))
typedef unsigned short bf16_t;
constexpr int BM = 256, BK = 64, HALF = 128, HTB = HALF * BK * 2, STAGE_BYTES = 8 * HTB;
__device__ __forceinline__ int lds_byte(int r, int c) { const int st = (r >> 4) * 2 + (c >> 5), rr = r & 15, cc = c & 31, ob = rr * 64 + cc * 2; return st * 1024 + (ob ^ (((ob >> 9) & 1) << 5)); }
__device__ __forceinline__ void stage_rc(int b, int& R, int& C) { const int st = b / 1024, sb = b % 1024, swz = sb ^ (((sb >> 9) & 1) << 5); R = (st >> 1) * 16 + swz / 64; C = (st & 1) * 32 + (swz % 64) / 2; }
struct Unit { int pm, pn; };
struct Gemm { const bf16_t* A; const bf16_t* Bt; int M, N, K; };
constexpr int NXCD = 8, WGM = 8;
struct StaticOrder {
    int nM, nN, nwg, G, c;
    __device__ void init(int M, int N, int G_, int c_) { nM = M / BM; nN = N / BM; nwg = nM * nN; G = G_; c = c_; }
    __device__ bool next(int i, Unit& u) const {
        const long L = (long)i * G + c; if (L >= nwg) return false;
        int wgid = (int)L; { const int q = nwg / NXCD, r = nwg % NXCD, xcd = wgid % NXCD, off = wgid / NXCD; wgid = (xcd < r ? xcd * (q + 1) : r * (q + 1) + (xcd - r) * q) + off; }
        const int nig = WGM * nN, gid = wgid / nig, fm = gid * WGM, gsz = (nM - fm) < WGM ? (nM - fm) : WGM;
        u.pm = fm + ((wgid % nig) % gsz); u.pn = (wgid % nig) / gsz; return true;
    }
};
struct RowOrder {
    int nN, ntile, G, c;
    __device__ bool next(int i, Unit& u) const {
        const int x = c & 7, lt = (c >> 3) + (G >> 3) * i;
        const int quad = lt >> 2, pm = quad * 8 + x;
        if (pm * 4 >= ntile) return false;
        u.pm = pm; u.pn = lt & 3; return true; }
};
template <class Epi, class Sched>
__device__ __forceinline__ void gemm_phase(PG8_LAS unsigned char* lds, const Gemm g, const Sched& S, const Epi& E) {
    const int tid = TID(), wid = __builtin_amdgcn_readfirstlane(tid >> 6), lane = tid & 63, wr = wid >> 2, wc = wid & 3, fr = lane & 15, fq = lane >> 4;
    const int K = g.K, nt = K / BK;
    unsigned voffA[2], voffB[2];
#pragma unroll
    for (int i = 0; i < 2; ++i) { int R, C; stage_rc(tid * 16 + i * 8192, R, C); voffA[i] = (unsigned)(R * K + C) * 2u; voffB[i] = voffA[i]; }
    const size_t kstep = (size_t)(BK * 2);
    const size_t hstep = (size_t)HALF * K * 2;
    const size_t tstep = 2 * hstep;
    const unsigned ldsw = (unsigned)wid * 1024u;
    const int aoff = lds_byte(wr * 64 + fr, fq * 8), boff = lds_byte(wc * 32 + fr, fq * 8);
#define PG8_SA(b, h) (((b) * 2 + (h)) * HTB)
#define PG8_SB(b, h) ((4 + (b) * 2 + (h)) * HTB)
#define PG8_STAGE(bufoff, gbase, voff) do { _Pragma("unroll") for (int _i = 0; _i < 2; ++_i) \
        __builtin_amdgcn_global_load_lds((const unsigned*)((const char*)(gbase) + (voff)[_i]), (PG8_LAS unsigned*)(lds + (bufoff) + ldsw + _i * 8192), 16, 0, 0); } while (0)
#define PG8_LDA(dst, b, h) do { _Pragma("unroll") for (int m = 0; m < 4; ++m) _Pragma("unroll") for (int k = 0; k < 2; ++k) dst[m][k] = *(const PG8_LAS bf16x8*)(lds + PG8_SA(b, h) + aoff + m * 2048 + k * 1024); } while (0)
#define PG8_LDB(dst, b, h) do { _Pragma("unroll") for (int n = 0; n < 2; ++n) _Pragma("unroll") for (int k = 0; k < 2; ++k) dst[n][k] = *(const PG8_LAS bf16x8*)(lds + PG8_SB(b, h) + boff + n * 2048 + k * 1024); } while (0)
#define PG8_MMA(ai, bj, At, Bt) do { __builtin_amdgcn_s_setprio(1); _Pragma("unroll") for (int m = 0; m < 4; ++m) _Pragma("unroll") for (int n = 0; n < 2; ++n) _Pragma("unroll") for (int k = 0; k < 2; ++k) \
        acc[ai][bj][m][n] = __builtin_amdgcn_mfma_f32_16x16x32_bf16(Bt[n][k], At[m][k], acc[ai][bj][m][n], 0, 0, 0); __builtin_amdgcn_s_setprio(0); } while (0)
#define PG8_WAIT_V(n) asm volatile("s_waitcnt vmcnt(" #n ")" ::: "memory")
#define PG8_WAIT_L(n) asm volatile("s_waitcnt lgkmcnt(" #n ")" ::: "memory")
#define PG8_BAR __builtin_amdgcn_s_barrier()
#define PG8_SCHED __builtin_amdgcn_sched_barrier(0)
    Unit cur, nxt; int ui = 0;
    if (!S.next(0, cur)) return;
    f32x4 acc[2][2][4][2];
#pragma unroll
    for (int a = 0; a < 2; ++a)
#pragma unroll
        for (int b = 0; b < 2; ++b)
#pragma unroll
            for (int m = 0; m < 4; ++m)
#pragma unroll
                for (int n = 0; n < 2; ++n) acc[a][b][m][n] = (f32x4){0.f, 0.f, 0.f, 0.f};
    bf16x8 At[4][2], B0[2][2], B1[2][2];
    const char* cA = (const char*)g.A + (size_t)cur.pm * tstep; const char* cB = (const char*)g.Bt + (size_t)cur.pn * tstep;
    PG8_STAGE(PG8_SB(0, 0), cB, voffB); PG8_STAGE(PG8_SA(0, 0), cA, voffA); PG8_STAGE(PG8_SB(0, 1), cB + hstep, voffB); PG8_STAGE(PG8_SA(0, 1), cA + hstep, voffA);
    if (wr == 1) PG8_BAR;
    PG8_WAIT_V(4); PG8_BAR;
    PG8_STAGE(PG8_SB(1, 0), cB + kstep, voffB); PG8_STAGE(PG8_SA(1, 0), cA + kstep, voffA); PG8_STAGE(PG8_SB(1, 1), cB + hstep + kstep, voffB);
    PG8_WAIT_V(6); PG8_BAR;
    for (;;) {
        const bool has_next = S.next(ui + 1, nxt);
        const char* nA = has_next ? (const char*)g.A + (size_t)nxt.pm * tstep : cA; const char* nB = has_next ? (const char*)g.Bt + (size_t)nxt.pn * tstep : cB;
        for (int t = 0; t < nt; t += 2) {
            const bool last = (t == nt - 2);
            const char* a1 = cA + (size_t)(t + 1) * kstep;
            const char* a2 = last ? nA : cA + (size_t)(t + 2) * kstep; const char* b2 = last ? nB : cB + (size_t)(t + 2) * kstep;
            const char* a3 = a2 + kstep; const char* b3 = b2 + kstep;
            PG8_LDB(B0, 0, 0); PG8_SCHED; PG8_LDA(At, 0, 0); PG8_STAGE(PG8_SA(1, 1), a1 + hstep, voffA);
            PG8_WAIT_L(8); PG8_BAR; PG8_WAIT_L(0); PG8_MMA(0, 0, At, B0); PG8_BAR; PG8_SCHED;
            PG8_LDB(B1, 0, 1); PG8_STAGE(PG8_SB(0, 0), b2, voffB);
            PG8_BAR; PG8_WAIT_L(0); PG8_MMA(0, 1, At, B1); PG8_BAR;
            PG8_LDA(At, 0, 1); PG8_STAGE(PG8_SA(0, 0), a2, voffA);
            PG8_BAR; PG8_WAIT_L(0); PG8_MMA(1, 0, At, B0); PG8_BAR; PG8_SCHED;
            PG8_STAGE(PG8_SB(0, 1), b2 + hstep, voffB);
            PG8_WAIT_V(6); PG8_BAR; PG8_MMA(1, 1, At, B1); PG8_BAR;
            PG8_LDB(B0, 1, 0); PG8_SCHED; PG8_LDA(At, 1, 0); PG8_STAGE(PG8_SA(0, 1), a2 + hstep, voffA);
            PG8_WAIT_L(8); PG8_BAR; PG8_WAIT_L(0); PG8_MMA(0, 0, At, B0); PG8_BAR; PG8_SCHED;
            PG8_LDB(B1, 1, 1); PG8_STAGE(PG8_SB(1, 0), b3, voffB);
            PG8_BAR; PG8_WAIT_L(0); PG8_MMA(0, 1, At, B1); PG8_BAR;
            PG8_LDA(At, 1, 1); PG8_STAGE(PG8_SA(1, 0), a3, voffA);
            PG8_BAR; PG8_WAIT_L(0); PG8_MMA(1, 0, At, B0); PG8_BAR; PG8_SCHED;
            PG8_STAGE(PG8_SB(1, 1), b3 + hstep, voffB);
            PG8_WAIT_V(6); PG8_BAR; PG8_MMA(1, 1, At, B1); PG8_BAR;
        }
        E(acc, cur, ui, wr, wc, fr, fq);
#ifdef DUP_EPI
        if (Epi::DUPOK) E(acc, cur, ui, wr, wc, fr, fq);
#endif
        if (!has_next) break;
#pragma unroll
        for (int a = 0; a < 2; ++a)
#pragma unroll
            for (int b = 0; b < 2; ++b)
#pragma unroll
                for (int m = 0; m < 4; ++m)
#pragma unroll
                    for (int n = 0; n < 2; ++n) acc[a][b][m][n] = (f32x4){0.f, 0.f, 0.f, 0.f};
        cur = nxt; cA = nA; cB = nB; ++ui;
    }
    PG8_WAIT_V(0);
    if (wr == 0) PG8_BAR;
    PG8_BAR;
#undef PG8_SA
#undef PG8_SB
#undef PG8_STAGE
#undef PG8_LDA
#undef PG8_LDB
#undef PG8_MMA
#undef PG8_WAIT_V
#undef PG8_WAIT_L
#undef PG8_BAR
#undef PG8_SCHED
}
}
typedef f32x4 acc_t[2][2][4][2];
#define ROWS_LOOP _Pragma("unroll") for (int ai = 0; ai < 2; ++ai) _Pragma("unroll") for (int m = 0; m < 4; ++m)
#define ROW_OF (u.pm * 256 + ai * 128 + wr * 64 + m * 16 + fr)

struct EpiIn {
    static constexpr bool DUPOK = true;
    const Params& p; int l;
    __device__ __forceinline__ void operator()(const acc_t& acc, const pg8::Unit& u, int ui, int wr, int wc, int fr, int fq) const {
        const float* ssq = p.sumsq() + (size_t)(l & 1) * T * 16;
        const int pn = u.pn, cl = wc * 4 + fq;
        __shared__ float s_rstd[256];
        { const int t_ = TID(); if (t_ < 256) s_rstd[t_] = row_rstd(ssq, u.pm * 256 + t_); __syncthreads(); }
        float rsa[8];
#pragma unroll
        for (int ix = 0; ix < 8; ++ix) rsa[ix] = s_rstd[(ix >> 2) * 128 + wr * 64 + (ix & 3) * 16 + fr];
        if (pn < 8) {
            ROWS_LOOP { const int row = ROW_OF; const float rs = rsa[ai * 4 + m];
                float zz[4], gg[4];
#pragma unroll
                for (int ch = 0; ch < 4; ++ch) { const f32x4 v = acc[ai][ch >> 1][m][ch & 1]; zz[ch] = (v[1] * rs) * (v[2] * rs); gg[ch] = (v[0] * rs) * siluf(v[3] * rs); }
                const size_t o = (size_t)row * 512 + pn * 64 + cl * 4;
                u32x2 a; a[0] = cvtpk(zz[0], zz[1]); a[1] = cvtpk(zz[2], zz[3]); *(u32x2*)(p.z() + o) = a;
                u32x2 b; b[0] = cvtpk(gg[0], gg[1]); b[1] = cvtpk(gg[2], gg[3]); *(u32x2*)(p.ga() + o) = b; }
        } else if (pn < 12 || (pn >= 16 && pn <= 18)) {
            if (pn == 18 && wc >= 1) {
                if (wc == 1 && fq == 0) {
                    ROWS_LOOP { const int row = ROW_OF; const float rs = rsa[ai * 4 + m] * 0.04419417382415922f;
                        *(f32x4*)(p.iw() + (size_t)row * 8) = acc[ai][0][m][0] * rs; *(f32x4*)(p.iw() + (size_t)row * 8 + 4) = acc[ai][0][m][1] * rs; }
                }
            } else {
                const bool isqk = pn < 12; const int which = (pn - 8) >> 1;
                int head; u16* dst; int pitch;
                if (isqk) { head = ((pn - 8) & 1) * 4 + wc; dst = which ? p.k() : p.q(); pitch = 512; }
                else if (pn < 18) { head = (pn - 16) * 4 + wc; dst = p.iq(); pitch = 512; }
                else { head = 0; dst = p.ik(); pitch = 64; }
                f32x4 g0[2], g1[2];
#pragma unroll
                for (int n = 0; n < 2; ++n) { g0[n] = (f32x4){1.f, 1.f, 1.f, 1.f}; g1[n] = g0[n]; }
                if (isqk) { const float* gg = (which ? p.k_g : p.q_g) + l * 64 + 8 * fq;
#pragma unroll
                    for (int n = 0; n < 2; ++n) { g0[n] = *(const f32x4*)(gg + 4 * n); g1[n] = *(const f32x4*)(gg + 32 + 4 * n); } }
                f32x4 rcb[2], rsb[2];
                { const int pos0 = (u.pm * 256 + wr * 64 + fr) & (SEQ - 1);
#pragma unroll
                  for (int n = 0; n < 2; ++n) { rcb[n] = *(const f32x4*)(p.ropec() + pos0 * 32 + 8 * fq + 4 * n); rsb[n] = *(const f32x4*)(p.ropes() + pos0 * 32 + 8 * fq + 4 * n); } }
                ROWS_LOOP { const int row = ROW_OF; const int ix = ai * 4 + m; const float rs = rsa[ix];
                    f32x4 a0[2], a1[2];
#pragma unroll
                    for (int n = 0; n < 2; ++n) { a0[n] = acc[ai][0][m][n] * rs; a1[n] = acc[ai][1][m][n] * rs; }
                    if (isqk) { float ss = 0.f;
#pragma unroll
                        for (int n = 0; n < 2; ++n)
#pragma unroll
                            for (int j = 0; j < 4; ++j) ss += a0[n][j] * a0[n][j] + a1[n][j] * a1[n][j];
                        ss += __shfl_xor(ss, 16); ss += __shfl_xor(ss, 32);
                        const float rn = __builtin_amdgcn_rsqf(ss * (1.f / 64.f) + RMS_EPS);
#pragma unroll
                        for (int n = 0; n < 2; ++n) { a0[n] = a0[n] * rn * g0[n]; a1[n] = a1[n] * rn * g1[n]; } }
                    u32x4 o0, o1;
#pragma unroll
                    for (int n = 0; n < 2; ++n) { const f32x4 cc = rcb[n], sn = rsb[n];
                        const f32x4 r0 = a0[n] * cc - a1[n] * sn, r1 = a1[n] * cc + a0[n] * sn;
                        o0[2 * n] = cvtpk(r0[0], r0[1]); o0[2 * n + 1] = cvtpk(r0[2], r0[3]); o1[2 * n] = cvtpk(r1[0], r1[1]); o1[2 * n + 1] = cvtpk(r1[2], r1[3]); }
                    if (ix < 7) { const int posn = (u.pm * 256 + ((ix + 1) >> 2) * 128 + wr * 64 + ((ix + 1) & 3) * 16 + fr) & (SEQ - 1);
#pragma unroll
                        for (int n = 0; n < 2; ++n) { rcb[n] = *(const f32x4*)(p.ropec() + posn * 32 + 8 * fq + 4 * n); rsb[n] = *(const f32x4*)(p.ropes() + posn * 32 + 8 * fq + 4 * n); } }
                    u16* d = dst + (size_t)row * pitch + head * 64 + 8 * fq;
                    *(u32x4*)d = o0; *(u32x4*)(d + 32) = o1; }
            }
        } else {
            u16* dst; int cb; int kind;
            if (pn < 14) { dst = p.v(); cb = (pn - 12) * 256; kind = 0; }
            else if (pn < 16) { dst = p.sg(); cb = (pn - 14) * 256; kind = 1; }
            else if (pn < 21) { dst = p.u(); cb = (pn - 19) * 256; kind = 0; }
            else { dst = p.sp(); cb = (pn - 21) * 256; kind = 2; }
            f32x4 sc[2][2];
#pragma unroll
            for (int bj = 0; bj < 2; ++bj)
#pragma unroll
                for (int n = 0; n < 2; ++n) sc[bj][n] = (kind == 2) ? *(const f32x4*)(p.pool_scale + l * 512 + cb + 16 * cl + bj * 8 + n * 4) : (f32x4){1.f, 1.f, 1.f, 1.f};
            ROWS_LOOP { const int row = ROW_OF; const float rs = rsa[ai * 4 + m];
#pragma unroll
                for (int bj = 0; bj < 2; ++bj) { f32x4 v0 = acc[ai][bj][m][0] * rs, v1 = acc[ai][bj][m][1] * rs;
                    if (kind >= 1) {
#pragma unroll
                        for (int j = 0; j < 4; ++j) { v0[j] = siluf(v0[j]) * sc[bj][0][j]; v1[j] = siluf(v1[j]) * sc[bj][1][j]; } }
                    u32x4 w; w[0] = cvtpk(v0[0], v0[1]); w[1] = cvtpk(v0[2], v0[3]); w[2] = cvtpk(v1[0], v1[1]); w[3] = cvtpk(v1[2], v1[3]);
                    *(u32x4*)(dst + (size_t)row * 512 + cb + 16 * cl + bj * 8) = w; } }
        }
    }
};
__device__ __forceinline__ void phase_in(const Params& p, int l, char* shm) {
    pg8::Gemm g{p.xb(), p.wt_in() + (size_t)l * NPA * 1024, T, NPA, 1024};
    pg8::StaticOrder S; S.init(T, NPA, GDIM(), BID());
    EpiIn E{p, l};
    pg8::gemm_phase((PG8_LAS unsigned char*)shm, g, S, E);
}
__device__ __forceinline__ void phase_mix(const Params& p, int l) {
    const float* cw = p.conv_w + l * 3 * 512;
    constexpr int RUN = 16;
    const int nitem = (T / RUN) * 256;
    const int it0 = BID() * NTHR + TID(), itstep = GDIM() * NTHR;
    for (int it = it0; it < nitem; it += itstep) {
        const int cp = it & 255, c = cp * 2, t0 = (it >> 8) * RUN, pos0 = t0 & (SEQ - 1);
        {
            const float w00 = cw[c], w01 = cw[c + 1], w10 = cw[512 + c], w11 = cw[513 + c], w20 = cw[1024 + c], w21 = cw[1025 + c];
            unsigned zr[RUN + 2], gr[RUN];
#pragma unroll
            for (int i = 0; i < RUN + 2; ++i) zr[i] = (pos0 + i - 2 >= 0) ? *(const unsigned*)(p.z() + (size_t)(t0 + i - 2) * 512 + c) : 0u;
#pragma unroll
            for (int i = 0; i < RUN; ++i) gr[i] = *(const unsigned*)(p.ga() + (size_t)(t0 + i) * 512 + c);
#pragma unroll
            for (int i = 0; i < RUN; ++i) {
                const float y0 = (w00 * bflo(zr[i]) + w10 * bflo(zr[i + 1]) + w20 * bflo(zr[i + 2])) * bflo(gr[i]);
                const float y1 = (w01 * bfhi(zr[i]) + w11 * bfhi(zr[i + 1]) + w21 * bfhi(zr[i + 2])) * bfhi(gr[i]);
                *(unsigned*)(p.ga() + (size_t)(t0 + i) * 512 + c) = cvtpk(y0, y1);
            }
        }
        {
            const int win = 2 << (c >> 7);
            unsigned ur[RUN + 15], gr[RUN];
#pragma unroll
            for (int i = 0; i < RUN + 15; ++i) ur[i] = (i >= 16 - win && pos0 + i - 15 >= 0) ? *(const unsigned*)(p.u() + (size_t)(t0 + i - 15) * 512 + c) : 0u;
#pragma unroll
            for (int i = 0; i < RUN; ++i) gr[i] = *(const unsigned*)(p.sp() + (size_t)(t0 + i) * 512 + c);
            float s0 = 0.f, s1 = 0.f;
#pragma unroll
            for (int i = 0; i < 15; ++i) { s0 += bflo(ur[i]); s1 += bfhi(ur[i]); }
#pragma unroll
            for (int i = 0; i < RUN; ++i) {
                const int pos = pos0 + i;
                const float u0 = bflo(ur[i + 15]), u1 = bfhi(ur[i + 15]);
                s0 += u0; s1 += u1;
                const float ic = __builtin_amdgcn_rcpf((float)min(pos + 1, win));
                *(unsigned*)(p.sp() + (size_t)(t0 + i) * 512 + c) = cvtpk((s0 * ic - u0) * bflo(gr[i]), (s1 * ic - u1) * bfhi(gr[i]));
                unsigned wo = 0u;
#pragma unroll
                for (int g = 0; g < 4; ++g) if (win == (2 << g)) wo = ur[i + 15 - ((2 << g) - 1)];
                s0 -= bflo(wo); s1 -= bfhi(wo);
            }
        }
    }
}

__device__ __forceinline__ int crow(int r, int hi) { return (r & 3) + 8 * (r >> 2) + 4 * hi; }
__device__ __forceinline__ size_t sc_base(int qb) { return (size_t)32768 * qb * (qb + 1); }
__device__ __forceinline__ void phase_indexer(const Params& p, int b, u16* scbuf, char* shm) {
    const int tid_ = TID(); const int wid = tid_ >> 6, lane = tid_ & 63, ql = lane & 15, fq = lane >> 4; const int bid_ = BID(), gdim_ = GDIM();
    constexpr int NSTEP = 64 * 65;
    const int f0 = (int)(((long)bid_ * NSTEP) / gdim_), f1 = (int)(((long)(bid_ + 1) * NSTEP) / gdim_);
    int qcur = -1;
    bf16x8 bq[8][2]; float wv[8]; u16* srow = nullptr; int qloc = 0;
    char* tl = shm + 40960 + wid * 2304;
#pragma unroll
    for (int h = 0; h < 8; ++h) { wv[h] = 0.f; bq[h][0] = bq[h][1] = (bf16x8){0, 0, 0, 0, 0, 0, 0, 0}; }
    const u16* ikb = p.ik() + ((size_t)b * SEQ + ql) * 64 + fq * 8;
    for (int f = f0; f < f1; ++f) {
        int q = (int)((sqrtf(4.f * f + 1.f) - 1.f) * 0.5f);
        while ((q + 1) * (q + 2) <= f) ++q;
        while (q * (q + 1) > f) --q;
        const int tt = f - q * (q + 1);
        if (q != qcur) {
            qcur = q; qloc = q * 128 + wid * 16 + ql;
            const size_t row = (size_t)b * SEQ + qloc;
#pragma unroll
            for (int h = 0; h < 8; ++h)
#pragma unroll
                for (int kc = 0; kc < 2; ++kc) bq[h][kc] = *(const bf16x8*)(p.iq() + row * 512 + h * 64 + kc * 32 + fq * 8);
            const f32x4 x = *(const f32x4*)(p.iw() + row * 8), y = *(const f32x4*)(p.iw() + row * 8 + 4);
            wv[0] = x[0]; wv[1] = x[1]; wv[2] = x[2]; wv[3] = x[3]; wv[4] = y[0]; wv[5] = y[1]; wv[6] = y[2]; wv[7] = y[3];
            const int a = q >> 1;
            srow = scbuf + sc_base(a) + (size_t)(q * 128 + wid * 16 + (lane >> 2) - a * 256) * (256 * (a + 1)) + (lane & 3) * 16;
        }
        const int key0 = tt * 64;
        bf16x8 ka[4][2];
#pragma unroll
        for (int kg = 0; kg < 4; ++kg)
#pragma unroll
            for (int kc = 0; kc < 2; ++kc) ka[kg][kc] = *(const bf16x8*)(ikb + (size_t)(key0 + kg * 16) * 64 + kc * 32);
        const bool band = (key0 + 63 > q * 128 + wid * 16);
#pragma unroll
        for (int kg = 0; kg < 4; ++kg) {
            f32x4 sacc = (f32x4){0.f, 0.f, 0.f, 0.f};
#pragma unroll
            for (int h = 0; h < 8; ++h) {
                f32x4 c = (f32x4){0.f, 0.f, 0.f, 0.f};
                c = __builtin_amdgcn_mfma_f32_16x16x32_bf16(ka[kg][0], bq[h][0], c, 0, 0, 0);
                c = __builtin_amdgcn_mfma_f32_16x16x32_bf16(ka[kg][1], bq[h][1], c, 0, 0, 0);
#pragma unroll
                for (int j = 0; j < 4; ++j) sacc[j] = __builtin_fmaf(wv[h], __builtin_fmaxf(c[j], 0.f), sacc[j]);
            }
            const int kb = key0 + kg * 16 + fq * 4;
            if (band) {
#pragma unroll
                for (int j = 0; j < 4; ++j) if (kb + j > qloc) sacc[j] = -INFINITY;
            }
            union { _Float16 h[4]; u32x2 v; } pk;
            pk.h[0] = (_Float16)sacc[0]; pk.h[1] = (_Float16)sacc[1]; pk.h[2] = (_Float16)sacc[2]; pk.h[3] = (_Float16)sacc[3];
            *(u32x2*)(tl + ql * 144 + kg * 32 + fq * 8) = pk.v;
        }
        { const u32x4 r0 = *(const u32x4*)(tl + (lane >> 2) * 144 + (lane & 3) * 32), r1 = *(const u32x4*)(tl + (lane >> 2) * 144 + (lane & 3) * 32 + 16);
          *(u32x4*)(srow + key0) = r0; *(u32x4*)(srow + key0 + 8) = r1; }
    }
}

__device__ __forceinline__ size_t mk_base(int qb) { return (size_t)512 * qb * (qb + 1); }
constexpr size_t MASK_WORDS_PER_BATCH = 540672;
__device__ __forceinline__ unsigned f16key(unsigned h) { return (h & 0x8000u) ? (~h & 0xffffu) : (h | 0x8000u); }
__device__ __forceinline__ void hist_scan(const unsigned* h, int lane, unsigned target, int& bin, unsigned& above, unsigned& inbin) {
    const u32x4 a = *(const u32x4*)(h + 4 * lane), b = *(const u32x4*)(h + 256 + 4 * lane), c = *(const u32x4*)(h + 512 + 4 * lane), d = *(const u32x4*)(h + 768 + 4 * lane);
    const unsigned h0 = a[0] + b[0] + c[0] + d[0], h1 = a[1] + b[1] + c[1] + d[1], h2 = a[2] + b[2] + c[2] + d[2], h3 = a[3] + b[3] + c[3] + d[3];
    const unsigned tot = h0 + h1 + h2 + h3;
    unsigned x = tot;
#pragma unroll
    for (int dd = 1; dd < 64; dd <<= 1) { const unsigned y = __shfl_down(x, dd); if (lane + dd < 64) x += y; }
    const unsigned ab = x - tot, c3 = ab + h3, c2 = c3 + h2, c1 = c2 + h1, c0 = c1 + h0;
    int fb = -1; unsigned fa = 0, fc = 0;
    if (ab < target && c3 >= target) { fb = 4 * lane + 3; fa = ab; fc = h3; }
    else if (c3 < target && c2 >= target) { fb = 4 * lane + 2; fa = c3; fc = h2; }
    else if (c2 < target && c1 >= target) { fb = 4 * lane + 1; fa = c2; fc = h1; }
    else if (c1 < target && c0 >= target) { fb = 4 * lane; fa = c1; fc = h0; }
    const u64 m = __ballot(fb >= 0); const int src = (m == 0) ? 0 : (__ffsll((unsigned long long)m) - 1);
    bin = __shfl(fb, src); above = __shfl(fa, src); inbin = __shfl(fc, src);
}
__device__ __forceinline__ unsigned f16key2(unsigned w) { const unsigned sg = (w >> 15) & 0x00010001u; return w ^ (((sg << 15) - sg) | 0x80008000u); }
__device__ __forceinline__ void phase_select(const Params& p, int b, char* shm, const u16* scbuf) {
    const int tid_ = TID(); const int wid = __builtin_amdgcn_readfirstlane(tid_ >> 6), lane = tid_ & 63;
    const int gw = BID() * 8 + wid, nw = GDIM() * 8;
    unsigned* hist = (unsigned*)shm + wid * 1152;
    const int hsubi = (lane >> 4) * 256, dummyi = 1024 + lane;
    typedef unsigned short us2 __attribute__((ext_vector_type(2)));
#define ROW_T(i_) ({ const int kq_ = (i_) / nw; ((mirror && (kq_ & 1)) ? (kq_ * nw + (nw - 1 - ((i_) - kq_ * nw))) : (i_)); })
#define ROW_LOAD(t_) do { const int qb_ = (t_) >> 8, ntr_ = 2 * (((t_) >> 7) + 1), nch_ = (ntr_ + 7) >> 3; \
        const u16* sr_ = scbuf + sc_base(qb_) + (size_t)((t_) - qb_ * 256) * (256 * (qb_ + 1)); \
        _Pragma("unroll") for (int c = 0; c < 16; ++c) { raw[c] = (u32x4){0u, 0u, 0u, 0u}; if (c < nch_) { if (lane < 8 * (ntr_ - 8 * c)) raw[c] = *(const u32x4*)(sr_ + 512 * c + 8 * lane); } } } while (0)
    const bool mirror = (SEQ % (2 * nw)) == 0;
    u32x4 raw[16];
    if (gw < SEQ) { const int t0_ = ROW_T(gw); ROW_LOAD(t0_); }
    for (int i = gw; i < SEQ; i += nw) {
        const int t = ROW_T(i);
        const int qb = t >> 8, ntile = 4 * (qb + 1), ntr = 2 * ((t >> 7) + 1);
        const int nch = (ntr + 7) >> 3, nchw = (ntile + 7) >> 3;
        unsigned char* mrow = (unsigned char*)(p.mask() + (size_t)b * MASK_WORDS_PER_BATCH + mk_base(qb) + (size_t)(t - qb * 256) * ntile);
        unsigned key[16][4];
#pragma unroll
        for (int c = 0; c < 16; ++c) {
            const bool valid = (c < nch) && (lane < 8 * (ntr - 8 * c));
#pragma unroll
            for (int r = 0; r < 4; ++r) key[c][r] = valid ? f16key2(raw[c][r]) : 0u;
        }
        if (i + nw < SEQ) { const int tn_ = ROW_T(i + nw); ROW_LOAD(tn_); }
        unsigned thrm1 = 0x03ffu, thr = 0x0400u; int need = 0; bool fast = true;
        if (t >= 256) {
            us2 a1 = (us2){0, 0}, a2 = (us2){0, 0};
#pragma unroll
            for (int c = 0; c < 16; ++c) {
                if (c < nch) {
#pragma unroll
                    for (int r = 0; r < 4; ++r) { const us2 kk = __builtin_bit_cast(us2, key[c][r]);
                        const us2 tmx = __builtin_elementwise_max(a1, kk), tmn = __builtin_elementwise_min(a1, kk); a1 = tmx; a2 = __builtin_elementwise_max(a2, tmn); }
                }
            }
            unsigned Lb = min((unsigned)a2[0], (unsigned)a2[1]);
#pragma unroll
            for (int m_ = 32; m_ >= 1; m_ >>= 1) Lb = min(Lb, (unsigned)__shfl_xor((int)Lb, m_));
            Lb = __builtin_amdgcn_readfirstlane(Lb);
            const u32x4 z4 = (u32x4){0u, 0u, 0u, 0u};
#pragma unroll
            for (int c = 0; c < 4; ++c) *(u32x4*)(hist + c * 256 + 4 * lane) = z4;
#pragma unroll
            for (int c = 0; c < 16; ++c) {
                if (c < nch) {
#pragma unroll
                    for (int r = 0; r < 4; ++r) { const unsigned kk = key[c][r]; const unsigned lo = kk & 0xffffu, hi = kk >> 16;
                        atomicAdd(hist + ((lo >= Lb) ? (hsubi + (int)(lo >> 8)) : dummyi), 1u);
                        atomicAdd(hist + ((hi >= Lb) ? (hsubi + (int)(hi >> 8)) : dummyi), 1u); }
                }
            }
            asm volatile("s_waitcnt lgkmcnt(0)" ::: "memory");
            int B1; unsigned ab1, in1;
            hist_scan(hist, lane, 256u, B1, ab1, in1);
            asm volatile("s_waitcnt lgkmcnt(0)" ::: "memory");
#pragma unroll
            for (int c = 0; c < 4; ++c) *(u32x4*)(hist + c * 256 + 4 * lane) = z4;
#pragma unroll
            for (int c = 0; c < 16; ++c) {
                if (c < nch) {
#pragma unroll
                    for (int r = 0; r < 4; ++r) { const unsigned kk = key[c][r]; const unsigned lo = kk & 0xffffu, hi = kk >> 16;
                        const bool ml = ((lo >> 8) == (unsigned)B1) && (lo >= Lb), mh = ((hi >> 8) == (unsigned)B1) && (hi >= Lb);
                        if (__any(ml || mh)) { if (ml) atomicAdd(hist + hsubi + (int)(lo & 255u), 1u); if (mh) atomicAdd(hist + hsubi + (int)(hi & 255u), 1u); } }
                }
            }
            asm volatile("s_waitcnt lgkmcnt(0)" ::: "memory");
            int B2; unsigned ab2, in2;
            hist_scan(hist, lane, 256u - ab1, B2, ab2, in2);
            asm volatile("s_waitcnt lgkmcnt(0)" ::: "memory");
            thr = __builtin_amdgcn_readfirstlane(((unsigned)B1 << 8) | (unsigned)B2);
            need = __builtin_amdgcn_readfirstlane(256 - (int)(ab1 + ab2));
            const int neq = __builtin_amdgcn_readfirstlane((int)in2);
            fast = (need == neq);
            thrm1 = thr - 1u;
        }
        if (fast) {
#pragma unroll
            for (int c = 0; c < 16; ++c) {
                if (c < nchw) {
                    unsigned m = 0u;
#pragma unroll
                    for (int ii = 7; ii >= 0; --ii) { const unsigned kk = key[c][ii >> 1]; const unsigned kv = (ii & 1) ? (kk >> 16) : (kk & 0xffffu); m = m + m + ((kv > thrm1) ? 1u : 0u); }
                    if (64 * c + lane < 8 * ntile) mrow[64 * c + lane] = (unsigned char)m;
                }
            }
        } else {
            int base = 0;
#pragma unroll 1
            for (int c = 0; c < 16; ++c) {
                if (c < nchw) {
                    unsigned m = 0u, e = 0u;
#pragma unroll
                    for (int ii = 7; ii >= 0; --ii) { unsigned kk = (ii >> 1) == 0 ? key[0][0] : 0u;
#pragma unroll
                        for (int cc = 0; cc < 16; ++cc) if (cc == c) kk = key[cc][ii >> 1];
                        const unsigned kv = (ii & 1) ? (kk >> 16) : (kk & 0xffffu); m = m + m + ((kv > thr) ? 1u : 0u); e = e + e + ((kv == thr) ? 1u : 0u); }
                    const int cnt = __builtin_popcount(e);
                    int pre = cnt;
#pragma unroll
                    for (int dd = 1; dd < 64; dd <<= 1) { const int y = __shfl_up(pre, dd); if (lane >= dd) pre += y; }
                    const int tot = __shfl(pre, 63);
                    int rank = base + pre - cnt;
#pragma unroll
                    for (int ii = 0; ii < 8; ++ii) if ((e >> ii) & 1u) { if (rank < need) m |= (1u << ii); ++rank; }
                    base += tot;
                    if (64 * c + lane < 8 * ntile) mrow[64 * c + lane] = (unsigned char)m;
                }
            }
        }
    }
}

constexpr int A_D = 64, A_DM = 512, A_NW = 8, A_QBLK = 32, A_QB = 256, A_KVBLK = 64, A_NQB = SEQ / A_QB, A_NHEAD = 8;
constexpr float A_C2 = 0.125f * 1.4426950408889634f;
constexpr int A_SLOTB = 8192, A_LDS_K = 0, A_LDS_V = 3 * A_SLOTB, A_LDS_WS = 6 * A_SLOTB, A_LDS_OST = A_LDS_WS + A_NW * 256, A_LDS_MK = A_LDS_OST + A_NW * 4096, A_LDS_BYTES = A_LDS_MK + A_NW * 2048;
#define ATTN_THR 8
#define SBAR() __builtin_amdgcn_sched_barrier(0)
#define PIN(x) asm volatile("" : "+v"(x))
#define MFMA32(a, b, c) __builtin_amdgcn_mfma_f32_32x32x16_bf16(a, b, c, 0, 0, 0)
#define WAIT_BAR(N) asm volatile("s_waitcnt vmcnt(" #N ") lgkmcnt(0)\n\ts_barrier" ::: "memory")
__device__ __forceinline__ void glds16s(const void* sbase, unsigned voff, unsigned lds_base) {
    unsigned sv; asm volatile("s_mov_b32 %0, m0\n\ts_mov_b32 m0, %3\n\ts_nop 0\n\tglobal_load_lds_dwordx4 %1, %2\n\ts_mov_b32 m0, %0" : "=&s"(sv) : "v"(voff), "s"(sbase), "s"(lds_base) : "memory"); }
typedef __attribute__((address_space(3))) const char* lds_cptr;
typedef short v4i16_t __attribute__((ext_vector_type(4)));
__device__ __forceinline__ void kload2(bf16x8* kf, lds_cptr kp, int d0) { kf[2 * d0] = *(const __attribute__((address_space(3))) bf16x8*)(kp + d0 * 2048); kf[2 * d0 + 1] = *(const __attribute__((address_space(3))) bf16x8*)(kp + d0 * 2048 + 512); }
__device__ __forceinline__ s16x4 vtr(lds_cptr p) { return __builtin_bit_cast(s16x4, __builtin_amdgcn_ds_read_tr16_b64_v4i16((__attribute__((address_space(3))) v4i16_t*)p)); }
#define MX3(a, b, c) __builtin_fmaxf(__builtin_fmaxf((a), (b)), (c))
__device__ __forceinline__ float rowmax(const f32x16& p0, const f32x16& p1) {
    float a = MX3(p0[0], p0[1], p1[0]), b = MX3(p0[2], p0[3], p1[1]); a = MX3(a, p1[2], p1[3]);
#pragma unroll
    for (int r = 4; r < 16; r += 4) { a = MX3(a, p0[r], p0[r + 1]); b = MX3(b, p0[r + 2], p0[r + 3]); a = MX3(a, p1[r], p1[r + 1]); b = MX3(b, p1[r + 2], p1[r + 3]); }
    float m = __builtin_fmaxf(a, b); auto rr = __builtin_amdgcn_permlane32_swap(__float_as_uint(m), __float_as_uint(m), false, false);
    return __builtin_fmaxf(__uint_as_float(rr[0]), __uint_as_float(rr[1])); }
__device__ __forceinline__ void cmask(f32x16& p0, f32x16& p1, int jb, int qrel, int hi) {
    const int kb = 64 * jb + 4 * hi;
#pragma unroll
    for (int r = 0; r < 16; ++r) { const int kv = kb + (r & 3) + 8 * (r >> 2); if (kv > qrel) p0[r] = -INFINITY; if (kv + 32 > qrel) p1[r] = -INFINITY; } }
__device__ __forceinline__ float mand(float x, unsigned w, int pos) { return __uint_as_float(__float_as_uint(x) & (unsigned)__builtin_amdgcn_sbfe((int)w, pos, 1)); }
#define BITP(i) (((i) & 3) + 8 * ((i) >> 2))

__device__ __forceinline__ void attn64_unit(int b, int h, int qb, const u16* Q, const u16* __restrict__ K, const u16* __restrict__ V, const u16* __restrict__ SG, u16* O, const u64* mrow0, char* lds) {
    const int tid = TID(), lane = tid & 63, r32 = lane & 31, hi = lane >> 5; const int wid = __builtin_amdgcn_readfirstlane(tid >> 6);
    const long rowbase = (long)b * SEQ; const int q0 = qb * A_QB, NT = (q0 + A_QB) / A_KVBLK;
    const u16* Qw = Q + (rowbase + q0 + wid * A_QBLK) * A_DM + h * A_D;
    const unsigned lds0 = (unsigned)(uintptr_t)lds; float* wsf = (float*)(lds + A_LDS_WS) + wid * 64;
    const u16* kbase = K + rowbase * A_DM + h * A_D; const u16* vbase = V + rowbase * A_DM + h * A_D;
    const unsigned koff = (unsigned)(lane * A_DM + wid * 8) * 2u;
    const unsigned voff = (unsigned)((16 * (wid & 3) + (lane >> 2)) * A_DM + (wid >> 2) * 32 + (lane & 3) * 8) * 2u;
    const unsigned kdst = lds0 + A_LDS_K + wid * 1024, vdst = lds0 + A_LDS_V + wid * 1024;
#define DMA_K(t, slot) glds16s(kbase + (long)(t) * A_KVBLK * A_DM, koff, (unsigned)__builtin_amdgcn_readfirstlane(kdst + (slot)))
#define DMA_V(t, slot) glds16s(vbase + (long)(t) * A_KVBLK * A_DM, voff, (unsigned)__builtin_amdgcn_readfirstlane(vdst + (slot)))
#define DMA_M(chunk) glds16s(mrow0 + 2 * (chunk), moff, (unsigned)__builtin_amdgcn_readfirstlane(mdst + ((chunk) & 1) * 1024))
#define MWORD(t) (*(const u64*)(lds + A_LDS_MK + wid * 2048 + (((t) >> 1) & 1) * 1024 + r32 * 16 + ((t) & 1) * 8))
    const lds_cptr vp0 = (lds_cptr)lds + A_LDS_V + ((lane >> 4) & 1) * 32 + (lane & 3) * 8 + (4 * hi + ((lane & 15) >> 2)) * 64;
    const lds_cptr kp0 = (lds_cptr)lds + A_LDS_K + hi * 1024 + r32 * 16;
    const int qrel = wid * A_QBLK + r32;
    const unsigned moff = (unsigned)(qrel * NT) * 8u;
    const unsigned mdst = lds0 + A_LDS_MK + wid * 2048;
    DMA_M(0);
    DMA_K(0, 0); DMA_V(0, 0); DMA_K(1, A_SLOTB);
    bf16x8 qr[4];
#pragma unroll
    for (int d0 = 0; d0 < 4; ++d0) qr[d0] = *reinterpret_cast<const bf16x8*>(&Qw[(long)r32 * A_DM + d0 * 16 + hi * 8]);
    float mhat = 0.f, l_reg = 0.f; f32x16 o[2]; o[0] = f32x16{}; o[1] = f32x16{};
    const f32x16 zero16 = f32x16{};
    bool resc = false;
    f32x16 pA0, pA1, pB0, pB1; bf16x8 kf[8]; s16x4 vlo[8], vhi[8]; u32x4 pw0, pw1, pw2, pw3;
    typedef unsigned u32x16 __attribute__((ext_vector_type(16)));
    u32x16 mk0, mk1;
    int sl_prev = 0, sl_cur = 0, sl_next = A_SLOTB;
    const int sh4 = 4 * hi;
#define ROT() do { sl_prev = sl_cur; sl_cur = sl_next; sl_next = (sl_next == 2 * A_SLOTB) ? 0 : sl_next + A_SLOTB; } while (0)
#define EX(v) __builtin_amdgcn_exp2f(__builtin_fmaf((v), A_C2, nmh))
#define RESC() do { if (resc) { _Pragma("unroll") for (int d_ = 0; d_ < 2; ++d_) _Pragma("unroll") for (int r = 0; r < 16; ++r) o[d_][r] *= wsf[crow(r, hi)]; } } while (0)
    DMA_K(2, 2 * A_SLOTB);
    WAIT_BAR(3);
    _Pragma("unroll") for (int d0 = 0; d0 < 4; ++d0) kload2(kf, kp0, d0);
    pA0 = MFMA32(kf[0], qr[0], zero16); pA1 = MFMA32(kf[1], qr[0], zero16); pA0 = MFMA32(kf[2], qr[1], pA0); pA1 = MFMA32(kf[3], qr[1], pA1);
    pA0 = MFMA32(kf[4], qr[2], pA0); pA1 = MFMA32(kf[5], qr[2], pA1); pA0 = MFMA32(kf[6], qr[3], pA0); pA1 = MFMA32(kf[7], qr[3], pA1);
    { const float rm = rowmax(pA0, pA1); mhat = rm * A_C2; const float nmh = -mhat;
      const u64 mw0 = MWORD(0); const unsigned wl = (unsigned)mw0 >> sh4, wh = (unsigned)(mw0 >> 32) >> sh4;
#pragma unroll
      for (int r = 0; r < 16; ++r) { pA0[r] = mand(EX(pA0[r]), wl, BITP(r)); pA1[r] = mand(EX(pA1[r]), wh, BITP(r)); } }
    WAIT_BAR(0);
    DMA_K(3, 0); DMA_V(1, A_SLOTB); ROT();
    _Pragma("unroll") for (int d0 = 0; d0 < 4; ++d0) kload2(kf, kp0 + sl_cur, d0);
    WAIT_BAR(2);
#define PKW(P, i) cvtpk(P[i], P[i + 1])
#define PAF(k) __builtin_bit_cast(bf16x8, pw##k)
#define VFR(i) (bf16x8){vlo[i][0], vlo[i][1], vlo[i][2], vlo[i][3], vhi[i][0], vhi[i][1], vhi[i][2], vhi[i][3]}
#define VRD(i) do { vlo[i] = vtr(vp_ + (((i) >> 2) * 4096 + ((i) & 3) * 1024)); vhi[i] = vtr(vp_ + (((i) >> 2) * 4096 + ((i) & 3) * 1024 + 512)); } while (0)
#define KRD(G, d0) do { if (G) { kload2(kf, kp0 + sl_next, d0); SBAR(); } } while (0)
#define GAPA(MF, a0, a1, a2, a3, W0, W1, PW, MK, WW, i) do { MF; sacc += a0; sacc += a1; sacc += a2; sacc += a3; W0; W1; \
    MK[i] = (unsigned)__builtin_amdgcn_sbfe((int)(WW), BITP(i), 1); MK[i + 1] = (unsigned)__builtin_amdgcn_sbfe((int)(WW), BITP(i + 1), 1); MK[i + 2] = (unsigned)__builtin_amdgcn_sbfe((int)(WW), BITP(i + 2), 1); MK[i + 3] = (unsigned)__builtin_amdgcn_sbfe((int)(WW), BITP(i + 3), 1); \
    PIN(PW); PIN(sacc); PIN(MK); SBAR(); } while (0)
#define MAND(x, m) __uint_as_float(__float_as_uint(x) & (m))
#define GAPB(MF, X, i, MK) do { MF; X[i] = MAND(EX(X[i]), MK[i]); X[i + 1] = MAND(EX(X[i + 1]), MK[i + 1]); X[i + 2] = MAND(EX(X[i + 2]), MK[i + 2]); X[i + 3] = MAND(EX(X[i + 3]), MK[i + 3]); PIN(X); SBAR(); } while (0)
#define STEP(C0, C1, P0, P1, t, MASK, GK, GV, GL, ML) do { SBAR(); \
    if (ML) DMA_M(((t) + 1) >> 1); \
    const u64 mw_ = MWORD(t); const unsigned wl_ = (unsigned)(mw_) >> sh4, wh_ = (unsigned)((mw_) >> 32) >> sh4; \
    const lds_cptr vp_ = vp0 + sl_prev; \
    VRD(0); SBAR(); float sacc = P0[0] + P0[1]; \
                    GAPA(C0 = MFMA32(kf[0], qr[0], zero16), P0[2], P0[3], P0[4], P0[5],     pw0[0] = PKW(P0, 0),  pw0[1] = PKW(P0, 2),  pw0, mk0, wl_, 0); \
    VRD(4); SBAR(); GAPA(C1 = MFMA32(kf[1], qr[0], zero16), P0[6], P0[7], P0[8], P0[9],     pw0[2] = PKW(P0, 4),  pw0[3] = PKW(P0, 6),  pw0, mk0, wl_, 4); \
    VRD(1); SBAR(); GAPA(C0 = MFMA32(kf[2], qr[1], C0),    P0[10], P0[11], P0[12], P0[13], pw1[0] = PKW(P0, 8),  pw1[1] = PKW(P0, 10), pw1, mk0, wl_, 8); \
    VRD(5); SBAR(); GAPA(C1 = MFMA32(kf[3], qr[1], C1),    P0[14], P0[15], P1[0], P1[1],   pw1[2] = PKW(P0, 12), pw1[3] = PKW(P0, 14), pw1, mk0, wl_, 12); \
    VRD(2); SBAR(); GAPA(C0 = MFMA32(kf[4], qr[2], C0),    P1[2], P1[3], P1[4], P1[5],     pw2[0] = PKW(P1, 0),  pw2[1] = PKW(P1, 2),  pw2, mk1, wh_, 0); \
    VRD(6); SBAR(); GAPA(C1 = MFMA32(kf[5], qr[2], C1),    P1[6], P1[7], P1[8], P1[9],     pw2[2] = PKW(P1, 4),  pw2[3] = PKW(P1, 6),  pw2, mk1, wh_, 4); \
    VRD(3); SBAR(); GAPA(C0 = MFMA32(kf[6], qr[3], C0),    P1[10], P1[11], P1[12], P1[13], pw3[0] = PKW(P1, 8),  pw3[1] = PKW(P1, 10), pw3, mk1, wh_, 8); \
    VRD(7); SBAR(); GAPA(C1 = MFMA32(kf[7], qr[3], C1),    P1[14], P1[15], 0.f, 0.f,       pw3[2] = PKW(P1, 12), pw3[3] = PKW(P1, 14), pw3, mk1, wh_, 12); \
    l_reg += sacc; \
    if (GK) DMA_K((t) + 3, sl_cur); if (GV) DMA_V((t) + 1, sl_next); \
    { const float rm = __builtin_fmaf(rowmax(C0, C1), A_C2, -mhat); resc = false; \
      if (__builtin_expect(__any(rm > (float)ATTN_THR), 0)) { const float dl = __builtin_fmaxf(rm, 0.f); mhat += dl; \
          const float f = __builtin_amdgcn_exp2f(-dl); l_reg *= f; if (hi == 0) wsf[r32] = f; resc = true; } } \
    const float nmh = -mhat; SBAR(); \
    GAPB(o[0] = MFMA32(PAF(0), VFR(0), o[0]), C0, 0, mk0);              GAPB(o[1] = MFMA32(PAF(0), VFR(4), o[1]), C0, 4, mk0); \
    KRD(GL, 0); GAPB(o[0] = MFMA32(PAF(1), VFR(1), o[0]), C0, 8, mk0);  KRD(GL, 1); GAPB(o[1] = MFMA32(PAF(1), VFR(5), o[1]), C0, 12, mk0); \
    KRD(GL, 2); GAPB(o[0] = MFMA32(PAF(2), VFR(2), o[0]), C1, 0, mk1);  KRD(GL, 3); GAPB(o[1] = MFMA32(PAF(2), VFR(6), o[1]), C1, 4, mk1); \
    GAPB(o[0] = MFMA32(PAF(3), VFR(3), o[0]), C1, 8, mk1);              GAPB(o[1] = MFMA32(PAF(3), VFR(7), o[1]), C1, 12, mk1); \
    } while (0)
    int t = 1;
    for (; t + 5 < NT; t += 2) {
        STEP(pB0, pB1, pA0, pA1, t, false, true, true, true, true);      WAIT_BAR(2); RESC(); ROT();
        STEP(pA0, pA1, pB0, pB1, t + 1, false, true, true, true, false); WAIT_BAR(2); RESC(); ROT();
    }
#define ENDW(tt) do { if ((tt) + 3 < NT) { WAIT_BAR(2); } else if ((tt) + 2 < NT) { WAIT_BAR(1); } else { WAIT_BAR(0); } } while (0)
    for (; t + 1 < NT; t += 2) {
        STEP(pB0, pB1, pA0, pA1, t, true, (t + 3 < NT), (t + 1 < NT), (t + 1 < NT), (t + 1 < NT));         ENDW(t);     RESC(); ROT();
        STEP(pA0, pA1, pB0, pB1, t + 1, true, (t + 4 < NT), (t + 2 < NT), (t + 2 < NT), false);            ENDW(t + 1); RESC(); ROT();
    }
    STEP(pB0, pB1, pA0, pA1, NT - 1, true, false, false, false, false); RESC();
    { float sacc = pB0[0] + pB0[1];
#pragma unroll
      for (int r = 2; r < 16; ++r) sacc += pB0[r];
#pragma unroll
      for (int r = 0; r < 16; ++r) sacc += pB1[r];
      l_reg += sacc;
      pw0 = (u32x4){PKW(pB0, 0), PKW(pB0, 2), PKW(pB0, 4), PKW(pB0, 6)}; pw1 = (u32x4){PKW(pB0, 8), PKW(pB0, 10), PKW(pB0, 12), PKW(pB0, 14)};
      pw2 = (u32x4){PKW(pB1, 0), PKW(pB1, 2), PKW(pB1, 4), PKW(pB1, 6)}; pw3 = (u32x4){PKW(pB1, 8), PKW(pB1, 10), PKW(pB1, 12), PKW(pB1, 14)};
      const lds_cptr vp_ = vp0 + sl_cur; _Pragma("unroll") for (int i = 0; i < 8; ++i) VRD(i);
      o[0] = MFMA32(PAF(0), VFR(0), o[0]); o[1] = MFMA32(PAF(0), VFR(4), o[1]); o[0] = MFMA32(PAF(1), VFR(1), o[0]); o[1] = MFMA32(PAF(1), VFR(5), o[1]);
      o[0] = MFMA32(PAF(2), VFR(2), o[0]); o[1] = MFMA32(PAF(2), VFR(6), o[1]); o[0] = MFMA32(PAF(3), VFR(3), o[0]); o[1] = MFMA32(PAF(3), VFR(7), o[1]); }
    { auto rr = __builtin_amdgcn_permlane32_swap(__float_as_uint(l_reg), __float_as_uint(l_reg), false, false); l_reg = __uint_as_float(rr[0]) + __uint_as_float(rr[1]); }
    if (hi == 0) wsf[32 + r32] = l_reg; asm volatile("s_waitcnt lgkmcnt(0)" ::: "memory");
    float rli[16];
#pragma unroll
    for (int r = 0; r < 16; ++r) rli[r] = __builtin_amdgcn_rcpf(wsf[32 + crow(r, hi)]);
    u16* Ow = O + (rowbase + q0 + wid * A_QBLK) * A_DM + h * A_D; const u16* Gw = SG + (rowbase + q0 + wid * A_QBLK) * A_DM + h * A_D;
    u16* stg = (u16*)(lds + A_LDS_OST) + wid * 2048;
#pragma unroll
    for (int r = 0; r < 16; ++r) { const int orow = crow(r, hi);
#pragma unroll
        for (int d0 = 0; d0 < 2; ++d0) stg[orow * 64 + d0 * 32 + r32] = f2bf(o[d0][r] * rli[r]); }
    asm volatile("s_waitcnt lgkmcnt(0)" ::: "memory");
#pragma unroll
    for (int i = 0; i < 4; ++i) { const int row = i * 8 + (lane >> 3), ch = lane & 7;
        u32x4 ov = *(const u32x4*)(stg + row * 64 + ch * 8); u32x4 gv = *(const u32x4*)(Gw + (long)row * A_DM + ch * 8); u32x4 rv;
#pragma unroll
        for (int e = 0; e < 4; ++e) rv[e] = cvtpk(bflo(ov[e]) * bflo(gv[e]), bfhi(ov[e]) * bfhi(gv[e]));
        *(u32x4*)(Ow + (long)row * A_DM + ch * 8) = rv; }
    asm volatile("s_waitcnt vmcnt(0) lgkmcnt(0)\n\ts_barrier" ::: "memory");
#undef DMA_K
#undef DMA_V
#undef DMA_M
#undef MWORD
#undef ROT
#undef EX
#undef RESC
#undef PKW
#undef PAF
#undef VFR
#undef VRD
#undef KRD
#undef ENDW
#undef GAPA
#undef GAPB
#undef MAND
#undef STEP
}
__device__ __forceinline__ void phase_attn(const Params& p, char* lds) {
    constexpr int NPAIR = A_NQB / 2, NUNIT = NBATCH * A_NHEAD * NPAIR;
    const int bid_ = BID(), gdim_ = GDIM();
    for (int u = bid_; u < NUNIT; u += gdim_) {
        const int x = u & 7, kk = u >> 3, bh = x + 8 * (kk / NPAIR), j = kk % NPAIR;
        const int b = bh / A_NHEAD, h = bh % A_NHEAD;
        const u64* mb = p.mask() + (size_t)b * MASK_WORDS_PER_BATCH;
        attn64_unit(b, h, j, p.q(), p.k(), p.v(), p.sg(), p.bin(), mb + mk_base(j), lds);
        attn64_unit(b, h, A_NQB - 1 - j, p.q(), p.k(), p.v(), p.sg(), p.bin(), mb + mk_base(A_NQB - 1 - j), lds);
    }
}

struct EpiStash {
    static constexpr bool DUPOK = false;
    u16* stash;
    __device__ __forceinline__ void operator()(const acc_t& acc, const pg8::Unit& u, int ui, int wr, int wc, int fr, int fq) const {
        const int tid_ = TID();
        u32x4* st = (u32x4*)(stash + (size_t)(u.pm * 4 + u.pn) * 65536);
        ROWS_LOOP {
#pragma unroll
            for (int bj = 0; bj < 2; ++bj) { const f32x4 v0 = acc[ai][bj][m][0], v1 = acc[ai][bj][m][1];
                u32x4 w; w[0] = cvtpk(v0[0], v0[1]); w[1] = cvtpk(v0[2], v0[3]); w[2] = cvtpk(v1[0], v1[1]); w[3] = cvtpk(v1[2], v1[3]);
                st[((ai * 4 + m) * 2 + bj) * 512 + tid_] = w; } }
    }
};
struct EpiGate {
    static constexpr bool DUPOK = false;
    const Params& p; int l; int br;
    __device__ __forceinline__ void operator()(const acc_t& acc, const pg8::Unit& u, int ui, int wr, int wc, int fr, int fq) const {
        const float* ssq = p.sumsq() + (size_t)(l & 1) * T * 16;
        const int tid_ = TID();
        const u32x4* st = (const u32x4*)(p.stash() + (size_t)(u.pm * 4 + u.pn) * 65536);
        const int cl = wc * 4 + fq;
        __shared__ float s_rstd[256];
        { if (tid_ < 256) s_rstd[tid_] = row_rstd(ssq, u.pm * 256 + tid_); __syncthreads(); }
        float rsa[8];
#pragma unroll
        for (int ix = 0; ix < 8; ++ix) rsa[ix] = s_rstd[(ix >> 2) * 128 + wr * 64 + (ix & 3) * 16 + fr];
        const char* stp = (const char*)st + (size_t)tid_ * 16;
        char* mpp = (char*)(p.merged() + (size_t)(u.pm * 256 + wr * 64 + fr) * 1024 + u.pn * 256 + 16 * cl);
        u32x4 yb = *(const u32x4*)stp, ob = (br > 0) ? *(const u32x4*)mpp : (u32x4){0u, 0u, 0u, 0u};
        ROWS_LOOP { const int ix = ai * 4 + m; const float rs = rsa[ix];
#pragma unroll
            for (int bj = 0; bj < 2; ++bj) { const f32x4 v0 = acc[ai][bj][m][0] * rs, v1 = acc[ai][bj][m][1] * rs;
                float r[8];
                r[0] = sigmf(v0[0]) * bflo(yb[0]); r[1] = sigmf(v0[1]) * bfhi(yb[0]); r[2] = sigmf(v0[2]) * bflo(yb[1]); r[3] = sigmf(v0[3]) * bfhi(yb[1]);
                r[4] = sigmf(v1[0]) * bflo(yb[2]); r[5] = sigmf(v1[1]) * bfhi(yb[2]); r[6] = sigmf(v1[2]) * bflo(yb[3]); r[7] = sigmf(v1[3]) * bfhi(yb[3]);
                if (br > 0) {
#pragma unroll
                    for (int e = 0; e < 4; ++e) { r[2 * e] += bflo(ob[e]); r[2 * e + 1] += bfhi(ob[e]); } }
                u32x4 wo; wo[0] = cvtpk(r[0], r[1]); wo[1] = cvtpk(r[2], r[3]); wo[2] = cvtpk(r[4], r[5]); wo[3] = cvtpk(r[6], r[7]);
                const char* stn = stp + 8192; char* mpn = (bj == 0) ? (mpp + 16) : (mpp - 16 + ((ix == 3) ? 80 : 16) * 2048);
                asm volatile("" : "+v"(stn), "+v"(mpn));
                if (!(ix == 7 && bj == 1)) { yb = *(const u32x4*)stn; if (br > 0) ob = *(const u32x4*)mpn; }
                *(u32x4*)mpp = wo;
                stp = stn; mpp = mpn; } }
    }
};
__device__ __forceinline__ void phase_merge(const Params& p, int l, char* shm) {
    pg8::RowOrder S{4, 512, GDIM(), BID()};
    for (int br = 0; br < 3; ++br) {
        const u16* Ain = br == 0 ? p.ga() : (br == 1 ? p.bin() : p.sp());
        const u16* Wy = (br == 0 ? p.wt_oa() : (br == 1 ? p.wt_ob() : p.wt_oc())) + (size_t)l * 1024 * 512;
        { pg8::Gemm g{Ain, Wy, T, 1024, 512}; EpiStash E{p.stash()}; pg8::gemm_phase((PG8_LAS unsigned char*)shm, g, S, E); }
        { pg8::Gemm g{p.xb(), p.wt_mg() + (size_t)l * 3072 * 1024 + (size_t)br * 1024 * 1024, T, 1024, 1024}; EpiGate E{p, l, br}; pg8::gemm_phase((PG8_LAS unsigned char*)shm, g, S, E); }
    }
}

struct EpiOut {
    static constexpr bool DUPOK = false;
    const Params& p; int l;
    __device__ __forceinline__ void ldx(size_t o, f32x4& a, f32x4& b) const {
        if (l == 0) { a = *(const f32x4*)(p.x_in + o); b = *(const f32x4*)(p.x_in + o + 4); }
        else { const u32x4 w = *(const u32x4*)(p.xb() + o); a = (f32x4){bflo(w[0]), bfhi(w[0]), bflo(w[1]), bfhi(w[1])}; b = (f32x4){bflo(w[2]), bfhi(w[2]), bflo(w[3]), bfhi(w[3])}; }
    }
    __device__ __forceinline__ void operator()(const acc_t& acc, const pg8::Unit& u, int ui, int wr, int wc, int fr, int fq) const {
        const int cl = wc * 4 + fq;
        f32x4 xb0[2], xb1[2];
#pragma unroll
        for (int bj = 0; bj < 2; ++bj) ldx((size_t)(u.pm * 256 + wr * 64 + fr) * 1024 + u.pn * 256 + 16 * cl + bj * 8, xb0[bj], xb1[bj]);
        ROWS_LOOP { const int row = ROW_OF; const int ix = ai * 4 + m; float ss = 0.f;
            f32x4 x0[2], x1[2];
#pragma unroll
            for (int bj = 0; bj < 2; ++bj) { x0[bj] = xb0[bj] + acc[ai][bj][m][0]; x1[bj] = xb1[bj] + acc[ai][bj][m][1]; }
            if (ix < 7) { const int rown = u.pm * 256 + ((ix + 1) >> 2) * 128 + wr * 64 + ((ix + 1) & 3) * 16 + fr;
#pragma unroll
                for (int bj = 0; bj < 2; ++bj) ldx((size_t)rown * 1024 + u.pn * 256 + 16 * cl + bj * 8, xb0[bj], xb1[bj]); }
#pragma unroll
            for (int bj = 0; bj < 2; ++bj) { const size_t o = (size_t)row * 1024 + u.pn * 256 + 16 * cl + bj * 8;
                if (l == NL - 1) { *(f32x4*)(p.x + o) = x0[bj]; *(f32x4*)(p.x + o + 4) = x1[bj]; }
                else { u32x4 w; w[0] = cvtpk(x0[bj][0], x0[bj][1]); w[1] = cvtpk(x0[bj][2], x0[bj][3]); w[2] = cvtpk(x1[bj][0], x1[bj][1]); w[3] = cvtpk(x1[bj][2], x1[bj][3]); *(u32x4*)(p.xb() + o) = w;
#pragma unroll
                    for (int j = 0; j < 4; ++j) ss += x0[bj][j] * x0[bj][j] + x1[bj][j] * x1[bj][j]; } }
            if (l < NL - 1) { ss += __shfl_xor(ss, 16); ss += __shfl_xor(ss, 32); if (fq == 0) p.sumsq()[(size_t)((l + 1) & 1) * T * 16 + (size_t)row * 16 + u.pn * 4 + wc] = ss; } }
    }
};
__device__ __forceinline__ void phase_out(const Params& p, int l, char* shm) {
    pg8::RowOrder S{4, 512, GDIM(), BID()};
    pg8::Gemm g{p.merged(), p.wt_o() + (size_t)l * 1024 * 1024, T, 1024, 1024};
    EpiOut E{p, l};
    pg8::gemm_phase((PG8_LAS unsigned char*)shm, g, S, E);
}

enum { PH_PREP0 = 0, PH_IN, PH_MIX, PH_IDX, PH_SEL, PH_ATTN, PH_MERGE, PH_OUT };
template <int PH> __global__ __launch_bounds__(NTHR) void k_phase(Params p, int l, int b) {
    extern __shared__ __attribute__((aligned(16))) char shm[];
    if (PH == PH_PREP0) phase_prep0(p, shm);
    if (PH == PH_IN) phase_in(p, l, shm);
    if (PH == PH_MIX) phase_mix(p, l);
    if (PH == PH_IDX) phase_indexer(p, b, p.scores(), shm);
    if (PH == PH_SEL) phase_select(p, b, shm, p.scores());
    if (PH == PH_ATTN) phase_attn(p, shm);
    if (PH == PH_MERGE) phase_merge(p, l, shm);
    if (PH == PH_OUT) phase_out(p, l, shm);
}

#define XB_TMO      128
#define XB_XCNT(j)  (256  + 64 * (j))
#define XB_XSUB(j)  (1280 + 64 * (j))
#define XB_XGEN(j)  (2304 + 64 * (j))
#define XB_TOP      3328
#define XB_TOPGEN   3392
#define XCD_BAR_WORDS 3456
#define XB_SPIN_CAP (1u << 22)
#define LAS __attribute__((address_space(3)))
__device__ __forceinline__ unsigned xb_ld(unsigned* p)              { return __hip_atomic_load(p, __ATOMIC_RELAXED, __HIP_MEMORY_SCOPE_AGENT); }
__device__ __forceinline__ unsigned xb_add(unsigned* p, unsigned v) { return __hip_atomic_fetch_add(p, v, __ATOMIC_RELAXED, __HIP_MEMORY_SCOPE_AGENT); }
__device__ __forceinline__ unsigned xb_xcc_id() { return (unsigned)__builtin_amdgcn_s_getreg((3 << 11) | 20) & 0xFu; }
#define XB_SPIN(cond, bar) do { unsigned _sp = 0; while (cond) { __builtin_amdgcn_s_sleep(1); \
    if ((++_sp & 255u) == 0u) { if (xb_ld(&(bar)[XB_TMO])) break; if (_sp > XB_SPIN_CAP) { atomicAdd(&(bar)[XB_TMO], 1u); break; } } } } while (0)
struct XcdBarrier { unsigned* bar; unsigned x; volatile LAS unsigned* st; };
__device__ __forceinline__ XcdBarrier xcd_barrier_post(unsigned* bar, volatile LAS unsigned* st) {
    XcdBarrier b; b.bar = bar; b.x = xb_xcc_id(); b.st = st;
    if (threadIdx.x == 0) (void)xb_add(&bar[XB_XCNT(b.x)], 1u);
    return b;
}
__device__ __forceinline__ void xcd_barrier_complete(unsigned* bar, unsigned x, unsigned& nloc, unsigned& nx) {
    const unsigned G = gridDim.x * gridDim.y * gridDim.z;
    unsigned sum, cnt, mine, sp = 0u;
    for (;;) {
        sum = 0u; cnt = 0u; mine = 0u;
#pragma unroll
        for (unsigned j = 0; j < 16; ++j) { const unsigned c = xb_ld(&bar[XB_XCNT(j)]); sum += c; cnt += (c > 0u) ? 1u : 0u; mine = (j == x) ? c : mine; }
        if (sum == G) break;
        __builtin_amdgcn_s_sleep(1);
        if ((++sp & 255u) == 0u) { if (xb_ld(&bar[XB_TMO])) break; if (sp > XB_SPIN_CAP) { atomicAdd(&bar[XB_TMO], 1u); break; } }
    }
    nloc = mine > 0u ? mine : 1u; nx = cnt > 0u ? cnt : 1u;
}
__device__ __forceinline__ void xcd_barrier(const XcdBarrier& b) {
    asm volatile("s_waitcnt vmcnt(0)" ::: "memory");
    __syncthreads();
    if (threadIdx.x == 0) {
        unsigned* bar = b.bar;
        __builtin_amdgcn_s_waitcnt(0);
        unsigned nloc = b.st[0], nx = b.st[1];
        if (nloc == 0u) { xcd_barrier_complete(bar, b.x, nloc, nx); b.st[0] = nloc; b.st[1] = nx; }
        const unsigned old = xb_add(&bar[XB_XSUB(b.x)], 1u);
        const unsigned gen = old / nloc;
        if (old + 1u == (gen + 1u) * nloc) {
            __builtin_amdgcn_fence(__ATOMIC_RELEASE, "agent");
            asm volatile("s_waitcnt vmcnt(0)" ::: "memory");
            const unsigned og = xb_add(&bar[XB_TOP], 1u);
            const unsigned tg = og / nx;
            if (og + 1u == (tg + 1u) * nx) xb_add(&bar[XB_TOPGEN], 1u);
            else XB_SPIN(xb_ld(&bar[XB_TOPGEN]) == tg, bar);
            __builtin_amdgcn_fence(__ATOMIC_ACQUIRE, "agent");
            xb_add(&bar[XB_XGEN(b.x)], 1u);
            asm volatile("s_waitcnt vmcnt(0)" ::: "memory");
        } else {
            XB_SPIN(xb_ld(&bar[XB_XGEN(b.x)]) == gen, bar);
            __builtin_amdgcn_fence(__ATOMIC_ACQUIRE, "agent");
            asm volatile("s_waitcnt vmcnt(0)" ::: "memory");
        }
    }
    __syncthreads();
}

#if MEGA
typedef const __attribute__((address_space(4))) Params* kparams_t;
__device__ __forceinline__ Params load_params(kparams_t k) {
    Params q; q.x_in = k->x_in; q.norm_g = k->norm_g; q.w_in = k->w_in; q.conv_w = k->conv_w; q.w_out_conv = k->w_out_conv; q.q_g = k->q_g; q.k_g = k->k_g; q.w_out_attn = k->w_out_attn;
    q.pool_w = k->pool_w; q.pool_scale = k->pool_scale; q.w_out_pool = k->w_out_pool; q.w_o = k->w_o; q.x = k->x; q.ws = k->ws; return q; }
#define PHP(q) kparams_t kq_##q = kp; asm volatile("" : "+s"(kq_##q)); const Params q = load_params(kq_##q);
__global__ __launch_bounds__(NTHR) void k_mega(Params p_unused) {
    extern __shared__ __attribute__((aligned(16))) char shm[];
    cg::grid_group grid = cg::this_grid();
    kparams_t kp = (kparams_t)__builtin_amdgcn_kernarg_segment_ptr();
    __shared__ uint4 xb_words;
    if (threadIdx.x == 0) xb_words = make_uint4(0u, 0u, 0u, 0u);
    __syncthreads();
    const XcdBarrier xb = xcd_barrier_post((unsigned*)(kp->ws + WS_BAR), (volatile LAS unsigned*)&xb_words);

#ifndef SK_PREP
        { PHP(p) phase_prep0(p, shm); }
#endif
#ifdef DUP_PREP
        { PHP(p) phase_prep0(p, shm); }
#endif

    grid.sync();
    for (int l = 0; l < NL; ++l) {

#ifndef SK_IN
        { PHP(p) phase_in(p, l, shm); }
#endif
#ifdef DUP_IN
        { PHP(p) phase_in(p, l, shm); }
#endif

        xcd_barrier(xb);

        { PHP(p) phase_mix(p, l); phase_indexer(p, 0, p.scores(), shm); }
        xcd_barrier(xb);
        { PHP(p) phase_indexer(p, 1, p.scores2(), shm); phase_select(p, 0, shm, p.scores()); }
        xcd_barrier(xb);
        { PHP(p) phase_indexer(p, 2, p.scores(), shm); phase_select(p, 1, shm, p.scores2()); }
        xcd_barrier(xb);
        { PHP(p) phase_indexer(p, 3, p.scores2(), shm); phase_select(p, 2, shm, p.scores()); }
        xcd_barrier(xb);
        { PHP(p) phase_select(p, 3, shm, p.scores2()); }
        xcd_barrier(xb);
#ifndef SK_ATTN
        { PHP(p) phase_attn(p, shm); }
#endif
#ifdef DUP_ATTN
        { PHP(p) phase_attn(p, shm); }
#endif

        xcd_barrier(xb);

#ifndef SK_MERGE
        { PHP(p) phase_merge(p, l, shm); }
#endif
#ifdef DUP_MERGE
        { PHP(p) phase_merge(p, l, shm); }
#endif

        xcd_barrier(xb);

#ifndef SK_OUT
        { PHP(p) phase_out(p, l, shm); }
#endif

        xcd_barrier(xb);
    }
}
#endif

static Params make_params(void* const* d_in, void* d_out, void* d_ws) {
    Params p{};
    p.x_in = (const float*)d_in[0]; p.norm_g = (const float*)d_in[1]; p.w_in = (const float*)d_in[2]; p.conv_w = (const float*)d_in[3];
    p.w_out_conv = (const float*)d_in[4]; p.q_g = (const float*)d_in[5]; p.k_g = (const float*)d_in[6]; p.w_out_attn = (const float*)d_in[7];
    p.pool_w = (const float*)d_in[8]; p.pool_scale = (const float*)d_in[9]; p.w_out_pool = (const float*)d_in[10]; p.w_o = (const float*)d_in[11];
    p.x = (float*)d_out; p.ws = (char*)d_ws;
    return p;
}

extern "C" void kernel_launch(void* const* d_in, const int* in_sizes, int n_in, void* d_out, int out_size, void* d_ws, size_t ws_size, hipStream_t stream) {
    if (ws_size < WS_NEEDED) { fprintf(stderr, "workspace too small: %zu < %zu\n", ws_size, (size_t)WS_NEEDED); return; }
    Params p = make_params(d_in, d_out, d_ws);
    static int grid = 0;
    if (!grid) { int dev = 0, cus = 0; hipGetDevice(&dev); hipDeviceGetAttribute(&cus, hipDeviceAttributeMultiprocessorCount, dev); if (cus <= 0 || cus > 256) cus = 256; grid = (cus / 8) * 8; }
#if MEGA
    static bool attr = false;
    if (!attr) { hipFuncSetAttribute((const void*)k_mega, hipFuncAttributeMaxDynamicSharedMemorySize, LDS_BYTES); attr = true; }
    hipMemsetAsync((char*)d_ws + WS_BAR, 0, 16384, stream);
    void* args[] = {&p};
    hipError_t e = hipLaunchCooperativeKernel((void*)k_mega, dim3(grid), dim3(NTHR), args, LDS_BYTES, stream);
    if (e != hipSuccess) fprintf(stderr, "cooperative launch failed: %s\n", hipGetErrorString(e));
#else
    static bool attr = false;
    if (!attr) {
        hipFuncSetAttribute((const void*)k_phase<PH_PREP0>, hipFuncAttributeMaxDynamicSharedMemorySize, LDS_BYTES);
        hipFuncSetAttribute((const void*)k_phase<PH_IN>, hipFuncAttributeMaxDynamicSharedMemorySize, LDS_BYTES);
        hipFuncSetAttribute((const void*)k_phase<PH_MIX>, hipFuncAttributeMaxDynamicSharedMemorySize, LDS_BYTES);
        hipFuncSetAttribute((const void*)k_phase<PH_IDX>, hipFuncAttributeMaxDynamicSharedMemorySize, LDS_BYTES);
        hipFuncSetAttribute((const void*)k_phase<PH_SEL>, hipFuncAttributeMaxDynamicSharedMemorySize, LDS_BYTES);
        hipFuncSetAttribute((const void*)k_phase<PH_ATTN>, hipFuncAttributeMaxDynamicSharedMemorySize, LDS_BYTES);
        hipFuncSetAttribute((const void*)k_phase<PH_MERGE>, hipFuncAttributeMaxDynamicSharedMemorySize, LDS_BYTES);
        hipFuncSetAttribute((const void*)k_phase<PH_OUT>, hipFuncAttributeMaxDynamicSharedMemorySize, LDS_BYTES);
        attr = true;
    }
#define LAUNCH(PH, l, b) hipLaunchKernelGGL(k_phase<PH>, dim3(grid), dim3(NTHR), LDS_BYTES, stream, p, l, b)
    LAUNCH(PH_PREP0, 0, 0);
    for (int l = 0; l < NL; ++l) {
        LAUNCH(PH_IN, l, 0);
        LAUNCH(PH_MIX, l, 0);
        for (int b = 0; b < NBATCH; ++b) { LAUNCH(PH_IDX, l, b); LAUNCH(PH_SEL, l, b); }
        LAUNCH(PH_ATTN, l, 0);
        LAUNCH(PH_MERGE, l, 0);
        LAUNCH(PH_OUT, l, 0);
    }
#endif
}
```

```cpp
#include <hip/hip_runtime.h>
#include <hip/hip_cooperative_groups.h>
#include <stdint.h>
#include <stdio.h>
namespace cg = cooperative_groups;

typedef unsigned short u16;
typedef unsigned long long u64;
typedef __attribute__((ext_vector_type(8))) short bf16x8;
typedef __attribute__((ext_vector_type(4))) short s16x4;
typedef __attribute__((ext_vector_type(4))) float f32x4;
typedef __attribute__((ext_vector_type(16))) float f32x16;
typedef __attribute__((ext_vector_type(4))) unsigned u32x4;
typedef __attribute__((ext_vector_type(2))) unsigned u32x2;

#ifndef MEGA
#define MEGA 1
#endif
__device__ __forceinline__ int TID() { int t = threadIdx.x; asm volatile("" : "+v"(t)); return t; }
__device__ __forceinline__ int BID() { int t = blockIdx.x; asm volatile("" : "+s"(t)); return t; }
__device__ __forceinline__ int GDIM() { int t = gridDim.x; asm volatile("" : "+s"(t)); return t; }

constexpr int SEQ = 8192, NBATCH = 4, T = NBATCH * SEQ, DMODEL = 1024, NL = 4, INW = 8776;
constexpr int NPA = 5888;
constexpr int NTHR = 512;
constexpr int LDS_BYTES = 131072;
constexpr float RMS_EPS = 1e-6f;

struct Params {
    const float *x_in, *norm_g, *w_in, *conv_w, *w_out_conv, *q_g, *k_g, *w_out_attn, *pool_w, *pool_scale, *w_out_pool, *w_o;
    float* x; char* ws;
    __device__ __forceinline__ u16* xb() const { return (u16*)(ws + 0ull); }
    __device__ __forceinline__ u16* ga() const { return (u16*)(ws + 67108864ull); }
    __device__ __forceinline__ u16* q() const { return (u16*)(ws + 100663296ull); }
    __device__ __forceinline__ u16* k() const { return (u16*)(ws + 134217728ull); }
    __device__ __forceinline__ u16* v() const { return (u16*)(ws + 167772160ull); }
    __device__ __forceinline__ u16* sg() const { return (u16*)(ws + 201326592ull); }
    __device__ __forceinline__ u16* iq() const { return (u16*)(ws + 234881024ull); }
    __device__ __forceinline__ u16* sp() const { return (u16*)(ws + 268435456ull); }
    __device__ __forceinline__ u16* z() const { return (u16*)(ws + 301989888ull); }
    __device__ __forceinline__ u16* u() const { return (u16*)(ws + 335544320ull); }
    __device__ __forceinline__ u16* zuspare() const { return (u16*)(ws + 369098752ull); }
    __device__ __forceinline__ u16* ik() const { return (u16*)(ws + 371195904ull); }
    __device__ __forceinline__ float* iw() const { return (float*)(ws + 375390208ull); }
    __device__ __forceinline__ u16* wt_in() const { return (u16*)(ws + 376438784ull); }
    __device__ __forceinline__ u16* wt_mg() const { return (u16*)(ws + 424673280ull); }
    __device__ __forceinline__ u16* wt_oa() const { return (u16*)(ws + 449839104ull); }
    __device__ __forceinline__ u16* wt_ob() const { return (u16*)(ws + 454033408ull); }
    __device__ __forceinline__ u16* wt_oc() const { return (u16*)(ws + 458227712ull); }
    __device__ __forceinline__ u16* wt_o() const { return (u16*)(ws + 462422016ull); }
    __device__ __forceinline__ float* ropec() const { return (float*)(ws + 470810624ull); }
    __device__ __forceinline__ float* ropes() const { return (float*)(ws + 471859200ull); }
    __device__ __forceinline__ float* sumsq() const { return (float*)(ws + 472907776ull); }
    __device__ __forceinline__ u64* mask() const { return (u64*)(ws + 477102080ull); }
    __device__ __forceinline__ u16* scores() const { return (u16*)(ws + 494403584ull); }
    __device__ __forceinline__ u16* scores2() const { return z(); }
    __device__ __forceinline__ u16* stash() const { return scores(); }
    __device__ __forceinline__ u16* merged() const { return q(); }
    __device__ __forceinline__ u16* bin() const { return iq(); }
};
constexpr size_t WS_BAR = 563609600ull;
constexpr size_t WS_NEEDED = WS_BAR + 16384;


__device__ __forceinline__ unsigned cvtpk(float lo, float hi) { unsigned r; asm("v_cvt_pk_bf16_f32 %0, %1, %2" : "=v"(r) : "v"(lo), "v"(hi)); return r; }
__device__ __forceinline__ u16 f2bf(float f) { return (u16)(cvtpk(f, 0.f) & 0xffffu); }
__device__ __forceinline__ float bf2f(u16 b) { return __uint_as_float(((unsigned)b) << 16); }
__device__ __forceinline__ float bflo(unsigned w) { return __uint_as_float(w << 16); }
__device__ __forceinline__ float bfhi(unsigned w) { return __uint_as_float(w & 0xffff0000u); }
__device__ __forceinline__ float siluf(float x) { return x * __builtin_amdgcn_rcpf(1.f + __builtin_amdgcn_exp2f(x * -1.4426950408889634f)); }
__device__ __forceinline__ float sigmf(float x) { return __builtin_amdgcn_rcpf(1.f + __builtin_amdgcn_exp2f(x * -1.4426950408889634f)); }

__device__ __forceinline__ float row_rstd(const float* ssp, int row) {
    const f32x4* q = (const f32x4*)(ssp + (size_t)row * 16);
    const f32x4 a = q[0], b = q[1], c = q[2], d = q[3];
    const float s = ((a[0] + a[1]) + (a[2] + a[3])) + ((b[0] + b[1]) + (b[2] + b[3])) + ((c[0] + c[1]) + (c[2] + c[3])) + ((d[0] + d[1]) + (d[2] + d[3]));
    return __builtin_amdgcn_rsqf(s * (1.f / 1024.f) + RMS_EPS);
}
__device__ __forceinline__ int lc_of_tc(int tc) { int bj = tc >> 7, wc = (tc >> 5) & 3, n = (tc >> 4) & 1, fq = (tc >> 2) & 3, j = tc & 3; return ((wc * 4 + fq) << 4) + bj * 8 + n * 4 + j; }
__device__ __forceinline__ int tc_of_lc(int lc) { int cl = lc >> 4, s = lc & 15, wc = cl >> 2, fq = cl & 3, bj = s >> 3, n = (s >> 2) & 1, j = s & 3; return bj * 128 + wc * 32 + n * 16 + fq * 4 + j; }

__device__ __forceinline__ int src_col_in(int np) {
    int pn = np >> 8, tc = np & 255;
    int bj = tc >> 7, wc = (tc >> 5) & 3, n = (tc >> 4) & 1, fq = (tc >> 2) & 3, j = tc & 3, cl = wc * 4 + fq, s = bj * 8 + n * 4 + j, lc = cl * 16 + s;
    int d = (s < 8) ? (8 * fq + s) : (8 * fq + 32 + (s - 8));
    if (pn < 8) return (s & 3) * 512 + pn * 64 + cl * 4 + (s >> 2);
    if (pn < 12) { int which = (pn - 8) >> 1, head = ((pn - 8) & 1) * 4 + wc; return 2048 + which * 512 + head * 64 + d; }
    if (pn < 14) return 3072 + (pn - 12) * 256 + lc;
    if (pn < 16) return 3584 + (pn - 14) * 256 + lc;
    if (pn < 18) { int head = (pn - 16) * 4 + wc; return 4096 + head * 64 + d; }
    if (pn == 18) { if (wc == 0) return 4608 + d; if (wc == 1 && fq == 0 && s < 8) return 4672 + s; return -1; }
    if (pn < 21) return -2;
    return 5192 + (pn - 21) * 256 + lc;
}

__device__ __forceinline__ void prep_x(const Params& p) {
    const int tid_ = TID(); const int lane = tid_ & 63, gw = BID() * (NTHR / 64) + (tid_ >> 6), nw = GDIM() * (NTHR / 64);
    for (int row0 = gw * 4; row0 < T; row0 += nw * 4) {
        float4 v[4][4];
#pragma unroll
        for (int r = 0; r < 4; ++r)
#pragma unroll
            for (int i = 0; i < 4; ++i) v[r][i] = ((const float4*)(p.x_in + (size_t)(row0 + r) * DMODEL))[i * 64 + lane];
        float ss[4];
#pragma unroll
        for (int r = 0; r < 4; ++r) { ss[r] = 0.f;
#pragma unroll
            for (int i = 0; i < 4; ++i) { const float4 q = v[r][i]; ss[r] += q.x * q.x + q.y * q.y + q.z * q.z + q.w * q.w;
                u32x2 o; o[0] = cvtpk(q.x, q.y); o[1] = cvtpk(q.z, q.w);
                *(u32x2*)(p.xb() + (size_t)(row0 + r) * DMODEL + (i * 64 + lane) * 4) = o; } }
#pragma unroll
        for (int m = 32; m >= 1; m >>= 1) {
#pragma unroll
            for (int r = 0; r < 4; ++r) ss[r] += __shfl_xor(ss[r], m); }
        if (lane < 16) {
#pragma unroll
            for (int r = 0; r < 4; ++r) p.sumsq()[(size_t)(row0 + r) * 16 + lane] = (lane == 0) ? ss[r] : 0.f; }
    }
}
__device__ __forceinline__ void prep_rope(const Params& p) {
    const int i0 = BID() * NTHR + TID(), istep = GDIM() * NTHR;
    for (int i = i0; i < SEQ * 32; i += istep) {
        int pos = i >> 5, j = i & 31;
        float inv = 1.0f / powf(10000.0f, (float)(2 * j) / 64.0f);
        float ang = (float)pos * inv;
        p.ropec()[i] = cosf(ang); p.ropes()[i] = sinf(ang);
    }
}
__device__ __forceinline__ void prep_wt(const float* src, int lds_, const float* scale, u16* dst, int K, int NP, int mode, float* tile) {
    const int tid_ = TID(); const int tx = tid_ & 63, ty = tid_ >> 6; const int bid_ = BID(), gdim_ = GDIM();
    const int ntn = NP / 64, ntk = K / 64;
    for (int t = bid_; t < ntn * ntk; t += gdim_) {
        const int n0 = (t / ntk) * 64, k0 = (t % ntk) * 64;
        int np = n0 + tx, col;
        if (mode == 0) col = src_col_in(np);
        else if (mode == 1) col = 5704 + (np & ~255) + lc_of_tc(np & 255);
        else col = (np & ~255) + lc_of_tc(np & 255);
        __syncthreads();
#pragma unroll
        for (int i = 0; i < 8; ++i) { int kk = ty + 8 * i; tile[kk * 65 + tx] = (col >= 0) ? src[(size_t)(k0 + kk) * lds_ + col] : 0.f; }
        __syncthreads();
        const float sc = scale ? scale[k0 + tx] : 1.f;
#pragma unroll
        for (int i = 0; i < 8; ++i) {
            int nn = ty + 8 * i; int npo = n0 + nn;
            bool skip = (mode == 0) && ((npo >> 8) == 19 || (npo >> 8) == 20);
            if (!skip) dst[(size_t)npo * K + k0 + tx] = f2bf(tile[tx * 65 + nn] * sc);
        }
    }
}
__device__ __forceinline__ void prep_fold(const float* win, const float* ng, const float* pw, u16* wt_in) {
    const int i0 = BID() * NTHR + TID(), istep = GDIM() * NTHR;
    for (int i = i0; i < 1024 * 512; i += istep) {
        int k = i >> 9, n = i & 511, g = n >> 7, d = n & 127;
        const float* wr = win + (size_t)k * INW + 4680 + g * 128;
        const float* pp = pw + (size_t)g * 128 * 128 + d;
        float acc = 0.f;
        for (int c = 0; c < 128; ++c) acc += wr[c] * pp[c * 128];
        int row = (19 + (n >> 8)) * 256 + tc_of_lc(n & 255);
        wt_in[(size_t)row * 1024 + k] = f2bf(acc * ng[k]);
    }
}
__device__ __forceinline__ void phase_prep0(const Params& p, char* shm) {
    prep_x(p); prep_rope(p);
    float* tile = (float*)shm;
    for (int l = 0; l < NL; ++l) {
        const float* ng = p.norm_g + l * 1024;
        const float* win = p.w_in + (size_t)l * 1024 * INW;
        prep_wt(win, INW, ng, p.wt_in() + (size_t)l * NPA * 1024, 1024, NPA, 0, tile);
        prep_wt(win, INW, ng, p.wt_mg() + (size_t)l * 3072 * 1024, 1024, 3072, 1, tile);
        prep_wt(p.w_out_conv + (size_t)l * 512 * 1024, 1024, nullptr, p.wt_oa() + (size_t)l * 1024 * 512, 512, 1024, 2, tile);
        prep_wt(p.w_out_attn + (size_t)l * 512 * 1024, 1024, nullptr, p.wt_ob() + (size_t)l * 1024 * 512, 512, 1024, 2, tile);
        prep_wt(p.w_out_pool + (size_t)l * 512 * 1024, 1024, nullptr, p.wt_oc() + (size_t)l * 1024 * 512, 512, 1024, 2, tile);
        prep_wt(p.w_o + (size_t)l * 1024 * 1024, 1024, nullptr, p.wt_o() + (size_t)l * 1024 * 1024, 1024, 1024, 3, tile);
        prep_fold(win, ng, p.pool_w + (size_t)l * 4 * 128 * 128, p.wt_in() + (size_t)l * NPA * 1024);
    }
}

namespace pg8 {
#define PG8_LAS __attribute__((address_space(3)))
typedef unsigned short bf16_t;
constexpr int BM = 256, BK = 64, HALF = 128, HTB = HALF * BK * 2, STAGE_BYTES = 8 * HTB;
__device__ __forceinline__ int lds_byte(int r, int c) { const int st = (r >> 4) * 2 + (c >> 5), rr = r & 15, cc = c & 31, ob = rr * 64 + cc * 2; return st * 1024 + (ob ^ (((ob >> 9) & 1) << 5)); }
__device__ __forceinline__ void stage_rc(int b, int& R, int& C) { const int st = b / 1024, sb = b % 1024, swz = sb ^ (((sb >> 9) & 1) << 5); R = (st >> 1) * 16 + swz / 64; C = (st & 1) * 32 + (swz % 64) / 2; }
struct Unit { int pm, pn; };
struct Gemm { const bf16_t* A; const bf16_t* Bt; int M, N, K; };
constexpr int NXCD = 8, WGM = 8;
struct StaticOrder {
    int nM, nN, nwg, G, c;
    __device__ void init(int M, int N, int G_, int c_) { nM = M / BM; nN = N / BM; nwg = nM * nN; G = G_; c = c_; }
    __device__ bool next(int i, Unit& u) const {
        const long L = (long)i * G + c; if (L >= nwg) return false;
        int wgid = (int)L; { const int q = nwg / NXCD, r = nwg % NXCD, xcd = wgid % NXCD, off = wgid / NXCD; wgid = (xcd < r ? xcd * (q + 1) : r * (q + 1) + (xcd - r) * q) + off; }
        const int nig = WGM * nN, gid = wgid / nig, fm = gid * WGM, gsz = (nM - fm) < WGM ? (nM - fm) : WGM;
        u.pm = fm + ((wgid % nig) % gsz); u.pn = (wgid % nig) / gsz; return true;
    }
};
struct RowOrder {
    int nN, ntile, G, c;
    __device__ bool next(int i, Unit& u) const {
        const int x = c & 7, lt = (c >> 3) + (G >> 3) * i;
        const int quad = lt >> 2, pm = quad * 8 + x;
        if (pm * 4 >= ntile) return false;
        u.pm = pm; u.pn = lt & 3; return true; }
};
template <class Epi, class Sched>
__device__ __forceinline__ void gemm_phase(PG8_LAS unsigned char* lds, const Gemm g, const Sched& S, const Epi& E) {
    const int tid = TID(), wid = __builtin_amdgcn_readfirstlane(tid >> 6), lane = tid & 63, wr = wid >> 2, wc = wid & 3, fr = lane & 15, fq = lane >> 4;
    const int K = g.K, nt = K / BK;
    unsigned voffA[2], voffB[2];
#pragma unroll
    for (int i = 0; i < 2; ++i) { int R, C; stage_rc(tid * 16 + i * 8192, R, C); voffA[i] = (unsigned)(R * K + C) * 2u; voffB[i] = voffA[i]; }
    const size_t kstep = (size_t)(BK * 2);
    const size_t hstep = (size_t)HALF * K * 2;
    const size_t tstep = 2 * hstep;
    const unsigned ldsw = (unsigned)wid * 1024u;
    const int aoff = lds_byte(wr * 64 + fr, fq * 8), boff = lds_byte(wc * 32 + fr, fq * 8);
#define PG8_SA(b, h) (((b) * 2 + (h)) * HTB)
#define PG8_SB(b, h) ((4 + (b) * 2 + (h)) * HTB)
#define PG8_STAGE(bufoff, gbase, voff) do { _Pragma("unroll") for (int _i = 0; _i < 2; ++_i) \
        __builtin_amdgcn_global_load_lds((const unsigned*)((const char*)(gbase) + (voff)[_i]), (PG8_LAS unsigned*)(lds + (bufoff) + ldsw + _i * 8192), 16, 0, 0); } while (0)
#define PG8_LDA(dst, b, h) do { _Pragma("unroll") for (int m = 0; m < 4; ++m) _Pragma("unroll") for (int k = 0; k < 2; ++k) dst[m][k] = *(const PG8_LAS bf16x8*)(lds + PG8_SA(b, h) + aoff + m * 2048 + k * 1024); } while (0)
#define PG8_LDB(dst, b, h) do { _Pragma("unroll") for (int n = 0; n < 2; ++n) _Pragma("unroll") for (int k = 0; k < 2; ++k) dst[n][k] = *(const PG8_LAS bf16x8*)(lds + PG8_SB(b, h) + boff + n * 2048 + k * 1024); } while (0)
#define PG8_MMA(ai, bj, At, Bt) do { __builtin_amdgcn_s_setprio(1); _Pragma("unroll") for (int m = 0; m < 4; ++m) _Pragma("unroll") for (int n = 0; n < 2; ++n) _Pragma("unroll") for (int k = 0; k < 2; ++k) \
        acc[ai][bj][m][n] = __builtin_amdgcn_mfma_f32_16x16x32_bf16(Bt[n][k], At[m][k], acc[ai][bj][m][n], 0, 0, 0); __builtin_amdgcn_s_setprio(0); } while (0)
#define PG8_WAIT_V(n) asm volatile("s_waitcnt vmcnt(" #n ")" ::: "memory")
#define PG8_WAIT_L(n) asm volatile("s_waitcnt lgkmcnt(" #n ")" ::: "memory")
#define PG8_BAR __builtin_amdgcn_s_barrier()
#define PG8_SCHED __builtin_amdgcn_sched_barrier(0)
    Unit cur, nxt; int ui = 0;
    if (!S.next(0, cur)) return;
    f32x4 acc[2][2][4][2];
#pragma unroll
    for (int a = 0; a < 2; ++a)
#pragma unroll
        for (int b = 0; b < 2; ++b)
#pragma unroll
            for (int m = 0; m < 4; ++m)
#pragma unroll
                for (int n = 0; n < 2; ++n) acc[a][b][m][n] = (f32x4){0.f, 0.f, 0.f, 0.f};
    bf16x8 At[4][2], B0[2][2], B1[2][2];
    const char* cA = (const char*)g.A + (size_t)cur.pm * tstep; const char* cB = (const char*)g.Bt + (size_t)cur.pn * tstep;
    PG8_STAGE(PG8_SB(0, 0), cB, voffB); PG8_STAGE(PG8_SA(0, 0), cA, voffA); PG8_STAGE(PG8_SB(0, 1), cB + hstep, voffB); PG8_STAGE(PG8_SA(0, 1), cA + hstep, voffA);
    if (wr == 1) PG8_BAR;
    PG8_WAIT_V(4); PG8_BAR;
    PG8_STAGE(PG8_SB(1, 0), cB + kstep, voffB); PG8_STAGE(PG8_SA(1, 0), cA + kstep, voffA); PG8_STAGE(PG8_SB(1, 1), cB + hstep + kstep, voffB);
    PG8_WAIT_V(6); PG8_BAR;
    for (;;) {
        const bool has_next = S.next(ui + 1, nxt);
        const char* nA = has_next ? (const char*)g.A + (size_t)nxt.pm * tstep : cA; const char* nB = has_next ? (const char*)g.Bt + (size_t)nxt.pn * tstep : cB;
        for (int t = 0; t < nt; t += 2) {
            const bool last = (t == nt - 2);
            const char* a1 = cA + (size_t)(t + 1) * kstep;
            const char* a2 = last ? nA : cA + (size_t)(t + 2) * kstep; const char* b2 = last ? nB : cB + (size_t)(t + 2) * kstep;
            const char* a3 = a2 + kstep; const char* b3 = b2 + kstep;
            PG8_LDB(B0, 0, 0); PG8_SCHED; PG8_LDA(At, 0, 0); PG8_STAGE(PG8_SA(1, 1), a1 + hstep, voffA);
            PG8_WAIT_L(8); PG8_BAR; PG8_WAIT_L(0); PG8_MMA(0, 0, At, B0); PG8_BAR; PG8_SCHED;
            PG8_LDB(B1, 0, 1); PG8_STAGE(PG8_SB(0, 0), b2, voffB);
            PG8_BAR; PG8_WAIT_L(0); PG8_MMA(0, 1, At, B1); PG8_BAR;
            PG8_LDA(At, 0, 1); PG8_STAGE(PG8_SA(0, 0), a2, voffA);
            PG8_BAR; PG8_WAIT_L(0); PG8_MMA(1, 0, At, B0); PG8_BAR; PG8_SCHED;
            PG8_STAGE(PG8_SB(0, 1), b2 + hstep, voffB);
            PG8_WAIT_V(6); PG8_BAR; PG8_MMA(1, 1, At, B1); PG8_BAR;
            PG8_LDB(B0, 1, 0); PG8_SCHED; PG8_LDA(At, 1, 0); PG8_STAGE(PG8_SA(0, 1), a2 + hstep, voffA);
            PG8_WAIT_L(8); PG8_BAR; PG8_WAIT_L(0); PG8_MMA(0, 0, At, B0); PG8_BAR; PG8_SCHED;
            PG8_LDB(B1, 1, 1); PG8_STAGE(PG8_SB(1, 0), b3, voffB);
            PG8_BAR; PG8_WAIT_L(0); PG8_MMA(0, 1, At, B1); PG8_BAR;
            PG8_LDA(At, 1, 1); PG8_STAGE(PG8_SA(1, 0), a3, voffA);
            PG8_BAR; PG8_WAIT_L(0); PG8_MMA(1, 0, At, B0); PG8_BAR; PG8_SCHED;
            PG8_STAGE(PG8_SB(1, 1), b3 + hstep, voffB);
            PG8_WAIT_V(6); PG8_BAR; PG8_MMA(1, 1, At, B1); PG8_BAR;
        }
        E(acc, cur, ui, wr, wc, fr, fq);
#ifdef DUP_EPI
        if (Epi::DUPOK) E(acc, cur, ui, wr, wc, fr, fq);
#endif
        if (!has_next) break;
#pragma unroll
        for (int a = 0; a < 2; ++a)
#pragma unroll
            for (int b = 0; b < 2; ++b)
#pragma unroll
                for (int m = 0; m < 4; ++m)
#pragma unroll
                    for (int n = 0; n < 2; ++n) acc[a][b][m][n] = (f32x4){0.f, 0.f, 0.f, 0.f};
        cur = nxt; cA = nA; cB = nB; ++ui;
    }
    PG8_WAIT_V(0);
    if (wr == 0) PG8_BAR;
    PG8_BAR;
#undef PG8_SA
#undef PG8_SB
#undef PG8_STAGE
#undef PG8_LDA
#undef PG8_LDB
#undef PG8_MMA
#undef PG8_WAIT_V
#undef PG8_WAIT_L
#undef PG8_BAR
#undef PG8_SCHED
}
}
typedef f32x4 acc_t[2][2][4][2];
#define ROWS_LOOP _Pragma("unroll") for (int ai = 0; ai < 2; ++ai) _Pragma("unroll") for (int m = 0; m < 4; ++m)
#define ROW_OF (u.pm * 256 + ai * 128 + wr * 64 + m * 16 + fr)

struct EpiIn {
    static constexpr bool DUPOK = true;
    const Params& p; int l;
    __device__ __forceinline__ void operator()(const acc_t& acc, const pg8::Unit& u, int ui, int wr, int wc, int fr, int fq) const {
        const float* ssq = p.sumsq() + (size_t)(l & 1) * T * 16;
        const int pn = u.pn, cl = wc * 4 + fq;
        __shared__ float s_rstd[256];
        { const int t_ = TID(); if (t_ < 256) s_rstd[t_] = row_rstd(ssq, u.pm * 256 + t_); __syncthreads(); }
        float rsa[8];
#pragma unroll
        for (int ix = 0; ix < 8; ++ix) rsa[ix] = s_rstd[(ix >> 2) * 128 + wr * 64 + (ix & 3) * 16 + fr];
        if (pn < 8) {
            ROWS_LOOP { const int row = ROW_OF; const float rs = rsa[ai * 4 + m];
                float zz[4], gg[4];
#pragma unroll
                for (int ch = 0; ch < 4; ++ch) { const f32x4 v = acc[ai][ch >> 1][m][ch & 1]; zz[ch] = (v[1] * rs) * (v[2] * rs); gg[ch] = (v[0] * rs) * siluf(v[3] * rs); }
                const size_t o = (size_t)row * 512 + pn * 64 + cl * 4;
                u32x2 a; a[0] = cvtpk(zz[0], zz[1]); a[1] = cvtpk(zz[2], zz[3]); *(u32x2*)(p.z() + o) = a;
                u32x2 b; b[0] = cvtpk(gg[0], gg[1]); b[1] = cvtpk(gg[2], gg[3]); *(u32x2*)(p.ga() + o) = b; }
        } else if (pn < 12 || (pn >= 16 && pn <= 18)) {
            if (pn == 18 && wc >= 1) {
                if (wc == 1 && fq == 0) {
                    ROWS_LOOP { const int row = ROW_OF; const float rs = rsa[ai * 4 + m] * 0.04419417382415922f;
                        *(f32x4*)(p.iw() + (size_t)row * 8) = acc[ai][0][m][0] * rs; *(f32x4*)(p.iw() + (size_t)row * 8 + 4) = acc[ai][0][m][1] * rs; }
                }
            } else {
                const bool isqk = pn < 12; const int which = (pn - 8) >> 1;
                int head; u16* dst; int pitch;
                if (isqk) { head = ((pn - 8) & 1) * 4 + wc; dst = which ? p.k() : p.q(); pitch = 512; }
                else if (pn < 18) { head = (pn - 16) * 4 + wc; dst = p.iq(); pitch = 512; }
                else { head = 0; dst = p.ik(); pitch = 64; }
                f32x4 g0[2], g1[2];
#pragma unroll
                for (int n = 0; n < 2; ++n) { g0[n] = (f32x4){1.f, 1.f, 1.f, 1.f}; g1[n] = g0[n]; }
                if (isqk) { const float* gg = (which ? p.k_g : p.q_g) + l * 64 + 8 * fq;
#pragma unroll
                    for (int n = 0; n < 2; ++n) { g0[n] = *(const f32x4*)(gg + 4 * n); g1[n] = *(const f32x4*)(gg + 32 + 4 * n); } }
                f32x4 rcb[2], rsb[2];
                { const int pos0 = (u.pm * 256 + wr * 64 + fr) & (SEQ - 1);
#pragma unroll
                  for (int n = 0; n < 2; ++n) { rcb[n] = *(const f32x4*)(p.ropec() + pos0 * 32 + 8 * fq + 4 * n); rsb[n] = *(const f32x4*)(p.ropes() + pos0 * 32 + 8 * fq + 4 * n); } }
                ROWS_LOOP { const int row = ROW_OF; const int ix = ai * 4 + m; const float rs = rsa[ix];
                    f32x4 a0[2], a1[2];
#pragma unroll
                    for (int n = 0; n < 2; ++n) { a0[n] = acc[ai][0][m][n] * rs; a1[n] = acc[ai][1][m][n] * rs; }
                    if (isqk) { float ss = 0.f;
#pragma unroll
                        for (int n = 0; n < 2; ++n)
#pragma unroll
                            for (int j = 0; j < 4; ++j) ss += a0[n][j] * a0[n][j] + a1[n][j] * a1[n][j];
                        ss += __shfl_xor(ss, 16); ss += __shfl_xor(ss, 32);
                        const float rn = __builtin_amdgcn_rsqf(ss * (1.f / 64.f) + RMS_EPS);
#pragma unroll
                        for (int n = 0; n < 2; ++n) { a0[n] = a0[n] * rn * g0[n]; a1[n] = a1[n] * rn * g1[n]; } }
                    u32x4 o0, o1;
#pragma unroll
                    for (int n = 0; n < 2; ++n) { const f32x4 cc = rcb[n], sn = rsb[n];
                        const f32x4 r0 = a0[n] * cc - a1[n] * sn, r1 = a1[n] * cc + a0[n] * sn;
                        o0[2 * n] = cvtpk(r0[0], r0[1]); o0[2 * n + 1] = cvtpk(r0[2], r0[3]); o1[2 * n] = cvtpk(r1[0], r1[1]); o1[2 * n + 1] = cvtpk(r1[2], r1[3]); }
                    if (ix < 7) { const int posn = (u.pm * 256 + ((ix + 1) >> 2) * 128 + wr * 64 + ((ix + 1) & 3) * 16 + fr) & (SEQ - 1);
#pragma unroll
                        for (int n = 0; n < 2; ++n) { rcb[n] = *(const f32x4*)(p.ropec() + posn * 32 + 8 * fq + 4 * n); rsb[n] = *(const f32x4*)(p.ropes() + posn * 32 + 8 * fq + 4 * n); } }
                    u16* d = dst + (size_t)row * pitch + head * 64 + 8 * fq;
                    *(u32x4*)d = o0; *(u32x4*)(d + 32) = o1; }
            }
        } else {
            u16* dst; int cb; int kind;
            if (pn < 14) { dst = p.v(); cb = (pn - 12) * 256; kind = 0; }
            else if (pn < 16) { dst = p.sg(); cb = (pn - 14) * 256; kind = 1; }
            else if (pn < 21) { dst = p.u(); cb = (pn - 19) * 256; kind = 0; }
            else { dst = p.sp(); cb = (pn - 21) * 256; kind = 2; }
            f32x4 sc[2][2];
#pragma unroll
            for (int bj = 0; bj < 2; ++bj)
#pragma unroll
                for (int n = 0; n < 2; ++n) sc[bj][n] = (kind == 2) ? *(const f32x4*)(p.pool_scale + l * 512 + cb + 16 * cl + bj * 8 + n * 4) : (f32x4){1.f, 1.f, 1.f, 1.f};
            ROWS_LOOP { const int row = ROW_OF; const float rs = rsa[ai * 4 + m];
#pragma unroll
                for (int bj = 0; bj < 2; ++bj) { f32x4 v0 = acc[ai][bj][m][0] * rs, v1 = acc[ai][bj][m][1] * rs;
                    if (kind >= 1) {
#pragma unroll
                        for (int j = 0; j < 4; ++j) { v0[j] = siluf(v0[j]) * sc[bj][0][j]; v1[j] = siluf(v1[j]) * sc[bj][1][j]; } }
                    u32x4 w; w[0] = cvtpk(v0[0], v0[1]); w[1] = cvtpk(v0[2], v0[3]); w[2] = cvtpk(v1[0], v1[1]); w[3] = cvtpk(v1[2], v1[3]);
                    *(u32x4*)(dst + (size_t)row * 512 + cb + 16 * cl + bj * 8) = w; } }
        }
    }
};
__device__ __forceinline__ void phase_in(const Params& p, int l, char* shm) {
    pg8::Gemm g{p.xb(), p.wt_in() + (size_t)l * NPA * 1024, T, NPA, 1024};
    pg8::StaticOrder S; S.init(T, NPA, GDIM(), BID());
    EpiIn E{p, l};
    pg8::gemm_phase((PG8_LAS unsigned char*)shm, g, S, E);
}
__device__ __forceinline__ void phase_mix(const Params& p, int l) {
    const float* cw = p.conv_w + l * 3 * 512;
    constexpr int RUN = 16;
    const int nitem = (T / RUN) * 256;
    const int it0 = BID() * NTHR + TID(), itstep = GDIM() * NTHR;
    for (int it = it0; it < nitem; it += itstep) {
        const int cp = it & 255, c = cp * 2, t0 = (it >> 8) * RUN, pos0 = t0 & (SEQ - 1);
        {
            const float w00 = cw[c], w01 = cw[c + 1], w10 = cw[512 + c], w11 = cw[513 + c], w20 = cw[1024 + c], w21 = cw[1025 + c];
            unsigned zr[RUN + 2], gr[RUN];
#pragma unroll
            for (int i = 0; i < RUN + 2; ++i) zr[i] = (pos0 + i - 2 >= 0) ? *(const unsigned*)(p.z() + (size_t)(t0 + i - 2) * 512 + c) : 0u;
#pragma unroll
            for (int i = 0; i < RUN; ++i) gr[i] = *(const unsigned*)(p.ga() + (size_t)(t0 + i) * 512 + c);
#pragma unroll
            for (int i = 0; i < RUN; ++i) {
                const float y0 = (w00 * bflo(zr[i]) + w10 * bflo(zr[i + 1]) + w20 * bflo(zr[i + 2])) * bflo(gr[i]);
                const float y1 = (w01 * bfhi(zr[i]) + w11 * bfhi(zr[i + 1]) + w21 * bfhi(zr[i + 2])) * bfhi(gr[i]);
                *(unsigned*)(p.ga() + (size_t)(t0 + i) * 512 + c) = cvtpk(y0, y1);
            }
        }
        {
            const int win = 2 << (c >> 7);
            unsigned ur[RUN + 15], gr[RUN];
#pragma unroll
            for (int i = 0; i < RUN + 15; ++i) ur[i] = (i >= 16 - win && pos0 + i - 15 >= 0) ? *(const unsigned*)(p.u() + (size_t)(t0 + i - 15) * 512 + c) : 0u;
#pragma unroll
            for (int i = 0; i < RUN; ++i) gr[i] = *(const unsigned*)(p.sp() + (size_t)(t0 + i) * 512 + c);
            float s0 = 0.f, s1 = 0.f;
#pragma unroll
            for (int i = 0; i < 15; ++i) { s0 += bflo(ur[i]); s1 += bfhi(ur[i]); }
#pragma unroll
            for (int i = 0; i < RUN; ++i) {
                const int pos = pos0 + i;
                const float u0 = bflo(ur[i + 15]), u1 = bfhi(ur[i + 15]);
                s0 += u0; s1 += u1;
                const float ic = __builtin_amdgcn_rcpf((float)min(pos + 1, win));
                *(unsigned*)(p.sp() + (size_t)(t0 + i) * 512 + c) = cvtpk((s0 * ic - u0) * bflo(gr[i]), (s1 * ic - u1) * bfhi(gr[i]));
                unsigned wo = 0u;
#pragma unroll
                for (int g = 0; g < 4; ++g) if (win == (2 << g)) wo = ur[i + 15 - ((2 << g) - 1)];
                s0 -= bflo(wo); s1 -= bfhi(wo);
            }
        }
    }
}

__device__ __forceinline__ int crow(int r, int hi) { return (r & 3) + 8 * (r >> 2) + 4 * hi; }
__device__ __forceinline__ size_t sc_base(int qb) { return (size_t)32768 * qb * (qb + 1); }
__device__ __forceinline__ void phase_indexer(const Params& p, int b, u16* scbuf, char* shm) {
    const int tid_ = TID(); const int wid = tid_ >> 6, lane = tid_ & 63, ql = lane & 15, fq = lane >> 4; const int bid_ = BID(), gdim_ = GDIM();
    constexpr int NSTEP = 64 * 65;
    const int f0 = (int)(((long)bid_ * NSTEP) / gdim_), f1 = (int)(((long)(bid_ + 1) * NSTEP) / gdim_);
    int qcur = -1;
    bf16x8 bq[8][2]; float wv[8]; u16* srow = nullptr; int qloc = 0;
    char* tl = shm + 40960 + wid * 2304;
#pragma unroll
    for (int h = 0; h < 8; ++h) { wv[h] = 0.f; bq[h][0] = bq[h][1] = (bf16x8){0, 0, 0, 0, 0, 0, 0, 0}; }
    const u16* ikb = p.ik() + ((size_t)b * SEQ + ql) * 64 + fq * 8;
    for (int f = f0; f < f1; ++f) {
        int q = (int)((sqrtf(4.f * f + 1.f) - 1.f) * 0.5f);
        while ((q + 1) * (q + 2) <= f) ++q;
        while (q * (q + 1) > f) --q;
        const int tt = f - q * (q + 1);
        if (q != qcur) {
            qcur = q; qloc = q * 128 + wid * 16 + ql;
            const size_t row = (size_t)b * SEQ + qloc;
#pragma unroll
            for (int h = 0; h < 8; ++h)
#pragma unroll
                for (int kc = 0; kc < 2; ++kc) bq[h][kc] = *(const bf16x8*)(p.iq() + row * 512 + h * 64 + kc * 32 + fq * 8);
            const f32x4 x = *(const f32x4*)(p.iw() + row * 8), y = *(const f32x4*)(p.iw() + row * 8 + 4);
            wv[0] = x[0]; wv[1] = x[1]; wv[2] = x[2]; wv[3] = x[3]; wv[4] = y[0]; wv[5] = y[1]; wv[6] = y[2]; wv[7] = y[3];
            const int a = q >> 1;
            srow = scbuf + sc_base(a) + (size_t)(q * 128 + wid * 16 + (lane >> 2) - a * 256) * (256 * (a + 1)) + (lane & 3) * 16;
        }
        const int key0 = tt * 64;
        bf16x8 ka[4][2];
#pragma unroll
        for (int kg = 0; kg < 4; ++kg)
#pragma unroll
            for (int kc = 0; kc < 2; ++kc) ka[kg][kc] = *(const bf16x8*)(ikb + (size_t)(key0 + kg * 16) * 64 + kc * 32);
        const bool band = (key0 + 63 > q * 128 + wid * 16);
#pragma unroll
        for (int kg = 0; kg < 4; ++kg) {
            f32x4 sacc = (f32x4){0.f, 0.f, 0.f, 0.f};
#pragma unroll
            for (int h = 0; h < 8; ++h) {
                f32x4 c = (f32x4){0.f, 0.f, 0.f, 0.f};
                c = __builtin_amdgcn_mfma_f32_16x16x32_bf16(ka[kg][0], bq[h][0], c, 0, 0, 0);
                c = __builtin_amdgcn_mfma_f32_16x16x32_bf16(ka[kg][1], bq[h][1], c, 0, 0, 0);
#pragma unroll
                for (int j = 0; j < 4; ++j) sacc[j] = __builtin_fmaf(wv[h], __builtin_fmaxf(c[j], 0.f), sacc[j]);
            }
            const int kb = key0 + kg * 16 + fq * 4;
            if (band) {
#pragma unroll
                for (int j = 0; j < 4; ++j) if (kb + j > qloc) sacc[j] = -INFINITY;
            }
            union { _Float16 h[4]; u32x2 v; } pk;
            pk.h[0] = (_Float16)sacc[0]; pk.h[1] = (_Float16)sacc[1]; pk.h[2] = (_Float16)sacc[2]; pk.h[3] = (_Float16)sacc[3];
            *(u32x2*)(tl + ql * 144 + kg * 32 + fq * 8) = pk.v;
        }
        { const u32x4 r0 = *(const u32x4*)(tl + (lane >> 2) * 144 + (lane & 3) * 32), r1 = *(const u32x4*)(tl + (lane >> 2) * 144 + (lane & 3) * 32 + 16);
          *(u32x4*)(srow + key0) = r0; *(u32x4*)(srow + key0 + 8) = r1; }
    }
}

__device__ __forceinline__ size_t mk_base(int qb) { return (size_t)512 * qb * (qb + 1); }
constexpr size_t MASK_WORDS_PER_BATCH = 540672;
__device__ __forceinline__ unsigned f16key(unsigned h) { return (h & 0x8000u) ? (~h & 0xffffu) : (h | 0x8000u); }
__device__ __forceinline__ void hist_scan(const unsigned* h, int lane, unsigned target, int& bin, unsigned& above, unsigned& inbin) {
    const u32x4 a = *(const u32x4*)(h + 4 * lane), b = *(const u32x4*)(h + 256 + 4 * lane), c = *(const u32x4*)(h + 512 + 4 * lane), d = *(const u32x4*)(h + 768 + 4 * lane);
    const unsigned h0 = a[0] + b[0] + c[0] + d[0], h1 = a[1] + b[1] + c[1] + d[1], h2 = a[2] + b[2] + c[2] + d[2], h3 = a[3] + b[3] + c[3] + d[3];
    const unsigned tot = h0 + h1 + h2 + h3;
#define DPP_SHL(v, n) ((unsigned)__builtin_amdgcn_update_dpp(0, (int)(v), 0x100 + (n), 0xf, 0xf, true))
    unsigned x = tot;
    x += DPP_SHL(x, 1); x += DPP_SHL(x, 2); x += DPP_SHL(x, 4); x += DPP_SHL(x, 8);
#undef DPP_SHL
    { const unsigned t1 = (unsigned)__builtin_amdgcn_readlane((int)x, 16), t2 = (unsigned)__builtin_amdgcn_readlane((int)x, 32), t3 = (unsigned)__builtin_amdgcn_readlane((int)x, 48);
      const int rowi = lane >> 4;
      x += (rowi == 0) ? (t1 + t2 + t3) : (rowi == 1) ? (t2 + t3) : (rowi == 2) ? t3 : 0u; }
    const unsigned ab = x - tot, c3 = ab + h3, c2 = c3 + h2, c1 = c2 + h1, c0 = c1 + h0;
    int fb = -1; unsigned fa = 0, fc = 0;
    if (ab < target && c3 >= target) { fb = 4 * lane + 3; fa = ab; fc = h3; }
    else if (c3 < target && c2 >= target) { fb = 4 * lane + 2; fa = c3; fc = h2; }
    else if (c2 < target && c1 >= target) { fb = 4 * lane + 1; fa = c2; fc = h1; }
    else if (c1 < target && c0 >= target) { fb = 4 * lane; fa = c1; fc = h0; }
    const u64 m = __ballot(fb >= 0); const int src = (m == 0) ? 0 : (__ffsll((unsigned long long)m) - 1);
    bin = __builtin_amdgcn_readlane(fb, src); above = (unsigned)__builtin_amdgcn_readlane((int)fa, src); inbin = (unsigned)__builtin_amdgcn_readlane((int)fc, src);
}
__device__ __forceinline__ unsigned f16key2(unsigned w) { const unsigned sg = (w >> 15) & 0x00010001u; return w ^ (((sg << 15) - sg) | 0x80008000u); }
__device__ __forceinline__ void phase_select(const Params& p, int b, char* shm, const u16* scbuf) {
    const int tid_ = TID(); const int wid = __builtin_amdgcn_readfirstlane(tid_ >> 6), lane = tid_ & 63;
    const int gw = BID() * 8 + wid, nw = GDIM() * 8;
    unsigned* hist = (unsigned*)shm + wid * 1152;
    const int hsubi = (lane >> 4) * 256, dummyi = 1024 + lane;
    typedef unsigned short us2 __attribute__((ext_vector_type(2)));
#define ROW_T(i_) ({ const int kq_ = (i_) / nw; ((mirror && (kq_ & 1)) ? (kq_ * nw + (nw - 1 - ((i_) - kq_ * nw))) : (i_)); })
#define ROW_LOAD(t_) do { const int qb_ = (t_) >> 8, ntr_ = 2 * (((t_) >> 7) + 1), nch_ = (ntr_ + 7) >> 3; \
        const u16* sr_ = scbuf + sc_base(qb_) + (size_t)((t_) - qb_ * 256) * (256 * (qb_ + 1)); \
        _Pragma("unroll") for (int c = 0; c < 16; ++c) { raw[c] = (u32x4){0u, 0u, 0u, 0u}; if (c < nch_) { if (lane < 8 * (ntr_ - 8 * c)) raw[c] = *(const u32x4*)(sr_ + 512 * c + 8 * lane); } } } while (0)
    const bool mirror = (SEQ % (2 * nw)) == 0;
    u32x4 raw[16];
    if (gw < SEQ) { const int t0_ = ROW_T(gw); ROW_LOAD(t0_); }
    for (int i = gw; i < SEQ; i += nw) {
        const int t = ROW_T(i);
        const int qb = t >> 8, ntile = 4 * (qb + 1), ntr = 2 * ((t >> 7) + 1);
        const int nch = (ntr + 7) >> 3, nchw = (ntile + 7) >> 3;
        unsigned char* mrow = (unsigned char*)(p.mask() + (size_t)b * MASK_WORDS_PER_BATCH + mk_base(qb) + (size_t)(t - qb * 256) * ntile);
        unsigned key[16][4];
#pragma unroll
        for (int c = 0; c < 16; ++c) {
            const bool valid = (c < nch) && (lane < 8 * (ntr - 8 * c));
#pragma unroll
            for (int r = 0; r < 4; ++r) key[c][r] = valid ? f16key2(raw[c][r]) : 0u;
        }
        if (i + nw < SEQ) { const int tn_ = ROW_T(i + nw); ROW_LOAD(tn_); }
        unsigned thrm1 = 0x03ffu, thr = 0x0400u; int need = 0; bool fast = true;
        if (t >= 256) {
            us2 a1 = (us2){0, 0}, a2 = (us2){0, 0};
#pragma unroll
            for (int c = 0; c < 16; ++c) {
                if (c < nch) {
#pragma unroll
                    for (int r = 0; r < 4; ++r) { const us2 kk = __builtin_bit_cast(us2, key[c][r]);
                        const us2 tmx = __builtin_elementwise_max(a1, kk), tmn = __builtin_elementwise_min(a1, kk); a1 = tmx; a2 = __builtin_elementwise_max(a2, tmn); }
                }
            }
            unsigned Lb = min((unsigned)a2[0], (unsigned)a2[1]);
#define DPP_ROR(v, n) ((unsigned)__builtin_amdgcn_update_dpp((int)(v), (int)(v), 0x120 + (n), 0xf, 0xf, false))
            Lb = min(Lb, DPP_ROR(Lb, 8)); Lb = min(Lb, DPP_ROR(Lb, 4)); Lb = min(Lb, DPP_ROR(Lb, 2)); Lb = min(Lb, DPP_ROR(Lb, 1));
#undef DPP_ROR
            Lb = min(min((unsigned)__builtin_amdgcn_readlane((int)Lb, 0), (unsigned)__builtin_amdgcn_readlane((int)Lb, 16)), min((unsigned)__builtin_amdgcn_readlane((int)Lb, 32), (unsigned)__builtin_amdgcn_readlane((int)Lb, 48)));
            const u32x4 z4 = (u32x4){0u, 0u, 0u, 0u};
#pragma unroll
            for (int c = 0; c < 4; ++c) *(u32x4*)(hist + c * 256 + 4 * lane) = z4;
#pragma unroll
            for (int c = 0; c < 16; ++c) {
                if (c < nch) {
#pragma unroll
                    for (int r = 0; r < 4; ++r) { const unsigned kk = key[c][r]; const unsigned lo = kk & 0xffffu, hi = kk >> 16;
                        atomicAdd(hist + ((lo >= Lb) ? (hsubi + (int)(lo >> 8)) : dummyi), 1u);
                        atomicAdd(hist + ((hi >= Lb) ? (hsubi + (int)(hi >> 8)) : dummyi), 1u); }
                }
            }
            asm volatile("s_waitcnt lgkmcnt(0)" ::: "memory");
            int B1; unsigned ab1, in1;
            hist_scan(hist, lane, 256u, B1, ab1, in1);
            asm volatile("s_waitcnt lgkmcnt(0)" ::: "memory");
#pragma unroll
            for (int c = 0; c < 4; ++c) *(u32x4*)(hist + c * 256 + 4 * lane) = z4;
#pragma unroll
            for (int c = 0; c < 16; ++c) {
                if (c < nch) {
#pragma unroll
                    for (int r = 0; r < 4; ++r) { const unsigned kk = key[c][r]; const unsigned lo = kk & 0xffffu, hi = kk >> 16;
                        const bool ml = ((lo >> 8) == (unsigned)B1) && (lo >= Lb), mh = ((hi >> 8) == (unsigned)B1) && (hi >= Lb);
                        if (__any(ml || mh)) { if (ml) atomicAdd(hist + hsubi + (int)(lo & 255u), 1u); if (mh) atomicAdd(hist + hsubi + (int)(hi & 255u), 1u); } }
                }
            }
            asm volatile("s_waitcnt lgkmcnt(0)" ::: "memory");
            int B2; unsigned ab2, in2;
            hist_scan(hist, lane, 256u - ab1, B2, ab2, in2);
            asm volatile("s_waitcnt lgkmcnt(0)" ::: "memory");
            thr = __builtin_amdgcn_readfirstlane(((unsigned)B1 << 8) | (unsigned)B2);
            need = __builtin_amdgcn_readfirstlane(256 - (int)(ab1 + ab2));
            const int neq = __builtin_amdgcn_readfirstlane((int)in2);
            fast = (need == neq);
            thrm1 = thr - 1u;
        }
        if (fast) {
#pragma unroll
            for (int c = 0; c < 16; ++c) {
                if (c < nchw) {
                    unsigned m = 0u;
#pragma unroll
                    for (int ii = 7; ii >= 0; --ii) { const unsigned kk = key[c][ii >> 1]; const unsigned kv = (ii & 1) ? (kk >> 16) : (kk & 0xffffu); m = m + m + ((kv > thrm1) ? 1u : 0u); }
                    if (64 * c + lane < 8 * ntile) mrow[64 * c + lane] = (unsigned char)m;
                }
            }
        } else {
            int base = 0;
#pragma unroll 1
            for (int c = 0; c < 16; ++c) {
                if (c < nchw) {
                    unsigned m = 0u, e = 0u;
#pragma unroll
                    for (int ii = 7; ii >= 0; --ii) { unsigned kk = (ii >> 1) == 0 ? key[0][0] : 0u;
#pragma unroll
                        for (int cc = 0; cc < 16; ++cc) if (cc == c) kk = key[cc][ii >> 1];
                        const unsigned kv = (ii & 1) ? (kk >> 16) : (kk & 0xffffu); m = m + m + ((kv > thr) ? 1u : 0u); e = e + e + ((kv == thr) ? 1u : 0u); }
                    const int cnt = __builtin_popcount(e);
                    int pre = cnt;
#pragma unroll
                    for (int dd = 1; dd < 64; dd <<= 1) { const int y = __shfl_up(pre, dd); if (lane >= dd) pre += y; }
                    const int tot = __shfl(pre, 63);
                    int rank = base + pre - cnt;
#pragma unroll
                    for (int ii = 0; ii < 8; ++ii) if ((e >> ii) & 1u) { if (rank < need) m |= (1u << ii); ++rank; }
                    base += tot;
                    if (64 * c + lane < 8 * ntile) mrow[64 * c + lane] = (unsigned char)m;
                }
            }
        }
    }
}

constexpr int A_D = 64, A_DM = 512, A_NW = 8, A_QBLK = 32, A_QB = 256, A_KVBLK = 64, A_NQB = SEQ / A_QB, A_NHEAD = 8;
constexpr float A_C2 = 0.125f * 1.4426950408889634f;
constexpr int A_SLOTB = 8192, A_LDS_K = 0, A_LDS_V = 3 * A_SLOTB, A_LDS_WS = 6 * A_SLOTB, A_LDS_OST = A_LDS_WS + A_NW * 256, A_LDS_MK = A_LDS_OST + A_NW * 4096, A_LDS_BYTES = A_LDS_MK + A_NW * 2048;
#define ATTN_THR 8
#define SBAR() __builtin_amdgcn_sched_barrier(0)
#define PIN(x) asm volatile("" : "+v"(x))
#define MFMA32(a, b, c) __builtin_amdgcn_mfma_f32_32x32x16_bf16(a, b, c, 0, 0, 0)
#define WAIT_BAR(N) asm volatile("s_waitcnt vmcnt(" #N ") lgkmcnt(0)\n\ts_barrier" ::: "memory")
__device__ __forceinline__ void glds16s(const void* sbase, unsigned voff, unsigned lds_base) {
    unsigned sv; asm volatile("s_mov_b32 %0, m0\n\ts_mov_b32 m0, %3\n\ts_nop 0\n\tglobal_load_lds_dwordx4 %1, %2\n\ts_mov_b32 m0, %0" : "=&s"(sv) : "v"(voff), "s"(sbase), "s"(lds_base) : "memory"); }
typedef __attribute__((address_space(3))) const char* lds_cptr;
typedef short v4i16_t __attribute__((ext_vector_type(4)));
__device__ __forceinline__ void kload2(bf16x8* kf, lds_cptr kp, int d0) { kf[2 * d0] = *(const __attribute__((address_space(3))) bf16x8*)(kp + d0 * 2048); kf[2 * d0 + 1] = *(const __attribute__((address_space(3))) bf16x8*)(kp + d0 * 2048 + 512); }
__device__ __forceinline__ s16x4 vtr(lds_cptr p) { return __builtin_bit_cast(s16x4, __builtin_amdgcn_ds_read_tr16_b64_v4i16((__attribute__((address_space(3))) v4i16_t*)p)); }
#define MX3(a, b, c) __builtin_fmaxf(__builtin_fmaxf((a), (b)), (c))
__device__ __forceinline__ float rowmax(const f32x16& p0, const f32x16& p1) {
    float a = MX3(p0[0], p0[1], p1[0]), b = MX3(p0[2], p0[3], p1[1]); a = MX3(a, p1[2], p1[3]);
#pragma unroll
    for (int r = 4; r < 16; r += 4) { a = MX3(a, p0[r], p0[r + 1]); b = MX3(b, p0[r + 2], p0[r + 3]); a = MX3(a, p1[r], p1[r + 1]); b = MX3(b, p1[r + 2], p1[r + 3]); }
    float m = __builtin_fmaxf(a, b); auto rr = __builtin_amdgcn_permlane32_swap(__float_as_uint(m), __float_as_uint(m), false, false);
    return __builtin_fmaxf(__uint_as_float(rr[0]), __uint_as_float(rr[1])); }
__device__ __forceinline__ void cmask(f32x16& p0, f32x16& p1, int jb, int qrel, int hi) {
    const int kb = 64 * jb + 4 * hi;
#pragma unroll
    for (int r = 0; r < 16; ++r) { const int kv = kb + (r & 3) + 8 * (r >> 2); if (kv > qrel) p0[r] = -INFINITY; if (kv + 32 > qrel) p1[r] = -INFINITY; } }
__device__ __forceinline__ float mand(float x, unsigned w, int pos) { return __uint_as_float(__float_as_uint(x) & (unsigned)__builtin_amdgcn_sbfe((int)w, pos, 1)); }
#define BITP(i) (((i) & 3) + 8 * ((i) >> 2))

__device__ __forceinline__ void attn64_unit(int b, int h, int qb, const u16* Q, const u16* __restrict__ K, const u16* __restrict__ V, const u16* __restrict__ SG, u16* O, const u64* mrow0, char* lds) {
    const int tid = TID(), lane = tid & 63, r32 = lane & 31, hi = lane >> 5; const int wid = __builtin_amdgcn_readfirstlane(tid >> 6);
    const long rowbase = (long)b * SEQ; const int q0 = qb * A_QB, NT = (q0 + A_QB) / A_KVBLK;
    const u16* Qw = Q + (rowbase + q0 + wid * A_QBLK) * A_DM + h * A_D;
    const unsigned lds0 = (unsigned)(uintptr_t)lds; float* wsf = (float*)(lds + A_LDS_WS) + wid * 64;
    const u16* kbase = K + rowbase * A_DM + h * A_D; const u16* vbase = V + rowbase * A_DM + h * A_D;
    const unsigned koff = (unsigned)(lane * A_DM + wid * 8) * 2u;
    const unsigned voff = (unsigned)((16 * (wid & 3) + (lane >> 2)) * A_DM + (wid >> 2) * 32 + (lane & 3) * 8) * 2u;
    const unsigned kdst = lds0 + A_LDS_K + wid * 1024, vdst = lds0 + A_LDS_V + wid * 1024;
#define DMA_K(t, slot) glds16s(kbase + (long)(t) * A_KVBLK * A_DM, koff, (unsigned)__builtin_amdgcn_readfirstlane(kdst + (slot)))
#define DMA_V(t, slot) glds16s(vbase + (long)(t) * A_KVBLK * A_DM, voff, (unsigned)__builtin_amdgcn_readfirstlane(vdst + (slot)))
#define DMA_M(chunk) glds16s(mrow0 + 2 * (chunk), moff, (unsigned)__builtin_amdgcn_readfirstlane(mdst + ((chunk) & 1) * 1024))
#define MWORD(t) (*(const u64*)(lds + A_LDS_MK + wid * 2048 + (((t) >> 1) & 1) * 1024 + r32 * 16 + ((t) & 1) * 8))
    const lds_cptr vp0 = (lds_cptr)lds + A_LDS_V + ((lane >> 4) & 1) * 32 + (lane & 3) * 8 + (4 * hi + ((lane & 15) >> 2)) * 64;
    const lds_cptr kp0 = (lds_cptr)lds + A_LDS_K + hi * 1024 + r32 * 16;
    const int qrel = wid * A_QBLK + r32;
    const unsigned moff = (unsigned)(qrel * NT) * 8u;
    const unsigned mdst = lds0 + A_LDS_MK + wid * 2048;
    DMA_M(0);
    DMA_K(0, 0); DMA_V(0, 0); DMA_K(1, A_SLOTB);
    bf16x8 qr[4];
#pragma unroll
    for (int d0 = 0; d0 < 4; ++d0) qr[d0] = *reinterpret_cast<const bf16x8*>(&Qw[(long)r32 * A_DM + d0 * 16 + hi * 8]);
    float mhat = 0.f, l_reg = 0.f; f32x16 o[2]; o[0] = f32x16{}; o[1] = f32x16{};
    const f32x16 zero16 = f32x16{};
    bool resc = false;
    f32x16 pA0, pA1, pB0, pB1; bf16x8 kf[8]; s16x4 vlo[8], vhi[8]; u32x4 pw0, pw1, pw2, pw3;
    typedef unsigned u32x16 __attribute__((ext_vector_type(16)));
    u32x16 mk0, mk1;
    int sl_prev = 0, sl_cur = 0, sl_next = A_SLOTB;
    const int sh4 = 4 * hi;
#define ROT() do { sl_prev = sl_cur; sl_cur = sl_next; sl_next = (sl_next == 2 * A_SLOTB) ? 0 : sl_next + A_SLOTB; } while (0)
#define EX(v) __builtin_amdgcn_exp2f(__builtin_fmaf((v), A_C2, nmh))
#define RESC() do { if (resc) { _Pragma("unroll") for (int d_ = 0; d_ < 2; ++d_) _Pragma("unroll") for (int r = 0; r < 16; ++r) o[d_][r] *= wsf[crow(r, hi)]; } } while (0)
    DMA_K(2, 2 * A_SLOTB);
    WAIT_BAR(3);
    _Pragma("unroll") for (int d0 = 0; d0 < 4; ++d0) kload2(kf, kp0, d0);
    pA0 = MFMA32(kf[0], qr[0], zero16); pA1 = MFMA32(kf[1], qr[0], zero16); pA0 = MFMA32(kf[2], qr[1], pA0); pA1 = MFMA32(kf[3], qr[1], pA1);
    pA0 = MFMA32(kf[4], qr[2], pA0); pA1 = MFMA32(kf[5], qr[2], pA1); pA0 = MFMA32(kf[6], qr[3], pA0); pA1 = MFMA32(kf[7], qr[3], pA1);
    { const float rm = rowmax(pA0, pA1); mhat = rm * A_C2; const float nmh = -mhat;
      const u64 mw0 = MWORD(0); const unsigned wl = (unsigned)mw0 >> sh4, wh = (unsigned)(mw0 >> 32) >> sh4;
#pragma unroll
      for (int r = 0; r < 16; ++r) { pA0[r] = mand(EX(pA0[r]), wl, BITP(r)); pA1[r] = mand(EX(pA1[r]), wh, BITP(r)); } }
    WAIT_BAR(0);
    DMA_K(3, 0); DMA_V(1, A_SLOTB); ROT();
    _Pragma("unroll") for (int d0 = 0; d0 < 4; ++d0) kload2(kf, kp0 + sl_cur, d0);
    WAIT_BAR(2);
#define PKW(P, i) cvtpk(P[i], P[i + 1])
#define PAF(k) __builtin_bit_cast(bf16x8, pw##k)
#define VFR(i) (bf16x8){vlo[i][0], vlo[i][1], vlo[i][2], vlo[i][3], vhi[i][0], vhi[i][1], vhi[i][2], vhi[i][3]}
#define VRD(i) do { vlo[i] = vtr(vp_ + (((i) >> 2) * 4096 + ((i) & 3) * 1024)); vhi[i] = vtr(vp_ + (((i) >> 2) * 4096 + ((i) & 3) * 1024 + 512)); } while (0)
#define KRD(G, d0) do { if (G) { kload2(kf, kp0 + sl_next, d0); SBAR(); } } while (0)
#define GAPA(MF, a0, a1, a2, a3, W0, W1, PW, MK, WW, i) do { MF; sacc += a0; sacc += a1; sacc += a2; sacc += a3; W0; W1; \
    MK[i] = (unsigned)__builtin_amdgcn_sbfe((int)(WW), BITP(i), 1); MK[i + 1] = (unsigned)__builtin_amdgcn_sbfe((int)(WW), BITP(i + 1), 1); MK[i + 2] = (unsigned)__builtin_amdgcn_sbfe((int)(WW), BITP(i + 2), 1); MK[i + 3] = (unsigned)__builtin_amdgcn_sbfe((int)(WW), BITP(i + 3), 1); \
    PIN(PW); PIN(sacc); PIN(MK); SBAR(); } while (0)
#define MAND(x, m) __uint_as_float(__float_as_uint(x) & (m))
#define GAPB(MF, X, i, MK) do { MF; X[i] = MAND(EX(X[i]), MK[i]); X[i + 1] = MAND(EX(X[i + 1]), MK[i + 1]); X[i + 2] = MAND(EX(X[i + 2]), MK[i + 2]); X[i + 3] = MAND(EX(X[i + 3]), MK[i + 3]); PIN(X); SBAR(); } while (0)
#define STEP(C0, C1, P0, P1, t, MASK, GK, GV, GL, ML) do { SBAR(); \
    if (ML) DMA_M(((t) + 1) >> 1); \
    const u64 mw_ = MWORD(t); const unsigned wl_ = (unsigned)(mw_) >> sh4, wh_ = (unsigned)((mw_) >> 32) >> sh4; \
    const lds_cptr vp_ = vp0 + sl_prev; \
    VRD(0); SBAR(); float sacc = P0[0] + P0[1]; \
                    GAPA(C0 = MFMA32(kf[0], qr[0], zero16), P0[2], P0[3], P0[4], P0[5],     pw0[0] = PKW(P0, 0),  pw0[1] = PKW(P0, 2),  pw0, mk0, wl_, 0); \
    VRD(4); SBAR(); GAPA(C1 = MFMA32(kf[1], qr[0], zero16), P0[6], P0[7], P0[8], P0[9],     pw0[2] = PKW(P0, 4),  pw0[3] = PKW(P0, 6),  pw0, mk0, wl_, 4); \
    VRD(1); SBAR(); GAPA(C0 = MFMA32(kf[2], qr[1], C0),    P0[10], P0[11], P0[12], P0[13], pw1[0] = PKW(P0, 8),  pw1[1] = PKW(P0, 10), pw1, mk0, wl_, 8); \
    VRD(5); SBAR(); GAPA(C1 = MFMA32(kf[3], qr[1], C1),    P0[14], P0[15], P1[0], P1[1],   pw1[2] = PKW(P0, 12), pw1[3] = PKW(P0, 14), pw1, mk0, wl_, 12); \
    VRD(2); SBAR(); GAPA(C0 = MFMA32(kf[4], qr[2], C0),    P1[2], P1[3], P1[4], P1[5],     pw2[0] = PKW(P1, 0),  pw2[1] = PKW(P1, 2),  pw2, mk1, wh_, 0); \
    VRD(6); SBAR(); GAPA(C1 = MFMA32(kf[5], qr[2], C1),    P1[6], P1[7], P1[8], P1[9],     pw2[2] = PKW(P1, 4),  pw2[3] = PKW(P1, 6),  pw2, mk1, wh_, 4); \
    VRD(3); SBAR(); GAPA(C0 = MFMA32(kf[6], qr[3], C0),    P1[10], P1[11], P1[12], P1[13], pw3[0] = PKW(P1, 8),  pw3[1] = PKW(P1, 10), pw3, mk1, wh_, 8); \
    VRD(7); SBAR(); GAPA(C1 = MFMA32(kf[7], qr[3], C1),    P1[14], P1[15], 0.f, 0.f,       pw3[2] = PKW(P1, 12), pw3[3] = PKW(P1, 14), pw3, mk1, wh_, 12); \
    l_reg += sacc; \
    if (GK) DMA_K((t) + 3, sl_cur); if (GV) DMA_V((t) + 1, sl_next); \
    { const float rm = __builtin_fmaf(rowmax(C0, C1), A_C2, -mhat); resc = false; \
      if (__builtin_expect(__any(rm > (float)ATTN_THR), 0)) { const float dl = __builtin_fmaxf(rm, 0.f); mhat += dl; \
          const float f = __builtin_amdgcn_exp2f(-dl); l_reg *= f; if (hi == 0) wsf[r32] = f; resc = true; } } \
    const float nmh = -mhat; SBAR(); \
    GAPB(o[0] = MFMA32(PAF(0), VFR(0), o[0]), C0, 0, mk0);              GAPB(o[1] = MFMA32(PAF(0), VFR(4), o[1]), C0, 4, mk0); \
    KRD(GL, 0); GAPB(o[0] = MFMA32(PAF(1), VFR(1), o[0]), C0, 8, mk0);  KRD(GL, 1); GAPB(o[1] = MFMA32(PAF(1), VFR(5), o[1]), C0, 12, mk0); \
    KRD(GL, 2); GAPB(o[0] = MFMA32(PAF(2), VFR(2), o[0]), C1, 0, mk1);  KRD(GL, 3); GAPB(o[1] = MFMA32(PAF(2), VFR(6), o[1]), C1, 4, mk1); \
    GAPB(o[0] = MFMA32(PAF(3), VFR(3), o[0]), C1, 8, mk1);              GAPB(o[1] = MFMA32(PAF(3), VFR(7), o[1]), C1, 12, mk1); \
    } while (0)
    int t = 1;
    for (; t + 5 < NT; t += 2) {
        STEP(pB0, pB1, pA0, pA1, t, false, true, true, true, true);      WAIT_BAR(2); RESC(); ROT();
        STEP(pA0, pA1, pB0, pB1, t + 1, false, true, true, true, false); WAIT_BAR(2); RESC(); ROT();
    }
#define ENDW(tt) do { if ((tt) + 3 < NT) { WAIT_BAR(2); } else if ((tt) + 2 < NT) { WAIT_BAR(1); } else { WAIT_BAR(0); } } while (0)
    for (; t + 1 < NT; t += 2) {
        STEP(pB0, pB1, pA0, pA1, t, true, (t + 3 < NT), (t + 1 < NT), (t + 1 < NT), (t + 1 < NT));         ENDW(t);     RESC(); ROT();
        STEP(pA0, pA1, pB0, pB1, t + 1, true, (t + 4 < NT), (t + 2 < NT), (t + 2 < NT), false);            ENDW(t + 1); RESC(); ROT();
    }
    STEP(pB0, pB1, pA0, pA1, NT - 1, true, false, false, false, false); RESC();
    { float sacc = pB0[0] + pB0[1];
#pragma unroll
      for (int r = 2; r < 16; ++r) sacc += pB0[r];
#pragma unroll
      for (int r = 0; r < 16; ++r) sacc += pB1[r];
      l_reg += sacc;
      pw0 = (u32x4){PKW(pB0, 0), PKW(pB0, 2), PKW(pB0, 4), PKW(pB0, 6)}; pw1 = (u32x4){PKW(pB0, 8), PKW(pB0, 10), PKW(pB0, 12), PKW(pB0, 14)};
      pw2 = (u32x4){PKW(pB1, 0), PKW(pB1, 2), PKW(pB1, 4), PKW(pB1, 6)}; pw3 = (u32x4){PKW(pB1, 8), PKW(pB1, 10), PKW(pB1, 12), PKW(pB1, 14)};
      const lds_cptr vp_ = vp0 + sl_cur; _Pragma("unroll") for (int i = 0; i < 8; ++i) VRD(i);
      o[0] = MFMA32(PAF(0), VFR(0), o[0]); o[1] = MFMA32(PAF(0), VFR(4), o[1]); o[0] = MFMA32(PAF(1), VFR(1), o[0]); o[1] = MFMA32(PAF(1), VFR(5), o[1]);
      o[0] = MFMA32(PAF(2), VFR(2), o[0]); o[1] = MFMA32(PAF(2), VFR(6), o[1]); o[0] = MFMA32(PAF(3), VFR(3), o[0]); o[1] = MFMA32(PAF(3), VFR(7), o[1]); }
    { auto rr = __builtin_amdgcn_permlane32_swap(__float_as_uint(l_reg), __float_as_uint(l_reg), false, false); l_reg = __uint_as_float(rr[0]) + __uint_as_float(rr[1]); }
    if (hi == 0) wsf[32 + r32] = l_reg; asm volatile("s_waitcnt lgkmcnt(0)" ::: "memory");
    float rli[16];
#pragma unroll
    for (int r = 0; r < 16; ++r) rli[r] = __builtin_amdgcn_rcpf(wsf[32 + crow(r, hi)]);
    u16* Ow = O + (rowbase + q0 + wid * A_QBLK) * A_DM + h * A_D; const u16* Gw = SG + (rowbase + q0 + wid * A_QBLK) * A_DM + h * A_D;
    u16* stg = (u16*)(lds + A_LDS_OST) + wid * 2048;
#pragma unroll
    for (int r = 0; r < 16; ++r) { const int orow = crow(r, hi);
#pragma unroll
        for (int d0 = 0; d0 < 2; ++d0) stg[orow * 64 + d0 * 32 + r32] = f2bf(o[d0][r] * rli[r]); }
    asm volatile("s_waitcnt lgkmcnt(0)" ::: "memory");
#pragma unroll
    for (int i = 0; i < 4; ++i) { const int row = i * 8 + (lane >> 3), ch = lane & 7;
        u32x4 ov = *(const u32x4*)(stg + row * 64 + ch * 8); u32x4 gv = *(const u32x4*)(Gw + (long)row * A_DM + ch * 8); u32x4 rv;
#pragma unroll
        for (int e = 0; e < 4; ++e) rv[e] = cvtpk(bflo(ov[e]) * bflo(gv[e]), bfhi(ov[e]) * bfhi(gv[e]));
        *(u32x4*)(Ow + (long)row * A_DM + ch * 8) = rv; }
    asm volatile("s_waitcnt vmcnt(0) lgkmcnt(0)\n\ts_barrier" ::: "memory");
#undef DMA_K
#undef DMA_V
#undef DMA_M
#undef MWORD
#undef ROT
#undef EX
#undef RESC
#undef PKW
#undef PAF
#undef VFR
#undef VRD
#undef KRD
#undef ENDW
#undef GAPA
#undef GAPB
#undef MAND
#undef STEP
}
__device__ __forceinline__ void phase_attn(const Params& p, char* lds) {
    constexpr int NPAIR = A_NQB / 2, NUNIT = NBATCH * A_NHEAD * NPAIR;
    const int bid_ = BID(), gdim_ = GDIM();
    for (int u = bid_; u < NUNIT; u += gdim_) {
        const int x = u & 7, kk = u >> 3, bh = x + 8 * (kk / NPAIR), j = kk % NPAIR;
        const int b = bh / A_NHEAD, h = bh % A_NHEAD;
        const u64* mb = p.mask() + (size_t)b * MASK_WORDS_PER_BATCH;
        attn64_unit(b, h, j, p.q(), p.k(), p.v(), p.sg(), p.bin(), mb + mk_base(j), lds);
        attn64_unit(b, h, A_NQB - 1 - j, p.q(), p.k(), p.v(), p.sg(), p.bin(), mb + mk_base(A_NQB - 1 - j), lds);
    }
}

struct EpiStash {
    static constexpr bool DUPOK = false;
    u16* stash;
    __device__ __forceinline__ void operator()(const acc_t& acc, const pg8::Unit& u, int ui, int wr, int wc, int fr, int fq) const {
        const int tid_ = TID();
        u32x4* st = (u32x4*)(stash + (size_t)(u.pm * 4 + u.pn) * 65536);
        ROWS_LOOP {
#pragma unroll
            for (int bj = 0; bj < 2; ++bj) { const f32x4 v0 = acc[ai][bj][m][0], v1 = acc[ai][bj][m][1];
                u32x4 w; w[0] = cvtpk(v0[0], v0[1]); w[1] = cvtpk(v0[2], v0[3]); w[2] = cvtpk(v1[0], v1[1]); w[3] = cvtpk(v1[2], v1[3]);
                st[((ai * 4 + m) * 2 + bj) * 512 + tid_] = w; } }
    }
};
struct EpiGate {
    static constexpr bool DUPOK = false;
    const Params& p; int l; int br;
    __device__ __forceinline__ void operator()(const acc_t& acc, const pg8::Unit& u, int ui, int wr, int wc, int fr, int fq) const {
        const float* ssq = p.sumsq() + (size_t)(l & 1) * T * 16;
        const int tid_ = TID();
        const u32x4* st = (const u32x4*)(p.stash() + (size_t)(u.pm * 4 + u.pn) * 65536);
        const int cl = wc * 4 + fq;
        __shared__ float s_rstd[256];
        { if (tid_ < 256) s_rstd[tid_] = row_rstd(ssq, u.pm * 256 + tid_); __syncthreads(); }
        float rsa[8];
#pragma unroll
        for (int ix = 0; ix < 8; ++ix) rsa[ix] = s_rstd[(ix >> 2) * 128 + wr * 64 + (ix & 3) * 16 + fr];
        const char* stp = (const char*)st + (size_t)tid_ * 16;
        char* mpp = (char*)(p.merged() + (size_t)(u.pm * 256 + wr * 64 + fr) * 1024 + u.pn * 256 + 16 * cl);
        u32x4 yb = *(const u32x4*)stp, ob = (br > 0) ? *(const u32x4*)mpp : (u32x4){0u, 0u, 0u, 0u};
        ROWS_LOOP { const int ix = ai * 4 + m; const float rs = rsa[ix];
#pragma unroll
            for (int bj = 0; bj < 2; ++bj) { const f32x4 v0 = acc[ai][bj][m][0] * rs, v1 = acc[ai][bj][m][1] * rs;
                float r[8];
                r[0] = sigmf(v0[0]) * bflo(yb[0]); r[1] = sigmf(v0[1]) * bfhi(yb[0]); r[2] = sigmf(v0[2]) * bflo(yb[1]); r[3] = sigmf(v0[3]) * bfhi(yb[1]);
                r[4] = sigmf(v1[0]) * bflo(yb[2]); r[5] = sigmf(v1[1]) * bfhi(yb[2]); r[6] = sigmf(v1[2]) * bflo(yb[3]); r[7] = sigmf(v1[3]) * bfhi(yb[3]);
                if (br > 0) {
#pragma unroll
                    for (int e = 0; e < 4; ++e) { r[2 * e] += bflo(ob[e]); r[2 * e + 1] += bfhi(ob[e]); } }
                u32x4 wo; wo[0] = cvtpk(r[0], r[1]); wo[1] = cvtpk(r[2], r[3]); wo[2] = cvtpk(r[4], r[5]); wo[3] = cvtpk(r[6], r[7]);
                const char* stn = stp + 8192; char* mpn = (bj == 0) ? (mpp + 16) : (mpp - 16 + ((ix == 3) ? 80 : 16) * 2048);
                asm volatile("" : "+v"(stn), "+v"(mpn));
                if (!(ix == 7 && bj == 1)) { yb = *(const u32x4*)stn; if (br > 0) ob = *(const u32x4*)mpn; }
                *(u32x4*)mpp = wo;
                stp = stn; mpp = mpn; } }
    }
};
__device__ __forceinline__ void phase_merge(const Params& p, int l, char* shm) {
    pg8::RowOrder S{4, 512, GDIM(), BID()};
    for (int br = 0; br < 3; ++br) {
        const u16* Ain = br == 0 ? p.ga() : (br == 1 ? p.bin() : p.sp());
        const u16* Wy = (br == 0 ? p.wt_oa() : (br == 1 ? p.wt_ob() : p.wt_oc())) + (size_t)l * 1024 * 512;
        { pg8::Gemm g{Ain, Wy, T, 1024, 512}; EpiStash E{p.stash()}; pg8::gemm_phase((PG8_LAS unsigned char*)shm, g, S, E); }
        { pg8::Gemm g{p.xb(), p.wt_mg() + (size_t)l * 3072 * 1024 + (size_t)br * 1024 * 1024, T, 1024, 1024}; EpiGate E{p, l, br}; pg8::gemm_phase((PG8_LAS unsigned char*)shm, g, S, E); }
    }
}

struct EpiOut {
    static constexpr bool DUPOK = false;
    const Params& p; int l;
    __device__ __forceinline__ void ldx(size_t o, f32x4& a, f32x4& b) const {
        if (l == 0) { a = *(const f32x4*)(p.x_in + o); b = *(const f32x4*)(p.x_in + o + 4); }
        else { const u32x4 w = *(const u32x4*)(p.xb() + o); a = (f32x4){bflo(w[0]), bfhi(w[0]), bflo(w[1]), bfhi(w[1])}; b = (f32x4){bflo(w[2]), bfhi(w[2]), bflo(w[3]), bfhi(w[3])}; }
    }
    __device__ __forceinline__ void operator()(const acc_t& acc, const pg8::Unit& u, int ui, int wr, int wc, int fr, int fq) const {
        const int cl = wc * 4 + fq;
        f32x4 xb0[2], xb1[2];
#pragma unroll
        for (int bj = 0; bj < 2; ++bj) ldx((size_t)(u.pm * 256 + wr * 64 + fr) * 1024 + u.pn * 256 + 16 * cl + bj * 8, xb0[bj], xb1[bj]);
        ROWS_LOOP { const int row = ROW_OF; const int ix = ai * 4 + m; float ss = 0.f;
            f32x4 x0[2], x1[2];
#pragma unroll
            for (int bj = 0; bj < 2; ++bj) { x0[bj] = xb0[bj] + acc[ai][bj][m][0]; x1[bj] = xb1[bj] + acc[ai][bj][m][1]; }
            if (ix < 7) { const int rown = u.pm * 256 + ((ix + 1) >> 2) * 128 + wr * 64 + ((ix + 1) & 3) * 16 + fr;
#pragma unroll
                for (int bj = 0; bj < 2; ++bj) ldx((size_t)rown * 1024 + u.pn * 256 + 16 * cl + bj * 8, xb0[bj], xb1[bj]); }
#pragma unroll
            for (int bj = 0; bj < 2; ++bj) { const size_t o = (size_t)row * 1024 + u.pn * 256 + 16 * cl + bj * 8;
                if (l == NL - 1) { *(f32x4*)(p.x + o) = x0[bj]; *(f32x4*)(p.x + o + 4) = x1[bj]; }
                else { u32x4 w; w[0] = cvtpk(x0[bj][0], x0[bj][1]); w[1] = cvtpk(x0[bj][2], x0[bj][3]); w[2] = cvtpk(x1[bj][0], x1[bj][1]); w[3] = cvtpk(x1[bj][2], x1[bj][3]); *(u32x4*)(p.xb() + o) = w;
#pragma unroll
                    for (int j = 0; j < 4; ++j) ss += x0[bj][j] * x0[bj][j] + x1[bj][j] * x1[bj][j]; } }
            if (l < NL - 1) { ss += __shfl_xor(ss, 16); ss += __shfl_xor(ss, 32); if (fq == 0) p.sumsq()[(size_t)((l + 1) & 1) * T * 16 + (size_t)row * 16 + u.pn * 4 + wc] = ss; } }
    }
};
__device__ __forceinline__ void phase_out(const Params& p, int l, char* shm) {
    pg8::RowOrder S{4, 512, GDIM(), BID()};
    pg8::Gemm g{p.merged(), p.wt_o() + (size_t)l * 1024 * 1024, T, 1024, 1024};
    EpiOut E{p, l};
    pg8::gemm_phase((PG8_LAS unsigned char*)shm, g, S, E);
}

enum { PH_PREP0 = 0, PH_IN, PH_MIX, PH_IDX, PH_SEL, PH_ATTN, PH_MERGE, PH_OUT };
template <int PH> __global__ __launch_bounds__(NTHR) void k_phase(Params p, int l, int b) {
    extern __shared__ __attribute__((aligned(16))) char shm[];
    if (PH == PH_PREP0) phase_prep0(p, shm);
    if (PH == PH_IN) phase_in(p, l, shm);
    if (PH == PH_MIX) phase_mix(p, l);
    if (PH == PH_IDX) phase_indexer(p, b, p.scores(), shm);
    if (PH == PH_SEL) phase_select(p, b, shm, p.scores());
    if (PH == PH_ATTN) phase_attn(p, shm);
    if (PH == PH_MERGE) phase_merge(p, l, shm);
    if (PH == PH_OUT) phase_out(p, l, shm);
}

#define XB_TMO      128
#define XB_XCNT(j)  (256  + 64 * (j))
#define XB_XSUB(j)  (1280 + 64 * (j))
#define XB_XGEN(j)  (2304 + 64 * (j))
#define XB_TOP      3328
#define XB_TOPGEN   3392
#define XCD_BAR_WORDS 3456
#define XB_SPIN_CAP (1u << 22)
#define LAS __attribute__((address_space(3)))
__device__ __forceinline__ unsigned xb_ld(unsigned* p)              { return __hip_atomic_load(p, __ATOMIC_RELAXED, __HIP_MEMORY_SCOPE_AGENT); }
__device__ __forceinline__ unsigned xb_add(unsigned* p, unsigned v) { return __hip_atomic_fetch_add(p, v, __ATOMIC_RELAXED, __HIP_MEMORY_SCOPE_AGENT); }
__device__ __forceinline__ unsigned xb_xcc_id() { return (unsigned)__builtin_amdgcn_s_getreg((3 << 11) | 20) & 0xFu; }
#define XB_SPIN(cond, bar) do { unsigned _sp = 0; while (cond) { __builtin_amdgcn_s_sleep(1); \
    if ((++_sp & 255u) == 0u) { if (xb_ld(&(bar)[XB_TMO])) break; if (_sp > XB_SPIN_CAP) { atomicAdd(&(bar)[XB_TMO], 1u); break; } } } } while (0)
struct XcdBarrier { unsigned* bar; unsigned x; volatile LAS unsigned* st; };
__device__ __forceinline__ XcdBarrier xcd_barrier_post(unsigned* bar, volatile LAS unsigned* st) {
    XcdBarrier b; b.bar = bar; b.x = xb_xcc_id(); b.st = st;
    if (threadIdx.x == 0) (void)xb_add(&bar[XB_XCNT(b.x)], 1u);
    return b;
}
__device__ __forceinline__ void xcd_barrier_complete(unsigned* bar, unsigned x, unsigned& nloc, unsigned& nx) {
    const unsigned G = gridDim.x * gridDim.y * gridDim.z;
    unsigned sum, cnt, mine, sp = 0u;
    for (;;) {
        sum = 0u; cnt = 0u; mine = 0u;
#pragma unroll
        for (unsigned j = 0; j < 16; ++j) { const unsigned c = xb_ld(&bar[XB_XCNT(j)]); sum += c; cnt += (c > 0u) ? 1u : 0u; mine = (j == x) ? c : mine; }
        if (sum == G) break;
        __builtin_amdgcn_s_sleep(1);
        if ((++sp & 255u) == 0u) { if (xb_ld(&bar[XB_TMO])) break; if (sp > XB_SPIN_CAP) { atomicAdd(&bar[XB_TMO], 1u); break; } }
    }
    nloc = mine > 0u ? mine : 1u; nx = cnt > 0u ? cnt : 1u;
}
__device__ __forceinline__ void xcd_barrier(const XcdBarrier& b) {
    asm volatile("s_waitcnt vmcnt(0)" ::: "memory");
    __syncthreads();
    if (threadIdx.x == 0) {
        unsigned* bar = b.bar;
        __builtin_amdgcn_s_waitcnt(0);
        unsigned nloc = b.st[0], nx = b.st[1];
        if (nloc == 0u) { xcd_barrier_complete(bar, b.x, nloc, nx); b.st[0] = nloc; b.st[1] = nx; }
        const unsigned old = xb_add(&bar[XB_XSUB(b.x)], 1u);
        const unsigned gen = old / nloc;
        if (old + 1u == (gen + 1u) * nloc) {
            __builtin_amdgcn_fence(__ATOMIC_RELEASE, "agent");
            asm volatile("s_waitcnt vmcnt(0)" ::: "memory");
            const unsigned og = xb_add(&bar[XB_TOP], 1u);
            const unsigned tg = og / nx;
            if (og + 1u == (tg + 1u) * nx) xb_add(&bar[XB_TOPGEN], 1u);
            else XB_SPIN(xb_ld(&bar[XB_TOPGEN]) == tg, bar);
            __builtin_amdgcn_fence(__ATOMIC_ACQUIRE, "agent");
            xb_add(&bar[XB_XGEN(b.x)], 1u);
            asm volatile("s_waitcnt vmcnt(0)" ::: "memory");
        } else {
            XB_SPIN(xb_ld(&bar[XB_XGEN(b.x)]) == gen, bar);
            __builtin_amdgcn_fence(__ATOMIC_ACQUIRE, "agent");
            asm volatile("s_waitcnt vmcnt(0)" ::: "memory");
        }
    }
    __syncthreads();
}

#if MEGA
typedef const __attribute__((address_space(4))) Params* kparams_t;
__device__ __forceinline__ Params load_params(kparams_t k) {
    Params q; q.x_in = k->x_in; q.norm_g = k->norm_g; q.w_in = k->w_in; q.conv_w = k->conv_w; q.w_out_conv = k->w_out_conv; q.q_g = k->q_g; q.k_g = k->k_g; q.w_out_attn = k->w_out_attn;
    q.pool_w = k->pool_w; q.pool_scale = k->pool_scale; q.w_out_pool = k->w_out_pool; q.w_o = k->w_o; q.x = k->x; q.ws = k->ws; return q; }
#define PHP(q) kparams_t kq_##q = kp; asm volatile("" : "+s"(kq_##q)); const Params q = load_params(kq_##q);
__global__ __launch_bounds__(NTHR) void k_mega(Params p_unused) {
    extern __shared__ __attribute__((aligned(16))) char shm[];
    cg::grid_group grid = cg::this_grid();
    kparams_t kp = (kparams_t)__builtin_amdgcn_kernarg_segment_ptr();
    __shared__ uint4 xb_words;
    if (threadIdx.x == 0) xb_words = make_uint4(0u, 0u, 0u, 0u);
    __syncthreads();
    const XcdBarrier xb = xcd_barrier_post((unsigned*)(kp->ws + WS_BAR), (volatile LAS unsigned*)&xb_words);

#ifndef SK_PREP
        { PHP(p) phase_prep0(p, shm); }
#endif
#ifdef DUP_PREP
        { PHP(p) phase_prep0(p, shm); }
#endif

    grid.sync();
    for (int l = 0; l < NL; ++l) {

#ifndef SK_IN
        { PHP(p) phase_in(p, l, shm); }
#endif
#ifdef DUP_IN
        { PHP(p) phase_in(p, l, shm); }
#endif

        xcd_barrier(xb);

        { PHP(p) phase_mix(p, l); phase_indexer(p, 0, p.scores(), shm); }
        xcd_barrier(xb);
        { PHP(p) phase_indexer(p, 1, p.scores2(), shm); phase_select(p, 0, shm, p.scores()); }
        xcd_barrier(xb);
        { PHP(p) phase_indexer(p, 2, p.scores(), shm); phase_select(p, 1, shm, p.scores2()); }
        xcd_barrier(xb);
        { PHP(p) phase_indexer(p, 3, p.scores2(), shm); phase_select(p, 2, shm, p.scores()); }
        xcd_barrier(xb);
        { PHP(p) phase_select(p, 3, shm, p.scores2()); }
        xcd_barrier(xb);
#ifndef SK_ATTN
        { PHP(p) phase_attn(p, shm); }
#endif
#ifdef DUP_ATTN
        { PHP(p) phase_attn(p, shm); }
#endif

        xcd_barrier(xb);

#ifndef SK_MERGE
        { PHP(p) phase_merge(p, l, shm); }
#endif
#ifdef DUP_MERGE
        { PHP(p) phase_merge(p, l, shm); }
#endif

        xcd_barrier(xb);

#ifndef SK_OUT
        { PHP(p) phase_out(p, l, shm); }
#endif

        xcd_barrier(xb);
    }
}
#endif

static Params make_params(void* const* d_in, void* d_out, void* d_ws) {
    Params p{};
    p.x_in = (const float*)d_in[0]; p.norm_g = (const float*)d_in[1]; p.w_in = (const float*)d_in[2]; p.conv_w = (const float*)d_in[3];
    p.w_out_conv = (const float*)d_in[4]; p.q_g = (const float*)d_in[5]; p.k_g = (const float*)d_in[6]; p.w_out_attn = (const float*)d_in[7];
    p.pool_w = (const float*)d_in[8]; p.pool_scale = (const float*)d_in[9]; p.w_out_pool = (const float*)d_in[10]; p.w_o = (const float*)d_in[11];
    p.x = (float*)d_out; p.ws = (char*)d_ws;
    return p;
}

extern "C" void kernel_launch(void* const* d_in, const int* in_sizes, int n_in, void* d_out, int out_size, void* d_ws, size_t ws_size, hipStream_t stream) {
    if (ws_size < WS_NEEDED) { fprintf(stderr, "workspace too small: %zu < %zu\n", ws_size, (size_t)WS_NEEDED); return; }
    Params p = make_params(d_in, d_out, d_ws);
    static int grid = 0;
    if (!grid) { int dev = 0, cus = 0; hipGetDevice(&dev); hipDeviceGetAttribute(&cus, hipDeviceAttributeMultiprocessorCount, dev); if (cus <= 0 || cus > 256) cus = 256; grid = (cus / 8) * 8; }
#if MEGA
    static bool attr = false;
    if (!attr) { hipFuncSetAttribute((const void*)k_mega, hipFuncAttributeMaxDynamicSharedMemorySize, LDS_BYTES); attr = true; }
    hipMemsetAsync((char*)d_ws + WS_BAR, 0, 16384, stream);
    void* args[] = {&p};
    hipError_t e = hipLaunchCooperativeKernel((void*)k_mega, dim3(grid), dim3(NTHR), args, LDS_BYTES, stream);
    if (e != hipSuccess) fprintf(stderr, "cooperative launch failed: %s\n", hipGetErrorString(e));
#else
    static bool attr = false;
    if (!attr) {
        hipFuncSetAttribute((const void*)k_phase<PH_PREP0>, hipFuncAttributeMaxDynamicSharedMemorySize, LDS_BYTES);
        hipFuncSetAttribute((const void*)k_phase<PH_IN>, hipFuncAttributeMaxDynamicSharedMemorySize, LDS_BYTES);
        hipFuncSetAttribute((const void*)k_phase<PH_MIX>, hipFuncAttributeMaxDynamicSharedMemorySize, LDS_BYTES);
        hipFuncSetAttribute((const void*)k_phase<PH_IDX>, hipFuncAttributeMaxDynamicSharedMemorySize, LDS_BYTES);
        hipFuncSetAttribute((const void*)k_phase<PH_SEL>, hipFuncAttributeMaxDynamicSharedMemorySize, LDS_BYTES);
        hipFuncSetAttribute((const void*)k_phase<PH_ATTN>, hipFuncAttributeMaxDynamicSharedMemorySize, LDS_BYTES);
        hipFuncSetAttribute((const void*)k_phase<PH_MERGE>, hipFuncAttributeMaxDynamicSharedMemorySize, LDS_BYTES);
        hipFuncSetAttribute((const void*)k_phase<PH_OUT>, hipFuncAttributeMaxDynamicSharedMemorySize, LDS_BYTES);
        attr = true;
    }
#define LAUNCH(PH, l, b) hipLaunchKernelGGL(k_phase<PH>, dim3(grid), dim3(NTHR), LDS_BYTES, stream, p, l, b)
    LAUNCH(PH_PREP0, 0, 0);
    for (int l = 0; l < NL; ++l) {
        LAUNCH(PH_IN, l, 0);
        LAUNCH(PH_MIX, l, 0);
        for (int b = 0; b < NBATCH; ++b) { LAUNCH(PH_IDX, l, b); LAUNCH(PH_SEL, l, b); }
        LAUNCH(PH_ATTN, l, 0);
        LAUNCH(PH_MERGE, l, 0);
        LAUNCH(PH_OUT, l, 0);
    }
#endif
}
```

```cpp
#include <hip/hip_runtime.h>
#include <hip/hip_cooperative_groups.h>
#include <stdint.h>
#include <stdio.h>
namespace cg = cooperative_groups;

typedef unsigned short u16;
typedef unsigned long long u64;
typedef __attribute__((ext_vector_type(8))) short bf16x8;
typedef __attribute__((ext_vector_type(4))) short s16x4;
typedef __attribute__((ext_vector_type(4))) float f32x4;
typedef __attribute__((ext_vector_type(16))) float f32x16;
typedef __attribute__((ext_vector_type(4))) unsigned u32x4;
typedef __attribute__((ext_vector_type(2))) unsigned u32x2;

#ifndef MEGA
#define MEGA 1
#endif
__device__ __forceinline__ int TID() { int t = threadIdx.x; asm volatile("" : "+v"(t)); return t; }
__device__ __forceinline__ int BID() { int t = blockIdx.x; asm volatile("" : "+s"(t)); return t; }
__device__ __forceinline__ int GDIM() { int t = gridDim.x; asm volatile("" : "+s"(t)); return t; }

constexpr int SEQ = 8192, NBATCH = 4, T = NBATCH * SEQ, DMODEL = 1024, NL = 4, INW = 8776;
constexpr int NPA = 5888;
constexpr int NTHR = 512;
constexpr int LDS_BYTES = 131072;
constexpr float RMS_EPS = 1e-6f;

struct Params {
    const float *x_in, *norm_g, *w_in, *conv_w, *w_out_conv, *q_g, *k_g, *w_out_attn, *pool_w, *pool_scale, *w_out_pool, *w_o;
    float* x; char* ws;
    __device__ __forceinline__ u16* xb() const { return (u16*)(ws + 0ull); }
    __device__ __forceinline__ u16* ga() const { return (u16*)(ws + 67108864ull); }
    __device__ __forceinline__ u16* q() const { return (u16*)(ws + 100663296ull); }
    __device__ __forceinline__ u16* k() const { return (u16*)(ws + 134217728ull); }
    __device__ __forceinline__ u16* v() const { return (u16*)(ws + 167772160ull); }
    __device__ __forceinline__ u16* sg() const { return (u16*)(ws + 201326592ull); }
    __device__ __forceinline__ u16* iq() const { return (u16*)(ws + 234881024ull); }
    __device__ __forceinline__ u16* sp() const { return (u16*)(ws + 268435456ull); }
    __device__ __forceinline__ u16* z() const { return (u16*)(ws + 301989888ull); }
    __device__ __forceinline__ u16* u() const { return (u16*)(ws + 335544320ull); }
    __device__ __forceinline__ u16* zuspare() const { return (u16*)(ws + 369098752ull); }
    __device__ __forceinline__ u16* ik() const { return (u16*)(ws + 371195904ull); }
    __device__ __forceinline__ float* iw() const { return (float*)(ws + 375390208ull); }
    __device__ __forceinline__ u16* wt_in() const { return (u16*)(ws + 376438784ull); }
    __device__ __forceinline__ u16* wt_mg() const { return (u16*)(ws + 424673280ull); }
    __device__ __forceinline__ u16* wt_oa() const { return (u16*)(ws + 449839104ull); }
    __device__ __forceinline__ u16* wt_ob() const { return (u16*)(ws + 454033408ull); }
    __device__ __forceinline__ u16* wt_oc() const { return (u16*)(ws + 458227712ull); }
    __device__ __forceinline__ u16* wt_o() const { return (u16*)(ws + 462422016ull); }
    __device__ __forceinline__ float* ropec() const { return (float*)(ws + 470810624ull); }
    __device__ __forceinline__ float* ropes() const { return (float*)(ws + 471859200ull); }
    __device__ __forceinline__ float* sumsq() const { return (float*)(ws + 472907776ull); }
    __device__ __forceinline__ u64* mask() const { return (u64*)(ws + 477102080ull); }
    __device__ __forceinline__ u16* scores() const { return (u16*)(ws + 494403584ull); }
    __device__ __forceinline__ u16* scores2() const { return z(); }
    __device__ __forceinline__ u16* stash() const { return scores(); }
    __device__ __forceinline__ u16* merged() const { return q(); }
    __device__ __forceinline__ u16* bin() const { return iq(); }
};
constexpr size_t WS_BAR = 563609600ull;
constexpr size_t WS_NEEDED = WS_BAR + 16384;


__device__ __forceinline__ unsigned cvtpk(float lo, float hi) { unsigned r; asm("v_cvt_pk_bf16_f32 %0, %1, %2" : "=v"(r) : "v"(lo), "v"(hi)); return r; }
__device__ __forceinline__ u16 f2bf(float f) { return (u16)(cvtpk(f, 0.f) & 0xffffu); }
__device__ __forceinline__ float bf2f(u16 b) { return __uint_as_float(((unsigned)b) << 16); }
__device__ __forceinline__ float bflo(unsigned w) { return __uint_as_float(w << 16); }
__device__ __forceinline__ float bfhi(unsigned w) { return __uint_as_float(w & 0xffff0000u); }
__device__ __forceinline__ float siluf(float x) { return x * __builtin_amdgcn_rcpf(1.f + __builtin_amdgcn_exp2f(x * -1.4426950408889634f)); }
__device__ __forceinline__ float sigmf(float x) { return __builtin_amdgcn_rcpf(1.f + __builtin_amdgcn_exp2f(x * -1.4426950408889634f)); }

__device__ __forceinline__ float row_rstd(const float* ssp, int row) {
    const f32x4* q = (const f32x4*)(ssp + (size_t)row * 16);
    const f32x4 a = q[0], b = q[1], c = q[2], d = q[3];
    const float s = ((a[0] + a[1]) + (a[2] + a[3])) + ((b[0] + b[1]) + (b[2] + b[3])) + ((c[0] + c[1]) + (c[2] + c[3])) + ((d[0] + d[1]) + (d[2] + d[3]));
    return __builtin_amdgcn_rsqf(s * (1.f / 1024.f) + RMS_EPS);
}
__device__ __forceinline__ int lc_of_tc(int tc) { int bj = tc >> 7, wc = (tc >> 5) & 3, n = (tc >> 4) & 1, fq = (tc >> 2) & 3, j = tc & 3; return ((wc * 4 + fq) << 4) + bj * 8 + n * 4 + j; }
__device__ __forceinline__ int tc_of_lc(int lc) { int cl = lc >> 4, s = lc & 15, wc = cl >> 2, fq = cl & 3, bj = s >> 3, n = (s >> 2) & 1, j = s & 3; return bj * 128 + wc * 32 + n * 16 + fq * 4 + j; }

__device__ __forceinline__ int src_col_in(int np) {
    int pn = np >> 8, tc = np & 255;
    int bj = tc >> 7, wc = (tc >> 5) & 3, n = (tc >> 4) & 1, fq = (tc >> 2) & 3, j = tc & 3, cl = wc * 4 + fq, s = bj * 8 + n * 4 + j, lc = cl * 16 + s;
    int d = (s < 8) ? (8 * fq + s) : (8 * fq + 32 + (s - 8));
    if (pn < 8) return (s & 3) * 512 + pn * 64 + cl * 4 + (s >> 2);
    if (pn < 12) { int which = (pn - 8) >> 1, head = ((pn - 8) & 1) * 4 + wc; return 2048 + which * 512 + head * 64 + d; }
    if (pn < 14) return 3072 + (pn - 12) * 256 + lc;
    if (pn < 16) return 3584 + (pn - 14) * 256 + lc;
    if (pn < 18) { int head = (pn - 16) * 4 + wc; return 4096 + head * 64 + d; }
    if (pn == 18) { if (wc == 0) return 4608 + d; if (wc == 1 && fq == 0 && s < 8) return 4672 + s; return -1; }
    if (pn < 21) return -2;
    return 5192 + (pn - 21) * 256 + lc;
}

__device__ __forceinline__ void prep_x(const Params& p) {
    const int tid_ = TID(); const int lane = tid_ & 63, gw = BID() * (NTHR / 64) + (tid_ >> 6), nw = GDIM() * (NTHR / 64);
    for (int row0 = gw * 4; row0 < T; row0 += nw * 4) {
        float4 v[4][4];
#pragma unroll
        for (int r = 0; r < 4; ++r)
#pragma unroll
            for (int i = 0; i < 4; ++i) v[r][i] = ((const float4*)(p.x_in + (size_t)(row0 + r) * DMODEL))[i * 64 + lane];
        float ss[4];
#pragma unroll
        for (int r = 0; r < 4; ++r) { ss[r] = 0.f;
#pragma unroll
            for (int i = 0; i < 4; ++i) { const float4 q = v[r][i]; ss[r] += q.x * q.x + q.y * q.y + q.z * q.z + q.w * q.w;
                u32x2 o; o[0] = cvtpk(q.x, q.y); o[1] = cvtpk(q.z, q.w);
                *(u32x2*)(p.xb() + (size_t)(row0 + r) * DMODEL + (i * 64 + lane) * 4) = o; } }
#pragma unroll
        for (int m = 32; m >= 1; m >>= 1) {
#pragma unroll
            for (int r = 0; r < 4; ++r) ss[r] += __shfl_xor(ss[r], m); }
        if (lane < 16) {
#pragma unroll
            for (int r = 0; r < 4; ++r) p.sumsq()[(size_t)(row0 + r) * 16 + lane] = (lane == 0) ? ss[r] : 0.f; }
    }
}
__device__ __forceinline__ void prep_rope(const Params& p) {
    const int i0 = BID() * NTHR + TID(), istep = GDIM() * NTHR;
    for (int i = i0; i < SEQ * 32; i += istep) {
        int pos = i >> 5, j = i & 31;
        float inv = 1.0f / powf(10000.0f, (float)(2 * j) / 64.0f);
        float ang = (float)pos * inv;
        p.ropec()[i] = cosf(ang); p.ropes()[i] = sinf(ang);
    }
}
__device__ __forceinline__ void prep_wt(const float* src, int lds_, const float* scale, u16* dst, int K, int NP, int mode, float* tile) {
    const int tid_ = TID(); const int tx = tid_ & 63, ty = tid_ >> 6; const int bid_ = BID(), gdim_ = GDIM();
    const int ntn = NP / 64, ntk = K / 64;
    for (int t = bid_; t < ntn * ntk; t += gdim_) {
        const int n0 = (t / ntk) * 64, k0 = (t % ntk) * 64;
        int np = n0 + tx, col;
        if (mode == 0) col = src_col_in(np);
        else if (mode == 1) col = 5704 + (np & ~255) + lc_of_tc(np & 255);
        else col = (np & ~255) + lc_of_tc(np & 255);
        __syncthreads();
#pragma unroll
        for (int i = 0; i < 8; ++i) { int kk = ty + 8 * i; tile[kk * 65 + tx] = (col >= 0) ? src[(size_t)(k0 + kk) * lds_ + col] : 0.f; }
        __syncthreads();
        const float sc = scale ? scale[k0 + tx] : 1.f;
#pragma unroll
        for (int i = 0; i < 8; ++i) {
            int nn = ty + 8 * i; int npo = n0 + nn;
            bool skip = (mode == 0) && ((npo >> 8) == 19 || (npo >> 8) == 20);
            if (!skip) dst[(size_t)npo * K + k0 + tx] = f2bf(tile[tx * 65 + nn] * sc);
        }
    }
}
__device__ __forceinline__ void prep_fold(const float* win, const float* ng, const float* pw, u16* wt_in) {
    const int i0 = BID() * NTHR + TID(), istep = GDIM() * NTHR;
    for (int i = i0; i < 1024 * 512; i += istep) {
        int k = i >> 9, n = i & 511, g = n >> 7, d = n & 127;
        const float* wr = win + (size_t)k * INW + 4680 + g * 128;
        const float* pp = pw + (size_t)g * 128 * 128 + d;
        float acc = 0.f;
        for (int c = 0; c < 128; ++c) acc += wr[c] * pp[c * 128];
        int row = (19 + (n >> 8)) * 256 + tc_of_lc(n & 255);
        wt_in[(size_t)row * 1024 + k] = f2bf(acc * ng[k]);
    }
}
__device__ __forceinline__ void phase_prep0(const Params& p, char* shm) {
    prep_x(p); prep_rope(p);
    float* tile = (float*)shm;
    for (int l = 0; l < NL; ++l) {
        const float* ng = p.norm_g + l * 1024;
        const float* win = p.w_in + (size_t)l * 1024 * INW;
        prep_wt(win, INW, ng, p.wt_in() + (size_t)l * NPA * 1024, 1024, NPA, 0, tile);
        prep_wt(win, INW, ng, p.wt_mg() + (size_t)l * 3072 * 1024, 1024, 3072, 1, tile);
        prep_wt(p.w_out_conv + (size_t)l * 512 * 1024, 1024, nullptr, p.wt_oa() + (size_t)l * 1024 * 512, 512, 1024, 2, tile);
        prep_wt(p.w_out_attn + (size_t)l * 512 * 1024, 1024, nullptr, p.wt_ob() + (size_t)l * 1024 * 512, 512, 1024, 2, tile);
        prep_wt(p.w_out_pool + (size_t)l * 512 * 1024, 1024, nullptr, p.wt_oc() + (size_t)l * 1024 * 512, 512, 1024, 2, tile);
        prep_wt(p.w_o + (size_t)l * 1024 * 1024, 1024, nullptr, p.wt_o() + (size_t)l * 1024 * 1024, 1024, 1024, 3, tile);
        prep_fold(win, ng, p.pool_w + (size_t)l * 4 * 128 * 128, p.wt_in() + (size_t)l * NPA * 1024);
    }
}

namespace pg8 {
#define PG8_LAS __attribute__((address_space(3)))
typedef unsigned short bf16_t;
constexpr int BM = 256, BK = 64, HALF = 128, HTB = HALF * BK * 2, STAGE_BYTES = 8 * HTB;
__device__ __forceinline__ int lds_byte(int r, int c) { const int st = (r >> 4) * 2 + (c >> 5), rr = r & 15, cc = c & 31, ob = rr * 64 + cc * 2; return st * 1024 + (ob ^ (((ob >> 9) & 1) << 5)); }
__device__ __forceinline__ void stage_rc(int b, int& R, int& C) { const int st = b / 1024, sb = b % 1024, swz = sb ^ (((sb >> 9) & 1) << 5); R = (st >> 1) * 16 + swz / 64; C = (st & 1) * 32 + (swz % 64) / 2; }
struct Unit { int pm, pn; };
struct Gemm { const bf16_t* A; const bf16_t* Bt; int M, N, K; };
constexpr int NXCD = 8, WGM = 8;
struct StaticOrder {
    int nM, nN, nwg, G, c;
    __device__ void init(int M, int N, int G_, int c_) { nM = M / BM; nN = N / BM; nwg = nM * nN; G = G_; c = c_; }
    __device__ bool next(int i, Unit& u) const {
        const long L = (long)i * G + c; if (L >= nwg) return false;
        int wgid = (int)L; { const int q = nwg / NXCD, r = nwg % NXCD, xcd = wgid % NXCD, off = wgid / NXCD; wgid = (xcd < r ? xcd * (q + 1) : r * (q + 1) + (xcd - r) * q) + off; }
        const int nig = WGM * nN, gid = wgid / nig, fm = gid * WGM, gsz = (nM - fm) < WGM ? (nM - fm) : WGM;
        u.pm = fm + ((wgid % nig) % gsz); u.pn = (wgid % nig) / gsz; return true;
    }
};
struct RowOrder {
    int nN, ntile, G, c;
    __device__ bool next(int i, Unit& u) const {
        const int x = c & 7, lt = (c >> 3) + (G >> 3) * i;
        const int quad = lt >> 2, pm = quad * 8 + x;
        if (pm * 4 >= ntile) return false;
        u.pm = pm; u.pn = lt & 3; return true; }
};
template <class Epi, class Sched>
__device__ __forceinline__ void gemm_phase(PG8_LAS unsigned char* lds, const Gemm g, const Sched& S, const Epi& E) {
    const int tid = TID(), wid = __builtin_amdgcn_readfirstlane(tid >> 6), lane = tid & 63, wr = wid >> 2, wc = wid & 3, fr = lane & 15, fq = lane >> 4;
    const int K = g.K, nt = K / BK;
    unsigned voffA[2], voffB[2];
#pragma unroll
    for (int i = 0; i < 2; ++i) { int R, C; stage_rc(tid * 16 + i * 8192, R, C); voffA[i] = (unsigned)(R * K + C) * 2u; voffB[i] = voffA[i]; }
    const size_t kstep = (size_t)(BK * 2);
    const size_t hstep = (size_t)HALF * K * 2;
    const size_t tstep = 2 * hstep;
    const unsigned ldsw = (unsigned)wid * 1024u;
    const int aoff = lds_byte(wr * 64 + fr, fq * 8), boff = lds_byte(wc * 32 + fr, fq * 8);
#define PG8_SA(b, h) (((b) * 2 + (h)) * HTB)
#define PG8_SB(b, h) ((4 + (b) * 2 + (h)) * HTB)
#define PG8_STAGE(bufoff, gbase, voff) do { _Pragma("unroll") for (int _i = 0; _i < 2; ++_i) \
        __builtin_amdgcn_global_load_lds((const unsigned*)((const char*)(gbase) + (voff)[_i]), (PG8_LAS unsigned*)(lds + (bufoff) + ldsw + _i * 8192), 16, 0, 0); } while (0)
#define PG8_LDA(dst, b, h) do { _Pragma("unroll") for (int m = 0; m < 4; ++m) _Pragma("unroll") for (int k = 0; k < 2; ++k) dst[m][k] = *(const PG8_LAS bf16x8*)(lds + PG8_SA(b, h) + aoff + m * 2048 + k * 1024); } while (0)
#define PG8_LDB(dst, b, h) do { _Pragma("unroll") for (int n = 0; n < 2; ++n) _Pragma("unroll") for (int k = 0; k < 2; ++k) dst[n][k] = *(const PG8_LAS bf16x8*)(lds + PG8_SB(b, h) + boff + n * 2048 + k * 1024); } while (0)
#define PG8_MMA(ai, bj, At, Bt) do { __builtin_amdgcn_s_setprio(1); _Pragma("unroll") for (int m = 0; m < 4; ++m) _Pragma("unroll") for (int n = 0; n < 2; ++n) _Pragma("unroll") for (int k = 0; k < 2; ++k) \
        acc[ai][bj][m][n] = __builtin_amdgcn_mfma_f32_16x16x32_bf16(Bt[n][k], At[m][k], acc[ai][bj][m][n], 0, 0, 0); __builtin_amdgcn_s_setprio(0); } while (0)
#define PG8_WAIT_V(n) asm volatile("s_waitcnt vmcnt(" #n ")" ::: "memory")
#define PG8_WAIT_L(n) asm volatile("s_waitcnt lgkmcnt(" #n ")" ::: "memory")
#define PG8_BAR __builtin_amdgcn_s_barrier()
#define PG8_SCHED __builtin_amdgcn_sched_barrier(0)
    Unit cur, nxt; int ui = 0;
    if (!S.next(0, cur)) return;
    f32x4 acc[2][2][4][2];
#pragma unroll
    for (int a = 0; a < 2; ++a)
#pragma unroll
        for (int b = 0; b < 2; ++b)
#pragma unroll
            for (int m = 0; m < 4; ++m)
#pragma unroll
                for (int n = 0; n < 2; ++n) acc[a][b][m][n] = (f32x4){0.f, 0.f, 0.f, 0.f};
    bf16x8 At[4][2], B0[2][2], B1[2][2];
    const char* cA = (const char*)g.A + (size_t)cur.pm * tstep; const char* cB = (const char*)g.Bt + (size_t)cur.pn * tstep;
    PG8_STAGE(PG8_SB(0, 0), cB, voffB); PG8_STAGE(PG8_SA(0, 0), cA, voffA); PG8_STAGE(PG8_SB(0, 1), cB + hstep, voffB); PG8_STAGE(PG8_SA(0, 1), cA + hstep, voffA);
    if (wr == 1) PG8_BAR;
    PG8_WAIT_V(4); PG8_BAR;
    PG8_STAGE(PG8_SB(1, 0), cB + kstep, voffB); PG8_STAGE(PG8_SA(1, 0), cA + kstep, voffA); PG8_STAGE(PG8_SB(1, 1), cB + hstep + kstep, voffB);
    PG8_WAIT_V(6); PG8_BAR;
    for (;;) {
        const bool has_next = S.next(ui + 1, nxt);
        const char* nA = has_next ? (const char*)g.A + (size_t)nxt.pm * tstep : cA; const char* nB = has_next ? (const char*)g.Bt + (size_t)nxt.pn * tstep : cB;
        for (int t = 0; t < nt; t += 2) {
            const bool last = (t == nt - 2);
            const char* a1 = cA + (size_t)(t + 1) * kstep;
            const char* a2 = last ? nA : cA + (size_t)(t + 2) * kstep; const char* b2 = last ? nB : cB + (size_t)(t + 2) * kstep;
            const char* a3 = a2 + kstep; const char* b3 = b2 + kstep;
            PG8_LDB(B0, 0, 0); PG8_SCHED; PG8_LDA(At, 0, 0); PG8_STAGE(PG8_SA(1, 1), a1 + hstep, voffA);
            PG8_WAIT_L(8); PG8_BAR; PG8_WAIT_L(0); PG8_MMA(0, 0, At, B0); PG8_BAR; PG8_SCHED;
            PG8_LDB(B1, 0, 1); PG8_STAGE(PG8_SB(0, 0), b2, voffB);
            PG8_BAR; PG8_WAIT_L(0); PG8_MMA(0, 1, At, B1); PG8_BAR;
            PG8_LDA(At, 0, 1); PG8_STAGE(PG8_SA(0, 0), a2, voffA);
            PG8_BAR; PG8_WAIT_L(0); PG8_MMA(1, 0, At, B0); PG8_BAR; PG8_SCHED;
            PG8_STAGE(PG8_SB(0, 1), b2 + hstep, voffB);
            PG8_WAIT_V(6); PG8_BAR; PG8_MMA(1, 1, At, B1); PG8_BAR;
            PG8_LDB(B0, 1, 0); PG8_SCHED; PG8_LDA(At, 1, 0); PG8_STAGE(PG8_SA(0, 1), a2 + hstep, voffA);
            PG8_WAIT_L(8); PG8_BAR; PG8_WAIT_L(0); PG8_MMA(0, 0, At, B0); PG8_BAR; PG8_SCHED;
            PG8_LDB(B1, 1, 1); PG8_STAGE(PG8_SB(1, 0), b3, voffB);
            PG8_BAR; PG8_WAIT_L(0); PG8_MMA(0, 1, At, B1); PG8_BAR;
            PG8_LDA(At, 1, 1); PG8_STAGE(PG8_SA(1, 0), a3, voffA);
            PG8_BAR; PG8_WAIT_L(0); PG8_MMA(1, 0, At, B0); PG8_BAR; PG8_SCHED;
            PG8_STAGE(PG8_SB(1, 1), b3 + hstep, voffB);
            PG8_WAIT_V(6); PG8_BAR; PG8_MMA(1, 1, At, B1); PG8_BAR;
        }
        E(acc, cur, ui, wr, wc, fr, fq);
#ifdef DUP_EPI
        if (Epi::DUPOK) E(acc, cur, ui, wr, wc, fr, fq);
#endif
        if (!has_next) break;
#pragma unroll
        for (int a = 0; a < 2; ++a)
#pragma unroll
            for (int b = 0; b < 2; ++b)
#pragma unroll
                for (int m = 0; m < 4; ++m)
#pragma unroll
                    for (int n = 0; n < 2; ++n) acc[a][b][m][n] = (f32x4){0.f, 0.f, 0.f, 0.f};
        cur = nxt; cA = nA; cB = nB; ++ui;
    }
    PG8_WAIT_V(0);
    if (wr == 0) PG8_BAR;
    PG8_BAR;
#undef PG8_SA
#undef PG8_SB
#undef PG8_STAGE
#undef PG8_LDA
#undef PG8_LDB
#undef PG8_MMA
#undef PG8_WAIT_V
#undef PG8_WAIT_L
#undef PG8_BAR
#undef PG8_SCHED
}
}
typedef f32x4 acc_t[2][2][4][2];
#define ROWS_LOOP _Pragma("unroll") for (int ai = 0; ai < 2; ++ai) _Pragma("unroll") for (int m = 0; m < 4; ++m)
#define ROW_OF (u.pm * 256 + ai * 128 + wr * 64 + m * 16 + fr)

struct EpiIn {
    static constexpr bool DUPOK = true;
    const Params& p; int l;
    __device__ __forceinline__ void operator()(const acc_t& acc, const pg8::Unit& u, int ui, int wr, int wc, int fr, int fq) const {
        const float* ssq = p.sumsq() + (size_t)(l & 1) * T * 16;
        const int pn = u.pn, cl = wc * 4 + fq;
        __shared__ float s_rstd[256];
        { const int t_ = TID(); if (t_ < 256) s_rstd[t_] = row_rstd(ssq, u.pm * 256 + t_); __syncthreads(); }
        float rsa[8];
#pragma unroll
        for (int ix = 0; ix < 8; ++ix) rsa[ix] = s_rstd[(ix >> 2) * 128 + wr * 64 + (ix & 3) * 16 + fr];
        if (pn < 8) {
            ROWS_LOOP { const int row = ROW_OF; const float rs = rsa[ai * 4 + m];
                float zz[4], gg[4];
#pragma unroll
                for (int ch = 0; ch < 4; ++ch) { const f32x4 v = acc[ai][ch >> 1][m][ch & 1]; zz[ch] = (v[1] * rs) * (v[2] * rs); gg[ch] = (v[0] * rs) * siluf(v[3] * rs); }
                const size_t o = (size_t)row * 512 + pn * 64 + cl * 4;
                u32x2 a; a[0] = cvtpk(zz[0], zz[1]); a[1] = cvtpk(zz[2], zz[3]); *(u32x2*)(p.z() + o) = a;
                u32x2 b; b[0] = cvtpk(gg[0], gg[1]); b[1] = cvtpk(gg[2], gg[3]); *(u32x2*)(p.ga() + o) = b; }
        } else if (pn < 12 || (pn >= 16 && pn <= 18)) {
            if (pn == 18 && wc >= 1) {
                if (wc == 1 && fq == 0) {
                    ROWS_LOOP { const int row = ROW_OF; const float rs = rsa[ai * 4 + m] * 0.04419417382415922f;
                        *(f32x4*)(p.iw() + (size_t)row * 8) = acc[ai][0][m][0] * rs; *(f32x4*)(p.iw() + (size_t)row * 8 + 4) = acc[ai][0][m][1] * rs; }
                }
            } else {
                const bool isqk = pn < 12; const int which = (pn - 8) >> 1;
                int head; u16* dst; int pitch;
                if (isqk) { head = ((pn - 8) & 1) * 4 + wc; dst = which ? p.k() : p.q(); pitch = 512; }
                else if (pn < 18) { head = (pn - 16) * 4 + wc; dst = p.iq(); pitch = 512; }
                else { head = 0; dst = p.ik(); pitch = 64; }
                f32x4 g0[2], g1[2];
#pragma unroll
                for (int n = 0; n < 2; ++n) { g0[n] = (f32x4){1.f, 1.f, 1.f, 1.f}; g1[n] = g0[n]; }
                if (isqk) { const float* gg = (which ? p.k_g : p.q_g) + l * 64 + 8 * fq;
#pragma unroll
                    for (int n = 0; n < 2; ++n) { g0[n] = *(const f32x4*)(gg + 4 * n); g1[n] = *(const f32x4*)(gg + 32 + 4 * n); } }
                f32x4 rcb[2], rsb[2];
                { const int pos0 = (u.pm * 256 + wr * 64 + fr) & (SEQ - 1);
#pragma unroll
                  for (int n = 0; n < 2; ++n) { rcb[n] = *(const f32x4*)(p.ropec() + pos0 * 32 + 8 * fq + 4 * n); rsb[n] = *(const f32x4*)(p.ropes() + pos0 * 32 + 8 * fq + 4 * n); } }
                ROWS_LOOP { const int row = ROW_OF; const int ix = ai * 4 + m; const float rs = rsa[ix];
                    f32x4 a0[2], a1[2];
#pragma unroll
                    for (int n = 0; n < 2; ++n) { a0[n] = acc[ai][0][m][n] * rs; a1[n] = acc[ai][1][m][n] * rs; }
                    if (isqk) { float ss = 0.f;
#pragma unroll
                        for (int n = 0; n < 2; ++n)
#pragma unroll
                            for (int j = 0; j < 4; ++j) ss += a0[n][j] * a0[n][j] + a1[n][j] * a1[n][j];
                        ss += __shfl_xor(ss, 16); ss += __shfl_xor(ss, 32);
                        const float rn = __builtin_amdgcn_rsqf(ss * (1.f / 64.f) + RMS_EPS);
#pragma unroll
                        for (int n = 0; n < 2; ++n) { a0[n] = a0[n] * rn * g0[n]; a1[n] = a1[n] * rn * g1[n]; } }
                    u32x4 o0, o1;
#pragma unroll
                    for (int n = 0; n < 2; ++n) { const f32x4 cc = rcb[n], sn = rsb[n];
                        const f32x4 r0 = a0[n] * cc - a1[n] * sn, r1 = a1[n] * cc + a0[n] * sn;
                        o0[2 * n] = cvtpk(r0[0], r0[1]); o0[2 * n + 1] = cvtpk(r0[2], r0[3]); o1[2 * n] = cvtpk(r1[0], r1[1]); o1[2 * n + 1] = cvtpk(r1[2], r1[3]); }
                    if (ix < 7) { const int posn = (u.pm * 256 + ((ix + 1) >> 2) * 128 + wr * 64 + ((ix + 1) & 3) * 16 + fr) & (SEQ - 1);
#pragma unroll
                        for (int n = 0; n < 2; ++n) { rcb[n] = *(const f32x4*)(p.ropec() + posn * 32 + 8 * fq + 4 * n); rsb[n] = *(const f32x4*)(p.ropes() + posn * 32 + 8 * fq + 4 * n); } }
                    u16* d = dst + (size_t)row * pitch + head * 64 + 8 * fq;
                    *(u32x4*)d = o0; *(u32x4*)(d + 32) = o1; }
            }
        } else {
            u16* dst; int cb; int kind;
            if (pn < 14) { dst = p.v(); cb = (pn - 12) * 256; kind = 0; }
            else if (pn < 16) { dst = p.sg(); cb = (pn - 14) * 256; kind = 1; }
            else if (pn < 21) { dst = p.u(); cb = (pn - 19) * 256; kind = 0; }
            else { dst = p.sp(); cb = (pn - 21) * 256; kind = 2; }
            f32x4 sc[2][2];
#pragma unroll
            for (int bj = 0; bj < 2; ++bj)
#pragma unroll
                for (int n = 0; n < 2; ++n) sc[bj][n] = (kind == 2) ? *(const f32x4*)(p.pool_scale + l * 512 + cb + 16 * cl + bj * 8 + n * 4) : (f32x4){1.f, 1.f, 1.f, 1.f};
            ROWS_LOOP { const int row = ROW_OF; const float rs = rsa[ai * 4 + m];
#pragma unroll
                for (int bj = 0; bj < 2; ++bj) { f32x4 v0 = acc[ai][bj][m][0] * rs, v1 = acc[ai][bj][m][1] * rs;
                    if (kind >= 1) {
#pragma unroll
                        for (int j = 0; j < 4; ++j) { v0[j] = siluf(v0[j]) * sc[bj][0][j]; v1[j] = siluf(v1[j]) * sc[bj][1][j]; } }
                    u32x4 w; w[0] = cvtpk(v0[0], v0[1]); w[1] = cvtpk(v0[2], v0[3]); w[2] = cvtpk(v1[0], v1[1]); w[3] = cvtpk(v1[2], v1[3]);
                    *(u32x4*)(dst + (size_t)row * 512 + cb + 16 * cl + bj * 8) = w; } }
        }
    }
};
__device__ __forceinline__ void phase_in(const Params& p, int l, char* shm) {
    pg8::Gemm g{p.xb(), p.wt_in() + (size_t)l * NPA * 1024, T, NPA, 1024};
    pg8::StaticOrder S; S.init(T, NPA, GDIM(), BID());
    EpiIn E{p, l};
    pg8::gemm_phase((PG8_LAS unsigned char*)shm, g, S, E);
}
__device__ __forceinline__ void phase_mix(const Params& p, int l) {
    const float* cw = p.conv_w + l * 3 * 512;
    constexpr int RUN = 16;
    const int nitem = (T / RUN) * 256;
    const int it0 = BID() * NTHR + TID(), itstep = GDIM() * NTHR;
    for (int it = it0; it < nitem; it += itstep) {
        const int cp = it & 255, c = cp * 2, t0 = (it >> 8) * RUN, pos0 = t0 & (SEQ - 1);
        {
            const float w00 = cw[c], w01 = cw[c + 1], w10 = cw[512 + c], w11 = cw[513 + c], w20 = cw[1024 + c], w21 = cw[1025 + c];
            unsigned zr[RUN + 2], gr[RUN];
#pragma unroll
            for (int i = 0; i < RUN + 2; ++i) zr[i] = (pos0 + i - 2 >= 0) ? *(const unsigned*)(p.z() + (size_t)(t0 + i - 2) * 512 + c) : 0u;
#pragma unroll
            for (int i = 0; i < RUN; ++i) gr[i] = *(const unsigned*)(p.ga() + (size_t)(t0 + i) * 512 + c);
#pragma unroll
            for (int i = 0; i < RUN; ++i) {
                const float y0 = (w00 * bflo(zr[i]) + w10 * bflo(zr[i + 1]) + w20 * bflo(zr[i + 2])) * bflo(gr[i]);
                const float y1 = (w01 * bfhi(zr[i]) + w11 * bfhi(zr[i + 1]) + w21 * bfhi(zr[i + 2])) * bfhi(gr[i]);
                *(unsigned*)(p.ga() + (size_t)(t0 + i) * 512 + c) = cvtpk(y0, y1);
            }
        }
        {
            const int win = 2 << (c >> 7);
            unsigned ur[RUN + 15], gr[RUN];
#pragma unroll
            for (int i = 0; i < RUN + 15; ++i) ur[i] = (i >= 16 - win && pos0 + i - 15 >= 0) ? *(const unsigned*)(p.u() + (size_t)(t0 + i - 15) * 512 + c) : 0u;
#pragma unroll
            for (int i = 0; i < RUN; ++i) gr[i] = *(const unsigned*)(p.sp() + (size_t)(t0 + i) * 512 + c);
            float s0 = 0.f, s1 = 0.f;
#pragma unroll
            for (int i = 0; i < 15; ++i) { s0 += bflo(ur[i]); s1 += bfhi(ur[i]); }
#pragma unroll
            for (int i = 0; i < RUN; ++i) {
                const int pos = pos0 + i;
                const float u0 = bflo(ur[i + 15]), u1 = bfhi(ur[i + 15]);
                s0 += u0; s1 += u1;
                const float ic = __builtin_amdgcn_rcpf((float)min(pos + 1, win));
                *(unsigned*)(p.sp() + (size_t)(t0 + i) * 512 + c) = cvtpk((s0 * ic - u0) * bflo(gr[i]), (s1 * ic - u1) * bfhi(gr[i]));
                unsigned wo = 0u;
#pragma unroll
                for (int g = 0; g < 4; ++g) if (win == (2 << g)) wo = ur[i + 15 - ((2 << g) - 1)];
                s0 -= bflo(wo); s1 -= bfhi(wo);
            }
        }
    }
}

__device__ __forceinline__ int crow(int r, int hi) { return (r & 3) + 8 * (r >> 2) + 4 * hi; }
__device__ __forceinline__ size_t sc_base(int qb) { return (size_t)32768 * qb * (qb + 1); }
__device__ __forceinline__ void phase_indexer(const Params& p, int b, u16* scbuf, char* shm) {
    const int tid_ = TID(); const int wid = tid_ >> 6, lane = tid_ & 63, ql = lane & 15, fq = lane >> 4; const int bid_ = BID(), gdim_ = GDIM();
    constexpr int NSTEP = 64 * 65;
    const int f0 = (int)(((long)bid_ * NSTEP) / gdim_), f1 = (int)(((long)(bid_ + 1) * NSTEP) / gdim_);
    int qcur = -1;
    bf16x8 bq[8][2]; float wv[8]; u16* srow = nullptr; int qloc = 0;
    char* tl = shm + 40960 + wid * 2304;
#pragma unroll
    for (int h = 0; h < 8; ++h) { wv[h] = 0.f; bq[h][0] = bq[h][1] = (bf16x8){0, 0, 0, 0, 0, 0, 0, 0}; }
    const u16* ikb = p.ik() + ((size_t)b * SEQ + ql) * 64 + fq * 8;
    for (int f = f0; f < f1; ++f) {
        int q = (int)((sqrtf(4.f * f + 1.f) - 1.f) * 0.5f);
        while ((q + 1) * (q + 2) <= f) ++q;
        while (q * (q + 1) > f) --q;
        const int tt = f - q * (q + 1);
        if (q != qcur) {
            qcur = q; qloc = q * 128 + wid * 16 + ql;
            const size_t row = (size_t)b * SEQ + qloc;
#pragma unroll
            for (int h = 0; h < 8; ++h)
#pragma unroll
                for (int kc = 0; kc < 2; ++kc) bq[h][kc] = *(const bf16x8*)(p.iq() + row * 512 + h * 64 + kc * 32 + fq * 8);
            const f32x4 x = *(const f32x4*)(p.iw() + row * 8), y = *(const f32x4*)(p.iw() + row * 8 + 4);
            wv[0] = x[0]; wv[1] = x[1]; wv[2] = x[2]; wv[3] = x[3]; wv[4] = y[0]; wv[5] = y[1]; wv[6] = y[2]; wv[7] = y[3];
            const int a = q >> 1;
            srow = scbuf + sc_base(a) + (size_t)(q * 128 + wid * 16 + (lane >> 2) - a * 256) * (256 * (a + 1)) + (lane & 3) * 16;
        }
        const int key0 = tt * 64;
        bf16x8 ka[4][2];
#pragma unroll
        for (int kg = 0; kg < 4; ++kg)
#pragma unroll
            for (int kc = 0; kc < 2; ++kc) ka[kg][kc] = *(const bf16x8*)(ikb + (size_t)(key0 + kg * 16) * 64 + kc * 32);
        const bool band = (key0 + 63 > q * 128 + wid * 16);
#pragma unroll
        for (int kg = 0; kg < 4; ++kg) {
            f32x4 sacc = (f32x4){0.f, 0.f, 0.f, 0.f};
#pragma unroll
            for (int h = 0; h < 8; ++h) {
                f32x4 c = (f32x4){0.f, 0.f, 0.f, 0.f};
                c = __builtin_amdgcn_mfma_f32_16x16x32_bf16(ka[kg][0], bq[h][0], c, 0, 0, 0);
                c = __builtin_amdgcn_mfma_f32_16x16x32_bf16(ka[kg][1], bq[h][1], c, 0, 0, 0);
#pragma unroll
                for (int j = 0; j < 4; ++j) sacc[j] = __builtin_fmaf(wv[h], __builtin_fmaxf(c[j], 0.f), sacc[j]);
            }
            const int kb = key0 + kg * 16 + fq * 4;
            if (band) {
#pragma unroll
                for (int j = 0; j < 4; ++j) if (kb + j > qloc) sacc[j] = -INFINITY;
            }
            union { _Float16 h[4]; u32x2 v; } pk;
            pk.h[0] = (_Float16)sacc[0]; pk.h[1] = (_Float16)sacc[1]; pk.h[2] = (_Float16)sacc[2]; pk.h[3] = (_Float16)sacc[3];
            *(u32x2*)(tl + ql * 144 + kg * 32 + fq * 8) = pk.v;
        }
        { const u32x4 r0 = *(const u32x4*)(tl + (lane >> 2) * 144 + (lane & 3) * 32), r1 = *(const u32x4*)(tl + (lane >> 2) * 144 + (lane & 3) * 32 + 16);
          *(u32x4*)(srow + key0) = r0; *(u32x4*)(srow + key0 + 8) = r1; }
    }
}

__device__ __forceinline__ size_t mk_base(int qb) { return (size_t)512 * qb * (qb + 1); }
constexpr size_t MASK_WORDS_PER_BATCH = 540672;
__device__ __forceinline__ unsigned f16key(unsigned h) { return (h & 0x8000u) ? (~h & 0xffffu) : (h | 0x8000u); }
__device__ __forceinline__ void hist_scan(const unsigned* h, int lane, unsigned target, int& bin, unsigned& above, unsigned& inbin) {
    const u32x4 a = *(const u32x4*)(h + 4 * lane), b = *(const u32x4*)(h + 256 + 4 * lane), c = *(const u32x4*)(h + 512 + 4 * lane), d = *(const u32x4*)(h + 768 + 4 * lane);
    const unsigned h0 = a[0] + b[0] + c[0] + d[0], h1 = a[1] + b[1] + c[1] + d[1], h2 = a[2] + b[2] + c[2] + d[2], h3 = a[3] + b[3] + c[3] + d[3];
    const unsigned tot = h0 + h1 + h2 + h3;
#define DPP_SHL(v, n) ((unsigned)__builtin_amdgcn_update_dpp(0, (int)(v), 0x100 + (n), 0xf, 0xf, true))
    unsigned x = tot;
    x += DPP_SHL(x, 1); x += DPP_SHL(x, 2); x += DPP_SHL(x, 4); x += DPP_SHL(x, 8);
#undef DPP_SHL
    { const unsigned t1 = (unsigned)__builtin_amdgcn_readlane((int)x, 16), t2 = (unsigned)__builtin_amdgcn_readlane((int)x, 32), t3 = (unsigned)__builtin_amdgcn_readlane((int)x, 48);
      const int rowi = lane >> 4;
      x += (rowi == 0) ? (t1 + t2 + t3) : (rowi == 1) ? (t2 + t3) : (rowi == 2) ? t3 : 0u; }
    const unsigned ab = x - tot, c3 = ab + h3, c2 = c3 + h2, c1 = c2 + h1, c0 = c1 + h0;
    int fb = -1; unsigned fa = 0, fc = 0;
    if (ab < target && c3 >= target) { fb = 4 * lane + 3; fa = ab; fc = h3; }
    else if (c3 < target && c2 >= target) { fb = 4 * lane + 2; fa = c3; fc = h2; }
    else if (c2 < target && c1 >= target) { fb = 4 * lane + 1; fa = c2; fc = h1; }
    else if (c1 < target && c0 >= target) { fb = 4 * lane; fa = c1; fc = h0; }
    const u64 m = __ballot(fb >= 0); const int src = (m == 0) ? 0 : (__ffsll((unsigned long long)m) - 1);
    bin = __builtin_amdgcn_readlane(fb, src); above = (unsigned)__builtin_amdgcn_readlane((int)fa, src); inbin = (unsigned)__builtin_amdgcn_readlane((int)fc, src);
}
__device__ __forceinline__ unsigned f16key2(unsigned w) { const unsigned sg = (w >> 15) & 0x00010001u; return w ^ (((sg << 15) - sg) | 0x80008000u); }
__device__ __forceinline__ void phase_select(const Params& p, int b, char* shm, const u16* scbuf) {
    const int tid_ = TID(); const int wid = __builtin_amdgcn_readfirstlane(tid_ >> 6), lane = tid_ & 63;
    const int gw = BID() * 8 + wid, nw = GDIM() * 8;
    unsigned* hist = (unsigned*)shm + wid * 1152;
    const int hsubi = (lane >> 4) * 256, dummyi = 1024 + lane;
    typedef unsigned short us2 __attribute__((ext_vector_type(2)));
#define ROW_T(i_) ({ const int kq_ = (i_) / nw; ((mirror && (kq_ & 1)) ? (kq_ * nw + (nw - 1 - ((i_) - kq_ * nw))) : (i_)); })
#define ROW_LOAD(t_) do { const int qb_ = (t_) >> 8, ntr_ = 2 * (((t_) >> 7) + 1), nch_ = (ntr_ + 7) >> 3; \
        const u16* sr_ = scbuf + sc_base(qb_) + (size_t)((t_) - qb_ * 256) * (256 * (qb_ + 1)); \
        _Pragma("unroll") for (int c = 0; c < 16; ++c) { raw[c] = (u32x4){0u, 0u, 0u, 0u}; if (c < nch_) { if (lane < 8 * (ntr_ - 8 * c)) raw[c] = *(const u32x4*)(sr_ + 512 * c + 8 * lane); } } } while (0)
    const bool mirror = (SEQ % (2 * nw)) == 0;
    u32x4 raw[16];
    if (gw < SEQ) { const int t0_ = ROW_T(gw); ROW_LOAD(t0_); }
    for (int i = gw; i < SEQ; i += nw) {
        const int t = ROW_T(i);
        const int qb = t >> 8, ntile = 4 * (qb + 1), ntr = 2 * ((t >> 7) + 1);
        const int nch = (ntr + 7) >> 3, nchw = (ntile + 7) >> 3;
        unsigned char* mrow = (unsigned char*)(p.mask() + (size_t)b * MASK_WORDS_PER_BATCH + mk_base(qb) + (size_t)(t - qb * 256) * ntile);
        unsigned key[16][4];
#pragma unroll
        for (int c = 0; c < 16; ++c) {
            const bool valid = (c < nch) && (lane < 8 * (ntr - 8 * c));
#pragma unroll
            for (int r = 0; r < 4; ++r) key[c][r] = valid ? f16key2(raw[c][r]) : 0u;
        }
        if (i + nw < SEQ) { const int tn_ = ROW_T(i + nw); ROW_LOAD(tn_); }
        unsigned thrm1 = 0x03ffu, thr = 0x0400u; int need = 0; bool fast = true;
        if (t >= 256) {
            us2 a1 = (us2){0, 0}, a2 = (us2){0, 0};
#pragma unroll
            for (int c = 0; c < 16; ++c) {
                if (c < nch) {
#pragma unroll
                    for (int r = 0; r < 4; ++r) { const us2 kk = __builtin_bit_cast(us2, key[c][r]);
                        const us2 tmx = __builtin_elementwise_max(a1, kk), tmn = __builtin_elementwise_min(a1, kk); a1 = tmx; a2 = __builtin_elementwise_max(a2, tmn); }
                }
            }
            unsigned Lb = min((unsigned)a2[0], (unsigned)a2[1]);
#define DPP_ROR(v, n) ((unsigned)__builtin_amdgcn_update_dpp((int)(v), (int)(v), 0x120 + (n), 0xf, 0xf, false))
            Lb = min(Lb, DPP_ROR(Lb, 8)); Lb = min(Lb, DPP_ROR(Lb, 4)); Lb = min(Lb, DPP_ROR(Lb, 2)); Lb = min(Lb, DPP_ROR(Lb, 1));
#undef DPP_ROR
            Lb = min(min((unsigned)__builtin_amdgcn_readlane((int)Lb, 0), (unsigned)__builtin_amdgcn_readlane((int)Lb, 16)), min((unsigned)__builtin_amdgcn_readlane((int)Lb, 32), (unsigned)__builtin_amdgcn_readlane((int)Lb, 48)));
            const u32x4 z4 = (u32x4){0u, 0u, 0u, 0u};
#pragma unroll
            for (int c = 0; c < 4; ++c) *(u32x4*)(hist + c * 256 + 4 * lane) = z4;
#pragma unroll
            for (int c = 0; c < 16; ++c) {
                if (c < nch) {
#pragma unroll
                    for (int r = 0; r < 4; ++r) { const unsigned kk = key[c][r]; const unsigned lo = kk & 0xffffu, hi = kk >> 16;
                        atomicAdd(hist + ((lo >= Lb) ? (hsubi + (int)(lo >> 8)) : dummyi), 1u);
                        atomicAdd(hist + ((hi >= Lb) ? (hsubi + (int)(hi >> 8)) : dummyi), 1u); }
                }
            }
            asm volatile("s_waitcnt lgkmcnt(0)" ::: "memory");
            int B1; unsigned ab1, in1;
            hist_scan(hist, lane, 256u, B1, ab1, in1);
            asm volatile("s_waitcnt lgkmcnt(0)" ::: "memory");
#pragma unroll
            for (int c = 0; c < 4; ++c) *(u32x4*)(hist + c * 256 + 4 * lane) = z4;
#pragma unroll
            for (int c = 0; c < 16; ++c) {
                if (c < nch) {
#pragma unroll
                    for (int r = 0; r < 4; ++r) { const unsigned kk = key[c][r]; const unsigned lo = kk & 0xffffu, hi = kk >> 16;
                        const bool ml = ((lo >> 8) == (unsigned)B1) && (lo >= Lb), mh = ((hi >> 8) == (unsigned)B1) && (hi >= Lb);
                        if (__any(ml || mh)) { if (ml) atomicAdd(hist + hsubi + (int)(lo & 255u), 1u); if (mh) atomicAdd(hist + hsubi + (int)(hi & 255u), 1u); } }
                }
            }
            asm volatile("s_waitcnt lgkmcnt(0)" ::: "memory");
            int B2; unsigned ab2, in2;
            hist_scan(hist, lane, 256u - ab1, B2, ab2, in2);
            asm volatile("s_waitcnt lgkmcnt(0)" ::: "memory");
            thr = __builtin_amdgcn_readfirstlane(((unsigned)B1 << 8) | (unsigned)B2);
            need = __builtin_amdgcn_readfirstlane(256 - (int)(ab1 + ab2));
            const int neq = __builtin_amdgcn_readfirstlane((int)in2);
            fast = (need == neq);
            thrm1 = thr - 1u;
        }
        if (fast) {
#pragma unroll
            for (int c = 0; c < 16; ++c) {
                if (c < nchw) {
                    unsigned m = 0u;
#pragma unroll
                    for (int ii = 7; ii >= 0; --ii) { const unsigned kk = key[c][ii >> 1]; const unsigned kv = (ii & 1) ? (kk >> 16) : (kk & 0xffffu); m = m + m + ((kv > thrm1) ? 1u : 0u); }
                    if (64 * c + lane < 8 * ntile) mrow[64 * c + lane] = (unsigned char)m;
                }
            }
        } else {
#define DPP_SHR(v, n) ((unsigned)__builtin_amdgcn_update_dpp(0, (int)(v), 0x110 + (n), 0xf, 0xf, true))
            int base = 0;
#pragma unroll
            for (int c = 0; c < 16; ++c) {
                if (c < nchw) {
                    unsigned m = 0u, e = 0u;
#pragma unroll
                    for (int ii = 7; ii >= 0; --ii) { const unsigned kk = key[c][ii >> 1]; const unsigned kv = (ii & 1) ? (kk >> 16) : (kk & 0xffffu); m = m + m + ((kv > thr) ? 1u : 0u); e = e + e + ((kv == thr) ? 1u : 0u); }
                    if (__any(e != 0u)) {
                        const unsigned cnt = (unsigned)__builtin_popcount(e);
                        unsigned pre = cnt;
                        pre += DPP_SHR(pre, 1); pre += DPP_SHR(pre, 2); pre += DPP_SHR(pre, 4); pre += DPP_SHR(pre, 8);
                        const unsigned t0 = (unsigned)__builtin_amdgcn_readlane((int)pre, 15), t1 = (unsigned)__builtin_amdgcn_readlane((int)pre, 31), t2 = (unsigned)__builtin_amdgcn_readlane((int)pre, 47), t3 = (unsigned)__builtin_amdgcn_readlane((int)pre, 63);
                        const int rowi = lane >> 4;
                        pre += (rowi == 1) ? t0 : (rowi == 2) ? (t0 + t1) : (rowi == 3) ? (t0 + t1 + t2) : 0u;
                        int rank = base + (int)(pre - cnt);
#pragma unroll
                        for (int ii = 0; ii < 8; ++ii) if ((e >> ii) & 1u) { if (rank < need) m |= (1u << ii); ++rank; }
                        base += (int)(t0 + t1 + t2 + t3);
                    }
                    if (64 * c + lane < 8 * ntile) mrow[64 * c + lane] = (unsigned char)m;
                }
            }
#undef DPP_SHR
        }
    }
}

constexpr int A_D = 64, A_DM = 512, A_NW = 8, A_QBLK = 32, A_QB = 256, A_KVBLK = 64, A_NQB = SEQ / A_QB, A_NHEAD = 8;
constexpr float A_C2 = 0.125f * 1.4426950408889634f;
constexpr int A_SLOTB = 8192, A_LDS_K = 0, A_LDS_V = 3 * A_SLOTB, A_LDS_WS = 6 * A_SLOTB, A_LDS_OST = A_LDS_WS + A_NW * 256, A_LDS_MK = A_LDS_OST + A_NW * 4096, A_LDS_BYTES = A_LDS_MK + A_NW * 2048;
#define ATTN_THR 8
#define SBAR() __builtin_amdgcn_sched_barrier(0)
#define PIN(x) asm volatile("" : "+v"(x))
#define MFMA32(a, b, c) __builtin_amdgcn_mfma_f32_32x32x16_bf16(a, b, c, 0, 0, 0)
#define WAIT_BAR(N) asm volatile("s_waitcnt vmcnt(" #N ") lgkmcnt(0)\n\ts_barrier" ::: "memory")
__device__ __forceinline__ void glds16s(const void* sbase, unsigned voff, unsigned lds_base) {
    unsigned sv; asm volatile("s_mov_b32 %0, m0\n\ts_mov_b32 m0, %3\n\ts_nop 0\n\tglobal_load_lds_dwordx4 %1, %2\n\ts_mov_b32 m0, %0" : "=&s"(sv) : "v"(voff), "s"(sbase), "s"(lds_base) : "memory"); }
typedef __attribute__((address_space(3))) const char* lds_cptr;
typedef short v4i16_t __attribute__((ext_vector_type(4)));
__device__ __forceinline__ void kload2(bf16x8* kf, lds_cptr kp, int d0) { kf[2 * d0] = *(const __attribute__((address_space(3))) bf16x8*)(kp + d0 * 2048); kf[2 * d0 + 1] = *(const __attribute__((address_space(3))) bf16x8*)(kp + d0 * 2048 + 512); }
__device__ __forceinline__ s16x4 vtr(lds_cptr p) { return __builtin_bit_cast(s16x4, __builtin_amdgcn_ds_read_tr16_b64_v4i16((__attribute__((address_space(3))) v4i16_t*)p)); }
#define MX3(a, b, c) __builtin_fmaxf(__builtin_fmaxf((a), (b)), (c))
__device__ __forceinline__ float rowmax(const f32x16& p0, const f32x16& p1) {
    float a = MX3(p0[0], p0[1], p1[0]), b = MX3(p0[2], p0[3], p1[1]); a = MX3(a, p1[2], p1[3]);
#pragma unroll
    for (int r = 4; r < 16; r += 4) { a = MX3(a, p0[r], p0[r + 1]); b = MX3(b, p0[r + 2], p0[r + 3]); a = MX3(a, p1[r], p1[r + 1]); b = MX3(b, p1[r + 2], p1[r + 3]); }
    float m = __builtin_fmaxf(a, b); auto rr = __builtin_amdgcn_permlane32_swap(__float_as_uint(m), __float_as_uint(m), false, false);
    return __builtin_fmaxf(__uint_as_float(rr[0]), __uint_as_float(rr[1])); }
__device__ __forceinline__ void cmask(f32x16& p0, f32x16& p1, int jb, int qrel, int hi) {
    const int kb = 64 * jb + 4 * hi;
#pragma unroll
    for (int r = 0; r < 16; ++r) { const int kv = kb + (r & 3) + 8 * (r >> 2); if (kv > qrel) p0[r] = -INFINITY; if (kv + 32 > qrel) p1[r] = -INFINITY; } }
__device__ __forceinline__ float mand(float x, unsigned w, int pos) { return __uint_as_float(__float_as_uint(x) & (unsigned)__builtin_amdgcn_sbfe((int)w, pos, 1)); }
#define BITP(i) (((i) & 3) + 8 * ((i) >> 2))

__device__ __forceinline__ void attn64_unit(int b, int h, int qb, const u16* Q, const u16* __restrict__ K, const u16* __restrict__ V, const u16* __restrict__ SG, u16* O, const u64* mrow0, char* lds) {
    const int tid = TID(), lane = tid & 63, r32 = lane & 31, hi = lane >> 5; const int wid = __builtin_amdgcn_readfirstlane(tid >> 6);
    const long rowbase = (long)b * SEQ; const int q0 = qb * A_QB, NT = (q0 + A_QB) / A_KVBLK;
    const u16* Qw = Q + (rowbase + q0 + wid * A_QBLK) * A_DM + h * A_D;
    const unsigned lds0 = (unsigned)(uintptr_t)lds; float* wsf = (float*)(lds + A_LDS_WS) + wid * 64;
    const u16* kbase = K + rowbase * A_DM + h * A_D; const u16* vbase = V + rowbase * A_DM + h * A_D;
    const unsigned koff = (unsigned)(lane * A_DM + wid * 8) * 2u;
    const unsigned voff = (unsigned)((16 * (wid & 3) + (lane >> 2)) * A_DM + (wid >> 2) * 32 + (lane & 3) * 8) * 2u;
    const unsigned kdst = lds0 + A_LDS_K + wid * 1024, vdst = lds0 + A_LDS_V + wid * 1024;
#define DMA_K(t, slot) glds16s(kbase + (long)(t) * A_KVBLK * A_DM, koff, (unsigned)__builtin_amdgcn_readfirstlane(kdst + (slot)))
#define DMA_V(t, slot) glds16s(vbase + (long)(t) * A_KVBLK * A_DM, voff, (unsigned)__builtin_amdgcn_readfirstlane(vdst + (slot)))
#define DMA_M(chunk) glds16s(mrow0 + 2 * (chunk), moff, (unsigned)__builtin_amdgcn_readfirstlane(mdst + ((chunk) & 1) * 1024))
#define MWORD(t) (*(const u64*)(lds + A_LDS_MK + wid * 2048 + (((t) >> 1) & 1) * 1024 + r32 * 16 + ((t) & 1) * 8))
    const lds_cptr vp0 = (lds_cptr)lds + A_LDS_V + ((lane >> 4) & 1) * 32 + (lane & 3) * 8 + (4 * hi + ((lane & 15) >> 2)) * 64;
    const lds_cptr kp0 = (lds_cptr)lds + A_LDS_K + hi * 1024 + r32 * 16;
    const int qrel = wid * A_QBLK + r32;
    const unsigned moff = (unsigned)(qrel * NT) * 8u;
    const unsigned mdst = lds0 + A_LDS_MK + wid * 2048;
    DMA_M(0);
    DMA_K(0, 0); DMA_V(0, 0); DMA_K(1, A_SLOTB);
    bf16x8 qr[4];
#pragma unroll
    for (int d0 = 0; d0 < 4; ++d0) qr[d0] = *reinterpret_cast<const bf16x8*>(&Qw[(long)r32 * A_DM + d0 * 16 + hi * 8]);
    float mhat = 0.f, l_reg = 0.f; f32x16 o[2]; o[0] = f32x16{}; o[1] = f32x16{};
    const f32x16 zero16 = f32x16{};
    bool resc = false;
    f32x16 pA0, pA1, pB0, pB1; bf16x8 kf[8]; s16x4 vlo[8], vhi[8]; u32x4 pw0, pw1, pw2, pw3;
    typedef unsigned u32x16 __attribute__((ext_vector_type(16)));
    u32x16 mk0, mk1;
    int sl_prev = 0, sl_cur = 0, sl_next = A_SLOTB;
    const int sh4 = 4 * hi;
#define ROT() do { sl_prev = sl_cur; sl_cur = sl_next; sl_next = (sl_next == 2 * A_SLOTB) ? 0 : sl_next + A_SLOTB; } while (0)
#define EX(v) __builtin_amdgcn_exp2f(__builtin_fmaf((v), A_C2, nmh))
#define RESC() do { if (resc) { _Pragma("unroll") for (int d_ = 0; d_ < 2; ++d_) _Pragma("unroll") for (int r = 0; r < 16; ++r) o[d_][r] *= wsf[crow(r, hi)]; } } while (0)
    DMA_K(2, 2 * A_SLOTB);
    WAIT_BAR(3);
    _Pragma("unroll") for (int d0 = 0; d0 < 4; ++d0) kload2(kf, kp0, d0);
    pA0 = MFMA32(kf[0], qr[0], zero16); pA1 = MFMA32(kf[1], qr[0], zero16); pA0 = MFMA32(kf[2], qr[1], pA0); pA1 = MFMA32(kf[3], qr[1], pA1);
    pA0 = MFMA32(kf[4], qr[2], pA0); pA1 = MFMA32(kf[5], qr[2], pA1); pA0 = MFMA32(kf[6], qr[3], pA0); pA1 = MFMA32(kf[7], qr[3], pA1);
    { const float rm = rowmax(pA0, pA1); mhat = rm * A_C2; const float nmh = -mhat;
      const u64 mw0 = MWORD(0); const unsigned wl = (unsigned)mw0 >> sh4, wh = (unsigned)(mw0 >> 32) >> sh4;
#pragma unroll
      for (int r = 0; r < 16; ++r) { pA0[r] = mand(EX(pA0[r]), wl, BITP(r)); pA1[r] = mand(EX(pA1[r]), wh, BITP(r)); } }
    WAIT_BAR(0);
    DMA_K(3, 0); DMA_V(1, A_SLOTB); ROT();
    _Pragma("unroll") for (int d0 = 0; d0 < 4; ++d0) kload2(kf, kp0 + sl_cur, d0);
    WAIT_BAR(2);
#define PKW(P, i) cvtpk(P[i], P[i + 1])
#define PAF(k) __builtin_bit_cast(bf16x8, pw##k)
#define VFR(i) (bf16x8){vlo[i][0], vlo[i][1], vlo[i][2], vlo[i][3], vhi[i][0], vhi[i][1], vhi[i][2], vhi[i][3]}
#define VRD(i) do { vlo[i] = vtr(vp_ + (((i) >> 2) * 4096 + ((i) & 3) * 1024)); vhi[i] = vtr(vp_ + (((i) >> 2) * 4096 + ((i) & 3) * 1024 + 512)); } while (0)
#define KRD(G, d0) do { if (G) { kload2(kf, kp0 + sl_next, d0); SBAR(); } } while (0)
#define GAPA(MF, a0, a1, a2, a3, W0, W1, PW, MK, WW, i) do { MF; sacc += a0; sacc += a1; sacc += a2; sacc += a3; W0; W1; \
    MK[i] = (unsigned)__builtin_amdgcn_sbfe((int)(WW), BITP(i), 1); MK[i + 1] = (unsigned)__builtin_amdgcn_sbfe((int)(WW), BITP(i + 1), 1); MK[i + 2] = (unsigned)__builtin_amdgcn_sbfe((int)(WW), BITP(i + 2), 1); MK[i + 3] = (unsigned)__builtin_amdgcn_sbfe((int)(WW), BITP(i + 3), 1); \
    PIN(PW); PIN(sacc); PIN(MK); SBAR(); } while (0)
#define MAND(x, m) __uint_as_float(__float_as_uint(x) & (m))
#define GAPB(MF, X, i, MK) do { MF; X[i] = MAND(EX(X[i]), MK[i]); X[i + 1] = MAND(EX(X[i + 1]), MK[i + 1]); X[i + 2] = MAND(EX(X[i + 2]), MK[i + 2]); X[i + 3] = MAND(EX(X[i + 3]), MK[i + 3]); PIN(X); SBAR(); } while (0)
#define STEP(C0, C1, P0, P1, t, MASK, GK, GV, GL, ML) do { SBAR(); \
    if (ML) DMA_M(((t) + 1) >> 1); \
    const u64 mw_ = MWORD(t); const unsigned wl_ = (unsigned)(mw_) >> sh4, wh_ = (unsigned)((mw_) >> 32) >> sh4; \
    const lds_cptr vp_ = vp0 + sl_prev; \
    VRD(0); SBAR(); float sacc = P0[0] + P0[1]; \
                    GAPA(C0 = MFMA32(kf[0], qr[0], zero16), P0[2], P0[3], P0[4], P0[5],     pw0[0] = PKW(P0, 0),  pw0[1] = PKW(P0, 2),  pw0, mk0, wl_, 0); \
    VRD(4); SBAR(); GAPA(C1 = MFMA32(kf[1], qr[0], zero16), P0[6], P0[7], P0[8], P0[9],     pw0[2] = PKW(P0, 4),  pw0[3] = PKW(P0, 6),  pw0, mk0, wl_, 4); \
    VRD(1); SBAR(); GAPA(C0 = MFMA32(kf[2], qr[1], C0),    P0[10], P0[11], P0[12], P0[13], pw1[0] = PKW(P0, 8),  pw1[1] = PKW(P0, 10), pw1, mk0, wl_, 8); \
    VRD(5); SBAR(); GAPA(C1 = MFMA32(kf[3], qr[1], C1),    P0[14], P0[15], P1[0], P1[1],   pw1[2] = PKW(P0, 12), pw1[3] = PKW(P0, 14), pw1, mk0, wl_, 12); \
    VRD(2); SBAR(); GAPA(C0 = MFMA32(kf[4], qr[2], C0),    P1[2], P1[3], P1[4], P1[5],     pw2[0] = PKW(P1, 0),  pw2[1] = PKW(P1, 2),  pw2, mk1, wh_, 0); \
    VRD(6); SBAR(); GAPA(C1 = MFMA32(kf[5], qr[2], C1),    P1[6], P1[7], P1[8], P1[9],     pw2[2] = PKW(P1, 4),  pw2[3] = PKW(P1, 6),  pw2, mk1, wh_, 4); \
    VRD(3); SBAR(); GAPA(C0 = MFMA32(kf[6], qr[3], C0),    P1[10], P1[11], P1[12], P1[13], pw3[0] = PKW(P1, 8),  pw3[1] = PKW(P1, 10), pw3, mk1, wh_, 8); \
    VRD(7); SBAR(); GAPA(C1 = MFMA32(kf[7], qr[3], C1),    P1[14], P1[15], 0.f, 0.f,       pw3[2] = PKW(P1, 12), pw3[3] = PKW(P1, 14), pw3, mk1, wh_, 12); \
    l_reg += sacc; \
    if (GK) DMA_K((t) + 3, sl_cur); if (GV) DMA_V((t) + 1, sl_next); \
    { const float rm = __builtin_fmaf(rowmax(C0, C1), A_C2, -mhat); resc = false; \
      if (__builtin_expect(__any(rm > (float)ATTN_THR), 0)) { const float dl = __builtin_fmaxf(rm, 0.f); mhat += dl; \
          const float f = __builtin_amdgcn_exp2f(-dl); l_reg *= f; if (hi == 0) wsf[r32] = f; resc = true; } } \
    const float nmh = -mhat; SBAR(); \
    GAPB(o[0] = MFMA32(PAF(0), VFR(0), o[0]), C0, 0, mk0);              GAPB(o[1] = MFMA32(PAF(0), VFR(4), o[1]), C0, 4, mk0); \
    KRD(GL, 0); GAPB(o[0] = MFMA32(PAF(1), VFR(1), o[0]), C0, 8, mk0);  KRD(GL, 1); GAPB(o[1] = MFMA32(PAF(1), VFR(5), o[1]), C0, 12, mk0); \
    KRD(GL, 2); GAPB(o[0] = MFMA32(PAF(2), VFR(2), o[0]), C1, 0, mk1);  KRD(GL, 3); GAPB(o[1] = MFMA32(PAF(2), VFR(6), o[1]), C1, 4, mk1); \
    GAPB(o[0] = MFMA32(PAF(3), VFR(3), o[0]), C1, 8, mk1);              GAPB(o[1] = MFMA32(PAF(3), VFR(7), o[1]), C1, 12, mk1); \
    } while (0)
    int t = 1;
    for (; t + 5 < NT; t += 2) {
        STEP(pB0, pB1, pA0, pA1, t, false, true, true, true, true);      WAIT_BAR(2); RESC(); ROT();
        STEP(pA0, pA1, pB0, pB1, t + 1, false, true, true, true, false); WAIT_BAR(2); RESC(); ROT();
    }
#define ENDW(tt) do { if ((tt) + 3 < NT) { WAIT_BAR(2); } else if ((tt) + 2 < NT) { WAIT_BAR(1); } else { WAIT_BAR(0); } } while (0)
    for (; t + 1 < NT; t += 2) {
        STEP(pB0, pB1, pA0, pA1, t, true, (t + 3 < NT), (t + 1 < NT), (t + 1 < NT), (t + 1 < NT));         ENDW(t);     RESC(); ROT();
        STEP(pA0, pA1, pB0, pB1, t + 1, true, (t + 4 < NT), (t + 2 < NT), (t + 2 < NT), false);            ENDW(t + 1); RESC(); ROT();
    }
    STEP(pB0, pB1, pA0, pA1, NT - 1, true, false, false, false, false); RESC();
    { float sacc = pB0[0] + pB0[1];
#pragma unroll
      for (int r = 2; r < 16; ++r) sacc += pB0[r];
#pragma unroll
      for (int r = 0; r < 16; ++r) sacc += pB1[r];
      l_reg += sacc;
      pw0 = (u32x4){PKW(pB0, 0), PKW(pB0, 2), PKW(pB0, 4), PKW(pB0, 6)}; pw1 = (u32x4){PKW(pB0, 8), PKW(pB0, 10), PKW(pB0, 12), PKW(pB0, 14)};
      pw2 = (u32x4){PKW(pB1, 0), PKW(pB1, 2), PKW(pB1, 4), PKW(pB1, 6)}; pw3 = (u32x4){PKW(pB1, 8), PKW(pB1, 10), PKW(pB1, 12), PKW(pB1, 14)};
      const lds_cptr vp_ = vp0 + sl_cur; _Pragma("unroll") for (int i = 0; i < 8; ++i) VRD(i);
      o[0] = MFMA32(PAF(0), VFR(0), o[0]); o[1] = MFMA32(PAF(0), VFR(4), o[1]); o[0] = MFMA32(PAF(1), VFR(1), o[0]); o[1] = MFMA32(PAF(1), VFR(5), o[1]);
      o[0] = MFMA32(PAF(2), VFR(2), o[0]); o[1] = MFMA32(PAF(2), VFR(6), o[1]); o[0] = MFMA32(PAF(3), VFR(3), o[0]); o[1] = MFMA32(PAF(3), VFR(7), o[1]); }
    { auto rr = __builtin_amdgcn_permlane32_swap(__float_as_uint(l_reg), __float_as_uint(l_reg), false, false); l_reg = __uint_as_float(rr[0]) + __uint_as_float(rr[1]); }
    if (hi == 0) wsf[32 + r32] = l_reg; asm volatile("s_waitcnt lgkmcnt(0)" ::: "memory");
    float rli[16];
#pragma unroll
    for (int r = 0; r < 16; ++r) rli[r] = __builtin_amdgcn_rcpf(wsf[32 + crow(r, hi)]);
    u16* Ow = O + (rowbase + q0 + wid * A_QBLK) * A_DM + h * A_D; const u16* Gw = SG + (rowbase + q0 + wid * A_QBLK) * A_DM + h * A_D;
    u16* stg = (u16*)(lds + A_LDS_OST) + wid * 2048;
#pragma unroll
    for (int r = 0; r < 16; ++r) { const int orow = crow(r, hi);
#pragma unroll
        for (int d0 = 0; d0 < 2; ++d0) stg[orow * 64 + d0 * 32 + r32] = f2bf(o[d0][r] * rli[r]); }
    asm volatile("s_waitcnt lgkmcnt(0)" ::: "memory");
#pragma unroll
    for (int i = 0; i < 4; ++i) { const int row = i * 8 + (lane >> 3), ch = lane & 7;
        u32x4 ov = *(const u32x4*)(stg + row * 64 + ch * 8); u32x4 gv = *(const u32x4*)(Gw + (long)row * A_DM + ch * 8); u32x4 rv;
#pragma unroll
        for (int e = 0; e < 4; ++e) rv[e] = cvtpk(bflo(ov[e]) * bflo(gv[e]), bfhi(ov[e]) * bfhi(gv[e]));
        *(u32x4*)(Ow + (long)row * A_DM + ch * 8) = rv; }
    asm volatile("s_waitcnt vmcnt(0) lgkmcnt(0)\n\ts_barrier" ::: "memory");
#undef DMA_K
#undef DMA_V
#undef DMA_M
#undef MWORD
#undef ROT
#undef EX
#undef RESC
#undef PKW
#undef PAF
#undef VFR
#undef VRD
#undef KRD
#undef ENDW
#undef GAPA
#undef GAPB
#undef MAND
#undef STEP
}
__device__ __forceinline__ void phase_attn(const Params& p, char* lds) {
    constexpr int NPAIR = A_NQB / 2, NUNIT = NBATCH * A_NHEAD * NPAIR;
    const int bid_ = BID(), gdim_ = GDIM();
    for (int u = bid_; u < NUNIT; u += gdim_) {
        const int x = u & 7, kk = u >> 3, bh = x + 8 * (kk / NPAIR), j = kk % NPAIR;
        const int b = bh / A_NHEAD, h = bh % A_NHEAD;
        const u64* mb = p.mask() + (size_t)b * MASK_WORDS_PER_BATCH;
        attn64_unit(b, h, j, p.q(), p.k(), p.v(), p.sg(), p.bin(), mb + mk_base(j), lds);
        attn64_unit(b, h, A_NQB - 1 - j, p.q(), p.k(), p.v(), p.sg(), p.bin(), mb + mk_base(A_NQB - 1 - j), lds);
    }
}

struct EpiStash {
    static constexpr bool DUPOK = false;
    u16* stash;
    __device__ __forceinline__ void operator()(const acc_t& acc, const pg8::Unit& u, int ui, int wr, int wc, int fr, int fq) const {
        const int tid_ = TID();
        u32x4* st = (u32x4*)(stash + (size_t)(u.pm * 4 + u.pn) * 65536);
        ROWS_LOOP {
#pragma unroll
            for (int bj = 0; bj < 2; ++bj) { const f32x4 v0 = acc[ai][bj][m][0], v1 = acc[ai][bj][m][1];
                u32x4 w; w[0] = cvtpk(v0[0], v0[1]); w[1] = cvtpk(v0[2], v0[3]); w[2] = cvtpk(v1[0], v1[1]); w[3] = cvtpk(v1[2], v1[3]);
                st[((ai * 4 + m) * 2 + bj) * 512 + tid_] = w; } }
    }
};
struct EpiGate {
    static constexpr bool DUPOK = false;
    const Params& p; int l; int br;
    __device__ __forceinline__ void operator()(const acc_t& acc, const pg8::Unit& u, int ui, int wr, int wc, int fr, int fq) const {
        const float* ssq = p.sumsq() + (size_t)(l & 1) * T * 16;
        const int tid_ = TID();
        const u32x4* st = (const u32x4*)(p.stash() + (size_t)(u.pm * 4 + u.pn) * 65536);
        const int cl = wc * 4 + fq;
        __shared__ float s_rstd[256];
        { if (tid_ < 256) s_rstd[tid_] = row_rstd(ssq, u.pm * 256 + tid_); __syncthreads(); }
        float rsa[8];
#pragma unroll
        for (int ix = 0; ix < 8; ++ix) rsa[ix] = s_rstd[(ix >> 2) * 128 + wr * 64 + (ix & 3) * 16 + fr];
        const char* stp = (const char*)st + (size_t)tid_ * 16;
        char* mpp = (char*)(p.merged() + (size_t)(u.pm * 256 + wr * 64 + fr) * 1024 + u.pn * 256 + 16 * cl);
        u32x4 yb = *(const u32x4*)stp, ob = (br > 0) ? *(const u32x4*)mpp : (u32x4){0u, 0u, 0u, 0u};
        ROWS_LOOP { const int ix = ai * 4 + m; const float rs = rsa[ix];
#pragma unroll
            for (int bj = 0; bj < 2; ++bj) { const f32x4 v0 = acc[ai][bj][m][0] * rs, v1 = acc[ai][bj][m][1] * rs;
                float r[8];
                r[0] = sigmf(v0[0]) * bflo(yb[0]); r[1] = sigmf(v0[1]) * bfhi(yb[0]); r[2] = sigmf(v0[2]) * bflo(yb[1]); r[3] = sigmf(v0[3]) * bfhi(yb[1]);
                r[4] = sigmf(v1[0]) * bflo(yb[2]); r[5] = sigmf(v1[1]) * bfhi(yb[2]); r[6] = sigmf(v1[2]) * bflo(yb[3]); r[7] = sigmf(v1[3]) * bfhi(yb[3]);
                if (br > 0) {
#pragma unroll
                    for (int e = 0; e < 4; ++e) { r[2 * e] += bflo(ob[e]); r[2 * e + 1] += bfhi(ob[e]); } }
                u32x4 wo; wo[0] = cvtpk(r[0], r[1]); wo[1] = cvtpk(r[2], r[3]); wo[2] = cvtpk(r[4], r[5]); wo[3] = cvtpk(r[6], r[7]);
                const char* stn = stp + 8192; char* mpn = (bj == 0) ? (mpp + 16) : (mpp - 16 + ((ix == 3) ? 80 : 16) * 2048);
                asm volatile("" : "+v"(stn), "+v"(mpn));
                if (!(ix == 7 && bj == 1)) { yb = *(const u32x4*)stn; if (br > 0) ob = *(const u32x4*)mpn; }
                *(u32x4*)mpp = wo;
                stp = stn; mpp = mpn; } }
    }
};
__device__ __forceinline__ void phase_merge(const Params& p, int l, char* shm) {
    pg8::RowOrder S{4, 512, GDIM(), BID()};
    for (int br = 0; br < 3; ++br) {
        const u16* Ain = br == 0 ? p.ga() : (br == 1 ? p.bin() : p.sp());
        const u16* Wy = (br == 0 ? p.wt_oa() : (br == 1 ? p.wt_ob() : p.wt_oc())) + (size_t)l * 1024 * 512;
        { pg8::Gemm g{Ain, Wy, T, 1024, 512}; EpiStash E{p.stash()}; pg8::gemm_phase((PG8_LAS unsigned char*)shm, g, S, E); }
        { pg8::Gemm g{p.xb(), p.wt_mg() + (size_t)l * 3072 * 1024 + (size_t)br * 1024 * 1024, T, 1024, 1024}; EpiGate E{p, l, br}; pg8::gemm_phase((PG8_LAS unsigned char*)shm, g, S, E); }
    }
}

struct EpiOut {
    static constexpr bool DUPOK = false;
    const Params& p; int l;
    __device__ __forceinline__ void ldx(size_t o, f32x4& a, f32x4& b) const {
        if (l == 0) { a = *(const f32x4*)(p.x_in + o); b = *(const f32x4*)(p.x_in + o + 4); }
        else { const u32x4 w = *(const u32x4*)(p.xb() + o); a = (f32x4){bflo(w[0]), bfhi(w[0]), bflo(w[1]), bfhi(w[1])}; b = (f32x4){bflo(w[2]), bfhi(w[2]), bflo(w[3]), bfhi(w[3])}; }
    }
    __device__ __forceinline__ void operator()(const acc_t& acc, const pg8::Unit& u, int ui, int wr, int wc, int fr, int fq) const {
        const int cl = wc * 4 + fq;
        f32x4 xb0[2], xb1[2];
#pragma unroll
        for (int bj = 0; bj < 2; ++bj) ldx((size_t)(u.pm * 256 + wr * 64 + fr) * 1024 + u.pn * 256 + 16 * cl + bj * 8, xb0[bj], xb1[bj]);
        ROWS_LOOP { const int row = ROW_OF; const int ix = ai * 4 + m; float ss = 0.f;
            f32x4 x0[2], x1[2];
#pragma unroll
            for (int bj = 0; bj < 2; ++bj) { x0[bj] = xb0[bj] + acc[ai][bj][m][0]; x1[bj] = xb1[bj] + acc[ai][bj][m][1]; }
            if (ix < 7) { const int rown = u.pm * 256 + ((ix + 1) >> 2) * 128 + wr * 64 + ((ix + 1) & 3) * 16 + fr;
#pragma unroll
                for (int bj = 0; bj < 2; ++bj) ldx((size_t)rown * 1024 + u.pn * 256 + 16 * cl + bj * 8, xb0[bj], xb1[bj]); }
#pragma unroll
            for (int bj = 0; bj < 2; ++bj) { const size_t o = (size_t)row * 1024 + u.pn * 256 + 16 * cl + bj * 8;
                if (l == NL - 1) { *(f32x4*)(p.x + o) = x0[bj]; *(f32x4*)(p.x + o + 4) = x1[bj]; }
                else { u32x4 w; w[0] = cvtpk(x0[bj][0], x0[bj][1]); w[1] = cvtpk(x0[bj][2], x0[bj][3]); w[2] = cvtpk(x1[bj][0], x1[bj][1]); w[3] = cvtpk(x1[bj][2], x1[bj][3]); *(u32x4*)(p.xb() + o) = w;
#pragma unroll
                    for (int j = 0; j < 4; ++j) ss += x0[bj][j] * x0[bj][j] + x1[bj][j] * x1[bj][j]; } }
            if (l < NL - 1) { ss += __shfl_xor(ss, 16); ss += __shfl_xor(ss, 32); if (fq == 0) p.sumsq()[(size_t)((l + 1) & 1) * T * 16 + (size_t)row * 16 + u.pn * 4 + wc] = ss; } }
    }
};
__device__ __forceinline__ void phase_out(const Params& p, int l, char* shm) {
    pg8::RowOrder S{4, 512, GDIM(), BID()};
    pg8::Gemm g{p.merged(), p.wt_o() + (size_t)l * 1024 * 1024, T, 1024, 1024};
    EpiOut E{p, l};
    pg8::gemm_phase((PG8_LAS unsigned char*)shm, g, S, E);
}

enum { PH_PREP0 = 0, PH_IN, PH_MIX, PH_IDX, PH_SEL, PH_ATTN, PH_MERGE, PH_OUT };
template <int PH> __global__ __launch_bounds__(NTHR) void k_phase(Params p, int l, int b) {
    extern __shared__ __attribute__((aligned(16))) char shm[];
    if (PH == PH_PREP0) phase_prep0(p, shm);
    if (PH == PH_IN) phase_in(p, l, shm);
    if (PH == PH_MIX) phase_mix(p, l);
    if (PH == PH_IDX) phase_indexer(p, b, p.scores(), shm);
    if (PH == PH_SEL) phase_select(p, b, shm, p.scores());
    if (PH == PH_ATTN) phase_attn(p, shm);
    if (PH == PH_MERGE) phase_merge(p, l, shm);
    if (PH == PH_OUT) phase_out(p, l, shm);
}

#define XB_TMO      128
#define XB_XCNT(j)  (256  + 64 * (j))
#define XB_XSUB(j)  (1280 + 64 * (j))
#define XB_XGEN(j)  (2304 + 64 * (j))
#define XB_TOP      3328
#define XB_TOPGEN   3392
#define XCD_BAR_WORDS 3456
#define XB_SPIN_CAP (1u << 22)
#define LAS __attribute__((address_space(3)))
__device__ __forceinline__ unsigned xb_ld(unsigned* p)              { return __hip_atomic_load(p, __ATOMIC_RELAXED, __HIP_MEMORY_SCOPE_AGENT); }
__device__ __forceinline__ unsigned xb_add(unsigned* p, unsigned v) { return __hip_atomic_fetch_add(p, v, __ATOMIC_RELAXED, __HIP_MEMORY_SCOPE_AGENT); }
__device__ __forceinline__ unsigned xb_xcc_id() { return (unsigned)__builtin_amdgcn_s_getreg((3 << 11) | 20) & 0xFu; }
#define XB_SPIN(cond, bar) do { unsigned _sp = 0; while (cond) { __builtin_amdgcn_s_sleep(1); \
    if ((++_sp & 255u) == 0u) { if (xb_ld(&(bar)[XB_TMO])) break; if (_sp > XB_SPIN_CAP) { atomicAdd(&(bar)[XB_TMO], 1u); break; } } } } while (0)
struct XcdBarrier { unsigned* bar; unsigned x; volatile LAS unsigned* st; };
__device__ __forceinline__ XcdBarrier xcd_barrier_post(unsigned* bar, volatile LAS unsigned* st) {
    XcdBarrier b; b.bar = bar; b.x = xb_xcc_id(); b.st = st;
    if (threadIdx.x == 0) (void)xb_add(&bar[XB_XCNT(b.x)], 1u);
    return b;
}
__device__ __forceinline__ void xcd_barrier_complete(unsigned* bar, unsigned x, unsigned& nloc, unsigned& nx) {
    const unsigned G = gridDim.x * gridDim.y * gridDim.z;
    unsigned sum, cnt, mine, sp = 0u;
    for (;;) {
        sum = 0u; cnt = 0u; mine = 0u;
#pragma unroll
        for (unsigned j = 0; j < 16; ++j) { const unsigned c = xb_ld(&bar[XB_XCNT(j)]); sum += c; cnt += (c > 0u) ? 1u : 0u; mine = (j == x) ? c : mine; }
        if (sum == G) break;
        __builtin_amdgcn_s_sleep(1);
        if ((++sp & 255u) == 0u) { if (xb_ld(&bar[XB_TMO])) break; if (sp > XB_SPIN_CAP) { atomicAdd(&bar[XB_TMO], 1u); break; } }
    }
    nloc = mine > 0u ? mine : 1u; nx = cnt > 0u ? cnt : 1u;
}
__device__ __forceinline__ void xcd_barrier(const XcdBarrier& b) {
    asm volatile("s_waitcnt vmcnt(0)" ::: "memory");
    __syncthreads();
    if (threadIdx.x == 0) {
        unsigned* bar = b.bar;
        __builtin_amdgcn_s_waitcnt(0);
        unsigned nloc = b.st[0], nx = b.st[1];
        if (nloc == 0u) { xcd_barrier_complete(bar, b.x, nloc, nx); b.st[0] = nloc; b.st[1] = nx; }
        const unsigned old = xb_add(&bar[XB_XSUB(b.x)], 1u);
        const unsigned gen = old / nloc;
        if (old + 1u == (gen + 1u) * nloc) {
            __builtin_amdgcn_fence(__ATOMIC_RELEASE, "agent");
            asm volatile("s_waitcnt vmcnt(0)" ::: "memory");
            const unsigned og = xb_add(&bar[XB_TOP], 1u);
            const unsigned tg = og / nx;
            if (og + 1u == (tg + 1u) * nx) xb_add(&bar[XB_TOPGEN], 1u);
            else XB_SPIN(xb_ld(&bar[XB_TOPGEN]) == tg, bar);
            __builtin_amdgcn_fence(__ATOMIC_ACQUIRE, "agent");
            xb_add(&bar[XB_XGEN(b.x)], 1u);
            asm volatile("s_waitcnt vmcnt(0)" ::: "memory");
        } else {
            XB_SPIN(xb_ld(&bar[XB_XGEN(b.x)]) == gen, bar);
            __builtin_amdgcn_fence(__ATOMIC_ACQUIRE, "agent");
            asm volatile("s_waitcnt vmcnt(0)" ::: "memory");
        }
    }
    __syncthreads();
}

#if MEGA
typedef const __attribute__((address_space(4))) Params* kparams_t;
__device__ __forceinline__ Params load_params(kparams_t k) {
    Params q; q.x_in = k->x_in; q.norm_g = k->norm_g; q.w_in = k->w_in; q.conv_w = k->conv_w; q.w_out_conv = k->w_out_conv; q.q_g = k->q_g; q.k_g = k->k_g; q.w_out_attn = k->w_out_attn;
    q.pool_w = k->pool_w; q.pool_scale = k->pool_scale; q.w_out_pool = k->w_out_pool; q.w_o = k->w_o; q.x = k->x; q.ws = k->ws; return q; }
#define PHP(q) kparams_t kq_##q = kp; asm volatile("" : "+s"(kq_##q)); const Params q = load_params(kq_##q);
__global__ __launch_bounds__(NTHR) void k_mega(Params p_unused) {
    extern __shared__ __attribute__((aligned(16))) char shm[];
    cg::grid_group grid = cg::this_grid();
    kparams_t kp = (kparams_t)__builtin_amdgcn_kernarg_segment_ptr();
    __shared__ uint4 xb_words;
    if (threadIdx.x == 0) xb_words = make_uint4(0u, 0u, 0u, 0u);
    __syncthreads();
    const XcdBarrier xb = xcd_barrier_post((unsigned*)(kp->ws + WS_BAR), (volatile LAS unsigned*)&xb_words);

#ifndef SK_PREP
        { PHP(p) phase_prep0(p, shm); }
#endif
#ifdef DUP_PREP
        { PHP(p) phase_prep0(p, shm); }
#endif

    grid.sync();
    for (int l = 0; l < NL; ++l) {

#ifndef SK_IN
        { PHP(p) phase_in(p, l, shm); }
#endif
#ifdef DUP_IN
        { PHP(p) phase_in(p, l, shm); }
#endif

        xcd_barrier(xb);

        { PHP(p) phase_mix(p, l); phase_indexer(p, 0, p.scores(), shm); }
        xcd_barrier(xb);
        { PHP(p) phase_indexer(p, 1, p.scores2(), shm); phase_select(p, 0, shm, p.scores()); }
        xcd_barrier(xb);
        { PHP(p) phase_indexer(p, 2, p.scores(), shm); phase_select(p, 1, shm, p.scores2()); }
        xcd_barrier(xb);
        { PHP(p) phase_indexer(p, 3, p.scores2(), shm); phase_select(p, 2, shm, p.scores()); }
        xcd_barrier(xb);
        { PHP(p) phase_select(p, 3, shm, p.scores2()); }
        xcd_barrier(xb);
#ifndef SK_ATTN
        { PHP(p) phase_attn(p, shm); }
#endif
#ifdef DUP_ATTN
        { PHP(p) phase_attn(p, shm); }
#endif

        xcd_barrier(xb);

#ifndef SK_MERGE
        { PHP(p) phase_merge(p, l, shm); }
#endif
#ifdef DUP_MERGE
        { PHP(p) phase_merge(p, l, shm); }
#endif

        xcd_barrier(xb);

#ifndef SK_OUT
        { PHP(p) phase_out(p, l, shm); }
#endif

        xcd_barrier(xb);
    }
}
#endif

static Params make_params(void* const* d_in, void* d_out, void* d_ws) {
    Params p{};
    p.x_in = (const float*)d_in[0]; p.norm_g = (const float*)d_in[1]; p.w_in = (const float*)d_in[2]; p.conv_w = (const float*)d_in[3];
    p.w_out_conv = (const float*)d_in[4]; p.q_g = (const float*)d_in[5]; p.k_g = (const float*)d_in[6]; p.w_out_attn = (const float*)d_in[7];
    p.pool_w = (const float*)d_in[8]; p.pool_scale = (const float*)d_in[9]; p.w_out_pool = (const float*)d_in[10]; p.w_o = (const float*)d_in[11];
    p.x = (float*)d_out; p.ws = (char*)d_ws;
    return p;
}

extern "C" void kernel_launch(void* const* d_in, const int* in_sizes, int n_in, void* d_out, int out_size, void* d_ws, size_t ws_size, hipStream_t stream) {
    if (ws_size < WS_NEEDED) { fprintf(stderr, "workspace too small: %zu < %zu\n", ws_size, (size_t)WS_NEEDED); return; }
    Params p = make_params(d_in, d_out, d_ws);
    static int grid = 0;
    if (!grid) { int dev = 0, cus = 0; hipGetDevice(&dev); hipDeviceGetAttribute(&cus, hipDeviceAttributeMultiprocessorCount, dev); if (cus <= 0 || cus > 256) cus = 256; grid = (cus / 8) * 8; }
#if MEGA
    static bool attr = false;
    if (!attr) { hipFuncSetAttribute((const void*)k_mega, hipFuncAttributeMaxDynamicSharedMemorySize, LDS_BYTES); attr = true; }
    hipMemsetAsync((char*)d_ws + WS_BAR, 0, 16384, stream);
    void* args[] = {&p};
    hipError_t e = hipLaunchCooperativeKernel((void*)k_mega, dim3(grid), dim3(NTHR), args, LDS_BYTES, stream);
    if (e != hipSuccess) fprintf(stderr, "cooperative launch failed: %s\n", hipGetErrorString(e));
#else
    static bool attr = false;
    if (!attr) {
        hipFuncSetAttribute((const void*)k_phase<PH_PREP0>, hipFuncAttributeMaxDynamicSharedMemorySize, LDS_BYTES);
        hipFuncSetAttribute((const void*)k_phase<PH_IN>, hipFuncAttributeMaxDynamicSharedMemorySize, LDS_BYTES);
        hipFuncSetAttribute((const void*)k_phase<PH_MIX>, hipFuncAttributeMaxDynamicSharedMemorySize, LDS_BYTES);
        hipFuncSetAttribute((const void*)k_phase<PH_IDX>, hipFuncAttributeMaxDynamicSharedMemorySize, LDS_BYTES);
        hipFuncSetAttribute((const void*)k_phase<PH_SEL>, hipFuncAttributeMaxDynamicSharedMemorySize, LDS_BYTES);
        hipFuncSetAttribute((const void*)k_phase<PH_ATTN>, hipFuncAttributeMaxDynamicSharedMemorySize, LDS_BYTES);
        hipFuncSetAttribute((const void*)k_phase<PH_MERGE>, hipFuncAttributeMaxDynamicSharedMemorySize, LDS_BYTES);
        hipFuncSetAttribute((const void*)k_phase<PH_OUT>, hipFuncAttributeMaxDynamicSharedMemorySize, LDS_BYTES);
        attr = true;
    }
#define LAUNCH(PH, l, b) hipLaunchKernelGGL(k_phase<PH>, dim3(grid), dim3(NTHR), LDS_BYTES, stream, p, l, b)
    LAUNCH(PH_PREP0, 0, 0);
    for (int l = 0; l < NL; ++l) {
        LAUNCH(PH_IN, l, 0);
        LAUNCH(PH_MIX, l, 0);
        for (int b = 0; b < NBATCH; ++b) { LAUNCH(PH_IDX, l, b); LAUNCH(PH_SEL, l, b); }
        LAUNCH(PH_ATTN, l, 0);
        LAUNCH(PH_MERGE, l, 0);
        LAUNCH(PH_OUT, l, 0);
    }
#endif
}
```

```cpp
#include <hip/hip_runtime.h>
#include <hip/hip_cooperative_groups.h>
#include <stdint.h>
#include <stdio.h>
namespace cg = cooperative_groups;

typedef unsigned short u16;
typedef unsigned long long u64;
typedef __attribute__((ext_vector_type(8))) short bf16x8;
typedef __attribute__((ext_vector_type(4))) short s16x4;
typedef __attribute__((ext_vector_type(4))) float f32x4;
typedef __attribute__((ext_vector_type(16))) float f32x16;
typedef __attribute__((ext_vector_type(4))) unsigned u32x4;
typedef __attribute__((ext_vector_type(2))) unsigned u32x2;

#ifndef MEGA
#define MEGA 1
#endif
__device__ __forceinline__ int TID() { int t = threadIdx.x; asm volatile("" : "+v"(t)); return t; }
__device__ __forceinline__ int BID() { int t = blockIdx.x; asm volatile("" : "+s"(t)); return t; }
__device__ __forceinline__ int GDIM() { int t = gridDim.x; asm volatile("" : "+s"(t)); return t; }

constexpr int SEQ = 8192, NBATCH = 4, T = NBATCH * SEQ, DMODEL = 1024, NL = 4, INW = 8776;
constexpr int NPA = 5888;
constexpr int NTHR = 512;
constexpr int LDS_BYTES = 131072;
constexpr float RMS_EPS = 1e-6f;

struct Params {
    const float *x_in, *norm_g, *w_in, *conv_w, *w_out_conv, *q_g, *k_g, *w_out_attn, *pool_w, *pool_scale, *w_out_pool, *w_o;
    float* x; char* ws;
    __device__ __forceinline__ u16* xb() const { return (u16*)(ws + 0ull); }
    __device__ __forceinline__ u16* ga() const { return (u16*)(ws + 67108864ull); }
    __device__ __forceinline__ u16* q() const { return (u16*)(ws + 100663296ull); }
    __device__ __forceinline__ u16* k() const { return (u16*)(ws + 134217728ull); }
    __device__ __forceinline__ u16* v() const { return (u16*)(ws + 167772160ull); }
    __device__ __forceinline__ u16* sg() const { return (u16*)(ws + 201326592ull); }
    __device__ __forceinline__ u16* iq() const { return (u16*)(ws + 234881024ull); }
    __device__ __forceinline__ u16* sp() const { return (u16*)(ws + 268435456ull); }
    __device__ __forceinline__ u16* z() const { return (u16*)(ws + 301989888ull); }
    __device__ __forceinline__ u16* u() const { return (u16*)(ws + 335544320ull); }
    __device__ __forceinline__ u16* zuspare() const { return (u16*)(ws + 369098752ull); }
    __device__ __forceinline__ u16* ik() const { return (u16*)(ws + 371195904ull); }
    __device__ __forceinline__ float* iw() const { return (float*)(ws + 375390208ull); }
    __device__ __forceinline__ u16* wt_in() const { return (u16*)(ws + 376438784ull); }
    __device__ __forceinline__ u16* wt_mg() const { return (u16*)(ws + 424673280ull); }
    __device__ __forceinline__ u16* wt_oa() const { return (u16*)(ws + 449839104ull); }
    __device__ __forceinline__ u16* wt_ob() const { return (u16*)(ws + 454033408ull); }
    __device__ __forceinline__ u16* wt_oc() const { return (u16*)(ws + 458227712ull); }
    __device__ __forceinline__ u16* wt_o() const { return (u16*)(ws + 462422016ull); }
    __device__ __forceinline__ float* ropec() const { return (float*)(ws + 470810624ull); }
    __device__ __forceinline__ float* ropes() const { return (float*)(ws + 471859200ull); }
    __device__ __forceinline__ float* sumsq() const { return (float*)(ws + 472907776ull); }
    __device__ __forceinline__ u64* mask() const { return (u64*)(ws + 477102080ull); }
    __device__ __forceinline__ u16* scores() const { return (u16*)(ws + 494403584ull); }
    __device__ __forceinline__ u16* scores2() const { return z(); }
    __device__ __forceinline__ u16* stash() const { return scores(); }
    __device__ __forceinline__ u16* merged() const { return q(); }
    __device__ __forceinline__ u16* bin() const { return iq(); }
};
constexpr size_t WS_BAR = 563609600ull;
constexpr size_t WS_NEEDED = WS_BAR + 16384;


__device__ __forceinline__ unsigned cvtpk(float lo, float hi) { unsigned r; asm("v_cvt_pk_bf16_f32 %0, %1, %2" : "=v"(r) : "v"(lo), "v"(hi)); return r; }
__device__ __forceinline__ u16 f2bf(float f) { return (u16)(cvtpk(f, 0.f) & 0xffffu); }
__device__ __forceinline__ float bf2f(u16 b) { return __uint_as_float(((unsigned)b) << 16); }
__device__ __forceinline__ float bflo(unsigned w) { return __uint_as_float(w << 16); }
__device__ __forceinline__ float bfhi(unsigned w) { return __uint_as_float(w & 0xffff0000u); }
__device__ __forceinline__ float siluf(float x) { return x * __builtin_amdgcn_rcpf(1.f + __builtin_amdgcn_exp2f(x * -1.4426950408889634f)); }
__device__ __forceinline__ float sigmf(float x) { return __builtin_amdgcn_rcpf(1.f + __builtin_amdgcn_exp2f(x * -1.4426950408889634f)); }

__device__ __forceinline__ float row_rstd(const float* ssp, int row) {
    const f32x4* q = (const f32x4*)(ssp + (size_t)row * 16);
    const f32x4 a = q[0], b = q[1], c = q[2], d = q[3];
    const float s = ((a[0] + a[1]) + (a[2] + a[3])) + ((b[0] + b[1]) + (b[2] + b[3])) + ((c[0] + c[1]) + (c[2] + c[3])) + ((d[0] + d[1]) + (d[2] + d[3]));
    return __builtin_amdgcn_rsqf(s * (1.f / 1024.f) + RMS_EPS);
}
__device__ __forceinline__ int lc_of_tc(int tc) { int bj = tc >> 7, wc = (tc >> 5) & 3, n = (tc >> 4) & 1, fq = (tc >> 2) & 3, j = tc & 3; return ((wc * 4 + fq) << 4) + bj * 8 + n * 4 + j; }
__device__ __forceinline__ int tc_of_lc(int lc) { int cl = lc >> 4, s = lc & 15, wc = cl >> 2, fq = cl & 3, bj = s >> 3, n = (s >> 2) & 1, j = s & 3; return bj * 128 + wc * 32 + n * 16 + fq * 4 + j; }

__device__ __forceinline__ int src_col_in(int np) {
    int pn = np >> 8, tc = np & 255;
    int bj = tc >> 7, wc = (tc >> 5) & 3, n = (tc >> 4) & 1, fq = (tc >> 2) & 3, j = tc & 3, cl = wc * 4 + fq, s = bj * 8 + n * 4 + j, lc = cl * 16 + s;
    int d = (s < 8) ? (8 * fq + s) : (8 * fq + 32 + (s - 8));
    if (pn < 8) return (s & 3) * 512 + pn * 64 + cl * 4 + (s >> 2);
    if (pn < 12) { int which = (pn - 8) >> 1, head = ((pn - 8) & 1) * 4 + wc; return 2048 + which * 512 + head * 64 + d; }
    if (pn < 14) return 3072 + (pn - 12) * 256 + lc;
    if (pn < 16) return 3584 + (pn - 14) * 256 + lc;
    if (pn < 18) { int head = (pn - 16) * 4 + wc; return 4096 + head * 64 + d; }
    if (pn == 18) { if (wc == 0) return 4608 + d; if (wc == 1 && fq == 0 && s < 8) return 4672 + s; return -1; }
    if (pn < 21) return -2;
    return 5192 + (pn - 21) * 256 + lc;
}

__device__ __forceinline__ void prep_x(const Params& p) {
    const int tid_ = TID(); const int lane = tid_ & 63, gw = BID() * (NTHR / 64) + (tid_ >> 6), nw = GDIM() * (NTHR / 64);
    for (int row0 = gw * 4; row0 < T; row0 += nw * 4) {
        float4 v[4][4];
#pragma unroll
        for (int r = 0; r < 4; ++r)
#pragma unroll
            for (int i = 0; i < 4; ++i) v[r][i] = ((const float4*)(p.x_in + (size_t)(row0 + r) * DMODEL))[i * 64 + lane];
        float ss[4];
#pragma unroll
        for (int r = 0; r < 4; ++r) { ss[r] = 0.f;
#pragma unroll
            for (int i = 0; i < 4; ++i) { const float4 q = v[r][i]; ss[r] += q.x * q.x + q.y * q.y + q.z * q.z + q.w * q.w;
                u32x2 o; o[0] = cvtpk(q.x, q.y); o[1] = cvtpk(q.z, q.w);
                *(u32x2*)(p.xb() + (size_t)(row0 + r) * DMODEL + (i * 64 + lane) * 4) = o; } }
#pragma unroll
        for (int m = 32; m >= 1; m >>= 1) {
#pragma unroll
            for (int r = 0; r < 4; ++r) ss[r] += __shfl_xor(ss[r], m); }
        if (lane < 16) {
#pragma unroll
            for (int r = 0; r < 4; ++r) p.sumsq()[(size_t)(row0 + r) * 16 + lane] = (lane == 0) ? ss[r] : 0.f; }
    }
}
__device__ __forceinline__ void prep_rope(const Params& p) {
    const int i0 = BID() * NTHR + TID(), istep = GDIM() * NTHR;
    for (int i = i0; i < SEQ * 32; i += istep) {
        int pos = i >> 5, j = i & 31;
        float inv = 1.0f / powf(10000.0f, (float)(2 * j) / 64.0f);
        float ang = (float)pos * inv;
        p.ropec()[i] = cosf(ang); p.ropes()[i] = sinf(ang);
    }
}
__device__ __forceinline__ void prep_wt(const float* src, int lds_, const float* scale, u16* dst, int K, int NP, int mode, float* tile) {
    const int tid_ = TID(); const int tx = tid_ & 63, ty = tid_ >> 6; const int bid_ = BID(), gdim_ = GDIM();
    const int ntn = NP / 64, ntk = K / 64;
    for (int t = bid_; t < ntn * ntk; t += gdim_) {
        const int n0 = (t / ntk) * 64, k0 = (t % ntk) * 64;
        int np = n0 + tx, col;
        if (mode == 0) col = src_col_in(np);
        else if (mode == 1) col = 5704 + (np & ~255) + lc_of_tc(np & 255);
        else col = (np & ~255) + lc_of_tc(np & 255);
        __syncthreads();
#pragma unroll
        for (int i = 0; i < 8; ++i) { int kk = ty + 8 * i; tile[kk * 65 + tx] = (col >= 0) ? src[(size_t)(k0 + kk) * lds_ + col] : 0.f; }
        __syncthreads();
        const float sc = scale ? scale[k0 + tx] : 1.f;
#pragma unroll
        for (int i = 0; i < 8; ++i) {
            int nn = ty + 8 * i; int npo = n0 + nn;
            bool skip = (mode == 0) && ((npo >> 8) == 19 || (npo >> 8) == 20);
            if (!skip) dst[(size_t)npo * K + k0 + tx] = f2bf(tile[tx * 65 + nn] * sc);
        }
    }
}
__device__ __forceinline__ void prep_fold(const float* win, const float* ng, const float* pw, u16* wt_in) {
    const int i0 = BID() * NTHR + TID(), istep = GDIM() * NTHR;
    for (int i = i0; i < 1024 * 512; i += istep) {
        int k = i >> 9, n = i & 511, g = n >> 7, d = n & 127;
        const float* wr = win + (size_t)k * INW + 4680 + g * 128;
        const float* pp = pw + (size_t)g * 128 * 128 + d;
        float acc = 0.f;
        for (int c = 0; c < 128; ++c) acc += wr[c] * pp[c * 128];
        int row = (19 + (n >> 8)) * 256 + tc_of_lc(n & 255);
        wt_in[(size_t)row * 1024 + k] = f2bf(acc * ng[k]);
    }
}
__device__ __forceinline__ void phase_prep0(const Params& p, char* shm) {
    prep_x(p); prep_rope(p);
    float* tile = (float*)shm;
    for (int l = 0; l < NL; ++l) {
        const float* ng = p.norm_g + l * 1024;
        const float* win = p.w_in + (size_t)l * 1024 * INW;
        prep_wt(win, INW, ng, p.wt_in() + (size_t)l * NPA * 1024, 1024, NPA, 0, tile);
        prep_wt(win, INW, ng, p.wt_mg() + (size_t)l * 3072 * 1024, 1024, 3072, 1, tile);
        prep_wt(p.w_out_conv + (size_t)l * 512 * 1024, 1024, nullptr, p.wt_oa() + (size_t)l * 1024 * 512, 512, 1024, 2, tile);
        prep_wt(p.w_out_attn + (size_t)l * 512 * 1024, 1024, nullptr, p.wt_ob() + (size_t)l * 1024 * 512, 512, 1024, 2, tile);
        prep_wt(p.w_out_pool + (size_t)l * 512 * 1024, 1024, nullptr, p.wt_oc() + (size_t)l * 1024 * 512, 512, 1024, 2, tile);
        prep_wt(p.w_o + (size_t)l * 1024 * 1024, 1024, nullptr, p.wt_o() + (size_t)l * 1024 * 1024, 1024, 1024, 3, tile);
        prep_fold(win, ng, p.pool_w + (size_t)l * 4 * 128 * 128, p.wt_in() + (size_t)l * NPA * 1024);
    }
}

namespace pg8 {
#define PG8_LAS __attribute__((address_space(3)))
typedef unsigned short bf16_t;
constexpr int BM = 256, BK = 64, HALF = 128, HTB = HALF * BK * 2, STAGE_BYTES = 8 * HTB;
__device__ __forceinline__ int lds_byte(int r, int c) { const int st = (r >> 4) * 2 + (c >> 5), rr = r & 15, cc = c & 31, ob = rr * 64 + cc * 2; return st * 1024 + (ob ^ (((ob >> 9) & 1) << 5)); }
__device__ __forceinline__ void stage_rc(int b, int& R, int& C) { const int st = b / 1024, sb = b % 1024, swz = sb ^ (((sb >> 9) & 1) << 5); R = (st >> 1) * 16 + swz / 64; C = (st & 1) * 32 + (swz % 64) / 2; }
struct Unit { int pm, pn; };
struct Gemm { const bf16_t* A; const bf16_t* Bt; int M, N, K; };
constexpr int NXCD = 8, WGM = 8;
struct StaticOrder {
    int nM, nN, nwg, G, c;
    __device__ void init(int M, int N, int G_, int c_) { nM = M / BM; nN = N / BM; nwg = nM * nN; G = G_; c = c_; }
    __device__ bool next(int i, Unit& u) const {
        const long L = (long)i * G + c; if (L >= nwg) return false;
        int wgid = (int)L; { const int q = nwg / NXCD, r = nwg % NXCD, xcd = wgid % NXCD, off = wgid / NXCD; wgid = (xcd < r ? xcd * (q + 1) : r * (q + 1) + (xcd - r) * q) + off; }
        const int nig = WGM * nN, gid = wgid / nig, fm = gid * WGM, gsz = (nM - fm) < WGM ? (nM - fm) : WGM;
        u.pm = fm + ((wgid % nig) % gsz); u.pn = (wgid % nig) / gsz; return true;
    }
};
struct RowOrder {
    int nN, ntile, G, c;
    __device__ bool next(int i, Unit& u) const {
        const int x = c & 7, lt = (c >> 3) + (G >> 3) * i;
        const int quad = lt >> 2, pm = quad * 8 + x;
        if (pm * 4 >= ntile) return false;
        u.pm = pm; u.pn = lt & 3; return true; }
};
template <class Epi, class Sched>
__device__ __forceinline__ void gemm_phase(PG8_LAS unsigned char* lds, const Gemm g, const Sched& S, const Epi& E) {
    const int tid = TID(), wid = __builtin_amdgcn_readfirstlane(tid >> 6), lane = tid & 63, wr = wid >> 2, wc = wid & 3, fr = lane & 15, fq = lane >> 4;
    const int K = g.K, nt = K / BK;
    unsigned voffA[2], voffB[2];
#pragma unroll
    for (int i = 0; i < 2; ++i) { int R, C; stage_rc(tid * 16 + i * 8192, R, C); voffA[i] = (unsigned)(R * K + C) * 2u; voffB[i] = voffA[i]; }
    const size_t kstep = (size_t)(BK * 2);
    const size_t hstep = (size_t)HALF * K * 2;
    const size_t tstep = 2 * hstep;
    const unsigned ldsw = (unsigned)wid * 1024u;
    const int aoff = lds_byte(wr * 64 + fr, fq * 8), boff = lds_byte(wc * 32 + fr, fq * 8);
#define PG8_SA(b, h) (((b) * 2 + (h)) * HTB)
#define PG8_SB(b, h) ((4 + (b) * 2 + (h)) * HTB)
#define PG8_STAGE(bufoff, gbase, voff) do { _Pragma("unroll") for (int _i = 0; _i < 2; ++_i) \
        __builtin_amdgcn_global_load_lds((const unsigned*)((const char*)(gbase) + (voff)[_i]), (PG8_LAS unsigned*)(lds + (bufoff) + ldsw + _i * 8192), 16, 0, 0); } while (0)
#define PG8_LDA(dst, b, h) do { _Pragma("unroll") for (int m = 0; m < 4; ++m) _Pragma("unroll") for (int k = 0; k < 2; ++k) dst[m][k] = *(const PG8_LAS bf16x8*)(lds + PG8_SA(b, h) + aoff + m * 2048 + k * 1024); } while (0)
#define PG8_LDB(dst, b, h) do { _Pragma("unroll") for (int n = 0; n < 2; ++n) _Pragma("unroll") for (int k = 0; k < 2; ++k) dst[n][k] = *(const PG8_LAS bf16x8*)(lds + PG8_SB(b, h) + boff + n * 2048 + k * 1024); } while (0)
#define PG8_MMA(ai, bj, At, Bt) do { __builtin_amdgcn_s_setprio(1); _Pragma("unroll") for (int m = 0; m < 4; ++m) _Pragma("unroll") for (int n = 0; n < 2; ++n) _Pragma("unroll") for (int k = 0; k < 2; ++k) \
        acc[ai][bj][m][n] = __builtin_amdgcn_mfma_f32_16x16x32_bf16(Bt[n][k], At[m][k], acc[ai][bj][m][n], 0, 0, 0); __builtin_amdgcn_s_setprio(0); } while (0)
#define PG8_WAIT_V(n) asm volatile("s_waitcnt vmcnt(" #n ")" ::: "memory")
#define PG8_WAIT_L(n) asm volatile("s_waitcnt lgkmcnt(" #n ")" ::: "memory")
#define PG8_BAR __builtin_amdgcn_s_barrier()
#define PG8_SCHED __builtin_amdgcn_sched_barrier(0)
    Unit cur, nxt; int ui = 0;
    if (!S.next(0, cur)) return;
    f32x4 acc[2][2][4][2];
#pragma unroll
    for (int a = 0; a < 2; ++a)
#pragma unroll
        for (int b = 0; b < 2; ++b)
#pragma unroll
            for (int m = 0; m < 4; ++m)
#pragma unroll
                for (int n = 0; n < 2; ++n) acc[a][b][m][n] = (f32x4){0.f, 0.f, 0.f, 0.f};
    bf16x8 At[4][2], B0[2][2], B1[2][2];
    const char* cA = (const char*)g.A + (size_t)cur.pm * tstep; const char* cB = (const char*)g.Bt + (size_t)cur.pn * tstep;
    PG8_STAGE(PG8_SB(0, 0), cB, voffB); PG8_STAGE(PG8_SA(0, 0), cA, voffA); PG8_STAGE(PG8_SB(0, 1), cB + hstep, voffB); PG8_STAGE(PG8_SA(0, 1), cA + hstep, voffA);
    if (wr == 1) PG8_BAR;
    PG8_WAIT_V(4); PG8_BAR;
    PG8_STAGE(PG8_SB(1, 0), cB + kstep, voffB); PG8_STAGE(PG8_SA(1, 0), cA + kstep, voffA); PG8_STAGE(PG8_SB(1, 1), cB + hstep + kstep, voffB);
    PG8_WAIT_V(6); PG8_BAR;
    for (;;) {
        const bool has_next = S.next(ui + 1, nxt);
        const char* nA = has_next ? (const char*)g.A + (size_t)nxt.pm * tstep : cA; const char* nB = has_next ? (const char*)g.Bt + (size_t)nxt.pn * tstep : cB;
        for (int t = 0; t < nt; t += 2) {
            const bool last = (t == nt - 2);
            const char* a1 = cA + (size_t)(t + 1) * kstep;
            const char* a2 = last ? nA : cA + (size_t)(t + 2) * kstep; const char* b2 = last ? nB : cB + (size_t)(t + 2) * kstep;
            const char* a3 = a2 + kstep; const char* b3 = b2 + kstep;
            PG8_LDB(B0, 0, 0); PG8_SCHED; PG8_LDA(At, 0, 0); PG8_STAGE(PG8_SA(1, 1), a1 + hstep, voffA);
            PG8_WAIT_L(8); PG8_BAR; PG8_WAIT_L(0); PG8_MMA(0, 0, At, B0); PG8_BAR; PG8_SCHED;
            PG8_LDB(B1, 0, 1); PG8_STAGE(PG8_SB(0, 0), b2, voffB);
            PG8_BAR; PG8_WAIT_L(0); PG8_MMA(0, 1, At, B1); PG8_BAR;
            PG8_LDA(At, 0, 1); PG8_STAGE(PG8_SA(0, 0), a2, voffA);
            PG8_BAR; PG8_WAIT_L(0); PG8_MMA(1, 0, At, B0); PG8_BAR; PG8_SCHED;
            PG8_STAGE(PG8_SB(0, 1), b2 + hstep, voffB);
            PG8_WAIT_V(6); PG8_BAR; PG8_MMA(1, 1, At, B1); PG8_BAR;
            PG8_LDB(B0, 1, 0); PG8_SCHED; PG8_LDA(At, 1, 0); PG8_STAGE(PG8_SA(0, 1), a2 + hstep, voffA);
            PG8_WAIT_L(8); PG8_BAR; PG8_WAIT_L(0); PG8_MMA(0, 0, At, B0); PG8_BAR; PG8_SCHED;
            PG8_LDB(B1, 1, 1); PG8_STAGE(PG8_SB(1, 0), b3, voffB);
            PG8_BAR; PG8_WAIT_L(0); PG8_MMA(0, 1, At, B1); PG8_BAR;
            PG8_LDA(At, 1, 1); PG8_STAGE(PG8_SA(1, 0), a3, voffA);
            PG8_BAR; PG8_WAIT_L(0); PG8_MMA(1, 0, At, B0); PG8_BAR; PG8_SCHED;
            PG8_STAGE(PG8_SB(1, 1), b3 + hstep, voffB);
            PG8_WAIT_V(6); PG8_BAR; PG8_MMA(1, 1, At, B1); PG8_BAR;
        }
        E(acc, cur, ui, wr, wc, fr, fq);
#ifdef DUP_EPI
        if (Epi::DUPOK) E(acc, cur, ui, wr, wc, fr, fq);
#endif
        if (!has_next) break;
#pragma unroll
        for (int a = 0; a < 2; ++a)
#pragma unroll
            for (int b = 0; b < 2; ++b)
#pragma unroll
                for (int m = 0; m < 4; ++m)
#pragma unroll
                    for (int n = 0; n < 2; ++n) acc[a][b][m][n] = (f32x4){0.f, 0.f, 0.f, 0.f};
        cur = nxt; cA = nA; cB = nB; ++ui;
    }
    PG8_WAIT_V(0);
    if (wr == 0) PG8_BAR;
    PG8_BAR;
#undef PG8_SA
#undef PG8_SB
#undef PG8_STAGE
#undef PG8_LDA
#undef PG8_LDB
#undef PG8_MMA
#undef PG8_WAIT_V
#undef PG8_WAIT_L
#undef PG8_BAR
#undef PG8_SCHED
}
}
typedef f32x4 acc_t[2][2][4][2];
#define ROWS_LOOP _Pragma("unroll") for (int ai = 0; ai < 2; ++ai) _Pragma("unroll") for (int m = 0; m < 4; ++m)
#define ROW_OF (u.pm * 256 + ai * 128 + wr * 64 + m * 16 + fr)

struct EpiIn {
    static constexpr bool DUPOK = true;
    const Params& p; int l;
    __device__ __forceinline__ void operator()(const acc_t& acc, const pg8::Unit& u, int ui, int wr, int wc, int fr, int fq) const {
        const float* ssq = p.sumsq() + (size_t)(l & 1) * T * 16;
        const int pn = u.pn, cl = wc * 4 + fq;
        __shared__ float s_rstd[256];
        { const int t_ = TID(); if (t_ < 256) s_rstd[t_] = row_rstd(ssq, u.pm * 256 + t_); __syncthreads(); }
        float rsa[8];
#pragma unroll
        for (int ix = 0; ix < 8; ++ix) rsa[ix] = s_rstd[(ix >> 2) * 128 + wr * 64 + (ix & 3) * 16 + fr];
        if (pn < 8) {
            ROWS_LOOP { const int row = ROW_OF; const float rs = rsa[ai * 4 + m];
                float zz[4], gg[4];
#pragma unroll
                for (int ch = 0; ch < 4; ++ch) { const f32x4 v = acc[ai][ch >> 1][m][ch & 1]; zz[ch] = (v[1] * rs) * (v[2] * rs); gg[ch] = (v[0] * rs) * siluf(v[3] * rs); }
                const size_t o = (size_t)row * 512 + pn * 64 + cl * 4;
                u32x2 a; a[0] = cvtpk(zz[0], zz[1]); a[1] = cvtpk(zz[2], zz[3]); *(u32x2*)(p.z() + o) = a;
                u32x2 b; b[0] = cvtpk(gg[0], gg[1]); b[1] = cvtpk(gg[2], gg[3]); *(u32x2*)(p.ga() + o) = b; }
        } else if (pn < 12 || (pn >= 16 && pn <= 18)) {
            if (pn == 18 && wc >= 1) {
                if (wc == 1 && fq == 0) {
                    ROWS_LOOP { const int row = ROW_OF; const float rs = rsa[ai * 4 + m] * 0.04419417382415922f;
                        *(f32x4*)(p.iw() + (size_t)row * 8) = acc[ai][0][m][0] * rs; *(f32x4*)(p.iw() + (size_t)row * 8 + 4) = acc[ai][0][m][1] * rs; }
                }
            } else {
                const bool isqk = pn < 12; const int which = (pn - 8) >> 1;
                int head; u16* dst; int pitch;
                if (isqk) { head = ((pn - 8) & 1) * 4 + wc; dst = which ? p.k() : p.q(); pitch = 512; }
                else if (pn < 18) { head = (pn - 16) * 4 + wc; dst = p.iq(); pitch = 512; }
                else { head = 0; dst = p.ik(); pitch = 64; }
                f32x4 g0[2], g1[2];
#pragma unroll
                for (int n = 0; n < 2; ++n) { g0[n] = (f32x4){1.f, 1.f, 1.f, 1.f}; g1[n] = g0[n]; }
                if (isqk) { const float* gg = (which ? p.k_g : p.q_g) + l * 64 + 8 * fq;
#pragma unroll
                    for (int n = 0; n < 2; ++n) { g0[n] = *(const f32x4*)(gg + 4 * n); g1[n] = *(const f32x4*)(gg + 32 + 4 * n); } }
                f32x4 rcb[2], rsb[2];
                { const int pos0 = (u.pm * 256 + wr * 64 + fr) & (SEQ - 1);
#pragma unroll
                  for (int n = 0; n < 2; ++n) { rcb[n] = *(const f32x4*)(p.ropec() + pos0 * 32 + 8 * fq + 4 * n); rsb[n] = *(const f32x4*)(p.ropes() + pos0 * 32 + 8 * fq + 4 * n); } }
                ROWS_LOOP { const int row = ROW_OF; const int ix = ai * 4 + m; const float rs = rsa[ix];
                    f32x4 a0[2], a1[2];
#pragma unroll
                    for (int n = 0; n < 2; ++n) { a0[n] = acc[ai][0][m][n] * rs; a1[n] = acc[ai][1][m][n] * rs; }
                    if (isqk) { float ss = 0.f;
#pragma unroll
                        for (int n = 0; n < 2; ++n)
#pragma unroll
                            for (int j = 0; j < 4; ++j) ss += a0[n][j] * a0[n][j] + a1[n][j] * a1[n][j];
                        ss += __shfl_xor(ss, 16); ss += __shfl_xor(ss, 32);
                        const float rn = __builtin_amdgcn_rsqf(ss * (1.f / 64.f) + RMS_EPS);
#pragma unroll
                        for (int n = 0; n < 2; ++n) { a0[n] = a0[n] * rn * g0[n]; a1[n] = a1[n] * rn * g1[n]; } }
                    u32x4 o0, o1;
#pragma unroll
                    for (int n = 0; n < 2; ++n) { const f32x4 cc = rcb[n], sn = rsb[n];
                        const f32x4 r0 = a0[n] * cc - a1[n] * sn, r1 = a1[n] * cc + a0[n] * sn;
                        o0[2 * n] = cvtpk(r0[0], r0[1]); o0[2 * n + 1] = cvtpk(r0[2], r0[3]); o1[2 * n] = cvtpk(r1[0], r1[1]); o1[2 * n + 1] = cvtpk(r1[2], r1[3]); }
                    if (ix < 7) { const int posn = (u.pm * 256 + ((ix + 1) >> 2) * 128 + wr * 64 + ((ix + 1) & 3) * 16 + fr) & (SEQ - 1);
#pragma unroll
                        for (int n = 0; n < 2; ++n) { rcb[n] = *(const f32x4*)(p.ropec() + posn * 32 + 8 * fq + 4 * n); rsb[n] = *(const f32x4*)(p.ropes() + posn * 32 + 8 * fq + 4 * n); } }
                    u16* d = dst + (size_t)row * pitch + head * 64 + 8 * fq;
                    *(u32x4*)d = o0; *(u32x4*)(d + 32) = o1; }
            }
        } else {
            u16* dst; int cb; int kind;
            if (pn < 14) { dst = p.v(); cb = (pn - 12) * 256; kind = 0; }
            else if (pn < 16) { dst = p.sg(); cb = (pn - 14) * 256; kind = 1; }
            else if (pn < 21) { dst = p.u(); cb = (pn - 19) * 256; kind = 0; }
            else { dst = p.sp(); cb = (pn - 21) * 256; kind = 2; }
            f32x4 sc[2][2];
#pragma unroll
            for (int bj = 0; bj < 2; ++bj)
#pragma unroll
                for (int n = 0; n < 2; ++n) sc[bj][n] = (kind == 2) ? *(const f32x4*)(p.pool_scale + l * 512 + cb + 16 * cl + bj * 8 + n * 4) : (f32x4){1.f, 1.f, 1.f, 1.f};
            ROWS_LOOP { const int row = ROW_OF; const float rs = rsa[ai * 4 + m];
#pragma unroll
                for (int bj = 0; bj < 2; ++bj) { f32x4 v0 = acc[ai][bj][m][0] * rs, v1 = acc[ai][bj][m][1] * rs;
                    if (kind >= 1) {
#pragma unroll
                        for (int j = 0; j < 4; ++j) { v0[j] = siluf(v0[j]) * sc[bj][0][j]; v1[j] = siluf(v1[j]) * sc[bj][1][j]; } }
                    u32x4 w; w[0] = cvtpk(v0[0], v0[1]); w[1] = cvtpk(v0[2], v0[3]); w[2] = cvtpk(v1[0], v1[1]); w[3] = cvtpk(v1[2], v1[3]);
                    *(u32x4*)(dst + (size_t)row * 512 + cb + 16 * cl + bj * 8) = w; } }
        }
    }
};
__device__ __forceinline__ void phase_in(const Params& p, int l, char* shm) {
    pg8::Gemm g{p.xb(), p.wt_in() + (size_t)l * NPA * 1024, T, NPA, 1024};
    pg8::StaticOrder S; S.init(T, NPA, GDIM(), BID());
    EpiIn E{p, l};
    pg8::gemm_phase((PG8_LAS unsigned char*)shm, g, S, E);
}
__device__ __forceinline__ void phase_mix(const Params& p, int l) {
    const float* cw = p.conv_w + l * 3 * 512;
    constexpr int RUN = 16;
    const int nitem = (T / RUN) * 256;
    const int it0 = BID() * NTHR + TID(), itstep = GDIM() * NTHR;
    for (int it = it0; it < nitem; it += itstep) {
        const int cp = it & 255, c = cp * 2, t0 = (it >> 8) * RUN, pos0 = t0 & (SEQ - 1);
        {
            const float w00 = cw[c], w01 = cw[c + 1], w10 = cw[512 + c], w11 = cw[513 + c], w20 = cw[1024 + c], w21 = cw[1025 + c];
            unsigned zr[RUN + 2], gr[RUN];
#pragma unroll
            for (int i = 0; i < RUN + 2; ++i) zr[i] = (pos0 + i - 2 >= 0) ? *(const unsigned*)(p.z() + (size_t)(t0 + i - 2) * 512 + c) : 0u;
#pragma unroll
            for (int i = 0; i < RUN; ++i) gr[i] = *(const unsigned*)(p.ga() + (size_t)(t0 + i) * 512 + c);
#pragma unroll
            for (int i = 0; i < RUN; ++i) {
                const float y0 = (w00 * bflo(zr[i]) + w10 * bflo(zr[i + 1]) + w20 * bflo(zr[i + 2])) * bflo(gr[i]);
                const float y1 = (w01 * bfhi(zr[i]) + w11 * bfhi(zr[i + 1]) + w21 * bfhi(zr[i + 2])) * bfhi(gr[i]);
                *(unsigned*)(p.ga() + (size_t)(t0 + i) * 512 + c) = cvtpk(y0, y1);
            }
        }
        {
            const int win = 2 << (c >> 7);
            unsigned ur[RUN + 15], gr[RUN];
#pragma unroll
            for (int i = 0; i < RUN + 15; ++i) ur[i] = (i >= 16 - win && pos0 + i - 15 >= 0) ? *(const unsigned*)(p.u() + (size_t)(t0 + i - 15) * 512 + c) : 0u;
#pragma unroll
            for (int i = 0; i < RUN; ++i) gr[i] = *(const unsigned*)(p.sp() + (size_t)(t0 + i) * 512 + c);
            float s0 = 0.f, s1 = 0.f;
#pragma unroll
            for (int i = 0; i < 15; ++i) { s0 += bflo(ur[i]); s1 += bfhi(ur[i]); }
#pragma unroll
            for (int i = 0; i < RUN; ++i) {
                const int pos = pos0 + i;
                const float u0 = bflo(ur[i + 15]), u1 = bfhi(ur[i + 15]);
                s0 += u0; s1 += u1;
                const float ic = __builtin_amdgcn_rcpf((float)min(pos + 1, win));
                *(unsigned*)(p.sp() + (size_t)(t0 + i) * 512 + c) = cvtpk((s0 * ic - u0) * bflo(gr[i]), (s1 * ic - u1) * bfhi(gr[i]));
                unsigned wo = 0u;
#pragma unroll
                for (int g = 0; g < 4; ++g) if (win == (2 << g)) wo = ur[i + 15 - ((2 << g) - 1)];
                s0 -= bflo(wo); s1 -= bfhi(wo);
            }
        }
    }
}

__device__ __forceinline__ int crow(int r, int hi) { return (r & 3) + 8 * (r >> 2) + 4 * hi; }
__device__ __forceinline__ size_t sc_base(int qb) { return (size_t)32768 * qb * (qb + 1); }
__device__ __forceinline__ void phase_indexer(const Params& p, int b, u16* scbuf, char* shm) {
    const int tid_ = TID(); const int wid = tid_ >> 6, lane = tid_ & 63, ql = lane & 15, fq = lane >> 4; const int bid_ = BID(), gdim_ = GDIM();
    constexpr int NSTEP = 64 * 65;
    const int f0 = (int)(((long)bid_ * NSTEP) / gdim_), f1 = (int)(((long)(bid_ + 1) * NSTEP) / gdim_);
    int qcur = -1;
    bf16x8 bq[8][2]; float wv[8]; u16* srow = nullptr; int qloc = 0;
    char* tl = shm + 40960 + wid * 2304;
#pragma unroll
    for (int h = 0; h < 8; ++h) { wv[h] = 0.f; bq[h][0] = bq[h][1] = (bf16x8){0, 0, 0, 0, 0, 0, 0, 0}; }
    const u16* ikb = p.ik() + ((size_t)b * SEQ + ql) * 64 + fq * 8;
    for (int f = f0; f < f1; ++f) {
        int q = (int)((sqrtf(4.f * f + 1.f) - 1.f) * 0.5f);
        while ((q + 1) * (q + 2) <= f) ++q;
        while (q * (q + 1) > f) --q;
        const int tt = f - q * (q + 1);
        if (q != qcur) {
            qcur = q; qloc = q * 128 + wid * 16 + ql;
            const size_t row = (size_t)b * SEQ + qloc;
#pragma unroll
            for (int h = 0; h < 8; ++h)
#pragma unroll
                for (int kc = 0; kc < 2; ++kc) bq[h][kc] = *(const bf16x8*)(p.iq() + row * 512 + h * 64 + kc * 32 + fq * 8);
            const f32x4 x = *(const f32x4*)(p.iw() + row * 8), y = *(const f32x4*)(p.iw() + row * 8 + 4);
            wv[0] = x[0]; wv[1] = x[1]; wv[2] = x[2]; wv[3] = x[3]; wv[4] = y[0]; wv[5] = y[1]; wv[6] = y[2]; wv[7] = y[3];
            const int a = q >> 1;
            srow = scbuf + sc_base(a) + (size_t)(q * 128 + wid * 16 + (lane >> 2) - a * 256) * (256 * (a + 1)) + (lane & 3) * 16;
        }
        const int key0 = tt * 64;
        bf16x8 ka[4][2];
#pragma unroll
        for (int kg = 0; kg < 4; ++kg)
#pragma unroll
            for (int kc = 0; kc < 2; ++kc) ka[kg][kc] = *(const bf16x8*)(ikb + (size_t)(key0 + kg * 16) * 64 + kc * 32);
        const bool band = (key0 + 63 > q * 128 + wid * 16);
#pragma unroll
        for (int kg = 0; kg < 4; ++kg) {
            f32x4 sacc = (f32x4){0.f, 0.f, 0.f, 0.f};
#pragma unroll
            for (int h = 0; h < 8; ++h) {
                f32x4 c = (f32x4){0.f, 0.f, 0.f, 0.f};
                c = __builtin_amdgcn_mfma_f32_16x16x32_bf16(ka[kg][0], bq[h][0], c, 0, 0, 0);
                c = __builtin_amdgcn_mfma_f32_16x16x32_bf16(ka[kg][1], bq[h][1], c, 0, 0, 0);
#pragma unroll
                for (int j = 0; j < 4; ++j) sacc[j] = __builtin_fmaf(wv[h], __builtin_fmaxf(c[j], 0.f), sacc[j]);
            }
            const int kb = key0 + kg * 16 + fq * 4;
            if (band) {
#pragma unroll
                for (int j = 0; j < 4; ++j) if (kb + j > qloc) sacc[j] = -INFINITY;
            }
            union { _Float16 h[4]; u32x2 v; } pk;
            pk.h[0] = (_Float16)sacc[0]; pk.h[1] = (_Float16)sacc[1]; pk.h[2] = (_Float16)sacc[2]; pk.h[3] = (_Float16)sacc[3];
            *(u32x2*)(tl + ql * 144 + kg * 32 + fq * 8) = pk.v;
        }
        { const u32x4 r0 = *(const u32x4*)(tl + (lane >> 2) * 144 + (lane & 3) * 32), r1 = *(const u32x4*)(tl + (lane >> 2) * 144 + (lane & 3) * 32 + 16);
          *(u32x4*)(srow + key0) = r0; *(u32x4*)(srow + key0 + 8) = r1; }
    }
}

__device__ __forceinline__ size_t mk_base(int qb) { return (size_t)512 * qb * (qb + 1); }
constexpr size_t MASK_WORDS_PER_BATCH = 540672;
__device__ __forceinline__ unsigned f16key(unsigned h) { return (h & 0x8000u) ? (~h & 0xffffu) : (h | 0x8000u); }
__device__ __forceinline__ void hist_scan(const unsigned* h, int lane, unsigned target, int& bin, unsigned& above, unsigned& inbin) {
    const u32x4 a = *(const u32x4*)(h + 4 * lane), b = *(const u32x4*)(h + 256 + 4 * lane), c = *(const u32x4*)(h + 512 + 4 * lane), d = *(const u32x4*)(h + 768 + 4 * lane);
    const unsigned h0 = a[0] + b[0] + c[0] + d[0], h1 = a[1] + b[1] + c[1] + d[1], h2 = a[2] + b[2] + c[2] + d[2], h3 = a[3] + b[3] + c[3] + d[3];
    const unsigned tot = h0 + h1 + h2 + h3;
#define DPP_SHL(v, n) ((unsigned)__builtin_amdgcn_update_dpp(0, (int)(v), 0x100 + (n), 0xf, 0xf, true))
    unsigned x = tot;
    x += DPP_SHL(x, 1); x += DPP_SHL(x, 2); x += DPP_SHL(x, 4); x += DPP_SHL(x, 8);
#undef DPP_SHL
    { const unsigned t1 = (unsigned)__builtin_amdgcn_readlane((int)x, 16), t2 = (unsigned)__builtin_amdgcn_readlane((int)x, 32), t3 = (unsigned)__builtin_amdgcn_readlane((int)x, 48);
      const int rowi = lane >> 4;
      x += (rowi == 0) ? (t1 + t2 + t3) : (rowi == 1) ? (t2 + t3) : (rowi == 2) ? t3 : 0u; }
    const unsigned ab = x - tot, c3 = ab + h3, c2 = c3 + h2, c1 = c2 + h1, c0 = c1 + h0;
    int fb = -1; unsigned fa = 0, fc = 0;
    if (ab < target && c3 >= target) { fb = 4 * lane + 3; fa = ab; fc = h3; }
    else if (c3 < target && c2 >= target) { fb = 4 * lane + 2; fa = c3; fc = h2; }
    else if (c2 < target && c1 >= target) { fb = 4 * lane + 1; fa = c2; fc = h1; }
    else if (c1 < target && c0 >= target) { fb = 4 * lane; fa = c1; fc = h0; }
    const u64 m = __ballot(fb >= 0); const int src = (m == 0) ? 0 : (__ffsll((unsigned long long)m) - 1);
    bin = __builtin_amdgcn_readlane(fb, src); above = (unsigned)__builtin_amdgcn_readlane((int)fa, src); inbin = (unsigned)__builtin_amdgcn_readlane((int)fc, src);
}
__device__ __forceinline__ unsigned f16key2(unsigned w) { const unsigned sg = (w >> 15) & 0x00010001u; return w ^ (((sg << 15) - sg) | 0x80008000u); }
__device__ __forceinline__ void phase_select(const Params& p, int b, char* shm, const u16* scbuf) {
    const int tid_ = TID(); const int wid = __builtin_amdgcn_readfirstlane(tid_ >> 6), lane = tid_ & 63;
    const int gw = BID() * 8 + wid, nw = GDIM() * 8;
    unsigned* hist = (unsigned*)shm + wid * 1152;
    const int hsubi = (lane >> 4) * 256, dummyi = 1024 + lane;
    typedef unsigned short us2 __attribute__((ext_vector_type(2)));
#define ROW_T(i_) ({ const int kq_ = (i_) / nw; ((mirror && (kq_ & 1)) ? (kq_ * nw + (nw - 1 - ((i_) - kq_ * nw))) : (i_)); })
#define ROW_LOAD(t_) do { const int qb_ = (t_) >> 8, ntr_ = 2 * (((t_) >> 7) + 1), nch_ = (ntr_ + 7) >> 3; \
        const u16* sr_ = scbuf + sc_base(qb_) + (size_t)((t_) - qb_ * 256) * (256 * (qb_ + 1)); \
        _Pragma("unroll") for (int c = 0; c < 16; ++c) { raw[c] = (u32x4){0u, 0u, 0u, 0u}; if (c < nch_) { if (lane < 8 * (ntr_ - 8 * c)) raw[c] = *(const u32x4*)(sr_ + 512 * c + 8 * lane); } } } while (0)
    const bool mirror = (SEQ % (2 * nw)) == 0;
    u32x4 raw[16];
    if (gw < SEQ) { const int t0_ = ROW_T(gw); ROW_LOAD(t0_); }
    for (int i = gw; i < SEQ; i += nw) {
        const int t = ROW_T(i);
        const int qb = t >> 8, ntile = 4 * (qb + 1), ntr = 2 * ((t >> 7) + 1);
        const int nch = (ntr + 7) >> 3, nchw = (ntile + 7) >> 3;
        unsigned char* mrow = (unsigned char*)(p.mask() + (size_t)b * MASK_WORDS_PER_BATCH + mk_base(qb) + (size_t)(t - qb * 256) * ntile);
        unsigned key[16][4];
#pragma unroll
        for (int c = 0; c < 16; ++c) {
            const bool valid = (c < nch) && (lane < 8 * (ntr - 8 * c));
#pragma unroll
            for (int r = 0; r < 4; ++r) key[c][r] = valid ? f16key2(raw[c][r]) : 0u;
        }
        if (i + nw < SEQ) { const int tn_ = ROW_T(i + nw); ROW_LOAD(tn_); }
        unsigned thrm1 = 0x03ffu, thr = 0x0400u; int need = 0; bool fast = true;
        if (t >= 256) {
            us2 a1 = (us2){0, 0}, a2 = (us2){0, 0};
#pragma unroll
            for (int c = 0; c < 16; ++c) {
                if (c < nch) {
#pragma unroll
                    for (int r = 0; r < 4; ++r) { const us2 kk = __builtin_bit_cast(us2, key[c][r]);
                        const us2 tmx = __builtin_elementwise_max(a1, kk), tmn = __builtin_elementwise_min(a1, kk); a1 = tmx; a2 = __builtin_elementwise_max(a2, tmn); }
                }
            }
            unsigned Lb = min((unsigned)a2[0], (unsigned)a2[1]);
#define DPP_ROR(v, n) ((unsigned)__builtin_amdgcn_update_dpp((int)(v), (int)(v), 0x120 + (n), 0xf, 0xf, false))
            Lb = min(Lb, DPP_ROR(Lb, 8)); Lb = min(Lb, DPP_ROR(Lb, 4)); Lb = min(Lb, DPP_ROR(Lb, 2)); Lb = min(Lb, DPP_ROR(Lb, 1));
#undef DPP_ROR
            Lb = min(min((unsigned)__builtin_amdgcn_readlane((int)Lb, 0), (unsigned)__builtin_amdgcn_readlane((int)Lb, 16)), min((unsigned)__builtin_amdgcn_readlane((int)Lb, 32), (unsigned)__builtin_amdgcn_readlane((int)Lb, 48)));
            const u32x4 z4 = (u32x4){0u, 0u, 0u, 0u};
#pragma unroll
            for (int c = 0; c < 4; ++c) *(u32x4*)(hist + c * 256 + 4 * lane) = z4;
#pragma unroll
            for (int c = 0; c < 16; ++c) {
                if (c < nch) {
#pragma unroll
                    for (int r = 0; r < 4; ++r) { const unsigned kk = key[c][r]; const unsigned lo = kk & 0xffffu, hi = kk >> 16;
                        atomicAdd(hist + ((lo >= Lb) ? (hsubi + (int)(lo >> 8)) : dummyi), 1u);
                        atomicAdd(hist + ((hi >= Lb) ? (hsubi + (int)(hi >> 8)) : dummyi), 1u); }
                }
            }
            asm volatile("s_waitcnt lgkmcnt(0)" ::: "memory");
            int B1; unsigned ab1, in1;
            hist_scan(hist, lane, 256u, B1, ab1, in1);
            asm volatile("s_waitcnt lgkmcnt(0)" ::: "memory");
#pragma unroll
            for (int c = 0; c < 4; ++c) *(u32x4*)(hist + c * 256 + 4 * lane) = z4;
#pragma unroll
            for (int c = 0; c < 16; ++c) {
                if (c < nch) {
#pragma unroll
                    for (int r = 0; r < 4; ++r) { const unsigned kk = key[c][r]; const unsigned lo = kk & 0xffffu, hi = kk >> 16;
                        const bool ml = ((lo >> 8) == (unsigned)B1) && (lo >= Lb), mh = ((hi >> 8) == (unsigned)B1) && (hi >= Lb);
                        if (__any(ml || mh)) { if (ml) atomicAdd(hist + hsubi + (int)(lo & 255u), 1u); if (mh) atomicAdd(hist + hsubi + (int)(hi & 255u), 1u); } }
                }
            }
            asm volatile("s_waitcnt lgkmcnt(0)" ::: "memory");
            int B2; unsigned ab2, in2;
            hist_scan(hist, lane, 256u - ab1, B2, ab2, in2);
            asm volatile("s_waitcnt lgkmcnt(0)" ::: "memory");
            thr = __builtin_amdgcn_readfirstlane(((unsigned)B1 << 8) | (unsigned)B2);
            need = __builtin_amdgcn_readfirstlane(256 - (int)(ab1 + ab2));
            const int neq = __builtin_amdgcn_readfirstlane((int)in2);
            fast = (need == neq);
            thrm1 = thr - 1u;
        }
        if (fast) {
#pragma unroll
            for (int c = 0; c < 16; ++c) {
                if (c < nchw) {
                    unsigned m = 0u;
#pragma unroll
                    for (int ii = 7; ii >= 0; --ii) { const unsigned kk = key[c][ii >> 1]; const unsigned kv = (ii & 1) ? (kk >> 16) : (kk & 0xffffu); m = m + m + ((kv > thrm1) ? 1u : 0u); }
                    if (64 * c + lane < 8 * ntile) mrow[64 * c + lane] = (unsigned char)m;
                }
            }
        } else {
#define DPP_SHR(v, n) ((unsigned)__builtin_amdgcn_update_dpp(0, (int)(v), 0x110 + (n), 0xf, 0xf, true))
            int base = 0;
#pragma unroll
            for (int c = 0; c < 16; ++c) {
                if (c < nchw) {
                    unsigned m = 0u, e = 0u;
#pragma unroll
                    for (int ii = 7; ii >= 0; --ii) { const unsigned kk = key[c][ii >> 1]; const unsigned kv = (ii & 1) ? (kk >> 16) : (kk & 0xffffu); m = m + m + ((kv > thr) ? 1u : 0u); e = e + e + ((kv == thr) ? 1u : 0u); }
                    if (__any(e != 0u)) {
                        const unsigned cnt = (unsigned)__builtin_popcount(e);
                        unsigned pre = cnt;
                        pre += DPP_SHR(pre, 1); pre += DPP_SHR(pre, 2); pre += DPP_SHR(pre, 4); pre += DPP_SHR(pre, 8);
                        const unsigned t0 = (unsigned)__builtin_amdgcn_readlane((int)pre, 15), t1 = (unsigned)__builtin_amdgcn_readlane((int)pre, 31), t2 = (unsigned)__builtin_amdgcn_readlane((int)pre, 47), t3 = (unsigned)__builtin_amdgcn_readlane((int)pre, 63);
                        const int rowi = lane >> 4;
                        pre += (rowi == 1) ? t0 : (rowi == 2) ? (t0 + t1) : (rowi == 3) ? (t0 + t1 + t2) : 0u;
                        int rank = base + (int)(pre - cnt);
#pragma unroll
                        for (int ii = 0; ii < 8; ++ii) if ((e >> ii) & 1u) { if (rank < need) m |= (1u << ii); ++rank; }
                        base += (int)(t0 + t1 + t2 + t3);
                    }
                    if (64 * c + lane < 8 * ntile) mrow[64 * c + lane] = (unsigned char)m;
                }
            }
#undef DPP_SHR
        }
    }
}

constexpr int A_D = 64, A_DM = 512, A_NW = 8, A_QBLK = 32, A_QB = 256, A_KVBLK = 64, A_NQB = SEQ / A_QB, A_NHEAD = 8;
constexpr float A_C2 = 0.125f * 1.4426950408889634f;
constexpr int A_SLOTB = 8192, A_LDS_K = 0, A_LDS_V = 3 * A_SLOTB, A_LDS_WS = 6 * A_SLOTB, A_LDS_OST = A_LDS_WS + A_NW * 256, A_LDS_MK = A_LDS_OST + A_NW * 4096, A_LDS_BYTES = A_LDS_MK + A_NW * 2048;
#define ATTN_THR 8
#define SBAR() __builtin_amdgcn_sched_barrier(0)
#define PIN(x) asm volatile("" : "+v"(x))
#define MFMA32(a, b, c) __builtin_amdgcn_mfma_f32_32x32x16_bf16(a, b, c, 0, 0, 0)
#define WAIT_BAR(N) asm volatile("s_waitcnt vmcnt(" #N ") lgkmcnt(0)\n\ts_barrier" ::: "memory")
__device__ __forceinline__ void glds16s(const void* sbase, unsigned voff, unsigned lds_base) {
    unsigned sv; asm volatile("s_mov_b32 %0, m0\n\ts_mov_b32 m0, %3\n\ts_nop 0\n\tglobal_load_lds_dwordx4 %1, %2\n\ts_mov_b32 m0, %0" : "=&s"(sv) : "v"(voff), "s"(sbase), "s"(lds_base) : "memory"); }
typedef __attribute__((address_space(3))) const char* lds_cptr;
typedef short v4i16_t __attribute__((ext_vector_type(4)));
__device__ __forceinline__ void kload2(bf16x8* kf, lds_cptr kp, int d0) { kf[2 * d0] = *(const __attribute__((address_space(3))) bf16x8*)(kp + d0 * 2048); kf[2 * d0 + 1] = *(const __attribute__((address_space(3))) bf16x8*)(kp + d0 * 2048 + 512); }
__device__ __forceinline__ s16x4 vtr(lds_cptr p) { return __builtin_bit_cast(s16x4, __builtin_amdgcn_ds_read_tr16_b64_v4i16((__attribute__((address_space(3))) v4i16_t*)p)); }
#define MX3(a, b, c) __builtin_fmaxf(__builtin_fmaxf((a), (b)), (c))
__device__ __forceinline__ float rowmax(const f32x16& p0, const f32x16& p1) {
    float a = MX3(p0[0], p0[1], p1[0]), b = MX3(p0[2], p0[3], p1[1]); a = MX3(a, p1[2], p1[3]);
#pragma unroll
    for (int r = 4; r < 16; r += 4) { a = MX3(a, p0[r], p0[r + 1]); b = MX3(b, p0[r + 2], p0[r + 3]); a = MX3(a, p1[r], p1[r + 1]); b = MX3(b, p1[r + 2], p1[r + 3]); }
    float m = __builtin_fmaxf(a, b); auto rr = __builtin_amdgcn_permlane32_swap(__float_as_uint(m), __float_as_uint(m), false, false);
    return __builtin_fmaxf(__uint_as_float(rr[0]), __uint_as_float(rr[1])); }
__device__ __forceinline__ void cmask(f32x16& p0, f32x16& p1, int jb, int qrel, int hi) {
    const int kb = 64 * jb + 4 * hi;
#pragma unroll
    for (int r = 0; r < 16; ++r) { const int kv = kb + (r & 3) + 8 * (r >> 2); if (kv > qrel) p0[r] = -INFINITY; if (kv + 32 > qrel) p1[r] = -INFINITY; } }
__device__ __forceinline__ float mand(float x, unsigned w, int pos) { return __uint_as_float(__float_as_uint(x) & (unsigned)__builtin_amdgcn_sbfe((int)w, pos, 1)); }
#define BITP(i) (((i) & 3) + 8 * ((i) >> 2))

__device__ __forceinline__ void attn64_unit(int b, int h, int qb, const u16* Q, const u16* __restrict__ K, const u16* __restrict__ V, const u16* __restrict__ SG, u16* O, const u64* mrow0, char* lds) {
    const int tid = TID(), lane = tid & 63, r32 = lane & 31, hi = lane >> 5; const int wid = __builtin_amdgcn_readfirstlane(tid >> 6);
    const long rowbase = (long)b * SEQ; const int q0 = qb * A_QB, NT = (q0 + A_QB) / A_KVBLK;
    const u16* Qw = Q + (rowbase + q0 + wid * A_QBLK) * A_DM + h * A_D;
    const unsigned lds0 = (unsigned)(uintptr_t)lds; float* wsf = (float*)(lds + A_LDS_WS) + wid * 64;
    const u16* kbase = K + rowbase * A_DM + h * A_D; const u16* vbase = V + rowbase * A_DM + h * A_D;
    const unsigned koff = (unsigned)(lane * A_DM + wid * 8) * 2u;
    const unsigned voff = (unsigned)((16 * (wid & 3) + (lane >> 2)) * A_DM + (wid >> 2) * 32 + (lane & 3) * 8) * 2u;
    const unsigned kdst = lds0 + A_LDS_K + wid * 1024, vdst = lds0 + A_LDS_V + wid * 1024;
#define DMA_K(t, slot) glds16s(kbase + (long)(t) * A_KVBLK * A_DM, koff, (unsigned)__builtin_amdgcn_readfirstlane(kdst + (slot)))
#define DMA_V(t, slot) glds16s(vbase + (long)(t) * A_KVBLK * A_DM, voff, (unsigned)__builtin_amdgcn_readfirstlane(vdst + (slot)))
#define DMA_M(chunk) glds16s(mrow0 + 2 * (chunk), moff, (unsigned)__builtin_amdgcn_readfirstlane(mdst + ((chunk) & 1) * 1024))
#define MWORD(t) (*(const u64*)(lds + A_LDS_MK + wid * 2048 + (((t) >> 1) & 1) * 1024 + r32 * 16 + ((t) & 1) * 8))
    const lds_cptr vp0 = (lds_cptr)lds + A_LDS_V + ((lane >> 4) & 1) * 32 + (lane & 3) * 8 + (4 * hi + ((lane & 15) >> 2)) * 64;
    const lds_cptr kp0 = (lds_cptr)lds + A_LDS_K + hi * 1024 + r32 * 16;
    const int qrel = wid * A_QBLK + r32;
    const unsigned moff = (unsigned)(qrel * NT) * 8u;
    const unsigned mdst = lds0 + A_LDS_MK + wid * 2048;
    DMA_M(0);
    DMA_K(0, 0); DMA_V(0, 0); DMA_K(1, A_SLOTB);
    bf16x8 qr[4];
#pragma unroll
    for (int d0 = 0; d0 < 4; ++d0) qr[d0] = *reinterpret_cast<const bf16x8*>(&Qw[(long)r32 * A_DM + d0 * 16 + hi * 8]);
    float mhat = 0.f, l_reg = 0.f; f32x16 o[2]; o[0] = f32x16{}; o[1] = f32x16{};
    const f32x16 zero16 = f32x16{};
    bool resc = false;
    f32x16 pA0, pA1, pB0, pB1; bf16x8 kf[8]; s16x4 vlo[8], vhi[8]; u32x4 pw0, pw1, pw2, pw3;
    typedef unsigned u32x16 __attribute__((ext_vector_type(16)));
    u32x16 mk0, mk1;
    int sl_prev = 0, sl_cur = 0, sl_next = A_SLOTB;
    const int sh4 = 4 * hi;
#define ROT() do { sl_prev = sl_cur; sl_cur = sl_next; sl_next = (sl_next == 2 * A_SLOTB) ? 0 : sl_next + A_SLOTB; } while (0)
#define EX(v) __builtin_amdgcn_exp2f(__builtin_fmaf((v), A_C2, nmh))
#define RESC() do { if (resc) { _Pragma("unroll") for (int d_ = 0; d_ < 2; ++d_) _Pragma("unroll") for (int r = 0; r < 16; ++r) o[d_][r] *= wsf[crow(r, hi)]; } } while (0)
    DMA_K(2, 2 * A_SLOTB);
    WAIT_BAR(3);
    _Pragma("unroll") for (int d0 = 0; d0 < 4; ++d0) kload2(kf, kp0, d0);
    pA0 = MFMA32(kf[0], qr[0], zero16); pA1 = MFMA32(kf[1], qr[0], zero16); pA0 = MFMA32(kf[2], qr[1], pA0); pA1 = MFMA32(kf[3], qr[1], pA1);
    pA0 = MFMA32(kf[4], qr[2], pA0); pA1 = MFMA32(kf[5], qr[2], pA1); pA0 = MFMA32(kf[6], qr[3], pA0); pA1 = MFMA32(kf[7], qr[3], pA1);
    { const float rm = rowmax(pA0, pA1); mhat = rm * A_C2; const float nmh = -mhat;
      const u64 mw0 = MWORD(0); const unsigned wl = (unsigned)mw0 >> sh4, wh = (unsigned)(mw0 >> 32) >> sh4;
#pragma unroll
      for (int r = 0; r < 16; ++r) { pA0[r] = mand(EX(pA0[r]), wl, BITP(r)); pA1[r] = mand(EX(pA1[r]), wh, BITP(r)); } }
    WAIT_BAR(0);
    DMA_K(3, 0); DMA_V(1, A_SLOTB); ROT();
    _Pragma("unroll") for (int d0 = 0; d0 < 4; ++d0) kload2(kf, kp0 + sl_cur, d0);
    WAIT_BAR(2);
#define PKW(P, i) cvtpk(P[i], P[i + 1])
#define PAF(k) __builtin_bit_cast(bf16x8, pw##k)
#define VFR(i) (bf16x8){vlo[i][0], vlo[i][1], vlo[i][2], vlo[i][3], vhi[i][0], vhi[i][1], vhi[i][2], vhi[i][3]}
#define VRD(i) do { vlo[i] = vtr(vp_ + (((i) >> 2) * 4096 + ((i) & 3) * 1024)); vhi[i] = vtr(vp_ + (((i) >> 2) * 4096 + ((i) & 3) * 1024 + 512)); } while (0)
#define KRD(G, d0) do { if (G) { kload2(kf, kp0 + sl_next, d0); SBAR(); } } while (0)
#define GAPA(MF, a0, a1, a2, a3, W0, W1, PW, MK, WW, i) do { MF; sacc += a0; sacc += a1; sacc += a2; sacc += a3; W0; W1; \
    MK[i] = (unsigned)__builtin_amdgcn_sbfe((int)(WW), BITP(i), 1); MK[i + 1] = (unsigned)__builtin_amdgcn_sbfe((int)(WW), BITP(i + 1), 1); MK[i + 2] = (unsigned)__builtin_amdgcn_sbfe((int)(WW), BITP(i + 2), 1); MK[i + 3] = (unsigned)__builtin_amdgcn_sbfe((int)(WW), BITP(i + 3), 1); \
    PIN(PW); PIN(sacc); PIN(MK); SBAR(); } while (0)
#define MAND(x, m) __uint_as_float(__float_as_uint(x) & (m))
#define GAPB(MF, X, i, MK) do { MF; X[i] = MAND(EX(X[i]), MK[i]); X[i + 1] = MAND(EX(X[i + 1]), MK[i + 1]); X[i + 2] = MAND(EX(X[i + 2]), MK[i + 2]); X[i + 3] = MAND(EX(X[i + 3]), MK[i + 3]); PIN(X); SBAR(); } while (0)
#define STEP(C0, C1, P0, P1, t, MASK, GK, GV, GL, ML) do { SBAR(); \
    if (ML) DMA_M(((t) + 1) >> 1); \
    const u64 mw_ = MWORD(t); const unsigned wl_ = (unsigned)(mw_) >> sh4, wh_ = (unsigned)((mw_) >> 32) >> sh4; \
    const lds_cptr vp_ = vp0 + sl_prev; \
    VRD(0); SBAR(); float sacc = P0[0] + P0[1]; \
                    GAPA(C0 = MFMA32(kf[0], qr[0], zero16), P0[2], P0[3], P0[4], P0[5],     pw0[0] = PKW(P0, 0),  pw0[1] = PKW(P0, 2),  pw0, mk0, wl_, 0); \
    VRD(4); SBAR(); GAPA(C1 = MFMA32(kf[1], qr[0], zero16), P0[6], P0[7], P0[8], P0[9],     pw0[2] = PKW(P0, 4),  pw0[3] = PKW(P0, 6),  pw0, mk0, wl_, 4); \
    VRD(1); SBAR(); GAPA(C0 = MFMA32(kf[2], qr[1], C0),    P0[10], P0[11], P0[12], P0[13], pw1[0] = PKW(P0, 8),  pw1[1] = PKW(P0, 10), pw1, mk0, wl_, 8); \
    VRD(5); SBAR(); GAPA(C1 = MFMA32(kf[3], qr[1], C1),    P0[14], P0[15], P1[0], P1[1],   pw1[2] = PKW(P0, 12), pw1[3] = PKW(P0, 14), pw1, mk0, wl_, 12); \
    VRD(2); SBAR(); GAPA(C0 = MFMA32(kf[4], qr[2], C0),    P1[2], P1[3], P1[4], P1[5],     pw2[0] = PKW(P1, 0),  pw2[1] = PKW(P1, 2),  pw2, mk1, wh_, 0); \
    VRD(6); SBAR(); GAPA(C1 = MFMA32(kf[5], qr[2], C1),    P1[6], P1[7], P1[8], P1[9],     pw2[2] = PKW(P1, 4),  pw2[3] = PKW(P1, 6),  pw2, mk1, wh_, 4); \
    VRD(3); SBAR(); GAPA(C0 = MFMA32(kf[6], qr[3], C0),    P1[10], P1[11], P1[12], P1[13], pw3[0] = PKW(P1, 8),  pw3[1] = PKW(P1, 10), pw3, mk1, wh_, 8); \
    VRD(7); SBAR(); GAPA(C1 = MFMA32(kf[7], qr[3], C1),    P1[14], P1[15], 0.f, 0.f,       pw3[2] = PKW(P1, 12), pw3[3] = PKW(P1, 14), pw3, mk1, wh_, 12); \
    l_reg += sacc; \
    if (GK) DMA_K((t) + 3, sl_cur); if (GV) DMA_V((t) + 1, sl_next); \
    { const float rm = __builtin_fmaf(rowmax(C0, C1), A_C2, -mhat); resc = false; \
      if (__builtin_expect(__any(rm > (float)ATTN_THR), 0)) { const float dl = __builtin_fmaxf(rm, 0.f); mhat += dl; \
          const float f = __builtin_amdgcn_exp2f(-dl); l_reg *= f; if (hi == 0) wsf[r32] = f; resc = true; } } \
    const float nmh = -mhat; SBAR(); \
    GAPB(o[0] = MFMA32(PAF(0), VFR(0), o[0]), C0, 0, mk0);              GAPB(o[1] = MFMA32(PAF(0), VFR(4), o[1]), C0, 4, mk0); \
    KRD(GL, 0); GAPB(o[0] = MFMA32(PAF(1), VFR(1), o[0]), C0, 8, mk0);  KRD(GL, 1); GAPB(o[1] = MFMA32(PAF(1), VFR(5), o[1]), C0, 12, mk0); \
    KRD(GL, 2); GAPB(o[0] = MFMA32(PAF(2), VFR(2), o[0]), C1, 0, mk1);  KRD(GL, 3); GAPB(o[1] = MFMA32(PAF(2), VFR(6), o[1]), C1, 4, mk1); \
    GAPB(o[0] = MFMA32(PAF(3), VFR(3), o[0]), C1, 8, mk1);              GAPB(o[1] = MFMA32(PAF(3), VFR(7), o[1]), C1, 12, mk1); \
    } while (0)
    int t = 1;
    for (; t + 5 < NT; t += 2) {
        STEP(pB0, pB1, pA0, pA1, t, false, true, true, true, true);      WAIT_BAR(2); RESC(); ROT();
        STEP(pA0, pA1, pB0, pB1, t + 1, false, true, true, true, false); WAIT_BAR(2); RESC(); ROT();
    }
#define ENDW(tt) do { if ((tt) + 3 < NT) { WAIT_BAR(2); } else if ((tt) + 2 < NT) { WAIT_BAR(1); } else { WAIT_BAR(0); } } while (0)
    for (; t + 1 < NT; t += 2) {
        STEP(pB0, pB1, pA0, pA1, t, true, (t + 3 < NT), (t + 1 < NT), (t + 1 < NT), (t + 1 < NT));         ENDW(t);     RESC(); ROT();
        STEP(pA0, pA1, pB0, pB1, t + 1, true, (t + 4 < NT), (t + 2 < NT), (t + 2 < NT), false);            ENDW(t + 1); RESC(); ROT();
    }
    STEP(pB0, pB1, pA0, pA1, NT - 1, true, false, false, false, false); RESC();
    { float sacc = pB0[0] + pB0[1];
#pragma unroll
      for (int r = 2; r < 16; ++r) sacc += pB0[r];
#pragma unroll
      for (int r = 0; r < 16; ++r) sacc += pB1[r];
      l_reg += sacc;
      pw0 = (u32x4){PKW(pB0, 0), PKW(pB0, 2), PKW(pB0, 4), PKW(pB0, 6)}; pw1 = (u32x4){PKW(pB0, 8), PKW(pB0, 10), PKW(pB0, 12), PKW(pB0, 14)};
      pw2 = (u32x4){PKW(pB1, 0), PKW(pB1, 2), PKW(pB1, 4), PKW(pB1, 6)}; pw3 = (u32x4){PKW(pB1, 8), PKW(pB1, 10), PKW(pB1, 12), PKW(pB1, 14)};
      const lds_cptr vp_ = vp0 + sl_cur; _Pragma("unroll") for (int i = 0; i < 8; ++i) VRD(i);
      o[0] = MFMA32(PAF(0), VFR(0), o[0]); o[1] = MFMA32(PAF(0), VFR(4), o[1]); o[0] = MFMA32(PAF(1), VFR(1), o[0]); o[1] = MFMA32(PAF(1), VFR(5), o[1]);
      o[0] = MFMA32(PAF(2), VFR(2), o[0]); o[1] = MFMA32(PAF(2), VFR(6), o[1]); o[0] = MFMA32(PAF(3), VFR(3), o[0]); o[1] = MFMA32(PAF(3), VFR(7), o[1]); }
    { auto rr = __builtin_amdgcn_permlane32_swap(__float_as_uint(l_reg), __float_as_uint(l_reg), false, false); l_reg = __uint_as_float(rr[0]) + __uint_as_float(rr[1]); }
    if (hi == 0) wsf[32 + r32] = l_reg; asm volatile("s_waitcnt lgkmcnt(0)" ::: "memory");
    float rli[16];
#pragma unroll
    for (int r = 0; r < 16; ++r) rli[r] = __builtin_amdgcn_rcpf(wsf[32 + crow(r, hi)]);
    u16* Ow = O + (rowbase + q0 + wid * A_QBLK) * A_DM + h * A_D; const u16* Gw = SG + (rowbase + q0 + wid * A_QBLK) * A_DM + h * A_D;
    u16* stg = (u16*)(lds + A_LDS_OST) + wid * 2048;
#pragma unroll
    for (int r = 0; r < 16; ++r) { const int orow = crow(r, hi);
#pragma unroll
        for (int d0 = 0; d0 < 2; ++d0) stg[orow * 64 + d0 * 32 + r32] = f2bf(o[d0][r] * rli[r]); }
    asm volatile("s_waitcnt lgkmcnt(0)" ::: "memory");
#pragma unroll
    for (int i = 0; i < 4; ++i) { const int row = i * 8 + (lane >> 3), ch = lane & 7;
        u32x4 ov = *(const u32x4*)(stg + row * 64 + ch * 8); u32x4 gv = *(const u32x4*)(Gw + (long)row * A_DM + ch * 8); u32x4 rv;
#pragma unroll
        for (int e = 0; e < 4; ++e) rv[e] = cvtpk(bflo(ov[e]) * bflo(gv[e]), bfhi(ov[e]) * bfhi(gv[e]));
        *(u32x4*)(Ow + (long)row * A_DM + ch * 8) = rv; }
    asm volatile("s_waitcnt vmcnt(0) lgkmcnt(0)\n\ts_barrier" ::: "memory");
#undef DMA_K
#undef DMA_V
#undef DMA_M
#undef MWORD
#undef ROT
#undef EX
#undef RESC
#undef PKW
#undef PAF
#undef VFR
#undef VRD
#undef KRD
#undef ENDW
#undef GAPA
#undef GAPB
#undef MAND
#undef STEP
}
__device__ __forceinline__ void phase_attn(const Params& p, char* lds) {
    constexpr int NPAIR = A_NQB / 2, NUNIT = NBATCH * A_NHEAD * NPAIR;
    const int bid_ = BID(), gdim_ = GDIM();
    for (int u = bid_; u < NUNIT; u += gdim_) {
        const int x = u & 7, kk = u >> 3, bh = x + 8 * (kk / NPAIR), j = kk % NPAIR;
        const int b = bh / A_NHEAD, h = bh % A_NHEAD;
        const u64* mb = p.mask() + (size_t)b * MASK_WORDS_PER_BATCH;
        attn64_unit(b, h, j, p.q(), p.k(), p.v(), p.sg(), p.bin(), mb + mk_base(j), lds);
        attn64_unit(b, h, A_NQB - 1 - j, p.q(), p.k(), p.v(), p.sg(), p.bin(), mb + mk_base(A_NQB - 1 - j), lds);
    }
}

struct EpiStash {
    static constexpr bool DUPOK = false;
    u16* stash;
    __device__ __forceinline__ void operator()(const acc_t& acc, const pg8::Unit& u, int ui, int wr, int wc, int fr, int fq) const {
        const int tid_ = TID();
        u32x4* st = (u32x4*)(stash + (size_t)(u.pm * 4 + u.pn) * 65536);
        ROWS_LOOP {
#pragma unroll
            for (int bj = 0; bj < 2; ++bj) { const f32x4 v0 = acc[ai][bj][m][0], v1 = acc[ai][bj][m][1];
                u32x4 w; w[0] = cvtpk(v0[0], v0[1]); w[1] = cvtpk(v0[2], v0[3]); w[2] = cvtpk(v1[0], v1[1]); w[3] = cvtpk(v1[2], v1[3]);
                st[((ai * 4 + m) * 2 + bj) * 512 + tid_] = w; } }
    }
};
struct EpiGate {
    static constexpr bool DUPOK = false;
    const Params& p; int l; int br;
    __device__ __forceinline__ void operator()(const acc_t& acc, const pg8::Unit& u, int ui, int wr, int wc, int fr, int fq) const {
        const float* ssq = p.sumsq() + (size_t)(l & 1) * T * 16;
        const int tid_ = TID();
        const u32x4* st = (const u32x4*)(p.stash() + (size_t)(u.pm * 4 + u.pn) * 65536);
        const int cl = wc * 4 + fq;
        __shared__ float s_rstd[256];
        { if (tid_ < 256) s_rstd[tid_] = row_rstd(ssq, u.pm * 256 + tid_); __syncthreads(); }
        float rsa[8];
#pragma unroll
        for (int ix = 0; ix < 8; ++ix) rsa[ix] = s_rstd[(ix >> 2) * 128 + wr * 64 + (ix & 3) * 16 + fr];
        const char* stp = (const char*)st + (size_t)tid_ * 16;
        char* mpp = (char*)(p.merged() + (size_t)(u.pm * 256 + wr * 64 + fr) * 1024 + u.pn * 256 + 16 * cl);
        u32x4 yb = *(const u32x4*)stp, ob = (br > 0) ? *(const u32x4*)mpp : (u32x4){0u, 0u, 0u, 0u};
        ROWS_LOOP { const int ix = ai * 4 + m; const float rs = rsa[ix];
#pragma unroll
            for (int bj = 0; bj < 2; ++bj) { const f32x4 v0 = acc[ai][bj][m][0] * rs, v1 = acc[ai][bj][m][1] * rs;
                float r[8];
                r[0] = sigmf(v0[0]) * bflo(yb[0]); r[1] = sigmf(v0[1]) * bfhi(yb[0]); r[2] = sigmf(v0[2]) * bflo(yb[1]); r[3] = sigmf(v0[3]) * bfhi(yb[1]);
                r[4] = sigmf(v1[0]) * bflo(yb[2]); r[5] = sigmf(v1[1]) * bfhi(yb[2]); r[6] = sigmf(v1[2]) * bflo(yb[3]); r[7] = sigmf(v1[3]) * bfhi(yb[3]);
                if (br > 0) {
#pragma unroll
                    for (int e = 0; e < 4; ++e) { r[2 * e] += bflo(ob[e]); r[2 * e + 1] += bfhi(ob[e]); } }
                u32x4 wo; wo[0] = cvtpk(r[0], r[1]); wo[1] = cvtpk(r[2], r[3]); wo[2] = cvtpk(r[4], r[5]); wo[3] = cvtpk(r[6], r[7]);
                const char* stn = stp + 8192; char* mpn = (bj == 0) ? (mpp + 16) : (mpp - 16 + ((ix == 3) ? 80 : 16) * 2048);
                asm volatile("" : "+v"(stn), "+v"(mpn));
                if (!(ix == 7 && bj == 1)) { yb = *(const u32x4*)stn; if (br > 0) ob = *(const u32x4*)mpn; }
                *(u32x4*)mpp = wo;
                stp = stn; mpp = mpn; } }
    }
};
__device__ __forceinline__ void phase_merge(const Params& p, int l, char* shm) {
    pg8::RowOrder S{4, 512, GDIM(), BID()};
    for (int br = 0; br < 3; ++br) {
        const u16* Ain = br == 0 ? p.ga() : (br == 1 ? p.bin() : p.sp());
        const u16* Wy = (br == 0 ? p.wt_oa() : (br == 1 ? p.wt_ob() : p.wt_oc())) + (size_t)l * 1024 * 512;
        { pg8::Gemm g{Ain, Wy, T, 1024, 512}; EpiStash E{p.stash()}; pg8::gemm_phase((PG8_LAS unsigned char*)shm, g, S, E); }
        { pg8::Gemm g{p.xb(), p.wt_mg() + (size_t)l * 3072 * 1024 + (size_t)br * 1024 * 1024, T, 1024, 1024}; EpiGate E{p, l, br}; pg8::gemm_phase((PG8_LAS unsigned char*)shm, g, S, E); }
    }
}

struct EpiOut {
    static constexpr bool DUPOK = false;
    const Params& p; int l;
    __device__ __forceinline__ void ldx(size_t o, f32x4& a, f32x4& b) const {
        if (l == 0) { a = *(const f32x4*)(p.x_in + o); b = *(const f32x4*)(p.x_in + o + 4); }
        else { const u32x4 w = *(const u32x4*)(p.xb() + o); a = (f32x4){bflo(w[0]), bfhi(w[0]), bflo(w[1]), bfhi(w[1])}; b = (f32x4){bflo(w[2]), bfhi(w[2]), bflo(w[3]), bfhi(w[3])}; }
    }
    __device__ __forceinline__ void operator()(const acc_t& acc, const pg8::Unit& u, int ui, int wr, int wc, int fr, int fq) const {
        const int cl = wc * 4 + fq;
        f32x4 xb0[2], xb1[2];
#pragma unroll
        for (int bj = 0; bj < 2; ++bj) ldx((size_t)(u.pm * 256 + wr * 64 + fr) * 1024 + u.pn * 256 + 16 * cl + bj * 8, xb0[bj], xb1[bj]);
        ROWS_LOOP { const int row = ROW_OF; const int ix = ai * 4 + m; float ss = 0.f;
            f32x4 x0[2], x1[2];
#pragma unroll
            for (int bj = 0; bj < 2; ++bj) { x0[bj] = xb0[bj] + acc[ai][bj][m][0]; x1[bj] = xb1[bj] + acc[ai][bj][m][1]; }
            if (ix < 7) { const int rown = u.pm * 256 + ((ix + 1) >> 2) * 128 + wr * 64 + ((ix + 1) & 3) * 16 + fr;
#pragma unroll
                for (int bj = 0; bj < 2; ++bj) ldx((size_t)rown * 1024 + u.pn * 256 + 16 * cl + bj * 8, xb0[bj], xb1[bj]); }
#pragma unroll
            for (int bj = 0; bj < 2; ++bj) { const size_t o = (size_t)row * 1024 + u.pn * 256 + 16 * cl + bj * 8;
                if (l == NL - 1) { *(f32x4*)(p.x + o) = x0[bj]; *(f32x4*)(p.x + o + 4) = x1[bj]; }
                else { u32x4 w; w[0] = cvtpk(x0[bj][0], x0[bj][1]); w[1] = cvtpk(x0[bj][2], x0[bj][3]); w[2] = cvtpk(x1[bj][0], x1[bj][1]); w[3] = cvtpk(x1[bj][2], x1[bj][3]); *(u32x4*)(p.xb() + o) = w;
#pragma unroll
                    for (int j = 0; j < 4; ++j) ss += x0[bj][j] * x0[bj][j] + x1[bj][j] * x1[bj][j]; } }
            if (l < NL - 1) { ss += __shfl_xor(ss, 16); ss += __shfl_xor(ss, 32); if (fq == 0) p.sumsq()[(size_t)((l + 1) & 1) * T * 16 + (size_t)row * 16 + u.pn * 4 + wc] = ss; } }
    }
};
__device__ __forceinline__ void phase_out(const Params& p, int l, char* shm) {
    pg8::RowOrder S{4, 512, GDIM(), BID()};
    pg8::Gemm g{p.merged(), p.wt_o() + (size_t)l * 1024 * 1024, T, 1024, 1024};
    EpiOut E{p, l};
    pg8::gemm_phase((PG8_LAS unsigned char*)shm, g, S, E);
}

enum { PH_PREP0 = 0, PH_IN, PH_MIX, PH_IDX, PH_SEL, PH_ATTN, PH_MERGE, PH_OUT };
template <int PH> __global__ __launch_bounds__(NTHR) void k_phase(Params p, int l, int b) {
    extern __shared__ __attribute__((aligned(16))) char shm[];
    if (PH == PH_PREP0) phase_prep0(p, shm);
    if (PH == PH_IN) phase_in(p, l, shm);
    if (PH == PH_MIX) phase_mix(p, l);
    if (PH == PH_IDX) phase_indexer(p, b, p.scores(), shm);
    if (PH == PH_SEL) phase_select(p, b, shm, p.scores());
    if (PH == PH_ATTN) phase_attn(p, shm);
    if (PH == PH_MERGE) phase_merge(p, l, shm);
    if (PH == PH_OUT) phase_out(p, l, shm);
}

#define XB_TMO      128
#define XB_XCNT(j)  (256  + 64 * (j))
#define XB_XSUB(j)  (1280 + 64 * (j))
#define XB_XGEN(j)  (2304 + 64 * (j))
#define XB_TOP      3328
#define XB_TOPGEN   3392
#define XCD_BAR_WORDS 3456
#define XB_SPIN_CAP (1u << 22)
#define LAS __attribute__((address_space(3)))
__device__ __forceinline__ unsigned xb_ld(unsigned* p)              { return __hip_atomic_load(p, __ATOMIC_RELAXED, __HIP_MEMORY_SCOPE_AGENT); }
__device__ __forceinline__ unsigned xb_add(unsigned* p, unsigned v) { return __hip_atomic_fetch_add(p, v, __ATOMIC_RELAXED, __HIP_MEMORY_SCOPE_AGENT); }
__device__ __forceinline__ unsigned xb_xcc_id() { return (unsigned)__builtin_amdgcn_s_getreg((3 << 11) | 20) & 0xFu; }
#define XB_SPIN(cond, bar) do { unsigned _sp = 0; while (cond) { __builtin_amdgcn_s_sleep(1); \
    if ((++_sp & 255u) == 0u) { if (xb_ld(&(bar)[XB_TMO])) break; if (_sp > XB_SPIN_CAP) { atomicAdd(&(bar)[XB_TMO], 1u); break; } } } } while (0)
struct XcdBarrier { unsigned* bar; unsigned x; volatile LAS unsigned* st; };
__device__ __forceinline__ XcdBarrier xcd_barrier_post(unsigned* bar, volatile LAS unsigned* st) {
    XcdBarrier b; b.bar = bar; b.x = xb_xcc_id(); b.st = st;
    if (threadIdx.x == 0) (void)xb_add(&bar[XB_XCNT(b.x)], 1u);
    return b;
}
__device__ __forceinline__ void xcd_barrier_complete(unsigned* bar, unsigned x, unsigned& nloc, unsigned& nx) {
    const unsigned G = gridDim.x * gridDim.y * gridDim.z;
    unsigned sum, cnt, mine, sp = 0u;
    for (;;) {
        sum = 0u; cnt = 0u; mine = 0u;
#pragma unroll
        for (unsigned j = 0; j < 16; ++j) { const unsigned c = xb_ld(&bar[XB_XCNT(j)]); sum += c; cnt += (c > 0u) ? 1u : 0u; mine = (j == x) ? c : mine; }
        if (sum == G) break;
        __builtin_amdgcn_s_sleep(1);
        if ((++sp & 255u) == 0u) { if (xb_ld(&bar[XB_TMO])) break; if (sp > XB_SPIN_CAP) { atomicAdd(&bar[XB_TMO], 1u); break; } }
    }
    nloc = mine > 0u ? mine : 1u; nx = cnt > 0u ? cnt : 1u;
}
__device__ __forceinline__ void xcd_barrier(const XcdBarrier& b) {
    asm volatile("s_waitcnt vmcnt(0)" ::: "memory");
    __syncthreads();
    if (threadIdx.x == 0) {
        unsigned* bar = b.bar;
        __builtin_amdgcn_s_waitcnt(0);
        unsigned nloc = b.st[0], nx = b.st[1];
        if (nloc == 0u) { xcd_barrier_complete(bar, b.x, nloc, nx); b.st[0] = nloc; b.st[1] = nx; }
        const unsigned old = xb_add(&bar[XB_XSUB(b.x)], 1u);
        const unsigned gen = old / nloc;
        if (old + 1u == (gen + 1u) * nloc) {
            __builtin_amdgcn_fence(__ATOMIC_RELEASE, "agent");
            asm volatile("s_waitcnt vmcnt(0)" ::: "memory");
            const unsigned og = xb_add(&bar[XB_TOP], 1u);
            const unsigned tg = og / nx;
            if (og + 1u == (tg + 1u) * nx) xb_add(&bar[XB_TOPGEN], 1u);
            else XB_SPIN(xb_ld(&bar[XB_TOPGEN]) == tg, bar);
            __builtin_amdgcn_fence(__ATOMIC_ACQUIRE, "agent");
            xb_add(&bar[XB_XGEN(b.x)], 1u);
            asm volatile("s_waitcnt vmcnt(0)" ::: "memory");
        } else {
            XB_SPIN(xb_ld(&bar[XB_XGEN(b.x)]) == gen, bar);
            __builtin_amdgcn_fence(__ATOMIC_ACQUIRE, "agent");
            asm volatile("s_waitcnt vmcnt(0)" ::: "memory");
        }
    }
    __syncthreads();
}

#if MEGA
typedef const __attribute__((address_space(4))) Params* kparams_t;
__device__ __forceinline__ Params load_params(kparams_t k) {
    Params q; q.x_in = k->x_in; q.norm_g = k->norm_g; q.w_in = k->w_in; q.conv_w = k->conv_w; q.w_out_conv = k->w_out_conv; q.q_g = k->q_g; q.k_g = k->k_g; q.w_out_attn = k->w_out_attn;
    q.pool_w = k->pool_w; q.pool_scale = k->pool_scale; q.w_out_pool = k->w_out_pool; q.w_o = k->w_o; q.x = k->x; q.ws = k->ws; return q; }
#define PHP(q) kparams_t kq_##q = kp; asm volatile("" : "+s"(kq_##q)); const Params q = load_params(kq_##q);
__global__ __launch_bounds__(NTHR) void k_mega(Params p_unused) {
    extern __shared__ __attribute__((aligned(16))) char shm[];
    cg::grid_group grid = cg::this_grid();
    kparams_t kp = (kparams_t)__builtin_amdgcn_kernarg_segment_ptr();
    __shared__ uint4 xb_words;
    if (threadIdx.x == 0) xb_words = make_uint4(0u, 0u, 0u, 0u);
    __syncthreads();
    const XcdBarrier xb = xcd_barrier_post((unsigned*)(kp->ws + WS_BAR), (volatile LAS unsigned*)&xb_words);

#ifndef SK_PREP
        { PHP(p) phase_prep0(p, shm); }
#endif
#ifdef DUP_PREP
        { PHP(p) phase_prep0(p, shm); }
#endif

    grid.sync();
    for (int l = 0; l < NL; ++l) {

#ifndef SK_IN
        { PHP(p) phase_in(p, l, shm); }
#endif
#ifdef DUP_IN
        { PHP(p) phase_in(p, l, shm); }
#endif

        xcd_barrier(xb);

        { PHP(p) phase_mix(p, l); phase_indexer(p, 0, p.scores(), shm); }
        xcd_barrier(xb);
        const bool wlo = __builtin_amdgcn_readfirstlane(TID() >> 6) < 4;
        { PHP(p) if (wlo) { phase_indexer(p, 1, p.scores2(), shm); phase_select(p, 0, shm, p.scores()); } else { phase_select(p, 0, shm, p.scores()); phase_indexer(p, 1, p.scores2(), shm); } }
        xcd_barrier(xb);
        { PHP(p) if (wlo) { phase_indexer(p, 2, p.scores(), shm); phase_select(p, 1, shm, p.scores2()); } else { phase_select(p, 1, shm, p.scores2()); phase_indexer(p, 2, p.scores(), shm); } }
        xcd_barrier(xb);
        { PHP(p) if (wlo) { phase_indexer(p, 3, p.scores2(), shm); phase_select(p, 2, shm, p.scores()); } else { phase_select(p, 2, shm, p.scores()); phase_indexer(p, 3, p.scores2(), shm); } }
        xcd_barrier(xb);
        { PHP(p) phase_select(p, 3, shm, p.scores2()); }
        xcd_barrier(xb);
#ifndef SK_ATTN
        { PHP(p) phase_attn(p, shm); }
#endif
#ifdef DUP_ATTN
        { PHP(p) phase_attn(p, shm); }
#endif

        xcd_barrier(xb);

#ifndef SK_MERGE
        { PHP(p) phase_merge(p, l, shm); }
#endif
#ifdef DUP_MERGE
        { PHP(p) phase_merge(p, l, shm); }
#endif

        xcd_barrier(xb);

#ifndef SK_OUT
        { PHP(p) phase_out(p, l, shm); }
#endif

        xcd_barrier(xb);
    }
}
#endif

static Params make_params(void* const* d_in, void* d_out, void* d_ws) {
    Params p{};
    p.x_in = (const float*)d_in[0]; p.norm_g = (const float*)d_in[1]; p.w_in = (const float*)d_in[2]; p.conv_w = (const float*)d_in[3];
    p.w_out_conv = (const float*)d_in[4]; p.q_g = (const float*)d_in[5]; p.k_g = (const float*)d_in[6]; p.w_out_attn = (const float*)d_in[7];
    p.pool_w = (const float*)d_in[8]; p.pool_scale = (const float*)d_in[9]; p.w_out_pool = (const float*)d_in[10]; p.w_o = (const float*)d_in[11];
    p.x = (float*)d_out; p.ws = (char*)d_ws;
    return p;
}

extern "C" void kernel_launch(void* const* d_in, const int* in_sizes, int n_in, void* d_out, int out_size, void* d_ws, size_t ws_size, hipStream_t stream) {
    if (ws_size < WS_NEEDED) { fprintf(stderr, "workspace too small: %zu < %zu\n", ws_size, (size_t)WS_NEEDED); return; }
    Params p = make_params(d_in, d_out, d_ws);
    static int grid = 0;
    if (!grid) { int dev = 0, cus = 0; hipGetDevice(&dev); hipDeviceGetAttribute(&cus, hipDeviceAttributeMultiprocessorCount, dev); if (cus <= 0 || cus > 256) cus = 256; grid = (cus / 8) * 8; }
#if MEGA
    static bool attr = false;
    if (!attr) { hipFuncSetAttribute((const void*)k_mega, hipFuncAttributeMaxDynamicSharedMemorySize, LDS_BYTES); attr = true; }
    hipMemsetAsync((char*)d_ws + WS_BAR, 0, 16384, stream);
    void* args[] = {&p};
    hipError_t e = hipLaunchCooperativeKernel((void*)k_mega, dim3(grid), dim3(NTHR), args, LDS_BYTES, stream);
    if (e != hipSuccess) fprintf(stderr, "cooperative launch failed: %s\n", hipGetErrorString(e));
#else
    static bool attr = false;
    if (!attr) {
        hipFuncSetAttribute((const void*)k_phase<PH_PREP0>, hipFuncAttributeMaxDynamicSharedMemorySize, LDS_BYTES);
        hipFuncSetAttribute((const void*)k_phase<PH_IN>, hipFuncAttributeMaxDynamicSharedMemorySize, LDS_BYTES);
        hipFuncSetAttribute((const void*)k_phase<PH_MIX>, hipFuncAttributeMaxDynamicSharedMemorySize, LDS_BYTES);
        hipFuncSetAttribute((const void*)k_phase<PH_IDX>, hipFuncAttributeMaxDynamicSharedMemorySize, LDS_BYTES);
        hipFuncSetAttribute((const void*)k_phase<PH_SEL>, hipFuncAttributeMaxDynamicSharedMemorySize, LDS_BYTES);
        hipFuncSetAttribute((const void*)k_phase<PH_ATTN>, hipFuncAttributeMaxDynamicSharedMemorySize, LDS_BYTES);
        hipFuncSetAttribute((const void*)k_phase<PH_MERGE>, hipFuncAttributeMaxDynamicSharedMemorySize, LDS_BYTES);
        hipFuncSetAttribute((const void*)k_phase<PH_OUT>, hipFuncAttributeMaxDynamicSharedMemorySize, LDS_BYTES);
        attr = true;
    }
#define LAUNCH(PH, l, b) hipLaunchKernelGGL(k_phase<PH>, dim3(grid), dim3(NTHR), LDS_BYTES, stream, p, l, b)
    LAUNCH(PH_PREP0, 0, 0);
    for (int l = 0; l < NL; ++l) {
        LAUNCH(PH_IN, l, 0);
        LAUNCH(PH_MIX, l, 0);
        for (int b = 0; b < NBATCH; ++b) { LAUNCH(PH_IDX, l, b); LAUNCH(PH_SEL, l, b); }
        LAUNCH(PH_ATTN, l, 0);
        LAUNCH(PH_MERGE, l, 0);
        LAUNCH(PH_OUT, l, 0);
    }
#endif
}
```

```cpp
#include <hip/hip_runtime.h>
#include <hip/hip_cooperative_groups.h>
#include <stdint.h>
#include <stdio.h>
namespace cg = cooperative_groups;

typedef unsigned short u16;
typedef unsigned long long u64;
typedef __attribute__((ext_vector_type(8))) short bf16x8;
typedef __attribute__((ext_vector_type(4))) short s16x4;
typedef __attribute__((ext_vector_type(4))) float f32x4;
typedef __attribute__((ext_vector_type(16))) float f32x16;
typedef __attribute__((ext_vector_type(4))) unsigned u32x4;
typedef __attribute__((ext_vector_type(2))) unsigned u32x2;

#ifndef MEGA
#define MEGA 1
#endif
__device__ __forceinline__ int TID() { int t = threadIdx.x; asm volatile("" : "+v"(t)); return t; }
__device__ __forceinline__ int BID() { int t = blockIdx.x; asm volatile("" : "+s"(t)); return t; }
__device__ __forceinline__ int GDIM() { int t = gridDim.x; asm volatile("" : "+s"(t)); return t; }

constexpr int SEQ = 8192, NBATCH = 4, T = NBATCH * SEQ, DMODEL = 1024, NL = 4, INW = 8776;
constexpr int NPA = 5888;
constexpr int NTHR = 512;
constexpr int LDS_BYTES = 131072;
constexpr float RMS_EPS = 1e-6f;

struct Params {
    const float *x_in, *norm_g, *w_in, *conv_w, *w_out_conv, *q_g, *k_g, *w_out_attn, *pool_w, *pool_scale, *w_out_pool, *w_o;
    float* x; char* ws;
    __device__ __forceinline__ u16* xb() const { return (u16*)(ws + 0ull); }
    __device__ __forceinline__ u16* ga() const { return (u16*)(ws + 67108864ull); }
    __device__ __forceinline__ u16* q() const { return (u16*)(ws + 100663296ull); }
    __device__ __forceinline__ u16* k() const { return (u16*)(ws + 134217728ull); }
    __device__ __forceinline__ u16* v() const { return (u16*)(ws + 167772160ull); }
    __device__ __forceinline__ u16* sg() const { return (u16*)(ws + 201326592ull); }
    __device__ __forceinline__ u16* iq() const { return (u16*)(ws + 234881024ull); }
    __device__ __forceinline__ u16* sp() const { return (u16*)(ws + 268435456ull); }
    __device__ __forceinline__ u16* z() const { return (u16*)(ws + 301989888ull); }
    __device__ __forceinline__ u16* u() const { return (u16*)(ws + 335544320ull); }
    __device__ __forceinline__ u16* zuspare() const { return (u16*)(ws + 369098752ull); }
    __device__ __forceinline__ u16* ik() const { return (u16*)(ws + 371195904ull); }
    __device__ __forceinline__ float* iw() const { return (float*)(ws + 375390208ull); }
    __device__ __forceinline__ u16* wt_in() const { return (u16*)(ws + 376438784ull); }
    __device__ __forceinline__ u16* wt_mg() const { return (u16*)(ws + 424673280ull); }
    __device__ __forceinline__ u16* wt_oa() const { return (u16*)(ws + 449839104ull); }
    __device__ __forceinline__ u16* wt_ob() const { return (u16*)(ws + 454033408ull); }
    __device__ __forceinline__ u16* wt_oc() const { return (u16*)(ws + 458227712ull); }
    __device__ __forceinline__ u16* wt_o() const { return (u16*)(ws + 462422016ull); }
    __device__ __forceinline__ float* ropec() const { return (float*)(ws + 470810624ull); }
    __device__ __forceinline__ float* ropes() const { return (float*)(ws + 471859200ull); }
    __device__ __forceinline__ float* sumsq() const { return (float*)(ws + 472907776ull); }
    __device__ __forceinline__ u64* mask() const { return (u64*)(ws + 477102080ull); }
    __device__ __forceinline__ u16* scores() const { return (u16*)(ws + 494403584ull); }
    __device__ __forceinline__ u16* scores2() const { return z(); }
    __device__ __forceinline__ u16* stash() const { return scores(); }
    __device__ __forceinline__ u16* merged() const { return q(); }
    __device__ __forceinline__ u16* bin() const { return iq(); }
};
constexpr size_t WS_BAR = 563609600ull;
constexpr size_t WS_NEEDED = WS_BAR + 16384;


__device__ __forceinline__ unsigned cvtpk(float lo, float hi) { unsigned r; asm("v_cvt_pk_bf16_f32 %0, %1, %2" : "=v"(r) : "v"(lo), "v"(hi)); return r; }
__device__ __forceinline__ u16 f2bf(float f) { return (u16)(cvtpk(f, 0.f) & 0xffffu); }
__device__ __forceinline__ float bf2f(u16 b) { return __uint_as_float(((unsigned)b) << 16); }
__device__ __forceinline__ float bflo(unsigned w) { return __uint_as_float(w << 16); }
__device__ __forceinline__ float bfhi(unsigned w) { return __uint_as_float(w & 0xffff0000u); }
__device__ __forceinline__ float siluf(float x) { return x * __builtin_amdgcn_rcpf(1.f + __builtin_amdgcn_exp2f(x * -1.4426950408889634f)); }
__device__ __forceinline__ float sigmf(float x) { return __builtin_amdgcn_rcpf(1.f + __builtin_amdgcn_exp2f(x * -1.4426950408889634f)); }

__device__ __forceinline__ float row_rstd(const float* ssp, int row) {
    const f32x4* q = (const f32x4*)(ssp + (size_t)row * 16);
    const f32x4 a = q[0], b = q[1], c = q[2], d = q[3];
    const float s = ((a[0] + a[1]) + (a[2] + a[3])) + ((b[0] + b[1]) + (b[2] + b[3])) + ((c[0] + c[1]) + (c[2] + c[3])) + ((d[0] + d[1]) + (d[2] + d[3]));
    return __builtin_amdgcn_rsqf(s * (1.f / 1024.f) + RMS_EPS);
}
__device__ __forceinline__ int lc_of_tc(int tc) { int bj = tc >> 7, wc = (tc >> 5) & 3, n = (tc >> 4) & 1, fq = (tc >> 2) & 3, j = tc & 3; return ((wc * 4 + fq) << 4) + bj * 8 + n * 4 + j; }
__device__ __forceinline__ int tc_of_lc(int lc) { int cl = lc >> 4, s = lc & 15, wc = cl >> 2, fq = cl & 3, bj = s >> 3, n = (s >> 2) & 1, j = s & 3; return bj * 128 + wc * 32 + n * 16 + fq * 4 + j; }

__device__ __forceinline__ int src_col_in(int np) {
    int pn = np >> 8, tc = np & 255;
    int bj = tc >> 7, wc = (tc >> 5) & 3, n = (tc >> 4) & 1, fq = (tc >> 2) & 3, j = tc & 3, cl = wc * 4 + fq, s = bj * 8 + n * 4 + j, lc = cl * 16 + s;
    int d = (s < 8) ? (8 * fq + s) : (8 * fq + 32 + (s - 8));
    if (pn < 8) return (s & 3) * 512 + pn * 64 + cl * 4 + (s >> 2);
    if (pn < 12) { int which = (pn - 8) >> 1, head = ((pn - 8) & 1) * 4 + wc; return 2048 + which * 512 + head * 64 + d; }
    if (pn < 14) return 3072 + (pn - 12) * 256 + lc;
    if (pn < 16) return 3584 + (pn - 14) * 256 + lc;
    if (pn < 18) { int head = (pn - 16) * 4 + wc; return 4096 + head * 64 + d; }
    if (pn == 18) { if (wc == 0) return 4608 + d; if (wc == 1 && fq == 0 && s < 8) return 4672 + s; return -1; }
    if (pn < 21) return -2;
    return 5192 + (pn - 21) * 256 + lc;
}

__device__ __forceinline__ void prep_x(const Params& p) {
    const int tid_ = TID(); const int lane = tid_ & 63, gw = BID() * (NTHR / 64) + (tid_ >> 6), nw = GDIM() * (NTHR / 64);
    for (int row0 = gw * 4; row0 < T; row0 += nw * 4) {
        float4 v[4][4];
#pragma unroll
        for (int r = 0; r < 4; ++r)
#pragma unroll
            for (int i = 0; i < 4; ++i) v[r][i] = ((const float4*)(p.x_in + (size_t)(row0 + r) * DMODEL))[i * 64 + lane];
        float ss[4];
#pragma unroll
        for (int r = 0; r < 4; ++r) { ss[r] = 0.f;
#pragma unroll
            for (int i = 0; i < 4; ++i) { const float4 q = v[r][i]; ss[r] += q.x * q.x + q.y * q.y + q.z * q.z + q.w * q.w;
                u32x2 o; o[0] = cvtpk(q.x, q.y); o[1] = cvtpk(q.z, q.w);
                *(u32x2*)(p.xb() + (size_t)(row0 + r) * DMODEL + (i * 64 + lane) * 4) = o; } }
#pragma unroll
        for (int m = 32; m >= 1; m >>= 1) {
#pragma unroll
            for (int r = 0; r < 4; ++r) ss[r] += __shfl_xor(ss[r], m); }
        if (lane < 16) {
#pragma unroll
            for (int r = 0; r < 4; ++r) p.sumsq()[(size_t)(row0 + r) * 16 + lane] = (lane == 0) ? ss[r] : 0.f; }
    }
}
__device__ __forceinline__ void prep_rope(const Params& p) {
    const int i0 = BID() * NTHR + TID(), istep = GDIM() * NTHR;
    for (int i = i0; i < SEQ * 32; i += istep) {
        int pos = i >> 5, j = i & 31;
        float inv = 1.0f / powf(10000.0f, (float)(2 * j) / 64.0f);
        float ang = (float)pos * inv;
        p.ropec()[i] = cosf(ang); p.ropes()[i] = sinf(ang);
    }
}
__device__ __forceinline__ void prep_wt(const float* src, int lds_, const float* scale, u16* dst, int K, int NP, int mode, float* tile) {
    const int tid_ = TID(); const int tx = tid_ & 63, ty = tid_ >> 6; const int bid_ = BID(), gdim_ = GDIM();
    const int ntn = NP / 64, ntk = K / 64;
    for (int t = bid_; t < ntn * ntk; t += gdim_) {
        const int n0 = (t / ntk) * 64, k0 = (t % ntk) * 64;
        int np = n0 + tx, col;
        if (mode == 0) col = src_col_in(np);
        else if (mode == 1) col = 5704 + (np & ~255) + lc_of_tc(np & 255);
        else col = (np & ~255) + lc_of_tc(np & 255);
        __syncthreads();
#pragma unroll
        for (int i = 0; i < 8; ++i) { int kk = ty + 8 * i; tile[kk * 65 + tx] = (col >= 0) ? src[(size_t)(k0 + kk) * lds_ + col] : 0.f; }
        __syncthreads();
        const float sc = scale ? scale[k0 + tx] : 1.f;
#pragma unroll
        for (int i = 0; i < 8; ++i) {
            int nn = ty + 8 * i; int npo = n0 + nn;
            bool skip = (mode == 0) && ((npo >> 8) == 19 || (npo >> 8) == 20);
            if (!skip) dst[(size_t)npo * K + k0 + tx] = f2bf(tile[tx * 65 + nn] * sc);
        }
    }
}
__device__ __forceinline__ void prep_fold(const float* win, const float* ng, const float* pw, u16* wt_in) {
    const int i0 = BID() * NTHR + TID(), istep = GDIM() * NTHR;
    for (int i = i0; i < 1024 * 512; i += istep) {
        int k = i >> 9, n = i & 511, g = n >> 7, d = n & 127;
        const float* wr = win + (size_t)k * INW + 4680 + g * 128;
        const float* pp = pw + (size_t)g * 128 * 128 + d;
        float acc = 0.f;
        for (int c = 0; c < 128; ++c) acc += wr[c] * pp[c * 128];
        int row = (19 + (n >> 8)) * 256 + tc_of_lc(n & 255);
        wt_in[(size_t)row * 1024 + k] = f2bf(acc * ng[k]);
    }
}
__device__ __forceinline__ void phase_prep0(const Params& p, char* shm) {
    prep_x(p); prep_rope(p);
    float* tile = (float*)shm;
    for (int l = 0; l < NL; ++l) {
        const float* ng = p.norm_g + l * 1024;
        const float* win = p.w_in + (size_t)l * 1024 * INW;
        prep_wt(win, INW, ng, p.wt_in() + (size_t)l * NPA * 1024, 1024, NPA, 0, tile);
        prep_wt(win, INW, ng, p.wt_mg() + (size_t)l * 3072 * 1024, 1024, 3072, 1, tile);
        prep_wt(p.w_out_conv + (size_t)l * 512 * 1024, 1024, nullptr, p.wt_oa() + (size_t)l * 1024 * 512, 512, 1024, 2, tile);
        prep_wt(p.w_out_attn + (size_t)l * 512 * 1024, 1024, nullptr, p.wt_ob() + (size_t)l * 1024 * 512, 512, 1024, 2, tile);
        prep_wt(p.w_out_pool + (size_t)l * 512 * 1024, 1024, nullptr, p.wt_oc() + (size_t)l * 1024 * 512, 512, 1024, 2, tile);
        prep_wt(p.w_o + (size_t)l * 1024 * 1024, 1024, nullptr, p.wt_o() + (size_t)l * 1024 * 1024, 1024, 1024, 3, tile);
        prep_fold(win, ng, p.pool_w + (size_t)l * 4 * 128 * 128, p.wt_in() + (size_t)l * NPA * 1024);
    }
}

namespace pg8 {
#define PG8_LAS __attribute__((address_space(3)))
typedef unsigned short bf16_t;
constexpr int BM = 256, BK = 64, HALF = 128, HTB = HALF * BK * 2, STAGE_BYTES = 8 * HTB;
__device__ __forceinline__ int lds_byte(int r, int c) { const int st = (r >> 4) * 2 + (c >> 5), rr = r & 15, cc = c & 31, ob = rr * 64 + cc * 2; return st * 1024 + (ob ^ (((ob >> 9) & 1) << 5)); }
__device__ __forceinline__ void stage_rc(int b, int& R, int& C) { const int st = b / 1024, sb = b % 1024, swz = sb ^ (((sb >> 9) & 1) << 5); R = (st >> 1) * 16 + swz / 64; C = (st & 1) * 32 + (swz % 64) / 2; }
struct Unit { int pm, pn; };
struct Gemm { const bf16_t* A; const bf16_t* Bt; int M, N, K; };
constexpr int NXCD = 8, WGM = 8;
struct StaticOrder {
    int nM, nN, nwg, G, c;
    __device__ void init(int M, int N, int G_, int c_) { nM = M / BM; nN = N / BM; nwg = nM * nN; G = G_; c = c_; }
    __device__ bool next(int i, Unit& u) const {
        const long L = (long)i * G + c; if (L >= nwg) return false;
        int wgid = (int)L; { const int q = nwg / NXCD, r = nwg % NXCD, xcd = wgid % NXCD, off = wgid / NXCD; wgid = (xcd < r ? xcd * (q + 1) : r * (q + 1) + (xcd - r) * q) + off; }
        const int nig = WGM * nN, gid = wgid / nig, fm = gid * WGM, gsz = (nM - fm) < WGM ? (nM - fm) : WGM;
        u.pm = fm + ((wgid % nig) % gsz); u.pn = (wgid % nig) / gsz; return true;
    }
};
struct RowOrder {
    int nN, ntile, G, c;
    __device__ bool next(int i, Unit& u) const {
        const int x = c & 7, lt = (c >> 3) + (G >> 3) * i;
        const int quad = lt >> 2, pm = quad * 8 + x;
        if (pm * 4 >= ntile) return false;
        u.pm = pm; u.pn = lt & 3; return true; }
};
template <class Epi, class Sched>
__device__ __forceinline__ void gemm_phase(PG8_LAS unsigned char* lds, const Gemm g, const Sched& S, const Epi& E) {
    const int tid = TID(), wid = __builtin_amdgcn_readfirstlane(tid >> 6), lane = tid & 63, wr = wid >> 2, wc = wid & 3, fr = lane & 15, fq = lane >> 4;
    const int K = g.K, nt = K / BK;
    unsigned voffA[2], voffB[2];
#pragma unroll
    for (int i = 0; i < 2; ++i) { int R, C; stage_rc(tid * 16 + i * 8192, R, C); voffA[i] = (unsigned)(R * K + C) * 2u; voffB[i] = voffA[i]; }
    const size_t kstep = (size_t)(BK * 2);
    const size_t hstep = (size_t)HALF * K * 2;
    const size_t tstep = 2 * hstep;
    const unsigned ldsw = (unsigned)wid * 1024u;
    const int aoff = lds_byte(wr * 64 + fr, fq * 8), boff = lds_byte(wc * 32 + fr, fq * 8);
#define PG8_SA(b, h) (((b) * 2 + (h)) * HTB)
#define PG8_SB(b, h) ((4 + (b) * 2 + (h)) * HTB)
#define PG8_STAGE(bufoff, gbase, voff) do { _Pragma("unroll") for (int _i = 0; _i < 2; ++_i) \
        __builtin_amdgcn_global_load_lds((const unsigned*)((const char*)(gbase) + (voff)[_i]), (PG8_LAS unsigned*)(lds + (bufoff) + ldsw + _i * 8192), 16, 0, 0); } while (0)
#define PG8_LDA(dst, b, h) do { _Pragma("unroll") for (int m = 0; m < 4; ++m) _Pragma("unroll") for (int k = 0; k < 2; ++k) dst[m][k] = *(const PG8_LAS bf16x8*)(lds + PG8_SA(b, h) + aoff + m * 2048 + k * 1024); } while (0)
#define PG8_LDB(dst, b, h) do { _Pragma("unroll") for (int n = 0; n < 2; ++n) _Pragma("unroll") for (int k = 0; k < 2; ++k) dst[n][k] = *(const PG8_LAS bf16x8*)(lds + PG8_SB(b, h) + boff + n * 2048 + k * 1024); } while (0)
#define PG8_MMA(ai, bj, At, Bt) do { __builtin_amdgcn_s_setprio(1); _Pragma("unroll") for (int m = 0; m < 4; ++m) _Pragma("unroll") for (int n = 0; n < 2; ++n) _Pragma("unroll") for (int k = 0; k < 2; ++k) \
        acc[ai][bj][m][n] = __builtin_amdgcn_mfma_f32_16x16x32_bf16(Bt[n][k], At[m][k], acc[ai][bj][m][n], 0, 0, 0); __builtin_amdgcn_s_setprio(0); } while (0)
#define PG8_WAIT_V(n) asm volatile("s_waitcnt vmcnt(" #n ")" ::: "memory")
#define PG8_WAIT_L(n) asm volatile("s_waitcnt lgkmcnt(" #n ")" ::: "memory")
#define PG8_BAR __builtin_amdgcn_s_barrier()
#define PG8_SCHED __builtin_amdgcn_sched_barrier(0)
    Unit cur, nxt; int ui = 0;
    if (!S.next(0, cur)) return;
    f32x4 acc[2][2][4][2];
#pragma unroll
    for (int a = 0; a < 2; ++a)
#pragma unroll
        for (int b = 0; b < 2; ++b)
#pragma unroll
            for (int m = 0; m < 4; ++m)
#pragma unroll
                for (int n = 0; n < 2; ++n) acc[a][b][m][n] = (f32x4){0.f, 0.f, 0.f, 0.f};
    bf16x8 At[4][2], B0[2][2], B1[2][2];
    const char* cA = (const char*)g.A + (size_t)cur.pm * tstep; const char* cB = (const char*)g.Bt + (size_t)cur.pn * tstep;
    PG8_STAGE(PG8_SB(0, 0), cB, voffB); PG8_STAGE(PG8_SA(0, 0), cA, voffA); PG8_STAGE(PG8_SB(0, 1), cB + hstep, voffB); PG8_STAGE(PG8_SA(0, 1), cA + hstep, voffA);
    if (wr == 1) PG8_BAR;
    PG8_WAIT_V(4); PG8_BAR;
    PG8_STAGE(PG8_SB(1, 0), cB + kstep, voffB); PG8_STAGE(PG8_SA(1, 0), cA + kstep, voffA); PG8_STAGE(PG8_SB(1, 1), cB + hstep + kstep, voffB);
    PG8_WAIT_V(6); PG8_BAR;
    for (;;) {
        const bool has_next = S.next(ui + 1, nxt);
        const char* nA = has_next ? (const char*)g.A + (size_t)nxt.pm * tstep : cA; const char* nB = has_next ? (const char*)g.Bt + (size_t)nxt.pn * tstep : cB;
        for (int t = 0; t < nt; t += 2) {
            const bool last = (t == nt - 2);
            const char* a1 = cA + (size_t)(t + 1) * kstep;
            const char* a2 = last ? nA : cA + (size_t)(t + 2) * kstep; const char* b2 = last ? nB : cB + (size_t)(t + 2) * kstep;
            const char* a3 = a2 + kstep; const char* b3 = b2 + kstep;
            PG8_LDB(B0, 0, 0); PG8_SCHED; PG8_LDA(At, 0, 0); PG8_STAGE(PG8_SA(1, 1), a1 + hstep, voffA);
            PG8_WAIT_L(8); PG8_BAR; PG8_WAIT_L(0); PG8_MMA(0, 0, At, B0); PG8_BAR; PG8_SCHED;
            PG8_LDB(B1, 0, 1); PG8_STAGE(PG8_SB(0, 0), b2, voffB);
            PG8_BAR; PG8_WAIT_L(0); PG8_MMA(0, 1, At, B1); PG8_BAR;
            PG8_LDA(At, 0, 1); PG8_STAGE(PG8_SA(0, 0), a2, voffA);
            PG8_BAR; PG8_WAIT_L(0); PG8_MMA(1, 0, At, B0); PG8_BAR; PG8_SCHED;
            PG8_STAGE(PG8_SB(0, 1), b2 + hstep, voffB);
            PG8_WAIT_V(6); PG8_BAR; PG8_MMA(1, 1, At, B1); PG8_BAR;
            PG8_LDB(B0, 1, 0); PG8_SCHED; PG8_LDA(At, 1, 0); PG8_STAGE(PG8_SA(0, 1), a2 + hstep, voffA);
            PG8_WAIT_L(8); PG8_BAR; PG8_WAIT_L(0); PG8_MMA(0, 0, At, B0); PG8_BAR; PG8_SCHED;
            PG8_LDB(B1, 1, 1); PG8_STAGE(PG8_SB(1, 0), b3, voffB);
            PG8_BAR; PG8_WAIT_L(0); PG8_MMA(0, 1, At, B1); PG8_BAR;
            PG8_LDA(At, 1, 1); PG8_STAGE(PG8_SA(1, 0), a3, voffA);
            PG8_BAR; PG8_WAIT_L(0); PG8_MMA(1, 0, At, B0); PG8_BAR; PG8_SCHED;
            PG8_STAGE(PG8_SB(1, 1), b3 + hstep, voffB);
            PG8_WAIT_V(6); PG8_BAR; PG8_MMA(1, 1, At, B1); PG8_BAR;
        }
        E(acc, cur, ui, wr, wc, fr, fq);
#ifdef DUP_EPI
        if (Epi::DUPOK) E(acc, cur, ui, wr, wc, fr, fq);
#endif
        if (!has_next) break;
#pragma unroll
        for (int a = 0; a < 2; ++a)
#pragma unroll
            for (int b = 0; b < 2; ++b)
#pragma unroll
                for (int m = 0; m < 4; ++m)
#pragma unroll
                    for (int n = 0; n < 2; ++n) acc[a][b][m][n] = (f32x4){0.f, 0.f, 0.f, 0.f};
        cur = nxt; cA = nA; cB = nB; ++ui;
    }
    PG8_WAIT_V(0);
    if (wr == 0) PG8_BAR;
    PG8_BAR;
#undef PG8_SA
#undef PG8_SB
#undef PG8_STAGE
#undef PG8_LDA
#undef PG8_LDB
#undef PG8_MMA
#undef PG8_WAIT_V
#undef PG8_WAIT_L
#undef PG8_BAR
#undef PG8_SCHED
}
}
typedef f32x4 acc_t[2][2][4][2];
#define ROWS_LOOP _Pragma("unroll") for (int ai = 0; ai < 2; ++ai) _Pragma("unroll") for (int m = 0; m < 4; ++m)
#define ROW_OF (u.pm * 256 + ai * 128 + wr * 64 + m * 16 + fr)

struct EpiIn {
    static constexpr bool DUPOK = true;
    const Params& p; int l;
    __device__ __forceinline__ void operator()(const acc_t& acc, const pg8::Unit& u, int ui, int wr, int wc, int fr, int fq) const {
        const float* ssq = p.sumsq() + (size_t)(l & 1) * T * 16;
        const int pn = u.pn, cl = wc * 4 + fq;
        __shared__ float s_rstd[256];
        { const int t_ = TID(); if (t_ < 256) s_rstd[t_] = row_rstd(ssq, u.pm * 256 + t_); __syncthreads(); }
        float rsa[8];
#pragma unroll
        for (int ix = 0; ix < 8; ++ix) rsa[ix] = s_rstd[(ix >> 2) * 128 + wr * 64 + (ix & 3) * 16 + fr];
        if (pn < 8) {
            ROWS_LOOP { const int row = ROW_OF; const float rs = rsa[ai * 4 + m];
                float zz[4], gg[4];
#pragma unroll
                for (int ch = 0; ch < 4; ++ch) { const f32x4 v = acc[ai][ch >> 1][m][ch & 1]; zz[ch] = (v[1] * rs) * (v[2] * rs); gg[ch] = (v[0] * rs) * siluf(v[3] * rs); }
                const size_t o = (size_t)row * 512 + pn * 64 + cl * 4;
                u32x2 a; a[0] = cvtpk(zz[0], zz[1]); a[1] = cvtpk(zz[2], zz[3]); *(u32x2*)(p.z() + o) = a;
                u32x2 b; b[0] = cvtpk(gg[0], gg[1]); b[1] = cvtpk(gg[2], gg[3]); *(u32x2*)(p.ga() + o) = b; }
        } else if (pn < 12 || (pn >= 16 && pn <= 18)) {
            if (pn == 18 && wc >= 1) {
                if (wc == 1 && fq == 0) {
                    ROWS_LOOP { const int row = ROW_OF; const float rs = rsa[ai * 4 + m] * 0.04419417382415922f;
                        *(f32x4*)(p.iw() + (size_t)row * 8) = acc[ai][0][m][0] * rs; *(f32x4*)(p.iw() + (size_t)row * 8 + 4) = acc[ai][0][m][1] * rs; }
                }
            } else {
                const bool isqk = pn < 12; const int which = (pn - 8) >> 1;
                int head; u16* dst; int pitch;
                if (isqk) { head = ((pn - 8) & 1) * 4 + wc; dst = which ? p.k() : p.q(); pitch = 512; }
                else if (pn < 18) { head = (pn - 16) * 4 + wc; dst = p.iq(); pitch = 512; }
                else { head = 0; dst = p.ik(); pitch = 64; }
                f32x4 g0[2], g1[2];
#pragma unroll
                for (int n = 0; n < 2; ++n) { g0[n] = (f32x4){1.f, 1.f, 1.f, 1.f}; g1[n] = g0[n]; }
                if (isqk) { const float* gg = (which ? p.k_g : p.q_g) + l * 64 + 8 * fq;
#pragma unroll
                    for (int n = 0; n < 2; ++n) { g0[n] = *(const f32x4*)(gg + 4 * n); g1[n] = *(const f32x4*)(gg + 32 + 4 * n); } }
                f32x4 rcb[2], rsb[2];
                { const int pos0 = (u.pm * 256 + wr * 64 + fr) & (SEQ - 1);
#pragma unroll
                  for (int n = 0; n < 2; ++n) { rcb[n] = *(const f32x4*)(p.ropec() + pos0 * 32 + 8 * fq + 4 * n); rsb[n] = *(const f32x4*)(p.ropes() + pos0 * 32 + 8 * fq + 4 * n); } }
                ROWS_LOOP { const int row = ROW_OF; const int ix = ai * 4 + m; const float rs = rsa[ix];
                    f32x4 a0[2], a1[2];
#pragma unroll
                    for (int n = 0; n < 2; ++n) { a0[n] = acc[ai][0][m][n] * rs; a1[n] = acc[ai][1][m][n] * rs; }
                    if (isqk) { float ss = 0.f;
#pragma unroll
                        for (int n = 0; n < 2; ++n)
#pragma unroll
                            for (int j = 0; j < 4; ++j) ss += a0[n][j] * a0[n][j] + a1[n][j] * a1[n][j];
                        ss += __shfl_xor(ss, 16); ss += __shfl_xor(ss, 32);
                        const float rn = __builtin_amdgcn_rsqf(ss * (1.f / 64.f) + RMS_EPS);
#pragma unroll
                        for (int n = 0; n < 2; ++n) { a0[n] = a0[n] * rn * g0[n]; a1[n] = a1[n] * rn * g1[n]; } }
                    u32x4 o0, o1;
#pragma unroll
                    for (int n = 0; n < 2; ++n) { const f32x4 cc = rcb[n], sn = rsb[n];
                        const f32x4 r0 = a0[n] * cc - a1[n] * sn, r1 = a1[n] * cc + a0[n] * sn;
                        o0[2 * n] = cvtpk(r0[0], r0[1]); o0[2 * n + 1] = cvtpk(r0[2], r0[3]); o1[2 * n] = cvtpk(r1[0], r1[1]); o1[2 * n + 1] = cvtpk(r1[2], r1[3]); }
                    if (ix < 7) { const int posn = (u.pm * 256 + ((ix + 1) >> 2) * 128 + wr * 64 + ((ix + 1) & 3) * 16 + fr) & (SEQ - 1);
#pragma unroll
                        for (int n = 0; n < 2; ++n) { rcb[n] = *(const f32x4*)(p.ropec() + posn * 32 + 8 * fq + 4 * n); rsb[n] = *(const f32x4*)(p.ropes() + posn * 32 + 8 * fq + 4 * n); } }
                    u16* d = dst + (size_t)row * pitch + head * 64 + 8 * fq;
                    *(u32x4*)d = o0; *(u32x4*)(d + 32) = o1; }
            }
        } else {
            u16* dst; int cb; int kind;
            if (pn < 14) { dst = p.v(); cb = (pn - 12) * 256; kind = 0; }
            else if (pn < 16) { dst = p.sg(); cb = (pn - 14) * 256; kind = 1; }
            else if (pn < 21) { dst = p.u(); cb = (pn - 19) * 256; kind = 0; }
            else { dst = p.sp(); cb = (pn - 21) * 256; kind = 2; }
            f32x4 sc[2][2];
#pragma unroll
            for (int bj = 0; bj < 2; ++bj)
#pragma unroll
                for (int n = 0; n < 2; ++n) sc[bj][n] = (kind == 2) ? *(const f32x4*)(p.pool_scale + l * 512 + cb + 16 * cl + bj * 8 + n * 4) : (f32x4){1.f, 1.f, 1.f, 1.f};
            ROWS_LOOP { const int row = ROW_OF; const float rs = rsa[ai * 4 + m];
#pragma unroll
                for (int bj = 0; bj < 2; ++bj) { f32x4 v0 = acc[ai][bj][m][0] * rs, v1 = acc[ai][bj][m][1] * rs;
                    if (kind >= 1) {
#pragma unroll
                        for (int j = 0; j < 4; ++j) { v0[j] = siluf(v0[j]) * sc[bj][0][j]; v1[j] = siluf(v1[j]) * sc[bj][1][j]; } }
                    u32x4 w; w[0] = cvtpk(v0[0], v0[1]); w[1] = cvtpk(v0[2], v0[3]); w[2] = cvtpk(v1[0], v1[1]); w[3] = cvtpk(v1[2], v1[3]);
                    *(u32x4*)(dst + (size_t)row * 512 + cb + 16 * cl + bj * 8) = w; } }
        }
    }
};
__device__ __forceinline__ void phase_in(const Params& p, int l, char* shm) {
    pg8::Gemm g{p.xb(), p.wt_in() + (size_t)l * NPA * 1024, T, NPA, 1024};
    pg8::StaticOrder S; S.init(T, NPA, GDIM(), BID());
    EpiIn E{p, l};
    pg8::gemm_phase((PG8_LAS unsigned char*)shm, g, S, E);
}
__device__ __forceinline__ void phase_mix(const Params& p, int l) {
    const float* cw = p.conv_w + l * 3 * 512;
    constexpr int RUN = 16;
    const int nitem = (T / RUN) * 256;
    const int it0 = BID() * NTHR + TID(), itstep = GDIM() * NTHR;
    for (int it = it0; it < nitem; it += itstep) {
        const int cp = it & 255, c = cp * 2, t0 = (it >> 8) * RUN, pos0 = t0 & (SEQ - 1);
        {
            const float w00 = cw[c], w01 = cw[c + 1], w10 = cw[512 + c], w11 = cw[513 + c], w20 = cw[1024 + c], w21 = cw[1025 + c];
            unsigned zr[RUN + 2], gr[RUN];
#pragma unroll
            for (int i = 0; i < RUN + 2; ++i) zr[i] = (pos0 + i - 2 >= 0) ? *(const unsigned*)(p.z() + (size_t)(t0 + i - 2) * 512 + c) : 0u;
#pragma unroll
            for (int i = 0; i < RUN; ++i) gr[i] = *(const unsigned*)(p.ga() + (size_t)(t0 + i) * 512 + c);
#pragma unroll
            for (int i = 0; i < RUN; ++i) {
                const float y0 = (w00 * bflo(zr[i]) + w10 * bflo(zr[i + 1]) + w20 * bflo(zr[i + 2])) * bflo(gr[i]);
                const float y1 = (w01 * bfhi(zr[i]) + w11 * bfhi(zr[i + 1]) + w21 * bfhi(zr[i + 2])) * bfhi(gr[i]);
                *(unsigned*)(p.ga() + (size_t)(t0 + i) * 512 + c) = cvtpk(y0, y1);
            }
        }
        {
            const int win = 2 << (c >> 7);
            unsigned ur[RUN + 15], gr[RUN];
#pragma unroll
            for (int i = 0; i < RUN + 15; ++i) ur[i] = (i >= 16 - win && pos0 + i - 15 >= 0) ? *(const unsigned*)(p.u() + (size_t)(t0 + i - 15) * 512 + c) : 0u;
#pragma unroll
            for (int i = 0; i < RUN; ++i) gr[i] = *(const unsigned*)(p.sp() + (size_t)(t0 + i) * 512 + c);
            float s0 = 0.f, s1 = 0.f;
#pragma unroll
            for (int i = 0; i < 15; ++i) { s0 += bflo(ur[i]); s1 += bfhi(ur[i]); }
#pragma unroll
            for (int i = 0; i < RUN; ++i) {
                const int pos = pos0 + i;
                const float u0 = bflo(ur[i + 15]), u1 = bfhi(ur[i + 15]);
                s0 += u0; s1 += u1;
                const float ic = __builtin_amdgcn_rcpf((float)min(pos + 1, win));
                *(unsigned*)(p.sp() + (size_t)(t0 + i) * 512 + c) = cvtpk((s0 * ic - u0) * bflo(gr[i]), (s1 * ic - u1) * bfhi(gr[i]));
                unsigned wo = 0u;
#pragma unroll
                for (int g = 0; g < 4; ++g) if (win == (2 << g)) wo = ur[i + 15 - ((2 << g) - 1)];
                s0 -= bflo(wo); s1 -= bfhi(wo);
            }
        }
    }
}

__device__ __forceinline__ int crow(int r, int hi) { return (r & 3) + 8 * (r >> 2) + 4 * hi; }
__device__ __forceinline__ size_t sc_base(int qb) { return (size_t)32768 * qb * (qb + 1); }
__device__ __forceinline__ void phase_indexer(const Params& p, int b, u16* scbuf, char* shm) {
    const int tid_ = TID(); const int wid = tid_ >> 6, lane = tid_ & 63, ql = lane & 15, fq = lane >> 4; const int bid_ = BID(), gdim_ = GDIM();
    constexpr int NSTEP = 64 * 65;
    const int f0 = (int)(((long)bid_ * NSTEP) / gdim_), f1 = (int)(((long)(bid_ + 1) * NSTEP) / gdim_);
    int qcur = -1;
    bf16x8 bq[8][2]; float wv[8]; u16* srow = nullptr; int qloc = 0;
    char* tl = shm + 40960 + wid * 2304;
#pragma unroll
    for (int h = 0; h < 8; ++h) { wv[h] = 0.f; bq[h][0] = bq[h][1] = (bf16x8){0, 0, 0, 0, 0, 0, 0, 0}; }
    const u16* ikb = p.ik() + ((size_t)b * SEQ + ql) * 64 + fq * 8;
    for (int f = f0; f < f1; ++f) {
        int q = (int)((sqrtf(4.f * f + 1.f) - 1.f) * 0.5f);
        while ((q + 1) * (q + 2) <= f) ++q;
        while (q * (q + 1) > f) --q;
        const int tt = f - q * (q + 1);
        if (q != qcur) {
            qcur = q; qloc = q * 128 + wid * 16 + ql;
            const size_t row = (size_t)b * SEQ + qloc;
#pragma unroll
            for (int h = 0; h < 8; ++h)
#pragma unroll
                for (int kc = 0; kc < 2; ++kc) bq[h][kc] = *(const bf16x8*)(p.iq() + row * 512 + h * 64 + kc * 32 + fq * 8);
            const f32x4 x = *(const f32x4*)(p.iw() + row * 8), y = *(const f32x4*)(p.iw() + row * 8 + 4);
            wv[0] = x[0]; wv[1] = x[1]; wv[2] = x[2]; wv[3] = x[3]; wv[4] = y[0]; wv[5] = y[1]; wv[6] = y[2]; wv[7] = y[3];
            const int a = q >> 1;
            srow = scbuf + sc_base(a) + (size_t)(q * 128 + wid * 16 + (lane >> 2) - a * 256) * (256 * (a + 1)) + (lane & 3) * 16;
        }
        const int key0 = tt * 64;
        bf16x8 ka[4][2];
#pragma unroll
        for (int kg = 0; kg < 4; ++kg)
#pragma unroll
            for (int kc = 0; kc < 2; ++kc) ka[kg][kc] = *(const bf16x8*)(ikb + (size_t)(key0 + kg * 16) * 64 + kc * 32);
        const bool band = (key0 + 63 > q * 128 + wid * 16);
#pragma unroll
        for (int kg = 0; kg < 4; ++kg) {
            f32x4 sacc = (f32x4){0.f, 0.f, 0.f, 0.f};
#pragma unroll
            for (int h = 0; h < 8; ++h) {
                f32x4 c = (f32x4){0.f, 0.f, 0.f, 0.f};
                c = __builtin_amdgcn_mfma_f32_16x16x32_bf16(ka[kg][0], bq[h][0], c, 0, 0, 0);
                c = __builtin_amdgcn_mfma_f32_16x16x32_bf16(ka[kg][1], bq[h][1], c, 0, 0, 0);
#pragma unroll
                for (int j = 0; j < 4; ++j) sacc[j] = __builtin_fmaf(wv[h], __builtin_fmaxf(c[j], 0.f), sacc[j]);
            }
            const int kb = key0 + kg * 16 + fq * 4;
            if (band) {
#pragma unroll
                for (int j = 0; j < 4; ++j) if (kb + j > qloc) sacc[j] = -INFINITY;
            }
            union { _Float16 h[4]; u32x2 v; } pk;
            pk.h[0] = (_Float16)sacc[0]; pk.h[1] = (_Float16)sacc[1]; pk.h[2] = (_Float16)sacc[2]; pk.h[3] = (_Float16)sacc[3];
            *(u32x2*)(tl + ql * 144 + kg * 32 + fq * 8) = pk.v;
        }
        { const u32x4 r0 = *(const u32x4*)(tl + (lane >> 2) * 144 + (lane & 3) * 32), r1 = *(const u32x4*)(tl + (lane >> 2) * 144 + (lane & 3) * 32 + 16);
          *(u32x4*)(srow + key0) = r0; *(u32x4*)(srow + key0 + 8) = r1; }
    }
}

__device__ __forceinline__ size_t mk_base(int qb) { return (size_t)512 * qb * (qb + 1); }
constexpr size_t MASK_WORDS_PER_BATCH = 540672;
__device__ __forceinline__ unsigned f16key(unsigned h) { return (h & 0x8000u) ? (~h & 0xffffu) : (h | 0x8000u); }
__device__ __forceinline__ void hist_scan(const unsigned* h, int lane, unsigned target, int& bin, unsigned& above, unsigned& inbin) {
    const u32x4 a = *(const u32x4*)(h + 4 * lane), b = *(const u32x4*)(h + 256 + 4 * lane), c = *(const u32x4*)(h + 512 + 4 * lane), d = *(const u32x4*)(h + 768 + 4 * lane);
    const unsigned h0 = a[0] + b[0] + c[0] + d[0], h1 = a[1] + b[1] + c[1] + d[1], h2 = a[2] + b[2] + c[2] + d[2], h3 = a[3] + b[3] + c[3] + d[3];
    const unsigned tot = h0 + h1 + h2 + h3;
#define DPP_SHL(v, n) ((unsigned)__builtin_amdgcn_update_dpp(0, (int)(v), 0x100 + (n), 0xf, 0xf, true))
    unsigned x = tot;
    x += DPP_SHL(x, 1); x += DPP_SHL(x, 2); x += DPP_SHL(x, 4); x += DPP_SHL(x, 8);
#undef DPP_SHL
    { const unsigned t1 = (unsigned)__builtin_amdgcn_readlane((int)x, 16), t2 = (unsigned)__builtin_amdgcn_readlane((int)x, 32), t3 = (unsigned)__builtin_amdgcn_readlane((int)x, 48);
      const int rowi = lane >> 4;
      x += (rowi == 0) ? (t1 + t2 + t3) : (rowi == 1) ? (t2 + t3) : (rowi == 2) ? t3 : 0u; }
    const unsigned ab = x - tot, c3 = ab + h3, c2 = c3 + h2, c1 = c2 + h1, c0 = c1 + h0;
    int fb = -1; unsigned fa = 0, fc = 0;
    if (ab < target && c3 >= target) { fb = 4 * lane + 3; fa = ab; fc = h3; }
    else if (c3 < target && c2 >= target) { fb = 4 * lane + 2; fa = c3; fc = h2; }
    else if (c2 < target && c1 >= target) { fb = 4 * lane + 1; fa = c2; fc = h1; }
    else if (c1 < target && c0 >= target) { fb = 4 * lane; fa = c1; fc = h0; }
    const u64 m = __ballot(fb >= 0); const int src = (m == 0) ? 0 : (__ffsll((unsigned long long)m) - 1);
    bin = __builtin_amdgcn_readlane(fb, src); above = (unsigned)__builtin_amdgcn_readlane((int)fa, src); inbin = (unsigned)__builtin_amdgcn_readlane((int)fc, src);
}
__device__ __forceinline__ unsigned f16key2(unsigned w) { const unsigned sg = (w >> 15) & 0x00010001u; return w ^ (((sg << 15) - sg) | 0x80008000u); }
__device__ __forceinline__ void phase_select(const Params& p, int b, char* shm, const u16* scbuf) {
    const int tid_ = TID(); const int wid = __builtin_amdgcn_readfirstlane(tid_ >> 6), lane = tid_ & 63;
    const int gw = BID() * 8 + wid, nw = GDIM() * 8;
    unsigned* hist = (unsigned*)shm + wid * 1152;
    const int hsubi = (lane >> 4) * 256, dummyi = 1024 + lane;
    typedef unsigned short us2 __attribute__((ext_vector_type(2)));
#define ROW_T(i_) ({ const int kq_ = (i_) / nw; ((mirror && (kq_ & 1)) ? (kq_ * nw + (nw - 1 - ((i_) - kq_ * nw))) : (i_)); })
#define ROW_LOAD(t_) do { const int qb_ = (t_) >> 8, ntr_ = 2 * (((t_) >> 7) + 1), nch_ = (ntr_ + 7) >> 3; \
        const u16* sr_ = scbuf + sc_base(qb_) + (size_t)((t_) - qb_ * 256) * (256 * (qb_ + 1)); \
        _Pragma("unroll") for (int c = 0; c < 16; ++c) { raw[c] = (u32x4){0u, 0u, 0u, 0u}; if (c < nch_) { if (lane < 8 * (ntr_ - 8 * c)) raw[c] = *(const u32x4*)(sr_ + 512 * c + 8 * lane); } } } while (0)
    const bool mirror = (SEQ % (2 * nw)) == 0;
    __builtin_amdgcn_s_setprio(2);
    u32x4 raw[16];
    if (gw < SEQ) { const int t0_ = ROW_T(gw); ROW_LOAD(t0_); }
    for (int i = gw; i < SEQ; i += nw) {
        const int t = ROW_T(i);
        const int qb = t >> 8, ntile = 4 * (qb + 1), ntr = 2 * ((t >> 7) + 1);
        const int nch = (ntr + 7) >> 3, nchw = (ntile + 7) >> 3;
        unsigned char* mrow = (unsigned char*)(p.mask() + (size_t)b * MASK_WORDS_PER_BATCH + mk_base(qb) + (size_t)(t - qb * 256) * ntile);
        unsigned key[16][4];
#pragma unroll
        for (int c = 0; c < 16; ++c) {
            const bool valid = (c < nch) && (lane < 8 * (ntr - 8 * c));
#pragma unroll
            for (int r = 0; r < 4; ++r) key[c][r] = valid ? f16key2(raw[c][r]) : 0u;
        }
        if (i + nw < SEQ) { const int tn_ = ROW_T(i + nw); ROW_LOAD(tn_); }
        unsigned thrm1 = 0x03ffu, thr = 0x0400u; int need = 0; bool fast = true;
        if (t >= 256) {
            us2 a1 = (us2){0, 0}, a2 = (us2){0, 0};
#pragma unroll
            for (int c = 0; c < 16; ++c) {
                if (c < nch) {
#pragma unroll
                    for (int r = 0; r < 4; ++r) { const us2 kk = __builtin_bit_cast(us2, key[c][r]);
                        const us2 tmx = __builtin_elementwise_max(a1, kk), tmn = __builtin_elementwise_min(a1, kk); a1 = tmx; a2 = __builtin_elementwise_max(a2, tmn); }
                }
            }
            unsigned Lb = min((unsigned)a2[0], (unsigned)a2[1]);
#define DPP_ROR(v, n) ((unsigned)__builtin_amdgcn_update_dpp((int)(v), (int)(v), 0x120 + (n), 0xf, 0xf, false))
            Lb = min(Lb, DPP_ROR(Lb, 8)); Lb = min(Lb, DPP_ROR(Lb, 4)); Lb = min(Lb, DPP_ROR(Lb, 2)); Lb = min(Lb, DPP_ROR(Lb, 1));
#undef DPP_ROR
            Lb = min(min((unsigned)__builtin_amdgcn_readlane((int)Lb, 0), (unsigned)__builtin_amdgcn_readlane((int)Lb, 16)), min((unsigned)__builtin_amdgcn_readlane((int)Lb, 32), (unsigned)__builtin_amdgcn_readlane((int)Lb, 48)));
            const u32x4 z4 = (u32x4){0u, 0u, 0u, 0u};
#pragma unroll
            for (int c = 0; c < 4; ++c) *(u32x4*)(hist + c * 256 + 4 * lane) = z4;
#pragma unroll
            for (int c = 0; c < 16; ++c) {
                if (c < nch) {
#pragma unroll
                    for (int r = 0; r < 4; ++r) { const unsigned kk = key[c][r]; const unsigned lo = kk & 0xffffu, hi = kk >> 16;
                        atomicAdd(hist + ((lo >= Lb) ? (hsubi + (int)(lo >> 8)) : dummyi), 1u);
                        atomicAdd(hist + ((hi >= Lb) ? (hsubi + (int)(hi >> 8)) : dummyi), 1u); }
                }
            }
            asm volatile("s_waitcnt lgkmcnt(0)" ::: "memory");
            int B1; unsigned ab1, in1;
            hist_scan(hist, lane, 256u, B1, ab1, in1);
            asm volatile("s_waitcnt lgkmcnt(0)" ::: "memory");
#pragma unroll
            for (int c = 0; c < 4; ++c) *(u32x4*)(hist + c * 256 + 4 * lane) = z4;
#pragma unroll
            for (int c = 0; c < 16; ++c) {
                if (c < nch) {
#pragma unroll
                    for (int r = 0; r < 4; ++r) { const unsigned kk = key[c][r]; const unsigned lo = kk & 0xffffu, hi = kk >> 16;
                        const bool ml = ((lo >> 8) == (unsigned)B1) && (lo >= Lb), mh = ((hi >> 8) == (unsigned)B1) && (hi >= Lb);
                        if (__any(ml || mh)) { if (ml) atomicAdd(hist + hsubi + (int)(lo & 255u), 1u); if (mh) atomicAdd(hist + hsubi + (int)(hi & 255u), 1u); } }
                }
            }
            asm volatile("s_waitcnt lgkmcnt(0)" ::: "memory");
            int B2; unsigned ab2, in2;
            hist_scan(hist, lane, 256u - ab1, B2, ab2, in2);
            asm volatile("s_waitcnt lgkmcnt(0)" ::: "memory");
            thr = __builtin_amdgcn_readfirstlane(((unsigned)B1 << 8) | (unsigned)B2);
            need = __builtin_amdgcn_readfirstlane(256 - (int)(ab1 + ab2));
            const int neq = __builtin_amdgcn_readfirstlane((int)in2);
            fast = (need == neq);
            thrm1 = thr - 1u;
        }
        if (fast) {
#pragma unroll
            for (int c = 0; c < 16; ++c) {
                if (c < nchw) {
                    unsigned m = 0u;
#pragma unroll
                    for (int ii = 7; ii >= 0; --ii) { const unsigned kk = key[c][ii >> 1]; const unsigned kv = (ii & 1) ? (kk >> 16) : (kk & 0xffffu); m = m + m + ((kv > thrm1) ? 1u : 0u); }
                    if (64 * c + lane < 8 * ntile) mrow[64 * c + lane] = (unsigned char)m;
                }
            }
        } else {
#define DPP_SHR(v, n) ((unsigned)__builtin_amdgcn_update_dpp(0, (int)(v), 0x110 + (n), 0xf, 0xf, true))
            int base = 0;
#pragma unroll
            for (int c = 0; c < 16; ++c) {
                if (c < nchw) {
                    unsigned m = 0u, e = 0u;
#pragma unroll
                    for (int ii = 7; ii >= 0; --ii) { const unsigned kk = key[c][ii >> 1]; const unsigned kv = (ii & 1) ? (kk >> 16) : (kk & 0xffffu); m = m + m + ((kv > thr) ? 1u : 0u); e = e + e + ((kv == thr) ? 1u : 0u); }
                    if (__any(e != 0u)) {
                        const unsigned cnt = (unsigned)__builtin_popcount(e);
                        unsigned pre = cnt;
                        pre += DPP_SHR(pre, 1); pre += DPP_SHR(pre, 2); pre += DPP_SHR(pre, 4); pre += DPP_SHR(pre, 8);
                        const unsigned t0 = (unsigned)__builtin_amdgcn_readlane((int)pre, 15), t1 = (unsigned)__builtin_amdgcn_readlane((int)pre, 31), t2 = (unsigned)__builtin_amdgcn_readlane((int)pre, 47), t3 = (unsigned)__builtin_amdgcn_readlane((int)pre, 63);
                        const int rowi = lane >> 4;
                        pre += (rowi == 1) ? t0 : (rowi == 2) ? (t0 + t1) : (rowi == 3) ? (t0 + t1 + t2) : 0u;
                        int rank = base + (int)(pre - cnt);
#pragma unroll
                        for (int ii = 0; ii < 8; ++ii) if ((e >> ii) & 1u) { if (rank < need) m |= (1u << ii); ++rank; }
                        base += (int)(t0 + t1 + t2 + t3);
                    }
                    if (64 * c + lane < 8 * ntile) mrow[64 * c + lane] = (unsigned char)m;
                }
            }
#undef DPP_SHR
        }
    }
    __builtin_amdgcn_s_setprio(0);
}

constexpr int A_D = 64, A_DM = 512, A_NW = 8, A_QBLK = 32, A_QB = 256, A_KVBLK = 64, A_NQB = SEQ / A_QB, A_NHEAD = 8;
constexpr float A_C2 = 0.125f * 1.4426950408889634f;
constexpr int A_SLOTB = 8192, A_LDS_K = 0, A_LDS_V = 3 * A_SLOTB, A_LDS_WS = 6 * A_SLOTB, A_LDS_OST = A_LDS_WS + A_NW * 256, A_LDS_MK = A_LDS_OST + A_NW * 4096, A_LDS_BYTES = A_LDS_MK + A_NW * 2048;
#define ATTN_THR 8
#define SBAR() __builtin_amdgcn_sched_barrier(0)
#define PIN(x) asm volatile("" : "+v"(x))
#define MFMA32(a, b, c) __builtin_amdgcn_mfma_f32_32x32x16_bf16(a, b, c, 0, 0, 0)
#define WAIT_BAR(N) asm volatile("s_waitcnt vmcnt(" #N ") lgkmcnt(0)\n\ts_barrier" ::: "memory")
__device__ __forceinline__ void glds16s(const void* sbase, unsigned voff, unsigned lds_base) {
    unsigned sv; asm volatile("s_mov_b32 %0, m0\n\ts_mov_b32 m0, %3\n\ts_nop 0\n\tglobal_load_lds_dwordx4 %1, %2\n\ts_mov_b32 m0, %0" : "=&s"(sv) : "v"(voff), "s"(sbase), "s"(lds_base) : "memory"); }
typedef __attribute__((address_space(3))) const char* lds_cptr;
typedef short v4i16_t __attribute__((ext_vector_type(4)));
__device__ __forceinline__ void kload2(bf16x8* kf, lds_cptr kp, int d0) { kf[2 * d0] = *(const __attribute__((address_space(3))) bf16x8*)(kp + d0 * 2048); kf[2 * d0 + 1] = *(const __attribute__((address_space(3))) bf16x8*)(kp + d0 * 2048 + 512); }
__device__ __forceinline__ s16x4 vtr(lds_cptr p) { return __builtin_bit_cast(s16x4, __builtin_amdgcn_ds_read_tr16_b64_v4i16((__attribute__((address_space(3))) v4i16_t*)p)); }
#define MX3(a, b, c) __builtin_fmaxf(__builtin_fmaxf((a), (b)), (c))
__device__ __forceinline__ float rowmax(const f32x16& p0, const f32x16& p1) {
    float a = MX3(p0[0], p0[1], p1[0]), b = MX3(p0[2], p0[3], p1[1]); a = MX3(a, p1[2], p1[3]);
#pragma unroll
    for (int r = 4; r < 16; r += 4) { a = MX3(a, p0[r], p0[r + 1]); b = MX3(b, p0[r + 2], p0[r + 3]); a = MX3(a, p1[r], p1[r + 1]); b = MX3(b, p1[r + 2], p1[r + 3]); }
    float m = __builtin_fmaxf(a, b); auto rr = __builtin_amdgcn_permlane32_swap(__float_as_uint(m), __float_as_uint(m), false, false);
    return __builtin_fmaxf(__uint_as_float(rr[0]), __uint_as_float(rr[1])); }
__device__ __forceinline__ void cmask(f32x16& p0, f32x16& p1, int jb, int qrel, int hi) {
    const int kb = 64 * jb + 4 * hi;
#pragma unroll
    for (int r = 0; r < 16; ++r) { const int kv = kb + (r & 3) + 8 * (r >> 2); if (kv > qrel) p0[r] = -INFINITY; if (kv + 32 > qrel) p1[r] = -INFINITY; } }
__device__ __forceinline__ float mand(float x, unsigned w, int pos) { return __uint_as_float(__float_as_uint(x) & (unsigned)__builtin_amdgcn_sbfe((int)w, pos, 1)); }
#define BITP(i) (((i) & 3) + 8 * ((i) >> 2))

__device__ __forceinline__ void attn64_unit(int b, int h, int qb, const u16* Q, const u16* __restrict__ K, const u16* __restrict__ V, const u16* __restrict__ SG, u16* O, const u64* mrow0, char* lds) {
    const int tid = TID(), lane = tid & 63, r32 = lane & 31, hi = lane >> 5; const int wid = __builtin_amdgcn_readfirstlane(tid >> 6);
    const long rowbase = (long)b * SEQ; const int q0 = qb * A_QB, NT = (q0 + A_QB) / A_KVBLK;
    const u16* Qw = Q + (rowbase + q0 + wid * A_QBLK) * A_DM + h * A_D;
    const unsigned lds0 = (unsigned)(uintptr_t)lds; float* wsf = (float*)(lds + A_LDS_WS) + wid * 64;
    const u16* kbase = K + rowbase * A_DM + h * A_D; const u16* vbase = V + rowbase * A_DM + h * A_D;
    const unsigned koff = (unsigned)(lane * A_DM + wid * 8) * 2u;
    const unsigned voff = (unsigned)((16 * (wid & 3) + (lane >> 2)) * A_DM + (wid >> 2) * 32 + (lane & 3) * 8) * 2u;
    const unsigned kdst = lds0 + A_LDS_K + wid * 1024, vdst = lds0 + A_LDS_V + wid * 1024;
#define DMA_K(t, slot) glds16s(kbase + (long)(t) * A_KVBLK * A_DM, koff, (unsigned)__builtin_amdgcn_readfirstlane(kdst + (slot)))
#define DMA_V(t, slot) glds16s(vbase + (long)(t) * A_KVBLK * A_DM, voff, (unsigned)__builtin_amdgcn_readfirstlane(vdst + (slot)))
#define DMA_M(chunk) glds16s(mrow0 + 2 * (chunk), moff, (unsigned)__builtin_amdgcn_readfirstlane(mdst + ((chunk) & 1) * 1024))
#define MWORD(t) (*(const u64*)(lds + A_LDS_MK + wid * 2048 + (((t) >> 1) & 1) * 1024 + r32 * 16 + ((t) & 1) * 8))
    const lds_cptr vp0 = (lds_cptr)lds + A_LDS_V + ((lane >> 4) & 1) * 32 + (lane & 3) * 8 + (4 * hi + ((lane & 15) >> 2)) * 64;
    const lds_cptr kp0 = (lds_cptr)lds + A_LDS_K + hi * 1024 + r32 * 16;
    const int qrel = wid * A_QBLK + r32;
    const unsigned moff = (unsigned)(qrel * NT) * 8u;
    const unsigned mdst = lds0 + A_LDS_MK + wid * 2048;
    DMA_M(0);
    DMA_K(0, 0); DMA_V(0, 0); DMA_K(1, A_SLOTB);
    bf16x8 qr[4];
#pragma unroll
    for (int d0 = 0; d0 < 4; ++d0) qr[d0] = *reinterpret_cast<const bf16x8*>(&Qw[(long)r32 * A_DM + d0 * 16 + hi * 8]);
    float mhat = 0.f, l_reg = 0.f; f32x16 o[2]; o[0] = f32x16{}; o[1] = f32x16{};
    const f32x16 zero16 = f32x16{};
    bool resc = false;
    f32x16 pA0, pA1, pB0, pB1; bf16x8 kf[8]; s16x4 vlo[8], vhi[8]; u32x4 pw0, pw1, pw2, pw3;
    typedef unsigned u32x16 __attribute__((ext_vector_type(16)));
    u32x16 mk0, mk1;
    int sl_prev = 0, sl_cur = 0, sl_next = A_SLOTB;
    const int sh4 = 4 * hi;
#define ROT() do { sl_prev = sl_cur; sl_cur = sl_next; sl_next = (sl_next == 2 * A_SLOTB) ? 0 : sl_next + A_SLOTB; } while (0)
#define EX(v) __builtin_amdgcn_exp2f(__builtin_fmaf((v), A_C2, nmh))
#define RESC() do { if (resc) { _Pragma("unroll") for (int d_ = 0; d_ < 2; ++d_) _Pragma("unroll") for (int r = 0; r < 16; ++r) o[d_][r] *= wsf[crow(r, hi)]; } } while (0)
    DMA_K(2, 2 * A_SLOTB);
    WAIT_BAR(3);
    _Pragma("unroll") for (int d0 = 0; d0 < 4; ++d0) kload2(kf, kp0, d0);
    pA0 = MFMA32(kf[0], qr[0], zero16); pA1 = MFMA32(kf[1], qr[0], zero16); pA0 = MFMA32(kf[2], qr[1], pA0); pA1 = MFMA32(kf[3], qr[1], pA1);
    pA0 = MFMA32(kf[4], qr[2], pA0); pA1 = MFMA32(kf[5], qr[2], pA1); pA0 = MFMA32(kf[6], qr[3], pA0); pA1 = MFMA32(kf[7], qr[3], pA1);
    { const float rm = rowmax(pA0, pA1); mhat = rm * A_C2; const float nmh = -mhat;
      const u64 mw0 = MWORD(0); const unsigned wl = (unsigned)mw0 >> sh4, wh = (unsigned)(mw0 >> 32) >> sh4;
#pragma unroll
      for (int r = 0; r < 16; ++r) { pA0[r] = mand(EX(pA0[r]), wl, BITP(r)); pA1[r] = mand(EX(pA1[r]), wh, BITP(r)); } }
    WAIT_BAR(0);
    DMA_K(3, 0); DMA_V(1, A_SLOTB); ROT();
    _Pragma("unroll") for (int d0 = 0; d0 < 4; ++d0) kload2(kf, kp0 + sl_cur, d0);
    WAIT_BAR(2);
#define PKW(P, i) cvtpk(P[i], P[i + 1])
#define PAF(k) __builtin_bit_cast(bf16x8, pw##k)
#define VFR(i) (bf16x8){vlo[i][0], vlo[i][1], vlo[i][2], vlo[i][3], vhi[i][0], vhi[i][1], vhi[i][2], vhi[i][3]}
#define VRD(i) do { vlo[i] = vtr(vp_ + (((i) >> 2) * 4096 + ((i) & 3) * 1024)); vhi[i] = vtr(vp_ + (((i) >> 2) * 4096 + ((i) & 3) * 1024 + 512)); } while (0)
#define KRD(G, d0) do { if (G) { kload2(kf, kp0 + sl_next, d0); SBAR(); } } while (0)
#define GAPA(MF, a0, a1, a2, a3, W0, W1, PW, MK, WW, i) do { MF; sacc += a0; sacc += a1; sacc += a2; sacc += a3; W0; W1; \
    MK[i] = (unsigned)__builtin_amdgcn_sbfe((int)(WW), BITP(i), 1); MK[i + 1] = (unsigned)__builtin_amdgcn_sbfe((int)(WW), BITP(i + 1), 1); MK[i + 2] = (unsigned)__builtin_amdgcn_sbfe((int)(WW), BITP(i + 2), 1); MK[i + 3] = (unsigned)__builtin_amdgcn_sbfe((int)(WW), BITP(i + 3), 1); \
    PIN(PW); PIN(sacc); PIN(MK); SBAR(); } while (0)
#define MAND(x, m) __uint_as_float(__float_as_uint(x) & (m))
#define GAPB(MF, X, i, MK) do { MF; X[i] = MAND(EX(X[i]), MK[i]); X[i + 1] = MAND(EX(X[i + 1]), MK[i + 1]); X[i + 2] = MAND(EX(X[i + 2]), MK[i + 2]); X[i + 3] = MAND(EX(X[i + 3]), MK[i + 3]); PIN(X); SBAR(); } while (0)
#define STEP(C0, C1, P0, P1, t, MASK, GK, GV, GL, ML) do { SBAR(); \
    if (ML) DMA_M(((t) + 1) >> 1); \
    const u64 mw_ = MWORD(t); const unsigned wl_ = (unsigned)(mw_) >> sh4, wh_ = (unsigned)((mw_) >> 32) >> sh4; \
    const lds_cptr vp_ = vp0 + sl_prev; \
    VRD(0); SBAR(); float sacc = P0[0] + P0[1]; \
                    GAPA(C0 = MFMA32(kf[0], qr[0], zero16), P0[2], P0[3], P0[4], P0[5],     pw0[0] = PKW(P0, 0),  pw0[1] = PKW(P0, 2),  pw0, mk0, wl_, 0); \
    VRD(4); SBAR(); GAPA(C1 = MFMA32(kf[1], qr[0], zero16), P0[6], P0[7], P0[8], P0[9],     pw0[2] = PKW(P0, 4),  pw0[3] = PKW(P0, 6),  pw0, mk0, wl_, 4); \
    VRD(1); SBAR(); GAPA(C0 = MFMA32(kf[2], qr[1], C0),    P0[10], P0[11], P0[12], P0[13], pw1[0] = PKW(P0, 8),  pw1[1] = PKW(P0, 10), pw1, mk0, wl_, 8); \
    VRD(5); SBAR(); GAPA(C1 = MFMA32(kf[3], qr[1], C1),    P0[14], P0[15], P1[0], P1[1],   pw1[2] = PKW(P0, 12), pw1[3] = PKW(P0, 14), pw1, mk0, wl_, 12); \
    VRD(2); SBAR(); GAPA(C0 = MFMA32(kf[4], qr[2], C0),    P1[2], P1[3], P1[4], P1[5],     pw2[0] = PKW(P1, 0),  pw2[1] = PKW(P1, 2),  pw2, mk1, wh_, 0); \
    VRD(6); SBAR(); GAPA(C1 = MFMA32(kf[5], qr[2], C1),    P1[6], P1[7], P1[8], P1[9],     pw2[2] = PKW(P1, 4),  pw2[3] = PKW(P1, 6),  pw2, mk1, wh_, 4); \
    VRD(3); SBAR(); GAPA(C0 = MFMA32(kf[6], qr[3], C0),    P1[10], P1[11], P1[12], P1[13], pw3[0] = PKW(P1, 8),  pw3[1] = PKW(P1, 10), pw3, mk1, wh_, 8); \
    VRD(7); SBAR(); GAPA(C1 = MFMA32(kf[7], qr[3], C1),    P1[14], P1[15], 0.f, 0.f,       pw3[2] = PKW(P1, 12), pw3[3] = PKW(P1, 14), pw3, mk1, wh_, 12); \
    l_reg += sacc; \
    if (GK) DMA_K((t) + 3, sl_cur); if (GV) DMA_V((t) + 1, sl_next); \
    { const float rm = __builtin_fmaf(rowmax(C0, C1), A_C2, -mhat); resc = false; \
      if (__builtin_expect(__any(rm > (float)ATTN_THR), 0)) { const float dl = __builtin_fmaxf(rm, 0.f); mhat += dl; \
          const float f = __builtin_amdgcn_exp2f(-dl); l_reg *= f; if (hi == 0) wsf[r32] = f; resc = true; } } \
    const float nmh = -mhat; SBAR(); \
    GAPB(o[0] = MFMA32(PAF(0), VFR(0), o[0]), C0, 0, mk0);              GAPB(o[1] = MFMA32(PAF(0), VFR(4), o[1]), C0, 4, mk0); \
    KRD(GL, 0); GAPB(o[0] = MFMA32(PAF(1), VFR(1), o[0]), C0, 8, mk0);  KRD(GL, 1); GAPB(o[1] = MFMA32(PAF(1), VFR(5), o[1]), C0, 12, mk0); \
    KRD(GL, 2); GAPB(o[0] = MFMA32(PAF(2), VFR(2), o[0]), C1, 0, mk1);  KRD(GL, 3); GAPB(o[1] = MFMA32(PAF(2), VFR(6), o[1]), C1, 4, mk1); \
    GAPB(o[0] = MFMA32(PAF(3), VFR(3), o[0]), C1, 8, mk1);              GAPB(o[1] = MFMA32(PAF(3), VFR(7), o[1]), C1, 12, mk1); \
    } while (0)
    int t = 1;
    for (; t + 5 < NT; t += 2) {
        STEP(pB0, pB1, pA0, pA1, t, false, true, true, true, true);      WAIT_BAR(2); RESC(); ROT();
        STEP(pA0, pA1, pB0, pB1, t + 1, false, true, true, true, false); WAIT_BAR(2); RESC(); ROT();
    }
#define ENDW(tt) do { if ((tt) + 3 < NT) { WAIT_BAR(2); } else if ((tt) + 2 < NT) { WAIT_BAR(1); } else { WAIT_BAR(0); } } while (0)
    for (; t + 1 < NT; t += 2) {
        STEP(pB0, pB1, pA0, pA1, t, true, (t + 3 < NT), (t + 1 < NT), (t + 1 < NT), (t + 1 < NT));         ENDW(t);     RESC(); ROT();
        STEP(pA0, pA1, pB0, pB1, t + 1, true, (t + 4 < NT), (t + 2 < NT), (t + 2 < NT), false);            ENDW(t + 1); RESC(); ROT();
    }
    STEP(pB0, pB1, pA0, pA1, NT - 1, true, false, false, false, false); RESC();
    { float sacc = pB0[0] + pB0[1];
#pragma unroll
      for (int r = 2; r < 16; ++r) sacc += pB0[r];
#pragma unroll
      for (int r = 0; r < 16; ++r) sacc += pB1[r];
      l_reg += sacc;
      pw0 = (u32x4){PKW(pB0, 0), PKW(pB0, 2), PKW(pB0, 4), PKW(pB0, 6)}; pw1 = (u32x4){PKW(pB0, 8), PKW(pB0, 10), PKW(pB0, 12), PKW(pB0, 14)};
      pw2 = (u32x4){PKW(pB1, 0), PKW(pB1, 2), PKW(pB1, 4), PKW(pB1, 6)}; pw3 = (u32x4){PKW(pB1, 8), PKW(pB1, 10), PKW(pB1, 12), PKW(pB1, 14)};
      const lds_cptr vp_ = vp0 + sl_cur; _Pragma("unroll") for (int i = 0; i < 8; ++i) VRD(i);
      o[0] = MFMA32(PAF(0), VFR(0), o[0]); o[1] = MFMA32(PAF(0), VFR(4), o[1]); o[0] = MFMA32(PAF(1), VFR(1), o[0]); o[1] = MFMA32(PAF(1), VFR(5), o[1]);
      o[0] = MFMA32(PAF(2), VFR(2), o[0]); o[1] = MFMA32(PAF(2), VFR(6), o[1]); o[0] = MFMA32(PAF(3), VFR(3), o[0]); o[1] = MFMA32(PAF(3), VFR(7), o[1]); }
    { auto rr = __builtin_amdgcn_permlane32_swap(__float_as_uint(l_reg), __float_as_uint(l_reg), false, false); l_reg = __uint_as_float(rr[0]) + __uint_as_float(rr[1]); }
    if (hi == 0) wsf[32 + r32] = l_reg; asm volatile("s_waitcnt lgkmcnt(0)" ::: "memory");
    float rli[16];
#pragma unroll
    for (int r = 0; r < 16; ++r) rli[r] = __builtin_amdgcn_rcpf(wsf[32 + crow(r, hi)]);
    u16* Ow = O + (rowbase + q0 + wid * A_QBLK) * A_DM + h * A_D; const u16* Gw = SG + (rowbase + q0 + wid * A_QBLK) * A_DM + h * A_D;
    u16* stg = (u16*)(lds + A_LDS_OST) + wid * 2048;
#pragma unroll
    for (int r = 0; r < 16; ++r) { const int orow = crow(r, hi);
#pragma unroll
        for (int d0 = 0; d0 < 2; ++d0) stg[orow * 64 + d0 * 32 + r32] = f2bf(o[d0][r] * rli[r]); }
    asm volatile("s_waitcnt lgkmcnt(0)" ::: "memory");
#pragma unroll
    for (int i = 0; i < 4; ++i) { const int row = i * 8 + (lane >> 3), ch = lane & 7;
        u32x4 ov = *(const u32x4*)(stg + row * 64 + ch * 8); u32x4 gv = *(const u32x4*)(Gw + (long)row * A_DM + ch * 8); u32x4 rv;
#pragma unroll
        for (int e = 0; e < 4; ++e) rv[e] = cvtpk(bflo(ov[e]) * bflo(gv[e]), bfhi(ov[e]) * bfhi(gv[e]));
        *(u32x4*)(Ow + (long)row * A_DM + ch * 8) = rv; }
    asm volatile("s_waitcnt vmcnt(0) lgkmcnt(0)\n\ts_barrier" ::: "memory");
#undef DMA_K
#undef DMA_V
#undef DMA_M
#undef MWORD
#undef ROT
#undef EX
#undef RESC
#undef PKW
#undef PAF
#undef VFR
#undef VRD
#undef KRD
#undef ENDW
#undef GAPA
#undef GAPB
#undef MAND
#undef STEP
}
__device__ __forceinline__ void phase_attn(const Params& p, char* lds) {
    constexpr int NPAIR = A_NQB / 2, NUNIT = NBATCH * A_NHEAD * NPAIR;
    const int bid_ = BID(), gdim_ = GDIM();
    for (int u = bid_; u < NUNIT; u += gdim_) {
        const int x = u & 7, kk = u >> 3, bh = x + 8 * (kk / NPAIR), j = kk % NPAIR;
        const int b = bh / A_NHEAD, h = bh % A_NHEAD;
        const u64* mb = p.mask() + (size_t)b * MASK_WORDS_PER_BATCH;
        attn64_unit(b, h, j, p.q(), p.k(), p.v(), p.sg(), p.bin(), mb + mk_base(j), lds);
        attn64_unit(b, h, A_NQB - 1 - j, p.q(), p.k(), p.v(), p.sg(), p.bin(), mb + mk_base(A_NQB - 1 - j), lds);
    }
}

struct EpiStash {
    static constexpr bool DUPOK = false;
    u16* stash;
    __device__ __forceinline__ void operator()(const acc_t& acc, const pg8::Unit& u, int ui, int wr, int wc, int fr, int fq) const {
        const int tid_ = TID();
        u32x4* st = (u32x4*)(stash + (size_t)(u.pm * 4 + u.pn) * 65536);
        ROWS_LOOP {
#pragma unroll
            for (int bj = 0; bj < 2; ++bj) { const f32x4 v0 = acc[ai][bj][m][0], v1 = acc[ai][bj][m][1];
                u32x4 w; w[0] = cvtpk(v0[0], v0[1]); w[1] = cvtpk(v0[2], v0[3]); w[2] = cvtpk(v1[0], v1[1]); w[3] = cvtpk(v1[2], v1[3]);
                st[((ai * 4 + m) * 2 + bj) * 512 + tid_] = w; } }
    }
};
struct EpiGate {
    static constexpr bool DUPOK = false;
    const Params& p; int l; int br;
    __device__ __forceinline__ void operator()(const acc_t& acc, const pg8::Unit& u, int ui, int wr, int wc, int fr, int fq) const {
        const float* ssq = p.sumsq() + (size_t)(l & 1) * T * 16;
        const int tid_ = TID();
        const u32x4* st = (const u32x4*)(p.stash() + (size_t)(u.pm * 4 + u.pn) * 65536);
        const int cl = wc * 4 + fq;
        __shared__ float s_rstd[256];
        { if (tid_ < 256) s_rstd[tid_] = row_rstd(ssq, u.pm * 256 + tid_); __syncthreads(); }
        float rsa[8];
#pragma unroll
        for (int ix = 0; ix < 8; ++ix) rsa[ix] = s_rstd[(ix >> 2) * 128 + wr * 64 + (ix & 3) * 16 + fr];
        const char* stp = (const char*)st + (size_t)tid_ * 16;
        char* mpp = (char*)(p.merged() + (size_t)(u.pm * 256 + wr * 64 + fr) * 1024 + u.pn * 256 + 16 * cl);
        u32x4 yb = *(const u32x4*)stp, ob = (br > 0) ? *(const u32x4*)mpp : (u32x4){0u, 0u, 0u, 0u};
        ROWS_LOOP { const int ix = ai * 4 + m; const float rs = rsa[ix];
#pragma unroll
            for (int bj = 0; bj < 2; ++bj) { const f32x4 v0 = acc[ai][bj][m][0] * rs, v1 = acc[ai][bj][m][1] * rs;
                float r[8];
                r[0] = sigmf(v0[0]) * bflo(yb[0]); r[1] = sigmf(v0[1]) * bfhi(yb[0]); r[2] = sigmf(v0[2]) * bflo(yb[1]); r[3] = sigmf(v0[3]) * bfhi(yb[1]);
                r[4] = sigmf(v1[0]) * bflo(yb[2]); r[5] = sigmf(v1[1]) * bfhi(yb[2]); r[6] = sigmf(v1[2]) * bflo(yb[3]); r[7] = sigmf(v1[3]) * bfhi(yb[3]);
                if (br > 0) {
#pragma unroll
                    for (int e = 0; e < 4; ++e) { r[2 * e] += bflo(ob[e]); r[2 * e + 1] += bfhi(ob[e]); } }
                u32x4 wo; wo[0] = cvtpk(r[0], r[1]); wo[1] = cvtpk(r[2], r[3]); wo[2] = cvtpk(r[4], r[5]); wo[3] = cvtpk(r[6], r[7]);
                const char* stn = stp + 8192; char* mpn = (bj == 0) ? (mpp + 16) : (mpp - 16 + ((ix == 3) ? 80 : 16) * 2048);
                asm volatile("" : "+v"(stn), "+v"(mpn));
                if (!(ix == 7 && bj == 1)) { yb = *(const u32x4*)stn; if (br > 0) ob = *(const u32x4*)mpn; }
                *(u32x4*)mpp = wo;
                stp = stn; mpp = mpn; } }
    }
};
__device__ __forceinline__ void phase_merge(const Params& p, int l, char* shm) {
    pg8::RowOrder S{4, 512, GDIM(), BID()};
    for (int br = 0; br < 3; ++br) {
        const u16* Ain = br == 0 ? p.ga() : (br == 1 ? p.bin() : p.sp());
        const u16* Wy = (br == 0 ? p.wt_oa() : (br == 1 ? p.wt_ob() : p.wt_oc())) + (size_t)l * 1024 * 512;
        { pg8::Gemm g{Ain, Wy, T, 1024, 512}; EpiStash E{p.stash()}; pg8::gemm_phase((PG8_LAS unsigned char*)shm, g, S, E); }
        { pg8::Gemm g{p.xb(), p.wt_mg() + (size_t)l * 3072 * 1024 + (size_t)br * 1024 * 1024, T, 1024, 1024}; EpiGate E{p, l, br}; pg8::gemm_phase((PG8_LAS unsigned char*)shm, g, S, E); }
    }
}

struct EpiOut {
    static constexpr bool DUPOK = false;
    const Params& p; int l;
    __device__ __forceinline__ void ldx(size_t o, f32x4& a, f32x4& b) const {
        if (l == 0) { a = *(const f32x4*)(p.x_in + o); b = *(const f32x4*)(p.x_in + o + 4); }
        else { const u32x4 w = *(const u32x4*)(p.xb() + o); a = (f32x4){bflo(w[0]), bfhi(w[0]), bflo(w[1]), bfhi(w[1])}; b = (f32x4){bflo(w[2]), bfhi(w[2]), bflo(w[3]), bfhi(w[3])}; }
    }
    __device__ __forceinline__ void operator()(const acc_t& acc, const pg8::Unit& u, int ui, int wr, int wc, int fr, int fq) const {
        const int cl = wc * 4 + fq;
        f32x4 xb0[2], xb1[2];
#pragma unroll
        for (int bj = 0; bj < 2; ++bj) ldx((size_t)(u.pm * 256 + wr * 64 + fr) * 1024 + u.pn * 256 + 16 * cl + bj * 8, xb0[bj], xb1[bj]);
        ROWS_LOOP { const int row = ROW_OF; const int ix = ai * 4 + m; float ss = 0.f;
            f32x4 x0[2], x1[2];
#pragma unroll
            for (int bj = 0; bj < 2; ++bj) { x0[bj] = xb0[bj] + acc[ai][bj][m][0]; x1[bj] = xb1[bj] + acc[ai][bj][m][1]; }
            if (ix < 7) { const int rown = u.pm * 256 + ((ix + 1) >> 2) * 128 + wr * 64 + ((ix + 1) & 3) * 16 + fr;
#pragma unroll
                for (int bj = 0; bj < 2; ++bj) ldx((size_t)rown * 1024 + u.pn * 256 + 16 * cl + bj * 8, xb0[bj], xb1[bj]); }
#pragma unroll
            for (int bj = 0; bj < 2; ++bj) { const size_t o = (size_t)row * 1024 + u.pn * 256 + 16 * cl + bj * 8;
                if (l == NL - 1) { *(f32x4*)(p.x + o) = x0[bj]; *(f32x4*)(p.x + o + 4) = x1[bj]; }
                else { u32x4 w; w[0] = cvtpk(x0[bj][0], x0[bj][1]); w[1] = cvtpk(x0[bj][2], x0[bj][3]); w[2] = cvtpk(x1[bj][0], x1[bj][1]); w[3] = cvtpk(x1[bj][2], x1[bj][3]); *(u32x4*)(p.xb() + o) = w;
#pragma unroll
                    for (int j = 0; j < 4; ++j) ss += x0[bj][j] * x0[bj][j] + x1[bj][j] * x1[bj][j]; } }
            if (l < NL - 1) { ss += __shfl_xor(ss, 16); ss += __shfl_xor(ss, 32); if (fq == 0) p.sumsq()[(size_t)((l + 1) & 1) * T * 16 + (size_t)row * 16 + u.pn * 4 + wc] = ss; } }
    }
};
__device__ __forceinline__ void phase_out(const Params& p, int l, char* shm) {
    pg8::RowOrder S{4, 512, GDIM(), BID()};
    pg8::Gemm g{p.merged(), p.wt_o() + (size_t)l * 1024 * 1024, T, 1024, 1024};
    EpiOut E{p, l};
    pg8::gemm_phase((PG8_LAS unsigned char*)shm, g, S, E);
}

enum { PH_PREP0 = 0, PH_IN, PH_MIX, PH_IDX, PH_SEL, PH_ATTN, PH_MERGE, PH_OUT };
template <int PH> __global__ __launch_bounds__(NTHR) void k_phase(Params p, int l, int b) {
    extern __shared__ __attribute__((aligned(16))) char shm[];
    if (PH == PH_PREP0) phase_prep0(p, shm);
    if (PH == PH_IN) phase_in(p, l, shm);
    if (PH == PH_MIX) phase_mix(p, l);
    if (PH == PH_IDX) phase_indexer(p, b, p.scores(), shm);
    if (PH == PH_SEL) phase_select(p, b, shm, p.scores());
    if (PH == PH_ATTN) phase_attn(p, shm);
    if (PH == PH_MERGE) phase_merge(p, l, shm);
    if (PH == PH_OUT) phase_out(p, l, shm);
}

#define XB_TMO      128
#define XB_XCNT(j)  (256  + 64 * (j))
#define XB_XSUB(j)  (1280 + 64 * (j))
#define XB_XGEN(j)  (2304 + 64 * (j))
#define XB_TOP      3328
#define XB_TOPGEN   3392
#define XCD_BAR_WORDS 3456
#define XB_SPIN_CAP (1u << 22)
#define LAS __attribute__((address_space(3)))
__device__ __forceinline__ unsigned xb_ld(unsigned* p)              { return __hip_atomic_load(p, __ATOMIC_RELAXED, __HIP_MEMORY_SCOPE_AGENT); }
__device__ __forceinline__ unsigned xb_add(unsigned* p, unsigned v) { return __hip_atomic_fetch_add(p, v, __ATOMIC_RELAXED, __HIP_MEMORY_SCOPE_AGENT); }
__device__ __forceinline__ unsigned xb_xcc_id() { return (unsigned)__builtin_amdgcn_s_getreg((3 << 11) | 20) & 0xFu; }
#define XB_SPIN(cond, bar) do { unsigned _sp = 0; while (cond) { __builtin_amdgcn_s_sleep(1); \
    if ((++_sp & 255u) == 0u) { if (xb_ld(&(bar)[XB_TMO])) break; if (_sp > XB_SPIN_CAP) { atomicAdd(&(bar)[XB_TMO], 1u); break; } } } } while (0)
struct XcdBarrier { unsigned* bar; unsigned x; volatile LAS unsigned* st; };
__device__ __forceinline__ XcdBarrier xcd_barrier_post(unsigned* bar, volatile LAS unsigned* st) {
    XcdBarrier b; b.bar = bar; b.x = xb_xcc_id(); b.st = st;
    if (threadIdx.x == 0) (void)xb_add(&bar[XB_XCNT(b.x)], 1u);
    return b;
}
__device__ __forceinline__ void xcd_barrier_complete(unsigned* bar, unsigned x, unsigned& nloc, unsigned& nx) {
    const unsigned G = gridDim.x * gridDim.y * gridDim.z;
    unsigned sum, cnt, mine, sp = 0u;
    for (;;) {
        sum = 0u; cnt = 0u; mine = 0u;
#pragma unroll
        for (unsigned j = 0; j < 16; ++j) { const unsigned c = xb_ld(&bar[XB_XCNT(j)]); sum += c; cnt += (c > 0u) ? 1u : 0u; mine = (j == x) ? c : mine; }
        if (sum == G) break;
        __builtin_amdgcn_s_sleep(1);
        if ((++sp & 255u) == 0u) { if (xb_ld(&bar[XB_TMO])) break; if (sp > XB_SPIN_CAP) { atomicAdd(&bar[XB_TMO], 1u); break; } }
    }
    nloc = mine > 0u ? mine : 1u; nx = cnt > 0u ? cnt : 1u;
}
__device__ __forceinline__ void xcd_barrier(const XcdBarrier& b) {
    asm volatile("s_waitcnt vmcnt(0)" ::: "memory");
    __syncthreads();
    if (threadIdx.x == 0) {
        unsigned* bar = b.bar;
        __builtin_amdgcn_s_waitcnt(0);
        unsigned nloc = b.st[0], nx = b.st[1];
        if (nloc == 0u) { xcd_barrier_complete(bar, b.x, nloc, nx); b.st[0] = nloc; b.st[1] = nx; }
        const unsigned old = xb_add(&bar[XB_XSUB(b.x)], 1u);
        const unsigned gen = old / nloc;
        if (old + 1u == (gen + 1u) * nloc) {
            __builtin_amdgcn_fence(__ATOMIC_RELEASE, "agent");
            asm volatile("s_waitcnt vmcnt(0)" ::: "memory");
            const unsigned og = xb_add(&bar[XB_TOP], 1u);
            const unsigned tg = og / nx;
            if (og + 1u == (tg + 1u) * nx) xb_add(&bar[XB_TOPGEN], 1u);
            else XB_SPIN(xb_ld(&bar[XB_TOPGEN]) == tg, bar);
            __builtin_amdgcn_fence(__ATOMIC_ACQUIRE, "agent");
            xb_add(&bar[XB_XGEN(b.x)], 1u);
            asm volatile("s_waitcnt vmcnt(0)" ::: "memory");
        } else {
            XB_SPIN(xb_ld(&bar[XB_XGEN(b.x)]) == gen, bar);
            __builtin_amdgcn_fence(__ATOMIC_ACQUIRE, "agent");
            asm volatile("s_waitcnt vmcnt(0)" ::: "memory");
        }
    }
    __syncthreads();
}

#if MEGA
typedef const __attribute__((address_space(4))) Params* kparams_t;
__device__ __forceinline__ Params load_params(kparams_t k) {
    Params q; q.x_in = k->x_in; q.norm_g = k->norm_g; q.w_in = k->w_in; q.conv_w = k->conv_w; q.w_out_conv = k->w_out_conv; q.q_g = k->q_g; q.k_g = k->k_g; q.w_out_attn = k->w_out_attn;
    q.pool_w = k->pool_w; q.pool_scale = k->pool_scale; q.w_out_pool = k->w_out_pool; q.w_o = k->w_o; q.x = k->x; q.ws = k->ws; return q; }
#define PHP(q) kparams_t kq_##q = kp; asm volatile("" : "+s"(kq_##q)); const Params q = load_params(kq_##q);
__global__ __launch_bounds__(NTHR) void k_mega(Params p_unused) {
    extern __shared__ __attribute__((aligned(16))) char shm[];
    cg::grid_group grid = cg::this_grid();
    kparams_t kp = (kparams_t)__builtin_amdgcn_kernarg_segment_ptr();
    __shared__ uint4 xb_words;
    if (threadIdx.x == 0) xb_words = make_uint4(0u, 0u, 0u, 0u);
    __syncthreads();
    const XcdBarrier xb = xcd_barrier_post((unsigned*)(kp->ws + WS_BAR), (volatile LAS unsigned*)&xb_words);

#ifndef SK_PREP
        { PHP(p) phase_prep0(p, shm); }
#endif
#ifdef DUP_PREP
        { PHP(p) phase_prep0(p, shm); }
#endif

    grid.sync();
    for (int l = 0; l < NL; ++l) {

#ifndef SK_IN
        { PHP(p) phase_in(p, l, shm); }
#endif
#ifdef DUP_IN
        { PHP(p) phase_in(p, l, shm); }
#endif

        xcd_barrier(xb);

        { PHP(p) phase_mix(p, l); phase_indexer(p, 0, p.scores(), shm); }
        xcd_barrier(xb);
        const bool wlo = __builtin_amdgcn_readfirstlane(TID() >> 6) < 4;
        { PHP(p) if (wlo) { phase_indexer(p, 1, p.scores2(), shm); phase_select(p, 0, shm, p.scores()); } else { phase_select(p, 0, shm, p.scores()); phase_indexer(p, 1, p.scores2(), shm); } }
        xcd_barrier(xb);
        { PHP(p) if (wlo) { phase_indexer(p, 2, p.scores(), shm); phase_select(p, 1, shm, p.scores2()); } else { phase_select(p, 1, shm, p.scores2()); phase_indexer(p, 2, p.scores(), shm); } }
        xcd_barrier(xb);
        { PHP(p) if (wlo) { phase_indexer(p, 3, p.scores2(), shm); phase_select(p, 2, shm, p.scores()); } else { phase_select(p, 2, shm, p.scores()); phase_indexer(p, 3, p.scores2(), shm); } }
        xcd_barrier(xb);
        { PHP(p) phase_select(p, 3, shm, p.scores2()); }
        xcd_barrier(xb);
#ifndef SK_ATTN
        { PHP(p) phase_attn(p, shm); }
#endif
#ifdef DUP_ATTN
        { PHP(p) phase_attn(p, shm); }
#endif

        xcd_barrier(xb);

#ifndef SK_MERGE
        { PHP(p) phase_merge(p, l, shm); }
#endif
#ifdef DUP_MERGE
        { PHP(p) phase_merge(p, l, shm); }
#endif

        xcd_barrier(xb);

#ifndef SK_OUT
        { PHP(p) phase_out(p, l, shm); }
#endif

        xcd_barrier(xb);
    }
}
#endif

static Params make_params(void* const* d_in, void* d_out, void* d_ws) {
    Params p{};
    p.x_in = (const float*)d_in[0]; p.norm_g = (const float*)d_in[1]; p.w_in = (const float*)d_in[2]; p.conv_w = (const float*)d_in[3];
    p.w_out_conv = (const float*)d_in[4]; p.q_g = (const float*)d_in[5]; p.k_g = (const float*)d_in[6]; p.w_out_attn = (const float*)d_in[7];
    p.pool_w = (const float*)d_in[8]; p.pool_scale = (const float*)d_in[9]; p.w_out_pool = (const float*)d_in[10]; p.w_o = (const float*)d_in[11];
    p.x = (float*)d_out; p.ws = (char*)d_ws;
    return p;
}

extern "C" void kernel_launch(void* const* d_in, const int* in_sizes, int n_in, void* d_out, int out_size, void* d_ws, size_t ws_size, hipStream_t stream) {
    if (ws_size < WS_NEEDED) { fprintf(stderr, "workspace too small: %zu < %zu\n", ws_size, (size_t)WS_NEEDED); return; }
    Params p = make_params(d_in, d_out, d_ws);
    static int grid = 0;
    if (!grid) { int dev = 0, cus = 0; hipGetDevice(&dev); hipDeviceGetAttribute(&cus, hipDeviceAttributeMultiprocessorCount, dev); if (cus <= 0 || cus > 256) cus = 256; grid = (cus / 8) * 8; }
#if MEGA
    static bool attr = false;
    if (!attr) { hipFuncSetAttribute((const void*)k_mega, hipFuncAttributeMaxDynamicSharedMemorySize, LDS_BYTES); attr = true; }
    hipMemsetAsync((char*)d_ws + WS_BAR, 0, 16384, stream);
    void* args[] = {&p};
    hipError_t e = hipLaunchCooperativeKernel((void*)k_mega, dim3(grid), dim3(NTHR), args, LDS_BYTES, stream);
    if (e != hipSuccess) fprintf(stderr, "cooperative launch failed: %s\n", hipGetErrorString(e));
#else
    static bool attr = false;
    if (!attr) {
        hipFuncSetAttribute((const void*)k_phase<PH_PREP0>, hipFuncAttributeMaxDynamicSharedMemorySize, LDS_BYTES);
        hipFuncSetAttribute((const void*)k_phase<PH_IN>, hipFuncAttributeMaxDynamicSharedMemorySize, LDS_BYTES);
        hipFuncSetAttribute((const void*)k_phase<PH_MIX>, hipFuncAttributeMaxDynamicSharedMemorySize, LDS_BYTES);
        hipFuncSetAttribute((const void*)k_phase<PH_IDX>, hipFuncAttributeMaxDynamicSharedMemorySize, LDS_BYTES);
        hipFuncSetAttribute((const void*)k_phase<PH_SEL>, hipFuncAttributeMaxDynamicSharedMemorySize, LDS_BYTES);
        hipFuncSetAttribute((const void*)k_phase<PH_ATTN>, hipFuncAttributeMaxDynamicSharedMemorySize, LDS_BYTES);
        hipFuncSetAttribute((const void*)k_phase<PH_MERGE>, hipFuncAttributeMaxDynamicSharedMemorySize, LDS_BYTES);
        hipFuncSetAttribute((const void*)k_phase<PH_OUT>, hipFuncAttributeMaxDynamicSharedMemorySize, LDS_BYTES);
        attr = true;
    }
#define LAUNCH(PH, l, b) hipLaunchKernelGGL(k_phase<PH>, dim3(grid), dim3(NTHR), LDS_BYTES, stream, p, l, b)
    LAUNCH(PH_PREP0, 0, 0);
    for (int l = 0; l < NL; ++l) {
        LAUNCH(PH_IN, l, 0);
        LAUNCH(PH_MIX, l, 0);
        for (int b = 0; b < NBATCH; ++b) { LAUNCH(PH_IDX, l, b); LAUNCH(PH_SEL, l, b); }
        LAUNCH(PH_ATTN, l, 0);
        LAUNCH(PH_MERGE, l, 0);
        LAUNCH(PH_OUT, l, 0);
    }
#endif
}
```
